# Optimizing an MI355X kernel written in HIP

```python
import math
import jax
import jax.numpy as jnp
from jax import lax
import numpy as np

D_MODEL = 1024
BATCH = 2
SEQ = 8192
DEPTH = 1
DEC_BATCH = 32
DEC_SEQ = 1
PAST_LEN = 8192
PAGE_SIZE = 128

N_MEM = 256
NSA_HEADS = 8
NSA_KV_HEADS = 2
NSA_GROUP = NSA_HEADS // NSA_KV_HEADS
HEAD_DIM = 64
CMP_BLOCK = 32
CMP_STRIDE = 16
SEL_BLOCK = 64
SEL_TOP = 16
WINDOW = 512
Q_BLOCK = 128
N_KV_SLOTS = 4
FORCE_BONUS = 1e4
GLA_HEADS = 4
GLA_DK = 64
GLA_DV = 128
GLA_GATE_RANK = 16
GLA_GATE_TAU = 16.0
GLA_CHUNK = 64
X_HEADS = 4
X_HEAD_DIM = 128
N_BUCKETS = 32
MAX_DISTANCE = 128
D_FF = 2816
CONV_W = 3
N_BRANCH = 3
EPS = 1e-6
NEG_INF = -1e30
TINY = 1e-30

NSA_QW = NSA_HEADS * HEAD_DIM
NSA_KVW = 6 * NSA_KV_HEADS * HEAD_DIM
NSA_GW = 3 * NSA_HEADS
GLA_KW = GLA_HEADS * GLA_DK
GLA_VW = GLA_HEADS * GLA_DV
X_W = X_HEADS * X_HEAD_DIM
IN_SIZES = (NSA_QW, NSA_KVW, NSA_GW, GLA_KW, GLA_KW, GLA_VW, GLA_GATE_RANK, GLA_VW, X_W, N_BRANCH * D_MODEL)
D_IN = sum(IN_SIZES)

kernel_name = 'nsa_gla_memory_hybrid_step'


def _rmsnorm(x, g):
    xf = x.astype(jnp.float32)
    y = xf * lax.rsqrt(jnp.mean(xf * xf, axis=-1, keepdims=True) + EPS)
    return (y * g.astype(jnp.float32)).astype(x.dtype)


def _t5_bucket(rel):
    n = jnp.maximum(rel, 0)
    max_exact = N_BUCKETS // 2
    nf = jnp.maximum(n, 1).astype(jnp.float32)
    large = max_exact + (jnp.log(nf / max_exact) / math.log(MAX_DISTANCE / max_exact)
                         * (N_BUCKETS - max_exact)).astype(jnp.int32)
    return jnp.where(n < max_exact, n, jnp.minimum(large, N_BUCKETS - 1))


def _masked_softmax(s, mask, axis):
    s = jnp.where(mask, s, NEG_INF)
    m = jnp.max(s, axis=axis, keepdims=True)
    p = jnp.where(mask, jnp.exp(s - m), 0.0)
    return p / jnp.maximum(jnp.sum(p, axis=axis, keepdims=True), TINY)


def _compress(rows, pe, w1, w2):
    b, length, nkv, dh = rows.shape
    n_chunks = length // CMP_STRIDE
    n_cmp = (length - CMP_BLOCK) // CMP_STRIDE + 1
    chunks = rows[:, :n_chunks * CMP_STRIDE].reshape(b, n_chunks, CMP_STRIDE, nkv, dh)
    hid = None
    for r in range(CMP_BLOCK // CMP_STRIDE):
        sl = slice(r * CMP_STRIDE, (r + 1) * CMP_STRIDE)
        part = jnp.einsum('bcjkd,jde->bcke', chunks + pe[sl][None, None, :, None, :], w1[sl])[:, r:r + n_cmp]
        hid = part if hid is None else hid + part
    return jax.nn.gelu(hid) @ w2


def _cmp_sel_overlap(n_cmp, n_sel):
    cs = (jnp.arange(n_cmp) * CMP_STRIDE)[:, None]
    ss = (jnp.arange(n_sel) * SEL_BLOCK)[None, :]
    return ((cs < ss + SEL_BLOCK) & (cs + CMP_BLOCK > ss)).astype(jnp.float32)


def _nsa_attend(q, gates, k_cmp, v_cmp, k_sel, v_sel, k_win, v_win, q0, pw0, rel_bias):
    b, tq = q.shape[:2]
    length = k_sel.shape[1]
    lw = k_win.shape[1]
    n_cmp = k_cmp.shape[1]
    n_sel = -(-length // SEL_BLOCK)
    top = min(SEL_TOP, n_sel)
    qb = min(Q_BLOCK, tq)
    nqb = -(-tq // qb)
    tp = nqb * qb
    f32 = jnp.float32
    scale = HEAD_DIM ** -0.5

    def blocks(a):
        a = jnp.pad(a, [(0, 0), (0, tp - tq)] + [(0, 0)] * (a.ndim - 2))
        return jnp.moveaxis(a.reshape((b, nqb, qb) + a.shape[2:]), 1, 0)

    q_blk = blocks(q.reshape(b, tq, NSA_KV_HEADS, NSA_GROUP, HEAD_DIM))
    g_blk = blocks(gates.reshape(b, tq, NSA_KV_HEADS, NSA_GROUP, 3))
    pad_sel = n_sel * SEL_BLOCK - length
    ks_blk = jnp.pad(k_sel, ((0, 0), (0, pad_sel), (0, 0), (0, 0))).reshape(b, n_sel, SEL_BLOCK, NSA_KV_HEADS, HEAD_DIM)
    vs_blk = jnp.pad(v_sel, ((0, 0), (0, pad_sel), (0, 0), (0, 0))).reshape(b, n_sel, SEL_BLOCK, NSA_KV_HEADS, HEAD_DIM)
    kw_pad = jnp.pad(k_win, ((0, 0), (WINDOW, qb), (0, 0), (0, 0)))
    vw_pad = jnp.pad(v_win, ((0, 0), (WINDOW, qb), (0, 0), (0, 0)))
    kc = k_cmp.astype(f32)
    vc = v_cmp.astype(f32)
    cmp_end = jnp.arange(n_cmp) * CMP_STRIDE + (CMP_BLOCK - 1)
    sel_id = jnp.arange(n_sel)
    overlap = _cmp_sel_overlap(n_cmp, n_sel)
    bias_hg = rel_bias.astype(f32).reshape(N_BUCKETS, NSA_KV_HEADS, NSA_GROUP)
    bias_kg = jnp.transpose(bias_hg, (1, 0, 2))
    b_ix = jnp.arange(b)[:, None, None, None]
    k_ix = jnp.arange(NSA_KV_HEADS)[None, None, :, None]
    win_len = WINDOW + qb

    def one_block(args):
        n, qn, gn = args
        qs = q0 + n * qb
        tpos = qs + jnp.arange(qb)
        qf = qn.astype(f32) * scale
        s_c = jnp.einsum('bqkgd,bckd->bqkgc', qf, kc)
        bias_c = bias_hg[_t5_bucket(tpos[:, None] - cmp_end[None, :])]
        s_c = s_c + jnp.transpose(bias_c, (0, 2, 3, 1))[None]
        mask_c = (cmp_end[None, :] <= tpos[:, None])[None, :, None, None, :]
        p_c = _masked_softmax(s_c, mask_c, -1)
        o_c = jnp.einsum('bqkgc,bckd->bqkgd', p_c, vc)
        imp = jnp.einsum('bqkgc,cj->bqkj', p_c, overlap)
        tblk = (tpos // SEL_BLOCK)[:, None]
        valid = sel_id[None, :] * SEL_BLOCK <= tpos[:, None]
        forced = (sel_id[None, :] == 0) | (sel_id[None, :] == tblk) | (sel_id[None, :] == tblk - 1)
        score = jnp.where(valid[None, :, None, :],
                          imp + jnp.where(forced, FORCE_BONUS, 0.0)[None, :, None, :], NEG_INF)
        _, idx = lax.top_k(score, top)
        k_g = ks_blk[b_ix, idx, :, k_ix, :].astype(f32)
        v_g = vs_blk[b_ix, idx, :, k_ix, :].astype(f32)
        pos = idx[..., None] * SEL_BLOCK + jnp.arange(SEL_BLOCK)
        rel = tpos[None, :, None, None, None] - pos
        s_s = jnp.einsum('bqkgd,bqktsd->bqkgts', qf, k_g)
        bias_s = bias_kg[k_ix[..., None], _t5_bucket(rel)]
        s_s = s_s + jnp.moveaxis(bias_s, -1, 3)
        mask_s = ((rel >= 0) & (pos < length))[:, :, :, None]
        p_s = _masked_softmax(s_s, mask_s, (-2, -1))
        o_s = jnp.einsum('bqkgts,bqktsd->bqkgd', p_s, v_g)
        start = qs - pw0
        k_w = lax.dynamic_slice_in_dim(kw_pad, start, win_len, axis=1).astype(f32)
        v_w = lax.dynamic_slice_in_dim(vw_pad, start, win_len, axis=1).astype(f32)
        wpos = qs - WINDOW + jnp.arange(win_len)
        rel_w = tpos[:, None] - wpos[None, :]
        s_w = jnp.einsum('bqkgd,bskd->bqkgs', qf, k_w)
        s_w = s_w + jnp.transpose(bias_hg[_t5_bucket(rel_w)], (0, 2, 3, 1))[None]
        mask_w = ((rel_w >= 0) & (rel_w < WINDOW) & (wpos[None, :] >= pw0)
                  & (wpos[None, :] < pw0 + lw))[None, :, None, None, :]
        p_w = _masked_softmax(s_w, mask_w, -1)
        o_w = jnp.einsum('bqkgs,bskd->bqkgd', p_w, v_w)
        gf = gn.astype(f32)
        o = gf[..., 0:1] * o_c + gf[..., 1:2] * o_s + gf[..., 2:3] * o_w
        return o.astype(q.dtype)

    out = lax.map(one_block, (jnp.arange(nqb), q_blk, g_blk))
    return jnp.moveaxis(out, 0, 1).reshape(b, tp, NSA_HEADS, HEAD_DIM)[:, :tq]


def _gla(q, k, v, log_a, s0):
    b, t, nh, _ = q.shape
    dv = v.shape[-1]
    c = min(GLA_CHUNK, t)
    nc = -(-t // c)
    tp = nc * c

    def prep(a):
        a = jnp.pad(a.astype(jnp.float32), ((0, 0), (0, tp - t), (0, 0), (0, 0)))
        return jnp.transpose(a.reshape(b, nc, c, nh, a.shape[-1]), (1, 0, 3, 2, 4))

    causal = jnp.tril(jnp.ones((c, c), dtype=bool))[None, None, :, :, None]

    def step(s, inp):
        qc, kc, vc, ac = inp
        cb = jnp.cumsum(ac, axis=2)
        diff = cb[:, :, :, None, :] - cb[:, :, None, :, :]
        decay = jnp.exp(jnp.where(causal, diff, -jnp.inf))
        att = jnp.einsum('bhtd,bhsd,bhtsd->bhts', qc, kc, decay)
        o = jnp.einsum('bhtd,bhde->bhte', qc * jnp.exp(cb), s) + jnp.einsum('bhts,bhse->bhte', att, vc)
        last = cb[:, :, -1, :]
        s = jnp.exp(last)[..., None] * s + jnp.einsum('bhsd,bhse->bhde', kc * jnp.exp(last[:, :, None, :] - cb), vc)
        return s, o

    s_new, o = lax.scan(step, s0.astype(jnp.float32), (prep(q), prep(k), prep(v), prep(log_a)))
    o = jnp.transpose(o, (1, 0, 3, 2, 4)).reshape(b, tp, nh, dv)[:, :t]
    return o, s_new


def _conv_ffn(h, conv_past, w_up, conv_w, conv_b, w_down):
    t = h.shape[1]
    u, g = jnp.split(h @ w_up, 2, axis=-1)
    g_ext = jnp.concatenate([conv_past.astype(g.dtype), g], axis=1)
    gc = conv_b + sum(conv_w[j] * g_ext[:, j:j + t] for j in range(CONV_W))
    out = (jax.nn.gelu(gc) * u) @ w_down
    return out, g_ext[:, g_ext.shape[1] - (CONV_W - 1):]


def _memory_kv(mem, g_mem, w_mem_kv, g_x_k):
    b, m, _ = mem.shape
    kv = (_rmsnorm(mem, g_mem) @ w_mem_kv).reshape(b, m, 2, X_HEADS, X_HEAD_DIM)
    return jnp.stack([_rmsnorm(kv[:, :, 0], g_x_k), kv[:, :, 1]], axis=2)


def _layer(x, past_rows, win_past, gla_s0, conv_past, mem_kv, q0, p):
    b, t, _ = x.shape
    f32 = jnp.float32
    h = _rmsnorm(x, p['g_mix'])
    splits = [int(s) for s in np.cumsum(IN_SIZES)[:-1]]
    (nsa_q, nsa_kv, nsa_g, gla_q, gla_k, gla_v, gla_lr, gla_r, x_q, merge_g) = jnp.split(h @ p['w_in'], splits, axis=-1)

    g_k = p['g_nsa_k']
    q = _rmsnorm(nsa_q.reshape(b, t, NSA_HEADS, HEAD_DIM), p['g_nsa_q'])
    kv = nsa_kv.reshape(b, t, 6, NSA_KV_HEADS, HEAD_DIM)
    new_rows = jnp.stack([kv[:, :, 0], kv[:, :, 1], _rmsnorm(kv[:, :, 2], g_k[1]), kv[:, :, 3]], axis=2)
    new_win = jnp.stack([_rmsnorm(kv[:, :, 4], g_k[2]), kv[:, :, 5]], axis=2)
    rows = jnp.concatenate([past_rows.astype(x.dtype), new_rows], axis=1)
    win_all = jnp.concatenate([win_past.astype(x.dtype), new_win], axis=1)
    k_cmp = _rmsnorm(_compress(rows[:, :, 0], p['cmp_k_pe'], p['cmp_k_w1'], p['cmp_k_w2']), g_k[0])
    v_cmp = _compress(rows[:, :, 1], p['cmp_v_pe'], p['cmp_v_w1'], p['cmp_v_w2'])
    nsa_gates = jax.nn.sigmoid(nsa_g.reshape(b, t, NSA_HEADS, 3))
    o_nsa = _nsa_attend(q, nsa_gates, k_cmp, v_cmp, rows[:, :, 2], rows[:, :, 3],
                        win_all[:, :, 0], win_all[:, :, 1], q0, q0 - win_past.shape[1], p['rel_bias'])
    new_win_state = win_all[:, win_all.shape[1] - min(WINDOW, q0 + t):]

    gq = gla_q.reshape(b, t, GLA_HEADS, GLA_DK) * (GLA_DK ** -0.5)
    gk = gla_k.reshape(b, t, GLA_HEADS, GLA_DK)
    gv = gla_v.reshape(b, t, GLA_HEADS, GLA_DV)
    log_a = jax.nn.log_sigmoid((gla_lr @ p['w_gla_gate'] + p['b_gla_gate']).astype(f32)) / GLA_GATE_TAU
    o_gla, s_new = _gla(gq, gk, gv, log_a.reshape(b, t, GLA_HEADS, GLA_DK), gla_s0)
    o_gla = _rmsnorm(o_gla.astype(x.dtype), p['g_gla_o']).reshape(b, t, GLA_VW) * jax.nn.silu(gla_r)

    xq = _rmsnorm(x_q.reshape(b, t, X_HEADS, X_HEAD_DIM), p['g_x_q'])
    s_x = jnp.einsum('bthd,bmhd->bhtm', xq.astype(f32) * (X_HEAD_DIM ** -0.5), mem_kv[:, :, 0].astype(f32))
    o_x = jnp.einsum('bhtm,bmhd->bthd', jax.nn.softmax(s_x, axis=-1), mem_kv[:, :, 1].astype(f32))
    o_x = o_x.astype(x.dtype).reshape(b, t, X_W)

    mg = jax.nn.sigmoid(merge_g.reshape(b, t, N_BRANCH, D_MODEL))
    merged = (mg[:, :, 0] * (o_nsa.reshape(b, t, NSA_QW) @ p['w_nsa_out'])
              + mg[:, :, 1] * (o_gla @ p['w_gla_out'])
              + mg[:, :, 2] * (o_x @ p['w_x_out']))
    x1 = x + merged @ p['w_o']

    ffn, conv_state = _conv_ffn(_rmsnorm(x1, p['g_ffn']), conv_past, p['w_up'], p['conv_w'], p['conv_b'], p['w_down'])
    y = x1 + ffn
    return y, new_rows, new_win_state, s_new.astype(gla_s0.dtype), conv_state


def setup_inputs(seed: int = 0) -> dict:
    key = jax.random.key(seed)
    keys = iter(jax.random.split(key, 48))
    f32 = jnp.float32

    def nrm(shape, scale):
        return jax.random.normal(next(keys), shape, f32) * scale

    def gain(shape):
        return 1.0 + 0.05 * jax.random.normal(next(keys), shape, f32)

    n_pages = PAST_LEN // PAGE_SIZE
    n_used = DEC_BATCH * n_pages
    n_phys = n_used + max(1, n_used // 4)
    win_buf = min(WINDOW, PAST_LEN)
    d = D_MODEL
    x_prompt = nrm((BATCH, SEQ, d), 1.0)
    x_sample = nrm((DEC_BATCH, DEC_SEQ, d), 1.0)
    cache_kv = nrm((n_phys, PAGE_SIZE, N_KV_SLOTS, NSA_KV_HEADS, HEAD_DIM), 1.0)
    cache_win = nrm((DEC_BATCH, win_buf, 2, NSA_KV_HEADS, HEAD_DIM), 1.0)
    state_gla = nrm((DEC_BATCH, GLA_HEADS, GLA_DK, GLA_DV), 1.0)
    state_conv = nrm((DEC_BATCH, CONV_W - 1, D_FF), 1.0)
    cache_mem = nrm((DEC_BATCH, N_MEM, 2, X_HEADS, X_HEAD_DIM), 1.0)
    page_table = jax.random.permutation(next(keys), n_phys)[:n_used].reshape(DEC_BATCH, n_pages).astype(jnp.int32)
    mem_prompt = nrm((BATCH, N_MEM, d), 1.0)
    return {
        'x_prompt': x_prompt, 'x_sample': x_sample, 'cache_kv': cache_kv, 'cache_win': cache_win,
        'state_gla': state_gla, 'state_conv': state_conv, 'cache_mem': cache_mem,
        'page_table': page_table, 'mem_prompt': mem_prompt,
        'g_mix': gain((d,)),
        'w_in': nrm((d, D_IN), d ** -0.5),
        'g_nsa_q': gain((HEAD_DIM,)),
        'g_nsa_k': gain((3, HEAD_DIM)),
        'cmp_k_pe': nrm((CMP_BLOCK, HEAD_DIM), 0.1),
        'cmp_k_w1': nrm((CMP_BLOCK, HEAD_DIM, HEAD_DIM), (CMP_BLOCK * HEAD_DIM) ** -0.5),
        'cmp_k_w2': nrm((HEAD_DIM, HEAD_DIM), HEAD_DIM ** -0.5),
        'cmp_v_pe': nrm((CMP_BLOCK, HEAD_DIM), 0.1),
        'cmp_v_w1': nrm((CMP_BLOCK, HEAD_DIM, HEAD_DIM), (CMP_BLOCK * HEAD_DIM) ** -0.5),
        'cmp_v_w2': nrm((HEAD_DIM, HEAD_DIM), HEAD_DIM ** -0.5),
        'rel_bias': nrm((N_BUCKETS, NSA_HEADS), 0.5),
        'w_gla_gate': nrm((GLA_GATE_RANK, GLA_KW), GLA_GATE_RANK ** -0.5),
        'b_gla_gate': nrm((GLA_KW,), 0.1),
        'g_gla_o': gain((GLA_DV,)),
        'g_mem': gain((d,)),
        'w_mem_kv': nrm((d, 2 * X_W), d ** -0.5),
        'g_x_q': gain((X_HEAD_DIM,)),
        'g_x_k': gain((X_HEAD_DIM,)),
        'w_nsa_out': nrm((NSA_QW, d), NSA_QW ** -0.5),
        'w_gla_out': nrm((GLA_VW, d), GLA_VW ** -0.5),
        'w_x_out': nrm((X_W, d), X_W ** -0.5),
        'w_o': nrm((d, d), d ** -0.5),
        'g_ffn': gain((d,)),
        'w_up': nrm((d, 2 * D_FF), d ** -0.5),
        'conv_w': nrm((CONV_W, D_FF), CONV_W ** -0.5),
        'conv_b': nrm((D_FF,), 0.02),
        'w_down': nrm((D_FF, d), D_FF ** -0.5),
    }


def reference(x_prompt, x_sample, cache_kv, cache_win, state_gla, state_conv, cache_mem, page_table, mem_prompt,
              g_mix, w_in, g_nsa_q, g_nsa_k, cmp_k_pe, cmp_k_w1, cmp_k_w2, cmp_v_pe, cmp_v_w1, cmp_v_w2,
              rel_bias, w_gla_gate, b_gla_gate, g_gla_o, g_mem, w_mem_kv, g_x_q, g_x_k,
              w_nsa_out, w_gla_out, w_x_out, w_o, g_ffn, w_up, conv_w, conv_b, w_down):
    p = dict(g_mix=g_mix, w_in=w_in, g_nsa_q=g_nsa_q, g_nsa_k=g_nsa_k,
             cmp_k_pe=cmp_k_pe, cmp_k_w1=cmp_k_w1, cmp_k_w2=cmp_k_w2,
             cmp_v_pe=cmp_v_pe, cmp_v_w1=cmp_v_w1, cmp_v_w2=cmp_v_w2,
             rel_bias=rel_bias, w_gla_gate=w_gla_gate, b_gla_gate=b_gla_gate, g_gla_o=g_gla_o,
             g_x_q=g_x_q, w_nsa_out=w_nsa_out, w_gla_out=w_gla_out, w_x_out=w_x_out, w_o=w_o,
             g_ffn=g_ffn, w_up=w_up, conv_w=conv_w, conv_b=conv_b, w_down=w_down)
    dt = x_prompt.dtype
    bp = x_prompt.shape[0]
    db = x_sample.shape[0]

    mem_kv_p = _memory_kv(mem_prompt, g_mem, w_mem_kv, g_x_k)
    y_p, rows_p, win_p, gla_p, conv_p = _layer(
        x_prompt,
        jnp.zeros((bp, 0, N_KV_SLOTS, NSA_KV_HEADS, HEAD_DIM), dt),
        jnp.zeros((bp, 0, 2, NSA_KV_HEADS, HEAD_DIM), dt),
        jnp.zeros((bp, GLA_HEADS, GLA_DK, GLA_DV), dt),
        jnp.zeros((bp, CONV_W - 1, D_FF), dt),
        mem_kv_p, 0, p)

    n_pages = page_table.shape[1]
    past_len = n_pages * cache_kv.shape[1]
    past_rows = cache_kv[page_table].reshape((db, past_len) + cache_kv.shape[2:])
    y_s, rows_s, win_s, gla_s, conv_s = _layer(
        x_sample, past_rows, cache_win, state_gla, state_conv, cache_mem, past_len, p)

    return (y_p, y_s, rows_p, win_p, gla_p, conv_p, mem_kv_p, rows_s, win_s, gla_s, conv_s)
```

```cpp
#include <hip/hip_runtime.h>
#include <hip/hip_cooperative_groups.h>
#include <cstdio>
#include <cstdint>
namespace cg = cooperative_groups;
#ifndef MK_N_LAUNCHES
#define MK_N_LAUNCHES 1
#endif
namespace pg8 {
#define PG8_LAS __attribute__((address_space(3)))
typedef unsigned short bf16_t;
typedef short bf16x8 __attribute__((ext_vector_type(8)));
typedef float f32x4 __attribute__((ext_vector_type(4)));
typedef unsigned u32x4 __attribute__((ext_vector_type(4)));
constexpr int BM = 256, BK = 64, HALF = 128, HTB = HALF * BK * 2  , STAGE_BYTES = 8 * HTB, NXCD = 8, WGM = 8;

__host__ __device__ __forceinline__ int lds_byte(int r, int c) { const int st = (r >> 4) * 2 + (c >> 5), rr = r & 15, cc = c & 31, ob = rr * 64 + cc * 2; return st * 1024 + (ob ^ (((ob >> 9) & 1) << 5)); }
__host__ __device__ __forceinline__ void stage_rc(int b, int& R, int& C) { const int st = b / 1024, sb = b % 1024, swz = sb ^ (((sb >> 9) & 1) << 5); R = (st >> 1) * 16 + swz / 64; C = (st & 1) * 32 + (swz % 64) / 2; }
__host__ __device__ __forceinline__ int perm32(int rho) { const int n = rho >> 4, i = rho & 15; return 8 * (i >> 2) + 4 * n + (i & 3); }

struct Unit { int pm, pn; };
struct Gemm { const bf16_t* A; const bf16_t* Bt; int M, N, K; };

struct StaticOrder {
    int nM, nN, nwg, G, c;
    __host__ __device__ void init(int M, int N, int G_, int c_) { nM = M / BM; nN = N / BM; nwg = nM * nN; G = G_; c = c_; }
    __host__ __device__ bool next(int i, Unit& u) const {
        const long L = (long)i * G + c; if (L >= nwg) return false;
        int wgid = (int)L; { const int q = nwg / NXCD, r = nwg % NXCD, xcd = wgid % NXCD, off = wgid / NXCD; wgid = (xcd < r ? xcd * (q + 1) : r * (q + 1) + (xcd - r) * q) + off; }
        const int nig = WGM * nN, gid = wgid / nig, fm = gid * WGM, gsz = (nM - fm) < WGM ? (nM - fm) : WGM;
        u.pm = fm + ((wgid % nig) % gsz); u.pn = (wgid % nig) / gsz; return true;
    }
    __device__ __forceinline__ void a_ready(const Unit&) const {}
    __device__ __forceinline__ void done(const Unit&) const {}
};

__device__ __forceinline__ unsigned cvt_pk_bf16(float lo, float hi) { unsigned r; asm volatile("v_cvt_pk_bf16_f32 %0, %1, %2" : "=v"(r) : "v"(lo), "v"(hi)); return r; }
__device__ __forceinline__ float bflo(unsigned w) { return __uint_as_float(w << 16); }
__device__ __forceinline__ float bfhi(unsigned w) { return __uint_as_float(w & 0xffff0000u); }
__device__ __forceinline__ float sigm(float x) { return 1.0f / (1.0f + __expf(-x)); }
struct EpiStore {
    static constexpr bool PERM = true, AFTER_DRAIN = false;
    bf16_t* O; int ldc; const float* ssq;
    __device__ __forceinline__ void operator()(const f32x4 (&acc)[2][2][4][2], const Unit& u, int wr, int wc, int fr, int fq) const {
        const int row0 = u.pm * BM + wr * 64 + fr, col0 = u.pn * BM + wc * 32 + 8 * fq;
#pragma unroll
        for (int ai = 0; ai < 2; ++ai)
#pragma unroll
            for (int m = 0; m < 4; ++m) { const int row = row0 + ai * HALF + m * 16; bf16_t* rowp = O + (size_t)row * ldc + col0;
                const float sc = ssq ? rsqrtf(ssq[row] * (1.0f / 1024.0f) + 1e-6f) : 1.0f;
#pragma unroll
                for (int bj = 0; bj < 2; ++bj) { const f32x4 v0 = acc[ai][bj][m][0] * sc, v1 = acc[ai][bj][m][1] * sc;
                    u32x4 w; w.x = cvt_pk_bf16(v0[0], v0[1]); w.y = cvt_pk_bf16(v0[2], v0[3]); w.z = cvt_pk_bf16(v1[0], v1[1]); w.w = cvt_pk_bf16(v1[2], v1[3]);
                    *(u32x4*)(rowp + bj * HALF) = w; } }
    }
};
template <int ACCUM> struct EpiMerge {
    static constexpr bool PERM = true, AFTER_DRAIN = false;
    const bf16_t* gate; int ldg; bf16_t* O; int ldc;
    __device__ __forceinline__ void operator()(const f32x4 (&acc)[2][2][4][2], const Unit& u, int wr, int wc, int fr, int fq) const {
        const int row0 = u.pm * BM + wr * 64 + fr, col0 = u.pn * BM + wc * 32 + 8 * fq;
#pragma unroll
        for (int ai = 0; ai < 2; ++ai)
#pragma unroll
            for (int m = 0; m < 4; ++m) { const int row = row0 + ai * HALF + m * 16; bf16_t* rowp = O + (size_t)row * ldc + col0; const bf16_t* gp = gate + (size_t)row * ldg + col0;
#pragma unroll
                for (int bj = 0; bj < 2; ++bj) {
                    const u32x4 g = *(const u32x4*)(gp + bj * HALF);
                    f32x4 v0 = acc[ai][bj][m][0], v1 = acc[ai][bj][m][1];
                    v0[0] *= sigm(bflo(g.x)); v0[1] *= sigm(bfhi(g.x)); v0[2] *= sigm(bflo(g.y)); v0[3] *= sigm(bfhi(g.y));
                    v1[0] *= sigm(bflo(g.z)); v1[1] *= sigm(bfhi(g.z)); v1[2] *= sigm(bflo(g.w)); v1[3] *= sigm(bfhi(g.w));
                    if (ACCUM) { const u32x4 o = *(const u32x4*)(rowp + bj * HALF);
                        v0[0] += bflo(o.x); v0[1] += bfhi(o.x); v0[2] += bflo(o.y); v0[3] += bfhi(o.y);
                        v1[0] += bflo(o.z); v1[1] += bfhi(o.z); v1[2] += bflo(o.w); v1[3] += bfhi(o.w); }
                    u32x4 w; w.x = cvt_pk_bf16(v0[0], v0[1]); w.y = cvt_pk_bf16(v0[2], v0[3]); w.z = cvt_pk_bf16(v1[0], v1[1]); w.w = cvt_pk_bf16(v1[2], v1[3]);
                    *(u32x4*)(rowp + bj * HALF) = w; } }
    }
};
struct EpiWo {
    static constexpr bool PERM = true, AFTER_DRAIN = false;
    const float* xp; const float* xs; float* X1; bf16_t* X1B; float* ssq;
    __device__ __forceinline__ void operator()(const f32x4 (&acc)[2][2][4][2], const Unit& u, int wr, int wc, int fr, int fq) const {
        const int row0 = u.pm * BM + wr * 64 + fr, col0 = u.pn * BM + wc * 32 + 8 * fq;
#pragma unroll
        for (int ai = 0; ai < 2; ++ai)
#pragma unroll
            for (int m = 0; m < 4; ++m) { const int row = row0 + ai * HALF + m * 16;
                const float* xr = row < 16384 ? xp + (size_t)row * 1024 : (row < 16416 ? xs + (size_t)(row - 16384) * 1024 : nullptr);
                float ss = 0.f;
#pragma unroll
                for (int bj = 0; bj < 2; ++bj) { const int col = col0 + bj * HALF;
                    f32x4 x0 = (f32x4){0.f, 0.f, 0.f, 0.f}, x1 = x0;
                    if (xr) { x0 = *(const f32x4*)(xr + col); x1 = *(const f32x4*)(xr + col + 4); }
                    const f32x4 v0 = acc[ai][bj][m][0] + x0, v1 = acc[ai][bj][m][1] + x1;
                    *(f32x4*)(X1 + (size_t)row * 1024 + col) = v0; *(f32x4*)(X1 + (size_t)row * 1024 + col + 4) = v1;
                    u32x4 w; w.x = cvt_pk_bf16(v0[0], v0[1]); w.y = cvt_pk_bf16(v0[2], v0[3]); w.z = cvt_pk_bf16(v1[0], v1[1]); w.w = cvt_pk_bf16(v1[2], v1[3]);
                    *(u32x4*)(X1B + (size_t)row * 1024 + col) = w;
                    ss += (v0[0] * v0[0] + v0[1] * v0[1]) + (v0[2] * v0[2] + v0[3] * v0[3]) + (v1[0] * v1[0] + v1[1] * v1[1]) + (v1[2] * v1[2] + v1[3] * v1[3]); }
                ss += __shfl_xor(ss, 16); ss += __shfl_xor(ss, 32);
                if (fq == 0) atomicAdd(ssq + row, ss); }
    }
};
struct EpiDown {
    static constexpr bool PERM = true, AFTER_DRAIN = false;
    const float* X1; float* yp; float* ys;
    __device__ __forceinline__ void operator()(const f32x4 (&acc)[2][2][4][2], const Unit& u, int wr, int wc, int fr, int fq) const {
        const int row0 = u.pm * BM + wr * 64 + fr, col0 = u.pn * BM + wc * 32 + 8 * fq;
#pragma unroll
        for (int ai = 0; ai < 2; ++ai)
#pragma unroll
            for (int m = 0; m < 4; ++m) { const int row = row0 + ai * HALF + m * 16;
                float* yr = row < 16384 ? yp + (size_t)row * 1024 : (row < 16416 ? ys + (size_t)(row - 16384) * 1024 : nullptr);
                if (!yr) continue;
#pragma unroll
                for (int bj = 0; bj < 2; ++bj) { const int col = col0 + bj * HALF;
                    const f32x4 x0 = *(const f32x4*)(X1 + (size_t)row * 1024 + col), x1 = *(const f32x4*)(X1 + (size_t)row * 1024 + col + 4);
                    *(f32x4*)(yr + col) = acc[ai][bj][m][0] + x0; *(f32x4*)(yr + col + 4) = acc[ai][bj][m][1] + x1; } }
    }
};
template <class Epi, class Sched, bool ALIGN_EPI = false, bool SP2 = false>
__device__ __forceinline__ void gemm_phase(PG8_LAS unsigned char* lds, const Gemm g, const Sched& S, const Epi& E) {
    const int tid = threadIdx.x, wid = __builtin_amdgcn_readfirstlane(tid >> 6), lane = tid & 63, wr = wid >> 2, wc = wid & 3, fr = lane & 15, fq = lane >> 4;
    const int K = g.K, nt = K / BK;
    unsigned voffA[2], voffB[2];
#pragma unroll
    for (int i = 0; i < 2; ++i) { int R, C; stage_rc(tid * 16 + i * 8192, R, C); const int Rb = Epi::PERM ? ((R & ~31) + perm32(R & 31)) : R;
        voffA[i] = (unsigned)(R * K + C) * 2u; voffB[i] = (unsigned)(Rb * K + C) * 2u; }
    const size_t kstep = (size_t)(BK * 2);
    const size_t hstep = (size_t)HALF * K * 2;
    const size_t tstep = 2 * hstep;
    const unsigned ldsw = (unsigned)wid * 1024u;
    const int aoff = lds_byte(wr * 64 + fr, fq * 8), boff = lds_byte(wc * 32 + fr, fq * 8);
#define PG8_SA(b, h) (((b) * 2 + (h)) * HTB)
#define PG8_SB(b, h) ((4 + (b) * 2 + (h)) * HTB)
#define PG8_STAGE(bufoff, gbase, voff) do { _Pragma("unroll") for (int _i = 0; _i < 2; ++_i) \
        __builtin_amdgcn_global_load_lds((const unsigned*)((const char*)(gbase) + (voff)[_i]), (PG8_LAS unsigned*)(lds + (bufoff) + ldsw + _i * 8192), 16, 0, 0); } while (0)
#define PG8_LDA(dst, b, h) do { _Pragma("unroll") for (int m = 0; m < 4; ++m) _Pragma("unroll") for (int k = 0; k < 2; ++k) dst[m][k] = *(const PG8_LAS bf16x8*)(lds + PG8_SA(b, h) + aoff + m * 2048 + k * 1024); } while (0)
#define PG8_LDB(dst, b, h) do { _Pragma("unroll") for (int n = 0; n < 2; ++n) _Pragma("unroll") for (int k = 0; k < 2; ++k) dst[n][k] = *(const PG8_LAS bf16x8*)(lds + PG8_SB(b, h) + boff + n * 2048 + k * 1024); } while (0)
#define PG8_MMA(ai, bj, At, Bt) do { __builtin_amdgcn_s_setprio(1); _Pragma("unroll") for (int m = 0; m < 4; ++m) _Pragma("unroll") for (int n = 0; n < 2; ++n) _Pragma("unroll") for (int k = 0; k < 2; ++k) \
        acc[ai][bj][m][n] = __builtin_amdgcn_mfma_f32_16x16x32_bf16(Bt[n][k], At[m][k], acc[ai][bj][m][n], 0, 0, 0); __builtin_amdgcn_s_setprio(0); } while (0)
#define PG8_WAIT_V(n) asm volatile("s_waitcnt vmcnt(" #n ")" ::: "memory")
#define PG8_WAIT_L(n) asm volatile("s_waitcnt lgkmcnt(" #n ")" ::: "memory")
#define PG8_BAR __builtin_amdgcn_s_barrier()
#define PG8_SCHED __builtin_amdgcn_sched_barrier(0)
    Unit cur, nxt; int ui = 0;
    if (!S.next(0, cur)) return;
    f32x4 acc[2][2][4][2];
#pragma unroll
    for (int a = 0; a < 2; ++a)
#pragma unroll
        for (int b = 0; b < 2; ++b)
#pragma unroll
            for (int m = 0; m < 4; ++m)
#pragma unroll
                for (int n = 0; n < 2; ++n) acc[a][b][m][n] = (f32x4){0.f, 0.f, 0.f, 0.f};
    bf16x8 At[4][2], B0[2][2], B1[2][2];
    const char* cA = (const char*)g.A + (size_t)cur.pm * tstep; const char* cB = (const char*)g.Bt + (size_t)cur.pn * tstep;
    S.a_ready(cur);
    if constexpr (SP2) {
        PG8_STAGE(PG8_SB(0, 0), cB, voffB); PG8_STAGE(PG8_SB(0, 1), cB + hstep, voffB); PG8_STAGE(PG8_SA(0, 0), cA, voffA); PG8_STAGE(PG8_SA(0, 1), cA + hstep, voffA);
        if (wr == 1) PG8_BAR;
        PG8_WAIT_V(2); PG8_BAR;
        PG8_STAGE(PG8_SB(1, 0), cB + kstep, voffB); PG8_STAGE(PG8_SA(1, 0), cA + kstep, voffA); PG8_STAGE(PG8_SB(1, 1), cB + hstep + kstep, voffB);
        PG8_WAIT_V(6); PG8_BAR;
    } else {
        PG8_STAGE(PG8_SB(0, 0), cB, voffB); PG8_STAGE(PG8_SA(0, 0), cA, voffA); PG8_STAGE(PG8_SB(0, 1), cB + hstep, voffB); PG8_STAGE(PG8_SA(0, 1), cA + hstep, voffA);
        if (wr == 1) PG8_BAR;
        PG8_WAIT_V(4); PG8_BAR;
        PG8_STAGE(PG8_SB(1, 0), cB + kstep, voffB); PG8_STAGE(PG8_SA(1, 0), cA + kstep, voffA); PG8_STAGE(PG8_SB(1, 1), cB + hstep + kstep, voffB);
        PG8_WAIT_V(6); PG8_BAR;
    }
    for (;;) {
        const bool has_next = S.next(ui + 1, nxt);
        const char* nA = has_next ? (const char*)g.A + (size_t)nxt.pm * tstep : cA; const char* nB = has_next ? (const char*)g.Bt + (size_t)nxt.pn * tstep : cB;
        for (int t = 0; t < nt; t += 2) {
            const bool last = (t == nt - 2);
            const char* a1 = cA + (size_t)(t + 1) * kstep;
            const char* a2 = last ? nA : cA + (size_t)(t + 2) * kstep; const char* b2 = last ? nB : cB + (size_t)(t + 2) * kstep;
            const char* a3 = a2 + kstep; const char* b3 = b2 + kstep;
            if (last && has_next) S.a_ready(nxt);
            if constexpr (SP2) {
            PG8_LDB(B0, 0, 0); PG8_LDB(B1, 0, 1); PG8_SCHED; PG8_LDA(At, 0, 0); PG8_STAGE(PG8_SA(1, 1), a1 + hstep, voffA);
            PG8_WAIT_V(8); PG8_WAIT_L(0); PG8_BAR; PG8_MMA(0, 0, At, B0); PG8_MMA(0, 1, At, B1); PG8_BAR; PG8_SCHED;
            PG8_LDA(At, 0, 1); PG8_STAGE(PG8_SB(0, 0), b2, voffB); PG8_STAGE(PG8_SB(0, 1), b2 + hstep, voffB); PG8_STAGE(PG8_SA(0, 0), a2, voffA);
            PG8_WAIT_V(8); PG8_WAIT_L(0); PG8_BAR; PG8_MMA(1, 0, At, B0); PG8_MMA(1, 1, At, B1); PG8_BAR; PG8_SCHED;
            PG8_LDB(B0, 1, 0); PG8_LDB(B1, 1, 1); PG8_SCHED; PG8_LDA(At, 1, 0); PG8_STAGE(PG8_SA(0, 1), a2 + hstep, voffA);
            PG8_WAIT_V(8); PG8_WAIT_L(0); PG8_BAR; PG8_MMA(0, 0, At, B0); PG8_MMA(0, 1, At, B1); PG8_BAR; PG8_SCHED;
            PG8_LDA(At, 1, 1); PG8_STAGE(PG8_SB(1, 0), b3, voffB); PG8_STAGE(PG8_SB(1, 1), b3 + hstep, voffB); PG8_STAGE(PG8_SA(1, 0), a3, voffA);
            PG8_WAIT_V(8); PG8_WAIT_L(0); PG8_BAR; PG8_MMA(1, 0, At, B0); PG8_MMA(1, 1, At, B1); PG8_BAR; PG8_SCHED;
            } else {
            PG8_LDB(B0, 0, 0); PG8_SCHED; PG8_LDA(At, 0, 0); PG8_STAGE(PG8_SA(1, 1), a1 + hstep, voffA);
            PG8_WAIT_L(8); PG8_BAR; PG8_WAIT_L(0); PG8_MMA(0, 0, At, B0); PG8_BAR; PG8_SCHED;
            PG8_LDB(B1, 0, 1); PG8_STAGE(PG8_SB(0, 0), b2, voffB);
            PG8_BAR; PG8_WAIT_L(0); PG8_MMA(0, 1, At, B1); PG8_BAR;
            PG8_LDA(At, 0, 1); PG8_STAGE(PG8_SA(0, 0), a2, voffA);
            PG8_BAR; PG8_WAIT_L(0); PG8_MMA(1, 0, At, B0); PG8_BAR; PG8_SCHED;
            PG8_STAGE(PG8_SB(0, 1), b2 + hstep, voffB);
            PG8_WAIT_V(6); PG8_BAR; PG8_MMA(1, 1, At, B1); PG8_BAR;
            PG8_LDB(B0, 1, 0); PG8_SCHED; PG8_LDA(At, 1, 0); PG8_STAGE(PG8_SA(0, 1), a2 + hstep, voffA);
            PG8_WAIT_L(8); PG8_BAR; PG8_WAIT_L(0); PG8_MMA(0, 0, At, B0); PG8_BAR; PG8_SCHED;
            PG8_LDB(B1, 1, 1); PG8_STAGE(PG8_SB(1, 0), b3, voffB);
            PG8_BAR; PG8_WAIT_L(0); PG8_MMA(0, 1, At, B1); PG8_BAR;
            PG8_LDA(At, 1, 1); PG8_STAGE(PG8_SA(1, 0), a3, voffA);
            PG8_BAR; PG8_WAIT_L(0); PG8_MMA(1, 0, At, B0); PG8_BAR; PG8_SCHED;
            PG8_STAGE(PG8_SB(1, 1), b3 + hstep, voffB);
            PG8_WAIT_V(6); PG8_BAR; PG8_MMA(1, 1, At, B1); PG8_BAR;
            }
        }
        if constexpr (ALIGN_EPI) { if (wr == 0) PG8_BAR; }
        if constexpr (!Epi::AFTER_DRAIN) { E(acc, cur, wr, wc, fr, fq); S.done(cur); }
        if (!has_next) break;
#pragma unroll
        for (int a = 0; a < 2; ++a)
#pragma unroll
            for (int b = 0; b < 2; ++b)
#pragma unroll
                for (int m = 0; m < 4; ++m)
#pragma unroll
                    for (int n = 0; n < 2; ++n) acc[a][b][m][n] = (f32x4){0.f, 0.f, 0.f, 0.f};
        cur = nxt; cA = nA; cB = nB; ++ui;
        if constexpr (ALIGN_EPI) { if (wr == 1) PG8_BAR; }
    }
    PG8_WAIT_V(0);
    if constexpr (!ALIGN_EPI) { if (wr == 0) PG8_BAR; }
    PG8_BAR;
    if constexpr (Epi::AFTER_DRAIN) { E.fused(acc, cur, wr, wc, fr, fq, lds, wid, lane); S.done(cur); }
#undef PG8_SA
#undef PG8_SB
#undef PG8_STAGE
#undef PG8_LDA
#undef PG8_LDB
#undef PG8_MMA
#undef PG8_WAIT_V
#undef PG8_WAIT_L
#undef PG8_BAR
#undef PG8_SCHED
}
}

typedef unsigned short bf16;
typedef short bf16x8 __attribute__((ext_vector_type(8)));
typedef short bf16x4 __attribute__((ext_vector_type(4)));
typedef float f32x4 __attribute__((ext_vector_type(4)));
typedef unsigned u32x4 __attribute__((ext_vector_type(4)));
typedef unsigned u32x2 __attribute__((ext_vector_type(2)));
#define LAS __attribute__((address_space(3)))
constexpr int NWAVES = 8, NTHR = 512;
constexpr int DM = 1024, T = 8192, NB = 2, NTOKP = NB * T, SB = 32, NTOK = NTOKP + SB, MPAD = 16640;
constexpr int DIN = 6440, DINP = 6656, DFF = 2816, DUP = 2 * DFF;
constexpr int C_Q = 0, C_KV = 512, C_G = 1280, C_GQ = 1304, C_GK = 1560, C_GV = 1816, C_LR = 2328, C_GR = 2344, C_XQ = 2856, C_MG = 3368;
constexpr float EPS = 1e-6f, LOG2E = 1.4426950408889634f;
constexpr float QSCALE = 0.125f * LOG2E;
constexpr float XSCALE = 0.08838834764831845f * LOG2E;
constexpr size_t O_Y = 0, O_YS = 16777216, O_KVP = O_YS + 32768, O_WINP = O_KVP + 8388608, O_GLAP = O_WINP + 262144, O_CONVP = O_GLAP + 65536,
                 O_MEMP = O_CONVP + 11264, O_KVS = O_MEMP + 524288, O_WINS = O_KVS + 16384, O_GLAS = O_WINS + 4194304, O_CONVS = O_GLAS + 1048576, O_END = O_CONVS + 180224;
enum { I_XP = 0, I_XS, I_CKV, I_CWIN, I_SGLA, I_SCONV, I_CMEM, I_PT, I_MEMP, I_GMIX, I_WIN, I_GNQ, I_GNK, I_CKPE, I_CKW1, I_CKW2, I_CVPE, I_CVW1, I_CVW2,
       I_RB, I_WGG, I_BGG, I_GGO, I_GMEM, I_WMEM, I_GXQ, I_GXK, I_WNSA, I_WGLA, I_WX, I_WO, I_GFFN, I_WUP, I_CONVW, I_CONVB, I_WDOWN, N_IN };
constexpr size_t al_(size_t x) { return (x + 255) & ~(size_t)255; }
constexpr size_t WS_SSQ = 0;
constexpr size_t WS_C0 = al_(WS_SSQ + (size_t)MPAD * 4);
constexpr size_t WS_WTIN = al_(WS_C0 + 1024);
constexpr size_t WS_WTMEM = al_(WS_WTIN + (size_t)DINP * 1024 * 2);
constexpr size_t WS_WTNSA = al_(WS_WTMEM + (size_t)1024 * 1024 * 2);
constexpr size_t WS_WTGLA = al_(WS_WTNSA + (size_t)1024 * 512 * 2);
constexpr size_t WS_WTX = al_(WS_WTGLA + (size_t)1024 * 512 * 2);
constexpr size_t WS_WTO = al_(WS_WTX + (size_t)1024 * 512 * 2);
constexpr size_t WS_WTUP = al_(WS_WTO + (size_t)1024 * 1024 * 2);
constexpr size_t WS_WTDOWN = al_(WS_WTUP + (size_t)DUP * 1024 * 2);
constexpr size_t WS_W1T = al_(WS_WTDOWN + (size_t)1024 * DFF * 2);
constexpr size_t WS_W2T = al_(WS_W1T + (size_t)2 * 64 * 2048 * 2);
constexpr size_t WS_XN = al_(WS_W2T + (size_t)2 * 64 * 64 * 2);
constexpr size_t WS_MN = al_(WS_XN + (size_t)MPAD * 1024 * 2);
constexpr size_t WS_PROJ = al_(WS_MN + (size_t)512 * 1024 * 2);
constexpr size_t WS_MEMPROJ = al_(WS_PROJ + (size_t)MPAD * DINP * 2);
constexpr size_t WS_QN = al_(WS_MEMPROJ + (size_t)512 * 1024 * 2);
constexpr size_t WS_KSEL = al_(WS_QN + (size_t)NTOK * 512 * 2);
constexpr size_t WS_VSELT = al_(WS_KSEL + (size_t)4 * T * 64 * 2);
constexpr size_t WS_KWIN = al_(WS_VSELT + (size_t)4 * T * 64 * 2);
constexpr size_t WS_VWINT = al_(WS_KWIN + (size_t)4 * T * 64 * 2);
constexpr size_t WS_GATES = al_(WS_VWINT + (size_t)4 * T * 64 * 2);
constexpr size_t WS_NEWKV = al_(WS_GATES + (size_t)NTOK * 24 * 4);
constexpr size_t WS_KCMP = al_(WS_NEWKV + (size_t)SB * 4 * 2 * 64 * 4);
constexpr size_t WS_VCMPT = al_(WS_KCMP + (size_t)4 * 512 * 64 * 2);
constexpr size_t WS_KCMPS = al_(WS_VCMPT + (size_t)4 * 512 * 64 * 2);
constexpr size_t WS_VCMPS = al_(WS_KCMPS + (size_t)SB * 2 * 512 * 64 * 4);
constexpr size_t WS_QTG = al_(WS_VCMPS + (size_t)SB * 2 * 512 * 64 * 4);
constexpr size_t WS_KTG = al_(WS_QTG + (size_t)NTOKP * 256 * 2);
constexpr size_t WS_VTG = al_(WS_KTG + (size_t)NTOKP * 256 * 2);
constexpr size_t WS_UP = al_(WS_VTG + (size_t)256 * 4 * 128 * 64 * 2);
constexpr size_t WS_DEC = al_(WS_UP + (size_t)256 * 4 * 128 * 64 * 4);
constexpr size_t WS_SC = al_(WS_DEC + (size_t)256 * 4 * 64 * 4);
constexpr size_t WS_XQ = al_(WS_SC + (size_t)256 * 4 * 128 * 64 * 2);
constexpr size_t WS_KMEM = al_(WS_XQ + (size_t)NTOK * 512 * 2);
constexpr size_t WS_VMEMT = al_(WS_KMEM + (size_t)8 * 256 * 128 * 2);
constexpr size_t WS_ONSA = al_(WS_VMEMT + (size_t)8 * 256 * 128 * 2);
constexpr size_t WS_OGLA = al_(WS_ONSA + (size_t)MPAD * 512 * 2);
constexpr size_t WS_OX = al_(WS_OGLA + (size_t)MPAD * 512 * 2);
constexpr size_t WS_MERGED = al_(WS_OX + (size_t)MPAD * 512 * 2);
constexpr size_t WS_X1 = al_(WS_MERGED + (size_t)MPAD * 1024 * 2);
constexpr size_t WS_X1B = al_(WS_X1 + (size_t)MPAD * 1024 * 4);
constexpr size_t WS_UG = al_(WS_X1B + (size_t)MPAD * 1024 * 2);
constexpr size_t WS_ACT = al_(WS_UG + (size_t)MPAD * DUP * 2);
constexpr size_t WS_END = al_(WS_ACT + (size_t)MPAD * DFF * 2);
constexpr int RING_BYTES = 131072, LDS_BYTES = 147456;

struct Args { const float* in[N_IN]; float* out; unsigned char* ws; int ph_lo, ph_hi; };

__device__ __forceinline__ unsigned f2bf(float f) { unsigned u = __float_as_uint(f); return (u + 0x7fffu + ((u >> 16) & 1u)) >> 16; }
__device__ __forceinline__ unsigned pk2(float lo, float hi) { return pg8::cvt_pk_bf16(lo, hi); }
__device__ __forceinline__ float bf2f(unsigned short u) { return __uint_as_float((unsigned)u << 16); }
__device__ __forceinline__ float bflo(unsigned w) { return __uint_as_float(w << 16); }
__device__ __forceinline__ float bfhi(unsigned w) { return __uint_as_float(w & 0xffff0000u); }
__device__ __forceinline__ void unpack8(const u32x4 w, float (&f)[8]) { f[0] = bflo(w.x); f[1] = bfhi(w.x); f[2] = bflo(w.y); f[3] = bfhi(w.y); f[4] = bflo(w.z); f[5] = bfhi(w.z); f[6] = bflo(w.w); f[7] = bfhi(w.w); }
__device__ __forceinline__ u32x4 pack8(const float (&f)[8]) { u32x4 w; w.x = pk2(f[0], f[1]); w.y = pk2(f[2], f[3]); w.z = pk2(f[4], f[5]); w.w = pk2(f[6], f[7]); return w; }
__device__ __forceinline__ bf16x8 as_frag(u32x4 w) { return __builtin_bit_cast(bf16x8, w); }
__device__ __forceinline__ bf16x8 frag_pk(f32x4 a, f32x4 b) { u32x4 w; w.x = pk2(a[0], a[1]); w.y = pk2(a[2], a[3]); w.z = pk2(b[0], b[1]); w.w = pk2(b[2], b[3]); return as_frag(w); }
__device__ __forceinline__ bf16x8 ldfrag(const bf16* p) { return as_frag(*(const u32x4*)p); }
__device__ __forceinline__ bf16x8 ldfrag2(const bf16* p0, const bf16* p1) { const u32x2 a = *(const u32x2*)p0, b = *(const u32x2*)p1; u32x4 w; w.x = a.x; w.y = a.y; w.z = b.x; w.w = b.y; return as_frag(w); }
__device__ __forceinline__ bf16x8 ldfrag_f32(const float* p) { const f32x4 a = *(const f32x4*)p, b = *(const f32x4*)(p + 4); return frag_pk(a, b); }
#define MFMA16(a, b, c) __builtin_amdgcn_mfma_f32_16x16x32_bf16((a), (b), (c), 0, 0, 0)
__device__ __forceinline__ float sigmoidf_(float x) { return 1.0f / (1.0f + __expf(-x)); }
__device__ __forceinline__ float gelu_tanh(float x) { const float u = 0.7978845608028654f * (x + 0.044715f * x * x * x); const float e = __expf(2.0f * u); return 0.5f * x * (2.0f - 2.0f / (e + 1.0f)); }
__device__ __forceinline__ float wave_sum(float v) {
#pragma unroll
    for (int o = 1; o < 64; o <<= 1) v += __shfl_xor(v, o);
    return v;
}
__device__ __forceinline__ float wave_max(float v) {
#pragma unroll
    for (int o = 1; o < 64; o <<= 1) v = fmaxf(v, __shfl_xor(v, o));
    return v;
}
__device__ __forceinline__ float absmax_arr(const float* g, int n, int lane) { float m = 0.f; for (int i = lane; i < n; i += 64) m = fmaxf(m, fabsf(g[i])); return wave_max(m); }
__device__ __forceinline__ int t5_bucket(int n) {
    if (n < 16) return n;
    if (n >= 128) return 31;
    const int v = 16 + (int)(__logf((float)n * 0.0625f) / 2.0794415416798357f * 16.0f);
    return v < 31 ? v : 31;
}

struct Frame {
    LAS unsigned char* lds;
    int tid, lane, wave, G, bid, gw, NGW;
    const float* const* in; float* out; unsigned char* ws;
};
#define WSP(T_, off) ((T_*)(F.ws + (off)))

__device__ __forceinline__ void transpose_item(const float* W, int K, int N, bf16* WT, const float* kscale, LAS float* scr, int item, int nblk, int lane) {
    const int kb = item / nblk, nb = item % nblk, k0 = 64 * kb, n0 = 32 * nb;
#pragma unroll 8
    for (int i = 0; i < 32; ++i) { const int kk = 2 * i + (lane >> 5); const int n = n0 + (lane & 31);
        float v = n < N ? W[(size_t)(k0 + kk) * N + n] : 0.f; if (kscale) v *= kscale[k0 + kk];
        scr[kk * 33 + (lane & 31)] = v; }
    asm volatile("s_waitcnt lgkmcnt(0)" ::: "memory");
    const int c = lane & 7;
#pragma unroll
    for (int j = 0; j < 4; ++j) { const int n = (lane >> 3) + 8 * j; const LAS float* s = scr + (8 * c) * 33 + n;
        u32x4 o; o.x = pk2(s[0 * 33], s[1 * 33]); o.y = pk2(s[2 * 33], s[3 * 33]); o.z = pk2(s[4 * 33], s[5 * 33]); o.w = pk2(s[6 * 33], s[7 * 33]);
        *(u32x4*)(WT + (size_t)(n0 + n) * K + k0 + 8 * c) = o; }
    asm volatile("s_waitcnt lgkmcnt(0)" ::: "memory");
}
__device__ __forceinline__ void rms_row_to_bf16(const float* xrow, const float* g, bf16* orow, int lane) {
    unsigned long long* o8 = (unsigned long long*)orow + lane;
    if (!xrow) {
#pragma unroll
        for (int j = 0; j < 4; ++j) o8[64 * j] = 0ull;
        return; }
    const f32x4* xr = (const f32x4*)xrow + lane; const f32x4* gr = (const f32x4*)g + lane;
    f32x4 v[4]; float s = 0.f;
#pragma unroll
    for (int j = 0; j < 4; ++j) { v[j] = xr[64 * j]; s += (v[j].x * v[j].x + v[j].y * v[j].y) + (v[j].z * v[j].z + v[j].w * v[j].w); }
    const float rs = rsqrtf(wave_sum(s) * (1.f / 1024.f) + EPS);
#pragma unroll
    for (int j = 0; j < 4; ++j) { const f32x4 gg = gr[64 * j]; const f32x4 y = v[j] * rs * gg;
        o8[64 * j] = (unsigned long long)pk2(y.x, y.y) | ((unsigned long long)pk2(y.z, y.w) << 32); }
}
__device__ __forceinline__ void p0_prologue(Frame& F) {
    LAS float* scr = (LAS float*)(F.lds + F.wave * 16384);
    const int gw = F.gw, NGW = F.NGW;
    constexpr int IT_IN = 16 * 208, IT_MEM = 16 * 32, IT_BR = 8 * 32, IT_O = 16 * 32, IT_UP = 16 * 176, IT_DOWN = 44 * 32, IT_W1 = 32 * 2, IT_W2 = 1 * 2;
    constexpr int NITEMS = IT_IN + IT_MEM + 3 * IT_BR + IT_O + IT_UP + IT_DOWN + 2 * IT_W1 + 2 * IT_W2;
    for (int it = gw; it < NITEMS; it += NGW) {
        int r = it;
        if (r < IT_UP) { transpose_item(F.in[I_WUP], 1024, DUP, WSP(bf16, WS_WTUP), F.in[I_GFFN], scr, r, 176, F.lane); continue; } r -= IT_UP;
        if (r < IT_IN) { transpose_item(F.in[I_WIN], 1024, DIN, WSP(bf16, WS_WTIN), nullptr, scr, r, 208, F.lane); continue; } r -= IT_IN;
        if (r < IT_DOWN) { transpose_item(F.in[I_WDOWN], DFF, 1024, WSP(bf16, WS_WTDOWN), nullptr, scr, r, 32, F.lane); continue; } r -= IT_DOWN;
        if (r < IT_MEM) { transpose_item(F.in[I_WMEM], 1024, 1024, WSP(bf16, WS_WTMEM), nullptr, scr, r, 32, F.lane); continue; } r -= IT_MEM;
        if (r < IT_O) { transpose_item(F.in[I_WO], 1024, 1024, WSP(bf16, WS_WTO), nullptr, scr, r, 32, F.lane); continue; } r -= IT_O;
        if (r < IT_BR) { transpose_item(F.in[I_WNSA], 512, 1024, WSP(bf16, WS_WTNSA), nullptr, scr, r, 32, F.lane); continue; } r -= IT_BR;
        if (r < IT_BR) { transpose_item(F.in[I_WGLA], 512, 1024, WSP(bf16, WS_WTGLA), nullptr, scr, r, 32, F.lane); continue; } r -= IT_BR;
        if (r < IT_BR) { transpose_item(F.in[I_WX], 512, 1024, WSP(bf16, WS_WTX), nullptr, scr, r, 32, F.lane); continue; } r -= IT_BR;
        if (r < IT_W1) { transpose_item(F.in[I_CKW1], 2048, 64, WSP(bf16, WS_W1T), nullptr, scr, r, 2, F.lane); continue; } r -= IT_W1;
        if (r < IT_W1) { transpose_item(F.in[I_CVW1], 2048, 64, WSP(bf16, WS_W1T) + 64 * 2048, nullptr, scr, r, 2, F.lane); continue; } r -= IT_W1;
        if (r < IT_W2) { transpose_item(F.in[I_CKW2], 64, 64, WSP(bf16, WS_W2T), nullptr, scr, r, 2, F.lane); continue; } r -= IT_W2;
        transpose_item(F.in[I_CVW2], 64, 64, WSP(bf16, WS_W2T) + 64 * 64, nullptr, scr, r, 2, F.lane);
    }
    for (int m = gw; m < MPAD + 512; m += NGW) {
        if (m < MPAD) { const float* xr = m < NTOKP ? F.in[I_XP] + (size_t)m * 1024 : (m < NTOK ? F.in[I_XS] + (size_t)(m - NTOKP) * 1024 : nullptr);
            rms_row_to_bf16(xr, F.in[I_GMIX], WSP(bf16, WS_XN) + (size_t)m * 1024, F.lane); }
        else { const int mm = m - MPAD; rms_row_to_bf16(F.in[I_MEMP] + (size_t)mm * 1024, F.in[I_GMEM], WSP(bf16, WS_MN) + (size_t)mm * 1024, F.lane); }
    }
    { float* ssq = WSP(float, WS_SSQ); for (int i = F.bid * NTHR + F.tid; i < MPAD; i += F.G * NTHR) ssq[i] = 0.f; }
    for (int s = gw; s < 2; s += NGW) { const float* pe = F.in[s ? I_CVPE : I_CKPE]; const float* w1 = F.in[s ? I_CVW1 : I_CKW1]; float a = 0.f;
        for (int k = 0; k < 2048; ++k) a += pe[k] * w1[(size_t)k * 64 + F.lane];
        WSP(float, WS_C0)[s * 64 + F.lane] = a; }
    { const f32x4* src = (const f32x4*)F.in[I_CWIN]; f32x4* dst = (f32x4*)(F.out + O_WINS);
      for (int i = F.bid * NTHR + F.tid; i < SB * 511 * 64; i += F.G * NTHR) { const int b = i / (511 * 64), r = i % (511 * 64); dst[(size_t)b * 512 * 64 + r] = src[(size_t)b * 512 * 64 + 64 + r]; } }
}

__device__ __forceinline__ void p2_token(Frame& F, int tok) {
    const int lane = F.lane; const bf16* pr = WSP(bf16, WS_PROJ) + (size_t)tok * DINP;
    const bool prompt = tok < NTOKP; const int b = tok >> 13, t = tok & (T - 1), sb = tok - NTOKP;
    float f[8];
    { unpack8(*(const u32x4*)(pr + C_Q + 8 * lane), f); float ss = 0.f;
#pragma unroll
      for (int i = 0; i < 8; ++i) ss += f[i] * f[i];
      ss += __shfl_xor(ss, 1); ss += __shfl_xor(ss, 2); ss += __shfl_xor(ss, 4);
      const float rs = rsqrtf(ss * (1.f / 64.f) + EPS) * QSCALE; const float* g = F.in[I_GNQ] + 8 * (lane & 7);
#pragma unroll
      for (int i = 0; i < 8; ++i) f[i] *= rs * g[i];
      *(u32x4*)(WSP(bf16, WS_QN) + (size_t)tok * 512 + 8 * lane) = pack8(f); }
    { unpack8(*(const u32x4*)(pr + C_KV + 8 * lane), f); float ss = 0.f;
#pragma unroll
      for (int i = 0; i < 8; ++i) ss += f[i] * f[i];
      ss += __shfl_xor(ss, 1); ss += __shfl_xor(ss, 2); ss += __shfl_xor(ss, 4);
      const int grp = lane >> 3, slot = grp >> 1, kv = grp & 1, d0 = 8 * (lane & 7);
      if (slot == 2) { const float rs = rsqrtf(ss * (1.f / 64.f) + EPS); const float* g = F.in[I_GNK] + 64 + d0;
#pragma unroll
          for (int i = 0; i < 8; ++i) f[i] *= rs * g[i]; }
      float* orow = prompt ? F.out + O_KVP + (size_t)tok * 512 + 8 * lane : F.out + O_KVS + (size_t)sb * 512 + 8 * lane;
      *(f32x4*)orow = (f32x4){f[0], f[1], f[2], f[3]}; *(f32x4*)(orow + 4) = (f32x4){f[4], f[5], f[6], f[7]};
      if (prompt) {
          if (slot == 2) *(u32x4*)(WSP(bf16, WS_KSEL) + ((size_t)(b * 2 + kv) * T + t) * 64 + d0) = pack8(f);
          if (slot == 3) { bf16* vt = WSP(bf16, WS_VSELT) + (((size_t)(b * 2 + kv) * 128 + (t >> 6)) * 64 + d0) * 64 + (t & 63);
#pragma unroll
              for (int i = 0; i < 8; ++i) vt[i * 64] = (bf16)f2bf(f[i]); }
      } else if (slot >= 2) { float* nk = WSP(float, WS_NEWKV) + ((size_t)(sb * 4 + (slot - 2)) * 2 + kv) * 64 + d0;
#pragma unroll
          for (int i = 0; i < 8; ++i) nk[i] = f[i]; }
    }
    { unpack8(*(const u32x4*)(pr + C_KV + 512 + 8 * lane), f); float ss = 0.f;
#pragma unroll
      for (int i = 0; i < 8; ++i) ss += f[i] * f[i];
      ss += __shfl_xor(ss, 1); ss += __shfl_xor(ss, 2); ss += __shfl_xor(ss, 4);
      const int grp = lane >> 3, slot = 4 + (grp >> 1), kv = grp & 1, d0 = 8 * (lane & 7);
      if (lane < 32) {
          if (slot == 4) { const float rs = rsqrtf(ss * (1.f / 64.f) + EPS); const float* g = F.in[I_GNK] + 128 + d0;
#pragma unroll
              for (int i = 0; i < 8; ++i) f[i] *= rs * g[i]; }
          if (prompt) {
              if (slot == 4) *(u32x4*)(WSP(bf16, WS_KWIN) + ((size_t)(b * 2 + kv) * T + t) * 64 + d0) = pack8(f);
              else { bf16* vt = WSP(bf16, WS_VWINT) + (((size_t)(b * 2 + kv) * 128 + (t >> 6)) * 64 + d0) * 64 + (t & 63);
#pragma unroll
                  for (int i = 0; i < 8; ++i) vt[i * 64] = (bf16)f2bf(f[i]); }
              if (t >= T - 512) { float* orow = F.out + O_WINP + ((size_t)b * 512 + (t - (T - 512))) * 256 + 8 * lane;
                  *(f32x4*)orow = (f32x4){f[0], f[1], f[2], f[3]}; *(f32x4*)(orow + 4) = (f32x4){f[4], f[5], f[6], f[7]}; }
          } else {
              float* nk = WSP(float, WS_NEWKV) + ((size_t)(sb * 4 + (slot - 2)) * 2 + kv) * 64 + d0;
#pragma unroll
              for (int i = 0; i < 8; ++i) nk[i] = f[i];
              float* orow = F.out + O_WINS + ((size_t)sb * 512 + 511) * 256 + 8 * lane;
              *(f32x4*)orow = (f32x4){f[0], f[1], f[2], f[3]}; *(f32x4*)(orow + 4) = (f32x4){f[4], f[5], f[6], f[7]};
          }
      }
    }
    if (lane < 24) WSP(float, WS_GATES)[(size_t)tok * 24 + lane] = sigmoidf_(bf2f(pr[C_G + lane]));
    { unpack8(*(const u32x4*)(pr + C_XQ + 8 * lane), f); float ss = 0.f;
#pragma unroll
      for (int i = 0; i < 8; ++i) ss += f[i] * f[i];
      ss += __shfl_xor(ss, 1); ss += __shfl_xor(ss, 2); ss += __shfl_xor(ss, 4); ss += __shfl_xor(ss, 8);
      const float rs = rsqrtf(ss * (1.f / 128.f) + EPS) * XSCALE; const float* g = F.in[I_GXQ] + 8 * (lane & 15);
#pragma unroll
      for (int i = 0; i < 8; ++i) f[i] *= rs * g[i];
      *(u32x4*)(WSP(bf16, WS_XQ) + (size_t)tok * 512 + 8 * lane) = pack8(f); }
}
__device__ __forceinline__ void p2_memrow(Frame& F, int row) {
    const int lane = F.lane, b = row >> 8, m = row & 255, head = lane >> 4, d0 = 8 * (lane & 15);
    const bf16* pr = WSP(bf16, WS_MEMPROJ) + (size_t)row * 1024; float f[8];
    { unpack8(*(const u32x4*)(pr + 8 * lane), f); float ss = 0.f;
#pragma unroll
      for (int i = 0; i < 8; ++i) ss += f[i] * f[i];
      ss += __shfl_xor(ss, 1); ss += __shfl_xor(ss, 2); ss += __shfl_xor(ss, 4); ss += __shfl_xor(ss, 8);
      const float rs = rsqrtf(ss * (1.f / 128.f) + EPS); const float* g = F.in[I_GXK] + d0;
#pragma unroll
      for (int i = 0; i < 8; ++i) f[i] *= rs * g[i];
      float* orow = F.out + O_MEMP + ((size_t)row * 2 + 0) * 512 + 8 * lane;
      *(f32x4*)orow = (f32x4){f[0], f[1], f[2], f[3]}; *(f32x4*)(orow + 4) = (f32x4){f[4], f[5], f[6], f[7]};
      *(u32x4*)(WSP(bf16, WS_KMEM) + ((size_t)(b * 4 + head) * 256 + m) * 128 + d0) = pack8(f); }
    { unpack8(*(const u32x4*)(pr + 512 + 8 * lane), f);
      float* orow = F.out + O_MEMP + ((size_t)row * 2 + 1) * 512 + 8 * lane;
      *(f32x4*)orow = (f32x4){f[0], f[1], f[2], f[3]}; *(f32x4*)(orow + 4) = (f32x4){f[4], f[5], f[6], f[7]};
      bf16* vt = WSP(bf16, WS_VMEMT) + ((size_t)(b * 4 + head) * 128 + d0) * 256 + m;
#pragma unroll
      for (int i = 0; i < 8; ++i) vt[i * 256] = (bf16)f2bf(f[i]); }
}

constexpr int CMP_TASKS_S = SB * 2 * 2 * 16, CMP_TASKS_P = NB * 2 * 2 * 16;
__device__ __forceinline__ void p2_compress(Frame& F, int task) {
    const int lane = F.lane, r = lane & 15, q = lane >> 4;
    const bool smp = task < CMP_TASKS_S; const int x = smp ? task : task - CMP_TASKS_S;
    const int b = x >> 6, kv = (x >> 5) & 1, slot = (x >> 4) & 1, i0 = 32 * (x & 15);
    const bf16* W1t = WSP(bf16, WS_W1T) + (size_t)slot * 64 * 2048;
    const bf16* W2t = WSP(bf16, WS_W2T) + (size_t)slot * 64 * 64;
    const int* pt = (const int*)F.in[I_PT] + b * 64;
    const float* ckv = F.in[I_CKV];
    const bf16* proj = WSP(bf16, WS_PROJ);
    f32x4 acc[4][2];
#pragma unroll
    for (int nt = 0; nt < 4; ++nt) { acc[nt][0] = (f32x4){0.f, 0.f, 0.f, 0.f}; acc[nt][1] = acc[nt][0]; }
#pragma unroll 2
    for (int ks = 0; ks < 64; ++ks) {
        bf16x8 bfr[2];
#pragma unroll
        for (int it = 0; it < 2; ++it) {
            int tok = 16 * (i0 + 16 * it + r) + (ks >> 1); tok = tok < T ? tok : T - 1;
            const int d = 32 * (ks & 1) + 8 * q;
            if (smp) { const int page = pt[tok >> 7]; bfr[it] = ldfrag_f32(ckv + (((size_t)page * 128 + (tok & 127)) * 4 + slot) * 128 + kv * 64 + d); }
            else bfr[it] = ldfrag(proj + ((size_t)b * T + tok) * DINP + C_KV + slot * 128 + kv * 64 + d);
        }
#pragma unroll
        for (int nt = 0; nt < 4; ++nt) { const bf16x8 a = ldfrag(W1t + (size_t)(16 * nt + r) * 2048 + 32 * ks + 8 * q);
            acc[nt][0] = MFMA16(a, bfr[0], acc[nt][0]); acc[nt][1] = MFMA16(a, bfr[1], acc[nt][1]); }
    }
    const float* c0 = WSP(float, WS_C0) + slot * 64;
    const float* gk0 = F.in[I_GNK];
#pragma unroll
    for (int it = 0; it < 2; ++it) {
        f32x4 g[4];
#pragma unroll
        for (int nt = 0; nt < 4; ++nt) { const f32x4 cc = *(const f32x4*)(c0 + 16 * nt + 4 * q);
#pragma unroll
            for (int i = 0; i < 4; ++i) g[nt][i] = gelu_tanh(acc[nt][it][i] + cc[i]); }
        const bf16x8 b0 = frag_pk(g[0], g[1]), b1 = frag_pk(g[2], g[3]);
        f32x4 o[4]; float ss = 0.f;
#pragma unroll
        for (int mt = 0; mt < 4; ++mt) { const bf16* wr = W2t + (size_t)(16 * mt + r) * 64 + 4 * q;
            o[mt] = MFMA16(ldfrag2(wr, wr + 16), b0, ((f32x4){0.f, 0.f, 0.f, 0.f}));
            o[mt] = MFMA16(ldfrag2(wr + 32, wr + 48), b1, o[mt]);
            ss += (o[mt][0] * o[mt][0] + o[mt][1] * o[mt][1]) + (o[mt][2] * o[mt][2] + o[mt][3] * o[mt][3]); }
        ss += __shfl_xor(ss, 16); ss += __shfl_xor(ss, 32);
        if (slot == 0) { const float rs = rsqrtf(ss * (1.f / 64.f) + EPS);
#pragma unroll
            for (int mt = 0; mt < 4; ++mt) { const f32x4 gg = *(const f32x4*)(gk0 + 16 * mt + 4 * q); o[mt] = o[mt] * rs * gg; } }
        const int i = i0 + 16 * it + r;
        if (smp) { float* dst = WSP(float, slot ? WS_VCMPS : WS_KCMPS) + ((size_t)(b * 2 + kv) * 512 + i) * 64 + 4 * q;
#pragma unroll
            for (int mt = 0; mt < 4; ++mt) *(f32x4*)(dst + 16 * mt) = o[mt]; }
        else if (slot == 0) { bf16* dst = WSP(bf16, WS_KCMP) + ((size_t)(b * 2 + kv) * 512 + i) * 64 + 4 * q;
#pragma unroll
            for (int mt = 0; mt < 4; ++mt) { u32x2 w; w.x = pk2(o[mt][0], o[mt][1]); w.y = pk2(o[mt][2], o[mt][3]); *(u32x2*)(dst + 16 * mt) = w; } }
        else { bf16* dst = WSP(bf16, WS_VCMPT) + ((size_t)(b * 2 + kv) * 64 + 4 * q) * 512 + i;
#pragma unroll
            for (int mt = 0; mt < 4; ++mt)
#pragma unroll
                for (int e = 0; e < 4; ++e) dst[(size_t)(16 * mt + e) * 512] = (bf16)f2bf(o[mt][e]); }
    }
}

__device__ __forceinline__ int swz64(int row, int col) { return row * 64 + ((((col >> 3) ^ (row & 7)) << 3) | (col & 7)); }
__device__ __forceinline__ float log_sigmoid_(float z) { return fminf(z, 0.f) - log1pf(__expf(-fabsf(z))); }
__device__ __forceinline__ void p2_gla_chunk(Frame& F, int bc) {
    const int lane = F.lane, r = lane & 15, q = lane >> 4, h = F.wave >> 1, eh = F.wave & 1;
    LAS bf16* ktT = (LAS bf16*)(F.lds + F.wave * 16384);
    LAS bf16* vT = ktT + 4096;
    const bf16* proj = WSP(bf16, WS_PROJ) + (size_t)bc * 64 * DINP;
    float wg[16];
#pragma unroll
    for (int j = 0; j < 16; ++j) wg[j] = F.in[I_WGG][j * 256 + h * 64 + lane];
    const float bg = F.in[I_BGG][h * 64 + lane];
    bf16* qtg = WSP(bf16, WS_QTG) + (size_t)bc * 64 * 256 + h * 64 + lane;
    bf16* ktg = WSP(bf16, WS_KTG) + (size_t)bc * 64 * 256 + h * 64 + lane;
    bf16* vtg = WSP(bf16, WS_VTG) + ((size_t)(bc * 4 + h) * 128 + eh * 64 + lane) * 64;
    float cb = 0.f;
    for (int t = 0; t < 64; ++t) {
        const bf16* pr = proj + (size_t)t * DINP;
        float lr[16]; { float f8[8]; unpack8(*(const u32x4*)(pr + C_LR), f8);
#pragma unroll
            for (int j = 0; j < 8; ++j) lr[j] = f8[j];
            unpack8(*(const u32x4*)(pr + C_LR + 8), f8);
#pragma unroll
            for (int j = 0; j < 8; ++j) lr[8 + j] = f8[j]; }
        float z = bg;
#pragma unroll
        for (int j = 0; j < 16; ++j) z += lr[j] * wg[j];
        cb += log_sigmoid_(z) * 0.0625f;
        const float kk = bf2f(pr[C_GK + h * 64 + lane]) * __expf(-cb);
        const float qq = bf2f(pr[C_GQ + h * 64 + lane]) * 0.125f * __expf(cb);
        const bf16 kb = (bf16)f2bf(kk);
        if (eh == 0) { qtg[(size_t)t * 256] = (bf16)f2bf(qq); ktg[(size_t)t * 256] = kb; }
        ktT[swz64(lane, t)] = kb;
        const bf16 vv = pr[C_GV + h * 128 + eh * 64 + lane];
        vT[swz64(lane, t)] = vv; vtg[t] = vv;
    }
    const float dec = __expf(cb);
    if (eh == 0) WSP(float, WS_DEC)[(size_t)(bc * 4 + h) * 64 + lane] = dec;
    asm volatile("s_waitcnt lgkmcnt(0)" ::: "memory");
    f32x4 acc[4][4];
#pragma unroll
    for (int et = 0; et < 4; ++et)
#pragma unroll
        for (int dt = 0; dt < 4; ++dt) acc[et][dt] = (f32x4){0.f, 0.f, 0.f, 0.f};
#pragma unroll
    for (int ks = 0; ks < 2; ++ks) {
        bf16x8 bfr[4];
#pragma unroll
        for (int dt = 0; dt < 4; ++dt) bfr[dt] = as_frag(*(const LAS u32x4*)(ktT + swz64(16 * dt + r, 32 * ks + 8 * q)));
#pragma unroll
        for (int et = 0; et < 4; ++et) { const bf16x8 a = as_frag(*(const LAS u32x4*)(vT + swz64(16 * et + r, 32 * ks + 8 * q)));
#pragma unroll
            for (int dt = 0; dt < 4; ++dt) acc[et][dt] = MFMA16(a, bfr[dt], acc[et][dt]); }
    }
    float* up = WSP(float, WS_UP) + ((size_t)(bc * 4 + h) * 128 + eh * 64) * 64;
#pragma unroll
    for (int dt = 0; dt < 4; ++dt) { const float dd = __shfl(dec, 16 * dt + r);
#pragma unroll
        for (int et = 0; et < 4; ++et)
#pragma unroll
            for (int i = 0; i < 4; ++i) up[(size_t)(16 * et + 4 * q + i) * 64 + 16 * dt + r] = acc[et][dt][i] * dd; }
}

__device__ __forceinline__ void p2_gla_sample(Frame& F, int task) {
    const int lane = F.lane, b = task >> 2, h = task & 3, tok = NTOKP + b;
    const bf16* pr = WSP(bf16, WS_PROJ) + (size_t)tok * DINP;
    LAS float* sh = (LAS float*)(F.lds + F.wave * 16384);
    { float z = F.in[I_BGG][h * 64 + lane];
#pragma unroll
      for (int j = 0; j < 16; ++j) z += bf2f(pr[C_LR + j]) * F.in[I_WGG][j * 256 + h * 64 + lane];
      sh[lane] = __expf(log_sigmoid_(z) * 0.0625f); sh[64 + lane] = bf2f(pr[C_GK + h * 64 + lane]); sh[128 + lane] = bf2f(pr[C_GQ + h * 64 + lane]) * 0.125f; }
    asm volatile("s_waitcnt lgkmcnt(0)" ::: "memory");
    const float v0 = bf2f(pr[C_GV + h * 128 + lane]), v1 = bf2f(pr[C_GV + h * 128 + 64 + lane]);
    const float* s0 = F.in[I_SGLA] + (size_t)(b * 4 + h) * 64 * 128; float* s1 = F.out + O_GLAS + (size_t)(b * 4 + h) * 64 * 128;
    float o0 = 0.f, o1 = 0.f;
#pragma unroll 4
    for (int d = 0; d < 64; ++d) { const float a = sh[d], k = sh[64 + d], qq = sh[128 + d];
        const float n0 = a * s0[d * 128 + lane] + k * v0, n1 = a * s0[d * 128 + 64 + lane] + k * v1;
        s1[d * 128 + lane] = n0; s1[d * 128 + 64 + lane] = n1; o0 += qq * n0; o1 += qq * n1; }
    const float rs = rsqrtf(wave_sum(o0 * o0 + o1 * o1) * (1.f / 128.f) + EPS);
    const float r0 = bf2f(pr[C_GR + h * 128 + lane]), r1 = bf2f(pr[C_GR + h * 128 + 64 + lane]);
    bf16* og = WSP(bf16, WS_OGLA) + (size_t)tok * 512 + h * 128;
    og[lane] = (bf16)f2bf(o0 * rs * F.in[I_GGO][lane] * r0 * sigmoidf_(r0));
    og[64 + lane] = (bf16)f2bf(o1 * rs * F.in[I_GGO][64 + lane] * r1 * sigmoidf_(r1));
}

__device__ __forceinline__ void p3_gla_scan(Frame& F, int task) {
    const int lane = F.lane, b = task >> 9, h = (task >> 7) & 3, e = task & 127;
    const float* up = WSP(float, WS_UP); const float* dec = WSP(float, WS_DEC); bf16* sc = WSP(bf16, WS_SC);
    float S = 0.f;
#pragma unroll 8
    for (int c = 0; c < 128; ++c) { const int bc = b * 128 + c; const size_t idx = ((size_t)(bc * 4 + h) * 128 + e) * 64 + lane;
        sc[idx] = (bf16)f2bf(S); S = dec[(size_t)(bc * 4 + h) * 64 + lane] * S + up[idx]; }
    F.out[O_GLAP + ((size_t)(b * 4 + h) * 64 + lane) * 128 + e] = S;
}

__device__ __forceinline__ void p4_gla_out(Frame& F, int task) {
    const int lane = F.lane, r = lane & 15, q = lane >> 4, bc = task >> 2, h = task & 3;
    const bf16* qtg = WSP(bf16, WS_QTG) + (size_t)bc * 64 * 256 + h * 64;
    const bf16* ktg = WSP(bf16, WS_KTG) + (size_t)bc * 64 * 256 + h * 64;
    const bf16* vtg = WSP(bf16, WS_VTG) + (size_t)(bc * 4 + h) * 128 * 64;
    const bf16* sc = WSP(bf16, WS_SC) + (size_t)(bc * 4 + h) * 128 * 64;
    const bf16* proj = WSP(bf16, WS_PROJ) + (size_t)bc * 64 * DINP;
    bf16* og = WSP(bf16, WS_OGLA) + (size_t)bc * 64 * 512 + h * 128;
    const float* ggo = F.in[I_GGO];
#pragma unroll 1
    for (int tt = 0; tt < 4; ++tt) {
        bf16x8 qf[2];
#pragma unroll
        for (int ks = 0; ks < 2; ++ks) qf[ks] = ldfrag(qtg + (size_t)(16 * tt + r) * 256 + 32 * ks + 8 * q);
        f32x4 sT[4];
#pragma unroll
        for (int st = 0; st < 4; ++st) { sT[st] = (f32x4){0.f, 0.f, 0.f, 0.f};
            if (st <= tt) {
#pragma unroll
                for (int ks = 0; ks < 2; ++ks) sT[st] = MFMA16(ldfrag(ktg + (size_t)(16 * st + r) * 256 + 32 * ks + 8 * q), qf[ks], sT[st]);
                if (st == tt) {
#pragma unroll
                    for (int i = 0; i < 4; ++i) if (4 * q + i > r) sT[st][i] = 0.f; } } }
        const bf16x8 p01 = frag_pk(sT[0], sT[1]), p23 = frag_pk(sT[2], sT[3]);
        f32x4 acc[8]; float ss = 0.f;
#pragma unroll
        for (int et = 0; et < 8; ++et) { acc[et] = (f32x4){0.f, 0.f, 0.f, 0.f};
            const bf16* srow = sc + (size_t)(16 * et + r) * 64 + 8 * q;
            acc[et] = MFMA16(ldfrag(srow), qf[0], acc[et]); acc[et] = MFMA16(ldfrag(srow + 32), qf[1], acc[et]);
            const bf16* vrow = vtg + (size_t)(16 * et + r) * 64 + 4 * q;
            acc[et] = MFMA16(ldfrag2(vrow, vrow + 16), p01, acc[et]);
            if (tt >= 2) acc[et] = MFMA16(ldfrag2(vrow + 32, vrow + 48), p23, acc[et]);
            ss += (acc[et][0] * acc[et][0] + acc[et][1] * acc[et][1]) + (acc[et][2] * acc[et][2] + acc[et][3] * acc[et][3]); }
        ss += __shfl_xor(ss, 16); ss += __shfl_xor(ss, 32);
        const float rs = rsqrtf(ss * (1.f / 128.f) + EPS);
        const bf16* pr = proj + (size_t)(16 * tt + r) * DINP + C_GR + h * 128 + 4 * q;
        bf16* orow = og + (size_t)(16 * tt + r) * 512 + 4 * q;
#pragma unroll
        for (int et = 0; et < 8; ++et) { const u32x2 rw = *(const u32x2*)(pr + 16 * et); const f32x4 gg = *(const f32x4*)(ggo + 16 * et + 4 * q);
            const float r0 = bflo(rw.x), r1 = bfhi(rw.x), r2 = bflo(rw.y), r3 = bfhi(rw.y);
            u32x2 w; w.x = pk2(acc[et][0] * rs * gg[0] * r0 * sigmoidf_(r0), acc[et][1] * rs * gg[1] * r1 * sigmoidf_(r1));
            w.y = pk2(acc[et][2] * rs * gg[2] * r2 * sigmoidf_(r2), acc[et][3] * rs * gg[3] * r3 * sigmoidf_(r3));
            *(u32x2*)(orow + 16 * et) = w; }
    }
}

__device__ __forceinline__ void p3_xatt(Frame& F, int task, float mb) {
    const int lane = F.lane, r = lane & 15, q = lane >> 4;
    const int h = task & 3, tile = task >> 2, tok0 = 16 * tile, b = tok0 >> 13;
    const bf16* xq = WSP(bf16, WS_XQ) + (size_t)(tok0 + r) * 512 + h * 128 + 8 * q;
    const bf16* km = WSP(bf16, WS_KMEM) + (size_t)(b * 4 + h) * 256 * 128;
    const bf16* vm = WSP(bf16, WS_VMEMT) + (size_t)(b * 4 + h) * 128 * 256;
    bf16x8 qf[4];
#pragma unroll
    for (int ks = 0; ks < 4; ++ks) qf[ks] = ldfrag(xq + 32 * ks);
    f32x4 o[8]; float l = 0.f;
#pragma unroll
    for (int dt = 0; dt < 8; ++dt) o[dt] = (f32x4){0.f, 0.f, 0.f, 0.f};
#pragma unroll 1
    for (int kk = 0; kk < 8; ++kk) {
        f32x4 p[2];
#pragma unroll
        for (int a = 0; a < 2; ++a) { p[a] = (f32x4){0.f, 0.f, 0.f, 0.f}; const bf16* kr = km + (size_t)(32 * kk + 16 * a + r) * 128 + 8 * q;
#pragma unroll
            for (int ks = 0; ks < 4; ++ks) p[a] = MFMA16(ldfrag(kr + 32 * ks), qf[ks], p[a]);
#pragma unroll
            for (int i = 0; i < 4; ++i) { p[a][i] = __builtin_amdgcn_exp2f(p[a][i] - mb); l += p[a][i]; } }
        const bf16x8 pf = frag_pk(p[0], p[1]);
#pragma unroll
        for (int dt = 0; dt < 8; ++dt) { const bf16* vr = vm + (size_t)(16 * dt + r) * 256 + 32 * kk + 4 * q; o[dt] = MFMA16(ldfrag2(vr, vr + 16), pf, o[dt]); }
    }
    l += __shfl_xor(l, 16); l += __shfl_xor(l, 32);
    const float inv = 1.f / l;
    bf16* ox = WSP(bf16, WS_OX) + (size_t)(tok0 + r) * 512 + h * 128 + 4 * q;
#pragma unroll
    for (int dt = 0; dt < 8; ++dt) { u32x2 w; w.x = pk2(o[dt][0] * inv, o[dt][1] * inv); w.y = pk2(o[dt][2] * inv, o[dt][3] * inv); *(u32x2*)(ox + 16 * dt) = w; }
}
__device__ __forceinline__ void p3_xatt_sample(Frame& F, int task) {
    const int lane = F.lane, b = task >> 2, h = task & 3, tok = NTOKP + b;
    LAS float* sh = (LAS float*)(F.lds + F.wave * 16384);
    const bf16* xq = WSP(bf16, WS_XQ) + (size_t)tok * 512 + h * 128;
    sh[lane] = bf2f(xq[lane]); sh[64 + lane] = bf2f(xq[64 + lane]);
    asm volatile("s_waitcnt lgkmcnt(0)" ::: "memory");
    const float* cm = F.in[I_CMEM] + (size_t)b * 256 * 1024 + h * 128;
    float s[4] = {0.f, 0.f, 0.f, 0.f};
    for (int d = 0; d < 128; d += 4) { const f32x4 qv = *(const LAS f32x4*)(sh + d);
#pragma unroll
        for (int k = 0; k < 4; ++k) { const f32x4 kv = *(const f32x4*)(cm + (size_t)(lane + 64 * k) * 1024 + d); s[k] += (qv[0] * kv[0] + qv[1] * kv[1]) + (qv[2] * kv[2] + qv[3] * kv[3]); } }
    const float m = wave_max(fmaxf(fmaxf(s[0], s[1]), fmaxf(s[2], s[3])));
    float l = 0.f;
#pragma unroll
    for (int k = 0; k < 4; ++k) { const float e = __builtin_amdgcn_exp2f(s[k] - m); sh[128 + lane + 64 * k] = e; l += e; }
    l = wave_sum(l);
    asm volatile("s_waitcnt lgkmcnt(0)" ::: "memory");
    float o0 = 0.f, o1 = 0.f; const float* vv = cm + 512;
#pragma unroll 4
    for (int mm = 0; mm < 256; ++mm) { const float p = sh[128 + mm]; o0 += p * vv[(size_t)mm * 1024 + lane]; o1 += p * vv[(size_t)mm * 1024 + 64 + lane]; }
    const float inv = 1.f / l;
    bf16* ox = WSP(bf16, WS_OX) + (size_t)tok * 512 + h * 128;
    ox[lane] = (bf16)f2bf(o0 * inv); ox[64 + lane] = (bf16)f2bf(o1 * inv);
}

constexpr int NL_Q = 0;
constexpr int NL_U = 16384;
constexpr int NL_OS = 81920;
constexpr int NL_LS = 114688;
constexpr int NL_SEL = 115200;
constexpr int NL_BKT = 115712;
constexpr int NL_BIAS = 116240;
constexpr int NL_LINV = 117264;
constexpr int NL_END = 117776;
static_assert(NL_END <= RING_BYTES, "NSA LDS map");

__device__ __forceinline__ void nsa_tables(Frame& F) {
    LAS int* bkt = (LAS int*)(F.lds + NL_BKT); LAS float* bl = (LAS float*)(F.lds + NL_BIAS);
    if (F.tid < 129) bkt[F.tid] = t5_bucket(F.tid);
    if (F.tid < 256) bl[F.tid] = F.in[I_RB][F.tid] * LOG2E;
    __syncthreads();
}
__device__ __forceinline__ float nsa_bound(Frame& F) {
    const float gq = absmax_arr(F.in[I_GNQ], 64, F.lane), gk = absmax_arr(F.in[I_GNK], 192, F.lane), bm = absmax_arr(F.in[I_RB], 256, F.lane);
    return (8.0f * gq * gk * 1.02f + bm) * LOG2E;
}
__device__ __forceinline__ unsigned fkey(float x) { const unsigned u = __float_as_uint(x); return (u & 0x80000000u) ? ~u : (u | 0x80000000u); }

__device__ __forceinline__ void p3_nsa_prompt(Frame& F, int n, float mb) {
    const int lane = F.lane, r = lane & 15, q = lane >> 4, w = F.wave;
    const int combo = n >> 8, idx = n & 255, ti = (combo & 1) ? 255 - idx : idx;
    const int b = combo >> 1, kv = combo & 1, t0 = 32 * ti, bk = b * 2 + kv;
    LAS bf16* Qs = (LAS bf16*)(F.lds + NL_Q); LAS float* U = (LAS float*)(F.lds + NL_U) + w * 2048; LAS float* Os = (LAS float*)(F.lds + NL_OS);
    LAS float* Ls = (LAS float*)(F.lds + NL_LS); LAS unsigned* selm = (LAS unsigned*)(F.lds + NL_SEL);
    LAS const int* bkt = (LAS const int*)(F.lds + NL_BKT); LAS const float* bl = (LAS const float*)(F.lds + NL_BIAS); LAS float* linv = (LAS float*)(F.lds + NL_LINV) + w * 16;
    __syncthreads();
    { const int tk = F.tid >> 4, ch = F.tid & 15; const bf16* src = WSP(bf16, WS_QN) + (size_t)(b * T + t0 + tk) * 512 + kv * 256 + ch * 16;
      const u32x4 a0 = *(const u32x4*)src, a1 = *(const u32x4*)(src + 8);
      *(LAS u32x4*)(Qs + tk * 256 + ch * 16) = a0; *(LAS u32x4*)(Qs + tk * 256 + ch * 16 + 8) = a1;
      for (int i = F.tid; i < 8192; i += NTHR) Os[i] = 0.f;
      if (F.tid < 128) { Ls[F.tid] = 0.f; selm[F.tid] = 0u; } }
    __syncthreads();
    const int tw = t0 + 4 * w, tr = tw + (r >> 2), h = kv * 4 + (r & 3);
    bf16x8 qf[2];
#pragma unroll
    for (int ks = 0; ks < 2; ++ks) qf[ks] = as_frag(*(LAS const u32x4*)(Qs + (16 * w + r) * 64 + 32 * ks + 8 * q));
    const int tlast = tw + 3; int ncv = tlast >= 31 ? (tlast - 31) / 16 + 1 : 0; ncv = ncv < 511 ? ncv : 511;
    const int nkk = (ncv + 31) >> 5;
    f32x4 oc[4]; float lc = 0.f, carry = 0.f;
#pragma unroll
    for (int dt = 0; dt < 4; ++dt) oc[dt] = (f32x4){0.f, 0.f, 0.f, 0.f};
    const bf16* kc = WSP(bf16, WS_KCMP) + (size_t)bk * 512 * 64; const bf16* vc = WSP(bf16, WS_VCMPT) + (size_t)bk * 64 * 512;
#pragma unroll 1
    for (int kk = 0; kk < nkk; ++kk) {
        f32x4 p[2];
#pragma unroll
        for (int a = 0; a < 2; ++a) { const int tile = 2 * kk + a; p[a] = (f32x4){0.f, 0.f, 0.f, 0.f};
            const bf16* kr = kc + (size_t)(16 * tile + r) * 64 + 8 * q;
            p[a] = MFMA16(ldfrag(kr), qf[0], p[a]); p[a] = MFMA16(ldfrag(kr + 32), qf[1], p[a]);
            float G = 0.f;
#pragma unroll
            for (int i = 0; i < 4; ++i) { const int c = 16 * tile + 4 * q + i, rel = tr - (16 * c + 31); const bool ok = rel >= 0 && c < 511;
                const int rc = rel < 0 ? 0 : (rel > 128 ? 128 : rel);
                const float e = ok ? __builtin_amdgcn_exp2f(p[a][i] + bl[bkt[rc] * 8 + h] - mb) : 0.f; p[a][i] = e; G += e; }
            const float send = (q == 3) ? carry : p[a][3]; const float prev = __shfl(send, (lane + 48) & 63); carry = p[a][3];
            U[r * 128 + 4 * tile + q] = G + prev; lc += G; }
        const bf16x8 pf = frag_pk(p[0], p[1]);
#pragma unroll
        for (int dt = 0; dt < 4; ++dt) { const bf16* vr = vc + (size_t)(16 * dt + r) * 512 + 32 * kk + 4 * q; oc[dt] = MFMA16(ldfrag2(vr, vr + 16), pf, oc[dt]); }
    }
    lc += __shfl_xor(lc, 16); lc += __shfl_xor(lc, 32);
    const float lcinv = lc > 0.f ? 1.f / lc : 0.f;
    if (q == 0) linv[r] = lcinv;
    asm volatile("s_waitcnt lgkmcnt(0)" ::: "memory");
    {
        const int tk = lane >> 4, jr = lane & 15, t = tw + tk, tblk = t >> 6, jlim = 8 * nkk;
        const float li0 = linv[4 * tk], li1 = linv[4 * tk + 1], li2 = linv[4 * tk + 2], li3 = linv[4 * tk + 3];
        unsigned key[8];
#pragma unroll
        for (int m = 0; m < 8; ++m) { const int j = jr + 16 * m; float v = 0.f;
            if (j < jlim) v = U[(4 * tk) * 128 + j] * li0 + U[(4 * tk + 1) * 128 + j] * li1 + U[(4 * tk + 2) * 128 + j] * li2 + U[(4 * tk + 3) * 128 + j] * li3;
            const bool forced = (j == 0) || (j == tblk) || (j == tblk - 1);
            const float sc = (j <= tblk) ? v + (forced ? 1e4f : 0.f) : -1e30f;
            key[m] = fkey(sc); }
        unsigned pre = 0u;
#pragma unroll 1
        for (int bit = 31; bit >= 0; --bit) { const unsigned cand = pre | (1u << bit); int cnt = 0;
#pragma unroll
            for (int m = 0; m < 8; ++m) cnt += key[m] >= cand ? 1 : 0;
            cnt += __shfl_xor(cnt, 1); cnt += __shfl_xor(cnt, 2); cnt += __shfl_xor(cnt, 4); cnt += __shfl_xor(cnt, 8);
            if (cnt >= 16) pre = cand; }
        int ngt = 0;
#pragma unroll
        for (int m = 0; m < 8; ++m) ngt += key[m] > pre ? 1 : 0;
        ngt += __shfl_xor(ngt, 1); ngt += __shfl_xor(ngt, 2); ngt += __shfl_xor(ngt, 4); ngt += __shfl_xor(ngt, 8);
        const int need = 16 - ngt; int run = 0; const unsigned kinv = fkey(-1e30f);
#pragma unroll
        for (int m = 0; m < 8; ++m) { const bool tie = key[m] == pre; const unsigned long long bal = __ballot(tie);
            const unsigned grp = (unsigned)(bal >> (16 * tk)) & 0xffffu; const int rank = __popc(grp & ((1u << jr) - 1u));
            const bool sel = (key[m] > pre || (tie && run + rank < need)) && key[m] > kinv;
            run += __popc(grp);
            if (sel) atomicOr((unsigned*)(selm + jr + 16 * m), 1u << (4 * w + tk)); }
    }
    __syncthreads();
    {
        const int jmax = (t0 + 31) >> 6;
        const bf16* ksel = WSP(bf16, WS_KSEL) + (size_t)bk * T * 64; const bf16* vsel = WSP(bf16, WS_VSELT) + (size_t)bk * 128 * 4096;
#pragma unroll 1
        for (int j = w; j <= jmax; j += 8) {
            unsigned mrem = (unsigned)__builtin_amdgcn_readfirstlane((int)selm[j]);
            if (!mrem) continue;
            bf16x8 kf[4][2], vf[4][2];
#pragma unroll
            for (int kt = 0; kt < 4; ++kt) { const bf16* kr = ksel + (size_t)(64 * j + 16 * kt + r) * 64 + 8 * q; kf[kt][0] = ldfrag(kr); kf[kt][1] = ldfrag(kr + 32); }
#pragma unroll
            for (int dt = 0; dt < 4; ++dt) { const bf16* vr = vsel + (size_t)j * 4096 + (size_t)(16 * dt + r) * 64 + 4 * q; vf[dt][0] = ldfrag2(vr, vr + 16); vf[dt][1] = ldfrag2(vr + 32, vr + 48); }
            const bool far = (t0 - (64 * j + 63)) >= 128;
#pragma unroll 1
            while (mrem) {
                unsigned mm = mrem; const int sub = r >> 2;
                if (sub > 0) mm &= mm - 1u; if (sub > 1) mm &= mm - 1u; if (sub > 2) mm &= mm - 1u;
                const bool tokv = mm != 0u; const int tk = tokv ? (__ffs((int)mm) - 1) : 0;
                mrem &= mrem - 1u; mrem &= mrem - 1u; mrem &= mrem - 1u; mrem &= mrem - 1u;
                bf16x8 qs[2];
#pragma unroll
                for (int ks = 0; ks < 2; ++ks) qs[ks] = as_frag(*(LAS const u32x4*)(Qs + (tk * 4 + (r & 3)) * 64 + 32 * ks + 8 * q));
                const int t = t0 + tk; f32x4 p[4]; float ls = 0.f; const float bfar = bl[31 * 8 + h];
#pragma unroll
                for (int kt = 0; kt < 4; ++kt) { p[kt] = (f32x4){0.f, 0.f, 0.f, 0.f};
                    p[kt] = MFMA16(kf[kt][0], qs[0], p[kt]); p[kt] = MFMA16(kf[kt][1], qs[1], p[kt]);
#pragma unroll
                    for (int i = 0; i < 4; ++i) { const int rel = t - (64 * j + 16 * kt + 4 * q + i); const bool ok = tokv && rel >= 0;
                        const int rc = rel < 0 ? 0 : (rel > 128 ? 128 : rel);
                        const float bias = far ? bfar : bl[bkt[rc] * 8 + h];
                        const float e = ok ? __builtin_amdgcn_exp2f(p[kt][i] + bias - mb) : 0.f; p[kt][i] = e; ls += e; } }
                ls += __shfl_xor(ls, 16); ls += __shfl_xor(ls, 32);
                if (q == 0 && tokv) atomicAdd((float*)(Ls + tk * 4 + (r & 3)), ls);
                const bf16x8 pf0 = frag_pk(p[0], p[1]), pf1 = frag_pk(p[2], p[3]);
#pragma unroll
                for (int dt = 0; dt < 4; ++dt) { f32x4 o = MFMA16(vf[dt][0], pf0, ((f32x4){0.f, 0.f, 0.f, 0.f})); o = MFMA16(vf[dt][1], pf1, o);
                    if (tokv) { LAS float* od = Os + (tk * 4 + (r & 3)) * 64 + 16 * dt + 4 * q;
#pragma unroll
                        for (int i = 0; i < 4; ++i) atomicAdd((float*)(od + i), o[i]); } }
            }
        }
    }
    f32x4 ow[4]; float lw = 0.f;
#pragma unroll
    for (int dt = 0; dt < 4; ++dt) ow[dt] = (f32x4){0.f, 0.f, 0.f, 0.f};
    {
        const bf16* kwin = WSP(bf16, WS_KWIN) + (size_t)bk * T * 64; const bf16* vwin = WSP(bf16, WS_VWINT) + (size_t)bk * 128 * 4096;
        const int jlo = (tw - 511 > 0 ? tw - 511 : 0) >> 6, jhi = (tw + 3) >> 6;
#pragma unroll 1
        for (int j = jlo; j <= jhi; ++j) {
            f32x4 p[4];
#pragma unroll
            for (int kt = 0; kt < 4; ++kt) { const bf16* kr = kwin + (size_t)(64 * j + 16 * kt + r) * 64 + 8 * q; p[kt] = (f32x4){0.f, 0.f, 0.f, 0.f};
                p[kt] = MFMA16(ldfrag(kr), qf[0], p[kt]); p[kt] = MFMA16(ldfrag(kr + 32), qf[1], p[kt]);
#pragma unroll
                for (int i = 0; i < 4; ++i) { const int rel = tr - (64 * j + 16 * kt + 4 * q + i); const bool ok = rel >= 0 && rel < 512;
                    const int rc = rel < 0 ? 0 : (rel > 128 ? 128 : rel);
                    const float e = ok ? __builtin_amdgcn_exp2f(p[kt][i] + bl[bkt[rc] * 8 + h] - mb) : 0.f; p[kt][i] = e; lw += e; } }
            const bf16x8 pf0 = frag_pk(p[0], p[1]), pf1 = frag_pk(p[2], p[3]);
#pragma unroll
            for (int dt = 0; dt < 4; ++dt) { const bf16* vr = vwin + (size_t)j * 4096 + (size_t)(16 * dt + r) * 64 + 4 * q;
                ow[dt] = MFMA16(ldfrag2(vr, vr + 16), pf0, ow[dt]); ow[dt] = MFMA16(ldfrag2(vr + 32, vr + 48), pf1, ow[dt]); }
        }
        lw += __shfl_xor(lw, 16); lw += __shfl_xor(lw, 32);
    }
    __syncthreads();
    {
        const int tok = b * T + tr; const float* gt = WSP(float, WS_GATES) + (size_t)tok * 24 + h * 3;
        const float ls = Ls[16 * w + r];
        const float g0 = gt[0] * lcinv, g1 = gt[1] * (ls > 0.f ? 1.f / ls : 0.f), g2 = gt[2] * (lw > 0.f ? 1.f / lw : 0.f);
        bf16* on = WSP(bf16, WS_ONSA) + (size_t)tok * 512 + h * 64 + 4 * q;
#pragma unroll
        for (int dt = 0; dt < 4; ++dt) { const f32x4 os = *(LAS const f32x4*)(Os + (16 * w + r) * 64 + 16 * dt + 4 * q);
            const f32x4 o = oc[dt] * g0 + os * g1 + ow[dt] * g2;
            u32x2 wv; wv.x = pk2(o[0], o[1]); wv.y = pk2(o[2], o[3]); *(u32x2*)(on + 16 * dt) = wv; }
    }
}

constexpr int SL_Q = 0;
constexpr int SL_S = 1024;
constexpr int SL_O = 17408;
constexpr int SL_PART = 20480;
constexpr int SL_IMP = 22528;
constexpr int SL_IDX = 23056;
constexpr int SL_END = 23184;
static_assert(SL_END <= NL_BKT, "sample NSA LDS map must not overlap the tables");
template <class KP, class VP, class RELF>
__device__ __forceinline__ void sample_segment(Frame& F, int nk, int kv, KP kptr, VP vptr, RELF relf, LAS float* odst) {
    LAS const float* qs = (LAS const float*)(F.lds + SL_Q); LAS float* sc = (LAS float*)(F.lds + SL_S); LAS float* part = (LAS float*)(F.lds + SL_PART);
    LAS const int* bkt = (LAS const int*)(F.lds + NL_BKT); LAS const float* bl = (LAS const float*)(F.lds + NL_BIAS);
    const int nkp = (nk + 63) & ~63;
    for (int n = F.tid; n < nkp; n += NTHR) {
        float s0 = -INFINITY, s1 = -INFINITY, s2 = -INFINITY, s3 = -INFINITY;
        const float* kr = n < nk ? kptr(n) : nullptr;
        if (kr) { s0 = s1 = s2 = s3 = 0.f;
            for (int d = 0; d < 64; d += 4) { const f32x4 k4 = *(const f32x4*)(kr + d);
                const f32x4 q0 = *(LAS const f32x4*)(qs + d), q1 = *(LAS const f32x4*)(qs + 64 + d), q2 = *(LAS const f32x4*)(qs + 128 + d), q3 = *(LAS const f32x4*)(qs + 192 + d);
                s0 += (q0[0] * k4[0] + q0[1] * k4[1]) + (q0[2] * k4[2] + q0[3] * k4[3]); s1 += (q1[0] * k4[0] + q1[1] * k4[1]) + (q1[2] * k4[2] + q1[3] * k4[3]);
                s2 += (q2[0] * k4[0] + q2[1] * k4[1]) + (q2[2] * k4[2] + q2[3] * k4[3]); s3 += (q3[0] * k4[0] + q3[1] * k4[1]) + (q3[2] * k4[2] + q3[3] * k4[3]); }
            int rel = relf(n); rel = rel > 128 ? 128 : rel; const int bb = bkt[rel] * 8 + kv * 4;
            s0 += bl[bb]; s1 += bl[bb + 1]; s2 += bl[bb + 2]; s3 += bl[bb + 3]; }
        sc[n] = s0; sc[1024 + n] = s1; sc[2048 + n] = s2; sc[3072 + n] = s3;
    }
    __syncthreads();
    if (F.wave < 4) { LAS float* row = sc + F.wave * 1024; float m = -INFINITY;
        for (int n = F.lane; n < nkp; n += 64) m = fmaxf(m, row[n]);
        m = wave_max(m); float l = 0.f;
        for (int n = F.lane; n < nkp; n += 64) { const float e = __builtin_amdgcn_exp2f(row[n] - m); row[n] = e; l += e; }
        l = wave_sum(l); const float inv = 1.f / l;
        for (int n = F.lane; n < nkp; n += 64) row[n] *= inv; }
    __syncthreads();
    { const int half = F.tid >> 8, g = (F.tid >> 6) & 3, d = F.tid & 63; float o = 0.f; LAS const float* row = sc + g * 1024;
      const int nh = nkp >> 1;
      for (int n = half * nh; n < (half + 1) * nh; ++n) { const float p = row[n]; if (p != 0.f) { const float* vr = vptr(n); o += p * vr[d]; } }
      part[(half * 4 + g) * 64 + d] = o; }
    __syncthreads();
    if (F.tid < 256) odst[F.tid] = part[F.tid] + part[256 + F.tid];
    __syncthreads();
}
__device__ __forceinline__ void p3_nsa_sample(Frame& F, int task) {
    const int b = task >> 1, kv = task & 1, tok = NTOKP + b, bk = b * 2 + kv;
    LAS float* qs = (LAS float*)(F.lds + SL_Q); LAS float* sc = (LAS float*)(F.lds + SL_S); LAS float* ob = (LAS float*)(F.lds + SL_O);
    LAS float* imp = (LAS float*)(F.lds + SL_IMP); LAS int* sidx = (LAS int*)(F.lds + SL_IDX);
    __syncthreads();
    if (F.tid < 256) qs[F.tid] = bf2f(WSP(bf16, WS_QN)[(size_t)tok * 512 + kv * 256 + F.tid]);
    __syncthreads();
    const float* kcs = WSP(float, WS_KCMPS) + (size_t)bk * 512 * 64; const float* vcs = WSP(float, WS_VCMPS) + (size_t)bk * 512 * 64;
    const float* nkv = WSP(float, WS_NEWKV) + (size_t)b * 4 * 2 * 64 + kv * 64;
    const float* ckv = F.in[I_CKV]; const int* pt = (const int*)F.in[I_PT] + b * 64; const float* cwin = F.in[I_CWIN] + (size_t)b * 512 * 256;
    sample_segment(F, 511, kv, [&](int n) { return kcs + (size_t)n * 64; }, [&](int n) { return vcs + (size_t)n * 64; }, [&](int n) { return T - (16 * n + 31); }, ob);
    if (F.tid < 129) { const int j = F.tid; float v = 0.f;
        for (int c = 4 * j - 1; c <= 4 * j + 3; ++c) if (c >= 0 && c < 511) v += (sc[c] + sc[1024 + c]) + (sc[2048 + c] + sc[3072 + c]);
        imp[j] = v; }
    __syncthreads();
    if (F.wave == 0) { const int lane = F.lane; unsigned key[3];
#pragma unroll
        for (int m = 0; m < 3; ++m) { const int j = lane + 64 * m; float s = -1e30f;
            if (j < 129) { const bool forced = (j == 0) || (j == 128) || (j == 127); s = imp[j] + (forced ? 1e4f : 0.f); }
            key[m] = (j < 129) ? fkey(s) : 0u; }
        unsigned pre = 0u;
#pragma unroll 1
        for (int bit = 31; bit >= 0; --bit) { const unsigned cand = pre | (1u << bit); int cnt = 0;
#pragma unroll
            for (int m = 0; m < 3; ++m) cnt += __popcll(__ballot(key[m] >= cand));
            if (cnt >= 16) pre = cand; }
        int ngt = 0;
#pragma unroll
        for (int m = 0; m < 3; ++m) ngt += __popcll(__ballot(key[m] > pre));
        int need = 16 - ngt, cnt = 0;
#pragma unroll
        for (int m = 0; m < 3; ++m) { const bool gt = key[m] > pre, tie = key[m] == pre; const unsigned long long tb = __ballot(tie);
            const int trank = __popcll(tb & ((1ull << lane) - 1ull)); const bool sel = gt || (tie && trank < need);
            need -= __popcll(tb); need = need < 0 ? 0 : need;
            const unsigned long long sb = __ballot(sel); const int pos = cnt + __popcll(sb & ((1ull << lane) - 1ull));
            if (sel && pos < 16) sidx[pos] = lane + 64 * m; cnt += __popcll(sb); } }
    __syncthreads();
    sample_segment(F, 1024, kv,
        [&](int n) -> const float* { const int pos = 64 * sidx[n >> 6] + (n & 63); if (pos > T) return nullptr; if (pos == T) return nkv;
                                     return ckv + (((size_t)pt[pos >> 7] * 128 + (pos & 127)) * 4 + 2) * 128 + kv * 64; },
        [&](int n) -> const float* { const int pos = 64 * sidx[n >> 6] + (n & 63); if (pos == T) return nkv + 128;
                                     return ckv + (((size_t)pt[pos >> 7] * 128 + (pos & 127)) * 4 + 3) * 128 + kv * 64; },
        [&](int n) { return T - (64 * sidx[n >> 6] + (n & 63)); }, ob + 256);
    sample_segment(F, 512, kv,
        [&](int n) -> const float* { return n < 511 ? cwin + (size_t)(n + 1) * 256 + kv * 64 : nkv + 256; },
        [&](int n) -> const float* { return n < 511 ? cwin + (size_t)(n + 1) * 256 + 128 + kv * 64 : nkv + 384; },
        [&](int n) { return 511 - n; }, ob + 512);
    if (F.tid < 256) { const int g = F.tid >> 6, d = F.tid & 63, h = kv * 4 + g; const float* gt = WSP(float, WS_GATES) + (size_t)tok * 24 + h * 3;
        WSP(bf16, WS_ONSA)[(size_t)tok * 512 + h * 64 + d] = (bf16)f2bf(gt[0] * ob[F.tid] + gt[1] * ob[256 + F.tid] + gt[2] * ob[512 + F.tid]); }
}

__device__ __forceinline__ void p6_conv(Frame& F) {
    const bf16* ug = WSP(bf16, WS_UG); bf16* act = WSP(bf16, WS_ACT);
    const float* cw = F.in[I_CONVW]; const float* cb = F.in[I_CONVB]; const float* sconv = F.in[I_SCONV];
    constexpr int NG = DFF / 8;
    for (size_t it = (size_t)F.bid * NTHR + F.tid; it < (size_t)MPAD * NG; it += (size_t)F.G * NTHR) {
        const int row = (int)(it / NG), c0 = 8 * (int)(it % NG);
        if (row >= NTOK) { *(u32x4*)(act + (size_t)row * DFF + c0) = (u32x4){0u, 0u, 0u, 0u}; continue; }
        float u[8], g2[8], g1[8], g0[8];
        unpack8(*(const u32x4*)(ug + (size_t)row * DUP + c0), u);
        unpack8(*(const u32x4*)(ug + (size_t)row * DUP + DFF + c0), g2);
        if (row < NTOKP) { const int t = row & (T - 1);
            if (t >= 1) unpack8(*(const u32x4*)(ug + (size_t)(row - 1) * DUP + DFF + c0), g1); else { for (int i = 0; i < 8; ++i) g1[i] = 0.f; }
            if (t >= 2) unpack8(*(const u32x4*)(ug + (size_t)(row - 2) * DUP + DFF + c0), g0); else { for (int i = 0; i < 8; ++i) g0[i] = 0.f; }
            if (t >= T - 2) { float* o = F.out + O_CONVP + ((size_t)(row >> 13) * 2 + (t - (T - 2))) * DFF + c0;
                for (int i = 0; i < 8; ++i) o[i] = g2[i]; }
        } else { const int sb = row - NTOKP;
            for (int i = 0; i < 8; ++i) { g0[i] = sconv[((size_t)sb * 2 + 0) * DFF + c0 + i]; g1[i] = sconv[((size_t)sb * 2 + 1) * DFF + c0 + i]; }
            float* o = F.out + O_CONVS + (size_t)sb * 2 * DFF + c0;
            for (int i = 0; i < 8; ++i) { o[i] = g1[i]; o[DFF + i] = g2[i]; } }
        float a[8];
#pragma unroll
        for (int i = 0; i < 8; ++i) { const float gc = cb[c0 + i] + cw[c0 + i] * g0[i] + cw[DFF + c0 + i] * g1[i] + cw[2 * DFF + c0 + i] * g2[i]; a[i] = gelu_tanh(gc) * u[i]; }
        *(u32x4*)(act + (size_t)row * DFF + c0) = pack8(a);
    }
}

constexpr int N_PHASES = 10;
__global__ void __launch_bounds__(NTHR, 2) mega_fwd(Args args) {
    extern __shared__ __attribute__((aligned(16))) unsigned char lds_raw[];
    cg::grid_group grid = cg::this_grid();
    Frame F;
    F.lds = (LAS unsigned char*)lds_raw;
    F.tid = threadIdx.x; F.lane = F.tid & 63; F.wave = __builtin_amdgcn_readfirstlane(F.tid >> 6);
    F.G = gridDim.x; F.bid = blockIdx.x; F.gw = F.bid * NWAVES + F.wave; F.NGW = F.G * NWAVES;
    F.in = args.in; F.out = args.out; F.ws = args.ws;
    const int lo = args.ph_lo, hi = args.ph_hi;
#define IN(k) (lo <= (k) && (k) < hi)
#define SEAM(k) do { if (IN(k) && IN((k) + 1)) grid.sync(); } while (0)
    typedef pg8::StaticOrder SO;

    if (IN(0)) { p0_prologue(F); }
    SEAM(0);
    if (IN(1)) {
        { pg8::Gemm g{WSP(bf16, WS_XN), WSP(bf16, WS_WTIN), MPAD, DINP, 1024}; SO S; S.init(MPAD, DINP, F.G, F.bid);
          pg8::EpiStore E{WSP(bf16, WS_PROJ), DINP, nullptr};
          pg8::gemm_phase<pg8::EpiStore, SO, true, true>(F.lds, g, S, E); }
        __syncthreads();
        { pg8::Gemm g{WSP(bf16, WS_MN), WSP(bf16, WS_WTMEM), 512, 1024, 1024}; SO S; S.init(512, 1024, F.G, F.G - 1 - F.bid);
          pg8::EpiStore E{WSP(bf16, WS_MEMPROJ), 1024, nullptr};
          pg8::gemm_phase<pg8::EpiStore, SO, true, true>(F.lds, g, S, E); }
    }
    SEAM(1);
    if (IN(2)) {
        for (int tok = F.gw; tok < NTOK; tok += F.NGW) p2_token(F, tok);
        for (int row = F.gw; row < 512; row += F.NGW) p2_memrow(F, row);
        for (int t = F.gw; t < CMP_TASKS_S + CMP_TASKS_P; t += F.NGW) p2_compress(F, t);
        for (int bc = F.bid; bc < 256; bc += F.G) { __syncthreads(); p2_gla_chunk(F, bc); }
        __syncthreads();
        for (int t = F.gw; t < SB * 4; t += F.NGW) p2_gla_sample(F, t);
    }
    SEAM(2);
    if (IN(3)) {
        nsa_tables(F);
        const float mb = nsa_bound(F);
        for (int n = F.bid; n < 1024; n += F.G) p3_nsa_prompt(F, n, mb);
        for (int t = F.G - 1 - F.bid; t < SB * 2; t += F.G) p3_nsa_sample(F, t);
        __syncthreads();
        { const float gq = absmax_arr(F.in[I_GXQ], 128, F.lane), gk = absmax_arr(F.in[I_GXK], 128, F.lane);
          const float mbx = 11.313708498984761f * gq * gk * 1.02f * LOG2E;
          for (int t = F.gw; t < 4096; t += F.NGW) p3_xatt(F, t, mbx); }
        for (int t = F.gw; t < SB * 4; t += F.NGW) p3_xatt_sample(F, t);
        for (int t = F.gw; t < 1024; t += F.NGW) p3_gla_scan(F, t);
    }
    SEAM(3);
    if (IN(4)) { for (int t = F.gw; t < 1024; t += F.NGW) p4_gla_out(F, t); }
    SEAM(4);
    if (IN(5)) {
        const bf16* gate = WSP(bf16, WS_PROJ) + C_MG;
        { pg8::Gemm g{WSP(bf16, WS_ONSA), WSP(bf16, WS_WTNSA), MPAD, 1024, 512}; SO S; S.init(MPAD, 1024, F.G, F.bid);
          pg8::EpiMerge<0> E{gate, DINP, WSP(bf16, WS_MERGED), 1024};
          pg8::gemm_phase<pg8::EpiMerge<0>, SO, true, true>(F.lds, g, S, E); }
        __syncthreads();
        { pg8::Gemm g{WSP(bf16, WS_OGLA), WSP(bf16, WS_WTGLA), MPAD, 1024, 512}; SO S; S.init(MPAD, 1024, F.G, F.bid);
          pg8::EpiMerge<1> E{gate + 1024, DINP, WSP(bf16, WS_MERGED), 1024};
          pg8::gemm_phase<pg8::EpiMerge<1>, SO, true, true>(F.lds, g, S, E); }
        __syncthreads();
        { pg8::Gemm g{WSP(bf16, WS_OX), WSP(bf16, WS_WTX), MPAD, 1024, 512}; SO S; S.init(MPAD, 1024, F.G, F.bid);
          pg8::EpiMerge<1> E{gate + 2048, DINP, WSP(bf16, WS_MERGED), 1024};
          pg8::gemm_phase<pg8::EpiMerge<1>, SO, true, true>(F.lds, g, S, E); }
    }
    SEAM(5);
    if (IN(6)) {
        pg8::Gemm g{WSP(bf16, WS_MERGED), WSP(bf16, WS_WTO), MPAD, 1024, 1024}; SO S; S.init(MPAD, 1024, F.G, F.bid);
        pg8::EpiWo E{F.in[I_XP], F.in[I_XS], WSP(float, WS_X1), WSP(bf16, WS_X1B), WSP(float, WS_SSQ)};
        pg8::gemm_phase<pg8::EpiWo, SO, true, true>(F.lds, g, S, E);
    }
    SEAM(6);
    if (IN(7)) {
        pg8::Gemm g{WSP(bf16, WS_X1B), WSP(bf16, WS_WTUP), MPAD, DUP, 1024}; SO S; S.init(MPAD, DUP, F.G, F.bid);
        pg8::EpiStore E{WSP(bf16, WS_UG), DUP, WSP(float, WS_SSQ)};
        pg8::gemm_phase<pg8::EpiStore, SO, true, true>(F.lds, g, S, E);
    }
    SEAM(7);
    if (IN(8)) { p6_conv(F); }
    SEAM(8);
    if (IN(9)) {
        pg8::Gemm g{WSP(bf16, WS_ACT), WSP(bf16, WS_WTDOWN), MPAD, 1024, DFF}; SO S; S.init(MPAD, 1024, F.G, F.bid);
        pg8::EpiDown E{WSP(float, WS_X1), F.out + O_Y, F.out + O_YS};
        pg8::gemm_phase<pg8::EpiDown, SO, true, true>(F.lds, g, S, E);
    }
#undef IN
#undef SEAM
}

extern "C" void kernel_launch(void* const* d_in, const int* in_sizes, int n_in, void* d_out, int out_size, void* d_ws, size_t ws_size, hipStream_t stream) {
    static int grid = 0;
    if (grid == 0) {
        if (n_in != N_IN || (size_t)out_size != O_END || ws_size < WS_END) {
            fprintf(stderr, "kernel_launch: built for %d inputs, %zu outputs, >= %zu bytes of workspace; got %d, %d, %zu\n", (int)N_IN, (size_t)O_END, (size_t)WS_END, n_in, out_size, ws_size); grid = -1; return; }
        int dev = 0, cus = 0, per_cu = 0;
        if (hipGetDevice(&dev) != hipSuccess || hipDeviceGetAttribute(&cus, hipDeviceAttributeMultiprocessorCount, dev) != hipSuccess) { grid = -1; return; }
        if (hipFuncSetAttribute((const void*)mega_fwd, hipFuncAttributeMaxDynamicSharedMemorySize, LDS_BYTES) != hipSuccess) { fprintf(stderr, "kernel_launch: hipFuncSetAttribute failed\n"); grid = -1; return; }
        if (hipOccupancyMaxActiveBlocksPerMultiprocessor(&per_cu, (const void*)mega_fwd, NTHR, LDS_BYTES) != hipSuccess || per_cu < 1) { fprintf(stderr, "kernel_launch: occupancy query gave %d\n", per_cu); per_cu = 1; }
        (void)hipGetLastError();
        grid = cus * (per_cu < 1 ? 1 : 1);
    }
    if (grid < 0) return;
    Args a{};
    for (int i = 0; i < N_IN; ++i) a.in[i] = (const float*)d_in[i];
    a.out = (float*)d_out; a.ws = (unsigned char*)d_ws;
#if MK_N_LAUNCHES == 1
    a.ph_lo = 0; a.ph_hi = N_PHASES;
    void* kargs[] = {&a};
    hipError_t e = hipLaunchCooperativeKernel((const void*)mega_fwd, dim3(grid), dim3(NTHR), kargs, LDS_BYTES, stream);
    if (e != hipSuccess) fprintf(stderr, "kernel_launch: cooperative launch failed: %s (grid %d)\n", hipGetErrorString(e), grid);
#else
    for (int p = 0; p < N_PHASES; ++p) { a.ph_lo = p; a.ph_hi = p + 1; hipLaunchKernelGGL(mega_fwd, dim3(grid), dim3(NTHR), LDS_BYTES, stream, a); }
#endif
}
```

```cpp
#include <hip/hip_runtime.h>
#include <hip/hip_cooperative_groups.h>
#include <cstdio>
#include <cstdint>
namespace cg = cooperative_groups;
#ifndef MK_N_LAUNCHES
#define MK_N_LAUNCHES 1
#endif
namespace pg8 {
#define PG8_LAS __attribute__((address_space(3)))
typedef unsigned short bf16_t;
typedef short bf16x8 __attribute__((ext_vector_type(8)));
typedef float f32x4 __attribute__((ext_vector_type(4)));
typedef unsigned u32x4 __attribute__((ext_vector_type(4)));
constexpr int BM = 256, BK = 64, HALF = 128, HTB = HALF * BK * 2  , STAGE_BYTES = 8 * HTB, NXCD = 8, WGM = 8;

__host__ __device__ __forceinline__ int lds_byte(int r, int c) { const int st = (r >> 4) * 2 + (c >> 5), rr = r & 15, cc = c & 31, ob = rr * 64 + cc * 2; return st * 1024 + (ob ^ (((ob >> 9) & 1) << 5)); }
__host__ __device__ __forceinline__ void stage_rc(int b, int& R, int& C) { const int st = b / 1024, sb = b % 1024, swz = sb ^ (((sb >> 9) & 1) << 5); R = (st >> 1) * 16 + swz / 64; C = (st & 1) * 32 + (swz % 64) / 2; }
__host__ __device__ __forceinline__ int perm32(int rho) { const int n = rho >> 4, i = rho & 15; return 8 * (i >> 2) + 4 * n + (i & 3); }

struct Unit { int pm, pn; };
struct Gemm { const bf16_t* A; const bf16_t* Bt; int M, N, K; };

struct StaticOrder {
    int nM, nN, nwg, G, c;
    __host__ __device__ void init(int M, int N, int G_, int c_) { nM = M / BM; nN = N / BM; nwg = nM * nN; G = G_; c = c_; }
    __host__ __device__ bool next(int i, Unit& u) const {
        const long L = (long)i * G + c; if (L >= nwg) return false;
        int wgid = (int)L; { const int q = nwg / NXCD, r = nwg % NXCD, xcd = wgid % NXCD, off = wgid / NXCD; wgid = (xcd < r ? xcd * (q + 1) : r * (q + 1) + (xcd - r) * q) + off; }
        const int nig = WGM * nN, gid = wgid / nig, fm = gid * WGM, gsz = (nM - fm) < WGM ? (nM - fm) : WGM;
        u.pm = fm + ((wgid % nig) % gsz); u.pn = (wgid % nig) / gsz; return true;
    }
    __device__ __forceinline__ void a_ready(const Unit&) const {}
    __device__ __forceinline__ void done(const Unit&) const {}
};

__device__ __forceinline__ unsigned cvt_pk_bf16(float lo, float hi) { unsigned r; asm volatile("v_cvt_pk_bf16_f32 %0, %1, %2" : "=v"(r) : "v"(lo), "v"(hi)); return r; }
__device__ __forceinline__ float bflo(unsigned w) { return __uint_as_float(w << 16); }
__device__ __forceinline__ float bfhi(unsigned w) { return __uint_as_float(w & 0xffff0000u); }
__device__ __forceinline__ float sigm(float x) { return 1.0f / (1.0f + __expf(-x)); }
struct EpiStore {
    static constexpr bool PERM = true, AFTER_DRAIN = false;
    bf16_t* O; int ldc; const float* ssq;
    __device__ __forceinline__ void operator()(const f32x4 (&acc)[2][2][4][2], const Unit& u, int wr, int wc, int fr, int fq) const {
        const int row0 = u.pm * BM + wr * 64 + fr, col0 = u.pn * BM + wc * 32 + 8 * fq;
#pragma unroll
        for (int ai = 0; ai < 2; ++ai)
#pragma unroll
            for (int m = 0; m < 4; ++m) { const int row = row0 + ai * HALF + m * 16; bf16_t* rowp = O + (size_t)row * ldc + col0;
                const float sc = ssq ? rsqrtf(ssq[row] * (1.0f / 1024.0f) + 1e-6f) : 1.0f;
#pragma unroll
                for (int bj = 0; bj < 2; ++bj) { const f32x4 v0 = acc[ai][bj][m][0] * sc, v1 = acc[ai][bj][m][1] * sc;
                    u32x4 w; w.x = cvt_pk_bf16(v0[0], v0[1]); w.y = cvt_pk_bf16(v0[2], v0[3]); w.z = cvt_pk_bf16(v1[0], v1[1]); w.w = cvt_pk_bf16(v1[2], v1[3]);
                    *(u32x4*)(rowp + bj * HALF) = w; } }
    }
};
template <int ACCUM> struct EpiMerge {
    static constexpr bool PERM = true, AFTER_DRAIN = false;
    const bf16_t* gate; int ldg; bf16_t* O; int ldc;
    __device__ __forceinline__ void operator()(const f32x4 (&acc)[2][2][4][2], const Unit& u, int wr, int wc, int fr, int fq) const {
        const int row0 = u.pm * BM + wr * 64 + fr, col0 = u.pn * BM + wc * 32 + 8 * fq;
#pragma unroll
        for (int ai = 0; ai < 2; ++ai)
#pragma unroll
            for (int m = 0; m < 4; ++m) { const int row = row0 + ai * HALF + m * 16; bf16_t* rowp = O + (size_t)row * ldc + col0; const bf16_t* gp = gate + (size_t)row * ldg + col0;
#pragma unroll
                for (int bj = 0; bj < 2; ++bj) {
                    const u32x4 g = *(const u32x4*)(gp + bj * HALF);
                    f32x4 v0 = acc[ai][bj][m][0], v1 = acc[ai][bj][m][1];
                    v0[0] *= sigm(bflo(g.x)); v0[1] *= sigm(bfhi(g.x)); v0[2] *= sigm(bflo(g.y)); v0[3] *= sigm(bfhi(g.y));
                    v1[0] *= sigm(bflo(g.z)); v1[1] *= sigm(bfhi(g.z)); v1[2] *= sigm(bflo(g.w)); v1[3] *= sigm(bfhi(g.w));
                    if (ACCUM) { const u32x4 o = *(const u32x4*)(rowp + bj * HALF);
                        v0[0] += bflo(o.x); v0[1] += bfhi(o.x); v0[2] += bflo(o.y); v0[3] += bfhi(o.y);
                        v1[0] += bflo(o.z); v1[1] += bfhi(o.z); v1[2] += bflo(o.w); v1[3] += bfhi(o.w); }
                    u32x4 w; w.x = cvt_pk_bf16(v0[0], v0[1]); w.y = cvt_pk_bf16(v0[2], v0[3]); w.z = cvt_pk_bf16(v1[0], v1[1]); w.w = cvt_pk_bf16(v1[2], v1[3]);
                    *(u32x4*)(rowp + bj * HALF) = w; } }
    }
};
struct EpiWo {
    static constexpr bool PERM = true, AFTER_DRAIN = false;
    const float* xp; const float* xs; float* X1; bf16_t* X1B; float* ssq;
    __device__ __forceinline__ void operator()(const f32x4 (&acc)[2][2][4][2], const Unit& u, int wr, int wc, int fr, int fq) const {
        const int row0 = u.pm * BM + wr * 64 + fr, col0 = u.pn * BM + wc * 32 + 8 * fq;
#pragma unroll
        for (int ai = 0; ai < 2; ++ai)
#pragma unroll
            for (int m = 0; m < 4; ++m) { const int row = row0 + ai * HALF + m * 16;
                const float* xr = row < 16384 ? xp + (size_t)row * 1024 : (row < 16416 ? xs + (size_t)(row - 16384) * 1024 : nullptr);
                float ss = 0.f;
#pragma unroll
                for (int bj = 0; bj < 2; ++bj) { const int col = col0 + bj * HALF;
                    f32x4 x0 = (f32x4){0.f, 0.f, 0.f, 0.f}, x1 = x0;
                    if (xr) { x0 = *(const f32x4*)(xr + col); x1 = *(const f32x4*)(xr + col + 4); }
                    const f32x4 v0 = acc[ai][bj][m][0] + x0, v1 = acc[ai][bj][m][1] + x1;
                    *(f32x4*)(X1 + (size_t)row * 1024 + col) = v0; *(f32x4*)(X1 + (size_t)row * 1024 + col + 4) = v1;
                    u32x4 w; w.x = cvt_pk_bf16(v0[0], v0[1]); w.y = cvt_pk_bf16(v0[2], v0[3]); w.z = cvt_pk_bf16(v1[0], v1[1]); w.w = cvt_pk_bf16(v1[2], v1[3]);
                    *(u32x4*)(X1B + (size_t)row * 1024 + col) = w;
                    ss += (v0[0] * v0[0] + v0[1] * v0[1]) + (v0[2] * v0[2] + v0[3] * v0[3]) + (v1[0] * v1[0] + v1[1] * v1[1]) + (v1[2] * v1[2] + v1[3] * v1[3]); }
                ss += __shfl_xor(ss, 16); ss += __shfl_xor(ss, 32);
                if (fq == 0) atomicAdd(ssq + row, ss); }
    }
};
struct EpiDown {
    static constexpr bool PERM = true, AFTER_DRAIN = false;
    const float* X1; float* yp; float* ys;
    __device__ __forceinline__ void operator()(const f32x4 (&acc)[2][2][4][2], const Unit& u, int wr, int wc, int fr, int fq) const {
        const int row0 = u.pm * BM + wr * 64 + fr, col0 = u.pn * BM + wc * 32 + 8 * fq;
#pragma unroll
        for (int ai = 0; ai < 2; ++ai)
#pragma unroll
            for (int m = 0; m < 4; ++m) { const int row = row0 + ai * HALF + m * 16;
                float* yr = row < 16384 ? yp + (size_t)row * 1024 : (row < 16416 ? ys + (size_t)(row - 16384) * 1024 : nullptr);
                if (!yr) continue;
#pragma unroll
                for (int bj = 0; bj < 2; ++bj) { const int col = col0 + bj * HALF;
                    const f32x4 x0 = *(const f32x4*)(X1 + (size_t)row * 1024 + col), x1 = *(const f32x4*)(X1 + (size_t)row * 1024 + col + 4);
                    *(f32x4*)(yr + col) = acc[ai][bj][m][0] + x0; *(f32x4*)(yr + col + 4) = acc[ai][bj][m][1] + x1; } }
    }
};
template <class Epi, class Sched, bool ALIGN_EPI = false, bool SP2 = false>
__device__ __forceinline__ void gemm_phase(PG8_LAS unsigned char* lds, const Gemm g, const Sched& S, const Epi& E, const int wid) {
    unsigned z_ = 0u; asm volatile("" : "+v"(z_));
    const int lane = (int)__builtin_amdgcn_mbcnt_hi(~0u, __builtin_amdgcn_mbcnt_lo(~0u, z_)), tid = wid * 64 + lane, wr = wid >> 2, wc = wid & 3, fr = lane & 15, fq = lane >> 4;
    const int K = g.K, nt = K / BK;
    unsigned voffA[2], voffB[2];
#pragma unroll
    for (int i = 0; i < 2; ++i) { int R, C; stage_rc(tid * 16 + i * 8192, R, C); const int Rb = Epi::PERM ? ((R & ~31) + perm32(R & 31)) : R;
        voffA[i] = (unsigned)(R * K + C) * 2u; voffB[i] = (unsigned)(Rb * K + C) * 2u; }
    const size_t kstep = (size_t)(BK * 2);
    const size_t hstep = (size_t)HALF * K * 2;
    const size_t tstep = 2 * hstep;
    const unsigned ldsw = (unsigned)wid * 1024u;
    const int aoff = lds_byte(wr * 64 + fr, fq * 8), boff = lds_byte(wc * 32 + fr, fq * 8);
#define PG8_SA(b, h) (((b) * 2 + (h)) * HTB)
#define PG8_SB(b, h) ((4 + (b) * 2 + (h)) * HTB)
#define PG8_STAGE(bufoff, gbase, voff) do { _Pragma("unroll") for (int _i = 0; _i < 2; ++_i) \
        __builtin_amdgcn_global_load_lds((const unsigned*)((const char*)(gbase) + (voff)[_i]), (PG8_LAS unsigned*)(lds + (bufoff) + ldsw + _i * 8192), 16, 0, 0); } while (0)
#define PG8_LDA(dst, b, h) do { _Pragma("unroll") for (int m = 0; m < 4; ++m) _Pragma("unroll") for (int k = 0; k < 2; ++k) dst[m][k] = *(const PG8_LAS bf16x8*)(lds + PG8_SA(b, h) + aoff + m * 2048 + k * 1024); } while (0)
#define PG8_LDB(dst, b, h) do { _Pragma("unroll") for (int n = 0; n < 2; ++n) _Pragma("unroll") for (int k = 0; k < 2; ++k) dst[n][k] = *(const PG8_LAS bf16x8*)(lds + PG8_SB(b, h) + boff + n * 2048 + k * 1024); } while (0)
#define PG8_MMA(ai, bj, At, Bt) do { __builtin_amdgcn_s_setprio(1); _Pragma("unroll") for (int m = 0; m < 4; ++m) _Pragma("unroll") for (int n = 0; n < 2; ++n) _Pragma("unroll") for (int k = 0; k < 2; ++k) \
        acc[ai][bj][m][n] = __builtin_amdgcn_mfma_f32_16x16x32_bf16(Bt[n][k], At[m][k], acc[ai][bj][m][n], 0, 0, 0); __builtin_amdgcn_s_setprio(0); } while (0)
#define PG8_WAIT_V(n) asm volatile("s_waitcnt vmcnt(" #n ")" ::: "memory")
#define PG8_WAIT_L(n) asm volatile("s_waitcnt lgkmcnt(" #n ")" ::: "memory")
#define PG8_BAR __builtin_amdgcn_s_barrier()
#define PG8_SCHED __builtin_amdgcn_sched_barrier(0)
    Unit cur, nxt; int ui = 0;
    if (!S.next(0, cur)) return;
    f32x4 acc[2][2][4][2];
#pragma unroll
    for (int a = 0; a < 2; ++a)
#pragma unroll
        for (int b = 0; b < 2; ++b)
#pragma unroll
            for (int m = 0; m < 4; ++m)
#pragma unroll
                for (int n = 0; n < 2; ++n) acc[a][b][m][n] = (f32x4){0.f, 0.f, 0.f, 0.f};
    bf16x8 At[4][2], B0[2][2], B1[2][2];
    const char* cA = (const char*)g.A + (size_t)cur.pm * tstep; const char* cB = (const char*)g.Bt + (size_t)cur.pn * tstep;
    S.a_ready(cur);
    if constexpr (SP2) {
        PG8_STAGE(PG8_SB(0, 0), cB, voffB); PG8_STAGE(PG8_SB(0, 1), cB + hstep, voffB); PG8_STAGE(PG8_SA(0, 0), cA, voffA); PG8_STAGE(PG8_SA(0, 1), cA + hstep, voffA);
        if (wr == 1) PG8_BAR;
        PG8_WAIT_V(2); PG8_BAR;
        PG8_STAGE(PG8_SB(1, 0), cB + kstep, voffB); PG8_STAGE(PG8_SA(1, 0), cA + kstep, voffA); PG8_STAGE(PG8_SB(1, 1), cB + hstep + kstep, voffB);
        PG8_WAIT_V(6); PG8_BAR;
    } else {
        PG8_STAGE(PG8_SB(0, 0), cB, voffB); PG8_STAGE(PG8_SA(0, 0), cA, voffA); PG8_STAGE(PG8_SB(0, 1), cB + hstep, voffB); PG8_STAGE(PG8_SA(0, 1), cA + hstep, voffA);
        if (wr == 1) PG8_BAR;
        PG8_WAIT_V(4); PG8_BAR;
        PG8_STAGE(PG8_SB(1, 0), cB + kstep, voffB); PG8_STAGE(PG8_SA(1, 0), cA + kstep, voffA); PG8_STAGE(PG8_SB(1, 1), cB + hstep + kstep, voffB);
        PG8_WAIT_V(6); PG8_BAR;
    }
    for (;;) {
        const bool has_next = S.next(ui + 1, nxt);
        const char* nA = has_next ? (const char*)g.A + (size_t)nxt.pm * tstep : cA; const char* nB = has_next ? (const char*)g.Bt + (size_t)nxt.pn * tstep : cB;
        for (int t = 0; t < nt; t += 2) {
            const bool last = (t == nt - 2);
            const char* a1 = cA + (size_t)(t + 1) * kstep;
            const char* a2 = last ? nA : cA + (size_t)(t + 2) * kstep; const char* b2 = last ? nB : cB + (size_t)(t + 2) * kstep;
            const char* a3 = a2 + kstep; const char* b3 = b2 + kstep;
            if (last && has_next) S.a_ready(nxt);
            if constexpr (SP2) {
            PG8_LDB(B0, 0, 0); PG8_LDB(B1, 0, 1); PG8_SCHED; PG8_LDA(At, 0, 0); PG8_STAGE(PG8_SA(1, 1), a1 + hstep, voffA);
            PG8_WAIT_V(8); PG8_WAIT_L(0); PG8_BAR; PG8_MMA(0, 0, At, B0); PG8_MMA(0, 1, At, B1); PG8_BAR; PG8_SCHED;
            PG8_LDA(At, 0, 1); PG8_STAGE(PG8_SB(0, 0), b2, voffB); PG8_STAGE(PG8_SB(0, 1), b2 + hstep, voffB); PG8_STAGE(PG8_SA(0, 0), a2, voffA);
            PG8_WAIT_V(8); PG8_WAIT_L(0); PG8_BAR; PG8_MMA(1, 0, At, B0); PG8_MMA(1, 1, At, B1); PG8_BAR; PG8_SCHED;
            PG8_LDB(B0, 1, 0); PG8_LDB(B1, 1, 1); PG8_SCHED; PG8_LDA(At, 1, 0); PG8_STAGE(PG8_SA(0, 1), a2 + hstep, voffA);
            PG8_WAIT_V(8); PG8_WAIT_L(0); PG8_BAR; PG8_MMA(0, 0, At, B0); PG8_MMA(0, 1, At, B1); PG8_BAR; PG8_SCHED;
            PG8_LDA(At, 1, 1); PG8_STAGE(PG8_SB(1, 0), b3, voffB); PG8_STAGE(PG8_SB(1, 1), b3 + hstep, voffB); PG8_STAGE(PG8_SA(1, 0), a3, voffA);
            PG8_WAIT_V(8); PG8_WAIT_L(0); PG8_BAR; PG8_MMA(1, 0, At, B0); PG8_MMA(1, 1, At, B1); PG8_BAR; PG8_SCHED;
            } else {
            PG8_LDB(B0, 0, 0); PG8_SCHED; PG8_LDA(At, 0, 0); PG8_STAGE(PG8_SA(1, 1), a1 + hstep, voffA);
            PG8_WAIT_L(8); PG8_BAR; PG8_WAIT_L(0); PG8_MMA(0, 0, At, B0); PG8_BAR; PG8_SCHED;
            PG8_LDB(B1, 0, 1); PG8_STAGE(PG8_SB(0, 0), b2, voffB);
            PG8_BAR; PG8_WAIT_L(0); PG8_MMA(0, 1, At, B1); PG8_BAR;
            PG8_LDA(At, 0, 1); PG8_STAGE(PG8_SA(0, 0), a2, voffA);
            PG8_BAR; PG8_WAIT_L(0); PG8_MMA(1, 0, At, B0); PG8_BAR; PG8_SCHED;
            PG8_STAGE(PG8_SB(0, 1), b2 + hstep, voffB);
            PG8_WAIT_V(6); PG8_BAR; PG8_MMA(1, 1, At, B1); PG8_BAR;
            PG8_LDB(B0, 1, 0); PG8_SCHED; PG8_LDA(At, 1, 0); PG8_STAGE(PG8_SA(0, 1), a2 + hstep, voffA);
            PG8_WAIT_L(8); PG8_BAR; PG8_WAIT_L(0); PG8_MMA(0, 0, At, B0); PG8_BAR; PG8_SCHED;
            PG8_LDB(B1, 1, 1); PG8_STAGE(PG8_SB(1, 0), b3, voffB);
            PG8_BAR; PG8_WAIT_L(0); PG8_MMA(0, 1, At, B1); PG8_BAR;
            PG8_LDA(At, 1, 1); PG8_STAGE(PG8_SA(1, 0), a3, voffA);
            PG8_BAR; PG8_WAIT_L(0); PG8_MMA(1, 0, At, B0); PG8_BAR; PG8_SCHED;
            PG8_STAGE(PG8_SB(1, 1), b3 + hstep, voffB);
            PG8_WAIT_V(6); PG8_BAR; PG8_MMA(1, 1, At, B1); PG8_BAR;
            }
        }
        if constexpr (ALIGN_EPI) { if (wr == 0) PG8_BAR; }
        if constexpr (!Epi::AFTER_DRAIN) { E(acc, cur, wr, wc, fr, fq); S.done(cur); }
        if (!has_next) break;
#pragma unroll
        for (int a = 0; a < 2; ++a)
#pragma unroll
            for (int b = 0; b < 2; ++b)
#pragma unroll
                for (int m = 0; m < 4; ++m)
#pragma unroll
                    for (int n = 0; n < 2; ++n) acc[a][b][m][n] = (f32x4){0.f, 0.f, 0.f, 0.f};
        cur = nxt; cA = nA; cB = nB; ++ui;
        if constexpr (ALIGN_EPI) { if (wr == 1) PG8_BAR; }
    }
    PG8_WAIT_V(0);
    if constexpr (!ALIGN_EPI) { if (wr == 0) PG8_BAR; }
    PG8_BAR;
    if constexpr (Epi::AFTER_DRAIN) { E.fused(acc, cur, wr, wc, fr, fq, lds, wid, lane); S.done(cur); }
#undef PG8_SA
#undef PG8_SB
#undef PG8_STAGE
#undef PG8_LDA
#undef PG8_LDB
#undef PG8_MMA
#undef PG8_WAIT_V
#undef PG8_WAIT_L
#undef PG8_BAR
#undef PG8_SCHED
}
}

typedef unsigned short bf16;
typedef short bf16x8 __attribute__((ext_vector_type(8)));
typedef short bf16x4 __attribute__((ext_vector_type(4)));
typedef float f32x4 __attribute__((ext_vector_type(4)));
typedef unsigned u32x4 __attribute__((ext_vector_type(4)));
typedef unsigned u32x2 __attribute__((ext_vector_type(2)));
#define LAS __attribute__((address_space(3)))
constexpr int NWAVES = 8, NTHR = 512;
constexpr int DM = 1024, T = 8192, NB = 2, NTOKP = NB * T, SB = 32, NTOK = NTOKP + SB, MPAD = 16640;
constexpr int DIN = 6440, DINP = 6656, DFF = 2816, DUP = 2 * DFF;
constexpr int C_Q = 0, C_KV = 512, C_G = 1280, C_GQ = 1304, C_GK = 1560, C_GV = 1816, C_LR = 2328, C_GR = 2344, C_XQ = 2856, C_MG = 3368;
constexpr float EPS = 1e-6f, LOG2E = 1.4426950408889634f;
constexpr float QSCALE = 0.125f * LOG2E;
constexpr float XSCALE = 0.08838834764831845f * LOG2E;
constexpr size_t O_Y = 0, O_YS = 16777216, O_KVP = O_YS + 32768, O_WINP = O_KVP + 8388608, O_GLAP = O_WINP + 262144, O_CONVP = O_GLAP + 65536,
                 O_MEMP = O_CONVP + 11264, O_KVS = O_MEMP + 524288, O_WINS = O_KVS + 16384, O_GLAS = O_WINS + 4194304, O_CONVS = O_GLAS + 1048576, O_END = O_CONVS + 180224;
enum { I_XP = 0, I_XS, I_CKV, I_CWIN, I_SGLA, I_SCONV, I_CMEM, I_PT, I_MEMP, I_GMIX, I_WIN, I_GNQ, I_GNK, I_CKPE, I_CKW1, I_CKW2, I_CVPE, I_CVW1, I_CVW2,
       I_RB, I_WGG, I_BGG, I_GGO, I_GMEM, I_WMEM, I_GXQ, I_GXK, I_WNSA, I_WGLA, I_WX, I_WO, I_GFFN, I_WUP, I_CONVW, I_CONVB, I_WDOWN, N_IN };
constexpr size_t al_(size_t x) { return (x + 255) & ~(size_t)255; }
constexpr size_t WS_SSQ = 0;
constexpr size_t WS_C0 = al_(WS_SSQ + (size_t)MPAD * 4);
constexpr size_t WS_WTIN = al_(WS_C0 + 1024);
constexpr size_t WS_WTMEM = al_(WS_WTIN + (size_t)DINP * 1024 * 2);
constexpr size_t WS_WTNSA = al_(WS_WTMEM + (size_t)1024 * 1024 * 2);
constexpr size_t WS_WTGLA = al_(WS_WTNSA + (size_t)1024 * 512 * 2);
constexpr size_t WS_WTX = al_(WS_WTGLA + (size_t)1024 * 512 * 2);
constexpr size_t WS_WTO = al_(WS_WTX + (size_t)1024 * 512 * 2);
constexpr size_t WS_WTUP = al_(WS_WTO + (size_t)1024 * 1024 * 2);
constexpr size_t WS_WTDOWN = al_(WS_WTUP + (size_t)DUP * 1024 * 2);
constexpr size_t WS_W1T = al_(WS_WTDOWN + (size_t)1024 * DFF * 2);
constexpr size_t WS_W2T = al_(WS_W1T + (size_t)2 * 64 * 2048 * 2);
constexpr size_t WS_XN = al_(WS_W2T + (size_t)2 * 64 * 64 * 2);
constexpr size_t WS_MN = al_(WS_XN + (size_t)MPAD * 1024 * 2);
constexpr size_t WS_PROJ = al_(WS_MN + (size_t)512 * 1024 * 2);
constexpr size_t WS_MEMPROJ = al_(WS_PROJ + (size_t)MPAD * DINP * 2);
constexpr size_t WS_QN = al_(WS_MEMPROJ + (size_t)512 * 1024 * 2);
constexpr size_t WS_KSEL = al_(WS_QN + (size_t)NTOK * 512 * 2);
constexpr size_t WS_VSELT = al_(WS_KSEL + (size_t)4 * T * 64 * 2);
constexpr size_t WS_KWIN = al_(WS_VSELT + (size_t)4 * T * 64 * 2);
constexpr size_t WS_VWINT = al_(WS_KWIN + (size_t)4 * T * 64 * 2);
constexpr size_t WS_GATES = al_(WS_VWINT + (size_t)4 * T * 64 * 2);
constexpr size_t WS_NEWKV = al_(WS_GATES + (size_t)NTOK * 24 * 4);
constexpr size_t WS_KCMP = al_(WS_NEWKV + (size_t)SB * 4 * 2 * 64 * 4);
constexpr size_t WS_VCMPT = al_(WS_KCMP + (size_t)4 * 512 * 64 * 2);
constexpr size_t WS_KCMPS = al_(WS_VCMPT + (size_t)4 * 512 * 64 * 2);
constexpr size_t WS_VCMPS = al_(WS_KCMPS + (size_t)SB * 2 * 512 * 64 * 4);
constexpr size_t WS_QTG = al_(WS_VCMPS + (size_t)SB * 2 * 512 * 64 * 4);
constexpr size_t WS_KTG = al_(WS_QTG + (size_t)NTOKP * 256 * 2);
constexpr size_t WS_VTG = al_(WS_KTG + (size_t)NTOKP * 256 * 2);
constexpr size_t WS_UP = al_(WS_VTG + (size_t)256 * 4 * 128 * 64 * 2);
constexpr size_t WS_DEC = al_(WS_UP + (size_t)256 * 4 * 128 * 64 * 4);
constexpr size_t WS_SC = al_(WS_DEC + (size_t)256 * 4 * 64 * 4);
constexpr size_t WS_XQ = al_(WS_SC + (size_t)256 * 4 * 128 * 64 * 2);
constexpr size_t WS_KMEM = al_(WS_XQ + (size_t)NTOK * 512 * 2);
constexpr size_t WS_VMEMT = al_(WS_KMEM + (size_t)8 * 256 * 128 * 2);
constexpr size_t WS_ONSA = al_(WS_VMEMT + (size_t)8 * 256 * 128 * 2);
constexpr size_t WS_OGLA = al_(WS_ONSA + (size_t)MPAD * 512 * 2);
constexpr size_t WS_OX = al_(WS_OGLA + (size_t)MPAD * 512 * 2);
constexpr size_t WS_MERGED = al_(WS_OX + (size_t)MPAD * 512 * 2);
constexpr size_t WS_X1 = al_(WS_MERGED + (size_t)MPAD * 1024 * 2);
constexpr size_t WS_X1B = al_(WS_X1 + (size_t)MPAD * 1024 * 4);
constexpr size_t WS_UG = al_(WS_X1B + (size_t)MPAD * 1024 * 2);
constexpr size_t WS_ACT = al_(WS_UG + (size_t)MPAD * DUP * 2);
constexpr size_t WS_END = al_(WS_ACT + (size_t)MPAD * DFF * 2);
constexpr int RING_BYTES = 131072, LDS_BYTES = 155648;

struct Args { const float* in[N_IN]; float* out; unsigned char* ws; int ph_lo, ph_hi, sub, pad; };

__device__ __forceinline__ unsigned f2bf(float f) { unsigned u = __float_as_uint(f); return (u + 0x7fffu + ((u >> 16) & 1u)) >> 16; }
__device__ __forceinline__ unsigned pk2(float lo, float hi) { return pg8::cvt_pk_bf16(lo, hi); }
__device__ __forceinline__ float bf2f(unsigned short u) { return __uint_as_float((unsigned)u << 16); }
__device__ __forceinline__ float bflo(unsigned w) { return __uint_as_float(w << 16); }
__device__ __forceinline__ float bfhi(unsigned w) { return __uint_as_float(w & 0xffff0000u); }
__device__ __forceinline__ void unpack8(const u32x4 w, float (&f)[8]) { f[0] = bflo(w.x); f[1] = bfhi(w.x); f[2] = bflo(w.y); f[3] = bfhi(w.y); f[4] = bflo(w.z); f[5] = bfhi(w.z); f[6] = bflo(w.w); f[7] = bfhi(w.w); }
__device__ __forceinline__ u32x4 pack8(const float (&f)[8]) { u32x4 w; w.x = pk2(f[0], f[1]); w.y = pk2(f[2], f[3]); w.z = pk2(f[4], f[5]); w.w = pk2(f[6], f[7]); return w; }
__device__ __forceinline__ bf16x8 as_frag(u32x4 w) { return __builtin_bit_cast(bf16x8, w); }
__device__ __forceinline__ bf16x8 frag_pk(f32x4 a, f32x4 b) { u32x4 w; w.x = pk2(a[0], a[1]); w.y = pk2(a[2], a[3]); w.z = pk2(b[0], b[1]); w.w = pk2(b[2], b[3]); return as_frag(w); }
__device__ __forceinline__ bf16x8 ldfrag(const bf16* p) { return as_frag(*(const u32x4*)p); }
__device__ __forceinline__ bf16x8 ldfrag2(const bf16* p0, const bf16* p1) { const u32x2 a = *(const u32x2*)p0, b = *(const u32x2*)p1; u32x4 w; w.x = a.x; w.y = a.y; w.z = b.x; w.w = b.y; return as_frag(w); }
__device__ __forceinline__ bf16x8 ldfrag_f32(const float* p) { const f32x4 a = *(const f32x4*)p, b = *(const f32x4*)(p + 4); return frag_pk(a, b); }
#define MFMA16(a, b, c) __builtin_amdgcn_mfma_f32_16x16x32_bf16((a), (b), (c), 0, 0, 0)
__device__ __forceinline__ float sigmoidf_(float x) { return 1.0f / (1.0f + __expf(-x)); }
__device__ __forceinline__ float gelu_tanh(float x) { const float u = 0.7978845608028654f * (x + 0.044715f * x * x * x); const float e = __expf(2.0f * u); return 0.5f * x * (2.0f - 2.0f / (e + 1.0f)); }
__device__ __forceinline__ float wave_sum(float v) {
#pragma unroll
    for (int o = 1; o < 64; o <<= 1) v += __shfl_xor(v, o);
    return v;
}
__device__ __forceinline__ float wave_max(float v) {
#pragma unroll
    for (int o = 1; o < 64; o <<= 1) v = fmaxf(v, __shfl_xor(v, o));
    return v;
}
__device__ __forceinline__ float absmax_arr(const float* g, int n, int lane) { float m = 0.f; for (int i = lane; i < n; i += 64) m = fmaxf(m, fabsf(g[i])); return wave_max(m); }
__device__ __forceinline__ int t5_bucket(int n) {
    if (n < 16) return n;
    if (n >= 128) return 31;
    const int v = 16 + (int)(__logf((float)n * 0.0625f) / 2.0794415416798357f * 16.0f);
    return v < 31 ? v : 31;
}

struct Frame {
    LAS unsigned char* lds;
    int wave, G, bid, gw, NGW;
    const float* const* in; float* out; unsigned char* ws;
};
#define WSP(T_, off) ((T_*)(F.ws + (off)))
__device__ __forceinline__ int lane_id_() { unsigned z = 0u; asm volatile("" : "+v"(z)); return (int)__builtin_amdgcn_mbcnt_hi(~0u, __builtin_amdgcn_mbcnt_lo(~0u, z)); }
#define LANE_ lane_id_()
#define TID_ (F.wave * 64 + lane_id_())

__device__ __forceinline__ void transpose_item(const float* W, int K, int N, bf16* WT, const float* kscale, LAS float* scr, int item, int nblk, int lane) {
    const int kb = item / nblk, nb = item % nblk, k0 = 64 * kb, n0 = 32 * nb;
#pragma unroll 8
    for (int i = 0; i < 32; ++i) { const int kk = 2 * i + (lane >> 5); const int n = n0 + (lane & 31);
        float v = n < N ? W[(size_t)(k0 + kk) * N + n] : 0.f; if (kscale) v *= kscale[k0 + kk];
        scr[kk * 33 + (lane & 31)] = v; }
    asm volatile("s_waitcnt lgkmcnt(0)" ::: "memory");
    const int c = lane & 7;
#pragma unroll
    for (int j = 0; j < 4; ++j) { const int n = (lane >> 3) + 8 * j; const LAS float* s = scr + (8 * c) * 33 + n;
        u32x4 o; o.x = pk2(s[0 * 33], s[1 * 33]); o.y = pk2(s[2 * 33], s[3 * 33]); o.z = pk2(s[4 * 33], s[5 * 33]); o.w = pk2(s[6 * 33], s[7 * 33]);
        *(u32x4*)(WT + (size_t)(n0 + n) * K + k0 + 8 * c) = o; }
    asm volatile("s_waitcnt lgkmcnt(0)" ::: "memory");
}
__device__ __forceinline__ void rms_row_to_bf16(const float* xrow, const float* g, bf16* orow, int lane) {
    unsigned long long* o8 = (unsigned long long*)orow + lane;
    if (!xrow) {
#pragma unroll
        for (int j = 0; j < 4; ++j) o8[64 * j] = 0ull;
        return; }
    const f32x4* xr = (const f32x4*)xrow + lane; const f32x4* gr = (const f32x4*)g + lane;
    f32x4 v[4]; float s = 0.f;
#pragma unroll
    for (int j = 0; j < 4; ++j) { v[j] = xr[64 * j]; s += (v[j].x * v[j].x + v[j].y * v[j].y) + (v[j].z * v[j].z + v[j].w * v[j].w); }
    const float rs = rsqrtf(wave_sum(s) * (1.f / 1024.f) + EPS);
#pragma unroll
    for (int j = 0; j < 4; ++j) { const f32x4 gg = gr[64 * j]; const f32x4 y = v[j] * rs * gg;
        o8[64 * j] = (unsigned long long)pk2(y.x, y.y) | ((unsigned long long)pk2(y.z, y.w) << 32); }
}
__device__ __forceinline__ void p0_prologue(Frame& F) {
    LAS float* scr = (LAS float*)(F.lds + F.wave * 16384);
    const int gw = F.gw, NGW = F.NGW;
    constexpr int IT_IN = 16 * 208, IT_MEM = 16 * 32, IT_BR = 8 * 32, IT_O = 16 * 32, IT_UP = 16 * 176, IT_DOWN = 44 * 32, IT_W1 = 32 * 2, IT_W2 = 1 * 2;
    constexpr int NITEMS = IT_IN + IT_MEM + 3 * IT_BR + IT_O + IT_UP + IT_DOWN + 2 * IT_W1 + 2 * IT_W2;
    for (int it = gw; it < NITEMS; it += NGW) {
        int r = it;
        if (r < IT_UP) { transpose_item(F.in[I_WUP], 1024, DUP, WSP(bf16, WS_WTUP), F.in[I_GFFN], scr, r, 176, LANE_); continue; } r -= IT_UP;
        if (r < IT_IN) { transpose_item(F.in[I_WIN], 1024, DIN, WSP(bf16, WS_WTIN), nullptr, scr, r, 208, LANE_); continue; } r -= IT_IN;
        if (r < IT_DOWN) { transpose_item(F.in[I_WDOWN], DFF, 1024, WSP(bf16, WS_WTDOWN), nullptr, scr, r, 32, LANE_); continue; } r -= IT_DOWN;
        if (r < IT_MEM) { transpose_item(F.in[I_WMEM], 1024, 1024, WSP(bf16, WS_WTMEM), nullptr, scr, r, 32, LANE_); continue; } r -= IT_MEM;
        if (r < IT_O) { transpose_item(F.in[I_WO], 1024, 1024, WSP(bf16, WS_WTO), nullptr, scr, r, 32, LANE_); continue; } r -= IT_O;
        if (r < IT_BR) { transpose_item(F.in[I_WNSA], 512, 1024, WSP(bf16, WS_WTNSA), nullptr, scr, r, 32, LANE_); continue; } r -= IT_BR;
        if (r < IT_BR) { transpose_item(F.in[I_WGLA], 512, 1024, WSP(bf16, WS_WTGLA), nullptr, scr, r, 32, LANE_); continue; } r -= IT_BR;
        if (r < IT_BR) { transpose_item(F.in[I_WX], 512, 1024, WSP(bf16, WS_WTX), nullptr, scr, r, 32, LANE_); continue; } r -= IT_BR;
        if (r < IT_W1) { transpose_item(F.in[I_CKW1], 2048, 64, WSP(bf16, WS_W1T), nullptr, scr, r, 2, LANE_); continue; } r -= IT_W1;
        if (r < IT_W1) { transpose_item(F.in[I_CVW1], 2048, 64, WSP(bf16, WS_W1T) + 64 * 2048, nullptr, scr, r, 2, LANE_); continue; } r -= IT_W1;
        if (r < IT_W2) { transpose_item(F.in[I_CKW2], 64, 64, WSP(bf16, WS_W2T), nullptr, scr, r, 2, LANE_); continue; } r -= IT_W2;
        transpose_item(F.in[I_CVW2], 64, 64, WSP(bf16, WS_W2T) + 64 * 64, nullptr, scr, r, 2, LANE_);
    }
    for (int m = gw; m < MPAD + 512; m += NGW) {
        if (m < MPAD) { const float* xr = m < NTOKP ? F.in[I_XP] + (size_t)m * 1024 : (m < NTOK ? F.in[I_XS] + (size_t)(m - NTOKP) * 1024 : nullptr);
            rms_row_to_bf16(xr, F.in[I_GMIX], WSP(bf16, WS_XN) + (size_t)m * 1024, LANE_); }
        else { const int mm = m - MPAD; rms_row_to_bf16(F.in[I_MEMP] + (size_t)mm * 1024, F.in[I_GMEM], WSP(bf16, WS_MN) + (size_t)mm * 1024, LANE_); }
    }
    { float* ssq = WSP(float, WS_SSQ); for (int i = F.bid * NTHR + TID_; i < MPAD; i += F.G * NTHR) ssq[i] = 0.f; }
    for (int s = gw; s < 2; s += NGW) { const float* pe = F.in[s ? I_CVPE : I_CKPE]; const float* w1 = F.in[s ? I_CVW1 : I_CKW1]; float a = 0.f;
        for (int k = 0; k < 2048; ++k) a += pe[k] * w1[(size_t)k * 64 + LANE_];
        WSP(float, WS_C0)[s * 64 + LANE_] = a; }
    { const f32x4* src = (const f32x4*)F.in[I_CWIN]; f32x4* dst = (f32x4*)(F.out + O_WINS);
      for (int i = F.bid * NTHR + TID_; i < SB * 511 * 64; i += F.G * NTHR) { const int b = i / (511 * 64), r = i % (511 * 64); dst[(size_t)b * 512 * 64 + r] = src[(size_t)b * 512 * 64 + 64 + r]; } }
}

__device__ __forceinline__ void p2_token(Frame& F, int tok) {
    const int lane = LANE_; const bf16* pr = WSP(bf16, WS_PROJ) + (size_t)tok * DINP;
    const bool prompt = tok < NTOKP; const int b = tok >> 13, t = tok & (T - 1), sb = tok - NTOKP;
    float f[8];
    { unpack8(*(const u32x4*)(pr + C_Q + 8 * lane), f); float ss = 0.f;
#pragma unroll
      for (int i = 0; i < 8; ++i) ss += f[i] * f[i];
      ss += __shfl_xor(ss, 1); ss += __shfl_xor(ss, 2); ss += __shfl_xor(ss, 4);
      const float rs = rsqrtf(ss * (1.f / 64.f) + EPS) * QSCALE; const float* g = F.in[I_GNQ] + 8 * (lane & 7);
#pragma unroll
      for (int i = 0; i < 8; ++i) f[i] *= rs * g[i];
      *(u32x4*)(WSP(bf16, WS_QN) + (size_t)tok * 512 + 8 * lane) = pack8(f); }
    { unpack8(*(const u32x4*)(pr + C_KV + 8 * lane), f); float ss = 0.f;
#pragma unroll
      for (int i = 0; i < 8; ++i) ss += f[i] * f[i];
      ss += __shfl_xor(ss, 1); ss += __shfl_xor(ss, 2); ss += __shfl_xor(ss, 4);
      const int grp = lane >> 3, slot = grp >> 1, kv = grp & 1, d0 = 8 * (lane & 7);
      if (slot == 2) { const float rs = rsqrtf(ss * (1.f / 64.f) + EPS); const float* g = F.in[I_GNK] + 64 + d0;
#pragma unroll
          for (int i = 0; i < 8; ++i) f[i] *= rs * g[i]; }
      float* orow = prompt ? F.out + O_KVP + (size_t)tok * 512 + 8 * lane : F.out + O_KVS + (size_t)sb * 512 + 8 * lane;
      *(f32x4*)orow = (f32x4){f[0], f[1], f[2], f[3]}; *(f32x4*)(orow + 4) = (f32x4){f[4], f[5], f[6], f[7]};
      if (prompt) {
          if (slot == 2) *(u32x4*)(WSP(bf16, WS_KSEL) + ((size_t)(b * 2 + kv) * T + t) * 64 + d0) = pack8(f);
          if (slot == 3) { bf16* vt = WSP(bf16, WS_VSELT) + (((size_t)(b * 2 + kv) * 128 + (t >> 6)) * 64 + d0) * 64 + (t & 63);
#pragma unroll
              for (int i = 0; i < 8; ++i) vt[i * 64] = (bf16)f2bf(f[i]); }
      } else if (slot >= 2) { float* nk = WSP(float, WS_NEWKV) + ((size_t)(sb * 4 + (slot - 2)) * 2 + kv) * 64 + d0;
#pragma unroll
          for (int i = 0; i < 8; ++i) nk[i] = f[i]; }
    }
    { unpack8(*(const u32x4*)(pr + C_KV + 512 + 8 * lane), f); float ss = 0.f;
#pragma unroll
      for (int i = 0; i < 8; ++i) ss += f[i] * f[i];
      ss += __shfl_xor(ss, 1); ss += __shfl_xor(ss, 2); ss += __shfl_xor(ss, 4);
      const int grp = lane >> 3, slot = 4 + (grp >> 1), kv = grp & 1, d0 = 8 * (lane & 7);
      if (lane < 32) {
          if (slot == 4) { const float rs = rsqrtf(ss * (1.f / 64.f) + EPS); const float* g = F.in[I_GNK] + 128 + d0;
#pragma unroll
              for (int i = 0; i < 8; ++i) f[i] *= rs * g[i]; }
          if (prompt) {
              if (slot == 4) *(u32x4*)(WSP(bf16, WS_KWIN) + ((size_t)(b * 2 + kv) * T + t) * 64 + d0) = pack8(f);
              else { bf16* vt = WSP(bf16, WS_VWINT) + (((size_t)(b * 2 + kv) * 128 + (t >> 6)) * 64 + d0) * 64 + (t & 63);
#pragma unroll
                  for (int i = 0; i < 8; ++i) vt[i * 64] = (bf16)f2bf(f[i]); }
              if (t >= T - 512) { float* orow = F.out + O_WINP + ((size_t)b * 512 + (t - (T - 512))) * 256 + 8 * lane;
                  *(f32x4*)orow = (f32x4){f[0], f[1], f[2], f[3]}; *(f32x4*)(orow + 4) = (f32x4){f[4], f[5], f[6], f[7]}; }
          } else {
              float* nk = WSP(float, WS_NEWKV) + ((size_t)(sb * 4 + (slot - 2)) * 2 + kv) * 64 + d0;
#pragma unroll
              for (int i = 0; i < 8; ++i) nk[i] = f[i];
              float* orow = F.out + O_WINS + ((size_t)sb * 512 + 511) * 256 + 8 * lane;
              *(f32x4*)orow = (f32x4){f[0], f[1], f[2], f[3]}; *(f32x4*)(orow + 4) = (f32x4){f[4], f[5], f[6], f[7]};
          }
      }
    }
    if (lane < 24) WSP(float, WS_GATES)[(size_t)tok * 24 + lane] = sigmoidf_(bf2f(pr[C_G + lane]));
    { unpack8(*(const u32x4*)(pr + C_XQ + 8 * lane), f); float ss = 0.f;
#pragma unroll
      for (int i = 0; i < 8; ++i) ss += f[i] * f[i];
      ss += __shfl_xor(ss, 1); ss += __shfl_xor(ss, 2); ss += __shfl_xor(ss, 4); ss += __shfl_xor(ss, 8);
      const float rs = rsqrtf(ss * (1.f / 128.f) + EPS) * XSCALE; const float* g = F.in[I_GXQ] + 8 * (lane & 15);
#pragma unroll
      for (int i = 0; i < 8; ++i) f[i] *= rs * g[i];
      *(u32x4*)(WSP(bf16, WS_XQ) + (size_t)tok * 512 + 8 * lane) = pack8(f); }
}
__device__ __forceinline__ void p2_memrow(Frame& F, int row) {
    const int lane = LANE_, b = row >> 8, m = row & 255, head = lane >> 4, d0 = 8 * (lane & 15);
    const bf16* pr = WSP(bf16, WS_MEMPROJ) + (size_t)row * 1024; float f[8];
    { unpack8(*(const u32x4*)(pr + 8 * lane), f); float ss = 0.f;
#pragma unroll
      for (int i = 0; i < 8; ++i) ss += f[i] * f[i];
      ss += __shfl_xor(ss, 1); ss += __shfl_xor(ss, 2); ss += __shfl_xor(ss, 4); ss += __shfl_xor(ss, 8);
      const float rs = rsqrtf(ss * (1.f / 128.f) + EPS); const float* g = F.in[I_GXK] + d0;
#pragma unroll
      for (int i = 0; i < 8; ++i) f[i] *= rs * g[i];
      float* orow = F.out + O_MEMP + ((size_t)row * 2 + 0) * 512 + 8 * lane;
      *(f32x4*)orow = (f32x4){f[0], f[1], f[2], f[3]}; *(f32x4*)(orow + 4) = (f32x4){f[4], f[5], f[6], f[7]};
      *(u32x4*)(WSP(bf16, WS_KMEM) + ((size_t)(b * 4 + head) * 256 + m) * 128 + d0) = pack8(f); }
    { unpack8(*(const u32x4*)(pr + 512 + 8 * lane), f);
      float* orow = F.out + O_MEMP + ((size_t)row * 2 + 1) * 512 + 8 * lane;
      *(f32x4*)orow = (f32x4){f[0], f[1], f[2], f[3]}; *(f32x4*)(orow + 4) = (f32x4){f[4], f[5], f[6], f[7]};
      bf16* vt = WSP(bf16, WS_VMEMT) + ((size_t)(b * 4 + head) * 128 + d0) * 256 + m;
#pragma unroll
      for (int i = 0; i < 8; ++i) vt[i * 256] = (bf16)f2bf(f[i]); }
}

constexpr int CMP_TASKS_S = SB * 2 * 2 * 16, CMP_TASKS_P = NB * 2 * 2 * 16;
__device__ __forceinline__ void p2_compress(Frame& F, int task) {
    const int lane = LANE_, r = lane & 15, q = lane >> 4;
    const bool smp = task < CMP_TASKS_S; const int x = smp ? task : task - CMP_TASKS_S;
    const int b = x >> 6, kv = (x >> 5) & 1, slot = (x >> 4) & 1, i0 = 32 * (x & 15);
    const bf16* W1t = WSP(bf16, WS_W1T) + (size_t)slot * 64 * 2048;
    const bf16* W2t = WSP(bf16, WS_W2T) + (size_t)slot * 64 * 64;
    const int* pt = (const int*)F.in[I_PT] + b * 64;
    const float* ckv = F.in[I_CKV];
    const bf16* proj = WSP(bf16, WS_PROJ);
    f32x4 acc[4][2];
#pragma unroll
    for (int nt = 0; nt < 4; ++nt) { acc[nt][0] = (f32x4){0.f, 0.f, 0.f, 0.f}; acc[nt][1] = acc[nt][0]; }
#pragma unroll 2
    for (int ks = 0; ks < 64; ++ks) {
        bf16x8 bfr[2];
#pragma unroll
        for (int it = 0; it < 2; ++it) {
            int tok = 16 * (i0 + 16 * it + r) + (ks >> 1); tok = tok < T ? tok : T - 1;
            const int d = 32 * (ks & 1) + 8 * q;
            if (smp) { const int page = pt[tok >> 7]; bfr[it] = ldfrag_f32(ckv + (((size_t)page * 128 + (tok & 127)) * 4 + slot) * 128 + kv * 64 + d); }
            else bfr[it] = ldfrag(proj + ((size_t)b * T + tok) * DINP + C_KV + slot * 128 + kv * 64 + d);
        }
#pragma unroll
        for (int nt = 0; nt < 4; ++nt) { const bf16x8 a = ldfrag(W1t + (size_t)(16 * nt + r) * 2048 + 32 * ks + 8 * q);
            acc[nt][0] = MFMA16(a, bfr[0], acc[nt][0]); acc[nt][1] = MFMA16(a, bfr[1], acc[nt][1]); }
    }
    const float* c0 = WSP(float, WS_C0) + slot * 64;
    const float* gk0 = F.in[I_GNK];
#pragma unroll
    for (int it = 0; it < 2; ++it) {
        f32x4 g[4];
#pragma unroll
        for (int nt = 0; nt < 4; ++nt) { const f32x4 cc = *(const f32x4*)(c0 + 16 * nt + 4 * q);
#pragma unroll
            for (int i = 0; i < 4; ++i) g[nt][i] = gelu_tanh(acc[nt][it][i] + cc[i]); }
        const bf16x8 b0 = frag_pk(g[0], g[1]), b1 = frag_pk(g[2], g[3]);
        f32x4 o[4]; float ss = 0.f;
#pragma unroll
        for (int mt = 0; mt < 4; ++mt) { const bf16* wr = W2t + (size_t)(16 * mt + r) * 64 + 4 * q;
            o[mt] = MFMA16(ldfrag2(wr, wr + 16), b0, ((f32x4){0.f, 0.f, 0.f, 0.f}));
            o[mt] = MFMA16(ldfrag2(wr + 32, wr + 48), b1, o[mt]);
            ss += (o[mt][0] * o[mt][0] + o[mt][1] * o[mt][1]) + (o[mt][2] * o[mt][2] + o[mt][3] * o[mt][3]); }
        ss += __shfl_xor(ss, 16); ss += __shfl_xor(ss, 32);
        if (slot == 0) { const float rs = rsqrtf(ss * (1.f / 64.f) + EPS);
#pragma unroll
            for (int mt = 0; mt < 4; ++mt) { const f32x4 gg = *(const f32x4*)(gk0 + 16 * mt + 4 * q); o[mt] = o[mt] * rs * gg; } }
        const int i = i0 + 16 * it + r;
        if (smp) { float* dst = WSP(float, slot ? WS_VCMPS : WS_KCMPS) + ((size_t)(b * 2 + kv) * 512 + i) * 64 + 4 * q;
#pragma unroll
            for (int mt = 0; mt < 4; ++mt) *(f32x4*)(dst + 16 * mt) = o[mt]; }
        else if (slot == 0) { bf16* dst = WSP(bf16, WS_KCMP) + ((size_t)(b * 2 + kv) * 512 + i) * 64 + 4 * q;
#pragma unroll
            for (int mt = 0; mt < 4; ++mt) { u32x2 w; w.x = pk2(o[mt][0], o[mt][1]); w.y = pk2(o[mt][2], o[mt][3]); *(u32x2*)(dst + 16 * mt) = w; } }
        else { bf16* dst = WSP(bf16, WS_VCMPT) + ((size_t)(b * 2 + kv) * 64 + 4 * q) * 512 + i;
#pragma unroll
            for (int mt = 0; mt < 4; ++mt)
#pragma unroll
                for (int e = 0; e < 4; ++e) dst[(size_t)(16 * mt + e) * 512] = (bf16)f2bf(o[mt][e]); }
    }
}

__device__ __forceinline__ int swz64(int row, int col) { return row * 64 + ((((col >> 3) ^ (row & 7)) << 3) | (col & 7)); }
__device__ __forceinline__ float log_sigmoid_(float z) { return fminf(z, 0.f) - log1pf(__expf(-fabsf(z))); }
__device__ __forceinline__ void p2_gla_chunk(Frame& F, int bc) {
    const int lane = LANE_, r = lane & 15, q = lane >> 4, h = F.wave >> 1, eh = F.wave & 1;
    LAS bf16* ktT = (LAS bf16*)(F.lds + F.wave * 16384);
    LAS bf16* vT = ktT + 4096;
    const bf16* proj = WSP(bf16, WS_PROJ) + (size_t)bc * 64 * DINP;
    float wg[16];
#pragma unroll
    for (int j = 0; j < 16; ++j) wg[j] = F.in[I_WGG][j * 256 + h * 64 + lane];
    const float bg = F.in[I_BGG][h * 64 + lane];
    bf16* qtg = WSP(bf16, WS_QTG) + (size_t)bc * 64 * 256 + h * 64 + lane;
    bf16* ktg = WSP(bf16, WS_KTG) + (size_t)bc * 64 * 256 + h * 64 + lane;
    bf16* vtg = WSP(bf16, WS_VTG) + ((size_t)(bc * 4 + h) * 128 + eh * 64 + lane) * 64;
    float cb = 0.f;
    for (int t = 0; t < 64; ++t) {
        const bf16* pr = proj + (size_t)t * DINP;
        float lr[16]; { float f8[8]; unpack8(*(const u32x4*)(pr + C_LR), f8);
#pragma unroll
            for (int j = 0; j < 8; ++j) lr[j] = f8[j];
            unpack8(*(const u32x4*)(pr + C_LR + 8), f8);
#pragma unroll
            for (int j = 0; j < 8; ++j) lr[8 + j] = f8[j]; }
        float z = bg;
#pragma unroll
        for (int j = 0; j < 16; ++j) z += lr[j] * wg[j];
        cb += log_sigmoid_(z) * 0.0625f;
        const float kk = bf2f(pr[C_GK + h * 64 + lane]) * __expf(-cb);
        const float qq = bf2f(pr[C_GQ + h * 64 + lane]) * 0.125f * __expf(cb);
        const bf16 kb = (bf16)f2bf(kk);
        if (eh == 0) { qtg[(size_t)t * 256] = (bf16)f2bf(qq); ktg[(size_t)t * 256] = kb; }
        ktT[swz64(lane, t)] = kb;
        const bf16 vv = pr[C_GV + h * 128 + eh * 64 + lane];
        vT[swz64(lane, t)] = vv; vtg[t] = vv;
    }
    const float dec = __expf(cb);
    if (eh == 0) WSP(float, WS_DEC)[(size_t)(bc * 4 + h) * 64 + lane] = dec;
    asm volatile("s_waitcnt lgkmcnt(0)" ::: "memory");
    f32x4 acc[4][4];
#pragma unroll
    for (int et = 0; et < 4; ++et)
#pragma unroll
        for (int dt = 0; dt < 4; ++dt) acc[et][dt] = (f32x4){0.f, 0.f, 0.f, 0.f};
#pragma unroll
    for (int ks = 0; ks < 2; ++ks) {
        bf16x8 bfr[4];
#pragma unroll
        for (int dt = 0; dt < 4; ++dt) bfr[dt] = as_frag(*(const LAS u32x4*)(ktT + swz64(16 * dt + r, 32 * ks + 8 * q)));
#pragma unroll
        for (int et = 0; et < 4; ++et) { const bf16x8 a = as_frag(*(const LAS u32x4*)(vT + swz64(16 * et + r, 32 * ks + 8 * q)));
#pragma unroll
            for (int dt = 0; dt < 4; ++dt) acc[et][dt] = MFMA16(a, bfr[dt], acc[et][dt]); }
    }
    float* up = WSP(float, WS_UP) + ((size_t)(bc * 4 + h) * 128 + eh * 64) * 64;
#pragma unroll
    for (int dt = 0; dt < 4; ++dt) { const float dd = __shfl(dec, 16 * dt + r);
#pragma unroll
        for (int et = 0; et < 4; ++et)
#pragma unroll
            for (int i = 0; i < 4; ++i) up[(size_t)(16 * et + 4 * q + i) * 64 + 16 * dt + r] = acc[et][dt][i] * dd; }
}

__device__ __forceinline__ void p2_gla_sample(Frame& F, int task) {
    const int lane = LANE_, b = task >> 2, h = task & 3, tok = NTOKP + b;
    const bf16* pr = WSP(bf16, WS_PROJ) + (size_t)tok * DINP;
    LAS float* sh = (LAS float*)(F.lds + F.wave * 16384);
    { float z = F.in[I_BGG][h * 64 + lane];
#pragma unroll
      for (int j = 0; j < 16; ++j) z += bf2f(pr[C_LR + j]) * F.in[I_WGG][j * 256 + h * 64 + lane];
      sh[lane] = __expf(log_sigmoid_(z) * 0.0625f); sh[64 + lane] = bf2f(pr[C_GK + h * 64 + lane]); sh[128 + lane] = bf2f(pr[C_GQ + h * 64 + lane]) * 0.125f; }
    asm volatile("s_waitcnt lgkmcnt(0)" ::: "memory");
    const float v0 = bf2f(pr[C_GV + h * 128 + lane]), v1 = bf2f(pr[C_GV + h * 128 + 64 + lane]);
    const float* s0 = F.in[I_SGLA] + (size_t)(b * 4 + h) * 64 * 128; float* s1 = F.out + O_GLAS + (size_t)(b * 4 + h) * 64 * 128;
    float o0 = 0.f, o1 = 0.f;
#pragma unroll 4
    for (int d = 0; d < 64; ++d) { const float a = sh[d], k = sh[64 + d], qq = sh[128 + d];
        const float n0 = a * s0[d * 128 + lane] + k * v0, n1 = a * s0[d * 128 + 64 + lane] + k * v1;
        s1[d * 128 + lane] = n0; s1[d * 128 + 64 + lane] = n1; o0 += qq * n0; o1 += qq * n1; }
    const float rs = rsqrtf(wave_sum(o0 * o0 + o1 * o1) * (1.f / 128.f) + EPS);
    const float r0 = bf2f(pr[C_GR + h * 128 + lane]), r1 = bf2f(pr[C_GR + h * 128 + 64 + lane]);
    bf16* og = WSP(bf16, WS_OGLA) + (size_t)tok * 512 + h * 128;
    og[lane] = (bf16)f2bf(o0 * rs * F.in[I_GGO][lane] * r0 * sigmoidf_(r0));
    og[64 + lane] = (bf16)f2bf(o1 * rs * F.in[I_GGO][64 + lane] * r1 * sigmoidf_(r1));
}

__device__ __forceinline__ void p3_gla_scan(Frame& F, int task) {
    const int lane = LANE_, b = task >> 9, h = (task >> 7) & 3, e = task & 127;
    const float* up = WSP(float, WS_UP); const float* dec = WSP(float, WS_DEC); bf16* sc = WSP(bf16, WS_SC);
    float S = 0.f;
#pragma unroll 8
    for (int c = 0; c < 128; ++c) { const int bc = b * 128 + c; const size_t idx = ((size_t)(bc * 4 + h) * 128 + e) * 64 + lane;
        sc[idx] = (bf16)f2bf(S); S = dec[(size_t)(bc * 4 + h) * 64 + lane] * S + up[idx]; }
    F.out[O_GLAP + ((size_t)(b * 4 + h) * 64 + lane) * 128 + e] = S;
}

__device__ __forceinline__ void p4_gla_out(Frame& F, int task) {
    const int lane = LANE_, r = lane & 15, q = lane >> 4, bc = task >> 2, h = task & 3;
    const bf16* qtg = WSP(bf16, WS_QTG) + (size_t)bc * 64 * 256 + h * 64;
    const bf16* ktg = WSP(bf16, WS_KTG) + (size_t)bc * 64 * 256 + h * 64;
    const bf16* vtg = WSP(bf16, WS_VTG) + (size_t)(bc * 4 + h) * 128 * 64;
    const bf16* sc = WSP(bf16, WS_SC) + (size_t)(bc * 4 + h) * 128 * 64;
    const bf16* proj = WSP(bf16, WS_PROJ) + (size_t)bc * 64 * DINP;
    bf16* og = WSP(bf16, WS_OGLA) + (size_t)bc * 64 * 512 + h * 128;
    const float* ggo = F.in[I_GGO];
#pragma unroll 1
    for (int tt = 0; tt < 4; ++tt) {
        bf16x8 qf[2];
#pragma unroll
        for (int ks = 0; ks < 2; ++ks) qf[ks] = ldfrag(qtg + (size_t)(16 * tt + r) * 256 + 32 * ks + 8 * q);
        f32x4 sT[4];
#pragma unroll
        for (int st = 0; st < 4; ++st) { sT[st] = (f32x4){0.f, 0.f, 0.f, 0.f};
            if (st <= tt) {
#pragma unroll
                for (int ks = 0; ks < 2; ++ks) sT[st] = MFMA16(ldfrag(ktg + (size_t)(16 * st + r) * 256 + 32 * ks + 8 * q), qf[ks], sT[st]);
                if (st == tt) {
#pragma unroll
                    for (int i = 0; i < 4; ++i) if (4 * q + i > r) sT[st][i] = 0.f; } } }
        const bf16x8 p01 = frag_pk(sT[0], sT[1]), p23 = frag_pk(sT[2], sT[3]);
        f32x4 acc[8]; float ss = 0.f;
#pragma unroll
        for (int et = 0; et < 8; ++et) { acc[et] = (f32x4){0.f, 0.f, 0.f, 0.f};
            const bf16* srow = sc + (size_t)(16 * et + r) * 64 + 8 * q;
            acc[et] = MFMA16(ldfrag(srow), qf[0], acc[et]); acc[et] = MFMA16(ldfrag(srow + 32), qf[1], acc[et]);
            const bf16* vrow = vtg + (size_t)(16 * et + r) * 64 + 4 * q;
            acc[et] = MFMA16(ldfrag2(vrow, vrow + 16), p01, acc[et]);
            if (tt >= 2) acc[et] = MFMA16(ldfrag2(vrow + 32, vrow + 48), p23, acc[et]);
            ss += (acc[et][0] * acc[et][0] + acc[et][1] * acc[et][1]) + (acc[et][2] * acc[et][2] + acc[et][3] * acc[et][3]); }
        ss += __shfl_xor(ss, 16); ss += __shfl_xor(ss, 32);
        const float rs = rsqrtf(ss * (1.f / 128.f) + EPS);
        const bf16* pr = proj + (size_t)(16 * tt + r) * DINP + C_GR + h * 128 + 4 * q;
        bf16* orow = og + (size_t)(16 * tt + r) * 512 + 4 * q;
#pragma unroll
        for (int et = 0; et < 8; ++et) { const u32x2 rw = *(const u32x2*)(pr + 16 * et); const f32x4 gg = *(const f32x4*)(ggo + 16 * et + 4 * q);
            const float r0 = bflo(rw.x), r1 = bfhi(rw.x), r2 = bflo(rw.y), r3 = bfhi(rw.y);
            u32x2 w; w.x = pk2(acc[et][0] * rs * gg[0] * r0 * sigmoidf_(r0), acc[et][1] * rs * gg[1] * r1 * sigmoidf_(r1));
            w.y = pk2(acc[et][2] * rs * gg[2] * r2 * sigmoidf_(r2), acc[et][3] * rs * gg[3] * r3 * sigmoidf_(r3));
            *(u32x2*)(orow + 16 * et) = w; }
    }
}

__device__ __forceinline__ void p3_xatt(Frame& F, int task, float mb) {
    const int lane = LANE_, r = lane & 15, q = lane >> 4;
    const int h = task & 3, tile = task >> 2, tok0 = 16 * tile, b = tok0 >> 13;
    const bf16* xq = WSP(bf16, WS_XQ) + (size_t)(tok0 + r) * 512 + h * 128 + 8 * q;
    const bf16* km = WSP(bf16, WS_KMEM) + (size_t)(b * 4 + h) * 256 * 128;
    const bf16* vm = WSP(bf16, WS_VMEMT) + (size_t)(b * 4 + h) * 128 * 256;
    bf16x8 qf[4];
#pragma unroll
    for (int ks = 0; ks < 4; ++ks) qf[ks] = ldfrag(xq + 32 * ks);
    f32x4 o[8]; float l = 0.f;
#pragma unroll
    for (int dt = 0; dt < 8; ++dt) o[dt] = (f32x4){0.f, 0.f, 0.f, 0.f};
#pragma unroll 1
    for (int kk = 0; kk < 8; ++kk) {
        f32x4 p[2];
#pragma unroll
        for (int a = 0; a < 2; ++a) { p[a] = (f32x4){0.f, 0.f, 0.f, 0.f}; const bf16* kr = km + (size_t)(32 * kk + 16 * a + r) * 128 + 8 * q;
#pragma unroll
            for (int ks = 0; ks < 4; ++ks) p[a] = MFMA16(ldfrag(kr + 32 * ks), qf[ks], p[a]);
#pragma unroll
            for (int i = 0; i < 4; ++i) { p[a][i] = __builtin_amdgcn_exp2f(p[a][i] - mb); l += p[a][i]; } }
        const bf16x8 pf = frag_pk(p[0], p[1]);
#pragma unroll
        for (int dt = 0; dt < 8; ++dt) { const bf16* vr = vm + (size_t)(16 * dt + r) * 256 + 32 * kk + 4 * q; o[dt] = MFMA16(ldfrag2(vr, vr + 16), pf, o[dt]); }
    }
    l += __shfl_xor(l, 16); l += __shfl_xor(l, 32);
    const float inv = 1.f / l;
    bf16* ox = WSP(bf16, WS_OX) + (size_t)(tok0 + r) * 512 + h * 128 + 4 * q;
#pragma unroll
    for (int dt = 0; dt < 8; ++dt) { u32x2 w; w.x = pk2(o[dt][0] * inv, o[dt][1] * inv); w.y = pk2(o[dt][2] * inv, o[dt][3] * inv); *(u32x2*)(ox + 16 * dt) = w; }
}
__device__ __forceinline__ void p3_xatt_sample(Frame& F, int task) {
    const int lane = LANE_, b = task >> 2, h = task & 3, tok = NTOKP + b;
    LAS float* sh = (LAS float*)(F.lds + F.wave * 16384);
    const bf16* xq = WSP(bf16, WS_XQ) + (size_t)tok * 512 + h * 128;
    sh[lane] = bf2f(xq[lane]); sh[64 + lane] = bf2f(xq[64 + lane]);
    asm volatile("s_waitcnt lgkmcnt(0)" ::: "memory");
    const float* cm = F.in[I_CMEM] + (size_t)b * 256 * 1024 + h * 128;
    float s[4] = {0.f, 0.f, 0.f, 0.f};
    for (int d = 0; d < 128; d += 4) { const f32x4 qv = *(const LAS f32x4*)(sh + d);
#pragma unroll
        for (int k = 0; k < 4; ++k) { const f32x4 kv = *(const f32x4*)(cm + (size_t)(lane + 64 * k) * 1024 + d); s[k] += (qv[0] * kv[0] + qv[1] * kv[1]) + (qv[2] * kv[2] + qv[3] * kv[3]); } }
    const float m = wave_max(fmaxf(fmaxf(s[0], s[1]), fmaxf(s[2], s[3])));
    float l = 0.f;
#pragma unroll
    for (int k = 0; k < 4; ++k) { const float e = __builtin_amdgcn_exp2f(s[k] - m); sh[128 + lane + 64 * k] = e; l += e; }
    l = wave_sum(l);
    asm volatile("s_waitcnt lgkmcnt(0)" ::: "memory");
    float o0 = 0.f, o1 = 0.f; const float* vv = cm + 512;
#pragma unroll 4
    for (int mm = 0; mm < 256; ++mm) { const float p = sh[128 + mm]; o0 += p * vv[(size_t)mm * 1024 + lane]; o1 += p * vv[(size_t)mm * 1024 + 64 + lane]; }
    const float inv = 1.f / l;
    bf16* ox = WSP(bf16, WS_OX) + (size_t)tok * 512 + h * 128;
    ox[lane] = (bf16)f2bf(o0 * inv); ox[64 + lane] = (bf16)f2bf(o1 * inv);
}

constexpr int NL_Q = 0;
constexpr int NL_U = 16384;
constexpr int NL_OS = 81920;
constexpr int NL_TB = 16384;
constexpr int NL_SEL = 147456;
constexpr int NL_BKT = 147968;
constexpr int NL_BIAS = 148496;
constexpr int NL_LINV = 149520;
constexpr int NL_END = 150032;
static_assert(NL_END <= LDS_BYTES, "NSA LDS map");

__device__ __forceinline__ void nsa_tables(Frame& F) {
    LAS int* bkt = (LAS int*)(F.lds + NL_BKT); LAS float* bl = (LAS float*)(F.lds + NL_BIAS);
    if (TID_ < 129) bkt[TID_] = t5_bucket(TID_);
    if (TID_ < 256) bl[TID_] = F.in[I_RB][TID_] * LOG2E;
    __syncthreads();
}
__device__ __forceinline__ float nsa_bound(Frame& F) {
    const float gq = absmax_arr(F.in[I_GNQ], 64, LANE_), gk = absmax_arr(F.in[I_GNK], 192, LANE_), bm = absmax_arr(F.in[I_RB], 256, LANE_);
    return (8.0f * gq * gk * 1.02f + bm) * LOG2E;
}
__device__ __forceinline__ unsigned fkey(float x) { const unsigned u = __float_as_uint(x); return (u & 0x80000000u) ? ~u : (u | 0x80000000u); }

__device__ __forceinline__ int tile_off16(int row, int c16) { return row * 128 + ((c16 ^ (row & 7)) << 4); }
struct TileAddr { int kb[2]; int vb[2][2]; };
__device__ __forceinline__ TileAddr tile_addr(int r, int q) { TileAddr a;
    for (int ks = 0; ks < 2; ++ks) a.kb[ks] = r * 128 + (((4 * ks + q) ^ (r & 7)) << 4);
    for (int s = 0; s < 2; ++s) for (int pc = 0; pc < 2; ++pc) a.vb[s][pc] = r * 128 + (((4 * s + 2 * pc + (q >> 1)) ^ (r & 7)) << 4) + 8 * (q & 1);
    return a; }
__device__ __forceinline__ bf16x8 tile_kfrag(LAS const unsigned char* kb, const TileAddr& ta, int kt, int ks) { return as_frag(*(LAS const u32x4*)(kb + ta.kb[ks] + kt * 2048)); }
__device__ __forceinline__ bf16x8 tile_vfrag(LAS const unsigned char* vb, const TileAddr& ta, int dt, int s) {
    const u32x2 a = *(LAS const u32x2*)(vb + ta.vb[s][0] + dt * 2048), b = *(LAS const u32x2*)(vb + ta.vb[s][1] + dt * 2048);
    u32x4 w; w.x = a.x; w.y = a.y; w.z = b.x; w.w = b.y; return as_frag(w); }

#define OPAQUE_V(x) asm volatile("" : "+v"(x))
__device__ __forceinline__ void p3_nsa_prompt(Frame& F, int n, float mb, int dbg) {
    int lane0 = LANE_; OPAQUE_V(lane0);
    const int lane = lane0, r = lane & 15, q = lane >> 4, w = F.wave;
    const int combo = n >> 8, idx = n & 255, ti = (combo & 1) ? 255 - idx : idx;
    const int b = combo >> 1, kv = combo & 1, t0 = 32 * ti, bk = b * 2 + kv;
    LAS bf16* Qs = (LAS bf16*)(F.lds + NL_Q); LAS float* U = (LAS float*)(F.lds + NL_U) + w * 2048; LAS unsigned* selm = (LAS unsigned*)(F.lds + NL_SEL);
    LAS const int* bkt = (LAS const int*)(F.lds + NL_BKT); LAS const float* bl = (LAS const float*)(F.lds + NL_BIAS); LAS float* linv = (LAS float*)(F.lds + NL_LINV) + w * 16;
    LAS unsigned char* stA = F.lds + NL_OS;
    LAS unsigned char* stC = F.lds + NL_U;
    LAS unsigned char* stB = F.lds + NL_TB + w * 16384;
    const int tid_ = w * 64 + lane, srow = tid_ >> 3, sc16 = tid_ & 7, soff = tile_off16(srow, sc16);
    const TileAddr ta = tile_addr(r, q);
    __syncthreads();
    { const int tk = TID_ >> 4, ch = TID_ & 15; const bf16* src = WSP(bf16, WS_QN) + (size_t)(b * T + t0 + tk) * 512 + kv * 256 + ch * 16;
      const u32x4 a0 = *(const u32x4*)src, a1 = *(const u32x4*)(src + 8);
      *(LAS u32x4*)(Qs + tk * 256 + ch * 16) = a0; *(LAS u32x4*)(Qs + tk * 256 + ch * 16 + 8) = a1;
      if (TID_ < 128) selm[TID_] = 0u; }
    __syncthreads();
    const int tw = t0 + 4 * w, tr = tw + (r >> 2), h = kv * 4 + (r & 3);
    bf16x8 qf[2];
#pragma unroll
    for (int ks = 0; ks < 2; ++ks) qf[ks] = as_frag(*(LAS const u32x4*)(Qs + (16 * w + r) * 64 + 32 * ks + 8 * q));
    int ncvb = (t0 + 31 - 31) / 16 + 1; ncvb = ncvb < 511 ? ncvb : 511;
    const int nst = (ncvb + 63) >> 6;
    const int tlast = tw + 3; int ncv = tlast >= 31 ? (tlast - 31) / 16 + 1 : 0; ncv = ncv < 511 ? ncv : 511;
    const int nstw = (ncv + 63) >> 6;
    f32x4 oc[4]; float lc = 0.f, carry = 0.f;
#pragma unroll
    for (int dt = 0; dt < 4; ++dt) oc[dt] = (f32x4){0.f, 0.f, 0.f, 0.f};
    {
        const bf16* kc = WSP(bf16, WS_KCMP) + (size_t)bk * 512 * 64 + srow * 64 + sc16 * 8; const bf16* vc = WSP(bf16, WS_VCMPT) + (size_t)bk * 64 * 512 + srow * 512 + sc16 * 8;
        u32x4 rk = *(const u32x4*)kc, rv = *(const u32x4*)vc;
#pragma unroll 1
        for (int st = 0; st < nst; ++st) {
            LAS unsigned char* kb = stA + (st & 1) * 16384; LAS unsigned char* vb = kb + 8192;
            *(LAS u32x4*)(kb + soff) = rk; *(LAS u32x4*)(vb + soff) = rv;
            __syncthreads();
            if (st + 1 < nst) { rk = *(const u32x4*)(kc + (size_t)(st + 1) * 4096); rv = *(const u32x4*)(vc + (st + 1) * 64); }
            if (st < nstw && !(dbg & 1)) {
                f32x4 p[4];
#pragma unroll
                for (int kt = 0; kt < 4; ++kt) { const int tile = 4 * st + kt; p[kt] = (f32x4){0.f, 0.f, 0.f, 0.f};
                    p[kt] = MFMA16(tile_kfrag(kb, ta, kt, 0), qf[0], p[kt]); p[kt] = MFMA16(tile_kfrag(kb, ta, kt, 1), qf[1], p[kt]);
                    float G = 0.f;
#pragma unroll
                    for (int i = 0; i < 4; ++i) { const int c = 16 * tile + 4 * q + i, rel = tr - (16 * c + 31); const bool ok = rel >= 0 && c < 511;
                        const int rc = rel < 0 ? 0 : (rel > 128 ? 128 : rel);
                        const float e = ok ? __builtin_amdgcn_exp2f(p[kt][i] + bl[bkt[rc] * 8 + h] - mb) : 0.f; p[kt][i] = e; G += e; }
                    const float send = (q == 3) ? carry : p[kt][3]; const float prev = __shfl(send, (lane + 48) & 63); carry = p[kt][3];
                    U[r * 128 + 4 * tile + q] = G + prev; lc += G; }
                const bf16x8 pf0 = frag_pk(p[0], p[1]), pf1 = frag_pk(p[2], p[3]);
#pragma unroll
                for (int dt = 0; dt < 4; ++dt) { oc[dt] = MFMA16(tile_vfrag(vb, ta, dt, 0), pf0, oc[dt]); oc[dt] = MFMA16(tile_vfrag(vb, ta, dt, 1), pf1, oc[dt]); }
            }
        }
    }
    lc += __shfl_xor(lc, 16); lc += __shfl_xor(lc, 32);
    const float lcinv = lc > 0.f ? 1.f / lc : 0.f;
    if (q == 0) linv[r] = lcinv;
    asm volatile("s_waitcnt lgkmcnt(0)" ::: "memory");
    if (!(dbg & 8)) {
        const int tk = lane >> 4, jr = lane & 15, t = tw + tk, tblk = t >> 6, jlim = 16 * nstw;
        const float li0 = linv[4 * tk], li1 = linv[4 * tk + 1], li2 = linv[4 * tk + 2], li3 = linv[4 * tk + 3];
        unsigned key[8];
#pragma unroll
        for (int m = 0; m < 8; ++m) { const int j = jr + 16 * m; float v = 0.f;
            if (j < jlim) v = U[(4 * tk) * 128 + j] * li0 + U[(4 * tk + 1) * 128 + j] * li1 + U[(4 * tk + 2) * 128 + j] * li2 + U[(4 * tk + 3) * 128 + j] * li3;
            const bool forced = (j == 0) || (j == tblk) || (j == tblk - 1);
            const float sc = (j <= tblk) ? v + (forced ? 1e4f : 0.f) : -1e30f;
            key[m] = fkey(sc); }
        unsigned pre = 0u;
#pragma unroll 1
        for (int bit = 31; bit >= 0; --bit) { const unsigned cand = pre | (1u << bit); int cnt = 0;
#pragma unroll
            for (int m = 0; m < 8; ++m) cnt += key[m] >= cand ? 1 : 0;
            cnt += __shfl_xor(cnt, 1); cnt += __shfl_xor(cnt, 2); cnt += __shfl_xor(cnt, 4); cnt += __shfl_xor(cnt, 8);
            if (cnt >= 16) pre = cand; }
        int ngt = 0;
#pragma unroll
        for (int m = 0; m < 8; ++m) ngt += key[m] > pre ? 1 : 0;
        ngt += __shfl_xor(ngt, 1); ngt += __shfl_xor(ngt, 2); ngt += __shfl_xor(ngt, 4); ngt += __shfl_xor(ngt, 8);
        const int need = 16 - ngt; int run = 0; const unsigned kinv = fkey(-1e30f);
#pragma unroll
        for (int m = 0; m < 8; ++m) { const bool tie = key[m] == pre; const unsigned long long bal = __ballot(tie);
            const unsigned grp = (unsigned)(bal >> (16 * tk)) & 0xffffu; const int rank = __popc(grp & ((1u << jr) - 1u));
            const bool sel = (key[m] > pre || (tie && run + rank < need)) && key[m] > kinv;
            run += __popc(grp);
            if (sel) atomicOr((unsigned*)(selm + jr + 16 * m), 1u << (4 * w + tk)); }
    }
    __syncthreads();
    f32x4 ow[4]; float lw = 0.f;
#pragma unroll
    for (int dt = 0; dt < 4; ++dt) ow[dt] = (f32x4){0.f, 0.f, 0.f, 0.f};
    {
        int lc_ = lane0; OPAQUE_V(lc_); const int lane = lc_, r = lane & 15, q = lane >> 4, tr = tw + (r >> 2), h = kv * 4 + (r & 3); const TileAddr ta = tile_addr(r, q);
        const int tid_ = w * 64 + lane, srow = tid_ >> 3, sc16 = tid_ & 7, soff = tile_off16(srow, sc16);
        const int jlob = (t0 - 511 > 0 ? t0 - 511 : 0) >> 6, jhib = (t0 + 31) >> 6, nstc = jhib - jlob + 1;
        const int jlo = (tw - 511 > 0 ? tw - 511 : 0) >> 6, jhi = (tw + 3) >> 6;
        const bf16* kwin = WSP(bf16, WS_KWIN) + (size_t)bk * T * 64 + srow * 64 + sc16 * 8; const bf16* vwin = WSP(bf16, WS_VWINT) + (size_t)bk * 128 * 4096 + srow * 64 + sc16 * 8;
        u32x4 rk = *(const u32x4*)(kwin + (size_t)jlob * 4096), rv = *(const u32x4*)(vwin + (size_t)jlob * 4096);
#pragma unroll 1
        for (int st = 0; st < nstc; ++st) { const int j = jlob + st;
            LAS unsigned char* kb = stC + (st & 1) * 16384; LAS unsigned char* vb = kb + 8192;
            *(LAS u32x4*)(kb + soff) = rk; *(LAS u32x4*)(vb + soff) = rv;
            __syncthreads();
            if (st + 1 < nstc) { rk = *(const u32x4*)(kwin + (size_t)(j + 1) * 4096); rv = *(const u32x4*)(vwin + (size_t)(j + 1) * 4096); }
            if (j >= jlo && j <= jhi && !(dbg & 2)) {
                f32x4 p[4];
#pragma unroll
                for (int kt = 0; kt < 4; ++kt) { p[kt] = (f32x4){0.f, 0.f, 0.f, 0.f};
                    p[kt] = MFMA16(tile_kfrag(kb, ta, kt, 0), qf[0], p[kt]); p[kt] = MFMA16(tile_kfrag(kb, ta, kt, 1), qf[1], p[kt]);
#pragma unroll
                    for (int i = 0; i < 4; ++i) { const int rel = tr - (64 * j + 16 * kt + 4 * q + i); const bool ok = rel >= 0 && rel < 512;
                        const int rc = rel < 0 ? 0 : (rel > 128 ? 128 : rel);
                        const float e = ok ? __builtin_amdgcn_exp2f(p[kt][i] + bl[bkt[rc] * 8 + h] - mb) : 0.f; p[kt][i] = e; lw += e; } }
                const bf16x8 pf0 = frag_pk(p[0], p[1]), pf1 = frag_pk(p[2], p[3]);
#pragma unroll
                for (int dt = 0; dt < 4; ++dt) { ow[dt] = MFMA16(tile_vfrag(vb, ta, dt, 0), pf0, ow[dt]); ow[dt] = MFMA16(tile_vfrag(vb, ta, dt, 1), pf1, ow[dt]); }
            }
        }
        lw += __shfl_xor(lw, 16); lw += __shfl_xor(lw, 32);
    }
    f32x4 ocw[4];
    { const float* gt = WSP(float, WS_GATES) + (size_t)(b * T + tr) * 24 + h * 3;
      const float g0 = gt[0] * lcinv, g2 = gt[2] * (lw > 0.f ? 1.f / lw : 0.f);
#pragma unroll
      for (int dt = 0; dt < 4; ++dt) ocw[dt] = oc[dt] * g0 + ow[dt] * g2; }
    __syncthreads();
    f32x4 osf[4]; float lsf = 0.f;
    {
        int lb_ = lane0; OPAQUE_V(lb_); const int lane = lb_, r = lane & 15, q = lane >> 4, h = kv * 4 + (r & 3); const TileAddr ta = tile_addr(r, q);
        const int half = w >> 2, jw = w & 3;
        f32x4 osa[4][4]; float lsa[4];
#pragma unroll
        for (int x = 0; x < 4; ++x) { lsa[x] = 0.f;
#pragma unroll
            for (int dt = 0; dt < 4; ++dt) osa[x][dt] = (f32x4){0.f, 0.f, 0.f, 0.f}; }
        const int jmax = (t0 + 31) >> 6;
        const int brow = lane >> 3, bc16 = lane & 7, boff = brow * 64 + bc16 * 8, bsoff = tile_off16(brow, bc16); const float bfar = bl[31 * 8 + h];
        const bf16* ksel = WSP(bf16, WS_KSEL) + (size_t)bk * T * 64 + boff; const bf16* vsel = WSP(bf16, WS_VSELT) + (size_t)bk * 128 * 4096 + boff;
        LAS const bf16* Qh = Qs + (64 * half + r) * 64 + 8 * q;
        u32x4 gk[8];
        if (jw <= jmax) {
#pragma unroll
            for (int i = 0; i < 8; ++i) gk[i] = *(const u32x4*)(ksel + (size_t)jw * 4096 + i * 512); }
#pragma unroll 1
        for (int j = jw; j <= jmax; j += 4) {
            const unsigned msel = ((unsigned)__builtin_amdgcn_readfirstlane((int)selm[j]) >> (16 * half)) & 0xffffu;
            const bool act = msel != 0u && !(dbg & 4);
            u32x4 gv[8];
            if (act) {
#pragma unroll
                for (int i = 0; i < 8; ++i) gv[i] = *(const u32x4*)(vsel + (size_t)j * 4096 + i * 512); }
            asm volatile("s_waitcnt lgkmcnt(0)" ::: "memory");
#pragma unroll
            for (int i = 0; i < 8; ++i) *(LAS u32x4*)(stB + bsoff + i * 1024) = gk[i];
            if (j + 4 <= jmax) {
#pragma unroll
                for (int i = 0; i < 8; ++i) gk[i] = *(const u32x4*)(ksel + (size_t)(j + 4) * 4096 + i * 512); }
            if (!act) continue;
#pragma unroll
            for (int i = 0; i < 8; ++i) *(LAS u32x4*)(stB + 8192 + bsoff + i * 1024) = gv[i];
            asm volatile("s_waitcnt lgkmcnt(0)" ::: "memory");
            const bool far = (t0 - (64 * j + 63)) >= 128;
#pragma unroll
            for (int x = 0; x < 4; ++x) {
                const unsigned nib = (msel >> (4 * x)) & 15u;
                if (nib) {
                    const bool tokv = (nib >> (r >> 2)) & 1u; const int t = t0 + 16 * half + 4 * x + (r >> 2);
                    const bf16x8 qs0 = as_frag(*(LAS const u32x4*)(Qh + x * 1024)), qs1 = as_frag(*(LAS const u32x4*)(Qh + x * 1024 + 32));
                    f32x4 p[4]; float ls = 0.f;
#pragma unroll
                    for (int kt = 0; kt < 4; ++kt) { p[kt] = (f32x4){0.f, 0.f, 0.f, 0.f};
                        p[kt] = MFMA16(tile_kfrag(stB, ta, kt, 0), qs0, p[kt]); p[kt] = MFMA16(tile_kfrag(stB, ta, kt, 1), qs1, p[kt]);
#pragma unroll
                        for (int i = 0; i < 4; ++i) { const int rel = t - (64 * j + 16 * kt + 4 * q + i); const bool ok = tokv && rel >= 0;
                            const int rc = rel < 0 ? 0 : (rel > 128 ? 128 : rel);
                            const float bias = far ? bfar : bl[bkt[rc] * 8 + h];
                            const float e = ok ? __builtin_amdgcn_exp2f(p[kt][i] + bias - mb) : 0.f; p[kt][i] = e; ls += e; } }
                    lsa[x] += ls;
                    const bf16x8 pf0 = frag_pk(p[0], p[1]), pf1 = frag_pk(p[2], p[3]);
#pragma unroll
                    for (int dt = 0; dt < 4; ++dt) { osa[x][dt] = MFMA16(tile_vfrag(stB + 8192, ta, dt, 0), pf0, osa[x][dt]); osa[x][dt] = MFMA16(tile_vfrag(stB + 8192, ta, dt, 1), pf1, osa[x][dt]); }
                }
            }
        }
#pragma unroll
        for (int dt = 0; dt < 4; ++dt) osf[dt] = (f32x4){0.f, 0.f, 0.f, 0.f};
#pragma unroll
        for (int x = 0; x <= 4; ++x) {
            __syncthreads();
            if (x > 0 && jw == x - 1) {
#pragma unroll
                for (int w2 = 0; w2 < 4; ++w2) { LAS const float* rp = (LAS const float*)(F.lds + NL_U + ((x - 1) & 1) * 32768) + (4 * half + w2) * 1024 + lane * 16;
#pragma unroll
                    for (int dt = 0; dt < 4; ++dt) osf[dt] += *(LAS const f32x4*)(rp + 4 * dt);
                    lsf += ((LAS const float*)(F.lds + NL_Q + ((x - 1) & 1) * 2048))[(4 * half + w2) * 64 + lane]; } }
            if (x < 4) { LAS float* Rb = (LAS float*)(F.lds + NL_U + (x & 1) * 32768); LAS float* RLb = (LAS float*)(F.lds + NL_Q + (x & 1) * 2048);
#pragma unroll
                for (int dt = 0; dt < 4; ++dt) *(LAS f32x4*)(Rb + w * 1024 + lane * 16 + 4 * dt) = osa[x][dt];
                RLb[w * 64 + lane] = lsa[x]; }
        }
        lsf += __shfl_xor(lsf, 16); lsf += __shfl_xor(lsf, 32);
    }
    {
        int lf_ = lane0; OPAQUE_V(lf_); const int r = lf_ & 15, q = lf_ >> 4, tr = tw + (r >> 2), h = kv * 4 + (r & 3);
        const int tok = b * T + tr; const float g1 = WSP(float, WS_GATES)[(size_t)tok * 24 + h * 3 + 1] * (lsf > 0.f ? 1.f / lsf : 0.f);
        bf16* on = WSP(bf16, WS_ONSA) + (size_t)tok * 512 + h * 64 + 4 * q;
#pragma unroll
        for (int dt = 0; dt < 4; ++dt) { const f32x4 o = ocw[dt] + osf[dt] * g1;
            u32x2 wv; wv.x = pk2(o[0], o[1]); wv.y = pk2(o[2], o[3]); *(u32x2*)(on + 16 * dt) = wv; }
    }
}

constexpr int SL_Q = 0;
constexpr int SL_S = 1024;
constexpr int SL_O = 17408;
constexpr int SL_PART = 20480;
constexpr int SL_IMP = 28672;
constexpr int SL_IDX = 29200;
constexpr int SL_END = 29328;
static_assert(SL_END <= NL_BKT, "sample NSA LDS map must not overlap the tables");
template <class KP, class VP, class RELF>
__device__ __forceinline__ void sample_segment(Frame& F, int nk, int kv, KP kptr, VP vptr, RELF relf, LAS float* odst) {
    LAS const float* qs = (LAS const float*)(F.lds + SL_Q); LAS float* sc = (LAS float*)(F.lds + SL_S); LAS float* part = (LAS float*)(F.lds + SL_PART);
    LAS const int* bkt = (LAS const int*)(F.lds + NL_BKT); LAS const float* bl = (LAS const float*)(F.lds + NL_BIAS);
    const int nkp = (nk + 63) & ~63;
    for (int n = TID_; n < nkp; n += NTHR) {
        float s0 = -INFINITY, s1 = -INFINITY, s2 = -INFINITY, s3 = -INFINITY;
        const float* kr = n < nk ? kptr(n) : nullptr;
        if (kr) { s0 = s1 = s2 = s3 = 0.f;
            for (int d = 0; d < 64; d += 4) { const f32x4 k4 = *(const f32x4*)(kr + d);
                const f32x4 q0 = *(LAS const f32x4*)(qs + d), q1 = *(LAS const f32x4*)(qs + 64 + d), q2 = *(LAS const f32x4*)(qs + 128 + d), q3 = *(LAS const f32x4*)(qs + 192 + d);
                s0 += (q0[0] * k4[0] + q0[1] * k4[1]) + (q0[2] * k4[2] + q0[3] * k4[3]); s1 += (q1[0] * k4[0] + q1[1] * k4[1]) + (q1[2] * k4[2] + q1[3] * k4[3]);
                s2 += (q2[0] * k4[0] + q2[1] * k4[1]) + (q2[2] * k4[2] + q2[3] * k4[3]); s3 += (q3[0] * k4[0] + q3[1] * k4[1]) + (q3[2] * k4[2] + q3[3] * k4[3]); }
            int rel = relf(n); rel = rel > 128 ? 128 : rel; const int bb = bkt[rel] * 8 + kv * 4;
            s0 += bl[bb]; s1 += bl[bb + 1]; s2 += bl[bb + 2]; s3 += bl[bb + 3]; }
        sc[n] = s0; sc[1024 + n] = s1; sc[2048 + n] = s2; sc[3072 + n] = s3;
    }
    __syncthreads();
    if (F.wave < 4) { LAS float* row = sc + F.wave * 1024; float m = -INFINITY;
        for (int n = LANE_; n < nkp; n += 64) m = fmaxf(m, row[n]);
        m = wave_max(m); float l = 0.f;
        for (int n = LANE_; n < nkp; n += 64) { const float e = __builtin_amdgcn_exp2f(row[n] - m); row[n] = e; l += e; }
        l = wave_sum(l); const float inv = 1.f / l;
        for (int n = LANE_; n < nkp; n += 64) row[n] *= inv; }
    __syncthreads();
    {
        const int d = LANE_; float o0 = 0.f, o1 = 0.f, o2 = 0.f, o3 = 0.f;
        for (int n0 = F.wave; n0 < nkp; n0 += 32) {
            float v[4];
#pragma unroll
            for (int u = 0; u < 4; ++u) { const int n = n0 + 8 * u; v[u] = n < nk ? vptr(n)[d] : 0.f; }
#pragma unroll
            for (int u = 0; u < 4; ++u) { const int n = n0 + 8 * u; if (n < nkp) { o0 += sc[n] * v[u]; o1 += sc[1024 + n] * v[u]; o2 += sc[2048 + n] * v[u]; o3 += sc[3072 + n] * v[u]; } }
        }
        part[(F.wave * 4 + 0) * 64 + d] = o0; part[(F.wave * 4 + 1) * 64 + d] = o1; part[(F.wave * 4 + 2) * 64 + d] = o2; part[(F.wave * 4 + 3) * 64 + d] = o3; }
    __syncthreads();
    if (TID_ < 256) { float a = 0.f;
#pragma unroll
        for (int w8 = 0; w8 < 8; ++w8) a += part[w8 * 256 + TID_];
        odst[TID_] = a; }
    __syncthreads();
}
__device__ __forceinline__ void p3_nsa_sample(Frame& F, int task) {
    const int b = task >> 1, kv = task & 1, tok = NTOKP + b, bk = b * 2 + kv;
    LAS float* qs = (LAS float*)(F.lds + SL_Q); LAS float* sc = (LAS float*)(F.lds + SL_S); LAS float* ob = (LAS float*)(F.lds + SL_O);
    LAS float* imp = (LAS float*)(F.lds + SL_IMP); LAS int* sidx = (LAS int*)(F.lds + SL_IDX);
    __syncthreads();
    if (TID_ < 256) qs[TID_] = bf2f(WSP(bf16, WS_QN)[(size_t)tok * 512 + kv * 256 + TID_]);
    __syncthreads();
    const float* kcs = WSP(float, WS_KCMPS) + (size_t)bk * 512 * 64; const float* vcs = WSP(float, WS_VCMPS) + (size_t)bk * 512 * 64;
    const float* nkv = WSP(float, WS_NEWKV) + (size_t)b * 4 * 2 * 64 + kv * 64;
    const float* ckv = F.in[I_CKV]; const int* pt = (const int*)F.in[I_PT] + b * 64; const float* cwin = F.in[I_CWIN] + (size_t)b * 512 * 256;
    sample_segment(F, 511, kv, [&](int n) { return kcs + (size_t)n * 64; }, [&](int n) { return vcs + (size_t)n * 64; }, [&](int n) { return T - (16 * n + 31); }, ob);
    if (TID_ < 129) { const int j = TID_; float v = 0.f;
        for (int c = 4 * j - 1; c <= 4 * j + 3; ++c) if (c >= 0 && c < 511) v += (sc[c] + sc[1024 + c]) + (sc[2048 + c] + sc[3072 + c]);
        imp[j] = v; }
    __syncthreads();
    if (F.wave == 0) { const int lane = LANE_; unsigned key[3];
#pragma unroll
        for (int m = 0; m < 3; ++m) { const int j = lane + 64 * m; float s = -1e30f;
            if (j < 129) { const bool forced = (j == 0) || (j == 128) || (j == 127); s = imp[j] + (forced ? 1e4f : 0.f); }
            key[m] = (j < 129) ? fkey(s) : 0u; }
        unsigned pre = 0u;
#pragma unroll 1
        for (int bit = 31; bit >= 0; --bit) { const unsigned cand = pre | (1u << bit); int cnt = 0;
#pragma unroll
            for (int m = 0; m < 3; ++m) cnt += __popcll(__ballot(key[m] >= cand));
            if (cnt >= 16) pre = cand; }
        int ngt = 0;
#pragma unroll
        for (int m = 0; m < 3; ++m) ngt += __popcll(__ballot(key[m] > pre));
        int need = 16 - ngt, cnt = 0;
#pragma unroll
        for (int m = 0; m < 3; ++m) { const bool gt = key[m] > pre, tie = key[m] == pre; const unsigned long long tb = __ballot(tie);
            const int trank = __popcll(tb & ((1ull << lane) - 1ull)); const bool sel = gt || (tie && trank < need);
            need -= __popcll(tb); need = need < 0 ? 0 : need;
            const unsigned long long sb = __ballot(sel); const int pos = cnt + __popcll(sb & ((1ull << lane) - 1ull));
            if (sel && pos < 16) sidx[pos] = lane + 64 * m; cnt += __popcll(sb); } }
    __syncthreads();
    sample_segment(F, 1024, kv,
        [&](int n) -> const float* { const int pos = 64 * sidx[n >> 6] + (n & 63); if (pos > T) return nullptr; if (pos == T) return nkv;
                                     return ckv + (((size_t)pt[pos >> 7] * 128 + (pos & 127)) * 4 + 2) * 128 + kv * 64; },
        [&](int n) -> const float* { const int pos = 64 * sidx[n >> 6] + (n & 63); if (pos >= T) return nkv + 128;
                                     return ckv + (((size_t)pt[pos >> 7] * 128 + (pos & 127)) * 4 + 3) * 128 + kv * 64; },
        [&](int n) { return T - (64 * sidx[n >> 6] + (n & 63)); }, ob + 256);
    sample_segment(F, 512, kv,
        [&](int n) -> const float* { return n < 511 ? cwin + (size_t)(n + 1) * 256 + kv * 64 : nkv + 256; },
        [&](int n) -> const float* { return n < 511 ? cwin + (size_t)(n + 1) * 256 + 128 + kv * 64 : nkv + 384; },
        [&](int n) { return 511 - n; }, ob + 512);
    if (TID_ < 256) { const int g = TID_ >> 6, d = TID_ & 63, h = kv * 4 + g; const float* gt = WSP(float, WS_GATES) + (size_t)tok * 24 + h * 3;
        WSP(bf16, WS_ONSA)[(size_t)tok * 512 + h * 64 + d] = (bf16)f2bf(gt[0] * ob[TID_] + gt[1] * ob[256 + TID_] + gt[2] * ob[512 + TID_]); }
}

__device__ __forceinline__ void p6_conv(Frame& F) {
    const bf16* ug = WSP(bf16, WS_UG); bf16* act = WSP(bf16, WS_ACT);
    const float* cw = F.in[I_CONVW]; const float* cb = F.in[I_CONVB]; const float* sconv = F.in[I_SCONV];
    constexpr int NG = DFF / 8;
    for (size_t it = (size_t)F.bid * NTHR + TID_; it < (size_t)MPAD * NG; it += (size_t)F.G * NTHR) {
        const int row = (int)(it / NG), c0 = 8 * (int)(it % NG);
        if (row >= NTOK) { *(u32x4*)(act + (size_t)row * DFF + c0) = (u32x4){0u, 0u, 0u, 0u}; continue; }
        float u[8], g2[8], g1[8], g0[8];
        unpack8(*(const u32x4*)(ug + (size_t)row * DUP + c0), u);
        unpack8(*(const u32x4*)(ug + (size_t)row * DUP + DFF + c0), g2);
        if (row < NTOKP) { const int t = row & (T - 1);
            if (t >= 1) unpack8(*(const u32x4*)(ug + (size_t)(row - 1) * DUP + DFF + c0), g1); else { for (int i = 0; i < 8; ++i) g1[i] = 0.f; }
            if (t >= 2) unpack8(*(const u32x4*)(ug + (size_t)(row - 2) * DUP + DFF + c0), g0); else { for (int i = 0; i < 8; ++i) g0[i] = 0.f; }
            if (t >= T - 2) { float* o = F.out + O_CONVP + ((size_t)(row >> 13) * 2 + (t - (T - 2))) * DFF + c0;
                for (int i = 0; i < 8; ++i) o[i] = g2[i]; }
        } else { const int sb = row - NTOKP;
            for (int i = 0; i < 8; ++i) { g0[i] = sconv[((size_t)sb * 2 + 0) * DFF + c0 + i]; g1[i] = sconv[((size_t)sb * 2 + 1) * DFF + c0 + i]; }
            float* o = F.out + O_CONVS + (size_t)sb * 2 * DFF + c0;
            for (int i = 0; i < 8; ++i) { o[i] = g1[i]; o[DFF + i] = g2[i]; } }
        float a[8];
#pragma unroll
        for (int i = 0; i < 8; ++i) { const float gc = cb[c0 + i] + cw[c0 + i] * g0[i] + cw[DFF + c0 + i] * g1[i] + cw[2 * DFF + c0 + i] * g2[i]; a[i] = gelu_tanh(gc) * u[i]; }
        *(u32x4*)(act + (size_t)row * DFF + c0) = pack8(a);
    }
}

constexpr int N_PHASES = 10;
__global__ void __launch_bounds__(NTHR, 2) mega_fwd(Args args) {
    extern __shared__ __attribute__((aligned(16))) unsigned char lds_raw[];
    cg::grid_group grid = cg::this_grid();
    Frame F;
    F.lds = (LAS unsigned char*)lds_raw;
    F.wave = __builtin_amdgcn_readfirstlane((int)(threadIdx.x >> 6));
    F.G = gridDim.x; F.bid = blockIdx.x; F.gw = F.bid * NWAVES + F.wave; F.NGW = F.G * NWAVES;
    F.in = args.in; F.out = args.out; F.ws = args.ws;
    const int lo = args.ph_lo, hi = args.ph_hi, sub = args.sub;
#define SUB(i) ((sub >> (i)) & 1)
#ifndef PROBE_REP
#define PROBE_REP -1
#endif
#define IN(k) (lo <= (k) && (k) < hi)
#define REP(k) for (int rep_ = 0; rep_ < ((k) == PROBE_REP ? 2 : 1); ++rep_)
#define SEAM(k) do { if (IN(k) && IN((k) + 1)) grid.sync(); { unsigned char* w_ = F.ws; asm volatile("" : "+s"(w_)); F.ws = w_; float* o_ = F.out; asm volatile("" : "+s"(o_)); F.out = o_; } } while (0)
    typedef pg8::StaticOrder SO;

    REP(0) if (IN(0)) { p0_prologue(F); }
    SEAM(0);
    if (IN(1)) {
        { pg8::Gemm g{WSP(bf16, WS_XN), WSP(bf16, WS_WTIN), MPAD, DINP, 1024}; SO S; S.init(MPAD, DINP, F.G, F.bid);
          pg8::EpiStore E{WSP(bf16, WS_PROJ), DINP, nullptr};
          pg8::gemm_phase<pg8::EpiStore, SO, true, true>(F.lds, g, S, E, F.wave); }
        __syncthreads();
        { pg8::Gemm g{WSP(bf16, WS_MN), WSP(bf16, WS_WTMEM), 512, 1024, 1024}; SO S; S.init(512, 1024, F.G, F.G - 1 - F.bid);
          pg8::EpiStore E{WSP(bf16, WS_MEMPROJ), 1024, nullptr};
          pg8::gemm_phase<pg8::EpiStore, SO, true, true>(F.lds, g, S, E, F.wave); }
    }
    SEAM(1);
    REP(2) if (IN(2)) {
        if (SUB(0)) { for (int tok = F.gw; tok < NTOK; tok += F.NGW) p2_token(F, tok);
        for (int row = F.gw; row < 512; row += F.NGW) p2_memrow(F, row); }
        if (SUB(1)) for (int t = F.gw; t < CMP_TASKS_S + CMP_TASKS_P; t += F.NGW) p2_compress(F, t);
        if (SUB(2)) for (int bc = F.bid; bc < 256; bc += F.G) { __syncthreads(); p2_gla_chunk(F, bc); }
        __syncthreads();
        if (SUB(3)) for (int t = F.gw; t < SB * 4; t += F.NGW) p2_gla_sample(F, t);
    }
    SEAM(2);
    REP(3) if (IN(3)) {
        nsa_tables(F);
        const float mb = nsa_bound(F);
        if (SUB(4)) for (int n = F.bid; n < 1024; n += F.G) p3_nsa_prompt(F, n, mb, (sub >> 8) & 31);
        if (SUB(5)) for (int t = F.G - 1 - F.bid; t < SB * 2; t += F.G) p3_nsa_sample(F, t);
        __syncthreads();
        if (SUB(6)) { const float gq = absmax_arr(F.in[I_GXQ], 128, LANE_), gk = absmax_arr(F.in[I_GXK], 128, LANE_);
          const float mbx = 11.313708498984761f * gq * gk * 1.02f * LOG2E;
          for (int t = F.gw; t < 4096; t += F.NGW) p3_xatt(F, t, mbx); }
        if (SUB(6)) for (int t = F.gw; t < SB * 4; t += F.NGW) p3_xatt_sample(F, t);
        if (SUB(7)) for (int t = F.gw; t < 1024; t += F.NGW) p3_gla_scan(F, t);
    }
    SEAM(3);
    REP(4) if (IN(4)) { for (int t = F.gw; t < 1024; t += F.NGW) p4_gla_out(F, t); }
    SEAM(4);
    if (IN(5)) {
        const bf16* gate = WSP(bf16, WS_PROJ) + C_MG;
        { pg8::Gemm g{WSP(bf16, WS_ONSA), WSP(bf16, WS_WTNSA), MPAD, 1024, 512}; SO S; S.init(MPAD, 1024, F.G, F.bid);
          pg8::EpiMerge<0> E{gate, DINP, WSP(bf16, WS_MERGED), 1024};
          pg8::gemm_phase<pg8::EpiMerge<0>, SO, true, true>(F.lds, g, S, E, F.wave); }
        __syncthreads();
        { pg8::Gemm g{WSP(bf16, WS_OGLA), WSP(bf16, WS_WTGLA), MPAD, 1024, 512}; SO S; S.init(MPAD, 1024, F.G, F.bid);
          pg8::EpiMerge<1> E{gate + 1024, DINP, WSP(bf16, WS_MERGED), 1024};
          pg8::gemm_phase<pg8::EpiMerge<1>, SO, true, true>(F.lds, g, S, E, F.wave); }
        __syncthreads();
        { pg8::Gemm g{WSP(bf16, WS_OX), WSP(bf16, WS_WTX), MPAD, 1024, 512}; SO S; S.init(MPAD, 1024, F.G, F.bid);
          pg8::EpiMerge<1> E{gate + 2048, DINP, WSP(bf16, WS_MERGED), 1024};
          pg8::gemm_phase<pg8::EpiMerge<1>, SO, true, true>(F.lds, g, S, E, F.wave); }
    }
    SEAM(5);
    if (IN(6)) {
        pg8::Gemm g{WSP(bf16, WS_MERGED), WSP(bf16, WS_WTO), MPAD, 1024, 1024}; SO S; S.init(MPAD, 1024, F.G, F.bid);
        pg8::EpiWo E{F.in[I_XP], F.in[I_XS], WSP(float, WS_X1), WSP(bf16, WS_X1B), WSP(float, WS_SSQ)};
        pg8::gemm_phase<pg8::EpiWo, SO, true, true>(F.lds, g, S, E, F.wave);
    }
    SEAM(6);
    if (IN(7)) {
        pg8::Gemm g{WSP(bf16, WS_X1B), WSP(bf16, WS_WTUP), MPAD, DUP, 1024}; SO S; S.init(MPAD, DUP, F.G, F.bid);
        pg8::EpiStore E{WSP(bf16, WS_UG), DUP, WSP(float, WS_SSQ)};
        pg8::gemm_phase<pg8::EpiStore, SO, true, true>(F.lds, g, S, E, F.wave);
    }
    SEAM(7);
    REP(8) if (IN(8)) { p6_conv(F); }
    SEAM(8);
    if (IN(9)) {
        pg8::Gemm g{WSP(bf16, WS_ACT), WSP(bf16, WS_WTDOWN), MPAD, 1024, DFF}; SO S; S.init(MPAD, 1024, F.G, F.bid);
        pg8::EpiDown E{WSP(float, WS_X1), F.out + O_Y, F.out + O_YS};
        pg8::gemm_phase<pg8::EpiDown, SO, true, true>(F.lds, g, S, E, F.wave);
    }
#undef IN
#undef SEAM
}

extern "C" void kernel_launch(void* const* d_in, const int* in_sizes, int n_in, void* d_out, int out_size, void* d_ws, size_t ws_size, hipStream_t stream) {
    static int grid = 0;
    if (grid == 0) {
        if (n_in != N_IN || (size_t)out_size != O_END || ws_size < WS_END) {
            fprintf(stderr, "kernel_launch: built for %d inputs, %zu outputs, >= %zu bytes of workspace; got %d, %d, %zu\n", (int)N_IN, (size_t)O_END, (size_t)WS_END, n_in, out_size, ws_size); grid = -1; return; }
        int dev = 0, cus = 0, per_cu = 0;
        if (hipGetDevice(&dev) != hipSuccess || hipDeviceGetAttribute(&cus, hipDeviceAttributeMultiprocessorCount, dev) != hipSuccess) { grid = -1; return; }
        if (hipFuncSetAttribute((const void*)mega_fwd, hipFuncAttributeMaxDynamicSharedMemorySize, LDS_BYTES) != hipSuccess) { fprintf(stderr, "kernel_launch: hipFuncSetAttribute failed\n"); grid = -1; return; }
        if (hipOccupancyMaxActiveBlocksPerMultiprocessor(&per_cu, (const void*)mega_fwd, NTHR, LDS_BYTES) != hipSuccess || per_cu < 1) { fprintf(stderr, "kernel_launch: occupancy query gave %d\n", per_cu); per_cu = 1; }
        (void)hipGetLastError();
        grid = cus * (per_cu < 1 ? 1 : 1);
    }
    if (grid < 0) return;
    Args a{};
    for (int i = 0; i < N_IN; ++i) a.in[i] = (const float*)d_in[i];
    a.out = (float*)d_out; a.ws = (unsigned char*)d_ws;
#if MK_N_LAUNCHES == 1
    a.ph_lo = 0; a.ph_hi = N_PHASES; a.sub = 0xff;
    void* kargs[] = {&a};
    hipError_t e = hipLaunchCooperativeKernel((const void*)mega_fwd, dim3(grid), dim3(NTHR), kargs, LDS_BYTES, stream);
    if (e != hipSuccess) fprintf(stderr, "kernel_launch: cooperative launch failed: %s (grid %d)\n", hipGetErrorString(e), grid);
#ifdef PROBE_EXTRA
    a.ph_lo = PROBE_EXTRA; a.ph_hi = PROBE_EXTRA + 1;
#ifdef PROBE_SUB
    a.sub = PROBE_SUB;
#endif
    hipLaunchKernelGGL(mega_fwd, dim3(grid), dim3(NTHR), LDS_BYTES, stream, a);
#endif
#else
    a.sub = 0xff;
    for (int p = 0; p < N_PHASES; ++p) { a.ph_lo = p; a.ph_hi = p + 1; hipLaunchKernelGGL(mega_fwd, dim3(grid), dim3(NTHR), LDS_BYTES, stream, a); }
#endif
}
```

```cpp
#include <hip/hip_runtime.h>
#include <hip/hip_cooperative_groups.h>
#include <cstdio>
#include <cstdint>
namespace cg = cooperative_groups;
#ifndef MK_N_LAUNCHES
#define MK_N_LAUNCHES 1
#endif
namespace pg8 {
#define PG8_LAS __attribute__((address_space(3)))
typedef unsigned short bf16_t;
typedef short bf16x8 __attribute__((ext_vector_type(8)));
typedef float f32x4 __attribute__((ext_vector_type(4)));
typedef unsigned u32x4 __attribute__((ext_vector_type(4)));
constexpr int BM = 256, BK = 64, HALF = 128, HTB = HALF * BK * 2  , STAGE_BYTES = 8 * HTB, NXCD = 8, WGM = 8;

__host__ __device__ __forceinline__ int lds_byte(int r, int c) { const int st = (r >> 4) * 2 + (c >> 5), rr = r & 15, cc = c & 31, ob = rr * 64 + cc * 2; return st * 1024 + (ob ^ (((ob >> 9) & 1) << 5)); }
__host__ __device__ __forceinline__ void stage_rc(int b, int& R, int& C) { const int st = b / 1024, sb = b % 1024, swz = sb ^ (((sb >> 9) & 1) << 5); R = (st >> 1) * 16 + swz / 64; C = (st & 1) * 32 + (swz % 64) / 2; }
__host__ __device__ __forceinline__ int perm32(int rho) { const int n = rho >> 4, i = rho & 15; return 8 * (i >> 2) + 4 * n + (i & 3); }

struct Unit { int pm, pn; };
struct Gemm { const bf16_t* A; const bf16_t* Bt; int M, N, K; };

struct StaticOrder {
    int nM, nN, nwg, G, c;
    __host__ __device__ void init(int M, int N, int G_, int c_) { nM = M / BM; nN = N / BM; nwg = nM * nN; G = G_; c = c_; }
    __host__ __device__ bool next(int i, Unit& u) const {
        const long L = (long)i * G + c; if (L >= nwg) return false;
        int wgid = (int)L; { const int q = nwg / NXCD, r = nwg % NXCD, xcd = wgid % NXCD, off = wgid / NXCD; wgid = (xcd < r ? xcd * (q + 1) : r * (q + 1) + (xcd - r) * q) + off; }
        const int nig = WGM * nN, gid = wgid / nig, fm = gid * WGM, gsz = (nM - fm) < WGM ? (nM - fm) : WGM;
        u.pm = fm + ((wgid % nig) % gsz); u.pn = (wgid % nig) / gsz; return true;
    }
    __device__ __forceinline__ void a_ready(const Unit&) const {}
    __device__ __forceinline__ void done(const Unit&) const {}
};

__device__ __forceinline__ unsigned cvt_pk_bf16(float lo, float hi) { unsigned r; asm volatile("v_cvt_pk_bf16_f32 %0, %1, %2" : "=v"(r) : "v"(lo), "v"(hi)); return r; }
__device__ __forceinline__ float bflo(unsigned w) { return __uint_as_float(w << 16); }
__device__ __forceinline__ float bfhi(unsigned w) { return __uint_as_float(w & 0xffff0000u); }
__device__ __forceinline__ float sigm(float x) { return 1.0f / (1.0f + __expf(-x)); }
struct EpiStore {
    static constexpr bool PERM = true, AFTER_DRAIN = false;
    bf16_t* O; int ldc; const float* ssq;
    __device__ __forceinline__ void operator()(const f32x4 (&acc)[2][2][4][2], const Unit& u, int wr, int wc, int fr, int fq) const {
        const int row0 = u.pm * BM + wr * 64 + fr, col0 = u.pn * BM + wc * 32 + 8 * fq;
#pragma unroll
        for (int ai = 0; ai < 2; ++ai)
#pragma unroll
            for (int m = 0; m < 4; ++m) { const int row = row0 + ai * HALF + m * 16; bf16_t* rowp = O + (size_t)row * ldc + col0;
                const float sc = ssq ? rsqrtf(ssq[row] * (1.0f / 1024.0f) + 1e-6f) : 1.0f;
#pragma unroll
                for (int bj = 0; bj < 2; ++bj) { const f32x4 v0 = acc[ai][bj][m][0] * sc, v1 = acc[ai][bj][m][1] * sc;
                    u32x4 w; w.x = cvt_pk_bf16(v0[0], v0[1]); w.y = cvt_pk_bf16(v0[2], v0[3]); w.z = cvt_pk_bf16(v1[0], v1[1]); w.w = cvt_pk_bf16(v1[2], v1[3]);
                    *(u32x4*)(rowp + bj * HALF) = w; } }
    }
};
template <int ACCUM> struct EpiMerge {
    static constexpr bool PERM = true, AFTER_DRAIN = false;
    const bf16_t* gate; int ldg; bf16_t* O; int ldc;
    __device__ __forceinline__ void operator()(const f32x4 (&acc)[2][2][4][2], const Unit& u, int wr, int wc, int fr, int fq) const {
        const int row0 = u.pm * BM + wr * 64 + fr, col0 = u.pn * BM + wc * 32 + 8 * fq;
#pragma unroll
        for (int ai = 0; ai < 2; ++ai)
#pragma unroll
            for (int m = 0; m < 4; ++m) { const int row = row0 + ai * HALF + m * 16; bf16_t* rowp = O + (size_t)row * ldc + col0; const bf16_t* gp = gate + (size_t)row * ldg + col0;
#pragma unroll
                for (int bj = 0; bj < 2; ++bj) {
                    const u32x4 g = *(const u32x4*)(gp + bj * HALF);
                    f32x4 v0 = acc[ai][bj][m][0], v1 = acc[ai][bj][m][1];
                    v0[0] *= sigm(bflo(g.x)); v0[1] *= sigm(bfhi(g.x)); v0[2] *= sigm(bflo(g.y)); v0[3] *= sigm(bfhi(g.y));
                    v1[0] *= sigm(bflo(g.z)); v1[1] *= sigm(bfhi(g.z)); v1[2] *= sigm(bflo(g.w)); v1[3] *= sigm(bfhi(g.w));
                    if (ACCUM) { const u32x4 o = *(const u32x4*)(rowp + bj * HALF);
                        v0[0] += bflo(o.x); v0[1] += bfhi(o.x); v0[2] += bflo(o.y); v0[3] += bfhi(o.y);
                        v1[0] += bflo(o.z); v1[1] += bfhi(o.z); v1[2] += bflo(o.w); v1[3] += bfhi(o.w); }
                    u32x4 w; w.x = cvt_pk_bf16(v0[0], v0[1]); w.y = cvt_pk_bf16(v0[2], v0[3]); w.z = cvt_pk_bf16(v1[0], v1[1]); w.w = cvt_pk_bf16(v1[2], v1[3]);
                    *(u32x4*)(rowp + bj * HALF) = w; } }
    }
};
struct EpiWo {
    static constexpr bool PERM = true, AFTER_DRAIN = false;
    const float* xp; const float* xs; float* X1; bf16_t* X1B; float* ssq;
    __device__ __forceinline__ void operator()(const f32x4 (&acc)[2][2][4][2], const Unit& u, int wr, int wc, int fr, int fq) const {
        const int row0 = u.pm * BM + wr * 64 + fr, col0 = u.pn * BM + wc * 32 + 8 * fq;
#pragma unroll
        for (int ai = 0; ai < 2; ++ai)
#pragma unroll
            for (int m = 0; m < 4; ++m) { const int row = row0 + ai * HALF + m * 16;
                const float* xr = row < 16384 ? xp + (size_t)row * 1024 : (row < 16416 ? xs + (size_t)(row - 16384) * 1024 : nullptr);
                float ss = 0.f;
#pragma unroll
                for (int bj = 0; bj < 2; ++bj) { const int col = col0 + bj * HALF;
                    f32x4 x0 = (f32x4){0.f, 0.f, 0.f, 0.f}, x1 = x0;
                    if (xr) { x0 = *(const f32x4*)(xr + col); x1 = *(const f32x4*)(xr + col + 4); }
                    const f32x4 v0 = acc[ai][bj][m][0] + x0, v1 = acc[ai][bj][m][1] + x1;
                    *(f32x4*)(X1 + (size_t)row * 1024 + col) = v0; *(f32x4*)(X1 + (size_t)row * 1024 + col + 4) = v1;
                    u32x4 w; w.x = cvt_pk_bf16(v0[0], v0[1]); w.y = cvt_pk_bf16(v0[2], v0[3]); w.z = cvt_pk_bf16(v1[0], v1[1]); w.w = cvt_pk_bf16(v1[2], v1[3]);
                    *(u32x4*)(X1B + (size_t)row * 1024 + col) = w;
                    ss += (v0[0] * v0[0] + v0[1] * v0[1]) + (v0[2] * v0[2] + v0[3] * v0[3]) + (v1[0] * v1[0] + v1[1] * v1[1]) + (v1[2] * v1[2] + v1[3] * v1[3]); }
                ss += __shfl_xor(ss, 16); ss += __shfl_xor(ss, 32);
                if (fq == 0) atomicAdd(ssq + row, ss); }
    }
};
struct EpiDown {
    static constexpr bool PERM = true, AFTER_DRAIN = false;
    const float* X1; float* yp; float* ys;
    __device__ __forceinline__ void operator()(const f32x4 (&acc)[2][2][4][2], const Unit& u, int wr, int wc, int fr, int fq) const {
        const int row0 = u.pm * BM + wr * 64 + fr, col0 = u.pn * BM + wc * 32 + 8 * fq;
#pragma unroll
        for (int ai = 0; ai < 2; ++ai)
#pragma unroll
            for (int m = 0; m < 4; ++m) { const int row = row0 + ai * HALF + m * 16;
                float* yr = row < 16384 ? yp + (size_t)row * 1024 : (row < 16416 ? ys + (size_t)(row - 16384) * 1024 : nullptr);
                if (!yr) continue;
#pragma unroll
                for (int bj = 0; bj < 2; ++bj) { const int col = col0 + bj * HALF;
                    const f32x4 x0 = *(const f32x4*)(X1 + (size_t)row * 1024 + col), x1 = *(const f32x4*)(X1 + (size_t)row * 1024 + col + 4);
                    *(f32x4*)(yr + col) = acc[ai][bj][m][0] + x0; *(f32x4*)(yr + col + 4) = acc[ai][bj][m][1] + x1; } }
    }
};
template <class Epi, class Sched, bool ALIGN_EPI = false, bool SP2 = false>
__device__ __forceinline__ void gemm_phase(PG8_LAS unsigned char* lds, const Gemm g, const Sched& S, const Epi& E, const int wid) {
    unsigned z_ = 0u; asm volatile("" : "+v"(z_));
    const int lane = (int)__builtin_amdgcn_mbcnt_hi(~0u, __builtin_amdgcn_mbcnt_lo(~0u, z_)), tid = wid * 64 + lane, wr = wid >> 2, wc = wid & 3, fr = lane & 15, fq = lane >> 4;
    const int K = g.K, nt = K / BK;
    unsigned voffA[2], voffB[2];
#pragma unroll
    for (int i = 0; i < 2; ++i) { int R, C; stage_rc(tid * 16 + i * 8192, R, C); const int Rb = Epi::PERM ? ((R & ~31) + perm32(R & 31)) : R;
        voffA[i] = (unsigned)(R * K + C) * 2u; voffB[i] = (unsigned)(Rb * K + C) * 2u; }
    const size_t kstep = (size_t)(BK * 2);
    const size_t hstep = (size_t)HALF * K * 2;
    const size_t tstep = 2 * hstep;
    const unsigned ldsw = (unsigned)wid * 1024u;
    const int aoff = lds_byte(wr * 64 + fr, fq * 8), boff = lds_byte(wc * 32 + fr, fq * 8);
#define PG8_SA(b, h) (((b) * 2 + (h)) * HTB)
#define PG8_SB(b, h) ((4 + (b) * 2 + (h)) * HTB)
#define PG8_STAGE(bufoff, gbase, voff) do { _Pragma("unroll") for (int _i = 0; _i < 2; ++_i) \
        __builtin_amdgcn_global_load_lds((const unsigned*)((const char*)(gbase) + (voff)[_i]), (PG8_LAS unsigned*)(lds + (bufoff) + ldsw + _i * 8192), 16, 0, 0); } while (0)
#define PG8_LDA(dst, b, h) do { _Pragma("unroll") for (int m = 0; m < 4; ++m) _Pragma("unroll") for (int k = 0; k < 2; ++k) dst[m][k] = *(const PG8_LAS bf16x8*)(lds + PG8_SA(b, h) + aoff + m * 2048 + k * 1024); } while (0)
#define PG8_LDB(dst, b, h) do { _Pragma("unroll") for (int n = 0; n < 2; ++n) _Pragma("unroll") for (int k = 0; k < 2; ++k) dst[n][k] = *(const PG8_LAS bf16x8*)(lds + PG8_SB(b, h) + boff + n * 2048 + k * 1024); } while (0)
#define PG8_MMA(ai, bj, At, Bt) do { __builtin_amdgcn_s_setprio(1); _Pragma("unroll") for (int m = 0; m < 4; ++m) _Pragma("unroll") for (int n = 0; n < 2; ++n) _Pragma("unroll") for (int k = 0; k < 2; ++k) \
        acc[ai][bj][m][n] = __builtin_amdgcn_mfma_f32_16x16x32_bf16(Bt[n][k], At[m][k], acc[ai][bj][m][n], 0, 0, 0); __builtin_amdgcn_s_setprio(0); } while (0)
#define PG8_WAIT_V(n) asm volatile("s_waitcnt vmcnt(" #n ")" ::: "memory")
#define PG8_WAIT_L(n) asm volatile("s_waitcnt lgkmcnt(" #n ")" ::: "memory")
#define PG8_BAR __builtin_amdgcn_s_barrier()
#define PG8_SCHED __builtin_amdgcn_sched_barrier(0)
    Unit cur, nxt; int ui = 0;
    if (!S.next(0, cur)) return;
    f32x4 acc[2][2][4][2];
#pragma unroll
    for (int a = 0; a < 2; ++a)
#pragma unroll
        for (int b = 0; b < 2; ++b)
#pragma unroll
            for (int m = 0; m < 4; ++m)
#pragma unroll
                for (int n = 0; n < 2; ++n) acc[a][b][m][n] = (f32x4){0.f, 0.f, 0.f, 0.f};
    bf16x8 At[4][2], B0[2][2], B1[2][2];
    const char* cA = (const char*)g.A + (size_t)cur.pm * tstep; const char* cB = (const char*)g.Bt + (size_t)cur.pn * tstep;
    S.a_ready(cur);
    if constexpr (SP2) {
        PG8_STAGE(PG8_SB(0, 0), cB, voffB); PG8_STAGE(PG8_SB(0, 1), cB + hstep, voffB); PG8_STAGE(PG8_SA(0, 0), cA, voffA); PG8_STAGE(PG8_SA(0, 1), cA + hstep, voffA);
        if (wr == 1) PG8_BAR;
        PG8_WAIT_V(2); PG8_BAR;
        PG8_STAGE(PG8_SB(1, 0), cB + kstep, voffB); PG8_STAGE(PG8_SA(1, 0), cA + kstep, voffA); PG8_STAGE(PG8_SB(1, 1), cB + hstep + kstep, voffB);
        PG8_WAIT_V(6); PG8_BAR;
    } else {
        PG8_STAGE(PG8_SB(0, 0), cB, voffB); PG8_STAGE(PG8_SA(0, 0), cA, voffA); PG8_STAGE(PG8_SB(0, 1), cB + hstep, voffB); PG8_STAGE(PG8_SA(0, 1), cA + hstep, voffA);
        if (wr == 1) PG8_BAR;
        PG8_WAIT_V(4); PG8_BAR;
        PG8_STAGE(PG8_SB(1, 0), cB + kstep, voffB); PG8_STAGE(PG8_SA(1, 0), cA + kstep, voffA); PG8_STAGE(PG8_SB(1, 1), cB + hstep + kstep, voffB);
        PG8_WAIT_V(6); PG8_BAR;
    }
    for (;;) {
        const bool has_next = S.next(ui + 1, nxt);
        const char* nA = has_next ? (const char*)g.A + (size_t)nxt.pm * tstep : cA; const char* nB = has_next ? (const char*)g.Bt + (size_t)nxt.pn * tstep : cB;
        for (int t = 0; t < nt; t += 2) {
            const bool last = (t == nt - 2);
            const char* a1 = cA + (size_t)(t + 1) * kstep;
            const char* a2 = last ? nA : cA + (size_t)(t + 2) * kstep; const char* b2 = last ? nB : cB + (size_t)(t + 2) * kstep;
            const char* a3 = a2 + kstep; const char* b3 = b2 + kstep;
            if (last && has_next) S.a_ready(nxt);
            if constexpr (SP2) {
            PG8_LDB(B0, 0, 0); PG8_LDB(B1, 0, 1); PG8_SCHED; PG8_LDA(At, 0, 0); PG8_STAGE(PG8_SA(1, 1), a1 + hstep, voffA);
            PG8_WAIT_V(8); PG8_WAIT_L(0); PG8_BAR; PG8_MMA(0, 0, At, B0); PG8_MMA(0, 1, At, B1); PG8_BAR; PG8_SCHED;
            PG8_LDA(At, 0, 1); PG8_STAGE(PG8_SB(0, 0), b2, voffB); PG8_STAGE(PG8_SB(0, 1), b2 + hstep, voffB); PG8_STAGE(PG8_SA(0, 0), a2, voffA);
            PG8_WAIT_V(8); PG8_WAIT_L(0); PG8_BAR; PG8_MMA(1, 0, At, B0); PG8_MMA(1, 1, At, B1); PG8_BAR; PG8_SCHED;
            PG8_LDB(B0, 1, 0); PG8_LDB(B1, 1, 1); PG8_SCHED; PG8_LDA(At, 1, 0); PG8_STAGE(PG8_SA(0, 1), a2 + hstep, voffA);
            PG8_WAIT_V(8); PG8_WAIT_L(0); PG8_BAR; PG8_MMA(0, 0, At, B0); PG8_MMA(0, 1, At, B1); PG8_BAR; PG8_SCHED;
            PG8_LDA(At, 1, 1); PG8_STAGE(PG8_SB(1, 0), b3, voffB); PG8_STAGE(PG8_SB(1, 1), b3 + hstep, voffB); PG8_STAGE(PG8_SA(1, 0), a3, voffA);
            PG8_WAIT_V(8); PG8_WAIT_L(0); PG8_BAR; PG8_MMA(1, 0, At, B0); PG8_MMA(1, 1, At, B1); PG8_BAR; PG8_SCHED;
            } else {
            PG8_LDB(B0, 0, 0); PG8_SCHED; PG8_LDA(At, 0, 0); PG8_STAGE(PG8_SA(1, 1), a1 + hstep, voffA);
            PG8_WAIT_L(8); PG8_BAR; PG8_WAIT_L(0); PG8_MMA(0, 0, At, B0); PG8_BAR; PG8_SCHED;
            PG8_LDB(B1, 0, 1); PG8_STAGE(PG8_SB(0, 0), b2, voffB);
            PG8_BAR; PG8_WAIT_L(0); PG8_MMA(0, 1, At, B1); PG8_BAR;
            PG8_LDA(At, 0, 1); PG8_STAGE(PG8_SA(0, 0), a2, voffA);
            PG8_BAR; PG8_WAIT_L(0); PG8_MMA(1, 0, At, B0); PG8_BAR; PG8_SCHED;
            PG8_STAGE(PG8_SB(0, 1), b2 + hstep, voffB);
            PG8_WAIT_V(6); PG8_BAR; PG8_MMA(1, 1, At, B1); PG8_BAR;
            PG8_LDB(B0, 1, 0); PG8_SCHED; PG8_LDA(At, 1, 0); PG8_STAGE(PG8_SA(0, 1), a2 + hstep, voffA);
            PG8_WAIT_L(8); PG8_BAR; PG8_WAIT_L(0); PG8_MMA(0, 0, At, B0); PG8_BAR; PG8_SCHED;
            PG8_LDB(B1, 1, 1); PG8_STAGE(PG8_SB(1, 0), b3, voffB);
            PG8_BAR; PG8_WAIT_L(0); PG8_MMA(0, 1, At, B1); PG8_BAR;
            PG8_LDA(At, 1, 1); PG8_STAGE(PG8_SA(1, 0), a3, voffA);
            PG8_BAR; PG8_WAIT_L(0); PG8_MMA(1, 0, At, B0); PG8_BAR; PG8_SCHED;
            PG8_STAGE(PG8_SB(1, 1), b3 + hstep, voffB);
            PG8_WAIT_V(6); PG8_BAR; PG8_MMA(1, 1, At, B1); PG8_BAR;
            }
        }
        if constexpr (ALIGN_EPI) { if (wr == 0) PG8_BAR; }
        if constexpr (!Epi::AFTER_DRAIN) { E(acc, cur, wr, wc, fr, fq); S.done(cur); }
        if (!has_next) break;
#pragma unroll
        for (int a = 0; a < 2; ++a)
#pragma unroll
            for (int b = 0; b < 2; ++b)
#pragma unroll
                for (int m = 0; m < 4; ++m)
#pragma unroll
                    for (int n = 0; n < 2; ++n) acc[a][b][m][n] = (f32x4){0.f, 0.f, 0.f, 0.f};
        cur = nxt; cA = nA; cB = nB; ++ui;
        if constexpr (ALIGN_EPI) { if (wr == 1) PG8_BAR; }
    }
    PG8_WAIT_V(0);
    if constexpr (!ALIGN_EPI) { if (wr == 0) PG8_BAR; }
    PG8_BAR;
    if constexpr (Epi::AFTER_DRAIN) { E.fused(acc, cur, wr, wc, fr, fq, lds, wid, lane); S.done(cur); }
#undef PG8_SA
#undef PG8_SB
#undef PG8_STAGE
#undef PG8_LDA
#undef PG8_LDB
#undef PG8_MMA
#undef PG8_WAIT_V
#undef PG8_WAIT_L
#undef PG8_BAR
#undef PG8_SCHED
}
}

typedef unsigned short bf16;
typedef short bf16x8 __attribute__((ext_vector_type(8)));
typedef short bf16x4 __attribute__((ext_vector_type(4)));
typedef float f32x4 __attribute__((ext_vector_type(4)));
typedef unsigned u32x4 __attribute__((ext_vector_type(4)));
typedef unsigned u32x2 __attribute__((ext_vector_type(2)));
#define LAS __attribute__((address_space(3)))
constexpr int NWAVES = 8, NTHR = 512;
constexpr int DM = 1024, T = 8192, NB = 2, NTOKP = NB * T, SB = 32, NTOK = NTOKP + SB, MPAD = 16640;
constexpr int DIN = 6440, DINP = 6656, DFF = 2816, DUP = 2 * DFF;
constexpr int C_Q = 0, C_KV = 512, C_G = 1280, C_GQ = 1304, C_GK = 1560, C_GV = 1816, C_LR = 2328, C_GR = 2344, C_XQ = 2856, C_MG = 3368;
constexpr float EPS = 1e-6f, LOG2E = 1.4426950408889634f;
constexpr float QSCALE = 0.125f * LOG2E;
constexpr float XSCALE = 0.08838834764831845f * LOG2E;
constexpr size_t O_Y = 0, O_YS = 16777216, O_KVP = O_YS + 32768, O_WINP = O_KVP + 8388608, O_GLAP = O_WINP + 262144, O_CONVP = O_GLAP + 65536,
                 O_MEMP = O_CONVP + 11264, O_KVS = O_MEMP + 524288, O_WINS = O_KVS + 16384, O_GLAS = O_WINS + 4194304, O_CONVS = O_GLAS + 1048576, O_END = O_CONVS + 180224;
enum { I_XP = 0, I_XS, I_CKV, I_CWIN, I_SGLA, I_SCONV, I_CMEM, I_PT, I_MEMP, I_GMIX, I_WIN, I_GNQ, I_GNK, I_CKPE, I_CKW1, I_CKW2, I_CVPE, I_CVW1, I_CVW2,
       I_RB, I_WGG, I_BGG, I_GGO, I_GMEM, I_WMEM, I_GXQ, I_GXK, I_WNSA, I_WGLA, I_WX, I_WO, I_GFFN, I_WUP, I_CONVW, I_CONVB, I_WDOWN, N_IN };
constexpr size_t al_(size_t x) { return (x + 255) & ~(size_t)255; }
constexpr size_t WS_SSQ = 0;
constexpr size_t WS_C0 = al_(WS_SSQ + (size_t)MPAD * 4);
constexpr size_t WS_WTIN = al_(WS_C0 + 1024);
constexpr size_t WS_WTMEM = al_(WS_WTIN + (size_t)DINP * 1024 * 2);
constexpr size_t WS_WTNSA = al_(WS_WTMEM + (size_t)1024 * 1024 * 2);
constexpr size_t WS_WTGLA = al_(WS_WTNSA + (size_t)1024 * 512 * 2);
constexpr size_t WS_WTX = al_(WS_WTGLA + (size_t)1024 * 512 * 2);
constexpr size_t WS_WTO = al_(WS_WTX + (size_t)1024 * 512 * 2);
constexpr size_t WS_WTUP = al_(WS_WTO + (size_t)1024 * 1024 * 2);
constexpr size_t WS_WTDOWN = al_(WS_WTUP + (size_t)DUP * 1024 * 2);
constexpr size_t WS_W1T = al_(WS_WTDOWN + (size_t)1024 * DFF * 2);
constexpr size_t WS_W2T = al_(WS_W1T + (size_t)2 * 64 * 2048 * 2);
constexpr size_t WS_XN = al_(WS_W2T + (size_t)2 * 64 * 64 * 2);
constexpr size_t WS_MN = al_(WS_XN + (size_t)MPAD * 1024 * 2);
constexpr size_t WS_PROJ = al_(WS_MN + (size_t)512 * 1024 * 2);
constexpr size_t WS_MEMPROJ = al_(WS_PROJ + (size_t)MPAD * DINP * 2);
constexpr size_t WS_QN = al_(WS_MEMPROJ + (size_t)512 * 1024 * 2);
constexpr size_t WS_KSEL = al_(WS_QN + (size_t)NTOK * 512 * 2);
constexpr size_t WS_VSELT = al_(WS_KSEL + (size_t)4 * T * 64 * 2);
constexpr size_t WS_KWIN = al_(WS_VSELT + (size_t)4 * T * 64 * 2);
constexpr size_t WS_VWINT = al_(WS_KWIN + (size_t)4 * T * 64 * 2);
constexpr size_t WS_GATES = al_(WS_VWINT + (size_t)4 * T * 64 * 2);
constexpr size_t WS_NEWKV = al_(WS_GATES + (size_t)NTOK * 24 * 4);
constexpr size_t WS_KCMP = al_(WS_NEWKV + (size_t)SB * 4 * 2 * 64 * 4);
constexpr size_t WS_VCMPT = al_(WS_KCMP + (size_t)4 * 512 * 64 * 2);
constexpr size_t WS_KCMPS = al_(WS_VCMPT + (size_t)4 * 512 * 64 * 2);
constexpr size_t WS_VCMPS = al_(WS_KCMPS + (size_t)SB * 2 * 512 * 64 * 4);
constexpr size_t WS_QTG = al_(WS_VCMPS + (size_t)SB * 2 * 512 * 64 * 4);
constexpr size_t WS_KTG = al_(WS_QTG + (size_t)NTOKP * 256 * 2);
constexpr size_t WS_VTG = al_(WS_KTG + (size_t)NTOKP * 256 * 2);
constexpr size_t WS_UP = al_(WS_VTG + (size_t)256 * 4 * 128 * 64 * 2);
constexpr size_t WS_DEC = al_(WS_UP + (size_t)256 * 4 * 128 * 64 * 4);
constexpr size_t WS_SC = al_(WS_DEC + (size_t)256 * 4 * 64 * 4);
constexpr size_t WS_XQ = al_(WS_SC + (size_t)256 * 4 * 128 * 64 * 2);
constexpr size_t WS_KMEM = al_(WS_XQ + (size_t)NTOK * 512 * 2);
constexpr size_t WS_VMEMT = al_(WS_KMEM + (size_t)8 * 256 * 128 * 2);
constexpr size_t WS_ONSA = al_(WS_VMEMT + (size_t)8 * 256 * 128 * 2);
constexpr size_t WS_OGLA = al_(WS_ONSA + (size_t)MPAD * 512 * 2);
constexpr size_t WS_OX = al_(WS_OGLA + (size_t)MPAD * 512 * 2);
constexpr size_t WS_MERGED = al_(WS_OX + (size_t)MPAD * 512 * 2);
constexpr size_t WS_X1 = al_(WS_MERGED + (size_t)MPAD * 1024 * 2);
constexpr size_t WS_X1B = al_(WS_X1 + (size_t)MPAD * 1024 * 4);
constexpr size_t WS_UG = al_(WS_X1B + (size_t)MPAD * 1024 * 2);
constexpr size_t WS_ACT = al_(WS_UG + (size_t)MPAD * DUP * 2);
constexpr size_t WS_END = al_(WS_ACT + (size_t)MPAD * DFF * 2);
constexpr int RING_BYTES = 131072, LDS_BYTES = 155648;

struct Args { const float* in[N_IN]; float* out; unsigned char* ws; int ph_lo, ph_hi, sub, pad; };

__device__ __forceinline__ unsigned f2bf(float f) { unsigned u = __float_as_uint(f); return (u + 0x7fffu + ((u >> 16) & 1u)) >> 16; }
__device__ __forceinline__ unsigned pk2(float lo, float hi) { return pg8::cvt_pk_bf16(lo, hi); }
__device__ __forceinline__ float bf2f(unsigned short u) { return __uint_as_float((unsigned)u << 16); }
__device__ __forceinline__ float bflo(unsigned w) { return __uint_as_float(w << 16); }
__device__ __forceinline__ float bfhi(unsigned w) { return __uint_as_float(w & 0xffff0000u); }
__device__ __forceinline__ void unpack8(const u32x4 w, float (&f)[8]) { f[0] = bflo(w.x); f[1] = bfhi(w.x); f[2] = bflo(w.y); f[3] = bfhi(w.y); f[4] = bflo(w.z); f[5] = bfhi(w.z); f[6] = bflo(w.w); f[7] = bfhi(w.w); }
__device__ __forceinline__ u32x4 pack8(const float (&f)[8]) { u32x4 w; w.x = pk2(f[0], f[1]); w.y = pk2(f[2], f[3]); w.z = pk2(f[4], f[5]); w.w = pk2(f[6], f[7]); return w; }
__device__ __forceinline__ bf16x8 as_frag(u32x4 w) { return __builtin_bit_cast(bf16x8, w); }
__device__ __forceinline__ bf16x8 frag_pk(f32x4 a, f32x4 b) { u32x4 w; w.x = pk2(a[0], a[1]); w.y = pk2(a[2], a[3]); w.z = pk2(b[0], b[1]); w.w = pk2(b[2], b[3]); return as_frag(w); }
__device__ __forceinline__ bf16x8 ldfrag(const bf16* p) { return as_frag(*(const u32x4*)p); }
__device__ __forceinline__ bf16x8 ldfrag2(const bf16* p0, const bf16* p1) { const u32x2 a = *(const u32x2*)p0, b = *(const u32x2*)p1; u32x4 w; w.x = a.x; w.y = a.y; w.z = b.x; w.w = b.y; return as_frag(w); }
__device__ __forceinline__ bf16x8 ldfrag_f32(const float* p) { const f32x4 a = *(const f32x4*)p, b = *(const f32x4*)(p + 4); return frag_pk(a, b); }
#define MFMA16(a, b, c) __builtin_amdgcn_mfma_f32_16x16x32_bf16((a), (b), (c), 0, 0, 0)
__device__ __forceinline__ float sigmoidf_(float x) { return 1.0f / (1.0f + __expf(-x)); }
__device__ __forceinline__ float gelu_tanh(float x) { const float u = 0.7978845608028654f * (x + 0.044715f * x * x * x); const float e = __expf(2.0f * u); return 0.5f * x * (2.0f - 2.0f / (e + 1.0f)); }
__device__ __forceinline__ float wave_sum(float v) {
#pragma unroll
    for (int o = 1; o < 64; o <<= 1) v += __shfl_xor(v, o);
    return v;
}
__device__ __forceinline__ float wave_max(float v) {
#pragma unroll
    for (int o = 1; o < 64; o <<= 1) v = fmaxf(v, __shfl_xor(v, o));
    return v;
}
__device__ __forceinline__ float absmax_arr(const float* g, int n, int lane) { float m = 0.f; for (int i = lane; i < n; i += 64) m = fmaxf(m, fabsf(g[i])); return wave_max(m); }
__device__ __forceinline__ int t5_bucket(int n) {
    if (n < 16) return n;
    if (n >= 128) return 31;
    const int v = 16 + (int)(__logf((float)n * 0.0625f) / 2.0794415416798357f * 16.0f);
    return v < 31 ? v : 31;
}

struct Frame {
    LAS unsigned char* lds;
    int wave, G, bid, gw, NGW;
    const float* const* in; float* out; unsigned char* ws;
};
#define WSP(T_, off) ((T_*)(F.ws + (off)))
__device__ __forceinline__ int lane_id_() { unsigned z = 0u; asm volatile("" : "+v"(z)); return (int)__builtin_amdgcn_mbcnt_hi(~0u, __builtin_amdgcn_mbcnt_lo(~0u, z)); }
#define LANE_ lane_id_()
#define TID_ (F.wave * 64 + lane_id_())

__device__ __forceinline__ void transpose_item(const float* W, int K, int N, bf16* WT, const float* kscale, LAS float* scr, int item, int nblk, int lane) {
    const int kb = item / nblk, nb = item % nblk, k0 = 64 * kb, n0 = 32 * nb;
#pragma unroll 8
    for (int i = 0; i < 32; ++i) { const int kk = 2 * i + (lane >> 5); const int n = n0 + (lane & 31);
        float v = n < N ? W[(size_t)(k0 + kk) * N + n] : 0.f; if (kscale) v *= kscale[k0 + kk];
        scr[kk * 33 + (lane & 31)] = v; }
    asm volatile("s_waitcnt lgkmcnt(0)" ::: "memory");
    const int c = lane & 7;
#pragma unroll
    for (int j = 0; j < 4; ++j) { const int n = (lane >> 3) + 8 * j; const LAS float* s = scr + (8 * c) * 33 + n;
        u32x4 o; o.x = pk2(s[0 * 33], s[1 * 33]); o.y = pk2(s[2 * 33], s[3 * 33]); o.z = pk2(s[4 * 33], s[5 * 33]); o.w = pk2(s[6 * 33], s[7 * 33]);
        *(u32x4*)(WT + (size_t)(n0 + n) * K + k0 + 8 * c) = o; }
    asm volatile("s_waitcnt lgkmcnt(0)" ::: "memory");
}
__device__ __forceinline__ void rms_row_to_bf16(const float* xrow, const float* g, bf16* orow, int lane) {
    unsigned long long* o8 = (unsigned long long*)orow + lane;
    if (!xrow) {
#pragma unroll
        for (int j = 0; j < 4; ++j) o8[64 * j] = 0ull;
        return; }
    const f32x4* xr = (const f32x4*)xrow + lane; const f32x4* gr = (const f32x4*)g + lane;
    f32x4 v[4]; float s = 0.f;
#pragma unroll
    for (int j = 0; j < 4; ++j) { v[j] = xr[64 * j]; s += (v[j].x * v[j].x + v[j].y * v[j].y) + (v[j].z * v[j].z + v[j].w * v[j].w); }
    const float rs = rsqrtf(wave_sum(s) * (1.f / 1024.f) + EPS);
#pragma unroll
    for (int j = 0; j < 4; ++j) { const f32x4 gg = gr[64 * j]; const f32x4 y = v[j] * rs * gg;
        o8[64 * j] = (unsigned long long)pk2(y.x, y.y) | ((unsigned long long)pk2(y.z, y.w) << 32); }
}
__device__ __forceinline__ void p0_prologue(Frame& F) {
    LAS float* scr = (LAS float*)(F.lds + F.wave * 16384);
    const int gw = F.gw, NGW = F.NGW;
    constexpr int IT_IN = 16 * 208, IT_MEM = 16 * 32, IT_BR = 8 * 32, IT_O = 16 * 32, IT_UP = 16 * 176, IT_DOWN = 44 * 32, IT_W1 = 32 * 2, IT_W2 = 1 * 2;
    constexpr int NITEMS = IT_IN + IT_MEM + 3 * IT_BR + IT_O + IT_UP + IT_DOWN + 2 * IT_W1 + 2 * IT_W2;
    for (int it = gw; it < NITEMS; it += NGW) {
        int r = it;
        if (r < IT_UP) { transpose_item(F.in[I_WUP], 1024, DUP, WSP(bf16, WS_WTUP), F.in[I_GFFN], scr, r, 176, LANE_); continue; } r -= IT_UP;
        if (r < IT_IN) { transpose_item(F.in[I_WIN], 1024, DIN, WSP(bf16, WS_WTIN), nullptr, scr, r, 208, LANE_); continue; } r -= IT_IN;
        if (r < IT_DOWN) { transpose_item(F.in[I_WDOWN], DFF, 1024, WSP(bf16, WS_WTDOWN), nullptr, scr, r, 32, LANE_); continue; } r -= IT_DOWN;
        if (r < IT_MEM) { transpose_item(F.in[I_WMEM], 1024, 1024, WSP(bf16, WS_WTMEM), nullptr, scr, r, 32, LANE_); continue; } r -= IT_MEM;
        if (r < IT_O) { transpose_item(F.in[I_WO], 1024, 1024, WSP(bf16, WS_WTO), nullptr, scr, r, 32, LANE_); continue; } r -= IT_O;
        if (r < IT_BR) { transpose_item(F.in[I_WNSA], 512, 1024, WSP(bf16, WS_WTNSA), nullptr, scr, r, 32, LANE_); continue; } r -= IT_BR;
        if (r < IT_BR) { transpose_item(F.in[I_WGLA], 512, 1024, WSP(bf16, WS_WTGLA), nullptr, scr, r, 32, LANE_); continue; } r -= IT_BR;
        if (r < IT_BR) { transpose_item(F.in[I_WX], 512, 1024, WSP(bf16, WS_WTX), nullptr, scr, r, 32, LANE_); continue; } r -= IT_BR;
        if (r < IT_W1) { transpose_item(F.in[I_CKW1], 2048, 64, WSP(bf16, WS_W1T), nullptr, scr, r, 2, LANE_); continue; } r -= IT_W1;
        if (r < IT_W1) { transpose_item(F.in[I_CVW1], 2048, 64, WSP(bf16, WS_W1T) + 64 * 2048, nullptr, scr, r, 2, LANE_); continue; } r -= IT_W1;
        if (r < IT_W2) { transpose_item(F.in[I_CKW2], 64, 64, WSP(bf16, WS_W2T), nullptr, scr, r, 2, LANE_); continue; } r -= IT_W2;
        transpose_item(F.in[I_CVW2], 64, 64, WSP(bf16, WS_W2T) + 64 * 64, nullptr, scr, r, 2, LANE_);
    }
    for (int m = gw; m < MPAD + 512; m += NGW) {
        if (m < MPAD) { const float* xr = m < NTOKP ? F.in[I_XP] + (size_t)m * 1024 : (m < NTOK ? F.in[I_XS] + (size_t)(m - NTOKP) * 1024 : nullptr);
            rms_row_to_bf16(xr, F.in[I_GMIX], WSP(bf16, WS_XN) + (size_t)m * 1024, LANE_); }
        else { const int mm = m - MPAD; rms_row_to_bf16(F.in[I_MEMP] + (size_t)mm * 1024, F.in[I_GMEM], WSP(bf16, WS_MN) + (size_t)mm * 1024, LANE_); }
    }
    { float* ssq = WSP(float, WS_SSQ); for (int i = F.bid * NTHR + TID_; i < MPAD; i += F.G * NTHR) ssq[i] = 0.f; }
    { const f32x4* src = (const f32x4*)F.in[I_CWIN]; f32x4* dst = (f32x4*)(F.out + O_WINS);
      for (int i = F.bid * NTHR + TID_; i < SB * 511 * 64; i += F.G * NTHR) { const int b = i / (511 * 64), r = i % (511 * 64); dst[(size_t)b * 512 * 64 + r] = src[(size_t)b * 512 * 64 + 64 + r]; } }
}

__device__ __forceinline__ void p2_token(Frame& F, int tok) {
    const int lane = LANE_; const bf16* pr = WSP(bf16, WS_PROJ) + (size_t)tok * DINP;
    const bool prompt = tok < NTOKP; const int b = tok >> 13, t = tok & (T - 1), sb = tok - NTOKP;
    float f[8];
    { unpack8(*(const u32x4*)(pr + C_Q + 8 * lane), f); float ss = 0.f;
#pragma unroll
      for (int i = 0; i < 8; ++i) ss += f[i] * f[i];
      ss += __shfl_xor(ss, 1); ss += __shfl_xor(ss, 2); ss += __shfl_xor(ss, 4);
      const float rs = rsqrtf(ss * (1.f / 64.f) + EPS) * QSCALE; const float* g = F.in[I_GNQ] + 8 * (lane & 7);
#pragma unroll
      for (int i = 0; i < 8; ++i) f[i] *= rs * g[i];
      *(u32x4*)(WSP(bf16, WS_QN) + (size_t)tok * 512 + 8 * lane) = pack8(f); }
    { unpack8(*(const u32x4*)(pr + C_KV + 8 * lane), f); float ss = 0.f;
#pragma unroll
      for (int i = 0; i < 8; ++i) ss += f[i] * f[i];
      ss += __shfl_xor(ss, 1); ss += __shfl_xor(ss, 2); ss += __shfl_xor(ss, 4);
      const int grp = lane >> 3, slot = grp >> 1, kv = grp & 1, d0 = 8 * (lane & 7);
      if (slot == 2) { const float rs = rsqrtf(ss * (1.f / 64.f) + EPS); const float* g = F.in[I_GNK] + 64 + d0;
#pragma unroll
          for (int i = 0; i < 8; ++i) f[i] *= rs * g[i]; }
      float* orow = prompt ? F.out + O_KVP + (size_t)tok * 512 + 8 * lane : F.out + O_KVS + (size_t)sb * 512 + 8 * lane;
      *(f32x4*)orow = (f32x4){f[0], f[1], f[2], f[3]}; *(f32x4*)(orow + 4) = (f32x4){f[4], f[5], f[6], f[7]};
      if (prompt) {
          if (slot == 2) *(u32x4*)(WSP(bf16, WS_KSEL) + ((size_t)(b * 2 + kv) * T + t) * 64 + d0) = pack8(f);
          if (slot == 3) { bf16* vt = WSP(bf16, WS_VSELT) + (((size_t)(b * 2 + kv) * 128 + (t >> 6)) * 64 + d0) * 64 + (t & 63);
#pragma unroll
              for (int i = 0; i < 8; ++i) vt[i * 64] = (bf16)f2bf(f[i]); }
      } else if (slot >= 2) { float* nk = WSP(float, WS_NEWKV) + ((size_t)(sb * 4 + (slot - 2)) * 2 + kv) * 64 + d0;
#pragma unroll
          for (int i = 0; i < 8; ++i) nk[i] = f[i]; }
    }
    { unpack8(*(const u32x4*)(pr + C_KV + 512 + 8 * lane), f); float ss = 0.f;
#pragma unroll
      for (int i = 0; i < 8; ++i) ss += f[i] * f[i];
      ss += __shfl_xor(ss, 1); ss += __shfl_xor(ss, 2); ss += __shfl_xor(ss, 4);
      const int grp = lane >> 3, slot = 4 + (grp >> 1), kv = grp & 1, d0 = 8 * (lane & 7);
      if (lane < 32) {
          if (slot == 4) { const float rs = rsqrtf(ss * (1.f / 64.f) + EPS); const float* g = F.in[I_GNK] + 128 + d0;
#pragma unroll
              for (int i = 0; i < 8; ++i) f[i] *= rs * g[i]; }
          if (prompt) {
              if (slot == 4) *(u32x4*)(WSP(bf16, WS_KWIN) + ((size_t)(b * 2 + kv) * T + t) * 64 + d0) = pack8(f);
              else { bf16* vt = WSP(bf16, WS_VWINT) + (((size_t)(b * 2 + kv) * 128 + (t >> 6)) * 64 + d0) * 64 + (t & 63);
#pragma unroll
                  for (int i = 0; i < 8; ++i) vt[i * 64] = (bf16)f2bf(f[i]); }
              if (t >= T - 512) { float* orow = F.out + O_WINP + ((size_t)b * 512 + (t - (T - 512))) * 256 + 8 * lane;
                  *(f32x4*)orow = (f32x4){f[0], f[1], f[2], f[3]}; *(f32x4*)(orow + 4) = (f32x4){f[4], f[5], f[6], f[7]}; }
          } else {
              float* nk = WSP(float, WS_NEWKV) + ((size_t)(sb * 4 + (slot - 2)) * 2 + kv) * 64 + d0;
#pragma unroll
              for (int i = 0; i < 8; ++i) nk[i] = f[i];
              float* orow = F.out + O_WINS + ((size_t)sb * 512 + 511) * 256 + 8 * lane;
              *(f32x4*)orow = (f32x4){f[0], f[1], f[2], f[3]}; *(f32x4*)(orow + 4) = (f32x4){f[4], f[5], f[6], f[7]};
          }
      }
    }
    if (lane < 24) WSP(float, WS_GATES)[(size_t)tok * 24 + lane] = sigmoidf_(bf2f(pr[C_G + lane]));
    { unpack8(*(const u32x4*)(pr + C_XQ + 8 * lane), f); float ss = 0.f;
#pragma unroll
      for (int i = 0; i < 8; ++i) ss += f[i] * f[i];
      ss += __shfl_xor(ss, 1); ss += __shfl_xor(ss, 2); ss += __shfl_xor(ss, 4); ss += __shfl_xor(ss, 8);
      const float rs = rsqrtf(ss * (1.f / 128.f) + EPS) * XSCALE; const float* g = F.in[I_GXQ] + 8 * (lane & 15);
#pragma unroll
      for (int i = 0; i < 8; ++i) f[i] *= rs * g[i];
      *(u32x4*)(WSP(bf16, WS_XQ) + (size_t)tok * 512 + 8 * lane) = pack8(f); }
}
__device__ __forceinline__ void p2_memrow(Frame& F, int row) {
    const int lane = LANE_, b = row >> 8, m = row & 255, head = lane >> 4, d0 = 8 * (lane & 15);
    const bf16* pr = WSP(bf16, WS_MEMPROJ) + (size_t)row * 1024; float f[8];
    { unpack8(*(const u32x4*)(pr + 8 * lane), f); float ss = 0.f;
#pragma unroll
      for (int i = 0; i < 8; ++i) ss += f[i] * f[i];
      ss += __shfl_xor(ss, 1); ss += __shfl_xor(ss, 2); ss += __shfl_xor(ss, 4); ss += __shfl_xor(ss, 8);
      const float rs = rsqrtf(ss * (1.f / 128.f) + EPS); const float* g = F.in[I_GXK] + d0;
#pragma unroll
      for (int i = 0; i < 8; ++i) f[i] *= rs * g[i];
      float* orow = F.out + O_MEMP + ((size_t)row * 2 + 0) * 512 + 8 * lane;
      *(f32x4*)orow = (f32x4){f[0], f[1], f[2], f[3]}; *(f32x4*)(orow + 4) = (f32x4){f[4], f[5], f[6], f[7]};
      *(u32x4*)(WSP(bf16, WS_KMEM) + ((size_t)(b * 4 + head) * 256 + m) * 128 + d0) = pack8(f); }
    { unpack8(*(const u32x4*)(pr + 512 + 8 * lane), f);
      float* orow = F.out + O_MEMP + ((size_t)row * 2 + 1) * 512 + 8 * lane;
      *(f32x4*)orow = (f32x4){f[0], f[1], f[2], f[3]}; *(f32x4*)(orow + 4) = (f32x4){f[4], f[5], f[6], f[7]};
      bf16* vt = WSP(bf16, WS_VMEMT) + ((size_t)(b * 4 + head) * 128 + d0) * 256 + m;
#pragma unroll
      for (int i = 0; i < 8; ++i) vt[i * 256] = (bf16)f2bf(f[i]); }
}

constexpr int CMP_TASKS_S = SB * 2 * 2, CMP_TASKS_P = NB * 2 * 2;
__device__ __forceinline__ int cmp_tile_off16(int row, int c16) { return row * 128 + ((c16 ^ (row & 7)) << 4); }
__device__ __forceinline__ void p2_compress(Frame& F, int task) {
    const int lane = LANE_, r = lane & 15, q = lane >> 4, w = F.wave, tid_ = w * 64 + lane;
    const bool smp = task < CMP_TASKS_S; const int x = smp ? task : task - CMP_TASKS_S;
    const int b = x >> 2, kv = (x >> 1) & 1, slot = x & 1, i0 = 64 * w;
    const bf16* W1t = WSP(bf16, WS_W1T) + (size_t)slot * 64 * 2048;
    const bf16* W2t = WSP(bf16, WS_W2T) + (size_t)slot * 64 * 64;
    const int* pt = (const int*)F.in[I_PT] + b * 64;
    const float* ckv = F.in[I_CKV]; const float* pe = F.in[slot ? I_CVPE : I_CKPE];
    const bf16* proj = WSP(bf16, WS_PROJ);
    LAS unsigned char* wb = F.lds;
    const int srow = tid_ >> 3, sc16 = tid_ & 7, soff = cmp_tile_off16(srow, sc16);
    int kb0[2]; kb0[0] = r * 128 + (((0 + q) ^ (r & 7)) << 4); kb0[1] = r * 128 + (((4 + q) ^ (r & 7)) << 4);
    f32x4 acc[4][4];
#pragma unroll
    for (int nt = 0; nt < 4; ++nt)
#pragma unroll
        for (int it = 0; it < 4; ++it) acc[nt][it] = (f32x4){0.f, 0.f, 0.f, 0.f};
    const bf16* wsrc = W1t + (size_t)srow * 2048 + sc16 * 8;
    u32x4 rw = *(const u32x4*)wsrc;
    __syncthreads();
#pragma unroll 1
    for (int kp = 0; kp < 32; ++kp) {
        bf16x8 xf[2][4];
#pragma unroll
        for (int it = 0; it < 4; ++it) { int tok = 16 * (i0 + 16 * it + r) + kp; tok = tok < T ? tok : T - 1;
#pragma unroll
            for (int ks2 = 0; ks2 < 2; ++ks2) { const int d = 32 * ks2 + 8 * q;
                f32x4 a0, a1;
                if (smp) { const float* src = ckv + (((size_t)pt[tok >> 7] * 128 + (tok & 127)) * 4 + slot) * 128 + kv * 64 + d; a0 = *(const f32x4*)src; a1 = *(const f32x4*)(src + 4); }
                else { float f8[8]; unpack8(*(const u32x4*)(proj + ((size_t)b * T + tok) * DINP + C_KV + slot * 128 + kv * 64 + d), f8); a0 = (f32x4){f8[0], f8[1], f8[2], f8[3]}; a1 = (f32x4){f8[4], f8[5], f8[6], f8[7]}; }
                const f32x4 p0 = *(const f32x4*)(pe + 64 * kp + d), p1 = *(const f32x4*)(pe + 64 * kp + d + 4);
                xf[ks2][it] = frag_pk(a0 + p0, a1 + p1); } }
        *(LAS u32x4*)(wb + (kp & 1) * 8192 + soff) = rw;
        __syncthreads();
        if (kp + 1 < 32) rw = *(const u32x4*)(wsrc + 64 * (kp + 1));
        LAS const unsigned char* wt = wb + (kp & 1) * 8192;
#pragma unroll
        for (int ks2 = 0; ks2 < 2; ++ks2)
#pragma unroll
            for (int nt = 0; nt < 4; ++nt) { const bf16x8 a = as_frag(*(LAS const u32x4*)(wt + kb0[ks2] + nt * 2048));
#pragma unroll
                for (int it = 0; it < 4; ++it) acc[nt][it] = MFMA16(a, xf[ks2][it], acc[nt][it]); }
    }
    const float* gk0 = F.in[I_GNK];
#pragma unroll
    for (int it = 0; it < 4; ++it) {
        f32x4 g[4];
#pragma unroll
        for (int nt = 0; nt < 4; ++nt)
#pragma unroll
            for (int i = 0; i < 4; ++i) g[nt][i] = gelu_tanh(acc[nt][it][i]);
        const bf16x8 b0 = frag_pk(g[0], g[1]), b1 = frag_pk(g[2], g[3]);
        f32x4 o[4]; float ss = 0.f;
#pragma unroll
        for (int mt = 0; mt < 4; ++mt) { const bf16* wr = W2t + (size_t)(16 * mt + r) * 64 + 4 * q;
            o[mt] = MFMA16(ldfrag2(wr, wr + 16), b0, ((f32x4){0.f, 0.f, 0.f, 0.f}));
            o[mt] = MFMA16(ldfrag2(wr + 32, wr + 48), b1, o[mt]);
            ss += (o[mt][0] * o[mt][0] + o[mt][1] * o[mt][1]) + (o[mt][2] * o[mt][2] + o[mt][3] * o[mt][3]); }
        ss += __shfl_xor(ss, 16); ss += __shfl_xor(ss, 32);
        if (slot == 0) { const float rs = rsqrtf(ss * (1.f / 64.f) + EPS);
#pragma unroll
            for (int mt = 0; mt < 4; ++mt) { const f32x4 gg = *(const f32x4*)(gk0 + 16 * mt + 4 * q); o[mt] = o[mt] * rs * gg; } }
        const int i = i0 + 16 * it + r;
        if (smp) { float* dst = WSP(float, slot ? WS_VCMPS : WS_KCMPS) + ((size_t)(b * 2 + kv) * 512 + i) * 64 + 4 * q;
#pragma unroll
            for (int mt = 0; mt < 4; ++mt) *(f32x4*)(dst + 16 * mt) = o[mt]; }
        else if (slot == 0) { bf16* dst = WSP(bf16, WS_KCMP) + ((size_t)(b * 2 + kv) * 512 + i) * 64 + 4 * q;
#pragma unroll
            for (int mt = 0; mt < 4; ++mt) { u32x2 wv; wv.x = pk2(o[mt][0], o[mt][1]); wv.y = pk2(o[mt][2], o[mt][3]); *(u32x2*)(dst + 16 * mt) = wv; } }
        else { bf16* dst = WSP(bf16, WS_VCMPT) + ((size_t)(b * 2 + kv) * 64 + 4 * q) * 512 + i;
#pragma unroll
            for (int mt = 0; mt < 4; ++mt)
#pragma unroll
                for (int e = 0; e < 4; ++e) dst[(size_t)(16 * mt + e) * 512] = (bf16)f2bf(o[mt][e]); }
    }
}

__device__ __forceinline__ int swz64(int row, int col) { return row * 64 + ((((col >> 3) ^ (row & 7)) << 3) | (col & 7)); }
__device__ __forceinline__ float log_sigmoid_(float z) { return fminf(z, 0.f) - log1pf(__expf(-fabsf(z))); }
__device__ __forceinline__ void p2_gla_chunk(Frame& F, int bc) {
    const int lane = LANE_, r = lane & 15, q = lane >> 4, h = F.wave >> 1, eh = F.wave & 1;
    LAS bf16* ktT = (LAS bf16*)(F.lds + F.wave * 16384);
    LAS bf16* vT = ktT + 4096;
    const bf16* proj = WSP(bf16, WS_PROJ) + (size_t)bc * 64 * DINP;
    float wg[16];
#pragma unroll
    for (int j = 0; j < 16; ++j) wg[j] = F.in[I_WGG][j * 256 + h * 64 + lane];
    const float bg = F.in[I_BGG][h * 64 + lane];
    bf16* qtg = WSP(bf16, WS_QTG) + (size_t)bc * 64 * 256 + h * 64 + lane;
    bf16* ktg = WSP(bf16, WS_KTG) + (size_t)bc * 64 * 256 + h * 64 + lane;
    bf16* vtg = WSP(bf16, WS_VTG) + ((size_t)(bc * 4 + h) * 128 + eh * 64 + lane) * 64;
    LAS float* lrs = (LAS float*)(F.lds + RING_BYTES);
    { const int tid_ = F.wave * 64 + lane; if (tid_ < 128) { float f8[8]; unpack8(*(const u32x4*)(proj + (size_t)(tid_ >> 1) * DINP + C_LR + 8 * (tid_ & 1)), f8);
#pragma unroll
        for (int i = 0; i < 8; ++i) lrs[(tid_ >> 1) * 16 + 8 * (tid_ & 1) + i] = f8[i]; } }
    __syncthreads();
    float cb = 0.f;
    bf16 kr[2][16], qr[2][16], vr[2][16];
#pragma unroll
    for (int i = 0; i < 16; ++i) { const bf16* pr = proj + (size_t)i * DINP; kr[0][i] = pr[C_GK + h * 64 + lane]; qr[0][i] = pr[C_GQ + h * 64 + lane]; vr[0][i] = pr[C_GV + h * 128 + eh * 64 + lane]; }
#pragma unroll
    for (int tb = 0; tb < 4; ++tb) {
        if (tb < 3) {
#pragma unroll
            for (int i = 0; i < 16; ++i) { const bf16* pr = proj + (size_t)(16 * (tb + 1) + i) * DINP; kr[(tb + 1) & 1][i] = pr[C_GK + h * 64 + lane]; qr[(tb + 1) & 1][i] = pr[C_GQ + h * 64 + lane]; vr[(tb + 1) & 1][i] = pr[C_GV + h * 128 + eh * 64 + lane]; } }
#pragma unroll
        for (int i = 0; i < 16; ++i) { const int t = 16 * tb + i;
            float z = bg;
#pragma unroll
            for (int j4 = 0; j4 < 4; ++j4) { const f32x4 l4 = *(LAS const f32x4*)(lrs + t * 16 + 4 * j4); z += l4[0] * wg[4 * j4] + l4[1] * wg[4 * j4 + 1] + l4[2] * wg[4 * j4 + 2] + l4[3] * wg[4 * j4 + 3]; }
            cb += log_sigmoid_(z) * 0.0625f;
            const float kk = bf2f(kr[tb & 1][i]) * __expf(-cb);
            const float qq = bf2f(qr[tb & 1][i]) * 0.125f * __expf(cb);
            const bf16 kb = (bf16)f2bf(kk);
            if (eh == 0) { qtg[(size_t)t * 256] = (bf16)f2bf(qq); ktg[(size_t)t * 256] = kb; }
            ktT[swz64(lane, t)] = kb;
            const bf16 vv = vr[tb & 1][i];
            vT[swz64(lane, t)] = vv; vtg[t] = vv; }
    }
    const float dec = __expf(cb);
    if (eh == 0) WSP(float, WS_DEC)[(size_t)(bc * 4 + h) * 64 + lane] = dec;
    asm volatile("s_waitcnt lgkmcnt(0)" ::: "memory");
    f32x4 acc[4][4];
#pragma unroll
    for (int et = 0; et < 4; ++et)
#pragma unroll
        for (int dt = 0; dt < 4; ++dt) acc[et][dt] = (f32x4){0.f, 0.f, 0.f, 0.f};
#pragma unroll
    for (int ks = 0; ks < 2; ++ks) {
        bf16x8 bfr[4];
#pragma unroll
        for (int dt = 0; dt < 4; ++dt) bfr[dt] = as_frag(*(const LAS u32x4*)(ktT + swz64(16 * dt + r, 32 * ks + 8 * q)));
#pragma unroll
        for (int et = 0; et < 4; ++et) { const bf16x8 a = as_frag(*(const LAS u32x4*)(vT + swz64(16 * et + r, 32 * ks + 8 * q)));
#pragma unroll
            for (int dt = 0; dt < 4; ++dt) acc[et][dt] = MFMA16(a, bfr[dt], acc[et][dt]); }
    }
    float* up = WSP(float, WS_UP) + ((size_t)(bc * 4 + h) * 128 + eh * 64) * 64;
#pragma unroll
    for (int dt = 0; dt < 4; ++dt) { const float dd = __shfl(dec, 16 * dt + r);
#pragma unroll
        for (int et = 0; et < 4; ++et)
#pragma unroll
            for (int i = 0; i < 4; ++i) up[(size_t)(16 * et + 4 * q + i) * 64 + 16 * dt + r] = acc[et][dt][i] * dd; }
}

__device__ __forceinline__ void p2_gla_sample(Frame& F, int task) {
    const int lane = LANE_, b = task >> 2, h = task & 3, tok = NTOKP + b;
    const bf16* pr = WSP(bf16, WS_PROJ) + (size_t)tok * DINP;
    LAS float* sh = (LAS float*)(F.lds + F.wave * 16384);
    { float z = F.in[I_BGG][h * 64 + lane];
#pragma unroll
      for (int j = 0; j < 16; ++j) z += bf2f(pr[C_LR + j]) * F.in[I_WGG][j * 256 + h * 64 + lane];
      sh[lane] = __expf(log_sigmoid_(z) * 0.0625f); sh[64 + lane] = bf2f(pr[C_GK + h * 64 + lane]); sh[128 + lane] = bf2f(pr[C_GQ + h * 64 + lane]) * 0.125f; }
    asm volatile("s_waitcnt lgkmcnt(0)" ::: "memory");
    const float v0 = bf2f(pr[C_GV + h * 128 + lane]), v1 = bf2f(pr[C_GV + h * 128 + 64 + lane]);
    const float* s0 = F.in[I_SGLA] + (size_t)(b * 4 + h) * 64 * 128; float* s1 = F.out + O_GLAS + (size_t)(b * 4 + h) * 64 * 128;
    float o0 = 0.f, o1 = 0.f;
#pragma unroll 4
    for (int d = 0; d < 64; ++d) { const float a = sh[d], k = sh[64 + d], qq = sh[128 + d];
        const float n0 = a * s0[d * 128 + lane] + k * v0, n1 = a * s0[d * 128 + 64 + lane] + k * v1;
        s1[d * 128 + lane] = n0; s1[d * 128 + 64 + lane] = n1; o0 += qq * n0; o1 += qq * n1; }
    const float rs = rsqrtf(wave_sum(o0 * o0 + o1 * o1) * (1.f / 128.f) + EPS);
    const float r0 = bf2f(pr[C_GR + h * 128 + lane]), r1 = bf2f(pr[C_GR + h * 128 + 64 + lane]);
    bf16* og = WSP(bf16, WS_OGLA) + (size_t)tok * 512 + h * 128;
    og[lane] = (bf16)f2bf(o0 * rs * F.in[I_GGO][lane] * r0 * sigmoidf_(r0));
    og[64 + lane] = (bf16)f2bf(o1 * rs * F.in[I_GGO][64 + lane] * r1 * sigmoidf_(r1));
}

__device__ __forceinline__ void p3_gla_scan(Frame& F, int task) {
    const int lane = LANE_, b = task >> 9, h = (task >> 7) & 3, e = task & 127;
    const float* up = WSP(float, WS_UP); const float* dec = WSP(float, WS_DEC); bf16* sc = WSP(bf16, WS_SC);
    float S = 0.f;
#pragma unroll 8
    for (int c = 0; c < 128; ++c) { const int bc = b * 128 + c; const size_t idx = ((size_t)(bc * 4 + h) * 128 + e) * 64 + lane;
        sc[idx] = (bf16)f2bf(S); S = dec[(size_t)(bc * 4 + h) * 64 + lane] * S + up[idx]; }
    F.out[O_GLAP + ((size_t)(b * 4 + h) * 64 + lane) * 128 + e] = S;
}

__device__ __forceinline__ void p4_gla_out(Frame& F, int task) {
    const int lane = LANE_, r = lane & 15, q = lane >> 4, bc = task >> 4, h = (task >> 2) & 3, tt = task & 3;
    const bf16* qtg = WSP(bf16, WS_QTG) + (size_t)bc * 64 * 256 + h * 64;
    const bf16* ktg = WSP(bf16, WS_KTG) + (size_t)bc * 64 * 256 + h * 64;
    const bf16* vtg = WSP(bf16, WS_VTG) + (size_t)(bc * 4 + h) * 128 * 64;
    const bf16* sc = WSP(bf16, WS_SC) + (size_t)(bc * 4 + h) * 128 * 64;
    const bf16* proj = WSP(bf16, WS_PROJ) + (size_t)bc * 64 * DINP;
    bf16* og = WSP(bf16, WS_OGLA) + (size_t)bc * 64 * 512 + h * 128;
    const float* ggo = F.in[I_GGO];
    {
        bf16x8 qf[2];
#pragma unroll
        for (int ks = 0; ks < 2; ++ks) qf[ks] = ldfrag(qtg + (size_t)(16 * tt + r) * 256 + 32 * ks + 8 * q);
        f32x4 sT[4];
#pragma unroll
        for (int st = 0; st < 4; ++st) { sT[st] = (f32x4){0.f, 0.f, 0.f, 0.f};
            if (st <= tt) {
#pragma unroll
                for (int ks = 0; ks < 2; ++ks) sT[st] = MFMA16(ldfrag(ktg + (size_t)(16 * st + r) * 256 + 32 * ks + 8 * q), qf[ks], sT[st]);
                if (st == tt) {
#pragma unroll
                    for (int i = 0; i < 4; ++i) if (4 * q + i > r) sT[st][i] = 0.f; } } }
        const bf16x8 p01 = frag_pk(sT[0], sT[1]), p23 = frag_pk(sT[2], sT[3]);
        f32x4 acc[8]; float ss = 0.f;
#pragma unroll
        for (int et = 0; et < 8; ++et) { acc[et] = (f32x4){0.f, 0.f, 0.f, 0.f};
            const bf16* srow = sc + (size_t)(16 * et + r) * 64 + 8 * q;
            acc[et] = MFMA16(ldfrag(srow), qf[0], acc[et]); acc[et] = MFMA16(ldfrag(srow + 32), qf[1], acc[et]);
            const bf16* vrow = vtg + (size_t)(16 * et + r) * 64 + 4 * q;
            acc[et] = MFMA16(ldfrag2(vrow, vrow + 16), p01, acc[et]);
            if (tt >= 2) acc[et] = MFMA16(ldfrag2(vrow + 32, vrow + 48), p23, acc[et]);
            ss += (acc[et][0] * acc[et][0] + acc[et][1] * acc[et][1]) + (acc[et][2] * acc[et][2] + acc[et][3] * acc[et][3]); }
        ss += __shfl_xor(ss, 16); ss += __shfl_xor(ss, 32);
        const float rs = rsqrtf(ss * (1.f / 128.f) + EPS);
        const bf16* pr = proj + (size_t)(16 * tt + r) * DINP + C_GR + h * 128 + 4 * q;
        bf16* orow = og + (size_t)(16 * tt + r) * 512 + 4 * q;
#pragma unroll
        for (int et = 0; et < 8; ++et) { const u32x2 rw = *(const u32x2*)(pr + 16 * et); const f32x4 gg = *(const f32x4*)(ggo + 16 * et + 4 * q);
            const float r0 = bflo(rw.x), r1 = bfhi(rw.x), r2 = bflo(rw.y), r3 = bfhi(rw.y);
            u32x2 w; w.x = pk2(acc[et][0] * rs * gg[0] * r0 * sigmoidf_(r0), acc[et][1] * rs * gg[1] * r1 * sigmoidf_(r1));
            w.y = pk2(acc[et][2] * rs * gg[2] * r2 * sigmoidf_(r2), acc[et][3] * rs * gg[3] * r3 * sigmoidf_(r3));
            *(u32x2*)(orow + 16 * et) = w; }
    }
}

__device__ __forceinline__ void p3_xatt(Frame& F, int n, float mb) {
    const int lane = LANE_, r = lane & 15, q = lane >> 4, w = F.wave, tid_ = w * 64 + lane;
    const int b = n >> 7, h = (n >> 5) & 3, chunk = n & 31;
    const bf16* km = WSP(bf16, WS_KMEM) + (size_t)(b * 4 + h) * 256 * 128;
    const bf16* vm = WSP(bf16, WS_VMEMT) + (size_t)(b * 4 + h) * 128 * 256;
    LAS unsigned char* kl = F.lds; LAS unsigned char* vl = F.lds + 65536;
    __syncthreads();
    { u32x4 gk[8], gv[8];
#pragma unroll
      for (int i = 0; i < 8; ++i) { gk[i] = *(const u32x4*)(km + (size_t)(i * 512 + tid_) * 8); gv[i] = *(const u32x4*)(vm + (size_t)(i * 512 + tid_) * 8); }
#pragma unroll
      for (int i = 0; i < 8; ++i) { const int id = i * 512 + tid_;
          *(LAS u32x4*)(kl + (id >> 4) * 256 + ((((id & 15) ^ ((id >> 4) & 15))) << 4)) = gk[i];
          *(LAS u32x4*)(vl + (id >> 5) * 512 + ((((id & 31) ^ ((id >> 5) & 15))) << 4)) = gv[i]; } }
    __syncthreads();
    int kb4[4];
#pragma unroll
    for (int ks = 0; ks < 4; ++ks) kb4[ks] = r * 256 + (((4 * ks + q) ^ r) << 4);
#pragma unroll 1
    for (int tile = 0; tile < 2; ++tile) {
        const int tok0 = b * T + chunk * 256 + w * 32 + tile * 16;
        const bf16* xq = WSP(bf16, WS_XQ) + (size_t)(tok0 + r) * 512 + h * 128 + 8 * q;
        bf16x8 qf[4];
#pragma unroll
        for (int ks = 0; ks < 4; ++ks) qf[ks] = ldfrag(xq + 32 * ks);
        f32x4 o[8]; float l = 0.f;
#pragma unroll
        for (int dt = 0; dt < 8; ++dt) o[dt] = (f32x4){0.f, 0.f, 0.f, 0.f};
#pragma unroll 2
        for (int kk = 0; kk < 8; ++kk) {
            f32x4 p[2];
#pragma unroll
            for (int a = 0; a < 2; ++a) { p[a] = (f32x4){0.f, 0.f, 0.f, 0.f};
#pragma unroll
                for (int ks = 0; ks < 4; ++ks) p[a] = MFMA16(as_frag(*(LAS const u32x4*)(kl + kb4[ks] + (2 * kk + a) * 4096)), qf[ks], p[a]);
#pragma unroll
                for (int i = 0; i < 4; ++i) { p[a][i] = __builtin_amdgcn_exp2f(p[a][i] - mb); l += p[a][i]; } }
            const bf16x8 pf = frag_pk(p[0], p[1]);
            const int v0 = r * 512 + (((4 * kk + (q >> 1)) ^ r) << 4) + 8 * (q & 1), v1 = r * 512 + (((4 * kk + 2 + (q >> 1)) ^ r) << 4) + 8 * (q & 1);
#pragma unroll
            for (int dt = 0; dt < 8; ++dt) { const u32x2 x0 = *(LAS const u32x2*)(vl + v0 + dt * 8192), x1 = *(LAS const u32x2*)(vl + v1 + dt * 8192);
                u32x4 wv; wv.x = x0.x; wv.y = x0.y; wv.z = x1.x; wv.w = x1.y; o[dt] = MFMA16(as_frag(wv), pf, o[dt]); }
        }
        l += __shfl_xor(l, 16); l += __shfl_xor(l, 32);
        const float inv = 1.f / l;
        bf16* ox = WSP(bf16, WS_OX) + (size_t)(tok0 + r) * 512 + h * 128 + 4 * q;
#pragma unroll
        for (int dt = 0; dt < 8; ++dt) { u32x2 wv; wv.x = pk2(o[dt][0] * inv, o[dt][1] * inv); wv.y = pk2(o[dt][2] * inv, o[dt][3] * inv); *(u32x2*)(ox + 16 * dt) = wv; }
    }
}
__device__ __forceinline__ void p3_xatt_sample(Frame& F, int task) {
    const int lane = LANE_, b = task >> 2, h = task & 3, tok = NTOKP + b;
    LAS float* sh = (LAS float*)(F.lds + F.wave * 16384);
    const bf16* xq = WSP(bf16, WS_XQ) + (size_t)tok * 512 + h * 128;
    sh[lane] = bf2f(xq[lane]); sh[64 + lane] = bf2f(xq[64 + lane]);
    asm volatile("s_waitcnt lgkmcnt(0)" ::: "memory");
    const float* cm = F.in[I_CMEM] + (size_t)b * 256 * 1024 + h * 128;
    float s[4] = {0.f, 0.f, 0.f, 0.f};
    for (int d = 0; d < 128; d += 4) { const f32x4 qv = *(const LAS f32x4*)(sh + d);
#pragma unroll
        for (int k = 0; k < 4; ++k) { const f32x4 kv = *(const f32x4*)(cm + (size_t)(lane + 64 * k) * 1024 + d); s[k] += (qv[0] * kv[0] + qv[1] * kv[1]) + (qv[2] * kv[2] + qv[3] * kv[3]); } }
    const float m = wave_max(fmaxf(fmaxf(s[0], s[1]), fmaxf(s[2], s[3])));
    float l = 0.f;
#pragma unroll
    for (int k = 0; k < 4; ++k) { const float e = __builtin_amdgcn_exp2f(s[k] - m); sh[128 + lane + 64 * k] = e; l += e; }
    l = wave_sum(l);
    asm volatile("s_waitcnt lgkmcnt(0)" ::: "memory");
    float o0 = 0.f, o1 = 0.f; const float* vv = cm + 512;
#pragma unroll 4
    for (int mm = 0; mm < 256; ++mm) { const float p = sh[128 + mm]; o0 += p * vv[(size_t)mm * 1024 + lane]; o1 += p * vv[(size_t)mm * 1024 + 64 + lane]; }
    const float inv = 1.f / l;
    bf16* ox = WSP(bf16, WS_OX) + (size_t)tok * 512 + h * 128;
    ox[lane] = (bf16)f2bf(o0 * inv); ox[64 + lane] = (bf16)f2bf(o1 * inv);
}

constexpr int NL_Q = 0;
constexpr int NL_U = 16384;
constexpr int NL_OS = 81920;
constexpr int NL_TB = 16384;
constexpr int NL_SEL = 147456;
constexpr int NL_BKT = 147968;
constexpr int NL_BIAS = 148496;
constexpr int NL_LINV = 149520;
constexpr int NL_END = 150032;
static_assert(NL_END <= LDS_BYTES, "NSA LDS map");

__device__ __forceinline__ void nsa_tables(Frame& F) {
    LAS int* bkt = (LAS int*)(F.lds + NL_BKT); LAS float* bl = (LAS float*)(F.lds + NL_BIAS);
    if (TID_ < 129) bkt[TID_] = t5_bucket(TID_);
    if (TID_ < 256) bl[TID_] = F.in[I_RB][TID_] * LOG2E;
    __syncthreads();
}
__device__ __forceinline__ float nsa_bound(Frame& F) {
    const float gq = absmax_arr(F.in[I_GNQ], 64, LANE_), gk = absmax_arr(F.in[I_GNK], 192, LANE_), bm = absmax_arr(F.in[I_RB], 256, LANE_);
    return (8.0f * gq * gk * 1.02f + bm) * LOG2E;
}
__device__ __forceinline__ unsigned fkey(float x) { const unsigned u = __float_as_uint(x); return (u & 0x80000000u) ? ~u : (u | 0x80000000u); }

__device__ __forceinline__ int tile_off16(int row, int c16) { return row * 128 + ((c16 ^ (row & 7)) << 4); }
struct TileAddr { int kb[2]; int vb[2][2]; };
__device__ __forceinline__ TileAddr tile_addr(int r, int q) { TileAddr a;
    for (int ks = 0; ks < 2; ++ks) a.kb[ks] = r * 128 + (((4 * ks + q) ^ (r & 7)) << 4);
    for (int s = 0; s < 2; ++s) for (int pc = 0; pc < 2; ++pc) a.vb[s][pc] = r * 128 + (((4 * s + 2 * pc + (q >> 1)) ^ (r & 7)) << 4) + 8 * (q & 1);
    return a; }
__device__ __forceinline__ bf16x8 tile_kfrag(LAS const unsigned char* kb, const TileAddr& ta, int kt, int ks) { return as_frag(*(LAS const u32x4*)(kb + ta.kb[ks] + kt * 2048)); }
__device__ __forceinline__ bf16x8 tile_vfrag(LAS const unsigned char* vb, const TileAddr& ta, int dt, int s) {
    const u32x2 a = *(LAS const u32x2*)(vb + ta.vb[s][0] + dt * 2048), b = *(LAS const u32x2*)(vb + ta.vb[s][1] + dt * 2048);
    u32x4 w; w.x = a.x; w.y = a.y; w.z = b.x; w.w = b.y; return as_frag(w); }

#define OPAQUE_V(x) asm volatile("" : "+v"(x))
__device__ __forceinline__ void p3_nsa_prompt(Frame& F, int n, float mb, int dbg) {
    int lane0 = LANE_; OPAQUE_V(lane0);
    const int lane = lane0, r = lane & 15, q = lane >> 4, w = F.wave;
    const int combo = n >> 8, idx = n & 255, ti = (combo & 1) ? 255 - idx : idx;
    const int b = combo >> 1, kv = combo & 1, t0 = 32 * ti, bk = b * 2 + kv;
    LAS bf16* Qs = (LAS bf16*)(F.lds + NL_Q); LAS float* U = (LAS float*)(F.lds + NL_U) + w * 2048; LAS unsigned* selm = (LAS unsigned*)(F.lds + NL_SEL);
    LAS const int* bkt = (LAS const int*)(F.lds + NL_BKT); LAS const float* bl = (LAS const float*)(F.lds + NL_BIAS); LAS float* linv = (LAS float*)(F.lds + NL_LINV) + w * 16;
    LAS unsigned char* stA = F.lds + NL_OS;
    LAS unsigned char* stC = F.lds + NL_U;
    LAS unsigned char* stB = F.lds + NL_TB + w * 16384;
    const int tid_ = w * 64 + lane, srow = tid_ >> 3, sc16 = tid_ & 7, soff = tile_off16(srow, sc16);
    const TileAddr ta = tile_addr(r, q);
    __syncthreads();
    { const int tk = TID_ >> 4, ch = TID_ & 15; const bf16* src = WSP(bf16, WS_QN) + (size_t)(b * T + t0 + tk) * 512 + kv * 256 + ch * 16;
      const u32x4 a0 = *(const u32x4*)src, a1 = *(const u32x4*)(src + 8);
      *(LAS u32x4*)(Qs + tk * 256 + ch * 16) = a0; *(LAS u32x4*)(Qs + tk * 256 + ch * 16 + 8) = a1;
      if (TID_ < 128) selm[TID_] = 0u; }
    __syncthreads();
    const int tw = t0 + 4 * w, tr = tw + (r >> 2), h = kv * 4 + (r & 3);
    bf16x8 qf[2];
#pragma unroll
    for (int ks = 0; ks < 2; ++ks) qf[ks] = as_frag(*(LAS const u32x4*)(Qs + (16 * w + r) * 64 + 32 * ks + 8 * q));
    int ncvb = (t0 + 31 - 31) / 16 + 1; ncvb = ncvb < 511 ? ncvb : 511;
    const int nst = (ncvb + 63) >> 6;
    const int tlast = tw + 3; int ncv = tlast >= 31 ? (tlast - 31) / 16 + 1 : 0; ncv = ncv < 511 ? ncv : 511;
    const int nstw = (ncv + 63) >> 6;
    f32x4 oc[4]; float lc = 0.f, carry = 0.f;
#pragma unroll
    for (int dt = 0; dt < 4; ++dt) oc[dt] = (f32x4){0.f, 0.f, 0.f, 0.f};
    {
        const bf16* kc = WSP(bf16, WS_KCMP) + (size_t)bk * 512 * 64 + srow * 64 + sc16 * 8; const bf16* vc = WSP(bf16, WS_VCMPT) + (size_t)bk * 64 * 512 + srow * 512 + sc16 * 8;
        const int nst2 = (nst + 1) >> 1;
        u32x4 rk0 = *(const u32x4*)kc, rv0 = *(const u32x4*)vc, rk1 = *(const u32x4*)(kc + 4096), rv1 = *(const u32x4*)(vc + 64);
#pragma unroll 1
        for (int s2 = 0; s2 < nst2; ++s2) {
            LAS unsigned char* bb = stA + (s2 & 1) * 32768;
            *(LAS u32x4*)(bb + soff) = rk0; *(LAS u32x4*)(bb + 8192 + soff) = rv0; *(LAS u32x4*)(bb + 16384 + soff) = rk1; *(LAS u32x4*)(bb + 24576 + soff) = rv1;
            __syncthreads();
            if (s2 + 1 < nst2) { rk0 = *(const u32x4*)(kc + (size_t)(2 * s2 + 2) * 4096); rv0 = *(const u32x4*)(vc + (2 * s2 + 2) * 64);
                                 rk1 = *(const u32x4*)(kc + (size_t)(2 * s2 + 3) * 4096); rv1 = *(const u32x4*)(vc + (2 * s2 + 3) * 64); }
#pragma unroll
            for (int sub = 0; sub < 2; ++sub) { const int st = 2 * s2 + sub; LAS unsigned char* kb = bb + sub * 16384; LAS unsigned char* vb = kb + 8192;
            if (st < nstw && !(dbg & 1)) {
                f32x4 p[4];
#pragma unroll
                for (int kt = 0; kt < 4; ++kt) { const int tile = 4 * st + kt; p[kt] = (f32x4){0.f, 0.f, 0.f, 0.f};
                    p[kt] = MFMA16(tile_kfrag(kb, ta, kt, 0), qf[0], p[kt]); p[kt] = MFMA16(tile_kfrag(kb, ta, kt, 1), qf[1], p[kt]);
                    float G = 0.f;
#pragma unroll
                    for (int i = 0; i < 4; ++i) { const int c = 16 * tile + 4 * q + i, rel = tr - (16 * c + 31); const bool ok = rel >= 0 && c < 511;
                        const int rc = rel < 0 ? 0 : (rel > 128 ? 128 : rel);
                        const float e = ok ? __builtin_amdgcn_exp2f(p[kt][i] + bl[bkt[rc] * 8 + h] - mb) : 0.f; p[kt][i] = e; G += e; }
                    const float send = (q == 3) ? carry : p[kt][3]; const float prev = __shfl(send, (lane + 48) & 63); carry = p[kt][3];
                    U[r * 128 + 4 * tile + q] = G + prev; lc += G; }
                const bf16x8 pf0 = frag_pk(p[0], p[1]), pf1 = frag_pk(p[2], p[3]);
#pragma unroll
                for (int dt = 0; dt < 4; ++dt) { oc[dt] = MFMA16(tile_vfrag(vb, ta, dt, 0), pf0, oc[dt]); oc[dt] = MFMA16(tile_vfrag(vb, ta, dt, 1), pf1, oc[dt]); }
            } }
        }
    }
    lc += __shfl_xor(lc, 16); lc += __shfl_xor(lc, 32);
    const float lcinv = lc > 0.f ? 1.f / lc : 0.f;
    if (q == 0) linv[r] = lcinv;
    asm volatile("s_waitcnt lgkmcnt(0)" ::: "memory");
    if (!(dbg & 8)) {
        const int tk = lane >> 4, jr = lane & 15, t = tw + tk, tblk = t >> 6, jlim = 16 * nstw;
        const float li0 = linv[4 * tk], li1 = linv[4 * tk + 1], li2 = linv[4 * tk + 2], li3 = linv[4 * tk + 3];
        unsigned key[8];
#pragma unroll
        for (int m = 0; m < 8; ++m) { const int j = jr + 16 * m; float v = 0.f;
            if (j < jlim) v = U[(4 * tk) * 128 + j] * li0 + U[(4 * tk + 1) * 128 + j] * li1 + U[(4 * tk + 2) * 128 + j] * li2 + U[(4 * tk + 3) * 128 + j] * li3;
            const bool forced = (j == 0) || (j == tblk) || (j == tblk - 1);
            const float sc = (j <= tblk) ? v + (forced ? 1e4f : 0.f) : -1e30f;
            key[m] = fkey(sc); }
        unsigned pre = 0u;
#pragma unroll 1
        for (int bit = 31; bit >= 0; --bit) { const unsigned cand = pre | (1u << bit); int cnt = 0;
#pragma unroll
            for (int m = 0; m < 8; ++m) cnt += key[m] >= cand ? 1 : 0;
            cnt += __shfl_xor(cnt, 1); cnt += __shfl_xor(cnt, 2); cnt += __shfl_xor(cnt, 4); cnt += __shfl_xor(cnt, 8);
            if (cnt >= 16) pre = cand; }
        int ngt = 0;
#pragma unroll
        for (int m = 0; m < 8; ++m) ngt += key[m] > pre ? 1 : 0;
        ngt += __shfl_xor(ngt, 1); ngt += __shfl_xor(ngt, 2); ngt += __shfl_xor(ngt, 4); ngt += __shfl_xor(ngt, 8);
        const int need = 16 - ngt; int run = 0; const unsigned kinv = fkey(-1e30f);
#pragma unroll
        for (int m = 0; m < 8; ++m) { const bool tie = key[m] == pre; const unsigned long long bal = __ballot(tie);
            const unsigned grp = (unsigned)(bal >> (16 * tk)) & 0xffffu; const int rank = __popc(grp & ((1u << jr) - 1u));
            const bool sel = (key[m] > pre || (tie && run + rank < need)) && key[m] > kinv;
            run += __popc(grp);
            if (sel) atomicOr((unsigned*)(selm + jr + 16 * m), 1u << (4 * w + tk)); }
    }
    __syncthreads();
    f32x4 ow[4]; float lw = 0.f;
#pragma unroll
    for (int dt = 0; dt < 4; ++dt) ow[dt] = (f32x4){0.f, 0.f, 0.f, 0.f};
    {
        int lc_ = lane0; OPAQUE_V(lc_); const int lane = lc_, r = lane & 15, q = lane >> 4, tr = tw + (r >> 2), h = kv * 4 + (r & 3); const TileAddr ta = tile_addr(r, q);
        const int tid_ = w * 64 + lane, srow = tid_ >> 3, sc16 = tid_ & 7, soff = tile_off16(srow, sc16);
        const int jlob = (t0 - 511 > 0 ? t0 - 511 : 0) >> 6, jhib = (t0 + 31) >> 6, nstc = jhib - jlob + 1;
        const int jlo = (tw - 511 > 0 ? tw - 511 : 0) >> 6, jhi = (tw + 3) >> 6;
        const bf16* kwin = WSP(bf16, WS_KWIN) + (size_t)bk * T * 64 + srow * 64 + sc16 * 8; const bf16* vwin = WSP(bf16, WS_VWINT) + (size_t)bk * 128 * 4096 + srow * 64 + sc16 * 8;
        const int nstc2 = (nstc + 1) >> 1;
        u32x4 rk0 = *(const u32x4*)(kwin + (size_t)jlob * 4096), rv0 = *(const u32x4*)(vwin + (size_t)jlob * 4096), rk1 = *(const u32x4*)(kwin + (size_t)(jlob + 1) * 4096), rv1 = *(const u32x4*)(vwin + (size_t)(jlob + 1) * 4096);
#pragma unroll 1
        for (int s2 = 0; s2 < nstc2; ++s2) { const int j0 = jlob + 2 * s2;
            LAS unsigned char* bb = stC + (s2 & 1) * 32768;
            *(LAS u32x4*)(bb + soff) = rk0; *(LAS u32x4*)(bb + 8192 + soff) = rv0; *(LAS u32x4*)(bb + 16384 + soff) = rk1; *(LAS u32x4*)(bb + 24576 + soff) = rv1;
            __syncthreads();
            if (s2 + 1 < nstc2) { rk0 = *(const u32x4*)(kwin + (size_t)(j0 + 2) * 4096); rv0 = *(const u32x4*)(vwin + (size_t)(j0 + 2) * 4096);
                                  rk1 = *(const u32x4*)(kwin + (size_t)(j0 + 3) * 4096); rv1 = *(const u32x4*)(vwin + (size_t)(j0 + 3) * 4096); }
#pragma unroll
            for (int sub = 0; sub < 2; ++sub) { const int j = j0 + sub; LAS unsigned char* kb = bb + sub * 16384; LAS unsigned char* vb = kb + 8192;
            if (j >= jlo && j <= jhi && !(dbg & 2)) {
                f32x4 p[4];
#pragma unroll
                for (int kt = 0; kt < 4; ++kt) { p[kt] = (f32x4){0.f, 0.f, 0.f, 0.f};
                    p[kt] = MFMA16(tile_kfrag(kb, ta, kt, 0), qf[0], p[kt]); p[kt] = MFMA16(tile_kfrag(kb, ta, kt, 1), qf[1], p[kt]);
#pragma unroll
                    for (int i = 0; i < 4; ++i) { const int rel = tr - (64 * j + 16 * kt + 4 * q + i); const bool ok = rel >= 0 && rel < 512;
                        const int rc = rel < 0 ? 0 : (rel > 128 ? 128 : rel);
                        const float e = ok ? __builtin_amdgcn_exp2f(p[kt][i] + bl[bkt[rc] * 8 + h] - mb) : 0.f; p[kt][i] = e; lw += e; } }
                const bf16x8 pf0 = frag_pk(p[0], p[1]), pf1 = frag_pk(p[2], p[3]);
#pragma unroll
                for (int dt = 0; dt < 4; ++dt) { ow[dt] = MFMA16(tile_vfrag(vb, ta, dt, 0), pf0, ow[dt]); ow[dt] = MFMA16(tile_vfrag(vb, ta, dt, 1), pf1, ow[dt]); }
            } }
        }
        lw += __shfl_xor(lw, 16); lw += __shfl_xor(lw, 32);
    }
    f32x4 ocw[4];
    { const float* gt = WSP(float, WS_GATES) + (size_t)(b * T + tr) * 24 + h * 3;
      const float g0 = gt[0] * lcinv, g2 = gt[2] * (lw > 0.f ? 1.f / lw : 0.f);
#pragma unroll
      for (int dt = 0; dt < 4; ++dt) ocw[dt] = oc[dt] * g0 + ow[dt] * g2; }
    __syncthreads();
    f32x4 osf[4]; float lsf = 0.f;
    {
        int lb_ = lane0; OPAQUE_V(lb_); const int lane = lb_, r = lane & 15, q = lane >> 4, h = kv * 4 + (r & 3); const TileAddr ta = tile_addr(r, q);
        const int half = w >> 2, jw = w & 3;
        f32x4 osa[4][4]; float lsa[4];
#pragma unroll
        for (int x = 0; x < 4; ++x) { lsa[x] = 0.f;
#pragma unroll
            for (int dt = 0; dt < 4; ++dt) osa[x][dt] = (f32x4){0.f, 0.f, 0.f, 0.f}; }
        const int jmax = (t0 + 31) >> 6;
        const int brow = lane >> 3, bc16 = lane & 7, boff = brow * 64 + bc16 * 8, bsoff = tile_off16(brow, bc16); const float bfar = bl[31 * 8 + h];
        const bf16* ksel = WSP(bf16, WS_KSEL) + (size_t)bk * T * 64 + boff; const bf16* vsel = WSP(bf16, WS_VSELT) + (size_t)bk * 128 * 4096 + boff;
        LAS const bf16* Qh = Qs + (64 * half + r) * 64 + 8 * q;
        u32x4 gk[8];
        if (jw <= jmax) {
#pragma unroll
            for (int i = 0; i < 8; ++i) gk[i] = *(const u32x4*)(ksel + (size_t)jw * 4096 + i * 512); }
#pragma unroll 1
        for (int j = jw; j <= jmax; j += 4) {
            const unsigned msel = ((unsigned)__builtin_amdgcn_readfirstlane((int)selm[j]) >> (16 * half)) & 0xffffu;
            const bool act = msel != 0u && !(dbg & 4);
            u32x4 gv[8];
            if (act) {
#pragma unroll
                for (int i = 0; i < 8; ++i) gv[i] = *(const u32x4*)(vsel + (size_t)j * 4096 + i * 512); }
            asm volatile("s_waitcnt lgkmcnt(0)" ::: "memory");
#pragma unroll
            for (int i = 0; i < 8; ++i) *(LAS u32x4*)(stB + bsoff + i * 1024) = gk[i];
            if (j + 4 <= jmax) {
#pragma unroll
                for (int i = 0; i < 8; ++i) gk[i] = *(const u32x4*)(ksel + (size_t)(j + 4) * 4096 + i * 512); }
            if (!act) continue;
#pragma unroll
            for (int i = 0; i < 8; ++i) *(LAS u32x4*)(stB + 8192 + bsoff + i * 1024) = gv[i];
            asm volatile("s_waitcnt lgkmcnt(0)" ::: "memory");
            const bool far = (t0 - (64 * j + 63)) >= 128;
#pragma unroll
            for (int x = 0; x < 4; ++x) {
                const unsigned nib = (msel >> (4 * x)) & 15u;
                if (nib) {
                    const bool tokv = (nib >> (r >> 2)) & 1u; const int t = t0 + 16 * half + 4 * x + (r >> 2);
                    const bf16x8 qs0 = as_frag(*(LAS const u32x4*)(Qh + x * 1024)), qs1 = as_frag(*(LAS const u32x4*)(Qh + x * 1024 + 32));
                    f32x4 p[4]; float ls = 0.f;
#pragma unroll
                    for (int kt = 0; kt < 4; ++kt) { p[kt] = (f32x4){0.f, 0.f, 0.f, 0.f};
                        p[kt] = MFMA16(tile_kfrag(stB, ta, kt, 0), qs0, p[kt]); p[kt] = MFMA16(tile_kfrag(stB, ta, kt, 1), qs1, p[kt]); }
                    if (far) {
                        const float cb_ = bfar - mb;
#pragma unroll
                        for (int kt = 0; kt < 4; ++kt)
#pragma unroll
                            for (int i = 0; i < 4; ++i) { const float e = tokv ? __builtin_amdgcn_exp2f(p[kt][i] + cb_) : 0.f; p[kt][i] = e; ls += e; }
                    } else {
#pragma unroll
                        for (int kt = 0; kt < 4; ++kt)
#pragma unroll
                            for (int i = 0; i < 4; ++i) { const int rel = t - (64 * j + 16 * kt + 4 * q + i); const bool ok = tokv && rel >= 0;
                                const int rc = rel < 0 ? 0 : (rel > 128 ? 128 : rel);
                                const float e = ok ? __builtin_amdgcn_exp2f(p[kt][i] + bl[bkt[rc] * 8 + h] - mb) : 0.f; p[kt][i] = e; ls += e; }
                    }
                    lsa[x] += ls;
                    const bf16x8 pf0 = frag_pk(p[0], p[1]), pf1 = frag_pk(p[2], p[3]);
#pragma unroll
                    for (int dt = 0; dt < 4; ++dt) { osa[x][dt] = MFMA16(tile_vfrag(stB + 8192, ta, dt, 0), pf0, osa[x][dt]); osa[x][dt] = MFMA16(tile_vfrag(stB + 8192, ta, dt, 1), pf1, osa[x][dt]); }
                }
            }
        }
#pragma unroll
        for (int dt = 0; dt < 4; ++dt) osf[dt] = (f32x4){0.f, 0.f, 0.f, 0.f};
#pragma unroll
        for (int x = 0; x <= 4; ++x) {
            __syncthreads();
            if (x > 0 && jw == x - 1) {
#pragma unroll
                for (int w2 = 0; w2 < 4; ++w2) { LAS const float* rp = (LAS const float*)(F.lds + NL_U + ((x - 1) & 1) * 32768) + (4 * half + w2) * 1024 + lane * 16;
#pragma unroll
                    for (int dt = 0; dt < 4; ++dt) osf[dt] += *(LAS const f32x4*)(rp + 4 * dt);
                    lsf += ((LAS const float*)(F.lds + NL_Q + ((x - 1) & 1) * 2048))[(4 * half + w2) * 64 + lane]; } }
            if (x < 4) { LAS float* Rb = (LAS float*)(F.lds + NL_U + (x & 1) * 32768); LAS float* RLb = (LAS float*)(F.lds + NL_Q + (x & 1) * 2048);
#pragma unroll
                for (int dt = 0; dt < 4; ++dt) *(LAS f32x4*)(Rb + w * 1024 + lane * 16 + 4 * dt) = osa[x][dt];
                RLb[w * 64 + lane] = lsa[x]; }
        }
        lsf += __shfl_xor(lsf, 16); lsf += __shfl_xor(lsf, 32);
    }
    {
        int lf_ = lane0; OPAQUE_V(lf_); const int r = lf_ & 15, q = lf_ >> 4, tr = tw + (r >> 2), h = kv * 4 + (r & 3);
        const int tok = b * T + tr; const float g1 = WSP(float, WS_GATES)[(size_t)tok * 24 + h * 3 + 1] * (lsf > 0.f ? 1.f / lsf : 0.f);
        bf16* on = WSP(bf16, WS_ONSA) + (size_t)tok * 512 + h * 64 + 4 * q;
#pragma unroll
        for (int dt = 0; dt < 4; ++dt) { const f32x4 o = ocw[dt] + osf[dt] * g1;
            u32x2 wv; wv.x = pk2(o[0], o[1]); wv.y = pk2(o[2], o[3]); *(u32x2*)(on + 16 * dt) = wv; }
    }
}

constexpr int SL_Q = 0;
constexpr int SL_S = 1024;
constexpr int SL_O = 17408;
constexpr int SL_PART = 20480;
constexpr int SL_IMP = 28672;
constexpr int SL_IDX = 29200;
constexpr int SL_END = 29328;
static_assert(SL_END <= NL_BKT, "sample NSA LDS map must not overlap the tables");
template <class KP, class VP, class RELF>
__device__ __forceinline__ void sample_segment(Frame& F, int nk, int kv, KP kptr, VP vptr, RELF relf, LAS float* odst) {
    LAS const float* qs = (LAS const float*)(F.lds + SL_Q); LAS float* sc = (LAS float*)(F.lds + SL_S); LAS float* part = (LAS float*)(F.lds + SL_PART);
    LAS const int* bkt = (LAS const int*)(F.lds + NL_BKT); LAS const float* bl = (LAS const float*)(F.lds + NL_BIAS);
    const int nkp = (nk + 63) & ~63;
    for (int n = TID_; n < nkp; n += NTHR) {
        float s0 = -INFINITY, s1 = -INFINITY, s2 = -INFINITY, s3 = -INFINITY;
        const float* kr = n < nk ? kptr(n) : nullptr;
        if (kr) { s0 = s1 = s2 = s3 = 0.f;
            for (int d = 0; d < 64; d += 4) { const f32x4 k4 = *(const f32x4*)(kr + d);
                const f32x4 q0 = *(LAS const f32x4*)(qs + d), q1 = *(LAS const f32x4*)(qs + 64 + d), q2 = *(LAS const f32x4*)(qs + 128 + d), q3 = *(LAS const f32x4*)(qs + 192 + d);
                s0 += (q0[0] * k4[0] + q0[1] * k4[1]) + (q0[2] * k4[2] + q0[3] * k4[3]); s1 += (q1[0] * k4[0] + q1[1] * k4[1]) + (q1[2] * k4[2] + q1[3] * k4[3]);
                s2 += (q2[0] * k4[0] + q2[1] * k4[1]) + (q2[2] * k4[2] + q2[3] * k4[3]); s3 += (q3[0] * k4[0] + q3[1] * k4[1]) + (q3[2] * k4[2] + q3[3] * k4[3]); }
            int rel = relf(n); rel = rel > 128 ? 128 : rel; const int bb = bkt[rel] * 8 + kv * 4;
            s0 += bl[bb]; s1 += bl[bb + 1]; s2 += bl[bb + 2]; s3 += bl[bb + 3]; }
        sc[n] = s0; sc[1024 + n] = s1; sc[2048 + n] = s2; sc[3072 + n] = s3;
    }
    __syncthreads();
    if (F.wave < 4) { LAS float* row = sc + F.wave * 1024; float m = -INFINITY;
        for (int n = LANE_; n < nkp; n += 64) m = fmaxf(m, row[n]);
        m = wave_max(m); float l = 0.f;
        for (int n = LANE_; n < nkp; n += 64) { const float e = __builtin_amdgcn_exp2f(row[n] - m); row[n] = e; l += e; }
        l = wave_sum(l); const float inv = 1.f / l;
        for (int n = LANE_; n < nkp; n += 64) row[n] *= inv; }
    __syncthreads();
    {
        const int d = LANE_; float o0 = 0.f, o1 = 0.f, o2 = 0.f, o3 = 0.f;
        for (int n0 = F.wave; n0 < nkp; n0 += 32) {
            float v[4];
#pragma unroll
            for (int u = 0; u < 4; ++u) { const int n = n0 + 8 * u; v[u] = n < nk ? vptr(n)[d] : 0.f; }
#pragma unroll
            for (int u = 0; u < 4; ++u) { const int n = n0 + 8 * u; if (n < nkp) { o0 += sc[n] * v[u]; o1 += sc[1024 + n] * v[u]; o2 += sc[2048 + n] * v[u]; o3 += sc[3072 + n] * v[u]; } }
        }
        part[(F.wave * 4 + 0) * 64 + d] = o0; part[(F.wave * 4 + 1) * 64 + d] = o1; part[(F.wave * 4 + 2) * 64 + d] = o2; part[(F.wave * 4 + 3) * 64 + d] = o3; }
    __syncthreads();
    if (TID_ < 256) { float a = 0.f;
#pragma unroll
        for (int w8 = 0; w8 < 8; ++w8) a += part[w8 * 256 + TID_];
        odst[TID_] = a; }
    __syncthreads();
}
__device__ __forceinline__ void p3_nsa_sample(Frame& F, int task) {
    const int b = task >> 1, kv = task & 1, tok = NTOKP + b, bk = b * 2 + kv;
    LAS float* qs = (LAS float*)(F.lds + SL_Q); LAS float* sc = (LAS float*)(F.lds + SL_S); LAS float* ob = (LAS float*)(F.lds + SL_O);
    LAS float* imp = (LAS float*)(F.lds + SL_IMP); LAS int* sidx = (LAS int*)(F.lds + SL_IDX);
    __syncthreads();
    if (TID_ < 256) qs[TID_] = bf2f(WSP(bf16, WS_QN)[(size_t)tok * 512 + kv * 256 + TID_]);
    __syncthreads();
    const float* kcs = WSP(float, WS_KCMPS) + (size_t)bk * 512 * 64; const float* vcs = WSP(float, WS_VCMPS) + (size_t)bk * 512 * 64;
    const float* nkv = WSP(float, WS_NEWKV) + (size_t)b * 4 * 2 * 64 + kv * 64;
    const float* ckv = F.in[I_CKV]; const int* pt = (const int*)F.in[I_PT] + b * 64; const float* cwin = F.in[I_CWIN] + (size_t)b * 512 * 256;
    sample_segment(F, 511, kv, [&](int n) { return kcs + (size_t)n * 64; }, [&](int n) { return vcs + (size_t)n * 64; }, [&](int n) { return T - (16 * n + 31); }, ob);
    if (TID_ < 129) { const int j = TID_; float v = 0.f;
        for (int c = 4 * j - 1; c <= 4 * j + 3; ++c) if (c >= 0 && c < 511) v += (sc[c] + sc[1024 + c]) + (sc[2048 + c] + sc[3072 + c]);
        imp[j] = v; }
    __syncthreads();
    if (F.wave == 0) { const int lane = LANE_; unsigned key[3];
#pragma unroll
        for (int m = 0; m < 3; ++m) { const int j = lane + 64 * m; float s = -1e30f;
            if (j < 129) { const bool forced = (j == 0) || (j == 128) || (j == 127); s = imp[j] + (forced ? 1e4f : 0.f); }
            key[m] = (j < 129) ? fkey(s) : 0u; }
        unsigned pre = 0u;
#pragma unroll 1
        for (int bit = 31; bit >= 0; --bit) { const unsigned cand = pre | (1u << bit); int cnt = 0;
#pragma unroll
            for (int m = 0; m < 3; ++m) cnt += __popcll(__ballot(key[m] >= cand));
            if (cnt >= 16) pre = cand; }
        int ngt = 0;
#pragma unroll
        for (int m = 0; m < 3; ++m) ngt += __popcll(__ballot(key[m] > pre));
        int need = 16 - ngt, cnt = 0;
#pragma unroll
        for (int m = 0; m < 3; ++m) { const bool gt = key[m] > pre, tie = key[m] == pre; const unsigned long long tb = __ballot(tie);
            const int trank = __popcll(tb & ((1ull << lane) - 1ull)); const bool sel = gt || (tie && trank < need);
            need -= __popcll(tb); need = need < 0 ? 0 : need;
            const unsigned long long sb = __ballot(sel); const int pos = cnt + __popcll(sb & ((1ull << lane) - 1ull));
            if (sel && pos < 16) sidx[pos] = lane + 64 * m; cnt += __popcll(sb); } }
    __syncthreads();
    sample_segment(F, 1024, kv,
        [&](int n) -> const float* { const int pos = 64 * sidx[n >> 6] + (n & 63); if (pos > T) return nullptr; if (pos == T) return nkv;
                                     return ckv + (((size_t)pt[pos >> 7] * 128 + (pos & 127)) * 4 + 2) * 128 + kv * 64; },
        [&](int n) -> const float* { const int pos = 64 * sidx[n >> 6] + (n & 63); if (pos >= T) return nkv + 128;
                                     return ckv + (((size_t)pt[pos >> 7] * 128 + (pos & 127)) * 4 + 3) * 128 + kv * 64; },
        [&](int n) { return T - (64 * sidx[n >> 6] + (n & 63)); }, ob + 256);
    sample_segment(F, 512, kv,
        [&](int n) -> const float* { return n < 511 ? cwin + (size_t)(n + 1) * 256 + kv * 64 : nkv + 256; },
        [&](int n) -> const float* { return n < 511 ? cwin + (size_t)(n + 1) * 256 + 128 + kv * 64 : nkv + 384; },
        [&](int n) { return 511 - n; }, ob + 512);
    if (TID_ < 256) { const int g = TID_ >> 6, d = TID_ & 63, h = kv * 4 + g; const float* gt = WSP(float, WS_GATES) + (size_t)tok * 24 + h * 3;
        WSP(bf16, WS_ONSA)[(size_t)tok * 512 + h * 64 + d] = (bf16)f2bf(gt[0] * ob[TID_] + gt[1] * ob[256 + TID_] + gt[2] * ob[512 + TID_]); }
}

__device__ __forceinline__ void p6_conv(Frame& F) {
    const bf16* ug = WSP(bf16, WS_UG); bf16* act = WSP(bf16, WS_ACT);
    const float* cw = F.in[I_CONVW]; const float* cb = F.in[I_CONVB]; const float* sconv = F.in[I_SCONV];
    constexpr int NG = DFF / 8;
    for (size_t it = (size_t)F.bid * NTHR + TID_; it < (size_t)MPAD * NG; it += (size_t)F.G * NTHR) {
        const int row = (int)(it / NG), c0 = 8 * (int)(it % NG);
        if (row >= NTOK) { *(u32x4*)(act + (size_t)row * DFF + c0) = (u32x4){0u, 0u, 0u, 0u}; continue; }
        float u[8], g2[8], g1[8], g0[8];
        unpack8(*(const u32x4*)(ug + (size_t)row * DUP + c0), u);
        unpack8(*(const u32x4*)(ug + (size_t)row * DUP + DFF + c0), g2);
        if (row < NTOKP) { const int t = row & (T - 1);
            if (t >= 1) unpack8(*(const u32x4*)(ug + (size_t)(row - 1) * DUP + DFF + c0), g1); else { for (int i = 0; i < 8; ++i) g1[i] = 0.f; }
            if (t >= 2) unpack8(*(const u32x4*)(ug + (size_t)(row - 2) * DUP + DFF + c0), g0); else { for (int i = 0; i < 8; ++i) g0[i] = 0.f; }
            if (t >= T - 2) { float* o = F.out + O_CONVP + ((size_t)(row >> 13) * 2 + (t - (T - 2))) * DFF + c0;
                for (int i = 0; i < 8; ++i) o[i] = g2[i]; }
        } else { const int sb = row - NTOKP;
            for (int i = 0; i < 8; ++i) { g0[i] = sconv[((size_t)sb * 2 + 0) * DFF + c0 + i]; g1[i] = sconv[((size_t)sb * 2 + 1) * DFF + c0 + i]; }
            float* o = F.out + O_CONVS + (size_t)sb * 2 * DFF + c0;
            for (int i = 0; i < 8; ++i) { o[i] = g1[i]; o[DFF + i] = g2[i]; } }
        float a[8];
#pragma unroll
        for (int i = 0; i < 8; ++i) { const float gc = cb[c0 + i] + cw[c0 + i] * g0[i] + cw[DFF + c0 + i] * g1[i] + cw[2 * DFF + c0 + i] * g2[i]; a[i] = gelu_tanh(gc) * u[i]; }
        *(u32x4*)(act + (size_t)row * DFF + c0) = pack8(a);
    }
}

constexpr int N_PHASES = 10;
__global__ void __launch_bounds__(NTHR, 2) mega_fwd(Args args) {
    extern __shared__ __attribute__((aligned(16))) unsigned char lds_raw[];
    cg::grid_group grid = cg::this_grid();
    Frame F;
    F.lds = (LAS unsigned char*)lds_raw;
    F.wave = __builtin_amdgcn_readfirstlane((int)(threadIdx.x >> 6));
    F.G = gridDim.x; F.bid = blockIdx.x; F.gw = F.bid * NWAVES + F.wave; F.NGW = F.G * NWAVES;
    F.in = args.in; F.out = args.out; F.ws = args.ws;
    const int lo = args.ph_lo, hi = args.ph_hi, sub = args.sub;
#define SUB(i) ((sub >> (i)) & 1)
#ifndef PROBE_REP
#define PROBE_REP -1
#endif
#define IN(k) (lo <= (k) && (k) < hi)
#define REP(k) for (int rep_ = 0; rep_ < ((k) == PROBE_REP ? 2 : 1); ++rep_)
#define SEAM(k) do { if (IN(k) && IN((k) + 1)) grid.sync(); { unsigned char* w_ = F.ws; asm volatile("" : "+s"(w_)); F.ws = w_; float* o_ = F.out; asm volatile("" : "+s"(o_)); F.out = o_; } } while (0)
    typedef pg8::StaticOrder SO;

    REP(0) if (IN(0)) { p0_prologue(F); }
    SEAM(0);
    if (IN(1)) {
        { pg8::Gemm g{WSP(bf16, WS_XN), WSP(bf16, WS_WTIN), MPAD, DINP, 1024}; SO S; S.init(MPAD, DINP, F.G, F.bid);
          pg8::EpiStore E{WSP(bf16, WS_PROJ), DINP, nullptr};
          pg8::gemm_phase<pg8::EpiStore, SO, true, true>(F.lds, g, S, E, F.wave); }
        __syncthreads();
        { pg8::Gemm g{WSP(bf16, WS_MN), WSP(bf16, WS_WTMEM), 512, 1024, 1024}; SO S; S.init(512, 1024, F.G, F.G - 1 - F.bid);
          pg8::EpiStore E{WSP(bf16, WS_MEMPROJ), 1024, nullptr};
          pg8::gemm_phase<pg8::EpiStore, SO, true, true>(F.lds, g, S, E, F.wave); }
    }
    SEAM(1);
    REP(2) if (IN(2)) {
        if (SUB(0)) { for (int tok = F.gw; tok < NTOK; tok += F.NGW) p2_token(F, tok);
        for (int row = F.gw; row < 512; row += F.NGW) p2_memrow(F, row); }
        if (SUB(1)) for (int t = F.bid; t < CMP_TASKS_S + CMP_TASKS_P; t += F.G) p2_compress(F, t);
        if (SUB(2)) for (int bc = F.bid; bc < 256; bc += F.G) { __syncthreads(); p2_gla_chunk(F, bc); }
        __syncthreads();
        if (SUB(3)) for (int t = F.gw; t < SB * 4; t += F.NGW) p2_gla_sample(F, t);
    }
    SEAM(2);
    REP(3) if (IN(3)) {
        nsa_tables(F);
        const float mb = nsa_bound(F);
        if (SUB(4)) for (int n = F.bid; n < 1024; n += F.G) p3_nsa_prompt(F, n, mb, (sub >> 8) & 31);
        __syncthreads();
        if (SUB(6)) { const float gq = absmax_arr(F.in[I_GXQ], 128, LANE_), gk = absmax_arr(F.in[I_GXK], 128, LANE_);
          const float mbx = 11.313708498984761f * gq * gk * 1.02f * LOG2E;
          for (int t = F.bid; t < 256; t += F.G) p3_xatt(F, t, mbx); }
        __syncthreads();
        if (SUB(6)) for (int t = F.gw; t < SB * 4; t += F.NGW) p3_xatt_sample(F, t);
        if (SUB(7)) for (int t = F.gw; t < 1024; t += F.NGW) p3_gla_scan(F, t);
    }
    SEAM(3);
    if (IN(4)) {
        nsa_tables(F);
        for (int t = F.G - 1 - F.bid; t < SB * 2; t += F.G) p3_nsa_sample(F, t);
        __syncthreads();
        { const int nb = F.G > 128 ? F.G - 64 : F.G;
          if (F.bid < nb) for (int t = F.gw; t < 4096; t += nb * NWAVES) p4_gla_out(F, t); }
    }
    SEAM(4);
    if (IN(5)) {
        const bf16* gate = WSP(bf16, WS_PROJ) + C_MG;
        { pg8::Gemm g{WSP(bf16, WS_ONSA), WSP(bf16, WS_WTNSA), MPAD, 1024, 512}; SO S; S.init(MPAD, 1024, F.G, F.bid);
          pg8::EpiMerge<0> E{gate, DINP, WSP(bf16, WS_MERGED), 1024};
          pg8::gemm_phase<pg8::EpiMerge<0>, SO, true, true>(F.lds, g, S, E, F.wave); }
        __syncthreads();
        { pg8::Gemm g{WSP(bf16, WS_OGLA), WSP(bf16, WS_WTGLA), MPAD, 1024, 512}; SO S; S.init(MPAD, 1024, F.G, F.bid);
          pg8::EpiMerge<1> E{gate + 1024, DINP, WSP(bf16, WS_MERGED), 1024};
          pg8::gemm_phase<pg8::EpiMerge<1>, SO, true, true>(F.lds, g, S, E, F.wave); }
        __syncthreads();
        { pg8::Gemm g{WSP(bf16, WS_OX), WSP(bf16, WS_WTX), MPAD, 1024, 512}; SO S; S.init(MPAD, 1024, F.G, F.bid);
          pg8::EpiMerge<1> E{gate + 2048, DINP, WSP(bf16, WS_MERGED), 1024};
          pg8::gemm_phase<pg8::EpiMerge<1>, SO, true, true>(F.lds, g, S, E, F.wave); }
    }
    SEAM(5);
    if (IN(6)) {
        pg8::Gemm g{WSP(bf16, WS_MERGED), WSP(bf16, WS_WTO), MPAD, 1024, 1024}; SO S; S.init(MPAD, 1024, F.G, F.bid);
        pg8::EpiWo E{F.in[I_XP], F.in[I_XS], WSP(float, WS_X1), WSP(bf16, WS_X1B), WSP(float, WS_SSQ)};
        pg8::gemm_phase<pg8::EpiWo, SO, true, true>(F.lds, g, S, E, F.wave);
    }
    SEAM(6);
    if (IN(7)) {
        pg8::Gemm g{WSP(bf16, WS_X1B), WSP(bf16, WS_WTUP), MPAD, DUP, 1024}; SO S; S.init(MPAD, DUP, F.G, F.bid);
        pg8::EpiStore E{WSP(bf16, WS_UG), DUP, WSP(float, WS_SSQ)};
        pg8::gemm_phase<pg8::EpiStore, SO, true, true>(F.lds, g, S, E, F.wave);
    }
    SEAM(7);
    REP(8) if (IN(8)) { p6_conv(F); }
    SEAM(8);
    if (IN(9)) {
        pg8::Gemm g{WSP(bf16, WS_ACT), WSP(bf16, WS_WTDOWN), MPAD, 1024, DFF}; SO S; S.init(MPAD, 1024, F.G, F.bid);
        pg8::EpiDown E{WSP(float, WS_X1), F.out + O_Y, F.out + O_YS};
        pg8::gemm_phase<pg8::EpiDown, SO, true, true>(F.lds, g, S, E, F.wave);
    }
#undef IN
#undef SEAM
}

extern "C" void kernel_launch(void* const* d_in, const int* in_sizes, int n_in, void* d_out, int out_size, void* d_ws, size_t ws_size, hipStream_t stream) {
    static int grid = 0;
    if (grid == 0) {
        if (n_in != N_IN || (size_t)out_size != O_END || ws_size < WS_END) {
            fprintf(stderr, "kernel_launch: built for %d inputs, %zu outputs, >= %zu bytes of workspace; got %d, %d, %zu\n", (int)N_IN, (size_t)O_END, (size_t)WS_END, n_in, out_size, ws_size); grid = -1; return; }
        int dev = 0, cus = 0, per_cu = 0;
        if (hipGetDevice(&dev) != hipSuccess || hipDeviceGetAttribute(&cus, hipDeviceAttributeMultiprocessorCount, dev) != hipSuccess) { grid = -1; return; }
        if (hipFuncSetAttribute((const void*)mega_fwd, hipFuncAttributeMaxDynamicSharedMemorySize, LDS_BYTES) != hipSuccess) { fprintf(stderr, "kernel_launch: hipFuncSetAttribute failed\n"); grid = -1; return; }
        if (hipOccupancyMaxActiveBlocksPerMultiprocessor(&per_cu, (const void*)mega_fwd, NTHR, LDS_BYTES) != hipSuccess || per_cu < 1) { fprintf(stderr, "kernel_launch: occupancy query gave %d\n", per_cu); per_cu = 1; }
        (void)hipGetLastError();
        grid = cus * (per_cu < 1 ? 1 : 1);
    }
    if (grid < 0) return;
    Args a{};
    for (int i = 0; i < N_IN; ++i) a.in[i] = (const float*)d_in[i];
    a.out = (float*)d_out; a.ws = (unsigned char*)d_ws;
#if MK_N_LAUNCHES == 1
    a.ph_lo = 0; a.ph_hi = N_PHASES; a.sub = 0xff;
    void* kargs[] = {&a};
    hipError_t e = hipLaunchCooperativeKernel((const void*)mega_fwd, dim3(grid), dim3(NTHR), kargs, LDS_BYTES, stream);
    if (e != hipSuccess) fprintf(stderr, "kernel_launch: cooperative launch failed: %s (grid %d)\n", hipGetErrorString(e), grid);
#ifdef PROBE_EXTRA
    a.ph_lo = PROBE_EXTRA; a.ph_hi = PROBE_EXTRA + 1;
#ifdef PROBE_SUB
    a.sub = PROBE_SUB;
#endif
    hipLaunchKernelGGL(mega_fwd, dim3(grid), dim3(NTHR), LDS_BYTES, stream, a);
#endif
#else
    a.sub = 0xff;
    for (int p = 0; p < N_PHASES; ++p) { a.ph_lo = p; a.ph_hi = p + 1; hipLaunchKernelGGL(mega_fwd, dim3(grid), dim3(NTHR), LDS_BYTES, stream, a); }
#endif
}
```

```cpp
#include <hip/hip_runtime.h>
#include <hip/hip_cooperative_groups.h>
#include <cstdio>
#include <cstdint>
namespace cg = cooperative_groups;
#ifndef MK_N_LAUNCHES
#define MK_N_LAUNCHES 1
#endif
namespace pg8 {
#define PG8_LAS __attribute__((address_space(3)))
typedef unsigned short bf16_t;
typedef short bf16x8 __attribute__((ext_vector_type(8)));
typedef float f32x4 __attribute__((ext_vector_type(4)));
typedef unsigned u32x4 __attribute__((ext_vector_type(4)));
constexpr int BM = 256, BK = 64, HALF = 128, HTB = HALF * BK * 2  , STAGE_BYTES = 8 * HTB, NXCD = 8, WGM = 8;

__host__ __device__ __forceinline__ int lds_byte(int r, int c) { const int st = (r >> 4) * 2 + (c >> 5), rr = r & 15, cc = c & 31, ob = rr * 64 + cc * 2; return st * 1024 + (ob ^ (((ob >> 9) & 1) << 5)); }
__host__ __device__ __forceinline__ void stage_rc(int b, int& R, int& C) { const int st = b / 1024, sb = b % 1024, swz = sb ^ (((sb >> 9) & 1) << 5); R = (st >> 1) * 16 + swz / 64; C = (st & 1) * 32 + (swz % 64) / 2; }
__host__ __device__ __forceinline__ int perm32(int rho) { const int n = rho >> 4, i = rho & 15; return 8 * (i >> 2) + 4 * n + (i & 3); }

struct Unit { int pm, pn; };
struct Gemm { const bf16_t* A; const bf16_t* Bt; int M, N, K; };

struct StaticOrder {
    int nM, nN, nwg, G, c;
    __host__ __device__ void init(int M, int N, int G_, int c_) { nM = M / BM; nN = N / BM; nwg = nM * nN; G = G_; c = c_; }
    __host__ __device__ bool next(int i, Unit& u) const {
        const long L = (long)i * G + c; if (L >= nwg) return false;
        int wgid = (int)L; { const int q = nwg / NXCD, r = nwg % NXCD, xcd = wgid % NXCD, off = wgid / NXCD; wgid = (xcd < r ? xcd * (q + 1) : r * (q + 1) + (xcd - r) * q) + off; }
        const int nig = WGM * nN, gid = wgid / nig, fm = gid * WGM, gsz = (nM - fm) < WGM ? (nM - fm) : WGM;
        u.pm = fm + ((wgid % nig) % gsz); u.pn = (wgid % nig) / gsz; return true;
    }
    __device__ __forceinline__ void a_ready(const Unit&) const {}
    __device__ __forceinline__ void done(const Unit&) const {}
};

__device__ __forceinline__ unsigned cvt_pk_bf16(float lo, float hi) { unsigned r; asm volatile("v_cvt_pk_bf16_f32 %0, %1, %2" : "=v"(r) : "v"(lo), "v"(hi)); return r; }
__device__ __forceinline__ float bflo(unsigned w) { return __uint_as_float(w << 16); }
__device__ __forceinline__ float bfhi(unsigned w) { return __uint_as_float(w & 0xffff0000u); }
__device__ __forceinline__ float sigm(float x) { return 1.0f / (1.0f + __expf(-x)); }
struct EpiStore {
    static constexpr bool PERM = true, AFTER_DRAIN = false;
    bf16_t* O; int ldc; const float* ssq;
    __device__ __forceinline__ void operator()(const f32x4 (&acc)[2][2][4][2], const Unit& u, int wr, int wc, int fr, int fq) const {
        const int row0 = u.pm * BM + wr * 64 + fr, col0 = u.pn * BM + wc * 32 + 8 * fq;
#pragma unroll
        for (int ai = 0; ai < 2; ++ai)
#pragma unroll
            for (int m = 0; m < 4; ++m) { const int row = row0 + ai * HALF + m * 16; bf16_t* rowp = O + (size_t)row * ldc + col0;
                const float sc = ssq ? rsqrtf(ssq[row] * (1.0f / 1024.0f) + 1e-6f) : 1.0f;
#pragma unroll
                for (int bj = 0; bj < 2; ++bj) { const f32x4 v0 = acc[ai][bj][m][0] * sc, v1 = acc[ai][bj][m][1] * sc;
                    u32x4 w; w.x = cvt_pk_bf16(v0[0], v0[1]); w.y = cvt_pk_bf16(v0[2], v0[3]); w.z = cvt_pk_bf16(v1[0], v1[1]); w.w = cvt_pk_bf16(v1[2], v1[3]);
                    *(u32x4*)(rowp + bj * HALF) = w; } }
    }
};
template <int ACCUM> struct EpiMerge {
    static constexpr bool PERM = true, AFTER_DRAIN = false;
    const bf16_t* gate; int ldg; bf16_t* O; int ldc;
    __device__ __forceinline__ void operator()(const f32x4 (&acc)[2][2][4][2], const Unit& u, int wr, int wc, int fr, int fq) const {
        const int row0 = u.pm * BM + wr * 64 + fr, col0 = u.pn * BM + wc * 32 + 8 * fq;
#pragma unroll
        for (int ai = 0; ai < 2; ++ai)
#pragma unroll
            for (int m = 0; m < 4; ++m) { const int row = row0 + ai * HALF + m * 16; bf16_t* rowp = O + (size_t)row * ldc + col0; const bf16_t* gp = gate + (size_t)row * ldg + col0;
#pragma unroll
                for (int bj = 0; bj < 2; ++bj) {
                    const u32x4 g = *(const u32x4*)(gp + bj * HALF);
                    f32x4 v0 = acc[ai][bj][m][0], v1 = acc[ai][bj][m][1];
                    v0[0] *= sigm(bflo(g.x)); v0[1] *= sigm(bfhi(g.x)); v0[2] *= sigm(bflo(g.y)); v0[3] *= sigm(bfhi(g.y));
                    v1[0] *= sigm(bflo(g.z)); v1[1] *= sigm(bfhi(g.z)); v1[2] *= sigm(bflo(g.w)); v1[3] *= sigm(bfhi(g.w));
                    if (ACCUM) { const u32x4 o = *(const u32x4*)(rowp + bj * HALF);
                        v0[0] += bflo(o.x); v0[1] += bfhi(o.x); v0[2] += bflo(o.y); v0[3] += bfhi(o.y);
                        v1[0] += bflo(o.z); v1[1] += bfhi(o.z); v1[2] += bflo(o.w); v1[3] += bfhi(o.w); }
                    u32x4 w; w.x = cvt_pk_bf16(v0[0], v0[1]); w.y = cvt_pk_bf16(v0[2], v0[3]); w.z = cvt_pk_bf16(v1[0], v1[1]); w.w = cvt_pk_bf16(v1[2], v1[3]);
                    *(u32x4*)(rowp + bj * HALF) = w; } }
    }
};
struct EpiWo {
    static constexpr bool PERM = true, AFTER_DRAIN = false;
    const float* xp; const float* xs; float* X1; bf16_t* X1B; float* ssq;
    __device__ __forceinline__ void operator()(const f32x4 (&acc)[2][2][4][2], const Unit& u, int wr, int wc, int fr, int fq) const {
        const int row0 = u.pm * BM + wr * 64 + fr, col0 = u.pn * BM + wc * 32 + 8 * fq;
#pragma unroll
        for (int ai = 0; ai < 2; ++ai)
#pragma unroll
            for (int m = 0; m < 4; ++m) { const int row = row0 + ai * HALF + m * 16;
                const float* xr = row < 16384 ? xp + (size_t)row * 1024 : (row < 16416 ? xs + (size_t)(row - 16384) * 1024 : nullptr);
                float ss = 0.f;
#pragma unroll
                for (int bj = 0; bj < 2; ++bj) { const int col = col0 + bj * HALF;
                    f32x4 x0 = (f32x4){0.f, 0.f, 0.f, 0.f}, x1 = x0;
                    if (xr) { x0 = *(const f32x4*)(xr + col); x1 = *(const f32x4*)(xr + col + 4); }
                    const f32x4 v0 = acc[ai][bj][m][0] + x0, v1 = acc[ai][bj][m][1] + x1;
                    *(f32x4*)(X1 + (size_t)row * 1024 + col) = v0; *(f32x4*)(X1 + (size_t)row * 1024 + col + 4) = v1;
                    u32x4 w; w.x = cvt_pk_bf16(v0[0], v0[1]); w.y = cvt_pk_bf16(v0[2], v0[3]); w.z = cvt_pk_bf16(v1[0], v1[1]); w.w = cvt_pk_bf16(v1[2], v1[3]);
                    *(u32x4*)(X1B + (size_t)row * 1024 + col) = w;
                    ss += (v0[0] * v0[0] + v0[1] * v0[1]) + (v0[2] * v0[2] + v0[3] * v0[3]) + (v1[0] * v1[0] + v1[1] * v1[1]) + (v1[2] * v1[2] + v1[3] * v1[3]); }
                ss += __shfl_xor(ss, 16); ss += __shfl_xor(ss, 32);
                if (fq == 0) atomicAdd(ssq + row, ss); }
    }
};
struct EpiDown {
    static constexpr bool PERM = true, AFTER_DRAIN = false;
    const float* X1; float* yp; float* ys;
    __device__ __forceinline__ void operator()(const f32x4 (&acc)[2][2][4][2], const Unit& u, int wr, int wc, int fr, int fq) const {
        const int row0 = u.pm * BM + wr * 64 + fr, col0 = u.pn * BM + wc * 32 + 8 * fq;
#pragma unroll
        for (int ai = 0; ai < 2; ++ai)
#pragma unroll
            for (int m = 0; m < 4; ++m) { const int row = row0 + ai * HALF + m * 16;
                float* yr = row < 16384 ? yp + (size_t)row * 1024 : (row < 16416 ? ys + (size_t)(row - 16384) * 1024 : nullptr);
                if (!yr) continue;
#pragma unroll
                for (int bj = 0; bj < 2; ++bj) { const int col = col0 + bj * HALF;
                    const f32x4 x0 = *(const f32x4*)(X1 + (size_t)row * 1024 + col), x1 = *(const f32x4*)(X1 + (size_t)row * 1024 + col + 4);
                    *(f32x4*)(yr + col) = acc[ai][bj][m][0] + x0; *(f32x4*)(yr + col + 4) = acc[ai][bj][m][1] + x1; } }
    }
};
template <class Epi, class Sched, bool ALIGN_EPI = false, bool SP2 = false>
__device__ __forceinline__ void gemm_phase(PG8_LAS unsigned char* lds, const Gemm g, const Sched& S, const Epi& E, const int wid) {
    unsigned z_ = 0u; asm volatile("" : "+v"(z_));
    const int lane = (int)__builtin_amdgcn_mbcnt_hi(~0u, __builtin_amdgcn_mbcnt_lo(~0u, z_)), tid = wid * 64 + lane, wr = wid >> 2, wc = wid & 3, fr = lane & 15, fq = lane >> 4;
    const int K = g.K, nt = K / BK;
    unsigned voffA[2], voffB[2];
#pragma unroll
    for (int i = 0; i < 2; ++i) { int R, C; stage_rc(tid * 16 + i * 8192, R, C); const int Rb = Epi::PERM ? ((R & ~31) + perm32(R & 31)) : R;
        voffA[i] = (unsigned)(R * K + C) * 2u; voffB[i] = (unsigned)(Rb * K + C) * 2u; }
    const size_t kstep = (size_t)(BK * 2);
    const size_t hstep = (size_t)HALF * K * 2;
    const size_t tstep = 2 * hstep;
    const unsigned ldsw = (unsigned)wid * 1024u;
    const int aoff = lds_byte(wr * 64 + fr, fq * 8), boff = lds_byte(wc * 32 + fr, fq * 8);
#define PG8_SA(b, h) (((b) * 2 + (h)) * HTB)
#define PG8_SB(b, h) ((4 + (b) * 2 + (h)) * HTB)
#define PG8_STAGE(bufoff, gbase, voff) do { _Pragma("unroll") for (int _i = 0; _i < 2; ++_i) \
        __builtin_amdgcn_global_load_lds((const unsigned*)((const char*)(gbase) + (voff)[_i]), (PG8_LAS unsigned*)(lds + (bufoff) + ldsw + _i * 8192), 16, 0, 0); } while (0)
#define PG8_LDA(dst, b, h) do { _Pragma("unroll") for (int m = 0; m < 4; ++m) _Pragma("unroll") for (int k = 0; k < 2; ++k) dst[m][k] = *(const PG8_LAS bf16x8*)(lds + PG8_SA(b, h) + aoff + m * 2048 + k * 1024); } while (0)
#define PG8_LDB(dst, b, h) do { _Pragma("unroll") for (int n = 0; n < 2; ++n) _Pragma("unroll") for (int k = 0; k < 2; ++k) dst[n][k] = *(const PG8_LAS bf16x8*)(lds + PG8_SB(b, h) + boff + n * 2048 + k * 1024); } while (0)
#define PG8_MMA(ai, bj, At, Bt) do { __builtin_amdgcn_s_setprio(1); _Pragma("unroll") for (int m = 0; m < 4; ++m) _Pragma("unroll") for (int n = 0; n < 2; ++n) _Pragma("unroll") for (int k = 0; k < 2; ++k) \
        acc[ai][bj][m][n] = __builtin_amdgcn_mfma_f32_16x16x32_bf16(Bt[n][k], At[m][k], acc[ai][bj][m][n], 0, 0, 0); __builtin_amdgcn_s_setprio(0); } while (0)
#define PG8_WAIT_V(n) asm volatile("s_waitcnt vmcnt(" #n ")" ::: "memory")
#define PG8_WAIT_L(n) asm volatile("s_waitcnt lgkmcnt(" #n ")" ::: "memory")
#define PG8_BAR __builtin_amdgcn_s_barrier()
#define PG8_SCHED __builtin_amdgcn_sched_barrier(0)
    Unit cur, nxt; int ui = 0;
    if (!S.next(0, cur)) return;
    f32x4 acc[2][2][4][2];
#pragma unroll
    for (int a = 0; a < 2; ++a)
#pragma unroll
        for (int b = 0; b < 2; ++b)
#pragma unroll
            for (int m = 0; m < 4; ++m)
#pragma unroll
                for (int n = 0; n < 2; ++n) acc[a][b][m][n] = (f32x4){0.f, 0.f, 0.f, 0.f};
    bf16x8 At[4][2], B0[2][2], B1[2][2];
    const char* cA = (const char*)g.A + (size_t)cur.pm * tstep; const char* cB = (const char*)g.Bt + (size_t)cur.pn * tstep;
    S.a_ready(cur);
    if constexpr (SP2) {
        PG8_STAGE(PG8_SB(0, 0), cB, voffB); PG8_STAGE(PG8_SB(0, 1), cB + hstep, voffB); PG8_STAGE(PG8_SA(0, 0), cA, voffA); PG8_STAGE(PG8_SA(0, 1), cA + hstep, voffA);
        if (wr == 1) PG8_BAR;
        PG8_WAIT_V(2); PG8_BAR;
        PG8_STAGE(PG8_SB(1, 0), cB + kstep, voffB); PG8_STAGE(PG8_SA(1, 0), cA + kstep, voffA); PG8_STAGE(PG8_SB(1, 1), cB + hstep + kstep, voffB);
        PG8_WAIT_V(6); PG8_BAR;
    } else {
        PG8_STAGE(PG8_SB(0, 0), cB, voffB); PG8_STAGE(PG8_SA(0, 0), cA, voffA); PG8_STAGE(PG8_SB(0, 1), cB + hstep, voffB); PG8_STAGE(PG8_SA(0, 1), cA + hstep, voffA);
        if (wr == 1) PG8_BAR;
        PG8_WAIT_V(4); PG8_BAR;
        PG8_STAGE(PG8_SB(1, 0), cB + kstep, voffB); PG8_STAGE(PG8_SA(1, 0), cA + kstep, voffA); PG8_STAGE(PG8_SB(1, 1), cB + hstep + kstep, voffB);
        PG8_WAIT_V(6); PG8_BAR;
    }
    for (;;) {
        const bool has_next = S.next(ui + 1, nxt);
        const char* nA = has_next ? (const char*)g.A + (size_t)nxt.pm * tstep : cA; const char* nB = has_next ? (const char*)g.Bt + (size_t)nxt.pn * tstep : cB;
        for (int t = 0; t < nt; t += 2) {
            const bool last = (t == nt - 2);
            const char* a1 = cA + (size_t)(t + 1) * kstep;
            const char* a2 = last ? nA : cA + (size_t)(t + 2) * kstep; const char* b2 = last ? nB : cB + (size_t)(t + 2) * kstep;
            const char* a3 = a2 + kstep; const char* b3 = b2 + kstep;
            if (last && has_next) S.a_ready(nxt);
            if constexpr (SP2) {
            PG8_LDB(B0, 0, 0); PG8_LDB(B1, 0, 1); PG8_SCHED; PG8_LDA(At, 0, 0); PG8_STAGE(PG8_SA(1, 1), a1 + hstep, voffA);
            PG8_WAIT_V(8); PG8_WAIT_L(0); PG8_BAR; PG8_MMA(0, 0, At, B0); PG8_MMA(0, 1, At, B1); PG8_BAR; PG8_SCHED;
            PG8_LDA(At, 0, 1); PG8_STAGE(PG8_SB(0, 0), b2, voffB); PG8_STAGE(PG8_SB(0, 1), b2 + hstep, voffB); PG8_STAGE(PG8_SA(0, 0), a2, voffA);
            PG8_WAIT_V(8); PG8_WAIT_L(0); PG8_BAR; PG8_MMA(1, 0, At, B0); PG8_MMA(1, 1, At, B1); PG8_BAR; PG8_SCHED;
            PG8_LDB(B0, 1, 0); PG8_LDB(B1, 1, 1); PG8_SCHED; PG8_LDA(At, 1, 0); PG8_STAGE(PG8_SA(0, 1), a2 + hstep, voffA);
            PG8_WAIT_V(8); PG8_WAIT_L(0); PG8_BAR; PG8_MMA(0, 0, At, B0); PG8_MMA(0, 1, At, B1); PG8_BAR; PG8_SCHED;
            PG8_LDA(At, 1, 1); PG8_STAGE(PG8_SB(1, 0), b3, voffB); PG8_STAGE(PG8_SB(1, 1), b3 + hstep, voffB); PG8_STAGE(PG8_SA(1, 0), a3, voffA);
            PG8_WAIT_V(8); PG8_WAIT_L(0); PG8_BAR; PG8_MMA(1, 0, At, B0); PG8_MMA(1, 1, At, B1); PG8_BAR; PG8_SCHED;
            } else {
            PG8_LDB(B0, 0, 0); PG8_SCHED; PG8_LDA(At, 0, 0); PG8_STAGE(PG8_SA(1, 1), a1 + hstep, voffA);
            PG8_WAIT_L(8); PG8_BAR; PG8_WAIT_L(0); PG8_MMA(0, 0, At, B0); PG8_BAR; PG8_SCHED;
            PG8_LDB(B1, 0, 1); PG8_STAGE(PG8_SB(0, 0), b2, voffB);
            PG8_BAR; PG8_WAIT_L(0); PG8_MMA(0, 1, At, B1); PG8_BAR;
            PG8_LDA(At, 0, 1); PG8_STAGE(PG8_SA(0, 0), a2, voffA);
            PG8_BAR; PG8_WAIT_L(0); PG8_MMA(1, 0, At, B0); PG8_BAR; PG8_SCHED;
            PG8_STAGE(PG8_SB(0, 1), b2 + hstep, voffB);
            PG8_WAIT_V(6); PG8_BAR; PG8_MMA(1, 1, At, B1); PG8_BAR;
            PG8_LDB(B0, 1, 0); PG8_SCHED; PG8_LDA(At, 1, 0); PG8_STAGE(PG8_SA(0, 1), a2 + hstep, voffA);
            PG8_WAIT_L(8); PG8_BAR; PG8_WAIT_L(0); PG8_MMA(0, 0, At, B0); PG8_BAR; PG8_SCHED;
            PG8_LDB(B1, 1, 1); PG8_STAGE(PG8_SB(1, 0), b3, voffB);
            PG8_BAR; PG8_WAIT_L(0); PG8_MMA(0, 1, At, B1); PG8_BAR;
            PG8_LDA(At, 1, 1); PG8_STAGE(PG8_SA(1, 0), a3, voffA);
            PG8_BAR; PG8_WAIT_L(0); PG8_MMA(1, 0, At, B0); PG8_BAR; PG8_SCHED;
            PG8_STAGE(PG8_SB(1, 1), b3 + hstep, voffB);
            PG8_WAIT_V(6); PG8_BAR; PG8_MMA(1, 1, At, B1); PG8_BAR;
            }
        }
        if constexpr (ALIGN_EPI) { if (wr == 0) PG8_BAR; }
        if constexpr (!Epi::AFTER_DRAIN) { E(acc, cur, wr, wc, fr, fq); S.done(cur); }
        if (!has_next) break;
#pragma unroll
        for (int a = 0; a < 2; ++a)
#pragma unroll
            for (int b = 0; b < 2; ++b)
#pragma unroll
                for (int m = 0; m < 4; ++m)
#pragma unroll
                    for (int n = 0; n < 2; ++n) acc[a][b][m][n] = (f32x4){0.f, 0.f, 0.f, 0.f};
        cur = nxt; cA = nA; cB = nB; ++ui;
        if constexpr (ALIGN_EPI) { if (wr == 1) PG8_BAR; }
    }
    PG8_WAIT_V(0);
    if constexpr (!ALIGN_EPI) { if (wr == 0) PG8_BAR; }
    PG8_BAR;
    if constexpr (Epi::AFTER_DRAIN) { E.fused(acc, cur, wr, wc, fr, fq, lds, wid, lane); S.done(cur); }
#undef PG8_SA
#undef PG8_SB
#undef PG8_STAGE
#undef PG8_LDA
#undef PG8_LDB
#undef PG8_MMA
#undef PG8_WAIT_V
#undef PG8_WAIT_L
#undef PG8_BAR
#undef PG8_SCHED
}
}

typedef unsigned short bf16;
typedef short bf16x8 __attribute__((ext_vector_type(8)));
typedef short bf16x4 __attribute__((ext_vector_type(4)));
typedef float f32x4 __attribute__((ext_vector_type(4)));
typedef unsigned u32x4 __attribute__((ext_vector_type(4)));
typedef unsigned u32x2 __attribute__((ext_vector_type(2)));
#define LAS __attribute__((address_space(3)))
constexpr int NWAVES = 8, NTHR = 512;
constexpr int DM = 1024, T = 8192, NB = 2, NTOKP = NB * T, SB = 32, NTOK = NTOKP + SB, MPAD = 16640;
constexpr int DIN = 6440, DINP = 6656, DFF = 2816, DUP = 2 * DFF;
constexpr int C_Q = 0, C_KV = 512, C_G = 1280, C_GQ = 1304, C_GK = 1560, C_GV = 1816, C_LR = 2328, C_GR = 2344, C_XQ = 2856, C_MG = 3368;
constexpr float EPS = 1e-6f, LOG2E = 1.4426950408889634f;
constexpr float QSCALE = 0.125f * LOG2E;
constexpr float XSCALE = 0.08838834764831845f * LOG2E;
constexpr size_t O_Y = 0, O_YS = 16777216, O_KVP = O_YS + 32768, O_WINP = O_KVP + 8388608, O_GLAP = O_WINP + 262144, O_CONVP = O_GLAP + 65536,
                 O_MEMP = O_CONVP + 11264, O_KVS = O_MEMP + 524288, O_WINS = O_KVS + 16384, O_GLAS = O_WINS + 4194304, O_CONVS = O_GLAS + 1048576, O_END = O_CONVS + 180224;
enum { I_XP = 0, I_XS, I_CKV, I_CWIN, I_SGLA, I_SCONV, I_CMEM, I_PT, I_MEMP, I_GMIX, I_WIN, I_GNQ, I_GNK, I_CKPE, I_CKW1, I_CKW2, I_CVPE, I_CVW1, I_CVW2,
       I_RB, I_WGG, I_BGG, I_GGO, I_GMEM, I_WMEM, I_GXQ, I_GXK, I_WNSA, I_WGLA, I_WX, I_WO, I_GFFN, I_WUP, I_CONVW, I_CONVB, I_WDOWN, N_IN };
constexpr size_t al_(size_t x) { return (x + 255) & ~(size_t)255; }
constexpr size_t WS_SSQ = 0;
constexpr size_t WS_C0 = al_(WS_SSQ + (size_t)MPAD * 4);
constexpr size_t WS_WTIN = al_(WS_C0 + 1024);
constexpr size_t WS_WTMEM = al_(WS_WTIN + (size_t)DINP * 1024 * 2);
constexpr size_t WS_WTNSA = al_(WS_WTMEM + (size_t)1024 * 1024 * 2);
constexpr size_t WS_WTGLA = al_(WS_WTNSA + (size_t)1024 * 512 * 2);
constexpr size_t WS_WTX = al_(WS_WTGLA + (size_t)1024 * 512 * 2);
constexpr size_t WS_WTO = al_(WS_WTX + (size_t)1024 * 512 * 2);
constexpr size_t WS_WTUP = al_(WS_WTO + (size_t)1024 * 1024 * 2);
constexpr size_t WS_WTDOWN = al_(WS_WTUP + (size_t)DUP * 1024 * 2);
constexpr size_t WS_W1T = al_(WS_WTDOWN + (size_t)1024 * DFF * 2);
constexpr size_t WS_W2T = al_(WS_W1T + (size_t)2 * 64 * 2048 * 2);
constexpr size_t WS_XN = al_(WS_W2T + (size_t)2 * 64 * 64 * 2);
constexpr size_t WS_MN = al_(WS_XN + (size_t)MPAD * 1024 * 2);
constexpr size_t WS_PROJ = al_(WS_MN + (size_t)512 * 1024 * 2);
constexpr size_t WS_MEMPROJ = al_(WS_PROJ + (size_t)MPAD * DINP * 2);
constexpr size_t WS_QN = al_(WS_MEMPROJ + (size_t)512 * 1024 * 2);
constexpr size_t WS_KSEL = al_(WS_QN + (size_t)NTOK * 512 * 2);
constexpr size_t WS_VSELT = al_(WS_KSEL + (size_t)4 * T * 64 * 2);
constexpr size_t WS_KWIN = al_(WS_VSELT + (size_t)4 * T * 64 * 2);
constexpr size_t WS_VWINT = al_(WS_KWIN + (size_t)4 * T * 64 * 2);
constexpr size_t WS_GATES = al_(WS_VWINT + (size_t)4 * T * 64 * 2);
constexpr size_t WS_NEWKV = al_(WS_GATES + (size_t)NTOK * 24 * 4);
constexpr size_t WS_KCMP = al_(WS_NEWKV + (size_t)SB * 4 * 2 * 64 * 4);
constexpr size_t WS_VCMPT = al_(WS_KCMP + (size_t)4 * 512 * 64 * 2);
constexpr size_t WS_KCMPS = al_(WS_VCMPT + (size_t)4 * 512 * 64 * 2);
constexpr size_t WS_VCMPS = al_(WS_KCMPS + (size_t)SB * 2 * 512 * 64 * 4);
constexpr size_t WS_QTG = al_(WS_VCMPS + (size_t)SB * 2 * 512 * 64 * 4);
constexpr size_t WS_KTG = al_(WS_QTG + (size_t)NTOKP * 256 * 2);
constexpr size_t WS_VTG = al_(WS_KTG + (size_t)NTOKP * 256 * 2);
constexpr size_t WS_UP = al_(WS_VTG + (size_t)256 * 4 * 128 * 64 * 2);
constexpr size_t WS_DEC = al_(WS_UP + (size_t)256 * 4 * 128 * 64 * 4);
constexpr size_t WS_SC = al_(WS_DEC + (size_t)256 * 4 * 64 * 4);
constexpr size_t WS_XQ = al_(WS_SC + (size_t)256 * 4 * 128 * 64 * 2);
constexpr size_t WS_KMEM = al_(WS_XQ + (size_t)NTOK * 512 * 2);
constexpr size_t WS_VMEMT = al_(WS_KMEM + (size_t)8 * 256 * 128 * 2);
constexpr size_t WS_ONSA = al_(WS_VMEMT + (size_t)8 * 256 * 128 * 2);
constexpr size_t WS_OGLA = al_(WS_ONSA + (size_t)MPAD * 512 * 2);
constexpr size_t WS_OX = al_(WS_OGLA + (size_t)MPAD * 512 * 2);
constexpr size_t WS_MERGED = al_(WS_OX + (size_t)MPAD * 512 * 2);
constexpr size_t WS_X1 = al_(WS_MERGED + (size_t)MPAD * 1024 * 2);
constexpr size_t WS_X1B = al_(WS_X1 + (size_t)MPAD * 1024 * 4);
constexpr size_t WS_UG = al_(WS_X1B + (size_t)MPAD * 1024 * 2);
constexpr size_t WS_ACT = al_(WS_UG + (size_t)MPAD * DUP * 2);
constexpr size_t WS_MS = al_(WS_ACT + (size_t)MPAD * DFF * 2);
constexpr size_t WS_X1S = al_(WS_MS + (size_t)SB * 1024 * 4);
constexpr size_t WS_CTL = al_(WS_X1S + (size_t)SB * 1024 * 4);
constexpr size_t CTL_BYTES = 16384;
constexpr size_t WS_END = al_(WS_CTL + CTL_BYTES);
constexpr int RING_BYTES = 131072, LDS_BYTES = 155648;

struct Args { const float* in[N_IN]; float* out; unsigned char* ws; int ph_lo, ph_hi, sub, pad; };

__device__ __forceinline__ unsigned f2bf(float f) { unsigned u = __float_as_uint(f); return (u + 0x7fffu + ((u >> 16) & 1u)) >> 16; }
__device__ __forceinline__ unsigned pk2(float lo, float hi) { return pg8::cvt_pk_bf16(lo, hi); }
__device__ __forceinline__ float bf2f(unsigned short u) { return __uint_as_float((unsigned)u << 16); }
__device__ __forceinline__ float bflo(unsigned w) { return __uint_as_float(w << 16); }
__device__ __forceinline__ float bfhi(unsigned w) { return __uint_as_float(w & 0xffff0000u); }
__device__ __forceinline__ void unpack8(const u32x4 w, float (&f)[8]) { f[0] = bflo(w.x); f[1] = bfhi(w.x); f[2] = bflo(w.y); f[3] = bfhi(w.y); f[4] = bflo(w.z); f[5] = bfhi(w.z); f[6] = bflo(w.w); f[7] = bfhi(w.w); }
__device__ __forceinline__ u32x4 pack8(const float (&f)[8]) { u32x4 w; w.x = pk2(f[0], f[1]); w.y = pk2(f[2], f[3]); w.z = pk2(f[4], f[5]); w.w = pk2(f[6], f[7]); return w; }
__device__ __forceinline__ bf16x8 as_frag(u32x4 w) { return __builtin_bit_cast(bf16x8, w); }
__device__ __forceinline__ bf16x8 frag_pk(f32x4 a, f32x4 b) { u32x4 w; w.x = pk2(a[0], a[1]); w.y = pk2(a[2], a[3]); w.z = pk2(b[0], b[1]); w.w = pk2(b[2], b[3]); return as_frag(w); }
__device__ __forceinline__ bf16x8 ldfrag(const bf16* p) { return as_frag(*(const u32x4*)p); }
__device__ __forceinline__ bf16x8 ldfrag2(const bf16* p0, const bf16* p1) { const u32x2 a = *(const u32x2*)p0, b = *(const u32x2*)p1; u32x4 w; w.x = a.x; w.y = a.y; w.z = b.x; w.w = b.y; return as_frag(w); }
__device__ __forceinline__ bf16x8 ldfrag_f32(const float* p) { const f32x4 a = *(const f32x4*)p, b = *(const f32x4*)(p + 4); return frag_pk(a, b); }
#define MFMA16(a, b, c) __builtin_amdgcn_mfma_f32_16x16x32_bf16((a), (b), (c), 0, 0, 0)
__device__ __forceinline__ float sigmoidf_(float x) { return 1.0f / (1.0f + __expf(-x)); }
__device__ __forceinline__ float gelu_tanh(float x) { const float u = 0.7978845608028654f * (x + 0.044715f * x * x * x); const float e = __expf(2.0f * u); return 0.5f * x * (2.0f - 2.0f / (e + 1.0f)); }
__device__ __forceinline__ float wave_sum(float v) {
#pragma unroll
    for (int o = 1; o < 64; o <<= 1) v += __shfl_xor(v, o);
    return v;
}
__device__ __forceinline__ float wave_max(float v) {
#pragma unroll
    for (int o = 1; o < 64; o <<= 1) v = fmaxf(v, __shfl_xor(v, o));
    return v;
}
__device__ __forceinline__ float absmax_arr(const float* g, int n, int lane) { float m = 0.f; for (int i = lane; i < n; i += 64) m = fmaxf(m, fabsf(g[i])); return wave_max(m); }
__device__ __forceinline__ int t5_bucket(int n) {
    if (n < 16) return n;
    if (n >= 128) return 31;
    const int v = 16 + (int)(__logf((float)n * 0.0625f) / 2.0794415416798357f * 16.0f);
    return v < 31 ? v : 31;
}

#define XB_TMO      128
#define XB_XCNT(j)  (256  + 64 * (j))
#define XB_XSUB(j)  (1280 + 64 * (j))
#define XB_XGEN(j)  (2304 + 64 * (j))
#define XB_TOP      3328
#define XB_TOPGEN   3392
#define XCD_BAR_WORDS 3456
#define XB_SPIN_CAP (1u << 18)

__device__ __forceinline__ unsigned xb_ld(unsigned* p)              { return __hip_atomic_load(p, __ATOMIC_RELAXED, __HIP_MEMORY_SCOPE_AGENT); }
__device__ __forceinline__ unsigned xb_add(unsigned* p, unsigned v) { return __hip_atomic_fetch_add(p, v, __ATOMIC_RELAXED, __HIP_MEMORY_SCOPE_AGENT); }
__device__ __forceinline__ unsigned xb_xcc_id() { return (unsigned)__builtin_amdgcn_s_getreg((3 << 11) | 20) & 0xFu; }
#define XB_SPIN(cond, bar) do { unsigned _sp = 0; while (cond) { __builtin_amdgcn_s_sleep(1); \
    if ((++_sp & 255u) == 0u) { if (xb_ld(&(bar)[XB_TMO])) break; if (_sp > XB_SPIN_CAP) { atomicAdd(&(bar)[XB_TMO], 1u); break; } } } } while (0)

struct XcdBarrier {
    unsigned* bar; unsigned x;
    volatile LAS unsigned* st;
};

__device__ __forceinline__ XcdBarrier xcd_barrier_post(unsigned* bar, volatile LAS unsigned* st) {
    XcdBarrier b; b.bar = bar; b.x = xb_xcc_id(); b.st = st;
    if (threadIdx.x == 0) (void)xb_add(&bar[XB_XCNT(b.x)], 1u);
    return b;
}
__device__ __forceinline__ void xcd_barrier_complete(unsigned* bar, unsigned x, unsigned& nloc, unsigned& nx) {
    const unsigned G = gridDim.x * gridDim.y * gridDim.z;
    unsigned sum, cnt, mine, sp = 0u;
    for (;;) {
        sum = 0u; cnt = 0u; mine = 0u;
#pragma unroll
        for (unsigned j = 0; j < 16; ++j) { const unsigned c = xb_ld(&bar[XB_XCNT(j)]); sum += c; cnt += (c > 0u) ? 1u : 0u; mine = (j == x) ? c : mine; }
        if (sum == G) break;
        __builtin_amdgcn_s_sleep(1);
        if ((++sp & 255u) == 0u) { if (xb_ld(&bar[XB_TMO])) break; if (sp > XB_SPIN_CAP) { atomicAdd(&bar[XB_TMO], 1u); break; } }
    }
    nloc = mine > 0u ? mine : 1u; nx = cnt > 0u ? cnt : 1u;
}

__device__ __forceinline__ void xcd_barrier(const XcdBarrier& b) {
    asm volatile("s_waitcnt vmcnt(0)" ::: "memory");
    __syncthreads();
    if (threadIdx.x == 0) {
        unsigned* bar = b.bar;
        __builtin_amdgcn_s_waitcnt(0);
        unsigned nloc = b.st[0], nx = b.st[1];
        if (nloc == 0u) { xcd_barrier_complete(bar, b.x, nloc, nx); b.st[0] = nloc; b.st[1] = nx; }
        const unsigned old = xb_add(&bar[XB_XSUB(b.x)], 1u);
        const unsigned gen = old / nloc;
        if (old + 1u == (gen + 1u) * nloc) {
            __builtin_amdgcn_fence(__ATOMIC_RELEASE, "agent");
            asm volatile("s_waitcnt vmcnt(0)" ::: "memory");
            const unsigned og = xb_add(&bar[XB_TOP], 1u);
            const unsigned tg = og / nx;
            if (og + 1u == (tg + 1u) * nx) xb_add(&bar[XB_TOPGEN], 1u);
            else XB_SPIN(xb_ld(&bar[XB_TOPGEN]) == tg, bar);
            __builtin_amdgcn_fence(__ATOMIC_ACQUIRE, "agent");
            xb_add(&bar[XB_XGEN(b.x)], 1u);
            asm volatile("s_waitcnt vmcnt(0)" ::: "memory");
        } else {
            XB_SPIN(xb_ld(&bar[XB_XGEN(b.x)]) == gen, bar);
            __builtin_amdgcn_fence(__ATOMIC_ACQUIRE, "agent");
            asm volatile("s_waitcnt vmcnt(0)" ::: "memory");
        }
    }
    __syncthreads();
}

struct Frame {
    LAS unsigned char* lds;
    int wave, G, bid, gw, NGW;
    const float* const* in; float* out; unsigned char* ws;
};
#define WSP(T_, off) ((T_*)(F.ws + (off)))
__device__ __forceinline__ int lane_id_() { unsigned z = 0u; asm volatile("" : "+v"(z)); return (int)__builtin_amdgcn_mbcnt_hi(~0u, __builtin_amdgcn_mbcnt_lo(~0u, z)); }
#define LANE_ lane_id_()
#define TID_ (F.wave * 64 + lane_id_())

__device__ __forceinline__ void transpose_item(const float* W, int K, int N, bf16* WT, const float* kscale, LAS float* scr, int item, int nblk, int lane) {
    const int kb = item / nblk, nb = item % nblk, k0 = 64 * kb, n0 = 32 * nb;
#pragma unroll
    for (int i = 0; i < 8; ++i) { const int kk = 8 * i + (lane >> 3); const int n = n0 + 4 * (lane & 7);
        f32x4 v = n < N ? *(const f32x4*)(W + (size_t)(k0 + kk) * N + n) : (f32x4){0.f, 0.f, 0.f, 0.f}; if (kscale) v = v * kscale[k0 + kk];
        LAS float* d = scr + kk * 33 + 4 * (lane & 7); d[0] = v[0]; d[1] = v[1]; d[2] = v[2]; d[3] = v[3]; }
    asm volatile("s_waitcnt lgkmcnt(0)" ::: "memory");
    const int c = lane & 7;
#pragma unroll
    for (int j = 0; j < 4; ++j) { const int n = (lane >> 3) + 8 * j; const LAS float* s = scr + (8 * c) * 33 + n;
        u32x4 o; o.x = pk2(s[0 * 33], s[1 * 33]); o.y = pk2(s[2 * 33], s[3 * 33]); o.z = pk2(s[4 * 33], s[5 * 33]); o.w = pk2(s[6 * 33], s[7 * 33]);
        *(u32x4*)(WT + (size_t)(n0 + n) * K + k0 + 8 * c) = o; }
    asm volatile("s_waitcnt lgkmcnt(0)" ::: "memory");
}
__device__ __forceinline__ void rms_row_to_bf16(const float* xrow, const float* g, bf16* orow, int lane) {
    unsigned long long* o8 = (unsigned long long*)orow + lane;
    if (!xrow) {
#pragma unroll
        for (int j = 0; j < 4; ++j) o8[64 * j] = 0ull;
        return; }
    const f32x4* xr = (const f32x4*)xrow + lane; const f32x4* gr = (const f32x4*)g + lane;
    f32x4 v[4]; float s = 0.f;
#pragma unroll
    for (int j = 0; j < 4; ++j) { v[j] = xr[64 * j]; s += (v[j].x * v[j].x + v[j].y * v[j].y) + (v[j].z * v[j].z + v[j].w * v[j].w); }
    const float rs = rsqrtf(wave_sum(s) * (1.f / 1024.f) + EPS);
#pragma unroll
    for (int j = 0; j < 4; ++j) { const f32x4 gg = gr[64 * j]; const f32x4 y = v[j] * rs * gg;
        o8[64 * j] = (unsigned long long)pk2(y.x, y.y) | ((unsigned long long)pk2(y.z, y.w) << 32); }
}
__device__ __forceinline__ void p0_prologue(Frame& F) {
    LAS float* scr = (LAS float*)(F.lds + F.wave * 16384);
    const int gw = F.gw, NGW = F.NGW;
    constexpr int IT_IN = 16 * 208, IT_MEM = 16 * 32, IT_BR = 8 * 32, IT_O = 16 * 32, IT_UP = 16 * 176, IT_DOWN = 44 * 32, IT_W1 = 32 * 2, IT_W2 = 1 * 2;
    constexpr int NITEMS = IT_IN + IT_MEM + 3 * IT_BR + IT_O + IT_UP + IT_DOWN + 2 * IT_W1 + 2 * IT_W2;
    const int ipw = (NITEMS + NGW - 1) / NGW;
    for (int it = gw * ipw; it < NITEMS && it < (gw + 1) * ipw; ++it) {
        int r = it;
        if (r < IT_UP) { transpose_item(F.in[I_WUP], 1024, DUP, WSP(bf16, WS_WTUP), F.in[I_GFFN], scr, r, 176, LANE_); continue; } r -= IT_UP;
        if (r < IT_IN) { transpose_item(F.in[I_WIN], 1024, DIN, WSP(bf16, WS_WTIN), nullptr, scr, r, 208, LANE_); continue; } r -= IT_IN;
        if (r < IT_DOWN) { transpose_item(F.in[I_WDOWN], DFF, 1024, WSP(bf16, WS_WTDOWN), nullptr, scr, r, 32, LANE_); continue; } r -= IT_DOWN;
        if (r < IT_MEM) { transpose_item(F.in[I_WMEM], 1024, 1024, WSP(bf16, WS_WTMEM), nullptr, scr, r, 32, LANE_); continue; } r -= IT_MEM;
        if (r < IT_O) { transpose_item(F.in[I_WO], 1024, 1024, WSP(bf16, WS_WTO), nullptr, scr, r, 32, LANE_); continue; } r -= IT_O;
        if (r < IT_BR) { transpose_item(F.in[I_WNSA], 512, 1024, WSP(bf16, WS_WTNSA), nullptr, scr, r, 32, LANE_); continue; } r -= IT_BR;
        if (r < IT_BR) { transpose_item(F.in[I_WGLA], 512, 1024, WSP(bf16, WS_WTGLA), nullptr, scr, r, 32, LANE_); continue; } r -= IT_BR;
        if (r < IT_BR) { transpose_item(F.in[I_WX], 512, 1024, WSP(bf16, WS_WTX), nullptr, scr, r, 32, LANE_); continue; } r -= IT_BR;
        if (r < IT_W1) { transpose_item(F.in[I_CKW1], 2048, 64, WSP(bf16, WS_W1T), nullptr, scr, r, 2, LANE_); continue; } r -= IT_W1;
        if (r < IT_W1) { transpose_item(F.in[I_CVW1], 2048, 64, WSP(bf16, WS_W1T) + 64 * 2048, nullptr, scr, r, 2, LANE_); continue; } r -= IT_W1;
        if (r < IT_W2) { transpose_item(F.in[I_CKW2], 64, 64, WSP(bf16, WS_W2T), nullptr, scr, r, 2, LANE_); continue; } r -= IT_W2;
        transpose_item(F.in[I_CVW2], 64, 64, WSP(bf16, WS_W2T) + 64 * 64, nullptr, scr, r, 2, LANE_);
    }
    for (int m = gw; m < MPAD + 512; m += NGW) {
        if (m < MPAD) { const float* xr = m < NTOKP ? F.in[I_XP] + (size_t)m * 1024 : (m < NTOK ? F.in[I_XS] + (size_t)(m - NTOKP) * 1024 : nullptr);
            rms_row_to_bf16(xr, F.in[I_GMIX], WSP(bf16, WS_XN) + (size_t)m * 1024, LANE_); }
        else { const int mm = m - MPAD; rms_row_to_bf16(F.in[I_MEMP] + (size_t)mm * 1024, F.in[I_GMEM], WSP(bf16, WS_MN) + (size_t)mm * 1024, LANE_); }
    }
    { float* ssq = WSP(float, WS_SSQ); for (int i = F.bid * NTHR + TID_; i < MPAD; i += F.G * NTHR) ssq[i] = 0.f; }
    { float* ms = WSP(float, WS_MS); float* x1s = WSP(float, WS_X1S); const float* xs = F.in[I_XS];
      for (int i = F.bid * NTHR + TID_; i < SB * 1024; i += F.G * NTHR) { ms[i] = 0.f; x1s[i] = xs[i]; } }
    { const f32x4* src = (const f32x4*)F.in[I_CWIN]; f32x4* dst = (f32x4*)(F.out + O_WINS);
      for (int i = F.bid * NTHR + TID_; i < SB * 511 * 64; i += F.G * NTHR) { const int b = i / (511 * 64), r = i % (511 * 64); dst[(size_t)b * 512 * 64 + r] = src[(size_t)b * 512 * 64 + 64 + r]; } }
}

__device__ __forceinline__ void p2_token(Frame& F, int tok) {
    const int lane = LANE_; const bf16* pr = WSP(bf16, WS_PROJ) + (size_t)tok * DINP;
    const bool prompt = tok < NTOKP; const int b = tok >> 13, t = tok & (T - 1), sb = tok - NTOKP;
    float f[8];
    { unpack8(*(const u32x4*)(pr + C_Q + 8 * lane), f); float ss = 0.f;
#pragma unroll
      for (int i = 0; i < 8; ++i) ss += f[i] * f[i];
      ss += __shfl_xor(ss, 1); ss += __shfl_xor(ss, 2); ss += __shfl_xor(ss, 4);
      const float rs = rsqrtf(ss * (1.f / 64.f) + EPS) * QSCALE; const float* g = F.in[I_GNQ] + 8 * (lane & 7);
#pragma unroll
      for (int i = 0; i < 8; ++i) f[i] *= rs * g[i];
      *(u32x4*)(WSP(bf16, WS_QN) + (size_t)tok * 512 + 8 * lane) = pack8(f); }
    { unpack8(*(const u32x4*)(pr + C_KV + 8 * lane), f); float ss = 0.f;
#pragma unroll
      for (int i = 0; i < 8; ++i) ss += f[i] * f[i];
      ss += __shfl_xor(ss, 1); ss += __shfl_xor(ss, 2); ss += __shfl_xor(ss, 4);
      const int grp = lane >> 3, slot = grp >> 1, kv = grp & 1, d0 = 8 * (lane & 7);
      if (slot == 2) { const float rs = rsqrtf(ss * (1.f / 64.f) + EPS); const float* g = F.in[I_GNK] + 64 + d0;
#pragma unroll
          for (int i = 0; i < 8; ++i) f[i] *= rs * g[i]; }
      float* orow = prompt ? F.out + O_KVP + (size_t)tok * 512 + 8 * lane : F.out + O_KVS + (size_t)sb * 512 + 8 * lane;
      *(f32x4*)orow = (f32x4){f[0], f[1], f[2], f[3]}; *(f32x4*)(orow + 4) = (f32x4){f[4], f[5], f[6], f[7]};
      if (prompt) {
          if (slot == 2) *(u32x4*)(WSP(bf16, WS_KSEL) + ((size_t)(b * 2 + kv) * T + t) * 64 + d0) = pack8(f);
          if (slot == 3) { bf16* vt = WSP(bf16, WS_VSELT) + (((size_t)(b * 2 + kv) * 128 + (t >> 6)) * 64 + d0) * 64 + (t & 63);
#pragma unroll
              for (int i = 0; i < 8; ++i) vt[i * 64] = (bf16)f2bf(f[i]); }
      } else if (slot >= 2) { float* nk = WSP(float, WS_NEWKV) + ((size_t)(sb * 4 + (slot - 2)) * 2 + kv) * 64 + d0;
#pragma unroll
          for (int i = 0; i < 8; ++i) nk[i] = f[i]; }
    }
    { unpack8(*(const u32x4*)(pr + C_KV + 512 + 8 * lane), f); float ss = 0.f;
#pragma unroll
      for (int i = 0; i < 8; ++i) ss += f[i] * f[i];
      ss += __shfl_xor(ss, 1); ss += __shfl_xor(ss, 2); ss += __shfl_xor(ss, 4);
      const int grp = lane >> 3, slot = 4 + (grp >> 1), kv = grp & 1, d0 = 8 * (lane & 7);
      if (lane < 32) {
          if (slot == 4) { const float rs = rsqrtf(ss * (1.f / 64.f) + EPS); const float* g = F.in[I_GNK] + 128 + d0;
#pragma unroll
              for (int i = 0; i < 8; ++i) f[i] *= rs * g[i]; }
          if (prompt) {
              if (slot == 4) *(u32x4*)(WSP(bf16, WS_KWIN) + ((size_t)(b * 2 + kv) * T + t) * 64 + d0) = pack8(f);
              else { bf16* vt = WSP(bf16, WS_VWINT) + (((size_t)(b * 2 + kv) * 128 + (t >> 6)) * 64 + d0) * 64 + (t & 63);
#pragma unroll
                  for (int i = 0; i < 8; ++i) vt[i * 64] = (bf16)f2bf(f[i]); }
              if (t >= T - 512) { float* orow = F.out + O_WINP + ((size_t)b * 512 + (t - (T - 512))) * 256 + 8 * lane;
                  *(f32x4*)orow = (f32x4){f[0], f[1], f[2], f[3]}; *(f32x4*)(orow + 4) = (f32x4){f[4], f[5], f[6], f[7]}; }
          } else {
              float* nk = WSP(float, WS_NEWKV) + ((size_t)(sb * 4 + (slot - 2)) * 2 + kv) * 64 + d0;
#pragma unroll
              for (int i = 0; i < 8; ++i) nk[i] = f[i];
              float* orow = F.out + O_WINS + ((size_t)sb * 512 + 511) * 256 + 8 * lane;
              *(f32x4*)orow = (f32x4){f[0], f[1], f[2], f[3]}; *(f32x4*)(orow + 4) = (f32x4){f[4], f[5], f[6], f[7]};
          }
      }
    }
    if (lane < 24) WSP(float, WS_GATES)[(size_t)tok * 24 + lane] = sigmoidf_(bf2f(pr[C_G + lane]));
    { unpack8(*(const u32x4*)(pr + C_XQ + 8 * lane), f); float ss = 0.f;
#pragma unroll
      for (int i = 0; i < 8; ++i) ss += f[i] * f[i];
      ss += __shfl_xor(ss, 1); ss += __shfl_xor(ss, 2); ss += __shfl_xor(ss, 4); ss += __shfl_xor(ss, 8);
      const float rs = rsqrtf(ss * (1.f / 128.f) + EPS) * XSCALE; const float* g = F.in[I_GXQ] + 8 * (lane & 15);
#pragma unroll
      for (int i = 0; i < 8; ++i) f[i] *= rs * g[i];
      *(u32x4*)(WSP(bf16, WS_XQ) + (size_t)tok * 512 + 8 * lane) = pack8(f); }
}
__device__ __forceinline__ void p2_memrow(Frame& F, int row) {
    const int lane = LANE_, b = row >> 8, m = row & 255, head = lane >> 4, d0 = 8 * (lane & 15);
    const bf16* pr = WSP(bf16, WS_MEMPROJ) + (size_t)row * 1024; float f[8];
    { unpack8(*(const u32x4*)(pr + 8 * lane), f); float ss = 0.f;
#pragma unroll
      for (int i = 0; i < 8; ++i) ss += f[i] * f[i];
      ss += __shfl_xor(ss, 1); ss += __shfl_xor(ss, 2); ss += __shfl_xor(ss, 4); ss += __shfl_xor(ss, 8);
      const float rs = rsqrtf(ss * (1.f / 128.f) + EPS); const float* g = F.in[I_GXK] + d0;
#pragma unroll
      for (int i = 0; i < 8; ++i) f[i] *= rs * g[i];
      float* orow = F.out + O_MEMP + ((size_t)row * 2 + 0) * 512 + 8 * lane;
      *(f32x4*)orow = (f32x4){f[0], f[1], f[2], f[3]}; *(f32x4*)(orow + 4) = (f32x4){f[4], f[5], f[6], f[7]};
      *(u32x4*)(WSP(bf16, WS_KMEM) + ((size_t)(b * 4 + head) * 256 + m) * 128 + d0) = pack8(f); }
    { unpack8(*(const u32x4*)(pr + 512 + 8 * lane), f);
      float* orow = F.out + O_MEMP + ((size_t)row * 2 + 1) * 512 + 8 * lane;
      *(f32x4*)orow = (f32x4){f[0], f[1], f[2], f[3]}; *(f32x4*)(orow + 4) = (f32x4){f[4], f[5], f[6], f[7]};
      bf16* vt = WSP(bf16, WS_VMEMT) + ((size_t)(b * 4 + head) * 128 + d0) * 256 + m;
#pragma unroll
      for (int i = 0; i < 8; ++i) vt[i * 256] = (bf16)f2bf(f[i]); }
}

constexpr int CMP_TASKS_S = SB * 2 * 2, CMP_TASKS_P = NB * 2 * 2;
__device__ __forceinline__ int cmp_tile_off16(int row, int c16) { return row * 128 + ((c16 ^ (row & 7)) << 4); }
__device__ __forceinline__ void p2_compress(Frame& F, int task) {
    const int lane = LANE_, r = lane & 15, q = lane >> 4, w = F.wave, tid_ = w * 64 + lane;
    const bool smp = task < CMP_TASKS_S; const int x = smp ? task : task - CMP_TASKS_S;
    const int b = x >> 2, kv = (x >> 1) & 1, slot = x & 1, i0 = 64 * w;
    const bf16* W1t = WSP(bf16, WS_W1T) + (size_t)slot * 64 * 2048;
    const bf16* W2t = WSP(bf16, WS_W2T) + (size_t)slot * 64 * 64;
    const int* pt = (const int*)F.in[I_PT] + b * 64;
    const float* ckv = F.in[I_CKV]; const float* pe = F.in[slot ? I_CVPE : I_CKPE];
    const bf16* proj = WSP(bf16, WS_PROJ);
    LAS unsigned char* wb = F.lds;
    const int srow = tid_ >> 3, sc16 = tid_ & 7, soff = cmp_tile_off16(srow, sc16);
    int kb0[2]; kb0[0] = r * 128 + (((0 + q) ^ (r & 7)) << 4); kb0[1] = r * 128 + (((4 + q) ^ (r & 7)) << 4);
    f32x4 acc[4][4];
#pragma unroll
    for (int nt = 0; nt < 4; ++nt)
#pragma unroll
        for (int it = 0; it < 4; ++it) acc[nt][it] = (f32x4){0.f, 0.f, 0.f, 0.f};
    int pg0[4], pg1[4];
#pragma unroll
    for (int it = 0; it < 4; ++it) { const int pb = (16 * (i0 + 16 * it + r)) >> 7; pg0[it] = smp ? pt[pb] : 0; pg1[it] = smp ? pt[pb < 63 ? pb + 1 : 63] : 0; }
    const bf16* wsrc = W1t + (size_t)srow * 2048 + sc16 * 8;
    u32x4 rw = *(const u32x4*)wsrc;
    u32x4 xr[2][4][2];
#define CMP_LOAD_ROWS(KP) do { _Pragma("unroll") for (int it = 0; it < 4; ++it) { int tok = 16 * (i0 + 16 * it + r) + (KP); tok = tok < T ? tok : T - 1; \
        _Pragma("unroll") for (int ks2 = 0; ks2 < 2; ++ks2) { const int d = 32 * ks2 + 8 * q; \
            if (smp) { const int page = (tok >> 7) == ((16 * (i0 + 16 * it + r)) >> 7) ? pg0[it] : pg1[it]; \
                const float* src = ckv + (((size_t)page * 128 + (tok & 127)) * 4 + slot) * 128 + kv * 64 + d; xr[ks2][it][0] = *(const u32x4*)src; xr[ks2][it][1] = *(const u32x4*)(src + 4); } \
            else xr[ks2][it][0] = *(const u32x4*)(proj + ((size_t)b * T + tok) * DINP + C_KV + slot * 128 + kv * 64 + d); } } } while (0)
    CMP_LOAD_ROWS(0);
    __syncthreads();
#pragma unroll 1
    for (int kp = 0; kp < 32; ++kp) {
        bf16x8 xf[2][4];
#pragma unroll
        for (int it = 0; it < 4; ++it)
#pragma unroll
            for (int ks2 = 0; ks2 < 2; ++ks2) { const int d = 32 * ks2 + 8 * q; f32x4 a0, a1;
                if (smp) { a0 = __builtin_bit_cast(f32x4, xr[ks2][it][0]); a1 = __builtin_bit_cast(f32x4, xr[ks2][it][1]); }
                else { float f8[8]; unpack8(xr[ks2][it][0], f8); a0 = (f32x4){f8[0], f8[1], f8[2], f8[3]}; a1 = (f32x4){f8[4], f8[5], f8[6], f8[7]}; }
                const f32x4 p0 = *(const f32x4*)(pe + 64 * kp + d), p1 = *(const f32x4*)(pe + 64 * kp + d + 4);
                xf[ks2][it] = frag_pk(a0 + p0, a1 + p1); }
        if (kp + 1 < 32) CMP_LOAD_ROWS(kp + 1);
        *(LAS u32x4*)(wb + (kp & 1) * 8192 + soff) = rw;
        __syncthreads();
        if (kp + 1 < 32) rw = *(const u32x4*)(wsrc + 64 * (kp + 1));
        LAS const unsigned char* wt = wb + (kp & 1) * 8192;
#pragma unroll
        for (int ks2 = 0; ks2 < 2; ++ks2)
#pragma unroll
            for (int nt = 0; nt < 4; ++nt) { const bf16x8 a = as_frag(*(LAS const u32x4*)(wt + kb0[ks2] + nt * 2048));
#pragma unroll
                for (int it = 0; it < 4; ++it) acc[nt][it] = MFMA16(a, xf[ks2][it], acc[nt][it]); }
    }
#undef CMP_LOAD_ROWS
    const float* gk0 = F.in[I_GNK];
#pragma unroll
    for (int it = 0; it < 4; ++it) {
        f32x4 g[4];
#pragma unroll
        for (int nt = 0; nt < 4; ++nt)
#pragma unroll
            for (int i = 0; i < 4; ++i) g[nt][i] = gelu_tanh(acc[nt][it][i]);
        const bf16x8 b0 = frag_pk(g[0], g[1]), b1 = frag_pk(g[2], g[3]);
        f32x4 o[4]; float ss = 0.f;
#pragma unroll
        for (int mt = 0; mt < 4; ++mt) { const bf16* wr = W2t + (size_t)(16 * mt + r) * 64 + 4 * q;
            o[mt] = MFMA16(ldfrag2(wr, wr + 16), b0, ((f32x4){0.f, 0.f, 0.f, 0.f}));
            o[mt] = MFMA16(ldfrag2(wr + 32, wr + 48), b1, o[mt]);
            ss += (o[mt][0] * o[mt][0] + o[mt][1] * o[mt][1]) + (o[mt][2] * o[mt][2] + o[mt][3] * o[mt][3]); }
        ss += __shfl_xor(ss, 16); ss += __shfl_xor(ss, 32);
        if (slot == 0) { const float rs = rsqrtf(ss * (1.f / 64.f) + EPS);
#pragma unroll
            for (int mt = 0; mt < 4; ++mt) { const f32x4 gg = *(const f32x4*)(gk0 + 16 * mt + 4 * q); o[mt] = o[mt] * rs * gg; } }
        const int i = i0 + 16 * it + r;
        if (smp) { float* dst = WSP(float, slot ? WS_VCMPS : WS_KCMPS) + ((size_t)(b * 2 + kv) * 512 + i) * 64 + 4 * q;
#pragma unroll
            for (int mt = 0; mt < 4; ++mt) *(f32x4*)(dst + 16 * mt) = o[mt]; }
        else if (slot == 0) { bf16* dst = WSP(bf16, WS_KCMP) + ((size_t)(b * 2 + kv) * 512 + i) * 64 + 4 * q;
#pragma unroll
            for (int mt = 0; mt < 4; ++mt) { u32x2 wv; wv.x = pk2(o[mt][0], o[mt][1]); wv.y = pk2(o[mt][2], o[mt][3]); *(u32x2*)(dst + 16 * mt) = wv; } }
        else { bf16* dst = WSP(bf16, WS_VCMPT) + ((size_t)(b * 2 + kv) * 64 + 4 * q) * 512 + i;
#pragma unroll
            for (int mt = 0; mt < 4; ++mt)
#pragma unroll
                for (int e = 0; e < 4; ++e) dst[(size_t)(16 * mt + e) * 512] = (bf16)f2bf(o[mt][e]); }
    }
}

__device__ __forceinline__ int swz64(int row, int col) { return row * 64 + ((((col >> 3) ^ (row & 7)) << 3) | (col & 7)); }
__device__ __forceinline__ float log_sigmoid_(float z) { return fminf(z, 0.f) - log1pf(__expf(-fabsf(z))); }
__device__ __forceinline__ void p2_gla_chunk(Frame& F, int bc) {
    const int lane = LANE_, r = lane & 15, q = lane >> 4, h = F.wave >> 1, eh = F.wave & 1;
    LAS bf16* ktT = (LAS bf16*)(F.lds + F.wave * 16384);
    LAS bf16* vT = ktT + 4096;
    const bf16* proj = WSP(bf16, WS_PROJ) + (size_t)bc * 64 * DINP;
    float wg[16];
#pragma unroll
    for (int j = 0; j < 16; ++j) wg[j] = F.in[I_WGG][j * 256 + h * 64 + lane];
    const float bg = F.in[I_BGG][h * 64 + lane];
    bf16* qtg = WSP(bf16, WS_QTG) + (size_t)bc * 64 * 256 + h * 64 + lane;
    bf16* ktg = WSP(bf16, WS_KTG) + (size_t)bc * 64 * 256 + h * 64 + lane;
    bf16* vtg = WSP(bf16, WS_VTG) + ((size_t)(bc * 4 + h) * 128 + eh * 64 + lane) * 64;
    LAS float* lrs = (LAS float*)(F.lds + RING_BYTES);
    { const int tid_ = F.wave * 64 + lane; if (tid_ < 128) { float f8[8]; unpack8(*(const u32x4*)(proj + (size_t)(tid_ >> 1) * DINP + C_LR + 8 * (tid_ & 1)), f8);
#pragma unroll
        for (int i = 0; i < 8; ++i) lrs[(tid_ >> 1) * 16 + 8 * (tid_ & 1) + i] = f8[i]; } }
    __syncthreads();
    float cb = 0.f;
    bf16 kr[2][16], qr[2][16], vr[2][16];
#pragma unroll
    for (int i = 0; i < 16; ++i) { const bf16* pr = proj + (size_t)i * DINP; kr[0][i] = pr[C_GK + h * 64 + lane]; qr[0][i] = pr[C_GQ + h * 64 + lane]; vr[0][i] = pr[C_GV + h * 128 + eh * 64 + lane]; }
#pragma unroll
    for (int tb = 0; tb < 4; ++tb) {
        if (tb < 3) {
#pragma unroll
            for (int i = 0; i < 16; ++i) { const bf16* pr = proj + (size_t)(16 * (tb + 1) + i) * DINP; kr[(tb + 1) & 1][i] = pr[C_GK + h * 64 + lane]; qr[(tb + 1) & 1][i] = pr[C_GQ + h * 64 + lane]; vr[(tb + 1) & 1][i] = pr[C_GV + h * 128 + eh * 64 + lane]; } }
#pragma unroll
        for (int i = 0; i < 16; ++i) { const int t = 16 * tb + i;
            float z = bg;
#pragma unroll
            for (int j4 = 0; j4 < 4; ++j4) { const f32x4 l4 = *(LAS const f32x4*)(lrs + t * 16 + 4 * j4); z += l4[0] * wg[4 * j4] + l4[1] * wg[4 * j4 + 1] + l4[2] * wg[4 * j4 + 2] + l4[3] * wg[4 * j4 + 3]; }
            cb += log_sigmoid_(z) * 0.0625f;
            const float kk = bf2f(kr[tb & 1][i]) * __expf(-cb);
            const float qq = bf2f(qr[tb & 1][i]) * 0.125f * __expf(cb);
            const bf16 kb = (bf16)f2bf(kk);
            if (eh == 0) { qtg[(size_t)t * 256] = (bf16)f2bf(qq); ktg[(size_t)t * 256] = kb; }
            ktT[swz64(lane, t)] = kb;
            const bf16 vv = vr[tb & 1][i];
            vT[swz64(lane, t)] = vv; vtg[t] = vv; }
    }
    const float dec = __expf(cb);
    if (eh == 0) WSP(float, WS_DEC)[(size_t)(bc * 4 + h) * 64 + lane] = dec;
    asm volatile("s_waitcnt lgkmcnt(0)" ::: "memory");
    f32x4 acc[4][4];
#pragma unroll
    for (int et = 0; et < 4; ++et)
#pragma unroll
        for (int dt = 0; dt < 4; ++dt) acc[et][dt] = (f32x4){0.f, 0.f, 0.f, 0.f};
#pragma unroll
    for (int ks = 0; ks < 2; ++ks) {
        bf16x8 bfr[4];
#pragma unroll
        for (int dt = 0; dt < 4; ++dt) bfr[dt] = as_frag(*(const LAS u32x4*)(ktT + swz64(16 * dt + r, 32 * ks + 8 * q)));
#pragma unroll
        for (int et = 0; et < 4; ++et) { const bf16x8 a = as_frag(*(const LAS u32x4*)(vT + swz64(16 * et + r, 32 * ks + 8 * q)));
#pragma unroll
            for (int dt = 0; dt < 4; ++dt) acc[et][dt] = MFMA16(a, bfr[dt], acc[et][dt]); }
    }
    float* up = WSP(float, WS_UP) + ((size_t)(bc * 4 + h) * 128 + eh * 64) * 64;
#pragma unroll
    for (int dt = 0; dt < 4; ++dt) { const float dd = __shfl(dec, 16 * dt + r);
#pragma unroll
        for (int et = 0; et < 4; ++et)
#pragma unroll
            for (int i = 0; i < 4; ++i) up[(size_t)(16 * et + 4 * q + i) * 64 + 16 * dt + r] = acc[et][dt][i] * dd; }
}

__device__ __forceinline__ void p2_gla_sample(Frame& F, int task) {
    const int lane = LANE_, b = task >> 2, h = task & 3, tok = NTOKP + b;
    const bf16* pr = WSP(bf16, WS_PROJ) + (size_t)tok * DINP;
    LAS float* sh = (LAS float*)(F.lds + F.wave * 16384);
    { float z = F.in[I_BGG][h * 64 + lane];
#pragma unroll
      for (int j = 0; j < 16; ++j) z += bf2f(pr[C_LR + j]) * F.in[I_WGG][j * 256 + h * 64 + lane];
      sh[lane] = __expf(log_sigmoid_(z) * 0.0625f); sh[64 + lane] = bf2f(pr[C_GK + h * 64 + lane]); sh[128 + lane] = bf2f(pr[C_GQ + h * 64 + lane]) * 0.125f; }
    asm volatile("s_waitcnt lgkmcnt(0)" ::: "memory");
    const float v0 = bf2f(pr[C_GV + h * 128 + lane]), v1 = bf2f(pr[C_GV + h * 128 + 64 + lane]);
    const float* s0 = F.in[I_SGLA] + (size_t)(b * 4 + h) * 64 * 128; float* s1 = F.out + O_GLAS + (size_t)(b * 4 + h) * 64 * 128;
    float o0 = 0.f, o1 = 0.f;
#pragma unroll 4
    for (int d = 0; d < 64; ++d) { const float a = sh[d], k = sh[64 + d], qq = sh[128 + d];
        const float n0 = a * s0[d * 128 + lane] + k * v0, n1 = a * s0[d * 128 + 64 + lane] + k * v1;
        s1[d * 128 + lane] = n0; s1[d * 128 + 64 + lane] = n1; o0 += qq * n0; o1 += qq * n1; }
    const float rs = rsqrtf(wave_sum(o0 * o0 + o1 * o1) * (1.f / 128.f) + EPS);
    const float r0 = bf2f(pr[C_GR + h * 128 + lane]), r1 = bf2f(pr[C_GR + h * 128 + 64 + lane]);
    bf16* og = WSP(bf16, WS_OGLA) + (size_t)tok * 512 + h * 128;
    og[lane] = (bf16)f2bf(o0 * rs * F.in[I_GGO][lane] * r0 * sigmoidf_(r0));
    og[64 + lane] = (bf16)f2bf(o1 * rs * F.in[I_GGO][64 + lane] * r1 * sigmoidf_(r1));
}

__device__ __forceinline__ void p3_gla_scan(Frame& F, int task) {
    const int lane = LANE_, b = task >> 9, h = (task >> 7) & 3, e = task & 127;
    const float* up = WSP(float, WS_UP); const float* dec = WSP(float, WS_DEC); bf16* sc = WSP(bf16, WS_SC);
    float S = 0.f;
#pragma unroll 8
    for (int c = 0; c < 128; ++c) { const int bc = b * 128 + c; const size_t idx = ((size_t)(bc * 4 + h) * 128 + e) * 64 + lane;
        sc[idx] = (bf16)f2bf(S); S = dec[(size_t)(bc * 4 + h) * 64 + lane] * S + up[idx]; }
    F.out[O_GLAP + ((size_t)(b * 4 + h) * 64 + lane) * 128 + e] = S;
}

__device__ __forceinline__ void p4_gla_out(Frame& F, int task) {
    const int lane = LANE_, r = lane & 15, q = lane >> 4, bc = task >> 4, h = (task >> 2) & 3, tt = task & 3;
    const bf16* qtg = WSP(bf16, WS_QTG) + (size_t)bc * 64 * 256 + h * 64;
    const bf16* ktg = WSP(bf16, WS_KTG) + (size_t)bc * 64 * 256 + h * 64;
    const bf16* vtg = WSP(bf16, WS_VTG) + (size_t)(bc * 4 + h) * 128 * 64;
    const bf16* sc = WSP(bf16, WS_SC) + (size_t)(bc * 4 + h) * 128 * 64;
    const bf16* proj = WSP(bf16, WS_PROJ) + (size_t)bc * 64 * DINP;
    bf16* og = WSP(bf16, WS_OGLA) + (size_t)bc * 64 * 512 + h * 128;
    const float* ggo = F.in[I_GGO];
    {
        bf16x8 qf[2];
#pragma unroll
        for (int ks = 0; ks < 2; ++ks) qf[ks] = ldfrag(qtg + (size_t)(16 * tt + r) * 256 + 32 * ks + 8 * q);
        f32x4 sT[4];
#pragma unroll
        for (int st = 0; st < 4; ++st) { sT[st] = (f32x4){0.f, 0.f, 0.f, 0.f};
            if (st <= tt) {
#pragma unroll
                for (int ks = 0; ks < 2; ++ks) sT[st] = MFMA16(ldfrag(ktg + (size_t)(16 * st + r) * 256 + 32 * ks + 8 * q), qf[ks], sT[st]);
                if (st == tt) {
#pragma unroll
                    for (int i = 0; i < 4; ++i) if (4 * q + i > r) sT[st][i] = 0.f; } } }
        const bf16x8 p01 = frag_pk(sT[0], sT[1]), p23 = frag_pk(sT[2], sT[3]);
        f32x4 acc[8]; float ss = 0.f;
#pragma unroll
        for (int et = 0; et < 8; ++et) { acc[et] = (f32x4){0.f, 0.f, 0.f, 0.f};
            const bf16* srow = sc + (size_t)(16 * et + r) * 64 + 8 * q;
            acc[et] = MFMA16(ldfrag(srow), qf[0], acc[et]); acc[et] = MFMA16(ldfrag(srow + 32), qf[1], acc[et]);
            const bf16* vrow = vtg + (size_t)(16 * et + r) * 64 + 4 * q;
            acc[et] = MFMA16(ldfrag2(vrow, vrow + 16), p01, acc[et]);
            if (tt >= 2) acc[et] = MFMA16(ldfrag2(vrow + 32, vrow + 48), p23, acc[et]);
            ss += (acc[et][0] * acc[et][0] + acc[et][1] * acc[et][1]) + (acc[et][2] * acc[et][2] + acc[et][3] * acc[et][3]); }
        ss += __shfl_xor(ss, 16); ss += __shfl_xor(ss, 32);
        const float rs = rsqrtf(ss * (1.f / 128.f) + EPS);
        const bf16* pr = proj + (size_t)(16 * tt + r) * DINP + C_GR + h * 128 + 4 * q;
        bf16* orow = og + (size_t)(16 * tt + r) * 512 + 4 * q;
#pragma unroll
        for (int et = 0; et < 8; ++et) { const u32x2 rw = *(const u32x2*)(pr + 16 * et); const f32x4 gg = *(const f32x4*)(ggo + 16 * et + 4 * q);
            const float r0 = bflo(rw.x), r1 = bfhi(rw.x), r2 = bflo(rw.y), r3 = bfhi(rw.y);
            u32x2 w; w.x = pk2(acc[et][0] * rs * gg[0] * r0 * sigmoidf_(r0), acc[et][1] * rs * gg[1] * r1 * sigmoidf_(r1));
            w.y = pk2(acc[et][2] * rs * gg[2] * r2 * sigmoidf_(r2), acc[et][3] * rs * gg[3] * r3 * sigmoidf_(r3));
            *(u32x2*)(orow + 16 * et) = w; }
    }
}

__device__ __forceinline__ void p3_xatt(Frame& F, int n, float mb) {
    const int lane = LANE_, r = lane & 15, q = lane >> 4, w = F.wave, tid_ = w * 64 + lane;
    const int b = n >> 7, h = (n >> 5) & 3, chunk = n & 31;
    const bf16* km = WSP(bf16, WS_KMEM) + (size_t)(b * 4 + h) * 256 * 128;
    const bf16* vm = WSP(bf16, WS_VMEMT) + (size_t)(b * 4 + h) * 128 * 256;
    LAS unsigned char* kl = F.lds; LAS unsigned char* vl = F.lds + 65536;
    __syncthreads();
    { u32x4 gk[8], gv[8];
#pragma unroll
      for (int i = 0; i < 8; ++i) { gk[i] = *(const u32x4*)(km + (size_t)(i * 512 + tid_) * 8); gv[i] = *(const u32x4*)(vm + (size_t)(i * 512 + tid_) * 8); }
#pragma unroll
      for (int i = 0; i < 8; ++i) { const int id = i * 512 + tid_;
          *(LAS u32x4*)(kl + (id >> 4) * 256 + ((((id & 15) ^ ((id >> 4) & 15))) << 4)) = gk[i];
          *(LAS u32x4*)(vl + (id >> 5) * 512 + ((((id & 31) ^ ((id >> 5) & 15))) << 4)) = gv[i]; } }
    __syncthreads();
    int kb4[4];
#pragma unroll
    for (int ks = 0; ks < 4; ++ks) kb4[ks] = r * 256 + (((4 * ks + q) ^ r) << 4);
#pragma unroll 1
    for (int tile = 0; tile < 2; ++tile) {
        const int tok0 = b * T + chunk * 256 + w * 32 + tile * 16;
        const bf16* xq = WSP(bf16, WS_XQ) + (size_t)(tok0 + r) * 512 + h * 128 + 8 * q;
        bf16x8 qf[4];
#pragma unroll
        for (int ks = 0; ks < 4; ++ks) qf[ks] = ldfrag(xq + 32 * ks);
        f32x4 o[8]; float l = 0.f;
#pragma unroll
        for (int dt = 0; dt < 8; ++dt) o[dt] = (f32x4){0.f, 0.f, 0.f, 0.f};
#pragma unroll 2
        for (int kk = 0; kk < 8; ++kk) {
            f32x4 p[2];
#pragma unroll
            for (int a = 0; a < 2; ++a) { p[a] = (f32x4){0.f, 0.f, 0.f, 0.f};
#pragma unroll
                for (int ks = 0; ks < 4; ++ks) p[a] = MFMA16(as_frag(*(LAS const u32x4*)(kl + kb4[ks] + (2 * kk + a) * 4096)), qf[ks], p[a]);
#pragma unroll
                for (int i = 0; i < 4; ++i) { p[a][i] = __builtin_amdgcn_exp2f(p[a][i] - mb); l += p[a][i]; } }
            const bf16x8 pf = frag_pk(p[0], p[1]);
            const int v0 = r * 512 + (((4 * kk + (q >> 1)) ^ r) << 4) + 8 * (q & 1), v1 = r * 512 + (((4 * kk + 2 + (q >> 1)) ^ r) << 4) + 8 * (q & 1);
#pragma unroll
            for (int dt = 0; dt < 8; ++dt) { const u32x2 x0 = *(LAS const u32x2*)(vl + v0 + dt * 8192), x1 = *(LAS const u32x2*)(vl + v1 + dt * 8192);
                u32x4 wv; wv.x = x0.x; wv.y = x0.y; wv.z = x1.x; wv.w = x1.y; o[dt] = MFMA16(as_frag(wv), pf, o[dt]); }
        }
        l += __shfl_xor(l, 16); l += __shfl_xor(l, 32);
        const float inv = 1.f / l;
        bf16* ox = WSP(bf16, WS_OX) + (size_t)(tok0 + r) * 512 + h * 128 + 4 * q;
#pragma unroll
        for (int dt = 0; dt < 8; ++dt) { u32x2 wv; wv.x = pk2(o[dt][0] * inv, o[dt][1] * inv); wv.y = pk2(o[dt][2] * inv, o[dt][3] * inv); *(u32x2*)(ox + 16 * dt) = wv; }
    }
}
__device__ __forceinline__ void p3_xatt_sample(Frame& F, int task) {
    const int lane = LANE_, b = task >> 2, h = task & 3, tok = NTOKP + b;
    LAS float* sh = (LAS float*)(F.lds + F.wave * 16384);
    const bf16* xq = WSP(bf16, WS_XQ) + (size_t)tok * 512 + h * 128;
    sh[lane] = bf2f(xq[lane]); sh[64 + lane] = bf2f(xq[64 + lane]);
    asm volatile("s_waitcnt lgkmcnt(0)" ::: "memory");
    const float* cm = F.in[I_CMEM] + (size_t)b * 256 * 1024 + h * 128;
    float s[4] = {0.f, 0.f, 0.f, 0.f};
    for (int d = 0; d < 128; d += 4) { const f32x4 qv = *(const LAS f32x4*)(sh + d);
#pragma unroll
        for (int k = 0; k < 4; ++k) { const f32x4 kv = *(const f32x4*)(cm + (size_t)(lane + 64 * k) * 1024 + d); s[k] += (qv[0] * kv[0] + qv[1] * kv[1]) + (qv[2] * kv[2] + qv[3] * kv[3]); } }
    const float m = wave_max(fmaxf(fmaxf(s[0], s[1]), fmaxf(s[2], s[3])));
    float l = 0.f;
#pragma unroll
    for (int k = 0; k < 4; ++k) { const float e = __builtin_amdgcn_exp2f(s[k] - m); sh[128 + lane + 64 * k] = e; l += e; }
    l = wave_sum(l);
    asm volatile("s_waitcnt lgkmcnt(0)" ::: "memory");
    float o0 = 0.f, o1 = 0.f; const float* vv = cm + 512;
#pragma unroll 4
    for (int mm = 0; mm < 256; ++mm) { const float p = sh[128 + mm]; o0 += p * vv[(size_t)mm * 1024 + lane]; o1 += p * vv[(size_t)mm * 1024 + 64 + lane]; }
    const float inv = 1.f / l;
    bf16* ox = WSP(bf16, WS_OX) + (size_t)tok * 512 + h * 128;
    ox[lane] = (bf16)f2bf(o0 * inv); ox[64 + lane] = (bf16)f2bf(o1 * inv);
}

constexpr int NL_Q = 0;
constexpr int NL_U = 16384;
constexpr int NL_OS = 81920;
constexpr int NL_TB = 16384;
constexpr int NL_SEL = 147456;
constexpr int NL_BKT = 147968;
constexpr int NL_BIAS = 148496;
constexpr int NL_LINV = 149520;
constexpr int NL_END = 150032;
static_assert(NL_END <= LDS_BYTES, "NSA LDS map");

__device__ __forceinline__ void nsa_tables(Frame& F) {
    LAS int* bkt = (LAS int*)(F.lds + NL_BKT); LAS float* bl = (LAS float*)(F.lds + NL_BIAS);
    if (TID_ < 129) bkt[TID_] = t5_bucket(TID_);
    if (TID_ < 256) bl[TID_] = F.in[I_RB][TID_] * LOG2E;
    __syncthreads();
}
__device__ __forceinline__ float nsa_bound(Frame& F) {
    const float gq = absmax_arr(F.in[I_GNQ], 64, LANE_), gk = absmax_arr(F.in[I_GNK], 192, LANE_), bm = absmax_arr(F.in[I_RB], 256, LANE_);
    return (8.0f * gq * gk * 1.02f + bm) * LOG2E;
}
__device__ __forceinline__ unsigned fkey(float x) { const unsigned u = __float_as_uint(x); return (u & 0x80000000u) ? ~u : (u | 0x80000000u); }

__device__ __forceinline__ int tile_off16(int row, int c16) { return row * 128 + ((c16 ^ (row & 7)) << 4); }
struct TileAddr { int kb[2]; int vb[2][2]; };
__device__ __forceinline__ TileAddr tile_addr(int r, int q) { TileAddr a;
    for (int ks = 0; ks < 2; ++ks) a.kb[ks] = r * 128 + (((4 * ks + q) ^ (r & 7)) << 4);
    for (int s = 0; s < 2; ++s) for (int pc = 0; pc < 2; ++pc) a.vb[s][pc] = r * 128 + (((4 * s + 2 * pc + (q >> 1)) ^ (r & 7)) << 4) + 8 * (q & 1);
    return a; }
__device__ __forceinline__ bf16x8 tile_kfrag(LAS const unsigned char* kb, const TileAddr& ta, int kt, int ks) { return as_frag(*(LAS const u32x4*)(kb + ta.kb[ks] + kt * 2048)); }
__device__ __forceinline__ bf16x8 tile_vfrag(LAS const unsigned char* vb, const TileAddr& ta, int dt, int s) {
    const u32x2 a = *(LAS const u32x2*)(vb + ta.vb[s][0] + dt * 2048), b = *(LAS const u32x2*)(vb + ta.vb[s][1] + dt * 2048);
    u32x4 w; w.x = a.x; w.y = a.y; w.z = b.x; w.w = b.y; return as_frag(w); }

#define OPAQUE_V(x) asm volatile("" : "+v"(x))
__device__ __forceinline__ void p3_nsa_prompt(Frame& F, int n, float mb, int dbg) {
    int lane0 = LANE_; OPAQUE_V(lane0);
    const int lane = lane0, r = lane & 15, q = lane >> 4, w = F.wave;
    const int combo = n >> 8, idx = n & 255, ti = (combo & 1) ? 255 - idx : idx;
    const int b = combo >> 1, kv = combo & 1, t0 = 32 * ti, bk = b * 2 + kv;
    LAS bf16* Qs = (LAS bf16*)(F.lds + NL_Q); LAS float* U = (LAS float*)(F.lds + NL_U) + w * 2048; LAS unsigned* selm = (LAS unsigned*)(F.lds + NL_SEL);
    LAS const int* bkt = (LAS const int*)(F.lds + NL_BKT); LAS const float* bl = (LAS const float*)(F.lds + NL_BIAS); LAS float* linv = (LAS float*)(F.lds + NL_LINV) + w * 16;
    LAS unsigned char* stA = F.lds + NL_OS;
    LAS unsigned char* stC = F.lds + NL_U;
    LAS unsigned char* stB = F.lds + NL_TB + w * 16384;
    const int tid_ = w * 64 + lane, srow = tid_ >> 3, sc16 = tid_ & 7, soff = tile_off16(srow, sc16);
    const TileAddr ta = tile_addr(r, q);
    __syncthreads();
    { const int tk = TID_ >> 4, ch = TID_ & 15; const bf16* src = WSP(bf16, WS_QN) + (size_t)(b * T + t0 + tk) * 512 + kv * 256 + ch * 16;
      const u32x4 a0 = *(const u32x4*)src, a1 = *(const u32x4*)(src + 8);
      *(LAS u32x4*)(Qs + tk * 256 + ch * 16) = a0; *(LAS u32x4*)(Qs + tk * 256 + ch * 16 + 8) = a1;
      if (TID_ < 128) selm[TID_] = 0u; }
    __syncthreads();
    const int tw = t0 + 4 * w, tr = tw + (r >> 2), h = kv * 4 + (r & 3);
    bf16x8 qf[2];
#pragma unroll
    for (int ks = 0; ks < 2; ++ks) qf[ks] = as_frag(*(LAS const u32x4*)(Qs + (16 * w + r) * 64 + 32 * ks + 8 * q));
    int ncvb = (t0 + 31 - 31) / 16 + 1; ncvb = ncvb < 511 ? ncvb : 511;
    const int nst = (ncvb + 63) >> 6;
    const int tlast = tw + 3; int ncv = tlast >= 31 ? (tlast - 31) / 16 + 1 : 0; ncv = ncv < 511 ? ncv : 511;
    const int nstw = (ncv + 63) >> 6;
    f32x4 oc[4]; float lc = 0.f, carry = 0.f;
#pragma unroll
    for (int dt = 0; dt < 4; ++dt) oc[dt] = (f32x4){0.f, 0.f, 0.f, 0.f};
    {
        const bf16* kc = WSP(bf16, WS_KCMP) + (size_t)bk * 512 * 64 + srow * 64 + sc16 * 8; const bf16* vc = WSP(bf16, WS_VCMPT) + (size_t)bk * 64 * 512 + srow * 512 + sc16 * 8;
        const int nst2 = (nst + 1) >> 1;
        u32x4 rk0 = *(const u32x4*)kc, rv0 = *(const u32x4*)vc, rk1 = *(const u32x4*)(kc + 4096), rv1 = *(const u32x4*)(vc + 64);
#pragma unroll 1
        for (int s2 = 0; s2 < nst2; ++s2) {
            LAS unsigned char* bb = stA + (s2 & 1) * 32768;
            *(LAS u32x4*)(bb + soff) = rk0; *(LAS u32x4*)(bb + 8192 + soff) = rv0; *(LAS u32x4*)(bb + 16384 + soff) = rk1; *(LAS u32x4*)(bb + 24576 + soff) = rv1;
            __syncthreads();
            if (s2 + 1 < nst2) { rk0 = *(const u32x4*)(kc + (size_t)(2 * s2 + 2) * 4096); rv0 = *(const u32x4*)(vc + (2 * s2 + 2) * 64);
                                 rk1 = *(const u32x4*)(kc + (size_t)(2 * s2 + 3) * 4096); rv1 = *(const u32x4*)(vc + (2 * s2 + 3) * 64); }
#pragma unroll
            for (int sub = 0; sub < 2; ++sub) { const int st = 2 * s2 + sub; LAS unsigned char* kb = bb + sub * 16384; LAS unsigned char* vb = kb + 8192;
            if (st < nstw && !(dbg & 1)) {
                f32x4 p[4];
#pragma unroll
                for (int kt = 0; kt < 4; ++kt) { const int tile = 4 * st + kt; p[kt] = (f32x4){0.f, 0.f, 0.f, 0.f};
                    p[kt] = MFMA16(tile_kfrag(kb, ta, kt, 0), qf[0], p[kt]); p[kt] = MFMA16(tile_kfrag(kb, ta, kt, 1), qf[1], p[kt]);
                    float G = 0.f;
#pragma unroll
                    for (int i = 0; i < 4; ++i) { const int c = 16 * tile + 4 * q + i, rel = tr - (16 * c + 31); const bool ok = rel >= 0 && c < 511;
                        const int rc = rel < 0 ? 0 : (rel > 128 ? 128 : rel);
                        const float e = ok ? __builtin_amdgcn_exp2f(p[kt][i] + bl[bkt[rc] * 8 + h] - mb) : 0.f; p[kt][i] = e; G += e; }
                    const float send = (q == 3) ? carry : p[kt][3]; const float prev = __shfl(send, (lane + 48) & 63); carry = p[kt][3];
                    U[r * 128 + 4 * tile + q] = G + prev; lc += G; }
                const bf16x8 pf0 = frag_pk(p[0], p[1]), pf1 = frag_pk(p[2], p[3]);
#pragma unroll
                for (int dt = 0; dt < 4; ++dt) { oc[dt] = MFMA16(tile_vfrag(vb, ta, dt, 0), pf0, oc[dt]); oc[dt] = MFMA16(tile_vfrag(vb, ta, dt, 1), pf1, oc[dt]); }
            } }
        }
    }
    lc += __shfl_xor(lc, 16); lc += __shfl_xor(lc, 32);
    const float lcinv = lc > 0.f ? 1.f / lc : 0.f;
    if (q == 0) linv[r] = lcinv;
    asm volatile("s_waitcnt lgkmcnt(0)" ::: "memory");
    if (!(dbg & 8)) {
        const int tk = lane >> 4, jr = lane & 15, t = tw + tk, tblk = t >> 6, jlim = 16 * nstw;
        const float li0 = linv[4 * tk], li1 = linv[4 * tk + 1], li2 = linv[4 * tk + 2], li3 = linv[4 * tk + 3];
        unsigned key[8];
#pragma unroll
        for (int m = 0; m < 8; ++m) { const int j = jr + 16 * m; float v = 0.f;
            if (j < jlim) v = U[(4 * tk) * 128 + j] * li0 + U[(4 * tk + 1) * 128 + j] * li1 + U[(4 * tk + 2) * 128 + j] * li2 + U[(4 * tk + 3) * 128 + j] * li3;
            const bool forced = (j == 0) || (j == tblk) || (j == tblk - 1);
            const float sc = (j <= tblk) ? v + (forced ? 1e4f : 0.f) : -1e30f;
            key[m] = fkey(sc); }
        unsigned pre = 0u;
#pragma unroll 1
        for (int bit = 31; bit >= 0; --bit) { const unsigned cand = pre | (1u << bit); int cnt = 0;
#pragma unroll
            for (int m = 0; m < 8; ++m) cnt += key[m] >= cand ? 1 : 0;
            cnt += __shfl_xor(cnt, 1); cnt += __shfl_xor(cnt, 2); cnt += __shfl_xor(cnt, 4); cnt += __shfl_xor(cnt, 8);
            if (cnt >= 16) pre = cand; }
        int ngt = 0;
#pragma unroll
        for (int m = 0; m < 8; ++m) ngt += key[m] > pre ? 1 : 0;
        ngt += __shfl_xor(ngt, 1); ngt += __shfl_xor(ngt, 2); ngt += __shfl_xor(ngt, 4); ngt += __shfl_xor(ngt, 8);
        const int need = 16 - ngt; int run = 0; const unsigned kinv = fkey(-1e30f);
#pragma unroll
        for (int m = 0; m < 8; ++m) { const bool tie = key[m] == pre; const unsigned long long bal = __ballot(tie);
            const unsigned grp = (unsigned)(bal >> (16 * tk)) & 0xffffu; const int rank = __popc(grp & ((1u << jr) - 1u));
            const bool sel = (key[m] > pre || (tie && run + rank < need)) && key[m] > kinv;
            run += __popc(grp);
            if (sel) atomicOr((unsigned*)(selm + jr + 16 * m), 1u << (4 * w + tk)); }
    }
    __syncthreads();
    f32x4 ow[4]; float lw = 0.f;
#pragma unroll
    for (int dt = 0; dt < 4; ++dt) ow[dt] = (f32x4){0.f, 0.f, 0.f, 0.f};
    {
        int lc_ = lane0; OPAQUE_V(lc_); const int lane = lc_, r = lane & 15, q = lane >> 4, tr = tw + (r >> 2), h = kv * 4 + (r & 3); const TileAddr ta = tile_addr(r, q);
        const int tid_ = w * 64 + lane, srow = tid_ >> 3, sc16 = tid_ & 7, soff = tile_off16(srow, sc16);
        const int jlob = (t0 - 511 > 0 ? t0 - 511 : 0) >> 6, jhib = (t0 + 31) >> 6, nstc = jhib - jlob + 1;
        const int jlo = (tw - 511 > 0 ? tw - 511 : 0) >> 6, jhi = (tw + 3) >> 6;
        const bf16* kwin = WSP(bf16, WS_KWIN) + (size_t)bk * T * 64 + srow * 64 + sc16 * 8; const bf16* vwin = WSP(bf16, WS_VWINT) + (size_t)bk * 128 * 4096 + srow * 64 + sc16 * 8;
        const int nstc2 = (nstc + 1) >> 1;
        u32x4 rk0 = *(const u32x4*)(kwin + (size_t)jlob * 4096), rv0 = *(const u32x4*)(vwin + (size_t)jlob * 4096), rk1 = *(const u32x4*)(kwin + (size_t)(jlob + 1) * 4096), rv1 = *(const u32x4*)(vwin + (size_t)(jlob + 1) * 4096);
#pragma unroll 1
        for (int s2 = 0; s2 < nstc2; ++s2) { const int j0 = jlob + 2 * s2;
            LAS unsigned char* bb = stC + (s2 & 1) * 32768;
            *(LAS u32x4*)(bb + soff) = rk0; *(LAS u32x4*)(bb + 8192 + soff) = rv0; *(LAS u32x4*)(bb + 16384 + soff) = rk1; *(LAS u32x4*)(bb + 24576 + soff) = rv1;
            __syncthreads();
            if (s2 + 1 < nstc2) { rk0 = *(const u32x4*)(kwin + (size_t)(j0 + 2) * 4096); rv0 = *(const u32x4*)(vwin + (size_t)(j0 + 2) * 4096);
                                  rk1 = *(const u32x4*)(kwin + (size_t)(j0 + 3) * 4096); rv1 = *(const u32x4*)(vwin + (size_t)(j0 + 3) * 4096); }
#pragma unroll
            for (int sub = 0; sub < 2; ++sub) { const int j = j0 + sub; LAS unsigned char* kb = bb + sub * 16384; LAS unsigned char* vb = kb + 8192;
            if (j >= jlo && j <= jhi && !(dbg & 2)) {
                f32x4 p[4];
#pragma unroll
                for (int kt = 0; kt < 4; ++kt) { p[kt] = (f32x4){0.f, 0.f, 0.f, 0.f};
                    p[kt] = MFMA16(tile_kfrag(kb, ta, kt, 0), qf[0], p[kt]); p[kt] = MFMA16(tile_kfrag(kb, ta, kt, 1), qf[1], p[kt]);
#pragma unroll
                    for (int i = 0; i < 4; ++i) { const int rel = tr - (64 * j + 16 * kt + 4 * q + i); const bool ok = rel >= 0 && rel < 512;
                        const int rc = rel < 0 ? 0 : (rel > 128 ? 128 : rel);
                        const float e = ok ? __builtin_amdgcn_exp2f(p[kt][i] + bl[bkt[rc] * 8 + h] - mb) : 0.f; p[kt][i] = e; lw += e; } }
                const bf16x8 pf0 = frag_pk(p[0], p[1]), pf1 = frag_pk(p[2], p[3]);
#pragma unroll
                for (int dt = 0; dt < 4; ++dt) { ow[dt] = MFMA16(tile_vfrag(vb, ta, dt, 0), pf0, ow[dt]); ow[dt] = MFMA16(tile_vfrag(vb, ta, dt, 1), pf1, ow[dt]); }
            } }
        }
        lw += __shfl_xor(lw, 16); lw += __shfl_xor(lw, 32);
    }
    f32x4 ocw[4];
    { const float* gt = WSP(float, WS_GATES) + (size_t)(b * T + tr) * 24 + h * 3;
      const float g0 = gt[0] * lcinv, g2 = gt[2] * (lw > 0.f ? 1.f / lw : 0.f);
#pragma unroll
      for (int dt = 0; dt < 4; ++dt) ocw[dt] = oc[dt] * g0 + ow[dt] * g2; }
    __syncthreads();
    f32x4 osf[4]; float lsf = 0.f;
    {
        int lb_ = lane0; OPAQUE_V(lb_); const int lane = lb_, r = lane & 15, q = lane >> 4, h = kv * 4 + (r & 3); const TileAddr ta = tile_addr(r, q);
        const int half = w >> 2, jw = w & 3;
        f32x4 osa[4][4]; float lsa[4];
#pragma unroll
        for (int x = 0; x < 4; ++x) { lsa[x] = 0.f;
#pragma unroll
            for (int dt = 0; dt < 4; ++dt) osa[x][dt] = (f32x4){0.f, 0.f, 0.f, 0.f}; }
        const int jmax = (t0 + 31) >> 6;
        const int brow = lane >> 3, bc16 = lane & 7, boff = brow * 64 + bc16 * 8, bsoff = tile_off16(brow, bc16); const float bfar = bl[31 * 8 + h];
        const bf16* ksel = WSP(bf16, WS_KSEL) + (size_t)bk * T * 64 + boff; const bf16* vsel = WSP(bf16, WS_VSELT) + (size_t)bk * 128 * 4096 + boff;
        LAS const bf16* Qh = Qs + (64 * half + r) * 64 + 8 * q;
        u32x4 gk[8], gv[8];
        if (jw <= jmax) {
#pragma unroll
            for (int i = 0; i < 8; ++i) { gk[i] = *(const u32x4*)(ksel + (size_t)jw * 4096 + i * 512); gv[i] = *(const u32x4*)(vsel + (size_t)jw * 4096 + i * 512); } }
#pragma unroll 1
        for (int j = jw; j <= jmax; j += 4) {
            const unsigned msel = ((unsigned)__builtin_amdgcn_readfirstlane((int)selm[j]) >> (16 * half)) & 0xffffu;
            const bool act = msel != 0u && !(dbg & 4);
            asm volatile("s_waitcnt lgkmcnt(0)" ::: "memory");
#pragma unroll
            for (int i = 0; i < 8; ++i) { *(LAS u32x4*)(stB + bsoff + i * 1024) = gk[i]; *(LAS u32x4*)(stB + 8192 + bsoff + i * 1024) = gv[i]; }
            if (j + 4 <= jmax) {
#pragma unroll
                for (int i = 0; i < 8; ++i) { gk[i] = *(const u32x4*)(ksel + (size_t)(j + 4) * 4096 + i * 512); gv[i] = *(const u32x4*)(vsel + (size_t)(j + 4) * 4096 + i * 512); } }
            if (!act) continue;
            asm volatile("s_waitcnt lgkmcnt(0)" ::: "memory");
            const bool far = (t0 - (64 * j + 63)) >= 128;
#pragma unroll 1
            for (int x = 0; x < 4; ++x) {
                const unsigned nib = (msel >> (4 * x)) & 15u;
                if (nib) {
                    asm volatile("" ::: "memory");
                    const bool tokv = (nib >> (r >> 2)) & 1u; const int t = t0 + 16 * half + 4 * x + (r >> 2);
                    const bf16x8 qs0 = as_frag(*(LAS const u32x4*)(Qh + x * 1024)), qs1 = as_frag(*(LAS const u32x4*)(Qh + x * 1024 + 32));
                    f32x4 p[4]; float ls = 0.f;
#pragma unroll
                    for (int kt = 0; kt < 4; ++kt) { p[kt] = (f32x4){0.f, 0.f, 0.f, 0.f};
                        p[kt] = MFMA16(tile_kfrag(stB, ta, kt, 0), qs0, p[kt]); p[kt] = MFMA16(tile_kfrag(stB, ta, kt, 1), qs1, p[kt]); }
                    if (far) {
                        const float cb_ = bfar - mb;
#pragma unroll
                        for (int kt = 0; kt < 4; ++kt)
#pragma unroll
                            for (int i = 0; i < 4; ++i) { const float e = tokv ? __builtin_amdgcn_exp2f(p[kt][i] + cb_) : 0.f; p[kt][i] = e; ls += e; }
                    } else {
#pragma unroll
                        for (int kt = 0; kt < 4; ++kt)
#pragma unroll
                            for (int i = 0; i < 4; ++i) { const int rel = t - (64 * j + 16 * kt + 4 * q + i); const bool ok = tokv && rel >= 0;
                                const int rc = rel < 0 ? 0 : (rel > 128 ? 128 : rel);
                                const float e = ok ? __builtin_amdgcn_exp2f(p[kt][i] + bl[bkt[rc] * 8 + h] - mb) : 0.f; p[kt][i] = e; ls += e; }
                    }
                    lsa[0] += ls;
                    const bf16x8 pf0 = frag_pk(p[0], p[1]), pf1 = frag_pk(p[2], p[3]);
#pragma unroll
                    for (int dt = 0; dt < 4; ++dt) { osa[0][dt] = MFMA16(tile_vfrag(stB + 8192, ta, dt, 0), pf0, osa[0][dt]); osa[0][dt] = MFMA16(tile_vfrag(stB + 8192, ta, dt, 1), pf1, osa[0][dt]); }
                }
                { const float l0 = lsa[0]; lsa[0] = lsa[1]; lsa[1] = lsa[2]; lsa[2] = lsa[3]; lsa[3] = l0;
#pragma unroll
                  for (int dt = 0; dt < 4; ++dt) { const f32x4 o0 = osa[0][dt]; osa[0][dt] = osa[1][dt]; osa[1][dt] = osa[2][dt]; osa[2][dt] = osa[3][dt]; osa[3][dt] = o0; } }
            }
        }
#pragma unroll
        for (int dt = 0; dt < 4; ++dt) osf[dt] = (f32x4){0.f, 0.f, 0.f, 0.f};
#pragma unroll
        for (int x = 0; x <= 4; ++x) {
            __syncthreads();
            if (x > 0 && jw == x - 1) {
#pragma unroll
                for (int w2 = 0; w2 < 4; ++w2) { LAS const float* rp = (LAS const float*)(F.lds + NL_U + ((x - 1) & 1) * 32768) + (4 * half + w2) * 1024 + lane * 16;
#pragma unroll
                    for (int dt = 0; dt < 4; ++dt) osf[dt] += *(LAS const f32x4*)(rp + 4 * dt);
                    lsf += ((LAS const float*)(F.lds + NL_Q + ((x - 1) & 1) * 2048))[(4 * half + w2) * 64 + lane]; } }
            if (x < 4) { LAS float* Rb = (LAS float*)(F.lds + NL_U + (x & 1) * 32768); LAS float* RLb = (LAS float*)(F.lds + NL_Q + (x & 1) * 2048);
#pragma unroll
                for (int dt = 0; dt < 4; ++dt) *(LAS f32x4*)(Rb + w * 1024 + lane * 16 + 4 * dt) = osa[x][dt];
                RLb[w * 64 + lane] = lsa[x]; }
        }
        lsf += __shfl_xor(lsf, 16); lsf += __shfl_xor(lsf, 32);
    }
    {
        int lf_ = lane0; OPAQUE_V(lf_); const int r = lf_ & 15, q = lf_ >> 4, tr = tw + (r >> 2), h = kv * 4 + (r & 3);
        const int tok = b * T + tr; const float g1 = WSP(float, WS_GATES)[(size_t)tok * 24 + h * 3 + 1] * (lsf > 0.f ? 1.f / lsf : 0.f);
        bf16* on = WSP(bf16, WS_ONSA) + (size_t)tok * 512 + h * 64 + 4 * q;
#pragma unroll
        for (int dt = 0; dt < 4; ++dt) { const f32x4 o = ocw[dt] + osf[dt] * g1;
            u32x2 wv; wv.x = pk2(o[0], o[1]); wv.y = pk2(o[2], o[3]); *(u32x2*)(on + 16 * dt) = wv; }
    }
}

constexpr int SL_Q = 0;
constexpr int SL_S = 1024;
constexpr int SL_O = 17408;
constexpr int SL_PART = 20480;
constexpr int SL_IMP = 28672;
constexpr int SL_IDX = 29200;
constexpr int SL_END = 29328;
static_assert(SL_END <= NL_BKT, "sample NSA LDS map must not overlap the tables");
template <class KP, class VP, class RELF>
__device__ __forceinline__ void sample_segment(Frame& F, int nk, int kv, KP kptr, VP vptr, RELF relf, LAS float* odst) {
    LAS const float* qs = (LAS const float*)(F.lds + SL_Q); LAS float* sc = (LAS float*)(F.lds + SL_S); LAS float* part = (LAS float*)(F.lds + SL_PART);
    LAS const int* bkt = (LAS const int*)(F.lds + NL_BKT); LAS const float* bl = (LAS const float*)(F.lds + NL_BIAS);
    const int nkp = (nk + 63) & ~63;
    for (int n = TID_; n < nkp; n += NTHR) {
        float s0 = -INFINITY, s1 = -INFINITY, s2 = -INFINITY, s3 = -INFINITY;
        const float* kr = n < nk ? kptr(n) : nullptr;
        if (kr) { s0 = s1 = s2 = s3 = 0.f;
            for (int d = 0; d < 64; d += 4) { const f32x4 k4 = *(const f32x4*)(kr + d);
                const f32x4 q0 = *(LAS const f32x4*)(qs + d), q1 = *(LAS const f32x4*)(qs + 64 + d), q2 = *(LAS const f32x4*)(qs + 128 + d), q3 = *(LAS const f32x4*)(qs + 192 + d);
                s0 += (q0[0] * k4[0] + q0[1] * k4[1]) + (q0[2] * k4[2] + q0[3] * k4[3]); s1 += (q1[0] * k4[0] + q1[1] * k4[1]) + (q1[2] * k4[2] + q1[3] * k4[3]);
                s2 += (q2[0] * k4[0] + q2[1] * k4[1]) + (q2[2] * k4[2] + q2[3] * k4[3]); s3 += (q3[0] * k4[0] + q3[1] * k4[1]) + (q3[2] * k4[2] + q3[3] * k4[3]); }
            int rel = relf(n); rel = rel > 128 ? 128 : rel; const int bb = bkt[rel] * 8 + kv * 4;
            s0 += bl[bb]; s1 += bl[bb + 1]; s2 += bl[bb + 2]; s3 += bl[bb + 3]; }
        sc[n] = s0; sc[1024 + n] = s1; sc[2048 + n] = s2; sc[3072 + n] = s3;
    }
    __syncthreads();
    if (F.wave < 4) { LAS float* row = sc + F.wave * 1024; float m = -INFINITY;
        for (int n = LANE_; n < nkp; n += 64) m = fmaxf(m, row[n]);
        m = wave_max(m); float l = 0.f;
        for (int n = LANE_; n < nkp; n += 64) { const float e = __builtin_amdgcn_exp2f(row[n] - m); row[n] = e; l += e; }
        l = wave_sum(l); const float inv = 1.f / l;
        for (int n = LANE_; n < nkp; n += 64) row[n] *= inv; }
    __syncthreads();
    {
        const int d = LANE_; float o0 = 0.f, o1 = 0.f, o2 = 0.f, o3 = 0.f;
        for (int n0 = F.wave; n0 < nkp; n0 += 32) {
            float v[4];
#pragma unroll
            for (int u = 0; u < 4; ++u) { const int n = n0 + 8 * u; v[u] = n < nk ? vptr(n)[d] : 0.f; }
#pragma unroll
            for (int u = 0; u < 4; ++u) { const int n = n0 + 8 * u; if (n < nkp) { o0 += sc[n] * v[u]; o1 += sc[1024 + n] * v[u]; o2 += sc[2048 + n] * v[u]; o3 += sc[3072 + n] * v[u]; } }
        }
        part[(F.wave * 4 + 0) * 64 + d] = o0; part[(F.wave * 4 + 1) * 64 + d] = o1; part[(F.wave * 4 + 2) * 64 + d] = o2; part[(F.wave * 4 + 3) * 64 + d] = o3; }
    __syncthreads();
    if (TID_ < 256) { float a = 0.f;
#pragma unroll
        for (int w8 = 0; w8 < 8; ++w8) a += part[w8 * 256 + TID_];
        odst[TID_] = a; }
    __syncthreads();
}
__device__ __forceinline__ void p3_nsa_sample(Frame& F, int task) {
    const int b = task >> 1, kv = task & 1, tok = NTOKP + b, bk = b * 2 + kv;
    LAS float* qs = (LAS float*)(F.lds + SL_Q); LAS float* sc = (LAS float*)(F.lds + SL_S); LAS float* ob = (LAS float*)(F.lds + SL_O);
    LAS float* imp = (LAS float*)(F.lds + SL_IMP); LAS int* sidx = (LAS int*)(F.lds + SL_IDX);
    __syncthreads();
    if (TID_ < 256) qs[TID_] = bf2f(WSP(bf16, WS_QN)[(size_t)tok * 512 + kv * 256 + TID_]);
    __syncthreads();
    const float* kcs = WSP(float, WS_KCMPS) + (size_t)bk * 512 * 64; const float* vcs = WSP(float, WS_VCMPS) + (size_t)bk * 512 * 64;
    const float* nkv = WSP(float, WS_NEWKV) + (size_t)b * 4 * 2 * 64 + kv * 64;
    const float* ckv = F.in[I_CKV]; const int* pt = (const int*)F.in[I_PT] + b * 64; const float* cwin = F.in[I_CWIN] + (size_t)b * 512 * 256;
    sample_segment(F, 511, kv, [&](int n) { return kcs + (size_t)n * 64; }, [&](int n) { return vcs + (size_t)n * 64; }, [&](int n) { return T - (16 * n + 31); }, ob);
    if (TID_ < 129) { const int j = TID_; float v = 0.f;
        for (int c = 4 * j - 1; c <= 4 * j + 3; ++c) if (c >= 0 && c < 511) v += (sc[c] + sc[1024 + c]) + (sc[2048 + c] + sc[3072 + c]);
        imp[j] = v; }
    __syncthreads();
    if (F.wave == 0) { const int lane = LANE_; unsigned key[3];
#pragma unroll
        for (int m = 0; m < 3; ++m) { const int j = lane + 64 * m; float s = -1e30f;
            if (j < 129) { const bool forced = (j == 0) || (j == 128) || (j == 127); s = imp[j] + (forced ? 1e4f : 0.f); }
            key[m] = (j < 129) ? fkey(s) : 0u; }
        unsigned pre = 0u;
#pragma unroll 1
        for (int bit = 31; bit >= 0; --bit) { const unsigned cand = pre | (1u << bit); int cnt = 0;
#pragma unroll
            for (int m = 0; m < 3; ++m) cnt += __popcll(__ballot(key[m] >= cand));
            if (cnt >= 16) pre = cand; }
        int ngt = 0;
#pragma unroll
        for (int m = 0; m < 3; ++m) ngt += __popcll(__ballot(key[m] > pre));
        int need = 16 - ngt, cnt = 0;
#pragma unroll
        for (int m = 0; m < 3; ++m) { const bool gt = key[m] > pre, tie = key[m] == pre; const unsigned long long tb = __ballot(tie);
            const int trank = __popcll(tb & ((1ull << lane) - 1ull)); const bool sel = gt || (tie && trank < need);
            need -= __popcll(tb); need = need < 0 ? 0 : need;
            const unsigned long long sb = __ballot(sel); const int pos = cnt + __popcll(sb & ((1ull << lane) - 1ull));
            if (sel && pos < 16) sidx[pos] = lane + 64 * m; cnt += __popcll(sb); } }
    __syncthreads();
    sample_segment(F, 1024, kv,
        [&](int n) -> const float* { const int pos = 64 * sidx[n >> 6] + (n & 63); if (pos > T) return nullptr; if (pos == T) return nkv;
                                     return ckv + (((size_t)pt[pos >> 7] * 128 + (pos & 127)) * 4 + 2) * 128 + kv * 64; },
        [&](int n) -> const float* { const int pos = 64 * sidx[n >> 6] + (n & 63); if (pos >= T) return nkv + 128;
                                     return ckv + (((size_t)pt[pos >> 7] * 128 + (pos & 127)) * 4 + 3) * 128 + kv * 64; },
        [&](int n) { return T - (64 * sidx[n >> 6] + (n & 63)); }, ob + 256);
    sample_segment(F, 512, kv,
        [&](int n) -> const float* { return n < 511 ? cwin + (size_t)(n + 1) * 256 + kv * 64 : nkv + 256; },
        [&](int n) -> const float* { return n < 511 ? cwin + (size_t)(n + 1) * 256 + 128 + kv * 64 : nkv + 384; },
        [&](int n) { return 511 - n; }, ob + 512);
    if (TID_ < 256) { const int g = TID_ >> 6, d = TID_ & 63, h = kv * 4 + g; const float* gt = WSP(float, WS_GATES) + (size_t)tok * 24 + h * 3;
        WSP(bf16, WS_ONSA)[(size_t)tok * 512 + h * 64 + d] = (bf16)f2bf(gt[0] * ob[TID_] + gt[1] * ob[256 + TID_] + gt[2] * ob[512 + TID_]); }
}

__device__ __forceinline__ void p6_conv(Frame& F) {
    const bf16* ug = WSP(bf16, WS_UG); bf16* act = WSP(bf16, WS_ACT);
    const float* cw = F.in[I_CONVW]; const float* cb = F.in[I_CONVB]; const float* sconv = F.in[I_SCONV];
    constexpr int NG = DFF / 8, RSEG = 32, NSEGP = NTOKP / RSEG, NITEM = NG * (NSEGP + 1);
    { const float* x1s = WSP(float, WS_X1S); float* ys = F.out + O_YS; for (int i = F.bid * NTHR + TID_; i < SB * 1024; i += F.G * NTHR) ys[i] = x1s[i]; }
    for (int it = F.bid * NTHR + TID_; it < NITEM; it += F.G * NTHR) {
        const int seg = it / NG, c0 = 8 * (it % NG);
        float w0[8], w1[8], w2[8], bb[8];
#pragma unroll
        for (int i = 0; i < 8; ++i) { w0[i] = cw[c0 + i]; w1[i] = cw[DFF + c0 + i]; w2[i] = cw[2 * DFF + c0 + i]; bb[i] = cb[c0 + i]; }
        if (seg < NSEGP) {
            const int row0 = seg * RSEG, t0 = row0 & (T - 1);
            float g0[8], g1[8];
            if (t0 >= 2) { unpack8(*(const u32x4*)(ug + (size_t)(row0 - 2) * DUP + DFF + c0), g0); unpack8(*(const u32x4*)(ug + (size_t)(row0 - 1) * DUP + DFF + c0), g1); }
            else {
#pragma unroll
                for (int i = 0; i < 8; ++i) { g0[i] = 0.f; g1[i] = 0.f; } }
#pragma unroll 4
            for (int rr = 0; rr < RSEG; ++rr) { const int row = row0 + rr; float u[8], g2[8], a[8];
                unpack8(*(const u32x4*)(ug + (size_t)row * DUP + c0), u); unpack8(*(const u32x4*)(ug + (size_t)row * DUP + DFF + c0), g2);
#pragma unroll
                for (int i = 0; i < 8; ++i) { a[i] = gelu_tanh(bb[i] + w0[i] * g0[i] + w1[i] * g1[i] + w2[i] * g2[i]) * u[i]; g0[i] = g1[i]; g1[i] = g2[i]; }
                *(u32x4*)(act + (size_t)row * DFF + c0) = pack8(a); }
            if (t0 + RSEG == T) { float* o = F.out + O_CONVP + (size_t)(row0 >> 13) * 2 * DFF + c0;
#pragma unroll
                for (int i = 0; i < 8; ++i) { o[i] = g0[i]; o[DFF + i] = g1[i]; } }
        } else {
            for (int sb = 0; sb < SB; ++sb) { const int row = NTOKP + sb; float u[8], g2[8], g0[8], g1[8], a[8];
                unpack8(*(const u32x4*)(ug + (size_t)row * DUP + c0), u); unpack8(*(const u32x4*)(ug + (size_t)row * DUP + DFF + c0), g2);
#pragma unroll
                for (int i = 0; i < 8; ++i) { g0[i] = sconv[((size_t)sb * 2 + 0) * DFF + c0 + i]; g1[i] = sconv[((size_t)sb * 2 + 1) * DFF + c0 + i]; }
                float* o = F.out + O_CONVS + (size_t)sb * 2 * DFF + c0;
#pragma unroll
                for (int i = 0; i < 8; ++i) { o[i] = g1[i]; o[DFF + i] = g2[i]; a[i] = gelu_tanh(bb[i] + w0[i] * g0[i] + w1[i] * g1[i] + w2[i] * g2[i]) * u[i]; }
                *(u32x4*)(act + (size_t)row * DFF + c0) = pack8(a); }
            for (int row = NTOK; row < MPAD; ++row) *(u32x4*)(act + (size_t)row * DFF + c0) = (u32x4){0u, 0u, 0u, 0u};
        }
    }
}

template <bool A_F32>
__device__ __forceinline__ void skinny_mma(f32x4 (&acc)[2], float (&ssq)[2], const void* A, int lda, const bf16* Bt, int K, int n0, int k0, int nks, int r, int q) {
    acc[0] = (f32x4){0.f, 0.f, 0.f, 0.f}; acc[1] = acc[0]; ssq[0] = 0.f; ssq[1] = 0.f;
#pragma unroll 4
    for (int ks = 0; ks < nks; ++ks) { const int k = k0 + 32 * ks + 8 * q;
        const bf16x8 a = ldfrag(Bt + (size_t)(n0 + r) * K + k);
#pragma unroll
        for (int mt = 0; mt < 2; ++mt) { bf16x8 bfr;
            if (A_F32) { const float* p = (const float*)A + (size_t)(16 * mt + r) * lda + k; const f32x4 x0 = *(const f32x4*)p, x1 = *(const f32x4*)(p + 4);
                ssq[mt] += (x0[0] * x0[0] + x0[1] * x0[1]) + (x0[2] * x0[2] + x0[3] * x0[3]) + (x1[0] * x1[0] + x1[1] * x1[1]) + (x1[2] * x1[2] + x1[3] * x1[3]); bfr = frag_pk(x0, x1); }
            else bfr = ldfrag((const bf16*)A + (size_t)(16 * mt + r) * lda + k);
            acc[mt] = MFMA16(a, bfr, acc[mt]); } }
}
__device__ __forceinline__ void s5_merge(Frame& F, int t) {
    const int lane = LANE_, r = lane & 15, q = lane >> 4, br = t >> 7, nt = (t >> 1) & 63, kc = t & 1;
    const bf16* A = (br == 0 ? WSP(bf16, WS_ONSA) : br == 1 ? WSP(bf16, WS_OGLA) : WSP(bf16, WS_OX)) + (size_t)NTOKP * 512;
    const bf16* Bt = br == 0 ? WSP(bf16, WS_WTNSA) : br == 1 ? WSP(bf16, WS_WTGLA) : WSP(bf16, WS_WTX);
    f32x4 acc[2]; float ssq[2]; skinny_mma<false>(acc, ssq, A, 512, Bt, 512, 16 * nt, 256 * kc, 8, r, q);
    float* ms = WSP(float, WS_MS); const bf16* gate = WSP(bf16, WS_PROJ) + (size_t)NTOKP * DINP + C_MG + br * 1024;
#pragma unroll
    for (int mt = 0; mt < 2; ++mt) { const int m = 16 * mt + r; const u32x2 g = *(const u32x2*)(gate + (size_t)m * DINP + 16 * nt + 4 * q);
        float* d = ms + (size_t)m * 1024 + 16 * nt + 4 * q;
        atomicAdd(d + 0, acc[mt][0] * sigmoidf_(bflo(g.x))); atomicAdd(d + 1, acc[mt][1] * sigmoidf_(bfhi(g.x)));
        atomicAdd(d + 2, acc[mt][2] * sigmoidf_(bflo(g.y))); atomicAdd(d + 3, acc[mt][3] * sigmoidf_(bfhi(g.y))); }
}
__device__ __forceinline__ void s6_wo(Frame& F, int t) {
    const int lane = LANE_, r = lane & 15, q = lane >> 4, nt = t >> 2, kc = t & 3;
    f32x4 acc[2]; float ssq[2]; skinny_mma<true>(acc, ssq, WSP(float, WS_MS), 1024, WSP(bf16, WS_WTO), 1024, 16 * nt, 256 * kc, 8, r, q);
    float* x1s = WSP(float, WS_X1S);
#pragma unroll
    for (int mt = 0; mt < 2; ++mt) { float* d = x1s + (size_t)(16 * mt + r) * 1024 + 16 * nt + 4 * q;
#pragma unroll
        for (int i = 0; i < 4; ++i) atomicAdd(d + i, acc[mt][i]); }
}
__device__ __forceinline__ void s7_up(Frame& F, int t) {
    const int lane = LANE_, r = lane & 15, q = lane >> 4;
    f32x4 acc[2]; float ssq[2]; skinny_mma<true>(acc, ssq, WSP(float, WS_X1S), 1024, WSP(bf16, WS_WTUP), 1024, 16 * t, 0, 32, r, q);
    bf16* ug = WSP(bf16, WS_UG) + (size_t)NTOKP * DUP;
#pragma unroll
    for (int mt = 0; mt < 2; ++mt) { float s = ssq[mt]; s += __shfl_xor(s, 16); s += __shfl_xor(s, 32); const float rs = rsqrtf(s * (1.f / 1024.f) + EPS);
        u32x2 w; w.x = pk2(acc[mt][0] * rs, acc[mt][1] * rs); w.y = pk2(acc[mt][2] * rs, acc[mt][3] * rs);
        *(u32x2*)(ug + (size_t)(16 * mt + r) * DUP + 16 * t + 4 * q) = w; }
}
__device__ __forceinline__ void s9_down(Frame& F, int t) {
    const int lane = LANE_, r = lane & 15, q = lane >> 4, nt = t / 11, kc = t % 11;
    f32x4 acc[2]; float ssq[2]; skinny_mma<false>(acc, ssq, WSP(bf16, WS_ACT) + (size_t)NTOKP * DFF, DFF, WSP(bf16, WS_WTDOWN), DFF, 16 * nt, 256 * kc, 8, r, q);
    float* ys = F.out + O_YS;
#pragma unroll
    for (int mt = 0; mt < 2; ++mt) { float* d = ys + (size_t)(16 * mt + r) * 1024 + 16 * nt + 4 * q;
#pragma unroll
        for (int i = 0; i < 4; ++i) atomicAdd(d + i, acc[mt][i]); }
}

constexpr int N_PHASES = 10;
__global__ void __launch_bounds__(NTHR, 2) mega_fwd(Args args) {
    extern __shared__ __attribute__((aligned(16))) unsigned char lds_raw[];
    cg::grid_group grid = cg::this_grid();
    Frame F;
    F.lds = (LAS unsigned char*)lds_raw;
    F.wave = __builtin_amdgcn_readfirstlane((int)(threadIdx.x >> 6));
    F.G = gridDim.x; F.bid = blockIdx.x; F.gw = F.bid * NWAVES + F.wave; F.NGW = F.G * NWAVES;
    F.in = args.in; F.out = args.out; F.ws = args.ws;
    const int lo = args.ph_lo, hi = args.ph_hi, sub = args.sub;
    volatile LAS unsigned* xst = (volatile LAS unsigned*)(F.lds + 150048);
    if (threadIdx.x < 2) xst[threadIdx.x] = 0u;
    __syncthreads();
    XcdBarrier xbar; xbar.bar = (unsigned*)(args.ws + WS_CTL); xbar.x = 0; xbar.st = xst;
    if (lo == 0 && hi == N_PHASES) xbar = xcd_barrier_post((unsigned*)(args.ws + WS_CTL), xst);
#define SUB(i) ((sub >> (i)) & 1)
#ifndef PROBE_REP
#define PROBE_REP -1
#endif
#define IN(k) (lo <= (k) && (k) < hi)
#define REP(k) for (int rep_ = 0; rep_ < ((k) == PROBE_REP ? 2 : 1); ++rep_)
#define SEAM(k) do { if (IN(k) && IN((k) + 1)) { if ((k) == 0) grid.sync(); else xcd_barrier(xbar); } { unsigned char* w_ = F.ws; asm volatile("" : "+s"(w_)); F.ws = w_; float* o_ = F.out; asm volatile("" : "+s"(o_)); F.out = o_; } } while (0)
    typedef pg8::StaticOrder SO;

    REP(0) if (IN(0)) { p0_prologue(F); }
    SEAM(0);
    if (IN(1)) {
        { pg8::Gemm g{WSP(bf16, WS_XN), WSP(bf16, WS_WTIN), MPAD, DINP, 1024}; SO S; S.init(MPAD, DINP, F.G, F.bid);
          pg8::EpiStore E{WSP(bf16, WS_PROJ), DINP, nullptr};
          pg8::gemm_phase<pg8::EpiStore, SO, true, true>(F.lds, g, S, E, F.wave); }
        __syncthreads();
        { pg8::Gemm g{WSP(bf16, WS_MN), WSP(bf16, WS_WTMEM), 512, 1024, 1024}; SO S; S.init(512, 1024, F.G, F.G - 1 - F.bid);
          pg8::EpiStore E{WSP(bf16, WS_MEMPROJ), 1024, nullptr};
          pg8::gemm_phase<pg8::EpiStore, SO, true, true>(F.lds, g, S, E, F.wave); }
    }
    SEAM(1);
    REP(2) if (IN(2)) {
        if (SUB(0)) { for (int tok = F.gw; tok < NTOK; tok += F.NGW) p2_token(F, tok);
        for (int row = F.gw; row < 512; row += F.NGW) p2_memrow(F, row); }
        if (SUB(1)) for (int t = F.bid; t < CMP_TASKS_S + CMP_TASKS_P; t += F.G) p2_compress(F, t);
        if (SUB(2)) for (int bc = F.bid; bc < 256; bc += F.G) { __syncthreads(); p2_gla_chunk(F, bc); }
        __syncthreads();
        if (SUB(3)) for (int t = F.gw; t < SB * 4; t += F.NGW) p2_gla_sample(F, t);
    }
    SEAM(2);
    REP(3) if (IN(3)) {
        nsa_tables(F);
        const float mb = nsa_bound(F);
        if (SUB(4)) for (int n = F.bid; n < 1024; n += F.G) p3_nsa_prompt(F, n, mb, (sub >> 8) & 31);
        __syncthreads();
        if (SUB(6)) { const float gq = absmax_arr(F.in[I_GXQ], 128, LANE_), gk = absmax_arr(F.in[I_GXK], 128, LANE_);
          const float mbx = 11.313708498984761f * gq * gk * 1.02f * LOG2E;
          for (int t = F.bid; t < 256; t += F.G) p3_xatt(F, t, mbx); }
        __syncthreads();
        if (SUB(6)) for (int t = F.gw; t < SB * 4; t += F.NGW) p3_xatt_sample(F, t);
        if (SUB(7)) for (int t = F.gw; t < 1024; t += F.NGW) p3_gla_scan(F, t);
    }
    SEAM(3);
    if (IN(4)) {
        nsa_tables(F);
        for (int t = F.G - 1 - F.bid; t < SB * 2; t += F.G) p3_nsa_sample(F, t);
        __syncthreads();
        { const int nb = F.G > 128 ? F.G - 64 : F.G;
          if (F.bid < nb) for (int t = F.gw; t < 4096; t += nb * NWAVES) p4_gla_out(F, t); }
    }
    SEAM(4);
    if (IN(5)) {
        const bf16* gate = WSP(bf16, WS_PROJ) + C_MG;
        for (int t = F.gw; t < 384; t += F.NGW) s5_merge(F, t);
        { pg8::Gemm g{WSP(bf16, WS_ONSA), WSP(bf16, WS_WTNSA), NTOKP, 1024, 512}; SO S; S.init(NTOKP, 1024, F.G, F.bid);
          pg8::EpiMerge<0> E{gate, DINP, WSP(bf16, WS_MERGED), 1024};
          pg8::gemm_phase<pg8::EpiMerge<0>, SO, true, true>(F.lds, g, S, E, F.wave); }
        __syncthreads();
        { pg8::Gemm g{WSP(bf16, WS_OGLA), WSP(bf16, WS_WTGLA), NTOKP, 1024, 512}; SO S; S.init(NTOKP, 1024, F.G, F.bid);
          pg8::EpiMerge<1> E{gate + 1024, DINP, WSP(bf16, WS_MERGED), 1024};
          pg8::gemm_phase<pg8::EpiMerge<1>, SO, true, true>(F.lds, g, S, E, F.wave); }
        __syncthreads();
        { pg8::Gemm g{WSP(bf16, WS_OX), WSP(bf16, WS_WTX), NTOKP, 1024, 512}; SO S; S.init(NTOKP, 1024, F.G, F.bid);
          pg8::EpiMerge<1> E{gate + 2048, DINP, WSP(bf16, WS_MERGED), 1024};
          pg8::gemm_phase<pg8::EpiMerge<1>, SO, true, true>(F.lds, g, S, E, F.wave); }
    }
    SEAM(5);
    if (IN(6)) {
        for (int t = F.gw; t < 256; t += F.NGW) s6_wo(F, t);
        pg8::Gemm g{WSP(bf16, WS_MERGED), WSP(bf16, WS_WTO), NTOKP, 1024, 1024}; SO S; S.init(NTOKP, 1024, F.G, F.bid);
        pg8::EpiWo E{F.in[I_XP], F.in[I_XS], WSP(float, WS_X1), WSP(bf16, WS_X1B), WSP(float, WS_SSQ)};
        pg8::gemm_phase<pg8::EpiWo, SO, true, true>(F.lds, g, S, E, F.wave);
    }
    SEAM(6);
    if (IN(7)) {
        for (int t = F.gw; t < 352; t += F.NGW) s7_up(F, t);
        pg8::Gemm g{WSP(bf16, WS_X1B), WSP(bf16, WS_WTUP), NTOKP, DUP, 1024}; SO S; S.init(NTOKP, DUP, F.G, F.bid);
        pg8::EpiStore E{WSP(bf16, WS_UG), DUP, WSP(float, WS_SSQ)};
        pg8::gemm_phase<pg8::EpiStore, SO, true, true>(F.lds, g, S, E, F.wave);
    }
    SEAM(7);
    REP(8) if (IN(8)) { p6_conv(F); }
    SEAM(8);
    if (IN(9)) {
        for (int t = F.gw; t < 704; t += F.NGW) s9_down(F, t);
        pg8::Gemm g{WSP(bf16, WS_ACT), WSP(bf16, WS_WTDOWN), NTOKP, 1024, DFF}; SO S; S.init(NTOKP, 1024, F.G, F.bid);
        pg8::EpiDown E{WSP(float, WS_X1), F.out + O_Y, F.out + O_YS};
        pg8::gemm_phase<pg8::EpiDown, SO, true, true>(F.lds, g, S, E, F.wave);
    }
#undef IN
#undef SEAM
}

extern "C" void kernel_launch(void* const* d_in, const int* in_sizes, int n_in, void* d_out, int out_size, void* d_ws, size_t ws_size, hipStream_t stream) {
    static int grid = 0;
    if (grid == 0) {
        if (n_in != N_IN || (size_t)out_size != O_END || ws_size < WS_END) {
            fprintf(stderr, "kernel_launch: built for %d inputs, %zu outputs, >= %zu bytes of workspace; got %d, %d, %zu\n", (int)N_IN, (size_t)O_END, (size_t)WS_END, n_in, out_size, ws_size); grid = -1; return; }
        int dev = 0, cus = 0, per_cu = 0;
        if (hipGetDevice(&dev) != hipSuccess || hipDeviceGetAttribute(&cus, hipDeviceAttributeMultiprocessorCount, dev) != hipSuccess) { grid = -1; return; }
        if (hipFuncSetAttribute((const void*)mega_fwd, hipFuncAttributeMaxDynamicSharedMemorySize, LDS_BYTES) != hipSuccess) { fprintf(stderr, "kernel_launch: hipFuncSetAttribute failed\n"); grid = -1; return; }
        if (hipOccupancyMaxActiveBlocksPerMultiprocessor(&per_cu, (const void*)mega_fwd, NTHR, LDS_BYTES) != hipSuccess || per_cu < 1) { fprintf(stderr, "kernel_launch: occupancy query gave %d\n", per_cu); per_cu = 1; }
        (void)hipGetLastError();
        grid = cus * (per_cu < 1 ? 1 : 1);
    }
    if (grid < 0) return;
    Args a{};
    for (int i = 0; i < N_IN; ++i) a.in[i] = (const float*)d_in[i];
    a.out = (float*)d_out; a.ws = (unsigned char*)d_ws;
#if MK_N_LAUNCHES == 1
    a.ph_lo = 0; a.ph_hi = N_PHASES; a.sub = 0xff;
    (void)hipMemsetAsync((unsigned char*)d_ws + WS_CTL, 0, CTL_BYTES, stream);
    void* kargs[] = {&a};
    hipError_t e = hipLaunchCooperativeKernel((const void*)mega_fwd, dim3(grid), dim3(NTHR), kargs, LDS_BYTES, stream);
    if (e != hipSuccess) fprintf(stderr, "kernel_launch: cooperative launch failed: %s (grid %d)\n", hipGetErrorString(e), grid);
#ifdef PROBE_EXTRA
    a.ph_lo = PROBE_EXTRA; a.ph_hi = PROBE_EXTRA + 1;
#ifdef PROBE_SUB
    a.sub = PROBE_SUB;
#endif
    hipLaunchKernelGGL(mega_fwd, dim3(grid), dim3(NTHR), LDS_BYTES, stream, a);
#endif
#else
    a.sub = 0xff;
    for (int p = 0; p < N_PHASES; ++p) { a.ph_lo = p; a.ph_hi = p + 1; hipLaunchKernelGGL(mega_fwd, dim3(grid), dim3(NTHR), LDS_BYTES, stream, a); }
#endif
}
```

```cpp
#include <hip/hip_runtime.h>
#include <hip/hip_cooperative_groups.h>
#include <cstdio>
#include <cstdint>
namespace cg = cooperative_groups;
#ifndef MK_N_LAUNCHES
#define MK_N_LAUNCHES 1
#endif
namespace pg8 {
#define PG8_LAS __attribute__((address_space(3)))
typedef unsigned short bf16_t;
typedef short bf16x8 __attribute__((ext_vector_type(8)));
typedef float f32x4 __attribute__((ext_vector_type(4)));
typedef unsigned u32x4 __attribute__((ext_vector_type(4)));
constexpr int BM = 256, BK = 64, HALF = 128, HTB = HALF * BK * 2  , STAGE_BYTES = 8 * HTB, NXCD = 8, WGM = 8;

__host__ __device__ __forceinline__ int lds_byte(int r, int c) { const int st = (r >> 4) * 2 + (c >> 5), rr = r & 15, cc = c & 31, ob = rr * 64 + cc * 2; return st * 1024 + (ob ^ (((ob >> 9) & 1) << 5)); }
__host__ __device__ __forceinline__ void stage_rc(int b, int& R, int& C) { const int st = b / 1024, sb = b % 1024, swz = sb ^ (((sb >> 9) & 1) << 5); R = (st >> 1) * 16 + swz / 64; C = (st & 1) * 32 + (swz % 64) / 2; }
__host__ __device__ __forceinline__ int perm32(int rho) { const int n = rho >> 4, i = rho & 15; return 8 * (i >> 2) + 4 * n + (i & 3); }

struct Unit { int pm, pn; };
struct Gemm { const bf16_t* A; const bf16_t* Bt; int M, N, K; };

struct StaticOrder {
    int nM, nN, nwg, G, c;
    __host__ __device__ void init(int M, int N, int G_, int c_) { nM = M / BM; nN = N / BM; nwg = nM * nN; G = G_; c = c_; }
    __host__ __device__ bool next(int i, Unit& u) const {
        const long L = (long)i * G + c; if (L >= nwg) return false;
        int wgid = (int)L; { const int q = nwg / NXCD, r = nwg % NXCD, xcd = wgid % NXCD, off = wgid / NXCD; wgid = (xcd < r ? xcd * (q + 1) : r * (q + 1) + (xcd - r) * q) + off; }
        const int nig = WGM * nN, gid = wgid / nig, fm = gid * WGM, gsz = (nM - fm) < WGM ? (nM - fm) : WGM;
        u.pm = fm + ((wgid % nig) % gsz); u.pn = (wgid % nig) / gsz; return true;
    }
    __device__ __forceinline__ void a_ready(const Unit&) const {}
    __device__ __forceinline__ void done(const Unit&) const {}
};

__device__ __forceinline__ unsigned cvt_pk_bf16(float lo, float hi) { unsigned r; asm volatile("v_cvt_pk_bf16_f32 %0, %1, %2" : "=v"(r) : "v"(lo), "v"(hi)); return r; }
__device__ __forceinline__ float bflo(unsigned w) { return __uint_as_float(w << 16); }
__device__ __forceinline__ float bfhi(unsigned w) { return __uint_as_float(w & 0xffff0000u); }
__device__ __forceinline__ float sigm(float x) { return 1.0f / (1.0f + __expf(-x)); }
struct EpiStore {
    static constexpr bool PERM = true, AFTER_DRAIN = false;
    bf16_t* O; int ldc; const float* ssq;
    __device__ __forceinline__ void operator()(const f32x4 (&acc)[2][2][4][2], const Unit& u, int wr, int wc, int fr, int fq) const {
        const int row0 = u.pm * BM + wr * 64 + fr, col0 = u.pn * BM + wc * 32 + 8 * fq;
#pragma unroll
        for (int ai = 0; ai < 2; ++ai)
#pragma unroll
            for (int m = 0; m < 4; ++m) { const int row = row0 + ai * HALF + m * 16; bf16_t* rowp = O + (size_t)row * ldc + col0;
                const float sc = ssq ? rsqrtf(ssq[row] * (1.0f / 1024.0f) + 1e-6f) : 1.0f;
#pragma unroll
                for (int bj = 0; bj < 2; ++bj) { const f32x4 v0 = acc[ai][bj][m][0] * sc, v1 = acc[ai][bj][m][1] * sc;
                    u32x4 w; w.x = cvt_pk_bf16(v0[0], v0[1]); w.y = cvt_pk_bf16(v0[2], v0[3]); w.z = cvt_pk_bf16(v1[0], v1[1]); w.w = cvt_pk_bf16(v1[2], v1[3]);
                    *(u32x4*)(rowp + bj * HALF) = w; } }
    }
};
template <int ACCUM> struct EpiMerge {
    static constexpr bool PERM = true, AFTER_DRAIN = false;
    const bf16_t* gate; int ldg; bf16_t* O; int ldc;
    __device__ __forceinline__ void operator()(const f32x4 (&acc)[2][2][4][2], const Unit& u, int wr, int wc, int fr, int fq) const {
        const int row0 = u.pm * BM + wr * 64 + fr, col0 = u.pn * BM + wc * 32 + 8 * fq;
#pragma unroll
        for (int ai = 0; ai < 2; ++ai)
#pragma unroll
            for (int m = 0; m < 4; ++m) { const int row = row0 + ai * HALF + m * 16; bf16_t* rowp = O + (size_t)row * ldc + col0; const bf16_t* gp = gate + (size_t)row * ldg + col0;
#pragma unroll
                for (int bj = 0; bj < 2; ++bj) {
                    const u32x4 g = *(const u32x4*)(gp + bj * HALF);
                    f32x4 v0 = acc[ai][bj][m][0], v1 = acc[ai][bj][m][1];
                    v0[0] *= sigm(bflo(g.x)); v0[1] *= sigm(bfhi(g.x)); v0[2] *= sigm(bflo(g.y)); v0[3] *= sigm(bfhi(g.y));
                    v1[0] *= sigm(bflo(g.z)); v1[1] *= sigm(bfhi(g.z)); v1[2] *= sigm(bflo(g.w)); v1[3] *= sigm(bfhi(g.w));
                    if (ACCUM) { const u32x4 o = *(const u32x4*)(rowp + bj * HALF);
                        v0[0] += bflo(o.x); v0[1] += bfhi(o.x); v0[2] += bflo(o.y); v0[3] += bfhi(o.y);
                        v1[0] += bflo(o.z); v1[1] += bfhi(o.z); v1[2] += bflo(o.w); v1[3] += bfhi(o.w); }
                    u32x4 w; w.x = cvt_pk_bf16(v0[0], v0[1]); w.y = cvt_pk_bf16(v0[2], v0[3]); w.z = cvt_pk_bf16(v1[0], v1[1]); w.w = cvt_pk_bf16(v1[2], v1[3]);
                    *(u32x4*)(rowp + bj * HALF) = w; } }
    }
};
struct EpiWo {
    static constexpr bool PERM = true, AFTER_DRAIN = false;
    const float* xp; const float* xs; float* X1; bf16_t* X1B; float* ssq;
    __device__ __forceinline__ void operator()(const f32x4 (&acc)[2][2][4][2], const Unit& u, int wr, int wc, int fr, int fq) const {
        const int row0 = u.pm * BM + wr * 64 + fr, col0 = u.pn * BM + wc * 32 + 8 * fq;
#pragma unroll
        for (int ai = 0; ai < 2; ++ai)
#pragma unroll
            for (int m = 0; m < 4; ++m) { const int row = row0 + ai * HALF + m * 16;
                const float* xr = row < 16384 ? xp + (size_t)row * 1024 : (row < 16416 ? xs + (size_t)(row - 16384) * 1024 : nullptr);
                float ss = 0.f;
#pragma unroll
                for (int bj = 0; bj < 2; ++bj) { const int col = col0 + bj * HALF;
                    f32x4 x0 = (f32x4){0.f, 0.f, 0.f, 0.f}, x1 = x0;
                    if (xr) { x0 = *(const f32x4*)(xr + col); x1 = *(const f32x4*)(xr + col + 4); }
                    const f32x4 v0 = acc[ai][bj][m][0] + x0, v1 = acc[ai][bj][m][1] + x1;
                    *(f32x4*)(X1 + (size_t)row * 1024 + col) = v0; *(f32x4*)(X1 + (size_t)row * 1024 + col + 4) = v1;
                    u32x4 w; w.x = cvt_pk_bf16(v0[0], v0[1]); w.y = cvt_pk_bf16(v0[2], v0[3]); w.z = cvt_pk_bf16(v1[0], v1[1]); w.w = cvt_pk_bf16(v1[2], v1[3]);
                    *(u32x4*)(X1B + (size_t)row * 1024 + col) = w;
                    ss += (v0[0] * v0[0] + v0[1] * v0[1]) + (v0[2] * v0[2] + v0[3] * v0[3]) + (v1[0] * v1[0] + v1[1] * v1[1]) + (v1[2] * v1[2] + v1[3] * v1[3]); }
                ss += __shfl_xor(ss, 16); ss += __shfl_xor(ss, 32);
                if (fq == 0) atomicAdd(ssq + row, ss); }
    }
};
struct EpiDown {
    static constexpr bool PERM = true, AFTER_DRAIN = false;
    const float* X1; float* yp; float* ys;
    __device__ __forceinline__ void operator()(const f32x4 (&acc)[2][2][4][2], const Unit& u, int wr, int wc, int fr, int fq) const {
        const int row0 = u.pm * BM + wr * 64 + fr, col0 = u.pn * BM + wc * 32 + 8 * fq;
#pragma unroll
        for (int ai = 0; ai < 2; ++ai)
#pragma unroll
            for (int m = 0; m < 4; ++m) { const int row = row0 + ai * HALF + m * 16;
                float* yr = row < 16384 ? yp + (size_t)row * 1024 : (row < 16416 ? ys + (size_t)(row - 16384) * 1024 : nullptr);
                if (!yr) continue;
#pragma unroll
                for (int bj = 0; bj < 2; ++bj) { const int col = col0 + bj * HALF;
                    const f32x4 x0 = *(const f32x4*)(X1 + (size_t)row * 1024 + col), x1 = *(const f32x4*)(X1 + (size_t)row * 1024 + col + 4);
                    *(f32x4*)(yr + col) = acc[ai][bj][m][0] + x0; *(f32x4*)(yr + col + 4) = acc[ai][bj][m][1] + x1; } }
    }
};
template <class Epi, class Sched, bool ALIGN_EPI = false, bool SP2 = false>
__device__ __forceinline__ void gemm_phase(PG8_LAS unsigned char* lds, const Gemm g, const Sched& S, const Epi& E, const int wid) {
    unsigned z_ = 0u; asm volatile("" : "+v"(z_));
    const int lane = (int)__builtin_amdgcn_mbcnt_hi(~0u, __builtin_amdgcn_mbcnt_lo(~0u, z_)), tid = wid * 64 + lane, wr = wid >> 2, wc = wid & 3, fr = lane & 15, fq = lane >> 4;
    const int K = g.K, nt = K / BK;
    unsigned voffA[2], voffB[2];
#pragma unroll
    for (int i = 0; i < 2; ++i) { int R, C; stage_rc(tid * 16 + i * 8192, R, C); const int Rb = Epi::PERM ? ((R & ~31) + perm32(R & 31)) : R;
        voffA[i] = (unsigned)(R * K + C) * 2u; voffB[i] = (unsigned)(Rb * K + C) * 2u; }
    const size_t kstep = (size_t)(BK * 2);
    const size_t hstep = (size_t)HALF * K * 2;
    const size_t tstep = 2 * hstep;
    const unsigned ldsw = (unsigned)wid * 1024u;
    const int aoff = lds_byte(wr * 64 + fr, fq * 8), boff = lds_byte(wc * 32 + fr, fq * 8);
#define PG8_SA(b, h) (((b) * 2 + (h)) * HTB)
#define PG8_SB(b, h) ((4 + (b) * 2 + (h)) * HTB)
#define PG8_STAGE(bufoff, gbase, voff) do { _Pragma("unroll") for (int _i = 0; _i < 2; ++_i) \
        __builtin_amdgcn_global_load_lds((const unsigned*)((const char*)(gbase) + (voff)[_i]), (PG8_LAS unsigned*)(lds + (bufoff) + ldsw + _i * 8192), 16, 0, 0); } while (0)
#define PG8_LDA(dst, b, h) do { _Pragma("unroll") for (int m = 0; m < 4; ++m) _Pragma("unroll") for (int k = 0; k < 2; ++k) dst[m][k] = *(const PG8_LAS bf16x8*)(lds + PG8_SA(b, h) + aoff + m * 2048 + k * 1024); } while (0)
#define PG8_LDB(dst, b, h) do { _Pragma("unroll") for (int n = 0; n < 2; ++n) _Pragma("unroll") for (int k = 0; k < 2; ++k) dst[n][k] = *(const PG8_LAS bf16x8*)(lds + PG8_SB(b, h) + boff + n * 2048 + k * 1024); } while (0)
#define PG8_MMA(ai, bj, At, Bt) do { __builtin_amdgcn_s_setprio(1); _Pragma("unroll") for (int m = 0; m < 4; ++m) _Pragma("unroll") for (int n = 0; n < 2; ++n) _Pragma("unroll") for (int k = 0; k < 2; ++k) \
        acc[ai][bj][m][n] = __builtin_amdgcn_mfma_f32_16x16x32_bf16(Bt[n][k], At[m][k], acc[ai][bj][m][n], 0, 0, 0); __builtin_amdgcn_s_setprio(0); } while (0)
#define PG8_WAIT_V(n) asm volatile("s_waitcnt vmcnt(" #n ")" ::: "memory")
#define PG8_WAIT_L(n) asm volatile("s_waitcnt lgkmcnt(" #n ")" ::: "memory")
#define PG8_BAR __builtin_amdgcn_s_barrier()
#define PG8_SCHED __builtin_amdgcn_sched_barrier(0)
    Unit cur, nxt; int ui = 0;
    if (!S.next(0, cur)) return;
    f32x4 acc[2][2][4][2];
#pragma unroll
    for (int a = 0; a < 2; ++a)
#pragma unroll
        for (int b = 0; b < 2; ++b)
#pragma unroll
            for (int m = 0; m < 4; ++m)
#pragma unroll
                for (int n = 0; n < 2; ++n) acc[a][b][m][n] = (f32x4){0.f, 0.f, 0.f, 0.f};
    bf16x8 At[4][2], B0[2][2], B1[2][2];
    const char* cA = (const char*)g.A + (size_t)cur.pm * tstep; const char* cB = (const char*)g.Bt + (size_t)cur.pn * tstep;
    S.a_ready(cur);
    if constexpr (SP2) {
        PG8_STAGE(PG8_SB(0, 0), cB, voffB); PG8_STAGE(PG8_SB(0, 1), cB + hstep, voffB); PG8_STAGE(PG8_SA(0, 0), cA, voffA); PG8_STAGE(PG8_SA(0, 1), cA + hstep, voffA);
        if (wr == 1) PG8_BAR;
        PG8_WAIT_V(2); PG8_BAR;
        PG8_STAGE(PG8_SB(1, 0), cB + kstep, voffB); PG8_STAGE(PG8_SA(1, 0), cA + kstep, voffA); PG8_STAGE(PG8_SB(1, 1), cB + hstep + kstep, voffB);
        PG8_WAIT_V(6); PG8_BAR;
    } else {
        PG8_STAGE(PG8_SB(0, 0), cB, voffB); PG8_STAGE(PG8_SA(0, 0), cA, voffA); PG8_STAGE(PG8_SB(0, 1), cB + hstep, voffB); PG8_STAGE(PG8_SA(0, 1), cA + hstep, voffA);
        if (wr == 1) PG8_BAR;
        PG8_WAIT_V(4); PG8_BAR;
        PG8_STAGE(PG8_SB(1, 0), cB + kstep, voffB); PG8_STAGE(PG8_SA(1, 0), cA + kstep, voffA); PG8_STAGE(PG8_SB(1, 1), cB + hstep + kstep, voffB);
        PG8_WAIT_V(6); PG8_BAR;
    }
    for (;;) {
        const bool has_next = S.next(ui + 1, nxt);
        const char* nA = has_next ? (const char*)g.A + (size_t)nxt.pm * tstep : cA; const char* nB = has_next ? (const char*)g.Bt + (size_t)nxt.pn * tstep : cB;
        for (int t = 0; t < nt; t += 2) {
            const bool last = (t == nt - 2);
            const char* a1 = cA + (size_t)(t + 1) * kstep;
            const char* a2 = last ? nA : cA + (size_t)(t + 2) * kstep; const char* b2 = last ? nB : cB + (size_t)(t + 2) * kstep;
            const char* a3 = a2 + kstep; const char* b3 = b2 + kstep;
            if (last && has_next) S.a_ready(nxt);
            if constexpr (SP2) {
            PG8_LDB(B0, 0, 0); PG8_LDB(B1, 0, 1); PG8_SCHED; PG8_LDA(At, 0, 0); PG8_STAGE(PG8_SA(1, 1), a1 + hstep, voffA);
            PG8_WAIT_V(8); PG8_WAIT_L(0); PG8_BAR; PG8_MMA(0, 0, At, B0); PG8_MMA(0, 1, At, B1); PG8_BAR; PG8_SCHED;
            PG8_LDA(At, 0, 1); PG8_STAGE(PG8_SB(0, 0), b2, voffB); PG8_STAGE(PG8_SB(0, 1), b2 + hstep, voffB); PG8_STAGE(PG8_SA(0, 0), a2, voffA);
            PG8_WAIT_V(8); PG8_WAIT_L(0); PG8_BAR; PG8_MMA(1, 0, At, B0); PG8_MMA(1, 1, At, B1); PG8_BAR; PG8_SCHED;
            PG8_LDB(B0, 1, 0); PG8_LDB(B1, 1, 1); PG8_SCHED; PG8_LDA(At, 1, 0); PG8_STAGE(PG8_SA(0, 1), a2 + hstep, voffA);
            PG8_WAIT_V(8); PG8_WAIT_L(0); PG8_BAR; PG8_MMA(0, 0, At, B0); PG8_MMA(0, 1, At, B1); PG8_BAR; PG8_SCHED;
            PG8_LDA(At, 1, 1); PG8_STAGE(PG8_SB(1, 0), b3, voffB); PG8_STAGE(PG8_SB(1, 1), b3 + hstep, voffB); PG8_STAGE(PG8_SA(1, 0), a3, voffA);
            PG8_WAIT_V(8); PG8_WAIT_L(0); PG8_BAR; PG8_MMA(1, 0, At, B0); PG8_MMA(1, 1, At, B1); PG8_BAR; PG8_SCHED;
            } else {
            PG8_LDB(B0, 0, 0); PG8_SCHED; PG8_LDA(At, 0, 0); PG8_STAGE(PG8_SA(1, 1), a1 + hstep, voffA);
            PG8_WAIT_L(8); PG8_BAR; PG8_WAIT_L(0); PG8_MMA(0, 0, At, B0); PG8_BAR; PG8_SCHED;
            PG8_LDB(B1, 0, 1); PG8_STAGE(PG8_SB(0, 0), b2, voffB);
            PG8_BAR; PG8_WAIT_L(0); PG8_MMA(0, 1, At, B1); PG8_BAR;
            PG8_LDA(At, 0, 1); PG8_STAGE(PG8_SA(0, 0), a2, voffA);
            PG8_BAR; PG8_WAIT_L(0); PG8_MMA(1, 0, At, B0); PG8_BAR; PG8_SCHED;
            PG8_STAGE(PG8_SB(0, 1), b2 + hstep, voffB);
            PG8_WAIT_V(6); PG8_BAR; PG8_MMA(1, 1, At, B1); PG8_BAR;
            PG8_LDB(B0, 1, 0); PG8_SCHED; PG8_LDA(At, 1, 0); PG8_STAGE(PG8_SA(0, 1), a2 + hstep, voffA);
            PG8_WAIT_L(8); PG8_BAR; PG8_WAIT_L(0); PG8_MMA(0, 0, At, B0); PG8_BAR; PG8_SCHED;
            PG8_LDB(B1, 1, 1); PG8_STAGE(PG8_SB(1, 0), b3, voffB);
            PG8_BAR; PG8_WAIT_L(0); PG8_MMA(0, 1, At, B1); PG8_BAR;
            PG8_LDA(At, 1, 1); PG8_STAGE(PG8_SA(1, 0), a3, voffA);
            PG8_BAR; PG8_WAIT_L(0); PG8_MMA(1, 0, At, B0); PG8_BAR; PG8_SCHED;
            PG8_STAGE(PG8_SB(1, 1), b3 + hstep, voffB);
            PG8_WAIT_V(6); PG8_BAR; PG8_MMA(1, 1, At, B1); PG8_BAR;
            }
        }
        if constexpr (ALIGN_EPI) { if (wr == 0) PG8_BAR; }
        if constexpr (!Epi::AFTER_DRAIN) { E(acc, cur, wr, wc, fr, fq); S.done(cur); }
        if (!has_next) break;
#pragma unroll
        for (int a = 0; a < 2; ++a)
#pragma unroll
            for (int b = 0; b < 2; ++b)
#pragma unroll
                for (int m = 0; m < 4; ++m)
#pragma unroll
                    for (int n = 0; n < 2; ++n) acc[a][b][m][n] = (f32x4){0.f, 0.f, 0.f, 0.f};
        cur = nxt; cA = nA; cB = nB; ++ui;
        if constexpr (ALIGN_EPI) { if (wr == 1) PG8_BAR; }
    }
    PG8_WAIT_V(0);
    if constexpr (!ALIGN_EPI) { if (wr == 0) PG8_BAR; }
    PG8_BAR;
    if constexpr (Epi::AFTER_DRAIN) { E.fused(acc, cur, wr, wc, fr, fq, lds, wid, lane); S.done(cur); }
#undef PG8_SA
#undef PG8_SB
#undef PG8_STAGE
#undef PG8_LDA
#undef PG8_LDB
#undef PG8_MMA
#undef PG8_WAIT_V
#undef PG8_WAIT_L
#undef PG8_BAR
#undef PG8_SCHED
}
}

typedef unsigned short bf16;
typedef short bf16x8 __attribute__((ext_vector_type(8)));
typedef short bf16x4 __attribute__((ext_vector_type(4)));
typedef float f32x4 __attribute__((ext_vector_type(4)));
typedef unsigned u32x4 __attribute__((ext_vector_type(4)));
typedef unsigned u32x2 __attribute__((ext_vector_type(2)));
#define LAS __attribute__((address_space(3)))
constexpr int NWAVES = 8, NTHR = 512;
constexpr int DM = 1024, T = 8192, NB = 2, NTOKP = NB * T, SB = 32, NTOK = NTOKP + SB, MPAD = 16640;
constexpr int DIN = 6440, DINP = 6656, DFF = 2816, DUP = 2 * DFF;
constexpr int C_Q = 0, C_KV = 512, C_G = 1280, C_GQ = 1304, C_GK = 1560, C_GV = 1816, C_LR = 2328, C_GR = 2344, C_XQ = 2856, C_MG = 3368;
constexpr float EPS = 1e-6f, LOG2E = 1.4426950408889634f;
constexpr float QSCALE = 0.125f * LOG2E;
constexpr float XSCALE = 0.08838834764831845f * LOG2E;
constexpr size_t O_Y = 0, O_YS = 16777216, O_KVP = O_YS + 32768, O_WINP = O_KVP + 8388608, O_GLAP = O_WINP + 262144, O_CONVP = O_GLAP + 65536,
                 O_MEMP = O_CONVP + 11264, O_KVS = O_MEMP + 524288, O_WINS = O_KVS + 16384, O_GLAS = O_WINS + 4194304, O_CONVS = O_GLAS + 1048576, O_END = O_CONVS + 180224;
enum { I_XP = 0, I_XS, I_CKV, I_CWIN, I_SGLA, I_SCONV, I_CMEM, I_PT, I_MEMP, I_GMIX, I_WIN, I_GNQ, I_GNK, I_CKPE, I_CKW1, I_CKW2, I_CVPE, I_CVW1, I_CVW2,
       I_RB, I_WGG, I_BGG, I_GGO, I_GMEM, I_WMEM, I_GXQ, I_GXK, I_WNSA, I_WGLA, I_WX, I_WO, I_GFFN, I_WUP, I_CONVW, I_CONVB, I_WDOWN, N_IN };
constexpr size_t al_(size_t x) { return (x + 255) & ~(size_t)255; }
constexpr size_t WS_SSQ = 0;
constexpr size_t WS_C0 = al_(WS_SSQ + (size_t)MPAD * 4);
constexpr size_t WS_WTIN = al_(WS_C0 + 1024);
constexpr size_t WS_WTMEM = al_(WS_WTIN + (size_t)DINP * 1024 * 2);
constexpr size_t WS_WTNSA = al_(WS_WTMEM + (size_t)1024 * 1024 * 2);
constexpr size_t WS_WTGLA = al_(WS_WTNSA + (size_t)1024 * 512 * 2);
constexpr size_t WS_WTX = al_(WS_WTGLA + (size_t)1024 * 512 * 2);
constexpr size_t WS_WTO = al_(WS_WTX + (size_t)1024 * 512 * 2);
constexpr size_t WS_WTUP = al_(WS_WTO + (size_t)1024 * 1024 * 2);
constexpr size_t WS_WTDOWN = al_(WS_WTUP + (size_t)DUP * 1024 * 2);
constexpr size_t WS_W1T = al_(WS_WTDOWN + (size_t)1024 * DFF * 2);
constexpr size_t WS_W2T = al_(WS_W1T + (size_t)2 * 64 * 2048 * 2);
constexpr size_t WS_XN = al_(WS_W2T + (size_t)2 * 64 * 64 * 2);
constexpr size_t WS_MN = al_(WS_XN + (size_t)MPAD * 1024 * 2);
constexpr size_t WS_PROJ = al_(WS_MN + (size_t)512 * 1024 * 2);
constexpr size_t WS_MEMPROJ = al_(WS_PROJ + (size_t)MPAD * DINP * 2);
constexpr size_t WS_QN = al_(WS_MEMPROJ + (size_t)512 * 1024 * 2);
constexpr size_t WS_KSEL = al_(WS_QN + (size_t)NTOK * 512 * 2);
constexpr size_t WS_VSELT = al_(WS_KSEL + (size_t)4 * T * 64 * 2);
constexpr size_t WS_KWIN = al_(WS_VSELT + (size_t)4 * T * 64 * 2);
constexpr size_t WS_VWINT = al_(WS_KWIN + (size_t)4 * T * 64 * 2);
constexpr size_t WS_GATES = al_(WS_VWINT + (size_t)4 * T * 64 * 2);
constexpr size_t WS_NEWKV = al_(WS_GATES + (size_t)NTOK * 24 * 4);
constexpr size_t WS_KCMP = al_(WS_NEWKV + (size_t)SB * 4 * 2 * 64 * 4);
constexpr size_t WS_VCMPT = al_(WS_KCMP + (size_t)4 * 512 * 64 * 2);
constexpr size_t WS_KCMPS = al_(WS_VCMPT + (size_t)4 * 512 * 64 * 2);
constexpr size_t WS_VCMPS = al_(WS_KCMPS + (size_t)SB * 2 * 512 * 64 * 4);
constexpr size_t WS_QTG = al_(WS_VCMPS + (size_t)SB * 2 * 512 * 64 * 4);
constexpr size_t WS_KTG = al_(WS_QTG + (size_t)NTOKP * 256 * 2);
constexpr size_t WS_VTG = al_(WS_KTG + (size_t)NTOKP * 256 * 2);
constexpr size_t WS_UP = al_(WS_VTG + (size_t)256 * 4 * 128 * 64 * 2);
constexpr size_t WS_DEC = al_(WS_UP + (size_t)256 * 4 * 128 * 64 * 4);
constexpr size_t WS_SC = al_(WS_DEC + (size_t)256 * 4 * 64 * 4);
constexpr size_t WS_XQ = al_(WS_SC + (size_t)256 * 4 * 128 * 64 * 2);
constexpr size_t WS_KMEM = al_(WS_XQ + (size_t)NTOK * 512 * 2);
constexpr size_t WS_VMEMT = al_(WS_KMEM + (size_t)8 * 256 * 128 * 2);
constexpr size_t WS_ONSA = al_(WS_VMEMT + (size_t)8 * 256 * 128 * 2);
constexpr size_t WS_OGLA = al_(WS_ONSA + (size_t)MPAD * 512 * 2);
constexpr size_t WS_OX = al_(WS_OGLA + (size_t)MPAD * 512 * 2);
constexpr size_t WS_MERGED = al_(WS_OX + (size_t)MPAD * 512 * 2);
constexpr size_t WS_X1 = al_(WS_MERGED + (size_t)MPAD * 1024 * 2);
constexpr size_t WS_X1B = al_(WS_X1 + (size_t)MPAD * 1024 * 4);
constexpr size_t WS_UG = al_(WS_X1B + (size_t)MPAD * 1024 * 2);
constexpr size_t WS_ACT = al_(WS_UG + (size_t)MPAD * DUP * 2);
constexpr size_t WS_MS = al_(WS_ACT + (size_t)MPAD * DFF * 2);
constexpr size_t WS_X1S = al_(WS_MS + (size_t)SB * 1024 * 4);
constexpr size_t WS_CTL = al_(WS_X1S + (size_t)SB * 1024 * 4);
constexpr size_t CTL_BYTES = 16384;
constexpr size_t WS_END = al_(WS_CTL + CTL_BYTES);
constexpr int RING_BYTES = 131072, LDS_BYTES = 155648;

struct Args { const float* in[N_IN]; float* out; unsigned char* ws; int ph_lo, ph_hi, sub, pad; };

__device__ __forceinline__ unsigned f2bf(float f) { unsigned u = __float_as_uint(f); return (u + 0x7fffu + ((u >> 16) & 1u)) >> 16; }
__device__ __forceinline__ unsigned pk2(float lo, float hi) { return pg8::cvt_pk_bf16(lo, hi); }
__device__ __forceinline__ float bf2f(unsigned short u) { return __uint_as_float((unsigned)u << 16); }
__device__ __forceinline__ float bflo(unsigned w) { return __uint_as_float(w << 16); }
__device__ __forceinline__ float bfhi(unsigned w) { return __uint_as_float(w & 0xffff0000u); }
__device__ __forceinline__ void unpack8(const u32x4 w, float (&f)[8]) { f[0] = bflo(w.x); f[1] = bfhi(w.x); f[2] = bflo(w.y); f[3] = bfhi(w.y); f[4] = bflo(w.z); f[5] = bfhi(w.z); f[6] = bflo(w.w); f[7] = bfhi(w.w); }
__device__ __forceinline__ u32x4 pack8(const float (&f)[8]) { u32x4 w; w.x = pk2(f[0], f[1]); w.y = pk2(f[2], f[3]); w.z = pk2(f[4], f[5]); w.w = pk2(f[6], f[7]); return w; }
__device__ __forceinline__ bf16x8 as_frag(u32x4 w) { return __builtin_bit_cast(bf16x8, w); }
__device__ __forceinline__ bf16x8 frag_pk(f32x4 a, f32x4 b) { u32x4 w; w.x = pk2(a[0], a[1]); w.y = pk2(a[2], a[3]); w.z = pk2(b[0], b[1]); w.w = pk2(b[2], b[3]); return as_frag(w); }
__device__ __forceinline__ bf16x8 ldfrag(const bf16* p) { return as_frag(*(const u32x4*)p); }
__device__ __forceinline__ bf16x8 ldfrag2(const bf16* p0, const bf16* p1) { const u32x2 a = *(const u32x2*)p0, b = *(const u32x2*)p1; u32x4 w; w.x = a.x; w.y = a.y; w.z = b.x; w.w = b.y; return as_frag(w); }
__device__ __forceinline__ bf16x8 ldfrag_f32(const float* p) { const f32x4 a = *(const f32x4*)p, b = *(const f32x4*)(p + 4); return frag_pk(a, b); }
#define MFMA16(a, b, c) __builtin_amdgcn_mfma_f32_16x16x32_bf16((a), (b), (c), 0, 0, 0)
__device__ __forceinline__ float sigmoidf_(float x) { return 1.0f / (1.0f + __expf(-x)); }
__device__ __forceinline__ float gelu_tanh(float x) { const float u = 0.7978845608028654f * (x + 0.044715f * x * x * x); const float e = __expf(2.0f * u); return 0.5f * x * (2.0f - 2.0f / (e + 1.0f)); }
__device__ __forceinline__ float wave_sum(float v) {
#pragma unroll
    for (int o = 1; o < 64; o <<= 1) v += __shfl_xor(v, o);
    return v;
}
__device__ __forceinline__ float wave_max(float v) {
#pragma unroll
    for (int o = 1; o < 64; o <<= 1) v = fmaxf(v, __shfl_xor(v, o));
    return v;
}
__device__ __forceinline__ float absmax_arr(const float* g, int n, int lane) { float m = 0.f; for (int i = lane; i < n; i += 64) m = fmaxf(m, fabsf(g[i])); return wave_max(m); }
__device__ __forceinline__ int t5_bucket(int n) {
    if (n < 16) return n;
    if (n >= 128) return 31;
    const int v = 16 + (int)(__logf((float)n * 0.0625f) / 2.0794415416798357f * 16.0f);
    return v < 31 ? v : 31;
}

#define XB_TMO      128
#define XB_XCNT(j)  (256  + 64 * (j))
#define XB_XSUB(j)  (1280 + 64 * (j))
#define XB_XGEN(j)  (2304 + 64 * (j))
#define XB_TOP      3328
#define XB_TOPGEN   3392
#define XCD_BAR_WORDS 3456
#define XB_SPIN_CAP (1u << 18)

__device__ __forceinline__ unsigned xb_ld(unsigned* p)              { return __hip_atomic_load(p, __ATOMIC_RELAXED, __HIP_MEMORY_SCOPE_AGENT); }
__device__ __forceinline__ unsigned xb_add(unsigned* p, unsigned v) { return __hip_atomic_fetch_add(p, v, __ATOMIC_RELAXED, __HIP_MEMORY_SCOPE_AGENT); }
__device__ __forceinline__ unsigned xb_xcc_id() { return (unsigned)__builtin_amdgcn_s_getreg((3 << 11) | 20) & 0xFu; }
#define XB_SPIN(cond, bar) do { unsigned _sp = 0; while (cond) { __builtin_amdgcn_s_sleep(1); \
    if ((++_sp & 255u) == 0u) { if (xb_ld(&(bar)[XB_TMO])) break; if (_sp > XB_SPIN_CAP) { atomicAdd(&(bar)[XB_TMO], 1u); break; } } } } while (0)

struct XcdBarrier {
    unsigned* bar; unsigned x;
    volatile LAS unsigned* st;
};

__device__ __forceinline__ XcdBarrier xcd_barrier_post(unsigned* bar, volatile LAS unsigned* st) {
    XcdBarrier b; b.bar = bar; b.x = xb_xcc_id(); b.st = st;
    if (threadIdx.x == 0) (void)xb_add(&bar[XB_XCNT(b.x)], 1u);
    return b;
}
__device__ __forceinline__ void xcd_barrier_complete(unsigned* bar, unsigned x, unsigned& nloc, unsigned& nx) {
    const unsigned G = gridDim.x * gridDim.y * gridDim.z;
    unsigned sum, cnt, mine, sp = 0u;
    for (;;) {
        sum = 0u; cnt = 0u; mine = 0u;
#pragma unroll
        for (unsigned j = 0; j < 16; ++j) { const unsigned c = xb_ld(&bar[XB_XCNT(j)]); sum += c; cnt += (c > 0u) ? 1u : 0u; mine = (j == x) ? c : mine; }
        if (sum == G) break;
        __builtin_amdgcn_s_sleep(1);
        if ((++sp & 255u) == 0u) { if (xb_ld(&bar[XB_TMO])) break; if (sp > XB_SPIN_CAP) { atomicAdd(&bar[XB_TMO], 1u); break; } }
    }
    nloc = mine > 0u ? mine : 1u; nx = cnt > 0u ? cnt : 1u;
}

__device__ __forceinline__ void xcd_barrier(const XcdBarrier& b) {
    asm volatile("s_waitcnt vmcnt(0)" ::: "memory");
    __syncthreads();
    if (threadIdx.x == 0) {
        unsigned* bar = b.bar;
        __builtin_amdgcn_s_waitcnt(0);
        unsigned nloc = b.st[0], nx = b.st[1];
        if (nloc == 0u) { xcd_barrier_complete(bar, b.x, nloc, nx); b.st[0] = nloc; b.st[1] = nx; }
        const unsigned old = xb_add(&bar[XB_XSUB(b.x)], 1u);
        const unsigned gen = old / nloc;
        if (old + 1u == (gen + 1u) * nloc) {
            __builtin_amdgcn_fence(__ATOMIC_RELEASE, "agent");
            asm volatile("s_waitcnt vmcnt(0)" ::: "memory");
            const unsigned og = xb_add(&bar[XB_TOP], 1u);
            const unsigned tg = og / nx;
            if (og + 1u == (tg + 1u) * nx) xb_add(&bar[XB_TOPGEN], 1u);
            else XB_SPIN(xb_ld(&bar[XB_TOPGEN]) == tg, bar);
            __builtin_amdgcn_fence(__ATOMIC_ACQUIRE, "agent");
            xb_add(&bar[XB_XGEN(b.x)], 1u);
            asm volatile("s_waitcnt vmcnt(0)" ::: "memory");
        } else {
            XB_SPIN(xb_ld(&bar[XB_XGEN(b.x)]) == gen, bar);
            __builtin_amdgcn_fence(__ATOMIC_ACQUIRE, "agent");
            asm volatile("s_waitcnt vmcnt(0)" ::: "memory");
        }
    }
    __syncthreads();
}

struct Frame {
    LAS unsigned char* lds;
    int wave, G, bid, gw, NGW;
    const float* const* in; float* out; unsigned char* ws;
};
#define WSP(T_, off) ((T_*)(F.ws + (off)))
__device__ __forceinline__ int lane_id_() { unsigned z = 0u; asm volatile("" : "+v"(z)); return (int)__builtin_amdgcn_mbcnt_hi(~0u, __builtin_amdgcn_mbcnt_lo(~0u, z)); }
#define LANE_ lane_id_()
#define TID_ (F.wave * 64 + lane_id_())

__device__ __forceinline__ void transpose_item(const float* W, int K, int N, bf16* WT, const float* kscale, LAS float* scr, int item, int nblk, int lane) {
    const int kb = item / nblk, nb = item % nblk, k0 = 64 * kb, n0 = 32 * nb;
#pragma unroll
    for (int i = 0; i < 8; ++i) { const int kk = 8 * i + (lane >> 3); const int n = n0 + 4 * (lane & 7);
        f32x4 v = n < N ? *(const f32x4*)(W + (size_t)(k0 + kk) * N + n) : (f32x4){0.f, 0.f, 0.f, 0.f}; if (kscale) v = v * kscale[k0 + kk];
        LAS float* d = scr + kk * 33 + 4 * (lane & 7); d[0] = v[0]; d[1] = v[1]; d[2] = v[2]; d[3] = v[3]; }
    asm volatile("s_waitcnt lgkmcnt(0)" ::: "memory");
    const int c = lane & 7;
#pragma unroll
    for (int j = 0; j < 4; ++j) { const int n = (lane >> 3) + 8 * j; const LAS float* s = scr + (8 * c) * 33 + n;
        u32x4 o; o.x = pk2(s[0 * 33], s[1 * 33]); o.y = pk2(s[2 * 33], s[3 * 33]); o.z = pk2(s[4 * 33], s[5 * 33]); o.w = pk2(s[6 * 33], s[7 * 33]);
        *(u32x4*)(WT + (size_t)(n0 + n) * K + k0 + 8 * c) = o; }
    asm volatile("s_waitcnt lgkmcnt(0)" ::: "memory");
}
__device__ __forceinline__ void rms_row_to_bf16(const float* xrow, const float* g, bf16* orow, int lane) {
    unsigned long long* o8 = (unsigned long long*)orow + lane;
    if (!xrow) {
#pragma unroll
        for (int j = 0; j < 4; ++j) o8[64 * j] = 0ull;
        return; }
    const f32x4* xr = (const f32x4*)xrow + lane; const f32x4* gr = (const f32x4*)g + lane;
    f32x4 v[4]; float s = 0.f;
#pragma unroll
    for (int j = 0; j < 4; ++j) { v[j] = xr[64 * j]; s += (v[j].x * v[j].x + v[j].y * v[j].y) + (v[j].z * v[j].z + v[j].w * v[j].w); }
    const float rs = rsqrtf(wave_sum(s) * (1.f / 1024.f) + EPS);
#pragma unroll
    for (int j = 0; j < 4; ++j) { const f32x4 gg = gr[64 * j]; const f32x4 y = v[j] * rs * gg;
        o8[64 * j] = (unsigned long long)pk2(y.x, y.y) | ((unsigned long long)pk2(y.z, y.w) << 32); }
}
__device__ __forceinline__ void p0_prologue(Frame& F) {
    LAS float* scr = (LAS float*)(F.lds + F.wave * 16384);
    const int gw = F.gw, NGW = F.NGW;
    constexpr int IT_IN = 16 * 208, IT_MEM = 16 * 32, IT_BR = 8 * 32, IT_O = 16 * 32, IT_UP = 16 * 176, IT_DOWN = 44 * 32, IT_W1 = 32 * 2, IT_W2 = 1 * 2;
    constexpr int NITEMS = IT_IN + IT_MEM + 3 * IT_BR + IT_O + IT_UP + IT_DOWN + 2 * IT_W1 + 2 * IT_W2;
    const int ipw = (NITEMS + NGW - 1) / NGW;
    for (int it = gw * ipw; it < NITEMS && it < (gw + 1) * ipw; ++it) {
        int r = it;
        if (r < IT_UP) { transpose_item(F.in[I_WUP], 1024, DUP, WSP(bf16, WS_WTUP), F.in[I_GFFN], scr, r, 176, LANE_); continue; } r -= IT_UP;
        if (r < IT_IN) { transpose_item(F.in[I_WIN], 1024, DIN, WSP(bf16, WS_WTIN), nullptr, scr, r, 208, LANE_); continue; } r -= IT_IN;
        if (r < IT_DOWN) { transpose_item(F.in[I_WDOWN], DFF, 1024, WSP(bf16, WS_WTDOWN), nullptr, scr, r, 32, LANE_); continue; } r -= IT_DOWN;
        if (r < IT_MEM) { transpose_item(F.in[I_WMEM], 1024, 1024, WSP(bf16, WS_WTMEM), nullptr, scr, r, 32, LANE_); continue; } r -= IT_MEM;
        if (r < IT_O) { transpose_item(F.in[I_WO], 1024, 1024, WSP(bf16, WS_WTO), nullptr, scr, r, 32, LANE_); continue; } r -= IT_O;
        if (r < IT_BR) { transpose_item(F.in[I_WNSA], 512, 1024, WSP(bf16, WS_WTNSA), nullptr, scr, r, 32, LANE_); continue; } r -= IT_BR;
        if (r < IT_BR) { transpose_item(F.in[I_WGLA], 512, 1024, WSP(bf16, WS_WTGLA), nullptr, scr, r, 32, LANE_); continue; } r -= IT_BR;
        if (r < IT_BR) { transpose_item(F.in[I_WX], 512, 1024, WSP(bf16, WS_WTX), nullptr, scr, r, 32, LANE_); continue; } r -= IT_BR;
        if (r < IT_W1) { transpose_item(F.in[I_CKW1], 2048, 64, WSP(bf16, WS_W1T), nullptr, scr, r, 2, LANE_); continue; } r -= IT_W1;
        if (r < IT_W1) { transpose_item(F.in[I_CVW1], 2048, 64, WSP(bf16, WS_W1T) + 64 * 2048, nullptr, scr, r, 2, LANE_); continue; } r -= IT_W1;
        if (r < IT_W2) { transpose_item(F.in[I_CKW2], 64, 64, WSP(bf16, WS_W2T), nullptr, scr, r, 2, LANE_); continue; } r -= IT_W2;
        transpose_item(F.in[I_CVW2], 64, 64, WSP(bf16, WS_W2T) + 64 * 64, nullptr, scr, r, 2, LANE_);
    }
    for (int m = gw; m < MPAD + 512; m += NGW) {
        if (m < MPAD) { const float* xr = m < NTOKP ? F.in[I_XP] + (size_t)m * 1024 : (m < NTOK ? F.in[I_XS] + (size_t)(m - NTOKP) * 1024 : nullptr);
            rms_row_to_bf16(xr, F.in[I_GMIX], WSP(bf16, WS_XN) + (size_t)m * 1024, LANE_); }
        else { const int mm = m - MPAD; rms_row_to_bf16(F.in[I_MEMP] + (size_t)mm * 1024, F.in[I_GMEM], WSP(bf16, WS_MN) + (size_t)mm * 1024, LANE_); }
    }
    { float* ssq = WSP(float, WS_SSQ); for (int i = F.bid * NTHR + TID_; i < MPAD; i += F.G * NTHR) ssq[i] = 0.f; }
    { float* ms = WSP(float, WS_MS); float* x1s = WSP(float, WS_X1S); const float* xs = F.in[I_XS];
      for (int i = F.bid * NTHR + TID_; i < SB * 1024; i += F.G * NTHR) { ms[i] = 0.f; x1s[i] = xs[i]; } }
    { const f32x4* src = (const f32x4*)F.in[I_CWIN]; f32x4* dst = (f32x4*)(F.out + O_WINS);
      for (int i = F.bid * NTHR + TID_; i < SB * 511 * 64; i += F.G * NTHR) { const int b = i / (511 * 64), r = i % (511 * 64); dst[(size_t)b * 512 * 64 + r] = src[(size_t)b * 512 * 64 + 64 + r]; } }
}

__device__ __forceinline__ void p2_token(Frame& F, int tok) {
    const int lane = LANE_; const bf16* pr = WSP(bf16, WS_PROJ) + (size_t)tok * DINP;
    const bool prompt = tok < NTOKP; const int b = tok >> 13, t = tok & (T - 1), sb = tok - NTOKP;
    float f[8];
    { unpack8(*(const u32x4*)(pr + C_Q + 8 * lane), f); float ss = 0.f;
#pragma unroll
      for (int i = 0; i < 8; ++i) ss += f[i] * f[i];
      ss += __shfl_xor(ss, 1); ss += __shfl_xor(ss, 2); ss += __shfl_xor(ss, 4);
      const float rs = rsqrtf(ss * (1.f / 64.f) + EPS) * QSCALE; const float* g = F.in[I_GNQ] + 8 * (lane & 7);
#pragma unroll
      for (int i = 0; i < 8; ++i) f[i] *= rs * g[i];
      *(u32x4*)(WSP(bf16, WS_QN) + (size_t)tok * 512 + 8 * lane) = pack8(f); }
    { unpack8(*(const u32x4*)(pr + C_KV + 8 * lane), f); float ss = 0.f;
#pragma unroll
      for (int i = 0; i < 8; ++i) ss += f[i] * f[i];
      ss += __shfl_xor(ss, 1); ss += __shfl_xor(ss, 2); ss += __shfl_xor(ss, 4);
      const int grp = lane >> 3, slot = grp >> 1, kv = grp & 1, d0 = 8 * (lane & 7);
      if (slot == 2) { const float rs = rsqrtf(ss * (1.f / 64.f) + EPS); const float* g = F.in[I_GNK] + 64 + d0;
#pragma unroll
          for (int i = 0; i < 8; ++i) f[i] *= rs * g[i]; }
      float* orow = prompt ? F.out + O_KVP + (size_t)tok * 512 + 8 * lane : F.out + O_KVS + (size_t)sb * 512 + 8 * lane;
      *(f32x4*)orow = (f32x4){f[0], f[1], f[2], f[3]}; *(f32x4*)(orow + 4) = (f32x4){f[4], f[5], f[6], f[7]};
      if (prompt) {
          if (slot == 2) *(u32x4*)(WSP(bf16, WS_KSEL) + ((size_t)(b * 2 + kv) * T + t) * 64 + d0) = pack8(f);
          if (slot == 3) { bf16* vt = WSP(bf16, WS_VSELT) + (((size_t)(b * 2 + kv) * 128 + (t >> 6)) * 64 + d0) * 64 + (t & 63);
#pragma unroll
              for (int i = 0; i < 8; ++i) vt[i * 64] = (bf16)f2bf(f[i]); }
      } else if (slot >= 2) { float* nk = WSP(float, WS_NEWKV) + ((size_t)(sb * 4 + (slot - 2)) * 2 + kv) * 64 + d0;
#pragma unroll
          for (int i = 0; i < 8; ++i) nk[i] = f[i]; }
    }
    { unpack8(*(const u32x4*)(pr + C_KV + 512 + 8 * lane), f); float ss = 0.f;
#pragma unroll
      for (int i = 0; i < 8; ++i) ss += f[i] * f[i];
      ss += __shfl_xor(ss, 1); ss += __shfl_xor(ss, 2); ss += __shfl_xor(ss, 4);
      const int grp = lane >> 3, slot = 4 + (grp >> 1), kv = grp & 1, d0 = 8 * (lane & 7);
      if (lane < 32) {
          if (slot == 4) { const float rs = rsqrtf(ss * (1.f / 64.f) + EPS); const float* g = F.in[I_GNK] + 128 + d0;
#pragma unroll
              for (int i = 0; i < 8; ++i) f[i] *= rs * g[i]; }
          if (prompt) {
              if (slot == 4) *(u32x4*)(WSP(bf16, WS_KWIN) + ((size_t)(b * 2 + kv) * T + t) * 64 + d0) = pack8(f);
              else { bf16* vt = WSP(bf16, WS_VWINT) + (((size_t)(b * 2 + kv) * 128 + (t >> 6)) * 64 + d0) * 64 + (t & 63);
#pragma unroll
                  for (int i = 0; i < 8; ++i) vt[i * 64] = (bf16)f2bf(f[i]); }
              if (t >= T - 512) { float* orow = F.out + O_WINP + ((size_t)b * 512 + (t - (T - 512))) * 256 + 8 * lane;
                  *(f32x4*)orow = (f32x4){f[0], f[1], f[2], f[3]}; *(f32x4*)(orow + 4) = (f32x4){f[4], f[5], f[6], f[7]}; }
          } else {
              float* nk = WSP(float, WS_NEWKV) + ((size_t)(sb * 4 + (slot - 2)) * 2 + kv) * 64 + d0;
#pragma unroll
              for (int i = 0; i < 8; ++i) nk[i] = f[i];
              float* orow = F.out + O_WINS + ((size_t)sb * 512 + 511) * 256 + 8 * lane;
              *(f32x4*)orow = (f32x4){f[0], f[1], f[2], f[3]}; *(f32x4*)(orow + 4) = (f32x4){f[4], f[5], f[6], f[7]};
          }
      }
    }
    if (lane < 24) WSP(float, WS_GATES)[(size_t)tok * 24 + lane] = sigmoidf_(bf2f(pr[C_G + lane]));
    { unpack8(*(const u32x4*)(pr + C_XQ + 8 * lane), f); float ss = 0.f;
#pragma unroll
      for (int i = 0; i < 8; ++i) ss += f[i] * f[i];
      ss += __shfl_xor(ss, 1); ss += __shfl_xor(ss, 2); ss += __shfl_xor(ss, 4); ss += __shfl_xor(ss, 8);
      const float rs = rsqrtf(ss * (1.f / 128.f) + EPS) * XSCALE; const float* g = F.in[I_GXQ] + 8 * (lane & 15);
#pragma unroll
      for (int i = 0; i < 8; ++i) f[i] *= rs * g[i];
      *(u32x4*)(WSP(bf16, WS_XQ) + (size_t)tok * 512 + 8 * lane) = pack8(f); }
}
__device__ __forceinline__ void p2_memrow(Frame& F, int row) {
    const int lane = LANE_, b = row >> 8, m = row & 255, head = lane >> 4, d0 = 8 * (lane & 15);
    const bf16* pr = WSP(bf16, WS_MEMPROJ) + (size_t)row * 1024; float f[8];
    { unpack8(*(const u32x4*)(pr + 8 * lane), f); float ss = 0.f;
#pragma unroll
      for (int i = 0; i < 8; ++i) ss += f[i] * f[i];
      ss += __shfl_xor(ss, 1); ss += __shfl_xor(ss, 2); ss += __shfl_xor(ss, 4); ss += __shfl_xor(ss, 8);
      const float rs = rsqrtf(ss * (1.f / 128.f) + EPS); const float* g = F.in[I_GXK] + d0;
#pragma unroll
      for (int i = 0; i < 8; ++i) f[i] *= rs * g[i];
      float* orow = F.out + O_MEMP + ((size_t)row * 2 + 0) * 512 + 8 * lane;
      *(f32x4*)orow = (f32x4){f[0], f[1], f[2], f[3]}; *(f32x4*)(orow + 4) = (f32x4){f[4], f[5], f[6], f[7]};
      *(u32x4*)(WSP(bf16, WS_KMEM) + ((size_t)(b * 4 + head) * 256 + m) * 128 + d0) = pack8(f); }
    { unpack8(*(const u32x4*)(pr + 512 + 8 * lane), f);
      float* orow = F.out + O_MEMP + ((size_t)row * 2 + 1) * 512 + 8 * lane;
      *(f32x4*)orow = (f32x4){f[0], f[1], f[2], f[3]}; *(f32x4*)(orow + 4) = (f32x4){f[4], f[5], f[6], f[7]};
      bf16* vt = WSP(bf16, WS_VMEMT) + ((size_t)(b * 4 + head) * 128 + d0) * 256 + m;
#pragma unroll
      for (int i = 0; i < 8; ++i) vt[i * 256] = (bf16)f2bf(f[i]); }
}

constexpr int CMP_TASKS_S = SB * 2 * 2, CMP_TASKS_P = NB * 2 * 2;
__device__ __forceinline__ int cmp_tile_off16(int row, int c16) { return row * 128 + ((c16 ^ (row & 7)) << 4); }
__device__ __forceinline__ void p2_compress(Frame& F, int task) {
    const int lane = LANE_, r = lane & 15, q = lane >> 4, w = F.wave, tid_ = w * 64 + lane;
    const bool smp = task < CMP_TASKS_S; const int x = smp ? task : task - CMP_TASKS_S;
    const int b = x >> 2, kv = (x >> 1) & 1, slot = x & 1, i0 = 64 * w;
    const bf16* W1t = WSP(bf16, WS_W1T) + (size_t)slot * 64 * 2048;
    const bf16* W2t = WSP(bf16, WS_W2T) + (size_t)slot * 64 * 64;
    const int* pt = (const int*)F.in[I_PT] + b * 64;
    const float* ckv = F.in[I_CKV]; const float* pe = F.in[slot ? I_CVPE : I_CKPE];
    const bf16* proj = WSP(bf16, WS_PROJ);
    LAS unsigned char* wb = F.lds;
    const int srow = tid_ >> 3, sc16 = tid_ & 7, soff = cmp_tile_off16(srow, sc16);
    int kb0[2]; kb0[0] = r * 128 + (((0 + q) ^ (r & 7)) << 4); kb0[1] = r * 128 + (((4 + q) ^ (r & 7)) << 4);
    f32x4 acc[4][4];
#pragma unroll
    for (int nt = 0; nt < 4; ++nt)
#pragma unroll
        for (int it = 0; it < 4; ++it) acc[nt][it] = (f32x4){0.f, 0.f, 0.f, 0.f};
    int pg0[4], pg1[4];
#pragma unroll
    for (int it = 0; it < 4; ++it) { const int pb = (16 * (i0 + 16 * it + r)) >> 7; pg0[it] = smp ? pt[pb] : 0; pg1[it] = smp ? pt[pb < 63 ? pb + 1 : 63] : 0; }
    const bf16* wsrc = W1t + (size_t)srow * 2048 + sc16 * 8;
    u32x4 rw = *(const u32x4*)wsrc;
    u32x4 xr[2][4][2];
#define CMP_LOAD_ROWS(KP) do { _Pragma("unroll") for (int it = 0; it < 4; ++it) { int tok = 16 * (i0 + 16 * it + r) + (KP); tok = tok < T ? tok : T - 1; \
        _Pragma("unroll") for (int ks2 = 0; ks2 < 2; ++ks2) { const int d = 32 * ks2 + 8 * q; \
            if (smp) { const int page = (tok >> 7) == ((16 * (i0 + 16 * it + r)) >> 7) ? pg0[it] : pg1[it]; \
                const float* src = ckv + (((size_t)page * 128 + (tok & 127)) * 4 + slot) * 128 + kv * 64 + d; xr[ks2][it][0] = *(const u32x4*)src; xr[ks2][it][1] = *(const u32x4*)(src + 4); } \
            else xr[ks2][it][0] = *(const u32x4*)(proj + ((size_t)b * T + tok) * DINP + C_KV + slot * 128 + kv * 64 + d); } } } while (0)
    CMP_LOAD_ROWS(0);
    __syncthreads();
#pragma unroll 1
    for (int kp = 0; kp < 32; ++kp) {
        bf16x8 xf[2][4];
#pragma unroll
        for (int it = 0; it < 4; ++it)
#pragma unroll
            for (int ks2 = 0; ks2 < 2; ++ks2) { const int d = 32 * ks2 + 8 * q; f32x4 a0, a1;
                if (smp) { a0 = __builtin_bit_cast(f32x4, xr[ks2][it][0]); a1 = __builtin_bit_cast(f32x4, xr[ks2][it][1]); }
                else { float f8[8]; unpack8(xr[ks2][it][0], f8); a0 = (f32x4){f8[0], f8[1], f8[2], f8[3]}; a1 = (f32x4){f8[4], f8[5], f8[6], f8[7]}; }
                const f32x4 p0 = *(const f32x4*)(pe + 64 * kp + d), p1 = *(const f32x4*)(pe + 64 * kp + d + 4);
                xf[ks2][it] = frag_pk(a0 + p0, a1 + p1); }
        if (kp + 1 < 32) CMP_LOAD_ROWS(kp + 1);
        *(LAS u32x4*)(wb + (kp & 1) * 8192 + soff) = rw;
        __syncthreads();
        if (kp + 1 < 32) rw = *(const u32x4*)(wsrc + 64 * (kp + 1));
        LAS const unsigned char* wt = wb + (kp & 1) * 8192;
#pragma unroll
        for (int ks2 = 0; ks2 < 2; ++ks2)
#pragma unroll
            for (int nt = 0; nt < 4; ++nt) { const bf16x8 a = as_frag(*(LAS const u32x4*)(wt + kb0[ks2] + nt * 2048));
#pragma unroll
                for (int it = 0; it < 4; ++it) acc[nt][it] = MFMA16(a, xf[ks2][it], acc[nt][it]); }
    }
#undef CMP_LOAD_ROWS
    const float* gk0 = F.in[I_GNK];
#pragma unroll
    for (int it = 0; it < 4; ++it) {
        f32x4 g[4];
#pragma unroll
        for (int nt = 0; nt < 4; ++nt)
#pragma unroll
            for (int i = 0; i < 4; ++i) g[nt][i] = gelu_tanh(acc[nt][it][i]);
        const bf16x8 b0 = frag_pk(g[0], g[1]), b1 = frag_pk(g[2], g[3]);
        f32x4 o[4]; float ss = 0.f;
#pragma unroll
        for (int mt = 0; mt < 4; ++mt) { const bf16* wr = W2t + (size_t)(16 * mt + r) * 64 + 4 * q;
            o[mt] = MFMA16(ldfrag2(wr, wr + 16), b0, ((f32x4){0.f, 0.f, 0.f, 0.f}));
            o[mt] = MFMA16(ldfrag2(wr + 32, wr + 48), b1, o[mt]);
            ss += (o[mt][0] * o[mt][0] + o[mt][1] * o[mt][1]) + (o[mt][2] * o[mt][2] + o[mt][3] * o[mt][3]); }
        ss += __shfl_xor(ss, 16); ss += __shfl_xor(ss, 32);
        if (slot == 0) { const float rs = rsqrtf(ss * (1.f / 64.f) + EPS);
#pragma unroll
            for (int mt = 0; mt < 4; ++mt) { const f32x4 gg = *(const f32x4*)(gk0 + 16 * mt + 4 * q); o[mt] = o[mt] * rs * gg; } }
        const int i = i0 + 16 * it + r;
        if (smp) { float* dst = WSP(float, slot ? WS_VCMPS : WS_KCMPS) + ((size_t)(b * 2 + kv) * 512 + i) * 64 + 4 * q;
#pragma unroll
            for (int mt = 0; mt < 4; ++mt) *(f32x4*)(dst + 16 * mt) = o[mt]; }
        else if (slot == 0) { bf16* dst = WSP(bf16, WS_KCMP) + ((size_t)(b * 2 + kv) * 512 + i) * 64 + 4 * q;
#pragma unroll
            for (int mt = 0; mt < 4; ++mt) { u32x2 wv; wv.x = pk2(o[mt][0], o[mt][1]); wv.y = pk2(o[mt][2], o[mt][3]); *(u32x2*)(dst + 16 * mt) = wv; } }
        else { bf16* dst = WSP(bf16, WS_VCMPT) + ((size_t)(b * 2 + kv) * 64 + 4 * q) * 512 + i;
#pragma unroll
            for (int mt = 0; mt < 4; ++mt)
#pragma unroll
                for (int e = 0; e < 4; ++e) dst[(size_t)(16 * mt + e) * 512] = (bf16)f2bf(o[mt][e]); }
    }
}

__device__ __forceinline__ int swz64(int row, int col) { return row * 64 + ((((col >> 3) ^ (row & 7)) << 3) | (col & 7)); }
__device__ __forceinline__ float log_sigmoid_(float z) { return fminf(z, 0.f) - __logf(1.0f + __expf(-fabsf(z))); }
__device__ __forceinline__ void p2_gla_chunk(Frame& F, int bc) {
    const int lane = LANE_, r = lane & 15, q = lane >> 4, h = F.wave >> 1, eh = F.wave & 1;
    LAS bf16* ktT = (LAS bf16*)(F.lds + F.wave * 16384);
    LAS bf16* vT = ktT + 4096;
    const bf16* proj = WSP(bf16, WS_PROJ) + (size_t)bc * 64 * DINP;
    float wg[16];
#pragma unroll
    for (int j = 0; j < 16; ++j) wg[j] = F.in[I_WGG][j * 256 + h * 64 + lane];
    const float bg = F.in[I_BGG][h * 64 + lane];
    bf16* qtg = WSP(bf16, WS_QTG) + (size_t)bc * 64 * 256 + h * 64 + lane;
    bf16* ktg = WSP(bf16, WS_KTG) + (size_t)bc * 64 * 256 + h * 64 + lane;
    bf16* vtg = WSP(bf16, WS_VTG) + ((size_t)(bc * 4 + h) * 128 + eh * 64 + lane) * 64;
    LAS float* lrs = (LAS float*)(F.lds + RING_BYTES);
    { const int tid_ = F.wave * 64 + lane; if (tid_ < 128) { float f8[8]; unpack8(*(const u32x4*)(proj + (size_t)(tid_ >> 1) * DINP + C_LR + 8 * (tid_ & 1)), f8);
#pragma unroll
        for (int i = 0; i < 8; ++i) lrs[(tid_ >> 1) * 16 + 8 * (tid_ & 1) + i] = f8[i]; } }
    __syncthreads();
    float cb = 0.f;
    bf16 kr[16], qr[16], vr[16], kn[16], qn[16], vn[16];
#pragma unroll
    for (int i = 0; i < 16; ++i) { const bf16* pr = proj + (size_t)i * DINP; kr[i] = pr[C_GK + h * 64 + lane]; qr[i] = pr[C_GQ + h * 64 + lane]; vr[i] = pr[C_GV + h * 128 + eh * 64 + lane]; }
#pragma unroll 1
    for (int tb = 0; tb < 4; ++tb) {
        const int tn = tb < 3 ? tb + 1 : 3;
#pragma unroll
        for (int i = 0; i < 16; ++i) { const bf16* pr = proj + (size_t)(16 * tn + i) * DINP; kn[i] = pr[C_GK + h * 64 + lane]; qn[i] = pr[C_GQ + h * 64 + lane]; vn[i] = pr[C_GV + h * 128 + eh * 64 + lane]; }
#pragma unroll
        for (int i = 0; i < 16; ++i) { const int t = 16 * tb + i;
            float z = bg;
#pragma unroll
            for (int j4 = 0; j4 < 4; ++j4) { const f32x4 l4 = *(LAS const f32x4*)(lrs + t * 16 + 4 * j4); z += l4[0] * wg[4 * j4] + l4[1] * wg[4 * j4 + 1] + l4[2] * wg[4 * j4 + 2] + l4[3] * wg[4 * j4 + 3]; }
            cb += log_sigmoid_(z) * 0.0625f;
            const float kk = bf2f(kr[i]) * __expf(-cb);
            const float qq = bf2f(qr[i]) * 0.125f * __expf(cb);
            const bf16 kb = (bf16)f2bf(kk);
            if (eh == 0) { qtg[(size_t)t * 256] = (bf16)f2bf(qq); ktg[(size_t)t * 256] = kb; }
            ktT[swz64(lane, t)] = kb;
            const bf16 vv = vr[i];
            vT[swz64(lane, t)] = vv; vtg[t] = vv; }
#pragma unroll
        for (int i = 0; i < 16; ++i) { kr[i] = kn[i]; qr[i] = qn[i]; vr[i] = vn[i]; }
    }
    const float dec = __expf(cb);
    if (eh == 0) WSP(float, WS_DEC)[(size_t)(bc * 4 + h) * 64 + lane] = dec;
    asm volatile("s_waitcnt lgkmcnt(0)" ::: "memory");
    f32x4 acc[4][4];
#pragma unroll
    for (int et = 0; et < 4; ++et)
#pragma unroll
        for (int dt = 0; dt < 4; ++dt) acc[et][dt] = (f32x4){0.f, 0.f, 0.f, 0.f};
#pragma unroll
    for (int ks = 0; ks < 2; ++ks) {
        bf16x8 bfr[4];
#pragma unroll
        for (int dt = 0; dt < 4; ++dt) bfr[dt] = as_frag(*(const LAS u32x4*)(ktT + swz64(16 * dt + r, 32 * ks + 8 * q)));
#pragma unroll
        for (int et = 0; et < 4; ++et) { const bf16x8 a = as_frag(*(const LAS u32x4*)(vT + swz64(16 * et + r, 32 * ks + 8 * q)));
#pragma unroll
            for (int dt = 0; dt < 4; ++dt) acc[et][dt] = MFMA16(a, bfr[dt], acc[et][dt]); }
    }
    float* up = WSP(float, WS_UP) + ((size_t)(bc * 4 + h) * 128 + eh * 64) * 64;
#pragma unroll
    for (int dt = 0; dt < 4; ++dt) { const float dd = __shfl(dec, 16 * dt + r);
#pragma unroll
        for (int et = 0; et < 4; ++et)
#pragma unroll
            for (int i = 0; i < 4; ++i) up[(size_t)(16 * et + 4 * q + i) * 64 + 16 * dt + r] = acc[et][dt][i] * dd; }
}

__device__ __forceinline__ void p2_gla_sample(Frame& F, int task) {
    const int lane = LANE_, b = task >> 2, h = task & 3, tok = NTOKP + b;
    const bf16* pr = WSP(bf16, WS_PROJ) + (size_t)tok * DINP;
    LAS float* sh = (LAS float*)(F.lds + F.wave * 16384);
    { float z = F.in[I_BGG][h * 64 + lane];
#pragma unroll
      for (int j = 0; j < 16; ++j) z += bf2f(pr[C_LR + j]) * F.in[I_WGG][j * 256 + h * 64 + lane];
      sh[lane] = __expf(log_sigmoid_(z) * 0.0625f); sh[64 + lane] = bf2f(pr[C_GK + h * 64 + lane]); sh[128 + lane] = bf2f(pr[C_GQ + h * 64 + lane]) * 0.125f; }
    asm volatile("s_waitcnt lgkmcnt(0)" ::: "memory");
    const float v0 = bf2f(pr[C_GV + h * 128 + lane]), v1 = bf2f(pr[C_GV + h * 128 + 64 + lane]);
    const float* s0 = F.in[I_SGLA] + (size_t)(b * 4 + h) * 64 * 128; float* s1 = F.out + O_GLAS + (size_t)(b * 4 + h) * 64 * 128;
    float o0 = 0.f, o1 = 0.f;
#pragma unroll 4
    for (int d = 0; d < 64; ++d) { const float a = sh[d], k = sh[64 + d], qq = sh[128 + d];
        const float n0 = a * s0[d * 128 + lane] + k * v0, n1 = a * s0[d * 128 + 64 + lane] + k * v1;
        s1[d * 128 + lane] = n0; s1[d * 128 + 64 + lane] = n1; o0 += qq * n0; o1 += qq * n1; }
    const float rs = rsqrtf(wave_sum(o0 * o0 + o1 * o1) * (1.f / 128.f) + EPS);
    const float r0 = bf2f(pr[C_GR + h * 128 + lane]), r1 = bf2f(pr[C_GR + h * 128 + 64 + lane]);
    bf16* og = WSP(bf16, WS_OGLA) + (size_t)tok * 512 + h * 128;
    og[lane] = (bf16)f2bf(o0 * rs * F.in[I_GGO][lane] * r0 * sigmoidf_(r0));
    og[64 + lane] = (bf16)f2bf(o1 * rs * F.in[I_GGO][64 + lane] * r1 * sigmoidf_(r1));
}

__device__ __forceinline__ void p3_gla_scan(Frame& F, int task) {
    const int lane = LANE_, b = task >> 9, h = (task >> 7) & 3, e = task & 127;
    const float* up = WSP(float, WS_UP); const float* dec = WSP(float, WS_DEC); bf16* sc = WSP(bf16, WS_SC);
    float S = 0.f;
#pragma unroll 8
    for (int c = 0; c < 128; ++c) { const int bc = b * 128 + c; const size_t idx = ((size_t)(bc * 4 + h) * 128 + e) * 64 + lane;
        sc[idx] = (bf16)f2bf(S); S = dec[(size_t)(bc * 4 + h) * 64 + lane] * S + up[idx]; }
    F.out[O_GLAP + ((size_t)(b * 4 + h) * 64 + lane) * 128 + e] = S;
}

__device__ __forceinline__ void p4_gla_out(Frame& F, int task) {
    const int lane = LANE_, r = lane & 15, q = lane >> 4, bc = task >> 4, h = (task >> 2) & 3, tt = task & 3;
    const bf16* qtg = WSP(bf16, WS_QTG) + (size_t)bc * 64 * 256 + h * 64;
    const bf16* ktg = WSP(bf16, WS_KTG) + (size_t)bc * 64 * 256 + h * 64;
    const bf16* vtg = WSP(bf16, WS_VTG) + (size_t)(bc * 4 + h) * 128 * 64;
    const bf16* sc = WSP(bf16, WS_SC) + (size_t)(bc * 4 + h) * 128 * 64;
    const bf16* proj = WSP(bf16, WS_PROJ) + (size_t)bc * 64 * DINP;
    bf16* og = WSP(bf16, WS_OGLA) + (size_t)bc * 64 * 512 + h * 128;
    const float* ggo = F.in[I_GGO];
    {
        bf16x8 qf[2];
#pragma unroll
        for (int ks = 0; ks < 2; ++ks) qf[ks] = ldfrag(qtg + (size_t)(16 * tt + r) * 256 + 32 * ks + 8 * q);
        f32x4 sT[4];
#pragma unroll
        for (int st = 0; st < 4; ++st) { sT[st] = (f32x4){0.f, 0.f, 0.f, 0.f};
            if (st <= tt) {
#pragma unroll
                for (int ks = 0; ks < 2; ++ks) sT[st] = MFMA16(ldfrag(ktg + (size_t)(16 * st + r) * 256 + 32 * ks + 8 * q), qf[ks], sT[st]);
                if (st == tt) {
#pragma unroll
                    for (int i = 0; i < 4; ++i) if (4 * q + i > r) sT[st][i] = 0.f; } } }
        const bf16x8 p01 = frag_pk(sT[0], sT[1]), p23 = frag_pk(sT[2], sT[3]);
        f32x4 acc[8]; float ss = 0.f;
#pragma unroll
        for (int et = 0; et < 8; ++et) { acc[et] = (f32x4){0.f, 0.f, 0.f, 0.f};
            const bf16* srow = sc + (size_t)(16 * et + r) * 64 + 8 * q;
            acc[et] = MFMA16(ldfrag(srow), qf[0], acc[et]); acc[et] = MFMA16(ldfrag(srow + 32), qf[1], acc[et]);
            const bf16* vrow = vtg + (size_t)(16 * et + r) * 64 + 4 * q;
            acc[et] = MFMA16(ldfrag2(vrow, vrow + 16), p01, acc[et]);
            if (tt >= 2) acc[et] = MFMA16(ldfrag2(vrow + 32, vrow + 48), p23, acc[et]);
            ss += (acc[et][0] * acc[et][0] + acc[et][1] * acc[et][1]) + (acc[et][2] * acc[et][2] + acc[et][3] * acc[et][3]); }
        ss += __shfl_xor(ss, 16); ss += __shfl_xor(ss, 32);
        const float rs = rsqrtf(ss * (1.f / 128.f) + EPS);
        const bf16* pr = proj + (size_t)(16 * tt + r) * DINP + C_GR + h * 128 + 4 * q;
        bf16* orow = og + (size_t)(16 * tt + r) * 512 + 4 * q;
#pragma unroll
        for (int et = 0; et < 8; ++et) { const u32x2 rw = *(const u32x2*)(pr + 16 * et); const f32x4 gg = *(const f32x4*)(ggo + 16 * et + 4 * q);
            const float r0 = bflo(rw.x), r1 = bfhi(rw.x), r2 = bflo(rw.y), r3 = bfhi(rw.y);
            u32x2 w; w.x = pk2(acc[et][0] * rs * gg[0] * r0 * sigmoidf_(r0), acc[et][1] * rs * gg[1] * r1 * sigmoidf_(r1));
            w.y = pk2(acc[et][2] * rs * gg[2] * r2 * sigmoidf_(r2), acc[et][3] * rs * gg[3] * r3 * sigmoidf_(r3));
            *(u32x2*)(orow + 16 * et) = w; }
    }
}

__device__ __forceinline__ void p3_xatt(Frame& F, int n, float mb) {
    const int lane = LANE_, r = lane & 15, q = lane >> 4, w = F.wave, tid_ = w * 64 + lane;
    const int b = n >> 7, h = (n >> 5) & 3, chunk = n & 31;
    const bf16* km = WSP(bf16, WS_KMEM) + (size_t)(b * 4 + h) * 256 * 128;
    const bf16* vm = WSP(bf16, WS_VMEMT) + (size_t)(b * 4 + h) * 128 * 256;
    LAS unsigned char* kl = F.lds; LAS unsigned char* vl = F.lds + 65536;
    __syncthreads();
    { u32x4 gk[8], gv[8];
#pragma unroll
      for (int i = 0; i < 8; ++i) { gk[i] = *(const u32x4*)(km + (size_t)(i * 512 + tid_) * 8); gv[i] = *(const u32x4*)(vm + (size_t)(i * 512 + tid_) * 8); }
#pragma unroll
      for (int i = 0; i < 8; ++i) { const int id = i * 512 + tid_;
          *(LAS u32x4*)(kl + (id >> 4) * 256 + ((((id & 15) ^ ((id >> 4) & 15))) << 4)) = gk[i];
          *(LAS u32x4*)(vl + (id >> 5) * 512 + ((((id & 31) ^ ((id >> 5) & 15))) << 4)) = gv[i]; } }
    __syncthreads();
    int kb4[4];
#pragma unroll
    for (int ks = 0; ks < 4; ++ks) kb4[ks] = r * 256 + (((4 * ks + q) ^ r) << 4);
#pragma unroll 1
    for (int tile = 0; tile < 2; ++tile) {
        const int tok0 = b * T + chunk * 256 + w * 32 + tile * 16;
        const bf16* xq = WSP(bf16, WS_XQ) + (size_t)(tok0 + r) * 512 + h * 128 + 8 * q;
        bf16x8 qf[4];
#pragma unroll
        for (int ks = 0; ks < 4; ++ks) qf[ks] = ldfrag(xq + 32 * ks);
        f32x4 o[8]; float l = 0.f;
#pragma unroll
        for (int dt = 0; dt < 8; ++dt) o[dt] = (f32x4){0.f, 0.f, 0.f, 0.f};
#pragma unroll 2
        for (int kk = 0; kk < 8; ++kk) {
            f32x4 p[2];
#pragma unroll
            for (int a = 0; a < 2; ++a) { p[a] = (f32x4){0.f, 0.f, 0.f, 0.f};
#pragma unroll
                for (int ks = 0; ks < 4; ++ks) p[a] = MFMA16(as_frag(*(LAS const u32x4*)(kl + kb4[ks] + (2 * kk + a) * 4096)), qf[ks], p[a]);
#pragma unroll
                for (int i = 0; i < 4; ++i) { p[a][i] = __builtin_amdgcn_exp2f(p[a][i] - mb); l += p[a][i]; } }
            const bf16x8 pf = frag_pk(p[0], p[1]);
            const int v0 = r * 512 + (((4 * kk + (q >> 1)) ^ r) << 4) + 8 * (q & 1), v1 = r * 512 + (((4 * kk + 2 + (q >> 1)) ^ r) << 4) + 8 * (q & 1);
#pragma unroll
            for (int dt = 0; dt < 8; ++dt) { const u32x2 x0 = *(LAS const u32x2*)(vl + v0 + dt * 8192), x1 = *(LAS const u32x2*)(vl + v1 + dt * 8192);
                u32x4 wv; wv.x = x0.x; wv.y = x0.y; wv.z = x1.x; wv.w = x1.y; o[dt] = MFMA16(as_frag(wv), pf, o[dt]); }
        }
        l += __shfl_xor(l, 16); l += __shfl_xor(l, 32);
        const float inv = 1.f / l;
        bf16* ox = WSP(bf16, WS_OX) + (size_t)(tok0 + r) * 512 + h * 128 + 4 * q;
#pragma unroll
        for (int dt = 0; dt < 8; ++dt) { u32x2 wv; wv.x = pk2(o[dt][0] * inv, o[dt][1] * inv); wv.y = pk2(o[dt][2] * inv, o[dt][3] * inv); *(u32x2*)(ox + 16 * dt) = wv; }
    }
}
__device__ __forceinline__ void p3_xatt_sample(Frame& F, int task) {
    const int lane = LANE_, b = task >> 2, h = task & 3, tok = NTOKP + b;
    LAS float* sh = (LAS float*)(F.lds + F.wave * 16384);
    const bf16* xq = WSP(bf16, WS_XQ) + (size_t)tok * 512 + h * 128;
    sh[lane] = bf2f(xq[lane]); sh[64 + lane] = bf2f(xq[64 + lane]);
    asm volatile("s_waitcnt lgkmcnt(0)" ::: "memory");
    const float* cm = F.in[I_CMEM] + (size_t)b * 256 * 1024 + h * 128;
    float s[4] = {0.f, 0.f, 0.f, 0.f};
    for (int d = 0; d < 128; d += 4) { const f32x4 qv = *(const LAS f32x4*)(sh + d);
#pragma unroll
        for (int k = 0; k < 4; ++k) { const f32x4 kv = *(const f32x4*)(cm + (size_t)(lane + 64 * k) * 1024 + d); s[k] += (qv[0] * kv[0] + qv[1] * kv[1]) + (qv[2] * kv[2] + qv[3] * kv[3]); } }
    const float m = wave_max(fmaxf(fmaxf(s[0], s[1]), fmaxf(s[2], s[3])));
    float l = 0.f;
#pragma unroll
    for (int k = 0; k < 4; ++k) { const float e = __builtin_amdgcn_exp2f(s[k] - m); sh[128 + lane + 64 * k] = e; l += e; }
    l = wave_sum(l);
    asm volatile("s_waitcnt lgkmcnt(0)" ::: "memory");
    float o0 = 0.f, o1 = 0.f; const float* vv = cm + 512;
#pragma unroll 4
    for (int mm = 0; mm < 256; ++mm) { const float p = sh[128 + mm]; o0 += p * vv[(size_t)mm * 1024 + lane]; o1 += p * vv[(size_t)mm * 1024 + 64 + lane]; }
    const float inv = 1.f / l;
    bf16* ox = WSP(bf16, WS_OX) + (size_t)tok * 512 + h * 128;
    ox[lane] = (bf16)f2bf(o0 * inv); ox[64 + lane] = (bf16)f2bf(o1 * inv);
}

constexpr int NL_Q = 0;
constexpr int NL_U = 16384;
constexpr int NL_OS = 81920;
constexpr int NL_TB = 16384;
constexpr int NL_SEL = 147456;
constexpr int NL_BT = 147968;
constexpr int NL_LINV = 152096;
constexpr int NL_END = 152608;
static_assert(NL_END <= LDS_BYTES, "NSA LDS map");

__device__ __forceinline__ void nsa_tables(Frame& F) {
    LAS float* bt = (LAS float*)(F.lds + NL_BT);
    for (int i = TID_; i < 129 * 8; i += NTHR) bt[i] = F.in[I_RB][t5_bucket(i >> 3) * 8 + (i & 7)] * LOG2E;
    __syncthreads();
}
__device__ __forceinline__ float nsa_bound(Frame& F) {
    const float gq = absmax_arr(F.in[I_GNQ], 64, LANE_), gk = absmax_arr(F.in[I_GNK], 192, LANE_), bm = absmax_arr(F.in[I_RB], 256, LANE_);
    return (8.0f * gq * gk * 1.02f + bm) * LOG2E;
}
__device__ __forceinline__ unsigned fkey(float x) { const unsigned u = __float_as_uint(x); return (u & 0x80000000u) ? ~u : (u | 0x80000000u); }

__device__ __forceinline__ int tile_off16(int row, int c16) { return row * 128 + ((c16 ^ (row & 7)) << 4); }
struct TileAddr { int kb[2]; int vb[2][2]; };
__device__ __forceinline__ TileAddr tile_addr(int r, int q) { TileAddr a;
    for (int ks = 0; ks < 2; ++ks) a.kb[ks] = r * 128 + (((4 * ks + q) ^ (r & 7)) << 4);
    for (int s = 0; s < 2; ++s) for (int pc = 0; pc < 2; ++pc) a.vb[s][pc] = r * 128 + (((4 * s + 2 * pc + (q >> 1)) ^ (r & 7)) << 4) + 8 * (q & 1);
    return a; }
__device__ __forceinline__ bf16x8 tile_kfrag(LAS const unsigned char* kb, const TileAddr& ta, int kt, int ks) { return as_frag(*(LAS const u32x4*)(kb + ta.kb[ks] + kt * 2048)); }
__device__ __forceinline__ bf16x8 tile_vfrag(LAS const unsigned char* vb, const TileAddr& ta, int dt, int s) {
    const u32x2 a = *(LAS const u32x2*)(vb + ta.vb[s][0] + dt * 2048), b = *(LAS const u32x2*)(vb + ta.vb[s][1] + dt * 2048);
    u32x4 w; w.x = a.x; w.y = a.y; w.z = b.x; w.w = b.y; return as_frag(w); }

#define OPAQUE_V(x) asm volatile("" : "+v"(x))
__device__ __forceinline__ void p3_nsa_prompt(Frame& F, int n, float mb, int dbg) {
    int lane0 = LANE_; OPAQUE_V(lane0);
    const int lane = lane0, r = lane & 15, q = lane >> 4, w = F.wave;
    const int combo = n >> 8, idx = n & 255, ti = (combo & 1) ? 255 - idx : idx;
    const int b = combo >> 1, kv = combo & 1, t0 = 32 * ti, bk = b * 2 + kv;
    LAS bf16* Qs = (LAS bf16*)(F.lds + NL_Q); LAS float* U = (LAS float*)(F.lds + NL_U) + w * 2048; LAS unsigned* selm = (LAS unsigned*)(F.lds + NL_SEL);
    LAS const float* bt = (LAS const float*)(F.lds + NL_BT); LAS float* linv = (LAS float*)(F.lds + NL_LINV) + w * 16;
    LAS unsigned char* stA = F.lds + NL_OS;
    LAS unsigned char* stC = F.lds + NL_U;
    LAS unsigned char* stB = F.lds + NL_TB + w * 16384;
    const int tid_ = w * 64 + lane, srow = tid_ >> 3, sc16 = tid_ & 7, soff = tile_off16(srow, sc16);
    const TileAddr ta = tile_addr(r, q);
    __syncthreads();
    { const int tk = TID_ >> 4, ch = TID_ & 15; const bf16* src = WSP(bf16, WS_QN) + (size_t)(b * T + t0 + tk) * 512 + kv * 256 + ch * 16;
      const u32x4 a0 = *(const u32x4*)src, a1 = *(const u32x4*)(src + 8);
      *(LAS u32x4*)(Qs + tk * 256 + ch * 16) = a0; *(LAS u32x4*)(Qs + tk * 256 + ch * 16 + 8) = a1;
      if (TID_ < 128) selm[TID_] = 0u; }
    __syncthreads();
    const int tw = t0 + 4 * w, tr = tw + (r >> 2), h = kv * 4 + (r & 3);
    bf16x8 qf[2];
#pragma unroll
    for (int ks = 0; ks < 2; ++ks) qf[ks] = as_frag(*(LAS const u32x4*)(Qs + (16 * w + r) * 64 + 32 * ks + 8 * q));
    int ncvb = (t0 + 31 - 31) / 16 + 1; ncvb = ncvb < 511 ? ncvb : 511;
    const int nst = (ncvb + 63) >> 6;
    const int tlast = tw + 3; int ncv = tlast >= 31 ? (tlast - 31) / 16 + 1 : 0; ncv = ncv < 511 ? ncv : 511;
    const int nstw = (ncv + 63) >> 6;
    f32x4 oc[4]; float lc = 0.f, carry = 0.f;
#pragma unroll
    for (int dt = 0; dt < 4; ++dt) oc[dt] = (f32x4){0.f, 0.f, 0.f, 0.f};
    {
        const bf16* kc = WSP(bf16, WS_KCMP) + (size_t)bk * 512 * 64 + srow * 64 + sc16 * 8; const bf16* vc = WSP(bf16, WS_VCMPT) + (size_t)bk * 64 * 512 + srow * 512 + sc16 * 8;
        const int nst2 = (nst + 1) >> 1;
        u32x4 rk0 = *(const u32x4*)kc, rv0 = *(const u32x4*)vc, rk1 = *(const u32x4*)(kc + 4096), rv1 = *(const u32x4*)(vc + 64);
#pragma unroll 1
        for (int s2 = 0; s2 < nst2; ++s2) {
            LAS unsigned char* bb = stA + (s2 & 1) * 32768;
            *(LAS u32x4*)(bb + soff) = rk0; *(LAS u32x4*)(bb + 8192 + soff) = rv0; *(LAS u32x4*)(bb + 16384 + soff) = rk1; *(LAS u32x4*)(bb + 24576 + soff) = rv1;
            __syncthreads();
            if (s2 + 1 < nst2) { rk0 = *(const u32x4*)(kc + (size_t)(2 * s2 + 2) * 4096); rv0 = *(const u32x4*)(vc + (2 * s2 + 2) * 64);
                                 rk1 = *(const u32x4*)(kc + (size_t)(2 * s2 + 3) * 4096); rv1 = *(const u32x4*)(vc + (2 * s2 + 3) * 64); }
#pragma unroll
            for (int sub = 0; sub < 2; ++sub) { const int st = 2 * s2 + sub; LAS unsigned char* kb = bb + sub * 16384; LAS unsigned char* vb = kb + 8192;
            if (st < nstw && !(dbg & 1)) {
                f32x4 p[4];
#pragma unroll
                for (int kt = 0; kt < 4; ++kt) { const int tile = 4 * st + kt; p[kt] = (f32x4){0.f, 0.f, 0.f, 0.f};
                    p[kt] = MFMA16(tile_kfrag(kb, ta, kt, 0), qf[0], p[kt]); p[kt] = MFMA16(tile_kfrag(kb, ta, kt, 1), qf[1], p[kt]);
                    float G = 0.f;
#pragma unroll
                    for (int i = 0; i < 4; ++i) { const int c = 16 * tile + 4 * q + i, rel = tr - (16 * c + 31); const bool ok = rel >= 0 && c < 511;
                        const int rc = rel < 0 ? 0 : (rel > 128 ? 128 : rel);
                        const float xv = p[kt][i] + bt[rc * 8 + h] - mb;
                        const float e = __builtin_amdgcn_exp2f(ok ? xv : -1e30f); p[kt][i] = e; G += e; }
                    const float send = (q == 3) ? carry : p[kt][3]; const float prev = __shfl(send, (lane + 48) & 63); carry = p[kt][3];
                    U[r * 128 + 4 * tile + q] = G + prev; lc += G; }
                const bf16x8 pf0 = frag_pk(p[0], p[1]), pf1 = frag_pk(p[2], p[3]);
#pragma unroll
                for (int dt = 0; dt < 4; ++dt) { oc[dt] = MFMA16(tile_vfrag(vb, ta, dt, 0), pf0, oc[dt]); oc[dt] = MFMA16(tile_vfrag(vb, ta, dt, 1), pf1, oc[dt]); }
            } }
        }
    }
    lc += __shfl_xor(lc, 16); lc += __shfl_xor(lc, 32);
    const float lcinv = lc > 0.f ? 1.f / lc : 0.f;
    if (q == 0) linv[r] = lcinv;
    asm volatile("s_waitcnt lgkmcnt(0)" ::: "memory");
    if (!(dbg & 8)) {
        const int tk = lane >> 4, jr = lane & 15, t = tw + tk, tblk = t >> 6, jlim = 16 * nstw;
        const float li0 = linv[4 * tk], li1 = linv[4 * tk + 1], li2 = linv[4 * tk + 2], li3 = linv[4 * tk + 3];
        unsigned key[8];
#pragma unroll
        for (int m = 0; m < 8; ++m) { const int j = jr + 16 * m; float v = 0.f;
            if (j < jlim) v = U[(4 * tk) * 128 + j] * li0 + U[(4 * tk + 1) * 128 + j] * li1 + U[(4 * tk + 2) * 128 + j] * li2 + U[(4 * tk + 3) * 128 + j] * li3;
            const bool forced = (j == 0) || (j == tblk) || (j == tblk - 1);
            const float sc = (j <= tblk) ? v + (forced ? 1e4f : 0.f) : -1e30f;
            key[m] = fkey(sc); }
        unsigned pre = 0u;
#pragma unroll 1
        for (int bit = 31; bit >= 0; --bit) { const unsigned cand = pre | (1u << bit); int cnt = 0;
#pragma unroll
            for (int m = 0; m < 8; ++m) cnt += key[m] >= cand ? 1 : 0;
            cnt += __shfl_xor(cnt, 1); cnt += __shfl_xor(cnt, 2); cnt += __shfl_xor(cnt, 4); cnt += __shfl_xor(cnt, 8);
            if (cnt >= 16) pre = cand; }
        int ngt = 0;
#pragma unroll
        for (int m = 0; m < 8; ++m) ngt += key[m] > pre ? 1 : 0;
        ngt += __shfl_xor(ngt, 1); ngt += __shfl_xor(ngt, 2); ngt += __shfl_xor(ngt, 4); ngt += __shfl_xor(ngt, 8);
        const int need = 16 - ngt; int run = 0; const unsigned kinv = fkey(-1e30f);
#pragma unroll
        for (int m = 0; m < 8; ++m) { const bool tie = key[m] == pre; const unsigned long long bal = __ballot(tie);
            const unsigned grp = (unsigned)(bal >> (16 * tk)) & 0xffffu; const int rank = __popc(grp & ((1u << jr) - 1u));
            const bool sel = (key[m] > pre || (tie && run + rank < need)) && key[m] > kinv;
            run += __popc(grp);
            if (sel) atomicOr((unsigned*)(selm + jr + 16 * m), 1u << (4 * w + tk)); }
    }
    __syncthreads();
    f32x4 ow[4]; float lw = 0.f;
#pragma unroll
    for (int dt = 0; dt < 4; ++dt) ow[dt] = (f32x4){0.f, 0.f, 0.f, 0.f};
    {
        int lc_ = lane0; OPAQUE_V(lc_); const int lane = lc_, r = lane & 15, q = lane >> 4, tr = tw + (r >> 2), h = kv * 4 + (r & 3); const TileAddr ta = tile_addr(r, q);
        const int tid_ = w * 64 + lane, srow = tid_ >> 3, sc16 = tid_ & 7, soff = tile_off16(srow, sc16);
        const int jlob = (t0 - 511 > 0 ? t0 - 511 : 0) >> 6, jhib = (t0 + 31) >> 6, nstc = jhib - jlob + 1;
        const int jlo = (tw - 511 > 0 ? tw - 511 : 0) >> 6, jhi = (tw + 3) >> 6;
        const bf16* kwin = WSP(bf16, WS_KWIN) + (size_t)bk * T * 64 + srow * 64 + sc16 * 8; const bf16* vwin = WSP(bf16, WS_VWINT) + (size_t)bk * 128 * 4096 + srow * 64 + sc16 * 8;
        const int nstc2 = (nstc + 1) >> 1;
        u32x4 rk0 = *(const u32x4*)(kwin + (size_t)jlob * 4096), rv0 = *(const u32x4*)(vwin + (size_t)jlob * 4096), rk1 = *(const u32x4*)(kwin + (size_t)(jlob + 1) * 4096), rv1 = *(const u32x4*)(vwin + (size_t)(jlob + 1) * 4096);
#pragma unroll 1
        for (int s2 = 0; s2 < nstc2; ++s2) { const int j0 = jlob + 2 * s2;
            LAS unsigned char* bb = stC + (s2 & 1) * 32768;
            *(LAS u32x4*)(bb + soff) = rk0; *(LAS u32x4*)(bb + 8192 + soff) = rv0; *(LAS u32x4*)(bb + 16384 + soff) = rk1; *(LAS u32x4*)(bb + 24576 + soff) = rv1;
            __syncthreads();
            if (s2 + 1 < nstc2) { rk0 = *(const u32x4*)(kwin + (size_t)(j0 + 2) * 4096); rv0 = *(const u32x4*)(vwin + (size_t)(j0 + 2) * 4096);
                                  rk1 = *(const u32x4*)(kwin + (size_t)(j0 + 3) * 4096); rv1 = *(const u32x4*)(vwin + (size_t)(j0 + 3) * 4096); }
#pragma unroll
            for (int sub = 0; sub < 2; ++sub) { const int j = j0 + sub; LAS unsigned char* kb = bb + sub * 16384; LAS unsigned char* vb = kb + 8192;
            if (j >= jlo && j <= jhi && !(dbg & 2)) {
                f32x4 p[4];
#pragma unroll
                for (int kt = 0; kt < 4; ++kt) { p[kt] = (f32x4){0.f, 0.f, 0.f, 0.f};
                    p[kt] = MFMA16(tile_kfrag(kb, ta, kt, 0), qf[0], p[kt]); p[kt] = MFMA16(tile_kfrag(kb, ta, kt, 1), qf[1], p[kt]);
#pragma unroll
                    for (int i = 0; i < 4; ++i) { const int rel = tr - (64 * j + 16 * kt + 4 * q + i); const bool ok = rel >= 0 && rel < 512;
                        const int rc = rel < 0 ? 0 : (rel > 128 ? 128 : rel);
                        const float xv = p[kt][i] + bt[rc * 8 + h] - mb;
                        const float e = __builtin_amdgcn_exp2f(ok ? xv : -1e30f); p[kt][i] = e; lw += e; } }
                const bf16x8 pf0 = frag_pk(p[0], p[1]), pf1 = frag_pk(p[2], p[3]);
#pragma unroll
                for (int dt = 0; dt < 4; ++dt) { ow[dt] = MFMA16(tile_vfrag(vb, ta, dt, 0), pf0, ow[dt]); ow[dt] = MFMA16(tile_vfrag(vb, ta, dt, 1), pf1, ow[dt]); }
            } }
        }
        lw += __shfl_xor(lw, 16); lw += __shfl_xor(lw, 32);
    }
    f32x4 ocw[4];
    { const float* gt = WSP(float, WS_GATES) + (size_t)(b * T + tr) * 24 + h * 3;
      const float g0 = gt[0] * lcinv, g2 = gt[2] * (lw > 0.f ? 1.f / lw : 0.f);
#pragma unroll
      for (int dt = 0; dt < 4; ++dt) ocw[dt] = oc[dt] * g0 + ow[dt] * g2; }
    __syncthreads();
    f32x4 osf[4]; float lsf = 0.f;
    {
        int lb_ = lane0; OPAQUE_V(lb_); const int lane = lb_, r = lane & 15, q = lane >> 4, h = kv * 4 + (r & 3); const TileAddr ta = tile_addr(r, q);
        const int half = w >> 2, jw = w & 3;
        f32x4 osa[4][4]; float lsa[4];
#pragma unroll
        for (int x = 0; x < 4; ++x) { lsa[x] = 0.f;
#pragma unroll
            for (int dt = 0; dt < 4; ++dt) osa[x][dt] = (f32x4){0.f, 0.f, 0.f, 0.f}; }
        const int jmax = (t0 + 31) >> 6;
        const int brow = lane >> 3, bc16 = lane & 7, boff = brow * 64 + bc16 * 8, bsoff = tile_off16(brow, bc16); const float bfar = bt[128 * 8 + h];
        const bf16* ksel = WSP(bf16, WS_KSEL) + (size_t)bk * T * 64 + boff; const bf16* vsel = WSP(bf16, WS_VSELT) + (size_t)bk * 128 * 4096 + boff;
        LAS const bf16* Qh = Qs + (64 * half + r) * 64 + 8 * q;
        u32x4 gk[8], gv[8];
        if (jw <= jmax) {
#pragma unroll
            for (int i = 0; i < 8; ++i) { gk[i] = *(const u32x4*)(ksel + (size_t)jw * 4096 + i * 512); gv[i] = *(const u32x4*)(vsel + (size_t)jw * 4096 + i * 512); } }
#pragma unroll 1
        for (int j = jw; j <= jmax; j += 4) {
            const unsigned msel = ((unsigned)__builtin_amdgcn_readfirstlane((int)selm[j]) >> (16 * half)) & 0xffffu;
            const bool act = msel != 0u && !(dbg & 4);
            asm volatile("s_waitcnt lgkmcnt(0)" ::: "memory");
#pragma unroll
            for (int i = 0; i < 8; ++i) { *(LAS u32x4*)(stB + bsoff + i * 1024) = gk[i]; *(LAS u32x4*)(stB + 8192 + bsoff + i * 1024) = gv[i]; }
            if (j + 4 <= jmax) {
#pragma unroll
                for (int i = 0; i < 8; ++i) { gk[i] = *(const u32x4*)(ksel + (size_t)(j + 4) * 4096 + i * 512); gv[i] = *(const u32x4*)(vsel + (size_t)(j + 4) * 4096 + i * 512); } }
            if (!act) continue;
            asm volatile("s_waitcnt lgkmcnt(0)" ::: "memory");
            const bool far = (t0 - (64 * j + 63)) >= 128;
#pragma unroll 1
            for (int x = 0; x < 4; ++x) {
                const unsigned nib = (msel >> (4 * x)) & 15u;
                if (nib) {
                    asm volatile("" ::: "memory");
                    const bool tokv = (nib >> (r >> 2)) & 1u; const int t = t0 + 16 * half + 4 * x + (r >> 2);
                    const bf16x8 qs0 = as_frag(*(LAS const u32x4*)(Qh + x * 1024)), qs1 = as_frag(*(LAS const u32x4*)(Qh + x * 1024 + 32));
                    f32x4 p[4]; float ls = 0.f;
#pragma unroll
                    for (int kt = 0; kt < 4; ++kt) { p[kt] = (f32x4){0.f, 0.f, 0.f, 0.f};
                        p[kt] = MFMA16(tile_kfrag(stB, ta, kt, 0), qs0, p[kt]); p[kt] = MFMA16(tile_kfrag(stB, ta, kt, 1), qs1, p[kt]); }
                    if (far) {
                        const float cb_ = bfar - mb;
#pragma unroll
                        for (int kt = 0; kt < 4; ++kt)
#pragma unroll
                            for (int i = 0; i < 4; ++i) { const float e = __builtin_amdgcn_exp2f(tokv ? p[kt][i] + cb_ : -1e30f); p[kt][i] = e; ls += e; }
                    } else {
#pragma unroll
                        for (int kt = 0; kt < 4; ++kt)
#pragma unroll
                            for (int i = 0; i < 4; ++i) { const int rel = t - (64 * j + 16 * kt + 4 * q + i); const bool ok = tokv && rel >= 0;
                                const int rc = rel < 0 ? 0 : (rel > 128 ? 128 : rel);
                                const float xv = p[kt][i] + bt[rc * 8 + h] - mb;
                                const float e = __builtin_amdgcn_exp2f(ok ? xv : -1e30f); p[kt][i] = e; ls += e; }
                    }
                    lsa[0] += ls;
                    const bf16x8 pf0 = frag_pk(p[0], p[1]), pf1 = frag_pk(p[2], p[3]);
#pragma unroll
                    for (int dt = 0; dt < 4; ++dt) { osa[0][dt] = MFMA16(tile_vfrag(stB + 8192, ta, dt, 0), pf0, osa[0][dt]); osa[0][dt] = MFMA16(tile_vfrag(stB + 8192, ta, dt, 1), pf1, osa[0][dt]); }
                }
                { const float l0 = lsa[0]; lsa[0] = lsa[1]; lsa[1] = lsa[2]; lsa[2] = lsa[3]; lsa[3] = l0;
#pragma unroll
                  for (int dt = 0; dt < 4; ++dt) { const f32x4 o0 = osa[0][dt]; osa[0][dt] = osa[1][dt]; osa[1][dt] = osa[2][dt]; osa[2][dt] = osa[3][dt]; osa[3][dt] = o0; } }
            }
        }
#pragma unroll
        for (int dt = 0; dt < 4; ++dt) osf[dt] = (f32x4){0.f, 0.f, 0.f, 0.f};
#pragma unroll
        for (int x = 0; x <= 4; ++x) {
            __syncthreads();
            if (x > 0 && jw == x - 1) {
#pragma unroll
                for (int w2 = 0; w2 < 4; ++w2) { LAS const float* rp = (LAS const float*)(F.lds + NL_U + ((x - 1) & 1) * 32768) + (4 * half + w2) * 1024 + lane * 16;
#pragma unroll
                    for (int dt = 0; dt < 4; ++dt) osf[dt] += *(LAS const f32x4*)(rp + 4 * dt);
                    lsf += ((LAS const float*)(F.lds + NL_Q + ((x - 1) & 1) * 2048))[(4 * half + w2) * 64 + lane]; } }
            if (x < 4) { LAS float* Rb = (LAS float*)(F.lds + NL_U + (x & 1) * 32768); LAS float* RLb = (LAS float*)(F.lds + NL_Q + (x & 1) * 2048);
#pragma unroll
                for (int dt = 0; dt < 4; ++dt) *(LAS f32x4*)(Rb + w * 1024 + lane * 16 + 4 * dt) = osa[x][dt];
                RLb[w * 64 + lane] = lsa[x]; }
        }
        lsf += __shfl_xor(lsf, 16); lsf += __shfl_xor(lsf, 32);
    }
    {
        int lf_ = lane0; OPAQUE_V(lf_); const int r = lf_ & 15, q = lf_ >> 4, tr = tw + (r >> 2), h = kv * 4 + (r & 3);
        const int tok = b * T + tr; const float g1 = WSP(float, WS_GATES)[(size_t)tok * 24 + h * 3 + 1] * (lsf > 0.f ? 1.f / lsf : 0.f);
        bf16* on = WSP(bf16, WS_ONSA) + (size_t)tok * 512 + h * 64 + 4 * q;
#pragma unroll
        for (int dt = 0; dt < 4; ++dt) { const f32x4 o = ocw[dt] + osf[dt] * g1;
            u32x2 wv; wv.x = pk2(o[0], o[1]); wv.y = pk2(o[2], o[3]); *(u32x2*)(on + 16 * dt) = wv; }
    }
}

constexpr int SL_Q = 0;
constexpr int SL_S = 1024;
constexpr int SL_O = 17408;
constexpr int SL_PART = 20480;
constexpr int SL_IMP = 28672;
constexpr int SL_IDX = 29200;
constexpr int SL_END = 29328;
static_assert(SL_END <= NL_SEL, "sample NSA LDS map must not overlap the tables");
template <class KP, class VP, class RELF>
__device__ __forceinline__ void sample_segment(Frame& F, int nk, int kv, KP kptr, VP vptr, RELF relf, LAS float* odst) {
    LAS const float* qs = (LAS const float*)(F.lds + SL_Q); LAS float* sc = (LAS float*)(F.lds + SL_S); LAS float* part = (LAS float*)(F.lds + SL_PART);
    LAS const float* bt = (LAS const float*)(F.lds + NL_BT);
    const int nkp = (nk + 63) & ~63;
    for (int n = TID_; n < nkp; n += NTHR) {
        float s0 = -INFINITY, s1 = -INFINITY, s2 = -INFINITY, s3 = -INFINITY;
        const float* kr = n < nk ? kptr(n) : nullptr;
        if (kr) { s0 = s1 = s2 = s3 = 0.f;
            for (int d = 0; d < 64; d += 4) { const f32x4 k4 = *(const f32x4*)(kr + d);
                const f32x4 q0 = *(LAS const f32x4*)(qs + d), q1 = *(LAS const f32x4*)(qs + 64 + d), q2 = *(LAS const f32x4*)(qs + 128 + d), q3 = *(LAS const f32x4*)(qs + 192 + d);
                s0 += (q0[0] * k4[0] + q0[1] * k4[1]) + (q0[2] * k4[2] + q0[3] * k4[3]); s1 += (q1[0] * k4[0] + q1[1] * k4[1]) + (q1[2] * k4[2] + q1[3] * k4[3]);
                s2 += (q2[0] * k4[0] + q2[1] * k4[1]) + (q2[2] * k4[2] + q2[3] * k4[3]); s3 += (q3[0] * k4[0] + q3[1] * k4[1]) + (q3[2] * k4[2] + q3[3] * k4[3]); }
            int rel = relf(n); rel = rel > 128 ? 128 : rel; const int bb = rel * 8 + kv * 4;
            s0 += bt[bb]; s1 += bt[bb + 1]; s2 += bt[bb + 2]; s3 += bt[bb + 3]; }
        sc[n] = s0; sc[1024 + n] = s1; sc[2048 + n] = s2; sc[3072 + n] = s3;
    }
    __syncthreads();
    if (F.wave < 4) { LAS float* row = sc + F.wave * 1024; float m = -INFINITY;
        for (int n = LANE_; n < nkp; n += 64) m = fmaxf(m, row[n]);
        m = wave_max(m); float l = 0.f;
        for (int n = LANE_; n < nkp; n += 64) { const float e = __builtin_amdgcn_exp2f(row[n] - m); row[n] = e; l += e; }
        l = wave_sum(l); const float inv = 1.f / l;
        for (int n = LANE_; n < nkp; n += 64) row[n] *= inv; }
    __syncthreads();
    {
        const int d = LANE_; float o0 = 0.f, o1 = 0.f, o2 = 0.f, o3 = 0.f;
        for (int n0 = F.wave; n0 < nkp; n0 += 32) {
            float v[4];
#pragma unroll
            for (int u = 0; u < 4; ++u) { const int n = n0 + 8 * u; v[u] = n < nk ? vptr(n)[d] : 0.f; }
#pragma unroll
            for (int u = 0; u < 4; ++u) { const int n = n0 + 8 * u; if (n < nkp) { o0 += sc[n] * v[u]; o1 += sc[1024 + n] * v[u]; o2 += sc[2048 + n] * v[u]; o3 += sc[3072 + n] * v[u]; } }
        }
        part[(F.wave * 4 + 0) * 64 + d] = o0; part[(F.wave * 4 + 1) * 64 + d] = o1; part[(F.wave * 4 + 2) * 64 + d] = o2; part[(F.wave * 4 + 3) * 64 + d] = o3; }
    __syncthreads();
    if (TID_ < 256) { float a = 0.f;
#pragma unroll
        for (int w8 = 0; w8 < 8; ++w8) a += part[w8 * 256 + TID_];
        odst[TID_] = a; }
    __syncthreads();
}
__device__ __forceinline__ void p3_nsa_sample(Frame& F, int task) {
    const int b = task >> 1, kv = task & 1, tok = NTOKP + b, bk = b * 2 + kv;
    LAS float* qs = (LAS float*)(F.lds + SL_Q); LAS float* sc = (LAS float*)(F.lds + SL_S); LAS float* ob = (LAS float*)(F.lds + SL_O);
    LAS float* imp = (LAS float*)(F.lds + SL_IMP); LAS int* sidx = (LAS int*)(F.lds + SL_IDX);
    __syncthreads();
    if (TID_ < 256) qs[TID_] = bf2f(WSP(bf16, WS_QN)[(size_t)tok * 512 + kv * 256 + TID_]);
    __syncthreads();
    const float* kcs = WSP(float, WS_KCMPS) + (size_t)bk * 512 * 64; const float* vcs = WSP(float, WS_VCMPS) + (size_t)bk * 512 * 64;
    const float* nkv = WSP(float, WS_NEWKV) + (size_t)b * 4 * 2 * 64 + kv * 64;
    const float* ckv = F.in[I_CKV]; const int* pt = (const int*)F.in[I_PT] + b * 64; const float* cwin = F.in[I_CWIN] + (size_t)b * 512 * 256;
    sample_segment(F, 511, kv, [&](int n) { return kcs + (size_t)n * 64; }, [&](int n) { return vcs + (size_t)n * 64; }, [&](int n) { return T - (16 * n + 31); }, ob);
    if (TID_ < 129) { const int j = TID_; float v = 0.f;
        for (int c = 4 * j - 1; c <= 4 * j + 3; ++c) if (c >= 0 && c < 511) v += (sc[c] + sc[1024 + c]) + (sc[2048 + c] + sc[3072 + c]);
        imp[j] = v; }
    __syncthreads();
    if (F.wave == 0) { const int lane = LANE_; unsigned key[3];
#pragma unroll
        for (int m = 0; m < 3; ++m) { const int j = lane + 64 * m; float s = -1e30f;
            if (j < 129) { const bool forced = (j == 0) || (j == 128) || (j == 127); s = imp[j] + (forced ? 1e4f : 0.f); }
            key[m] = (j < 129) ? fkey(s) : 0u; }
        unsigned pre = 0u;
#pragma unroll 1
        for (int bit = 31; bit >= 0; --bit) { const unsigned cand = pre | (1u << bit); int cnt = 0;
#pragma unroll
            for (int m = 0; m < 3; ++m) cnt += __popcll(__ballot(key[m] >= cand));
            if (cnt >= 16) pre = cand; }
        int ngt = 0;
#pragma unroll
        for (int m = 0; m < 3; ++m) ngt += __popcll(__ballot(key[m] > pre));
        int need = 16 - ngt, cnt = 0;
#pragma unroll
        for (int m = 0; m < 3; ++m) { const bool gt = key[m] > pre, tie = key[m] == pre; const unsigned long long tb = __ballot(tie);
            const int trank = __popcll(tb & ((1ull << lane) - 1ull)); const bool sel = gt || (tie && trank < need);
            need -= __popcll(tb); need = need < 0 ? 0 : need;
            const unsigned long long sb = __ballot(sel); const int pos = cnt + __popcll(sb & ((1ull << lane) - 1ull));
            if (sel && pos < 16) sidx[pos] = lane + 64 * m; cnt += __popcll(sb); } }
    __syncthreads();
    sample_segment(F, 1024, kv,
        [&](int n) -> const float* { const int pos = 64 * sidx[n >> 6] + (n & 63); if (pos > T) return nullptr; if (pos == T) return nkv;
                                     return ckv + (((size_t)pt[pos >> 7] * 128 + (pos & 127)) * 4 + 2) * 128 + kv * 64; },
        [&](int n) -> const float* { const int pos = 64 * sidx[n >> 6] + (n & 63); if (pos >= T) return nkv + 128;
                                     return ckv + (((size_t)pt[pos >> 7] * 128 + (pos & 127)) * 4 + 3) * 128 + kv * 64; },
        [&](int n) { return T - (64 * sidx[n >> 6] + (n & 63)); }, ob + 256);
    sample_segment(F, 512, kv,
        [&](int n) -> const float* { return n < 511 ? cwin + (size_t)(n + 1) * 256 + kv * 64 : nkv + 256; },
        [&](int n) -> const float* { return n < 511 ? cwin + (size_t)(n + 1) * 256 + 128 + kv * 64 : nkv + 384; },
        [&](int n) { return 511 - n; }, ob + 512);
    if (TID_ < 256) { const int g = TID_ >> 6, d = TID_ & 63, h = kv * 4 + g; const float* gt = WSP(float, WS_GATES) + (size_t)tok * 24 + h * 3;
        WSP(bf16, WS_ONSA)[(size_t)tok * 512 + h * 64 + d] = (bf16)f2bf(gt[0] * ob[TID_] + gt[1] * ob[256 + TID_] + gt[2] * ob[512 + TID_]); }
}

__device__ __forceinline__ void p6_conv(Frame& F) {
    const bf16* ug = WSP(bf16, WS_UG); bf16* act = WSP(bf16, WS_ACT);
    const float* cw = F.in[I_CONVW]; const float* cb = F.in[I_CONVB]; const float* sconv = F.in[I_SCONV];
    constexpr int NG = DFF / 8, RSEG = 32, NSEGP = NTOKP / RSEG, NITEM = NG * (NSEGP + 1);
    { const float* x1s = WSP(float, WS_X1S); float* ys = F.out + O_YS; for (int i = F.bid * NTHR + TID_; i < SB * 1024; i += F.G * NTHR) ys[i] = x1s[i]; }
    for (int it = F.bid * NTHR + TID_; it < NITEM; it += F.G * NTHR) {
        const int seg = it / NG, c0 = 8 * (it % NG);
        float w0[8], w1[8], w2[8], bb[8];
#pragma unroll
        for (int i = 0; i < 8; ++i) { w0[i] = cw[c0 + i]; w1[i] = cw[DFF + c0 + i]; w2[i] = cw[2 * DFF + c0 + i]; bb[i] = cb[c0 + i]; }
        if (seg < NSEGP) {
            const int row0 = seg * RSEG, t0 = row0 & (T - 1);
            float g0[8], g1[8];
            if (t0 >= 2) { unpack8(*(const u32x4*)(ug + (size_t)(row0 - 2) * DUP + DFF + c0), g0); unpack8(*(const u32x4*)(ug + (size_t)(row0 - 1) * DUP + DFF + c0), g1); }
            else {
#pragma unroll
                for (int i = 0; i < 8; ++i) { g0[i] = 0.f; g1[i] = 0.f; } }
#pragma unroll 4
            for (int rr = 0; rr < RSEG; ++rr) { const int row = row0 + rr; float u[8], g2[8], a[8];
                unpack8(*(const u32x4*)(ug + (size_t)row * DUP + c0), u); unpack8(*(const u32x4*)(ug + (size_t)row * DUP + DFF + c0), g2);
#pragma unroll
                for (int i = 0; i < 8; ++i) { a[i] = gelu_tanh(bb[i] + w0[i] * g0[i] + w1[i] * g1[i] + w2[i] * g2[i]) * u[i]; g0[i] = g1[i]; g1[i] = g2[i]; }
                *(u32x4*)(act + (size_t)row * DFF + c0) = pack8(a); }
            if (t0 + RSEG == T) { float* o = F.out + O_CONVP + (size_t)(row0 >> 13) * 2 * DFF + c0;
#pragma unroll
                for (int i = 0; i < 8; ++i) { o[i] = g0[i]; o[DFF + i] = g1[i]; } }
        } else {
            for (int sb = 0; sb < SB; ++sb) { const int row = NTOKP + sb; float u[8], g2[8], g0[8], g1[8], a[8];
                unpack8(*(const u32x4*)(ug + (size_t)row * DUP + c0), u); unpack8(*(const u32x4*)(ug + (size_t)row * DUP + DFF + c0), g2);
#pragma unroll
                for (int i = 0; i < 8; ++i) { g0[i] = sconv[((size_t)sb * 2 + 0) * DFF + c0 + i]; g1[i] = sconv[((size_t)sb * 2 + 1) * DFF + c0 + i]; }
                float* o = F.out + O_CONVS + (size_t)sb * 2 * DFF + c0;
#pragma unroll
                for (int i = 0; i < 8; ++i) { o[i] = g1[i]; o[DFF + i] = g2[i]; a[i] = gelu_tanh(bb[i] + w0[i] * g0[i] + w1[i] * g1[i] + w2[i] * g2[i]) * u[i]; }
                *(u32x4*)(act + (size_t)row * DFF + c0) = pack8(a); }
            for (int row = NTOK; row < MPAD; ++row) *(u32x4*)(act + (size_t)row * DFF + c0) = (u32x4){0u, 0u, 0u, 0u};
        }
    }
}

template <bool A_F32>
__device__ __forceinline__ void skinny_mma(f32x4 (&acc)[2], float (&ssq)[2], const void* A, int lda, const bf16* Bt, int K, int n0, int k0, int nks, int r, int q) {
    acc[0] = (f32x4){0.f, 0.f, 0.f, 0.f}; acc[1] = acc[0]; ssq[0] = 0.f; ssq[1] = 0.f;
#pragma unroll 4
    for (int ks = 0; ks < nks; ++ks) { const int k = k0 + 32 * ks + 8 * q;
        const bf16x8 a = ldfrag(Bt + (size_t)(n0 + r) * K + k);
#pragma unroll
        for (int mt = 0; mt < 2; ++mt) { bf16x8 bfr;
            if (A_F32) { const float* p = (const float*)A + (size_t)(16 * mt + r) * lda + k; const f32x4 x0 = *(const f32x4*)p, x1 = *(const f32x4*)(p + 4);
                ssq[mt] += (x0[0] * x0[0] + x0[1] * x0[1]) + (x0[2] * x0[2] + x0[3] * x0[3]) + (x1[0] * x1[0] + x1[1] * x1[1]) + (x1[2] * x1[2] + x1[3] * x1[3]); bfr = frag_pk(x0, x1); }
            else bfr = ldfrag((const bf16*)A + (size_t)(16 * mt + r) * lda + k);
            acc[mt] = MFMA16(a, bfr, acc[mt]); } }
}
__device__ __forceinline__ void s5_merge(Frame& F, int t) {
    const int lane = LANE_, r = lane & 15, q = lane >> 4, br = t >> 7, nt = (t >> 1) & 63, kc = t & 1;
    const bf16* A = (br == 0 ? WSP(bf16, WS_ONSA) : br == 1 ? WSP(bf16, WS_OGLA) : WSP(bf16, WS_OX)) + (size_t)NTOKP * 512;
    const bf16* Bt = br == 0 ? WSP(bf16, WS_WTNSA) : br == 1 ? WSP(bf16, WS_WTGLA) : WSP(bf16, WS_WTX);
    f32x4 acc[2]; float ssq[2]; skinny_mma<false>(acc, ssq, A, 512, Bt, 512, 16 * nt, 256 * kc, 8, r, q);
    float* ms = WSP(float, WS_MS); const bf16* gate = WSP(bf16, WS_PROJ) + (size_t)NTOKP * DINP + C_MG + br * 1024;
#pragma unroll
    for (int mt = 0; mt < 2; ++mt) { const int m = 16 * mt + r; const u32x2 g = *(const u32x2*)(gate + (size_t)m * DINP + 16 * nt + 4 * q);
        float* d = ms + (size_t)m * 1024 + 16 * nt + 4 * q;
        atomicAdd(d + 0, acc[mt][0] * sigmoidf_(bflo(g.x))); atomicAdd(d + 1, acc[mt][1] * sigmoidf_(bfhi(g.x)));
        atomicAdd(d + 2, acc[mt][2] * sigmoidf_(bflo(g.y))); atomicAdd(d + 3, acc[mt][3] * sigmoidf_(bfhi(g.y))); }
}
__device__ __forceinline__ void s6_wo(Frame& F, int t) {
    const int lane = LANE_, r = lane & 15, q = lane >> 4, nt = t >> 2, kc = t & 3;
    f32x4 acc[2]; float ssq[2]; skinny_mma<true>(acc, ssq, WSP(float, WS_MS), 1024, WSP(bf16, WS_WTO), 1024, 16 * nt, 256 * kc, 8, r, q);
    float* x1s = WSP(float, WS_X1S);
#pragma unroll
    for (int mt = 0; mt < 2; ++mt) { float* d = x1s + (size_t)(16 * mt + r) * 1024 + 16 * nt + 4 * q;
#pragma unroll
        for (int i = 0; i < 4; ++i) atomicAdd(d + i, acc[mt][i]); }
}
__device__ __forceinline__ void s7_up(Frame& F, int t) {
    const int lane = LANE_, r = lane & 15, q = lane >> 4;
    f32x4 acc[2]; float ssq[2]; skinny_mma<true>(acc, ssq, WSP(float, WS_X1S), 1024, WSP(bf16, WS_WTUP), 1024, 16 * t, 0, 32, r, q);
    bf16* ug = WSP(bf16, WS_UG) + (size_t)NTOKP * DUP;
#pragma unroll
    for (int mt = 0; mt < 2; ++mt) { float s = ssq[mt]; s += __shfl_xor(s, 16); s += __shfl_xor(s, 32); const float rs = rsqrtf(s * (1.f / 1024.f) + EPS);
        u32x2 w; w.x = pk2(acc[mt][0] * rs, acc[mt][1] * rs); w.y = pk2(acc[mt][2] * rs, acc[mt][3] * rs);
        *(u32x2*)(ug + (size_t)(16 * mt + r) * DUP + 16 * t + 4 * q) = w; }
}
__device__ __forceinline__ void s9_down(Frame& F, int t) {
    const int lane = LANE_, r = lane & 15, q = lane >> 4, nt = t / 11, kc = t % 11;
    f32x4 acc[2]; float ssq[2]; skinny_mma<false>(acc, ssq, WSP(bf16, WS_ACT) + (size_t)NTOKP * DFF, DFF, WSP(bf16, WS_WTDOWN), DFF, 16 * nt, 256 * kc, 8, r, q);
    float* ys = F.out + O_YS;
#pragma unroll
    for (int mt = 0; mt < 2; ++mt) { float* d = ys + (size_t)(16 * mt + r) * 1024 + 16 * nt + 4 * q;
#pragma unroll
        for (int i = 0; i < 4; ++i) atomicAdd(d + i, acc[mt][i]); }
}

constexpr int N_PHASES = 10;
__global__ void __launch_bounds__(NTHR, 2) mega_fwd(Args args) {
    extern __shared__ __attribute__((aligned(16))) unsigned char lds_raw[];
    cg::grid_group grid = cg::this_grid();
    Frame F;
    F.lds = (LAS unsigned char*)lds_raw;
    F.wave = __builtin_amdgcn_readfirstlane((int)(threadIdx.x >> 6));
    F.G = gridDim.x; F.bid = blockIdx.x; F.gw = F.bid * NWAVES + F.wave; F.NGW = F.G * NWAVES;
    F.in = args.in; F.out = args.out; F.ws = args.ws;
    const int lo = args.ph_lo, hi = args.ph_hi, sub = args.sub;
    volatile LAS unsigned* xst = (volatile LAS unsigned*)(F.lds + 152640);
    if (threadIdx.x < 2) xst[threadIdx.x] = 0u;
    __syncthreads();
    XcdBarrier xbar; xbar.bar = (unsigned*)(args.ws + WS_CTL); xbar.x = 0; xbar.st = xst;
    if (lo == 0 && hi == N_PHASES) xbar = xcd_barrier_post((unsigned*)(args.ws + WS_CTL), xst);
#define SUB(i) ((sub >> (i)) & 1)
#ifndef PROBE_REP
#define PROBE_REP -1
#endif
#define IN(k) (lo <= (k) && (k) < hi)
#define REP(k) for (int rep_ = 0; rep_ < ((k) == PROBE_REP ? 2 : 1); ++rep_)
#define SEAM(k) do { if (IN(k) && IN((k) + 1)) { if ((k) == 0) grid.sync(); else xcd_barrier(xbar); } { unsigned char* w_ = F.ws; asm volatile("" : "+s"(w_)); F.ws = w_; float* o_ = F.out; asm volatile("" : "+s"(o_)); F.out = o_; } } while (0)
    typedef pg8::StaticOrder SO;

    REP(0) if (IN(0)) { p0_prologue(F); }
    SEAM(0);
    if (IN(1)) {
        { pg8::Gemm g{WSP(bf16, WS_XN), WSP(bf16, WS_WTIN), MPAD, DINP, 1024}; SO S; S.init(MPAD, DINP, F.G, F.bid);
          pg8::EpiStore E{WSP(bf16, WS_PROJ), DINP, nullptr};
          pg8::gemm_phase<pg8::EpiStore, SO, true, true>(F.lds, g, S, E, F.wave); }
        __syncthreads();
        { pg8::Gemm g{WSP(bf16, WS_MN), WSP(bf16, WS_WTMEM), 512, 1024, 1024}; SO S; S.init(512, 1024, F.G, F.G - 1 - F.bid);
          pg8::EpiStore E{WSP(bf16, WS_MEMPROJ), 1024, nullptr};
          pg8::gemm_phase<pg8::EpiStore, SO, true, true>(F.lds, g, S, E, F.wave); }
    }
    SEAM(1);
    REP(2) if (IN(2)) {
        if (SUB(0)) { for (int tok = F.gw; tok < NTOK; tok += F.NGW) p2_token(F, tok);
        for (int row = F.gw; row < 512; row += F.NGW) p2_memrow(F, row); }
        if (SUB(1)) for (int t = F.bid; t < CMP_TASKS_S + CMP_TASKS_P; t += F.G) p2_compress(F, t);
        if (SUB(2)) for (int bc = F.bid; bc < 256; bc += F.G) { __syncthreads(); p2_gla_chunk(F, bc); }
        __syncthreads();
        if (SUB(3)) for (int t = F.gw; t < SB * 4; t += F.NGW) p2_gla_sample(F, t);
    }
    SEAM(2);
    REP(3) if (IN(3)) {
        nsa_tables(F);
        const float mb = nsa_bound(F);
        if (SUB(4)) for (int n = F.bid; n < 1024; n += F.G) p3_nsa_prompt(F, n, mb, (sub >> 8) & 31);
        __syncthreads();
        if (SUB(7)) for (int t = F.gw; t < 1024; t += F.NGW) p3_gla_scan(F, t);
    }
    SEAM(3);
    if (IN(4)) {
        nsa_tables(F);
        for (int t = F.G - 1 - F.bid; t < SB * 2; t += F.G) p3_nsa_sample(F, t);
        __syncthreads();
        { const float gq = absmax_arr(F.in[I_GXQ], 128, LANE_), gk = absmax_arr(F.in[I_GXK], 128, LANE_);
          const float mbx = 11.313708498984761f * gq * gk * 1.02f * LOG2E;
          for (int t = F.bid; t < 256; t += F.G) p3_xatt(F, t, mbx); }
        __syncthreads();
        for (int t = F.gw; t < SB * 4; t += F.NGW) p3_xatt_sample(F, t);
        __syncthreads();
        { const int nb = F.G > 128 ? F.G - 64 : F.G;
          if (F.bid < nb) for (int t = F.gw; t < 4096; t += nb * NWAVES) p4_gla_out(F, t); }
    }
    SEAM(4);
    if (IN(5)) {
        const bf16* gate = WSP(bf16, WS_PROJ) + C_MG;
        for (int t = F.gw; t < 384; t += F.NGW) s5_merge(F, t);
        { pg8::Gemm g{WSP(bf16, WS_ONSA), WSP(bf16, WS_WTNSA), NTOKP, 1024, 512}; SO S; S.init(NTOKP, 1024, F.G, F.bid);
          pg8::EpiMerge<0> E{gate, DINP, WSP(bf16, WS_MERGED), 1024};
          pg8::gemm_phase<pg8::EpiMerge<0>, SO, true, true>(F.lds, g, S, E, F.wave); }
        __syncthreads();
        { pg8::Gemm g{WSP(bf16, WS_OGLA), WSP(bf16, WS_WTGLA), NTOKP, 1024, 512}; SO S; S.init(NTOKP, 1024, F.G, F.bid);
          pg8::EpiMerge<1> E{gate + 1024, DINP, WSP(bf16, WS_MERGED), 1024};
          pg8::gemm_phase<pg8::EpiMerge<1>, SO, true, true>(F.lds, g, S, E, F.wave); }
        __syncthreads();
        { pg8::Gemm g{WSP(bf16, WS_OX), WSP(bf16, WS_WTX), NTOKP, 1024, 512}; SO S; S.init(NTOKP, 1024, F.G, F.bid);
          pg8::EpiMerge<1> E{gate + 2048, DINP, WSP(bf16, WS_MERGED), 1024};
          pg8::gemm_phase<pg8::EpiMerge<1>, SO, true, true>(F.lds, g, S, E, F.wave); }
    }
    SEAM(5);
    if (IN(6)) {
        for (int t = F.gw; t < 256; t += F.NGW) s6_wo(F, t);
        pg8::Gemm g{WSP(bf16, WS_MERGED), WSP(bf16, WS_WTO), NTOKP, 1024, 1024}; SO S; S.init(NTOKP, 1024, F.G, F.bid);
        pg8::EpiWo E{F.in[I_XP], F.in[I_XS], WSP(float, WS_X1), WSP(bf16, WS_X1B), WSP(float, WS_SSQ)};
        pg8::gemm_phase<pg8::EpiWo, SO, true, true>(F.lds, g, S, E, F.wave);
    }
    SEAM(6);
    if (IN(7)) {
        for (int t = F.gw; t < 352; t += F.NGW) s7_up(F, t);
        pg8::Gemm g{WSP(bf16, WS_X1B), WSP(bf16, WS_WTUP), NTOKP, DUP, 1024}; SO S; S.init(NTOKP, DUP, F.G, F.bid);
        pg8::EpiStore E{WSP(bf16, WS_UG), DUP, WSP(float, WS_SSQ)};
        pg8::gemm_phase<pg8::EpiStore, SO, true, true>(F.lds, g, S, E, F.wave);
    }
    SEAM(7);
    REP(8) if (IN(8)) { p6_conv(F); }
    SEAM(8);
    if (IN(9)) {
        for (int t = F.gw; t < 704; t += F.NGW) s9_down(F, t);
        pg8::Gemm g{WSP(bf16, WS_ACT), WSP(bf16, WS_WTDOWN), NTOKP, 1024, DFF}; SO S; S.init(NTOKP, 1024, F.G, F.bid);
        pg8::EpiDown E{WSP(float, WS_X1), F.out + O_Y, F.out + O_YS};
        pg8::gemm_phase<pg8::EpiDown, SO, true, true>(F.lds, g, S, E, F.wave);
    }
#undef IN
#undef SEAM
}

extern "C" void kernel_launch(void* const* d_in, const int* in_sizes, int n_in, void* d_out, int out_size, void* d_ws, size_t ws_size, hipStream_t stream) {
    static int grid = 0;
    if (grid == 0) {
        if (n_in != N_IN || (size_t)out_size != O_END || ws_size < WS_END) {
            fprintf(stderr, "kernel_launch: built for %d inputs, %zu outputs, >= %zu bytes of workspace; got %d, %d, %zu\n", (int)N_IN, (size_t)O_END, (size_t)WS_END, n_in, out_size, ws_size); grid = -1; return; }
        int dev = 0, cus = 0, per_cu = 0;
        if (hipGetDevice(&dev) != hipSuccess || hipDeviceGetAttribute(&cus, hipDeviceAttributeMultiprocessorCount, dev) != hipSuccess) { grid = -1; return; }
        if (hipFuncSetAttribute((const void*)mega_fwd, hipFuncAttributeMaxDynamicSharedMemorySize, LDS_BYTES) != hipSuccess) { fprintf(stderr, "kernel_launch: hipFuncSetAttribute failed\n"); grid = -1; return; }
        if (hipOccupancyMaxActiveBlocksPerMultiprocessor(&per_cu, (const void*)mega_fwd, NTHR, LDS_BYTES) != hipSuccess || per_cu < 1) { fprintf(stderr, "kernel_launch: occupancy query gave %d\n", per_cu); per_cu = 1; }
        (void)hipGetLastError();
        grid = cus * (per_cu < 1 ? 1 : 1);
    }
    if (grid < 0) return;
    Args a{};
    for (int i = 0; i < N_IN; ++i) a.in[i] = (const float*)d_in[i];
    a.out = (float*)d_out; a.ws = (unsigned char*)d_ws;
#if MK_N_LAUNCHES == 1
    a.ph_lo = 0; a.ph_hi = N_PHASES; a.sub = 0xff;
    (void)hipMemsetAsync((unsigned char*)d_ws + WS_CTL, 0, CTL_BYTES, stream);
    void* kargs[] = {&a};
    hipError_t e = hipLaunchCooperativeKernel((const void*)mega_fwd, dim3(grid), dim3(NTHR), kargs, LDS_BYTES, stream);
    if (e != hipSuccess) fprintf(stderr, "kernel_launch: cooperative launch failed: %s (grid %d)\n", hipGetErrorString(e), grid);
#ifdef PROBE_EXTRA
    a.ph_lo = PROBE_EXTRA; a.ph_hi = PROBE_EXTRA + 1;
#ifdef PROBE_SUB
    a.sub = PROBE_SUB;
#endif
    hipLaunchKernelGGL(mega_fwd, dim3(grid), dim3(NTHR), LDS_BYTES, stream, a);
#endif
#else
    a.sub = 0xff;
    for (int p = 0; p < N_PHASES; ++p) { a.ph_lo = p; a.ph_hi = p + 1; hipLaunchKernelGGL(mega_fwd, dim3(grid), dim3(NTHR), LDS_BYTES, stream, a); }
#endif
}
```

```cpp
#include <hip/hip_runtime.h>
#include <hip/hip_cooperative_groups.h>
#include <cstdio>
#include <cstdint>
namespace cg = cooperative_groups;
#ifndef MK_N_LAUNCHES
#define MK_N_LAUNCHES 1
#endif
namespace pg8 {
#define PG8_LAS __attribute__((address_space(3)))
typedef unsigned short bf16_t;
typedef short bf16x8 __attribute__((ext_vector_type(8)));
typedef float f32x4 __attribute__((ext_vector_type(4)));
typedef unsigned u32x4 __attribute__((ext_vector_type(4)));
constexpr int BM = 256, BK = 64, HALF = 128, HTB = HALF * BK * 2  , STAGE_BYTES = 8 * HTB, NXCD = 8, WGM = 8;

__host__ __device__ __forceinline__ int lds_byte(int r, int c) { const int st = (r >> 4) * 2 + (c >> 5), rr = r & 15, cc = c & 31, ob = rr * 64 + cc * 2; return st * 1024 + (ob ^ (((ob >> 9) & 1) << 5)); }
__host__ __device__ __forceinline__ void stage_rc(int b, int& R, int& C) { const int st = b / 1024, sb = b % 1024, swz = sb ^ (((sb >> 9) & 1) << 5); R = (st >> 1) * 16 + swz / 64; C = (st & 1) * 32 + (swz % 64) / 2; }
__host__ __device__ __forceinline__ int perm32(int rho) { const int n = rho >> 4, i = rho & 15; return 8 * (i >> 2) + 4 * n + (i & 3); }

struct Unit { int pm, pn; };
struct Gemm { const bf16_t* A; const bf16_t* Bt; int M, N, K; };

struct StaticOrder {
    int nM, nN, nwg, G, c;
    __host__ __device__ void init(int M, int N, int G_, int c_) { nM = M / BM; nN = N / BM; nwg = nM * nN; G = G_; c = c_; }
    __host__ __device__ bool next(int i, Unit& u) const {
        const long L = (long)i * G + c; if (L >= nwg) return false;
        int wgid = (int)L; { const int q = nwg / NXCD, r = nwg % NXCD, xcd = wgid % NXCD, off = wgid / NXCD; wgid = (xcd < r ? xcd * (q + 1) : r * (q + 1) + (xcd - r) * q) + off; }
        const int nig = WGM * nN, gid = wgid / nig, fm = gid * WGM, gsz = (nM - fm) < WGM ? (nM - fm) : WGM;
        u.pm = fm + ((wgid % nig) % gsz); u.pn = (wgid % nig) / gsz; return true;
    }
    __device__ __forceinline__ void a_ready(const Unit&) const {}
    __device__ __forceinline__ void done(const Unit&) const {}
};

__device__ __forceinline__ unsigned cvt_pk_bf16(float lo, float hi) { unsigned r; asm volatile("v_cvt_pk_bf16_f32 %0, %1, %2" : "=v"(r) : "v"(lo), "v"(hi)); return r; }
__device__ __forceinline__ float bflo(unsigned w) { return __uint_as_float(w << 16); }
__device__ __forceinline__ float bfhi(unsigned w) { return __uint_as_float(w & 0xffff0000u); }
__device__ __forceinline__ float sigm(float x) { return 1.0f / (1.0f + __expf(-x)); }
struct EpiStore {
    static constexpr bool PERM = true, AFTER_DRAIN = false;
    bf16_t* O; int ldc; const float* ssq;
    __device__ __forceinline__ void operator()(const f32x4 (&acc)[2][2][4][2], const Unit& u, int wr, int wc, int fr, int fq) const {
        const int row0 = u.pm * BM + wr * 64 + fr, col0 = u.pn * BM + wc * 32 + 8 * fq;
#pragma unroll
        for (int ai = 0; ai < 2; ++ai)
#pragma unroll
            for (int m = 0; m < 4; ++m) { const int row = row0 + ai * HALF + m * 16; bf16_t* rowp = O + (size_t)row * ldc + col0;
                const float sc = ssq ? rsqrtf(ssq[row] * (1.0f / 1024.0f) + 1e-6f) : 1.0f;
#pragma unroll
                for (int bj = 0; bj < 2; ++bj) { const f32x4 v0 = acc[ai][bj][m][0] * sc, v1 = acc[ai][bj][m][1] * sc;
                    u32x4 w; w.x = cvt_pk_bf16(v0[0], v0[1]); w.y = cvt_pk_bf16(v0[2], v0[3]); w.z = cvt_pk_bf16(v1[0], v1[1]); w.w = cvt_pk_bf16(v1[2], v1[3]);
                    *(u32x4*)(rowp + bj * HALF) = w; } }
    }
};
template <int ACCUM> struct EpiMerge {
    static constexpr bool PERM = true, AFTER_DRAIN = false;
    const bf16_t* gate; int ldg; bf16_t* O; int ldc;
    __device__ __forceinline__ void operator()(const f32x4 (&acc)[2][2][4][2], const Unit& u, int wr, int wc, int fr, int fq) const {
        const int row0 = u.pm * BM + wr * 64 + fr, col0 = u.pn * BM + wc * 32 + 8 * fq;
#pragma unroll
        for (int ai = 0; ai < 2; ++ai)
#pragma unroll
            for (int m = 0; m < 4; ++m) { const int row = row0 + ai * HALF + m * 16; bf16_t* rowp = O + (size_t)row * ldc + col0; const bf16_t* gp = gate + (size_t)row * ldg + col0;
#pragma unroll
                for (int bj = 0; bj < 2; ++bj) {
                    const u32x4 g = *(const u32x4*)(gp + bj * HALF);
                    f32x4 v0 = acc[ai][bj][m][0], v1 = acc[ai][bj][m][1];
                    v0[0] *= sigm(bflo(g.x)); v0[1] *= sigm(bfhi(g.x)); v0[2] *= sigm(bflo(g.y)); v0[3] *= sigm(bfhi(g.y));
                    v1[0] *= sigm(bflo(g.z)); v1[1] *= sigm(bfhi(g.z)); v1[2] *= sigm(bflo(g.w)); v1[3] *= sigm(bfhi(g.w));
                    if (ACCUM) { const u32x4 o = *(const u32x4*)(rowp + bj * HALF);
                        v0[0] += bflo(o.x); v0[1] += bfhi(o.x); v0[2] += bflo(o.y); v0[3] += bfhi(o.y);
                        v1[0] += bflo(o.z); v1[1] += bfhi(o.z); v1[2] += bflo(o.w); v1[3] += bfhi(o.w); }
                    u32x4 w; w.x = cvt_pk_bf16(v0[0], v0[1]); w.y = cvt_pk_bf16(v0[2], v0[3]); w.z = cvt_pk_bf16(v1[0], v1[1]); w.w = cvt_pk_bf16(v1[2], v1[3]);
                    *(u32x4*)(rowp + bj * HALF) = w; } }
    }
};
struct EpiWo {
    static constexpr bool PERM = true, AFTER_DRAIN = false;
    const float* xp; const float* xs; float* X1; bf16_t* X1B; float* ssq;
    __device__ __forceinline__ void operator()(const f32x4 (&acc)[2][2][4][2], const Unit& u, int wr, int wc, int fr, int fq) const {
        const int row0 = u.pm * BM + wr * 64 + fr, col0 = u.pn * BM + wc * 32 + 8 * fq;
#pragma unroll
        for (int ai = 0; ai < 2; ++ai)
#pragma unroll
            for (int m = 0; m < 4; ++m) { const int row = row0 + ai * HALF + m * 16;
                const float* xr = row < 16384 ? xp + (size_t)row * 1024 : (row < 16416 ? xs + (size_t)(row - 16384) * 1024 : nullptr);
                float ss = 0.f;
#pragma unroll
                for (int bj = 0; bj < 2; ++bj) { const int col = col0 + bj * HALF;
                    f32x4 x0 = (f32x4){0.f, 0.f, 0.f, 0.f}, x1 = x0;
                    if (xr) { x0 = *(const f32x4*)(xr + col); x1 = *(const f32x4*)(xr + col + 4); }
                    const f32x4 v0 = acc[ai][bj][m][0] + x0, v1 = acc[ai][bj][m][1] + x1;
                    *(f32x4*)(X1 + (size_t)row * 1024 + col) = v0; *(f32x4*)(X1 + (size_t)row * 1024 + col + 4) = v1;
                    u32x4 w; w.x = cvt_pk_bf16(v0[0], v0[1]); w.y = cvt_pk_bf16(v0[2], v0[3]); w.z = cvt_pk_bf16(v1[0], v1[1]); w.w = cvt_pk_bf16(v1[2], v1[3]);
                    *(u32x4*)(X1B + (size_t)row * 1024 + col) = w;
                    ss += (v0[0] * v0[0] + v0[1] * v0[1]) + (v0[2] * v0[2] + v0[3] * v0[3]) + (v1[0] * v1[0] + v1[1] * v1[1]) + (v1[2] * v1[2] + v1[3] * v1[3]); }
                ss += __shfl_xor(ss, 16); ss += __shfl_xor(ss, 32);
                if (fq == 0) atomicAdd(ssq + row, ss); }
    }
};
struct EpiDown {
    static constexpr bool PERM = true, AFTER_DRAIN = false;
    const float* X1; float* yp; float* ys;
    __device__ __forceinline__ void operator()(const f32x4 (&acc)[2][2][4][2], const Unit& u, int wr, int wc, int fr, int fq) const {
        const int row0 = u.pm * BM + wr * 64 + fr, col0 = u.pn * BM + wc * 32 + 8 * fq;
#pragma unroll
        for (int ai = 0; ai < 2; ++ai)
#pragma unroll
            for (int m = 0; m < 4; ++m) { const int row = row0 + ai * HALF + m * 16;
                float* yr = row < 16384 ? yp + (size_t)row * 1024 : (row < 16416 ? ys + (size_t)(row - 16384) * 1024 : nullptr);
                if (!yr) continue;
#pragma unroll
                for (int bj = 0; bj < 2; ++bj) { const int col = col0 + bj * HALF;
                    const f32x4 x0 = *(const f32x4*)(X1 + (size_t)row * 1024 + col), x1 = *(const f32x4*)(X1 + (size_t)row * 1024 + col + 4);
                    *(f32x4*)(yr + col) = acc[ai][bj][m][0] + x0; *(f32x4*)(yr + col + 4) = acc[ai][bj][m][1] + x1; } }
    }
};
template <class Epi, class Sched, bool ALIGN_EPI = false, bool SP2 = false>
__device__ __forceinline__ void gemm_phase(PG8_LAS unsigned char* lds, const Gemm g, const Sched& S, const Epi& E, const int wid) {
    unsigned z_ = 0u; asm volatile("" : "+v"(z_));
    const int lane = (int)__builtin_amdgcn_mbcnt_hi(~0u, __builtin_amdgcn_mbcnt_lo(~0u, z_)), tid = wid * 64 + lane, wr = wid >> 2, wc = wid & 3, fr = lane & 15, fq = lane >> 4;
    const int K = g.K, nt = K / BK;
    unsigned voffA[2], voffB[2];
#pragma unroll
    for (int i = 0; i < 2; ++i) { int R, C; stage_rc(tid * 16 + i * 8192, R, C); const int Rb = Epi::PERM ? ((R & ~31) + perm32(R & 31)) : R;
        voffA[i] = (unsigned)(R * K + C) * 2u; voffB[i] = (unsigned)(Rb * K + C) * 2u; }
    const size_t kstep = (size_t)(BK * 2);
    const size_t hstep = (size_t)HALF * K * 2;
    const size_t tstep = 2 * hstep;
    const unsigned ldsw = (unsigned)wid * 1024u;
    const int aoff = lds_byte(wr * 64 + fr, fq * 8), boff = lds_byte(wc * 32 + fr, fq * 8);
#define PG8_SA(b, h) (((b) * 2 + (h)) * HTB)
#define PG8_SB(b, h) ((4 + (b) * 2 + (h)) * HTB)
#define PG8_STAGE(bufoff, gbase, voff) do { _Pragma("unroll") for (int _i = 0; _i < 2; ++_i) \
        __builtin_amdgcn_global_load_lds((const unsigned*)((const char*)(gbase) + (voff)[_i]), (PG8_LAS unsigned*)(lds + (bufoff) + ldsw + _i * 8192), 16, 0, 0); } while (0)
#define PG8_LDA(dst, b, h) do { _Pragma("unroll") for (int m = 0; m < 4; ++m) _Pragma("unroll") for (int k = 0; k < 2; ++k) dst[m][k] = *(const PG8_LAS bf16x8*)(lds + PG8_SA(b, h) + aoff + m * 2048 + k * 1024); } while (0)
#define PG8_LDB(dst, b, h) do { _Pragma("unroll") for (int n = 0; n < 2; ++n) _Pragma("unroll") for (int k = 0; k < 2; ++k) dst[n][k] = *(const PG8_LAS bf16x8*)(lds + PG8_SB(b, h) + boff + n * 2048 + k * 1024); } while (0)
#define PG8_MMA(ai, bj, At, Bt) do { __builtin_amdgcn_s_setprio(1); _Pragma("unroll") for (int m = 0; m < 4; ++m) _Pragma("unroll") for (int n = 0; n < 2; ++n) _Pragma("unroll") for (int k = 0; k < 2; ++k) \
        acc[ai][bj][m][n] = __builtin_amdgcn_mfma_f32_16x16x32_bf16(Bt[n][k], At[m][k], acc[ai][bj][m][n], 0, 0, 0); __builtin_amdgcn_s_setprio(0); } while (0)
#define PG8_WAIT_V(n) asm volatile("s_waitcnt vmcnt(" #n ")" ::: "memory")
#define PG8_WAIT_L(n) asm volatile("s_waitcnt lgkmcnt(" #n ")" ::: "memory")
#define PG8_BAR __builtin_amdgcn_s_barrier()
#define PG8_SCHED __builtin_amdgcn_sched_barrier(0)
    Unit cur, nxt; int ui = 0;
    if (!S.next(0, cur)) return;
    f32x4 acc[2][2][4][2];
#pragma unroll
    for (int a = 0; a < 2; ++a)
#pragma unroll
        for (int b = 0; b < 2; ++b)
#pragma unroll
            for (int m = 0; m < 4; ++m)
#pragma unroll
                for (int n = 0; n < 2; ++n) acc[a][b][m][n] = (f32x4){0.f, 0.f, 0.f, 0.f};
    bf16x8 At[4][2], B0[2][2], B1[2][2];
    const char* cA = (const char*)g.A + (size_t)cur.pm * tstep; const char* cB = (const char*)g.Bt + (size_t)cur.pn * tstep;
    S.a_ready(cur);
    if constexpr (SP2) {
        PG8_STAGE(PG8_SB(0, 0), cB, voffB); PG8_STAGE(PG8_SB(0, 1), cB + hstep, voffB); PG8_STAGE(PG8_SA(0, 0), cA, voffA); PG8_STAGE(PG8_SA(0, 1), cA + hstep, voffA);
        if (wr == 1) PG8_BAR;
        PG8_WAIT_V(2); PG8_BAR;
        PG8_STAGE(PG8_SB(1, 0), cB + kstep, voffB); PG8_STAGE(PG8_SA(1, 0), cA + kstep, voffA); PG8_STAGE(PG8_SB(1, 1), cB + hstep + kstep, voffB);
        PG8_WAIT_V(6); PG8_BAR;
    } else {
        PG8_STAGE(PG8_SB(0, 0), cB, voffB); PG8_STAGE(PG8_SA(0, 0), cA, voffA); PG8_STAGE(PG8_SB(0, 1), cB + hstep, voffB); PG8_STAGE(PG8_SA(0, 1), cA + hstep, voffA);
        if (wr == 1) PG8_BAR;
        PG8_WAIT_V(4); PG8_BAR;
        PG8_STAGE(PG8_SB(1, 0), cB + kstep, voffB); PG8_STAGE(PG8_SA(1, 0), cA + kstep, voffA); PG8_STAGE(PG8_SB(1, 1), cB + hstep + kstep, voffB);
        PG8_WAIT_V(6); PG8_BAR;
    }
    for (;;) {
        const bool has_next = S.next(ui + 1, nxt);
        const char* nA = has_next ? (const char*)g.A + (size_t)nxt.pm * tstep : cA; const char* nB = has_next ? (const char*)g.Bt + (size_t)nxt.pn * tstep : cB;
        for (int t = 0; t < nt; t += 2) {
            const bool last = (t == nt - 2);
            const char* a1 = cA + (size_t)(t + 1) * kstep;
            const char* a2 = last ? nA : cA + (size_t)(t + 2) * kstep; const char* b2 = last ? nB : cB + (size_t)(t + 2) * kstep;
            const char* a3 = a2 + kstep; const char* b3 = b2 + kstep;
            if (last && has_next) S.a_ready(nxt);
            if constexpr (SP2) {
            PG8_LDB(B0, 0, 0); PG8_LDB(B1, 0, 1); PG8_SCHED; PG8_LDA(At, 0, 0); PG8_STAGE(PG8_SA(1, 1), a1 + hstep, voffA);
            PG8_WAIT_V(8); PG8_WAIT_L(0); PG8_BAR; PG8_MMA(0, 0, At, B0); PG8_MMA(0, 1, At, B1); PG8_BAR; PG8_SCHED;
            PG8_LDA(At, 0, 1); PG8_STAGE(PG8_SB(0, 0), b2, voffB); PG8_STAGE(PG8_SB(0, 1), b2 + hstep, voffB); PG8_STAGE(PG8_SA(0, 0), a2, voffA);
            PG8_WAIT_V(8); PG8_WAIT_L(0); PG8_BAR; PG8_MMA(1, 0, At, B0); PG8_MMA(1, 1, At, B1); PG8_BAR; PG8_SCHED;
            PG8_LDB(B0, 1, 0); PG8_LDB(B1, 1, 1); PG8_SCHED; PG8_LDA(At, 1, 0); PG8_STAGE(PG8_SA(0, 1), a2 + hstep, voffA);
            PG8_WAIT_V(8); PG8_WAIT_L(0); PG8_BAR; PG8_MMA(0, 0, At, B0); PG8_MMA(0, 1, At, B1); PG8_BAR; PG8_SCHED;
            PG8_LDA(At, 1, 1); PG8_STAGE(PG8_SB(1, 0), b3, voffB); PG8_STAGE(PG8_SB(1, 1), b3 + hstep, voffB); PG8_STAGE(PG8_SA(1, 0), a3, voffA);
            PG8_WAIT_V(8); PG8_WAIT_L(0); PG8_BAR; PG8_MMA(1, 0, At, B0); PG8_MMA(1, 1, At, B1); PG8_BAR; PG8_SCHED;
            } else {
            PG8_LDB(B0, 0, 0); PG8_SCHED; PG8_LDA(At, 0, 0); PG8_STAGE(PG8_SA(1, 1), a1 + hstep, voffA);
            PG8_WAIT_L(8); PG8_BAR; PG8_WAIT_L(0); PG8_MMA(0, 0, At, B0); PG8_BAR; PG8_SCHED;
            PG8_LDB(B1, 0, 1); PG8_STAGE(PG8_SB(0, 0), b2, voffB);
            PG8_BAR; PG8_WAIT_L(0); PG8_MMA(0, 1, At, B1); PG8_BAR;
            PG8_LDA(At, 0, 1); PG8_STAGE(PG8_SA(0, 0), a2, voffA);
            PG8_BAR; PG8_WAIT_L(0); PG8_MMA(1, 0, At, B0); PG8_BAR; PG8_SCHED;
            PG8_STAGE(PG8_SB(0, 1), b2 + hstep, voffB);
            PG8_WAIT_V(6); PG8_BAR; PG8_MMA(1, 1, At, B1); PG8_BAR;
            PG8_LDB(B0, 1, 0); PG8_SCHED; PG8_LDA(At, 1, 0); PG8_STAGE(PG8_SA(0, 1), a2 + hstep, voffA);
            PG8_WAIT_L(8); PG8_BAR; PG8_WAIT_L(0); PG8_MMA(0, 0, At, B0); PG8_BAR; PG8_SCHED;
            PG8_LDB(B1, 1, 1); PG8_STAGE(PG8_SB(1, 0), b3, voffB);
            PG8_BAR; PG8_WAIT_L(0); PG8_MMA(0, 1, At, B1); PG8_BAR;
            PG8_LDA(At, 1, 1); PG8_STAGE(PG8_SA(1, 0), a3, voffA);
            PG8_BAR; PG8_WAIT_L(0); PG8_MMA(1, 0, At, B0); PG8_BAR; PG8_SCHED;
            PG8_STAGE(PG8_SB(1, 1), b3 + hstep, voffB);
            PG8_WAIT_V(6); PG8_BAR; PG8_MMA(1, 1, At, B1); PG8_BAR;
            }
        }
        if constexpr (ALIGN_EPI) { if (wr == 0) PG8_BAR; }
        if constexpr (!Epi::AFTER_DRAIN) { E(acc, cur, wr, wc, fr, fq); S.done(cur); }
        if (!has_next) break;
#pragma unroll
        for (int a = 0; a < 2; ++a)
#pragma unroll
            for (int b = 0; b < 2; ++b)
#pragma unroll
                for (int m = 0; m < 4; ++m)
#pragma unroll
                    for (int n = 0; n < 2; ++n) acc[a][b][m][n] = (f32x4){0.f, 0.f, 0.f, 0.f};
        cur = nxt; cA = nA; cB = nB; ++ui;
        if constexpr (ALIGN_EPI) { if (wr == 1) PG8_BAR; }
    }
    PG8_WAIT_V(0);
    if constexpr (!ALIGN_EPI) { if (wr == 0) PG8_BAR; }
    PG8_BAR;
    if constexpr (Epi::AFTER_DRAIN) { E.fused(acc, cur, wr, wc, fr, fq, lds, wid, lane); S.done(cur); }
#undef PG8_SA
#undef PG8_SB
#undef PG8_STAGE
#undef PG8_LDA
#undef PG8_LDB
#undef PG8_MMA
#undef PG8_WAIT_V
#undef PG8_WAIT_L
#undef PG8_BAR
#undef PG8_SCHED
}
}

typedef unsigned short bf16;
typedef short bf16x8 __attribute__((ext_vector_type(8)));
typedef short bf16x4 __attribute__((ext_vector_type(4)));
typedef float f32x4 __attribute__((ext_vector_type(4)));
typedef unsigned u32x4 __attribute__((ext_vector_type(4)));
typedef unsigned u32x2 __attribute__((ext_vector_type(2)));
#define LAS __attribute__((address_space(3)))
constexpr int NWAVES = 8, NTHR = 512;
constexpr int DM = 1024, T = 8192, NB = 2, NTOKP = NB * T, SB = 32, NTOK = NTOKP + SB, MPAD = 16640;
constexpr int DIN = 6440, DINP = 6656, DFF = 2816, DUP = 2 * DFF;
constexpr int C_Q = 0, C_KV = 512, C_G = 1280, C_GQ = 1304, C_GK = 1560, C_GV = 1816, C_LR = 2328, C_GR = 2344, C_XQ = 2856, C_MG = 3368;
constexpr float EPS = 1e-6f, LOG2E = 1.4426950408889634f;
constexpr float QSCALE = 0.125f * LOG2E;
constexpr float XSCALE = 0.08838834764831845f * LOG2E;
constexpr size_t O_Y = 0, O_YS = 16777216, O_KVP = O_YS + 32768, O_WINP = O_KVP + 8388608, O_GLAP = O_WINP + 262144, O_CONVP = O_GLAP + 65536,
                 O_MEMP = O_CONVP + 11264, O_KVS = O_MEMP + 524288, O_WINS = O_KVS + 16384, O_GLAS = O_WINS + 4194304, O_CONVS = O_GLAS + 1048576, O_END = O_CONVS + 180224;
enum { I_XP = 0, I_XS, I_CKV, I_CWIN, I_SGLA, I_SCONV, I_CMEM, I_PT, I_MEMP, I_GMIX, I_WIN, I_GNQ, I_GNK, I_CKPE, I_CKW1, I_CKW2, I_CVPE, I_CVW1, I_CVW2,
       I_RB, I_WGG, I_BGG, I_GGO, I_GMEM, I_WMEM, I_GXQ, I_GXK, I_WNSA, I_WGLA, I_WX, I_WO, I_GFFN, I_WUP, I_CONVW, I_CONVB, I_WDOWN, N_IN };
constexpr size_t al_(size_t x) { return (x + 255) & ~(size_t)255; }
constexpr size_t WS_SSQ = 0;
constexpr size_t WS_C0 = al_(WS_SSQ + (size_t)MPAD * 4);
constexpr size_t WS_WTIN = al_(WS_C0 + 1024);
constexpr size_t WS_WTMEM = al_(WS_WTIN + (size_t)DINP * 1024 * 2);
constexpr size_t WS_WTNSA = al_(WS_WTMEM + (size_t)1024 * 1024 * 2);
constexpr size_t WS_WTGLA = al_(WS_WTNSA + (size_t)1024 * 512 * 2);
constexpr size_t WS_WTX = al_(WS_WTGLA + (size_t)1024 * 512 * 2);
constexpr size_t WS_WTO = al_(WS_WTX + (size_t)1024 * 512 * 2);
constexpr size_t WS_WTUP = al_(WS_WTO + (size_t)1024 * 1024 * 2);
constexpr size_t WS_WTDOWN = al_(WS_WTUP + (size_t)DUP * 1024 * 2);
constexpr size_t WS_W1T = al_(WS_WTDOWN + (size_t)1024 * DFF * 2);
constexpr size_t WS_W2T = al_(WS_W1T + (size_t)2 * 64 * 2048 * 2);
constexpr size_t WS_XN = al_(WS_W2T + (size_t)2 * 64 * 64 * 2);
constexpr size_t WS_MN = al_(WS_XN + (size_t)MPAD * 1024 * 2);
constexpr size_t WS_PROJ = al_(WS_MN + (size_t)512 * 1024 * 2);
constexpr size_t WS_MEMPROJ = al_(WS_PROJ + (size_t)MPAD * DINP * 2);
constexpr size_t WS_QN = al_(WS_MEMPROJ + (size_t)512 * 1024 * 2);
constexpr size_t WS_KSEL = al_(WS_QN + (size_t)NTOK * 512 * 2);
constexpr size_t WS_VSELT = al_(WS_KSEL + (size_t)4 * T * 64 * 2);
constexpr size_t WS_KWIN = al_(WS_VSELT + (size_t)4 * T * 64 * 2);
constexpr size_t WS_VWINT = al_(WS_KWIN + (size_t)4 * T * 64 * 2);
constexpr size_t WS_GATES = al_(WS_VWINT + (size_t)4 * T * 64 * 2);
constexpr size_t WS_NEWKV = al_(WS_GATES + (size_t)NTOK * 24 * 4);
constexpr size_t WS_KCMP = al_(WS_NEWKV + (size_t)SB * 4 * 2 * 64 * 4);
constexpr size_t WS_VCMPT = al_(WS_KCMP + (size_t)4 * 512 * 64 * 2);
constexpr size_t WS_KCMPS = al_(WS_VCMPT + (size_t)4 * 512 * 64 * 2);
constexpr size_t WS_VCMPS = al_(WS_KCMPS + (size_t)SB * 2 * 512 * 64 * 4);
constexpr size_t WS_QTG = al_(WS_VCMPS + (size_t)SB * 2 * 512 * 64 * 4);
constexpr size_t WS_KTG = al_(WS_QTG + (size_t)NTOKP * 256 * 2);
constexpr size_t WS_VTG = al_(WS_KTG + (size_t)NTOKP * 256 * 2);
constexpr size_t WS_UP = al_(WS_VTG + (size_t)256 * 4 * 128 * 64 * 2);
constexpr size_t WS_DEC = al_(WS_UP + (size_t)256 * 4 * 128 * 64 * 4);
constexpr size_t WS_SC = al_(WS_DEC + (size_t)256 * 4 * 64 * 4);
constexpr size_t WS_XQ = al_(WS_SC + (size_t)256 * 4 * 128 * 64 * 2);
constexpr size_t WS_KMEM = al_(WS_XQ + (size_t)NTOK * 512 * 2);
constexpr size_t WS_VMEMT = al_(WS_KMEM + (size_t)8 * 256 * 128 * 2);
constexpr size_t WS_ONSA = al_(WS_VMEMT + (size_t)8 * 256 * 128 * 2);
constexpr size_t WS_OGLA = al_(WS_ONSA + (size_t)MPAD * 512 * 2);
constexpr size_t WS_OX = al_(WS_OGLA + (size_t)MPAD * 512 * 2);
constexpr size_t WS_MERGED = al_(WS_OX + (size_t)MPAD * 512 * 2);
constexpr size_t WS_X1 = al_(WS_MERGED + (size_t)MPAD * 1024 * 2);
constexpr size_t WS_X1B = al_(WS_X1 + (size_t)MPAD * 1024 * 4);
constexpr size_t WS_UG = al_(WS_X1B + (size_t)MPAD * 1024 * 2);
constexpr size_t WS_ACT = al_(WS_UG + (size_t)MPAD * DUP * 2);
constexpr size_t WS_MS = al_(WS_ACT + (size_t)MPAD * DFF * 2);
constexpr size_t WS_X1S = al_(WS_MS + (size_t)SB * 1024 * 4);
constexpr size_t WS_ONS = al_(WS_X1S + (size_t)SB * 1024 * 4);
constexpr size_t WS_PARK = al_(WS_ONS + (size_t)SB * 512 * 4);
constexpr size_t WS_CTL = al_(WS_PARK + (size_t)2048 * 4096);
constexpr size_t CTL_BYTES = 16384;
constexpr size_t WS_END = al_(WS_CTL + CTL_BYTES);
constexpr int RING_BYTES = 131072, LDS_BYTES = 155648;

struct Args { const float* in[N_IN]; float* out; unsigned char* ws; int ph_lo, ph_hi, sub, pad; };

__device__ __forceinline__ unsigned f2bf(float f) { unsigned u = __float_as_uint(f); return (u + 0x7fffu + ((u >> 16) & 1u)) >> 16; }
__device__ __forceinline__ unsigned pk2(float lo, float hi) { return pg8::cvt_pk_bf16(lo, hi); }
__device__ __forceinline__ float bf2f(unsigned short u) { return __uint_as_float((unsigned)u << 16); }
__device__ __forceinline__ float bflo(unsigned w) { return __uint_as_float(w << 16); }
__device__ __forceinline__ float bfhi(unsigned w) { return __uint_as_float(w & 0xffff0000u); }
__device__ __forceinline__ void unpack8(const u32x4 w, float (&f)[8]) { f[0] = bflo(w.x); f[1] = bfhi(w.x); f[2] = bflo(w.y); f[3] = bfhi(w.y); f[4] = bflo(w.z); f[5] = bfhi(w.z); f[6] = bflo(w.w); f[7] = bfhi(w.w); }
__device__ __forceinline__ u32x4 pack8(const float (&f)[8]) { u32x4 w; w.x = pk2(f[0], f[1]); w.y = pk2(f[2], f[3]); w.z = pk2(f[4], f[5]); w.w = pk2(f[6], f[7]); return w; }
__device__ __forceinline__ bf16x8 as_frag(u32x4 w) { return __builtin_bit_cast(bf16x8, w); }
__device__ __forceinline__ bf16x8 frag_pk(f32x4 a, f32x4 b) { u32x4 w; w.x = pk2(a[0], a[1]); w.y = pk2(a[2], a[3]); w.z = pk2(b[0], b[1]); w.w = pk2(b[2], b[3]); return as_frag(w); }
__device__ __forceinline__ bf16x8 ldfrag(const bf16* p) { return as_frag(*(const u32x4*)p); }
__device__ __forceinline__ bf16x8 ldfrag2(const bf16* p0, const bf16* p1) { const u32x2 a = *(const u32x2*)p0, b = *(const u32x2*)p1; u32x4 w; w.x = a.x; w.y = a.y; w.z = b.x; w.w = b.y; return as_frag(w); }
__device__ __forceinline__ bf16x8 ldfrag_f32(const float* p) { const f32x4 a = *(const f32x4*)p, b = *(const f32x4*)(p + 4); return frag_pk(a, b); }
#define MFMA16(a, b, c) __builtin_amdgcn_mfma_f32_16x16x32_bf16((a), (b), (c), 0, 0, 0)
__device__ __forceinline__ float sigmoidf_(float x) { return 1.0f / (1.0f + __expf(-x)); }
__device__ __forceinline__ float gelu_tanh(float x) { const float u = 0.7978845608028654f * (x + 0.044715f * x * x * x); const float e = __expf(2.0f * u); return 0.5f * x * (2.0f - 2.0f / (e + 1.0f)); }
__device__ __forceinline__ float wave_sum(float v) {
#pragma unroll
    for (int o = 1; o < 64; o <<= 1) v += __shfl_xor(v, o);
    return v;
}
__device__ __forceinline__ float wave_max(float v) {
#pragma unroll
    for (int o = 1; o < 64; o <<= 1) v = fmaxf(v, __shfl_xor(v, o));
    return v;
}
__device__ __forceinline__ float absmax_arr(const float* g, int n, int lane) { float m = 0.f; for (int i = lane; i < n; i += 64) m = fmaxf(m, fabsf(g[i])); return wave_max(m); }
__device__ __forceinline__ int t5_bucket(int n) {
    if (n < 16) return n;
    if (n >= 128) return 31;
    const int v = 16 + (int)(__logf((float)n * 0.0625f) / 2.0794415416798357f * 16.0f);
    return v < 31 ? v : 31;
}

#define XB_TMO      128
#define XB_XCNT(j)  (256  + 64 * (j))
#define XB_XSUB(j)  (1280 + 64 * (j))
#define XB_XGEN(j)  (2304 + 64 * (j))
#define XB_TOP      3328
#define XB_TOPGEN   3392
#define XCD_BAR_WORDS 3456
#define XB_SPIN_CAP (1u << 18)

__device__ __forceinline__ unsigned xb_ld(unsigned* p)              { return __hip_atomic_load(p, __ATOMIC_RELAXED, __HIP_MEMORY_SCOPE_AGENT); }
__device__ __forceinline__ unsigned xb_add(unsigned* p, unsigned v) { return __hip_atomic_fetch_add(p, v, __ATOMIC_RELAXED, __HIP_MEMORY_SCOPE_AGENT); }
__device__ __forceinline__ unsigned xb_xcc_id() { return (unsigned)__builtin_amdgcn_s_getreg((3 << 11) | 20) & 0xFu; }
#define XB_SPIN(cond, bar) do { unsigned _sp = 0; while (cond) { __builtin_amdgcn_s_sleep(1); \
    if ((++_sp & 255u) == 0u) { if (xb_ld(&(bar)[XB_TMO])) break; if (_sp > XB_SPIN_CAP) { atomicAdd(&(bar)[XB_TMO], 1u); break; } } } } while (0)

struct XcdBarrier {
    unsigned* bar; unsigned x;
    volatile LAS unsigned* st;
};

__device__ __forceinline__ XcdBarrier xcd_barrier_post(unsigned* bar, volatile LAS unsigned* st) {
    XcdBarrier b; b.bar = bar; b.x = xb_xcc_id(); b.st = st;
    if (threadIdx.x == 0) (void)xb_add(&bar[XB_XCNT(b.x)], 1u);
    return b;
}
__device__ __forceinline__ void xcd_barrier_complete(unsigned* bar, unsigned x, unsigned& nloc, unsigned& nx) {
    const unsigned G = gridDim.x * gridDim.y * gridDim.z;
    unsigned sum, cnt, mine, sp = 0u;
    for (;;) {
        sum = 0u; cnt = 0u; mine = 0u;
#pragma unroll
        for (unsigned j = 0; j < 16; ++j) { const unsigned c = xb_ld(&bar[XB_XCNT(j)]); sum += c; cnt += (c > 0u) ? 1u : 0u; mine = (j == x) ? c : mine; }
        if (sum == G) break;
        __builtin_amdgcn_s_sleep(1);
        if ((++sp & 255u) == 0u) { if (xb_ld(&bar[XB_TMO])) break; if (sp > XB_SPIN_CAP) { atomicAdd(&bar[XB_TMO], 1u); break; } }
    }
    nloc = mine > 0u ? mine : 1u; nx = cnt > 0u ? cnt : 1u;
}

__device__ __forceinline__ void xcd_barrier(const XcdBarrier& b) {
    asm volatile("s_waitcnt vmcnt(0)" ::: "memory");
    __syncthreads();
    if (threadIdx.x == 0) {
        unsigned* bar = b.bar;
        __builtin_amdgcn_s_waitcnt(0);
        unsigned nloc = b.st[0], nx = b.st[1];
        if (nloc == 0u) { xcd_barrier_complete(bar, b.x, nloc, nx); b.st[0] = nloc; b.st[1] = nx; }
        const unsigned old = xb_add(&bar[XB_XSUB(b.x)], 1u);
        const unsigned gen = old / nloc;
        if (old + 1u == (gen + 1u) * nloc) {
            __builtin_amdgcn_fence(__ATOMIC_RELEASE, "agent");
            asm volatile("s_waitcnt vmcnt(0)" ::: "memory");
            const unsigned og = xb_add(&bar[XB_TOP], 1u);
            const unsigned tg = og / nx;
            if (og + 1u == (tg + 1u) * nx) xb_add(&bar[XB_TOPGEN], 1u);
            else XB_SPIN(xb_ld(&bar[XB_TOPGEN]) == tg, bar);
            __builtin_amdgcn_fence(__ATOMIC_ACQUIRE, "agent");
            xb_add(&bar[XB_XGEN(b.x)], 1u);
            asm volatile("s_waitcnt vmcnt(0)" ::: "memory");
        } else {
            XB_SPIN(xb_ld(&bar[XB_XGEN(b.x)]) == gen, bar);
            __builtin_amdgcn_fence(__ATOMIC_ACQUIRE, "agent");
            asm volatile("s_waitcnt vmcnt(0)" ::: "memory");
        }
    }
    __syncthreads();
}

struct Frame {
    LAS unsigned char* lds;
    int wave, G, bid, gw, NGW;
    const float* const* in; float* out; unsigned char* ws;
};
#define WSP(T_, off) ((T_*)(F.ws + (off)))
__device__ __forceinline__ int lane_id_() { unsigned z = 0u; asm volatile("" : "+v"(z)); return (int)__builtin_amdgcn_mbcnt_hi(~0u, __builtin_amdgcn_mbcnt_lo(~0u, z)); }
#define LANE_ lane_id_()
#define TID_ (F.wave * 64 + lane_id_())

__device__ __forceinline__ void transpose_item(const float* W, int K, int N, bf16* WT, const float* kscale, LAS float* scr, int item, int nblk, int lane) {
    const int kb = item / nblk, nb = item % nblk, k0 = 64 * kb, n0 = 32 * nb;
#pragma unroll
    for (int i = 0; i < 8; ++i) { const int kk = 8 * i + (lane >> 3); const int n = n0 + 4 * (lane & 7);
        f32x4 v = n < N ? *(const f32x4*)(W + (size_t)(k0 + kk) * N + n) : (f32x4){0.f, 0.f, 0.f, 0.f}; if (kscale) v = v * kscale[k0 + kk];
        LAS float* d = scr + kk * 33 + 4 * (lane & 7); d[0] = v[0]; d[1] = v[1]; d[2] = v[2]; d[3] = v[3]; }
    asm volatile("s_waitcnt lgkmcnt(0)" ::: "memory");
    const int c = lane & 7;
#pragma unroll
    for (int j = 0; j < 4; ++j) { const int n = (lane >> 3) + 8 * j; const LAS float* s = scr + (8 * c) * 33 + n;
        u32x4 o; o.x = pk2(s[0 * 33], s[1 * 33]); o.y = pk2(s[2 * 33], s[3 * 33]); o.z = pk2(s[4 * 33], s[5 * 33]); o.w = pk2(s[6 * 33], s[7 * 33]);
        *(u32x4*)(WT + (size_t)(n0 + n) * K + k0 + 8 * c) = o; }
    asm volatile("s_waitcnt lgkmcnt(0)" ::: "memory");
}
__device__ __forceinline__ void rms_row_to_bf16(const float* xrow, const float* g, bf16* orow, int lane) {
    unsigned long long* o8 = (unsigned long long*)orow + lane;
    if (!xrow) {
#pragma unroll
        for (int j = 0; j < 4; ++j) o8[64 * j] = 0ull;
        return; }
    const f32x4* xr = (const f32x4*)xrow + lane; const f32x4* gr = (const f32x4*)g + lane;
    f32x4 v[4]; float s = 0.f;
#pragma unroll
    for (int j = 0; j < 4; ++j) { v[j] = xr[64 * j]; s += (v[j].x * v[j].x + v[j].y * v[j].y) + (v[j].z * v[j].z + v[j].w * v[j].w); }
    const float rs = rsqrtf(wave_sum(s) * (1.f / 1024.f) + EPS);
#pragma unroll
    for (int j = 0; j < 4; ++j) { const f32x4 gg = gr[64 * j]; const f32x4 y = v[j] * rs * gg;
        o8[64 * j] = (unsigned long long)pk2(y.x, y.y) | ((unsigned long long)pk2(y.z, y.w) << 32); }
}
__device__ __forceinline__ void p0_prologue(Frame& F) {
    LAS float* scr = (LAS float*)(F.lds + F.wave * 16384);
    const int gw = F.gw, NGW = F.NGW;
    constexpr int IT_IN = 16 * 208, IT_MEM = 16 * 32, IT_BR = 8 * 32, IT_O = 16 * 32, IT_UP = 16 * 176, IT_DOWN = 44 * 32, IT_W1 = 32 * 2, IT_W2 = 1 * 2;
    constexpr int NITEMS = IT_IN + IT_MEM + 3 * IT_BR + IT_O + IT_UP + IT_DOWN + 2 * IT_W1 + 2 * IT_W2;
    const int ipw = (NITEMS + NGW - 1) / NGW;
    for (int it = gw * ipw; it < NITEMS && it < (gw + 1) * ipw; ++it) {
        int r = it;
        if (r < IT_UP) { transpose_item(F.in[I_WUP], 1024, DUP, WSP(bf16, WS_WTUP), F.in[I_GFFN], scr, r, 176, LANE_); continue; } r -= IT_UP;
        if (r < IT_IN) { transpose_item(F.in[I_WIN], 1024, DIN, WSP(bf16, WS_WTIN), nullptr, scr, r, 208, LANE_); continue; } r -= IT_IN;
        if (r < IT_DOWN) { transpose_item(F.in[I_WDOWN], DFF, 1024, WSP(bf16, WS_WTDOWN), nullptr, scr, r, 32, LANE_); continue; } r -= IT_DOWN;
        if (r < IT_MEM) { transpose_item(F.in[I_WMEM], 1024, 1024, WSP(bf16, WS_WTMEM), nullptr, scr, r, 32, LANE_); continue; } r -= IT_MEM;
        if (r < IT_O) { transpose_item(F.in[I_WO], 1024, 1024, WSP(bf16, WS_WTO), nullptr, scr, r, 32, LANE_); continue; } r -= IT_O;
        if (r < IT_BR) { transpose_item(F.in[I_WNSA], 512, 1024, WSP(bf16, WS_WTNSA), nullptr, scr, r, 32, LANE_); continue; } r -= IT_BR;
        if (r < IT_BR) { transpose_item(F.in[I_WGLA], 512, 1024, WSP(bf16, WS_WTGLA), nullptr, scr, r, 32, LANE_); continue; } r -= IT_BR;
        if (r < IT_BR) { transpose_item(F.in[I_WX], 512, 1024, WSP(bf16, WS_WTX), nullptr, scr, r, 32, LANE_); continue; } r -= IT_BR;
        if (r < IT_W1) { transpose_item(F.in[I_CKW1], 2048, 64, WSP(bf16, WS_W1T), nullptr, scr, r, 2, LANE_); continue; } r -= IT_W1;
        if (r < IT_W1) { transpose_item(F.in[I_CVW1], 2048, 64, WSP(bf16, WS_W1T) + 64 * 2048, nullptr, scr, r, 2, LANE_); continue; } r -= IT_W1;
        if (r < IT_W2) { transpose_item(F.in[I_CKW2], 64, 64, WSP(bf16, WS_W2T), nullptr, scr, r, 2, LANE_); continue; } r -= IT_W2;
        transpose_item(F.in[I_CVW2], 64, 64, WSP(bf16, WS_W2T) + 64 * 64, nullptr, scr, r, 2, LANE_);
    }
    for (int m = gw; m < MPAD + 512; m += NGW) {
        if (m < MPAD) { const float* xr = m < NTOKP ? F.in[I_XP] + (size_t)m * 1024 : (m < NTOK ? F.in[I_XS] + (size_t)(m - NTOKP) * 1024 : nullptr);
            rms_row_to_bf16(xr, F.in[I_GMIX], WSP(bf16, WS_XN) + (size_t)m * 1024, LANE_); }
        else { const int mm = m - MPAD; rms_row_to_bf16(F.in[I_MEMP] + (size_t)mm * 1024, F.in[I_GMEM], WSP(bf16, WS_MN) + (size_t)mm * 1024, LANE_); }
    }
    { float* ssq = WSP(float, WS_SSQ); for (int i = F.bid * NTHR + TID_; i < MPAD; i += F.G * NTHR) ssq[i] = 0.f; }
    { float* ms = WSP(float, WS_MS); float* x1s = WSP(float, WS_X1S); const float* xs = F.in[I_XS];
      for (int i = F.bid * NTHR + TID_; i < SB * 1024; i += F.G * NTHR) { ms[i] = 0.f; x1s[i] = xs[i]; }
      float* ons = WSP(float, WS_ONS); for (int i = F.bid * NTHR + TID_; i < SB * 512; i += F.G * NTHR) ons[i] = 0.f; }
    { const f32x4* src = (const f32x4*)F.in[I_CWIN]; f32x4* dst = (f32x4*)(F.out + O_WINS);
      for (int i = F.bid * NTHR + TID_; i < SB * 511 * 64; i += F.G * NTHR) { const int b = i / (511 * 64), r = i % (511 * 64); dst[(size_t)b * 512 * 64 + r] = src[(size_t)b * 512 * 64 + 64 + r]; } }
}

__device__ __forceinline__ void p2_token(Frame& F, int tok) {
    const int lane = LANE_; const bf16* pr = WSP(bf16, WS_PROJ) + (size_t)tok * DINP;
    const bool prompt = tok < NTOKP; const int b = tok >> 13, t = tok & (T - 1), sb = tok - NTOKP;
    float f[8];
    { unpack8(*(const u32x4*)(pr + C_Q + 8 * lane), f); float ss = 0.f;
#pragma unroll
      for (int i = 0; i < 8; ++i) ss += f[i] * f[i];
      ss += __shfl_xor(ss, 1); ss += __shfl_xor(ss, 2); ss += __shfl_xor(ss, 4);
      const float rs = rsqrtf(ss * (1.f / 64.f) + EPS) * QSCALE; const float* g = F.in[I_GNQ] + 8 * (lane & 7);
#pragma unroll
      for (int i = 0; i < 8; ++i) f[i] *= rs * g[i];
      *(u32x4*)(WSP(bf16, WS_QN) + (size_t)tok * 512 + 8 * lane) = pack8(f); }
    { unpack8(*(const u32x4*)(pr + C_KV + 8 * lane), f); float ss = 0.f;
#pragma unroll
      for (int i = 0; i < 8; ++i) ss += f[i] * f[i];
      ss += __shfl_xor(ss, 1); ss += __shfl_xor(ss, 2); ss += __shfl_xor(ss, 4);
      const int grp = lane >> 3, slot = grp >> 1, kv = grp & 1, d0 = 8 * (lane & 7);
      if (slot == 2) { const float rs = rsqrtf(ss * (1.f / 64.f) + EPS); const float* g = F.in[I_GNK] + 64 + d0;
#pragma unroll
          for (int i = 0; i < 8; ++i) f[i] *= rs * g[i]; }
      float* orow = prompt ? F.out + O_KVP + (size_t)tok * 512 + 8 * lane : F.out + O_KVS + (size_t)sb * 512 + 8 * lane;
      *(f32x4*)orow = (f32x4){f[0], f[1], f[2], f[3]}; *(f32x4*)(orow + 4) = (f32x4){f[4], f[5], f[6], f[7]};
      if (prompt) {
          if (slot == 2) *(u32x4*)(WSP(bf16, WS_KSEL) + ((size_t)(b * 2 + kv) * T + t) * 64 + d0) = pack8(f);
          if (slot == 3) { bf16* vt = WSP(bf16, WS_VSELT) + (((size_t)(b * 2 + kv) * 128 + (t >> 6)) * 64 + d0) * 64 + (t & 63);
#pragma unroll
              for (int i = 0; i < 8; ++i) vt[i * 64] = (bf16)f2bf(f[i]); }
      } else if (slot >= 2) { float* nk = WSP(float, WS_NEWKV) + ((size_t)(sb * 4 + (slot - 2)) * 2 + kv) * 64 + d0;
#pragma unroll
          for (int i = 0; i < 8; ++i) nk[i] = f[i]; }
    }
    { unpack8(*(const u32x4*)(pr + C_KV + 512 + 8 * lane), f); float ss = 0.f;
#pragma unroll
      for (int i = 0; i < 8; ++i) ss += f[i] * f[i];
      ss += __shfl_xor(ss, 1); ss += __shfl_xor(ss, 2); ss += __shfl_xor(ss, 4);
      const int grp = lane >> 3, slot = 4 + (grp >> 1), kv = grp & 1, d0 = 8 * (lane & 7);
      if (lane < 32) {
          if (slot == 4) { const float rs = rsqrtf(ss * (1.f / 64.f) + EPS); const float* g = F.in[I_GNK] + 128 + d0;
#pragma unroll
              for (int i = 0; i < 8; ++i) f[i] *= rs * g[i]; }
          if (prompt) {
              if (slot == 4) *(u32x4*)(WSP(bf16, WS_KWIN) + ((size_t)(b * 2 + kv) * T + t) * 64 + d0) = pack8(f);
              else { bf16* vt = WSP(bf16, WS_VWINT) + (((size_t)(b * 2 + kv) * 128 + (t >> 6)) * 64 + d0) * 64 + (t & 63);
#pragma unroll
                  for (int i = 0; i < 8; ++i) vt[i * 64] = (bf16)f2bf(f[i]); }
              if (t >= T - 512) { float* orow = F.out + O_WINP + ((size_t)b * 512 + (t - (T - 512))) * 256 + 8 * lane;
                  *(f32x4*)orow = (f32x4){f[0], f[1], f[2], f[3]}; *(f32x4*)(orow + 4) = (f32x4){f[4], f[5], f[6], f[7]}; }
          } else {
              float* nk = WSP(float, WS_NEWKV) + ((size_t)(sb * 4 + (slot - 2)) * 2 + kv) * 64 + d0;
#pragma unroll
              for (int i = 0; i < 8; ++i) nk[i] = f[i];
              float* orow = F.out + O_WINS + ((size_t)sb * 512 + 511) * 256 + 8 * lane;
              *(f32x4*)orow = (f32x4){f[0], f[1], f[2], f[3]}; *(f32x4*)(orow + 4) = (f32x4){f[4], f[5], f[6], f[7]};
          }
      }
    }
    if (lane < 24) WSP(float, WS_GATES)[(size_t)tok * 24 + lane] = sigmoidf_(bf2f(pr[C_G + lane]));
    { unpack8(*(const u32x4*)(pr + C_XQ + 8 * lane), f); float ss = 0.f;
#pragma unroll
      for (int i = 0; i < 8; ++i) ss += f[i] * f[i];
      ss += __shfl_xor(ss, 1); ss += __shfl_xor(ss, 2); ss += __shfl_xor(ss, 4); ss += __shfl_xor(ss, 8);
      const float rs = rsqrtf(ss * (1.f / 128.f) + EPS) * XSCALE; const float* g = F.in[I_GXQ] + 8 * (lane & 15);
#pragma unroll
      for (int i = 0; i < 8; ++i) f[i] *= rs * g[i];
      *(u32x4*)(WSP(bf16, WS_XQ) + (size_t)tok * 512 + 8 * lane) = pack8(f); }
}
__device__ __forceinline__ void p2_memrow(Frame& F, int row) {
    const int lane = LANE_, b = row >> 8, m = row & 255, head = lane >> 4, d0 = 8 * (lane & 15);
    const bf16* pr = WSP(bf16, WS_MEMPROJ) + (size_t)row * 1024; float f[8];
    { unpack8(*(const u32x4*)(pr + 8 * lane), f); float ss = 0.f;
#pragma unroll
      for (int i = 0; i < 8; ++i) ss += f[i] * f[i];
      ss += __shfl_xor(ss, 1); ss += __shfl_xor(ss, 2); ss += __shfl_xor(ss, 4); ss += __shfl_xor(ss, 8);
      const float rs = rsqrtf(ss * (1.f / 128.f) + EPS); const float* g = F.in[I_GXK] + d0;
#pragma unroll
      for (int i = 0; i < 8; ++i) f[i] *= rs * g[i];
      float* orow = F.out + O_MEMP + ((size_t)row * 2 + 0) * 512 + 8 * lane;
      *(f32x4*)orow = (f32x4){f[0], f[1], f[2], f[3]}; *(f32x4*)(orow + 4) = (f32x4){f[4], f[5], f[6], f[7]};
      *(u32x4*)(WSP(bf16, WS_KMEM) + ((size_t)(b * 4 + head) * 256 + m) * 128 + d0) = pack8(f); }
    { unpack8(*(const u32x4*)(pr + 512 + 8 * lane), f);
      float* orow = F.out + O_MEMP + ((size_t)row * 2 + 1) * 512 + 8 * lane;
      *(f32x4*)orow = (f32x4){f[0], f[1], f[2], f[3]}; *(f32x4*)(orow + 4) = (f32x4){f[4], f[5], f[6], f[7]};
      bf16* vt = WSP(bf16, WS_VMEMT) + ((size_t)(b * 4 + head) * 128 + d0) * 256 + m;
#pragma unroll
      for (int i = 0; i < 8; ++i) vt[i * 256] = (bf16)f2bf(f[i]); }
}

constexpr int CMP_TASKS_S = SB * 2 * 2, CMP_TASKS_P = NB * 2 * 2;
__device__ __forceinline__ int cmp_tile_off16(int row, int c16) { return row * 128 + ((c16 ^ (row & 7)) << 4); }
__device__ __forceinline__ void p2_compress(Frame& F, int task) {
    const int lane = LANE_, r = lane & 15, q = lane >> 4, w = F.wave, tid_ = w * 64 + lane;
    const bool smp = task < CMP_TASKS_S; const int x = smp ? task : task - CMP_TASKS_S;
    const int b = x >> 2, kv = (x >> 1) & 1, slot = x & 1, i0 = 64 * w;
    const bf16* W1t = WSP(bf16, WS_W1T) + (size_t)slot * 64 * 2048;
    const bf16* W2t = WSP(bf16, WS_W2T) + (size_t)slot * 64 * 64;
    const int* pt = (const int*)F.in[I_PT] + b * 64;
    const float* ckv = F.in[I_CKV]; const float* pe = F.in[slot ? I_CVPE : I_CKPE];
    const bf16* proj = WSP(bf16, WS_PROJ);
    LAS unsigned char* wb = F.lds;
    const int srow = tid_ >> 3, sc16 = tid_ & 7, soff = cmp_tile_off16(srow, sc16);
    int kb0[2]; kb0[0] = r * 128 + (((0 + q) ^ (r & 7)) << 4); kb0[1] = r * 128 + (((4 + q) ^ (r & 7)) << 4);
    f32x4 acc[4][4];
#pragma unroll
    for (int nt = 0; nt < 4; ++nt)
#pragma unroll
        for (int it = 0; it < 4; ++it) acc[nt][it] = (f32x4){0.f, 0.f, 0.f, 0.f};
    int pg0[4], pg1[4];
#pragma unroll
    for (int it = 0; it < 4; ++it) { const int pb = (16 * (i0 + 16 * it + r)) >> 7; pg0[it] = smp ? pt[pb] : 0; pg1[it] = smp ? pt[pb < 63 ? pb + 1 : 63] : 0; }
    const bf16* wsrc = W1t + (size_t)srow * 2048 + sc16 * 8;
    u32x4 rw = *(const u32x4*)wsrc;
    u32x4 xr[2][4][2];
#define CMP_LOAD_ROWS(KP) do { _Pragma("unroll") for (int it = 0; it < 4; ++it) { int tok = 16 * (i0 + 16 * it + r) + (KP); tok = tok < T ? tok : T - 1; \
        _Pragma("unroll") for (int ks2 = 0; ks2 < 2; ++ks2) { const int d = 32 * ks2 + 8 * q; \
            if (smp) { const int page = (tok >> 7) == ((16 * (i0 + 16 * it + r)) >> 7) ? pg0[it] : pg1[it]; \
                const float* src = ckv + (((size_t)page * 128 + (tok & 127)) * 4 + slot) * 128 + kv * 64 + d; xr[ks2][it][0] = *(const u32x4*)src; xr[ks2][it][1] = *(const u32x4*)(src + 4); } \
            else xr[ks2][it][0] = *(const u32x4*)(proj + ((size_t)b * T + tok) * DINP + C_KV + slot * 128 + kv * 64 + d); } } } while (0)
    CMP_LOAD_ROWS(0);
    __syncthreads();
#pragma unroll 1
    for (int kp = 0; kp < 32; ++kp) {
        bf16x8 xf[2][4];
#pragma unroll
        for (int it = 0; it < 4; ++it)
#pragma unroll
            for (int ks2 = 0; ks2 < 2; ++ks2) { const int d = 32 * ks2 + 8 * q; f32x4 a0, a1;
                if (smp) { a0 = __builtin_bit_cast(f32x4, xr[ks2][it][0]); a1 = __builtin_bit_cast(f32x4, xr[ks2][it][1]); }
                else { float f8[8]; unpack8(xr[ks2][it][0], f8); a0 = (f32x4){f8[0], f8[1], f8[2], f8[3]}; a1 = (f32x4){f8[4], f8[5], f8[6], f8[7]}; }
                const f32x4 p0 = *(const f32x4*)(pe + 64 * kp + d), p1 = *(const f32x4*)(pe + 64 * kp + d + 4);
                xf[ks2][it] = frag_pk(a0 + p0, a1 + p1); }
        if (kp + 1 < 32) CMP_LOAD_ROWS(kp + 1);
        *(LAS u32x4*)(wb + (kp & 1) * 8192 + soff) = rw;
        __syncthreads();
        if (kp + 1 < 32) rw = *(const u32x4*)(wsrc + 64 * (kp + 1));
        LAS const unsigned char* wt = wb + (kp & 1) * 8192;
#pragma unroll
        for (int ks2 = 0; ks2 < 2; ++ks2)
#pragma unroll
            for (int nt = 0; nt < 4; ++nt) { const bf16x8 a = as_frag(*(LAS const u32x4*)(wt + kb0[ks2] + nt * 2048));
#pragma unroll
                for (int it = 0; it < 4; ++it) acc[nt][it] = MFMA16(a, xf[ks2][it], acc[nt][it]); }
    }
#undef CMP_LOAD_ROWS
    const float* gk0 = F.in[I_GNK];
#pragma unroll
    for (int it = 0; it < 4; ++it) {
        f32x4 g[4];
#pragma unroll
        for (int nt = 0; nt < 4; ++nt)
#pragma unroll
            for (int i = 0; i < 4; ++i) g[nt][i] = gelu_tanh(acc[nt][it][i]);
        const bf16x8 b0 = frag_pk(g[0], g[1]), b1 = frag_pk(g[2], g[3]);
        f32x4 o[4]; float ss = 0.f;
#pragma unroll
        for (int mt = 0; mt < 4; ++mt) { const bf16* wr = W2t + (size_t)(16 * mt + r) * 64 + 4 * q;
            o[mt] = MFMA16(ldfrag2(wr, wr + 16), b0, ((f32x4){0.f, 0.f, 0.f, 0.f}));
            o[mt] = MFMA16(ldfrag2(wr + 32, wr + 48), b1, o[mt]);
            ss += (o[mt][0] * o[mt][0] + o[mt][1] * o[mt][1]) + (o[mt][2] * o[mt][2] + o[mt][3] * o[mt][3]); }
        ss += __shfl_xor(ss, 16); ss += __shfl_xor(ss, 32);
        if (slot == 0) { const float rs = rsqrtf(ss * (1.f / 64.f) + EPS);
#pragma unroll
            for (int mt = 0; mt < 4; ++mt) { const f32x4 gg = *(const f32x4*)(gk0 + 16 * mt + 4 * q); o[mt] = o[mt] * rs * gg; } }
        const int i = i0 + 16 * it + r;
        if (smp) { float* dst = WSP(float, slot ? WS_VCMPS : WS_KCMPS) + ((size_t)(b * 2 + kv) * 512 + i) * 64 + 4 * q;
#pragma unroll
            for (int mt = 0; mt < 4; ++mt) *(f32x4*)(dst + 16 * mt) = o[mt]; }
        else if (slot == 0) { bf16* dst = WSP(bf16, WS_KCMP) + ((size_t)(b * 2 + kv) * 512 + i) * 64 + 4 * q;
#pragma unroll
            for (int mt = 0; mt < 4; ++mt) { u32x2 wv; wv.x = pk2(o[mt][0], o[mt][1]); wv.y = pk2(o[mt][2], o[mt][3]); *(u32x2*)(dst + 16 * mt) = wv; } }
        else { bf16* dst = WSP(bf16, WS_VCMPT) + ((size_t)(b * 2 + kv) * 64 + 4 * q) * 512 + i;
#pragma unroll
            for (int mt = 0; mt < 4; ++mt)
#pragma unroll
                for (int e = 0; e < 4; ++e) dst[(size_t)(16 * mt + e) * 512] = (bf16)f2bf(o[mt][e]); }
    }
}

__device__ __forceinline__ int swz64(int row, int col) { return row * 64 + ((((col >> 3) ^ (row & 7)) << 3) | (col & 7)); }
__device__ __forceinline__ float log_sigmoid_(float z) { return fminf(z, 0.f) - __logf(1.0f + __expf(-fabsf(z))); }
__device__ __forceinline__ void p2_gla_chunk(Frame& F, int bc) {
    const int lane = LANE_, r = lane & 15, q = lane >> 4, h = F.wave >> 1, eh = F.wave & 1;
    LAS bf16* ktT = (LAS bf16*)(F.lds + F.wave * 16384);
    LAS bf16* vT = ktT + 4096;
    const bf16* proj = WSP(bf16, WS_PROJ) + (size_t)bc * 64 * DINP;
    float wg[16];
#pragma unroll
    for (int j = 0; j < 16; ++j) wg[j] = F.in[I_WGG][j * 256 + h * 64 + lane];
    const float bg = F.in[I_BGG][h * 64 + lane];
    bf16* qtg = WSP(bf16, WS_QTG) + (size_t)bc * 64 * 256 + h * 64 + lane;
    bf16* ktg = WSP(bf16, WS_KTG) + (size_t)bc * 64 * 256 + h * 64 + lane;
    bf16* vtg = WSP(bf16, WS_VTG) + ((size_t)(bc * 4 + h) * 128 + eh * 64 + lane) * 64;
    LAS float* lrs = (LAS float*)(F.lds + RING_BYTES);
    { const int tid_ = F.wave * 64 + lane; if (tid_ < 128) { float f8[8]; unpack8(*(const u32x4*)(proj + (size_t)(tid_ >> 1) * DINP + C_LR + 8 * (tid_ & 1)), f8);
#pragma unroll
        for (int i = 0; i < 8; ++i) lrs[(tid_ >> 1) * 16 + 8 * (tid_ & 1) + i] = f8[i]; } }
    __syncthreads();
    float cb = 0.f;
    bf16 kr[16], qr[16], vr[16], kn[16], qn[16], vn[16];
#pragma unroll
    for (int i = 0; i < 16; ++i) { const bf16* pr = proj + (size_t)i * DINP; kr[i] = pr[C_GK + h * 64 + lane]; qr[i] = pr[C_GQ + h * 64 + lane]; vr[i] = pr[C_GV + h * 128 + eh * 64 + lane]; }
#pragma unroll 1
    for (int tb = 0; tb < 4; ++tb) {
        const int tn = tb < 3 ? tb + 1 : 3;
#pragma unroll
        for (int i = 0; i < 16; ++i) { const bf16* pr = proj + (size_t)(16 * tn + i) * DINP; kn[i] = pr[C_GK + h * 64 + lane]; qn[i] = pr[C_GQ + h * 64 + lane]; vn[i] = pr[C_GV + h * 128 + eh * 64 + lane]; }
#pragma unroll
        for (int i = 0; i < 16; ++i) { const int t = 16 * tb + i;
            float z = bg;
#pragma unroll
            for (int j4 = 0; j4 < 4; ++j4) { const f32x4 l4 = *(LAS const f32x4*)(lrs + t * 16 + 4 * j4); z += l4[0] * wg[4 * j4] + l4[1] * wg[4 * j4 + 1] + l4[2] * wg[4 * j4 + 2] + l4[3] * wg[4 * j4 + 3]; }
            cb += log_sigmoid_(z) * 0.0625f;
            const float kk = bf2f(kr[i]) * __expf(-cb);
            const float qq = bf2f(qr[i]) * 0.125f * __expf(cb);
            const bf16 kb = (bf16)f2bf(kk);
            if (eh == 0) { qtg[(size_t)t * 256] = (bf16)f2bf(qq); ktg[(size_t)t * 256] = kb; }
            ktT[swz64(lane, t)] = kb;
            const bf16 vv = vr[i];
            vT[swz64(lane, t)] = vv; vtg[t] = vv; }
#pragma unroll
        for (int i = 0; i < 16; ++i) { kr[i] = kn[i]; qr[i] = qn[i]; vr[i] = vn[i]; }
    }
    const float dec = __expf(cb);
    if (eh == 0) WSP(float, WS_DEC)[(size_t)(bc * 4 + h) * 64 + lane] = dec;
    asm volatile("s_waitcnt lgkmcnt(0)" ::: "memory");
    f32x4 acc[4][4];
#pragma unroll
    for (int et = 0; et < 4; ++et)
#pragma unroll
        for (int dt = 0; dt < 4; ++dt) acc[et][dt] = (f32x4){0.f, 0.f, 0.f, 0.f};
#pragma unroll
    for (int ks = 0; ks < 2; ++ks) {
        bf16x8 bfr[4];
#pragma unroll
        for (int dt = 0; dt < 4; ++dt) bfr[dt] = as_frag(*(const LAS u32x4*)(ktT + swz64(16 * dt + r, 32 * ks + 8 * q)));
#pragma unroll
        for (int et = 0; et < 4; ++et) { const bf16x8 a = as_frag(*(const LAS u32x4*)(vT + swz64(16 * et + r, 32 * ks + 8 * q)));
#pragma unroll
            for (int dt = 0; dt < 4; ++dt) acc[et][dt] = MFMA16(a, bfr[dt], acc[et][dt]); }
    }
    float* up = WSP(float, WS_UP) + ((size_t)(bc * 4 + h) * 128 + eh * 64) * 64;
#pragma unroll
    for (int dt = 0; dt < 4; ++dt) { const float dd = __shfl(dec, 16 * dt + r);
#pragma unroll
        for (int et = 0; et < 4; ++et)
#pragma unroll
            for (int i = 0; i < 4; ++i) up[(size_t)(16 * et + 4 * q + i) * 64 + 16 * dt + r] = acc[et][dt][i] * dd; }
}

__device__ __forceinline__ void p2_gla_sample(Frame& F, int task) {
    const int lane = LANE_, b = task >> 2, h = task & 3, tok = NTOKP + b;
    const bf16* pr = WSP(bf16, WS_PROJ) + (size_t)tok * DINP;
    LAS float* sh = (LAS float*)(F.lds + F.wave * 16384);
    { float z = F.in[I_BGG][h * 64 + lane];
#pragma unroll
      for (int j = 0; j < 16; ++j) z += bf2f(pr[C_LR + j]) * F.in[I_WGG][j * 256 + h * 64 + lane];
      sh[lane] = __expf(log_sigmoid_(z) * 0.0625f); sh[64 + lane] = bf2f(pr[C_GK + h * 64 + lane]); sh[128 + lane] = bf2f(pr[C_GQ + h * 64 + lane]) * 0.125f; }
    asm volatile("s_waitcnt lgkmcnt(0)" ::: "memory");
    const float v0 = bf2f(pr[C_GV + h * 128 + lane]), v1 = bf2f(pr[C_GV + h * 128 + 64 + lane]);
    const float* s0 = F.in[I_SGLA] + (size_t)(b * 4 + h) * 64 * 128; float* s1 = F.out + O_GLAS + (size_t)(b * 4 + h) * 64 * 128;
    float o0 = 0.f, o1 = 0.f;
#pragma unroll 4
    for (int d = 0; d < 64; ++d) { const float a = sh[d], k = sh[64 + d], qq = sh[128 + d];
        const float n0 = a * s0[d * 128 + lane] + k * v0, n1 = a * s0[d * 128 + 64 + lane] + k * v1;
        s1[d * 128 + lane] = n0; s1[d * 128 + 64 + lane] = n1; o0 += qq * n0; o1 += qq * n1; }
    const float rs = rsqrtf(wave_sum(o0 * o0 + o1 * o1) * (1.f / 128.f) + EPS);
    const float r0 = bf2f(pr[C_GR + h * 128 + lane]), r1 = bf2f(pr[C_GR + h * 128 + 64 + lane]);
    bf16* og = WSP(bf16, WS_OGLA) + (size_t)tok * 512 + h * 128;
    og[lane] = (bf16)f2bf(o0 * rs * F.in[I_GGO][lane] * r0 * sigmoidf_(r0));
    og[64 + lane] = (bf16)f2bf(o1 * rs * F.in[I_GGO][64 + lane] * r1 * sigmoidf_(r1));
}

__device__ __forceinline__ void p3_gla_scan(Frame& F, int task) {
    const int lane = LANE_, b = task >> 9, h = (task >> 7) & 3, e = task & 127;
    const float* up = WSP(float, WS_UP); const float* dec = WSP(float, WS_DEC); bf16* sc = WSP(bf16, WS_SC);
    float S = 0.f;
#pragma unroll 8
    for (int c = 0; c < 128; ++c) { const int bc = b * 128 + c; const size_t idx = ((size_t)(bc * 4 + h) * 128 + e) * 64 + lane;
        sc[idx] = (bf16)f2bf(S); S = dec[(size_t)(bc * 4 + h) * 64 + lane] * S + up[idx]; }
    F.out[O_GLAP + ((size_t)(b * 4 + h) * 64 + lane) * 128 + e] = S;
}

__device__ __forceinline__ void p4_gla_out(Frame& F, int task) {
    const int lane = LANE_, r = lane & 15, q = lane >> 4, bc = task >> 4, h = (task >> 2) & 3, tt = task & 3;
    const bf16* qtg = WSP(bf16, WS_QTG) + (size_t)bc * 64 * 256 + h * 64;
    const bf16* ktg = WSP(bf16, WS_KTG) + (size_t)bc * 64 * 256 + h * 64;
    const bf16* vtg = WSP(bf16, WS_VTG) + (size_t)(bc * 4 + h) * 128 * 64;
    const bf16* sc = WSP(bf16, WS_SC) + (size_t)(bc * 4 + h) * 128 * 64;
    const bf16* proj = WSP(bf16, WS_PROJ) + (size_t)bc * 64 * DINP;
    bf16* og = WSP(bf16, WS_OGLA) + (size_t)bc * 64 * 512 + h * 128;
    const float* ggo = F.in[I_GGO];
    {
        bf16x8 qf[2];
#pragma unroll
        for (int ks = 0; ks < 2; ++ks) qf[ks] = ldfrag(qtg + (size_t)(16 * tt + r) * 256 + 32 * ks + 8 * q);
        f32x4 sT[4];
#pragma unroll
        for (int st = 0; st < 4; ++st) { sT[st] = (f32x4){0.f, 0.f, 0.f, 0.f};
            if (st <= tt) {
#pragma unroll
                for (int ks = 0; ks < 2; ++ks) sT[st] = MFMA16(ldfrag(ktg + (size_t)(16 * st + r) * 256 + 32 * ks + 8 * q), qf[ks], sT[st]);
                if (st == tt) {
#pragma unroll
                    for (int i = 0; i < 4; ++i) if (4 * q + i > r) sT[st][i] = 0.f; } } }
        const bf16x8 p01 = frag_pk(sT[0], sT[1]), p23 = frag_pk(sT[2], sT[3]);
        f32x4 acc[8]; float ss = 0.f;
#pragma unroll
        for (int et = 0; et < 8; ++et) { acc[et] = (f32x4){0.f, 0.f, 0.f, 0.f};
            const bf16* srow = sc + (size_t)(16 * et + r) * 64 + 8 * q;
            acc[et] = MFMA16(ldfrag(srow), qf[0], acc[et]); acc[et] = MFMA16(ldfrag(srow + 32), qf[1], acc[et]);
            const bf16* vrow = vtg + (size_t)(16 * et + r) * 64 + 4 * q;
            acc[et] = MFMA16(ldfrag2(vrow, vrow + 16), p01, acc[et]);
            if (tt >= 2) acc[et] = MFMA16(ldfrag2(vrow + 32, vrow + 48), p23, acc[et]);
            ss += (acc[et][0] * acc[et][0] + acc[et][1] * acc[et][1]) + (acc[et][2] * acc[et][2] + acc[et][3] * acc[et][3]); }
        ss += __shfl_xor(ss, 16); ss += __shfl_xor(ss, 32);
        const float rs = rsqrtf(ss * (1.f / 128.f) + EPS);
        const bf16* pr = proj + (size_t)(16 * tt + r) * DINP + C_GR + h * 128 + 4 * q;
        bf16* orow = og + (size_t)(16 * tt + r) * 512 + 4 * q;
#pragma unroll
        for (int et = 0; et < 8; ++et) { const u32x2 rw = *(const u32x2*)(pr + 16 * et); const f32x4 gg = *(const f32x4*)(ggo + 16 * et + 4 * q);
            const float r0 = bflo(rw.x), r1 = bfhi(rw.x), r2 = bflo(rw.y), r3 = bfhi(rw.y);
            u32x2 w; w.x = pk2(acc[et][0] * rs * gg[0] * r0 * sigmoidf_(r0), acc[et][1] * rs * gg[1] * r1 * sigmoidf_(r1));
            w.y = pk2(acc[et][2] * rs * gg[2] * r2 * sigmoidf_(r2), acc[et][3] * rs * gg[3] * r3 * sigmoidf_(r3));
            *(u32x2*)(orow + 16 * et) = w; }
    }
}

__device__ __forceinline__ void p3_xatt(Frame& F, int n, float mb) {
    const int lane = LANE_, r = lane & 15, q = lane >> 4, w = F.wave, tid_ = w * 64 + lane;
    const int b = n >> 7, h = (n >> 5) & 3, chunk = n & 31;
    const bf16* km = WSP(bf16, WS_KMEM) + (size_t)(b * 4 + h) * 256 * 128;
    const bf16* vm = WSP(bf16, WS_VMEMT) + (size_t)(b * 4 + h) * 128 * 256;
    LAS unsigned char* kl = F.lds; LAS unsigned char* vl = F.lds + 65536;
    __syncthreads();
    { u32x4 gk[8], gv[8];
#pragma unroll
      for (int i = 0; i < 8; ++i) { gk[i] = *(const u32x4*)(km + (size_t)(i * 512 + tid_) * 8); gv[i] = *(const u32x4*)(vm + (size_t)(i * 512 + tid_) * 8); }
#pragma unroll
      for (int i = 0; i < 8; ++i) { const int id = i * 512 + tid_;
          *(LAS u32x4*)(kl + (id >> 4) * 256 + ((((id & 15) ^ ((id >> 4) & 15))) << 4)) = gk[i];
          *(LAS u32x4*)(vl + (id >> 5) * 512 + ((((id & 31) ^ ((id >> 5) & 15))) << 4)) = gv[i]; } }
    __syncthreads();
    int kb4[4];
#pragma unroll
    for (int ks = 0; ks < 4; ++ks) kb4[ks] = r * 256 + (((4 * ks + q) ^ r) << 4);
#pragma unroll 1
    for (int tile = 0; tile < 2; ++tile) {
        const int tok0 = b * T + chunk * 256 + w * 32 + tile * 16;
        const bf16* xq = WSP(bf16, WS_XQ) + (size_t)(tok0 + r) * 512 + h * 128 + 8 * q;
        bf16x8 qf[4];
#pragma unroll
        for (int ks = 0; ks < 4; ++ks) qf[ks] = ldfrag(xq + 32 * ks);
        f32x4 o[8]; float l = 0.f;
#pragma unroll
        for (int dt = 0; dt < 8; ++dt) o[dt] = (f32x4){0.f, 0.f, 0.f, 0.f};
#pragma unroll 2
        for (int kk = 0; kk < 8; ++kk) {
            f32x4 p[2];
#pragma unroll
            for (int a = 0; a < 2; ++a) { p[a] = (f32x4){0.f, 0.f, 0.f, 0.f};
#pragma unroll
                for (int ks = 0; ks < 4; ++ks) p[a] = MFMA16(as_frag(*(LAS const u32x4*)(kl + kb4[ks] + (2 * kk + a) * 4096)), qf[ks], p[a]);
#pragma unroll
                for (int i = 0; i < 4; ++i) { p[a][i] = __builtin_amdgcn_exp2f(p[a][i] - mb); l += p[a][i]; } }
            const bf16x8 pf = frag_pk(p[0], p[1]);
            const int v0 = r * 512 + (((4 * kk + (q >> 1)) ^ r) << 4) + 8 * (q & 1), v1 = r * 512 + (((4 * kk + 2 + (q >> 1)) ^ r) << 4) + 8 * (q & 1);
#pragma unroll
            for (int dt = 0; dt < 8; ++dt) { const u32x2 x0 = *(LAS const u32x2*)(vl + v0 + dt * 8192), x1 = *(LAS const u32x2*)(vl + v1 + dt * 8192);
                u32x4 wv; wv.x = x0.x; wv.y = x0.y; wv.z = x1.x; wv.w = x1.y; o[dt] = MFMA16(as_frag(wv), pf, o[dt]); }
        }
        l += __shfl_xor(l, 16); l += __shfl_xor(l, 32);
        const float inv = 1.f / l;
        bf16* ox = WSP(bf16, WS_OX) + (size_t)(tok0 + r) * 512 + h * 128 + 4 * q;
#pragma unroll
        for (int dt = 0; dt < 8; ++dt) { u32x2 wv; wv.x = pk2(o[dt][0] * inv, o[dt][1] * inv); wv.y = pk2(o[dt][2] * inv, o[dt][3] * inv); *(u32x2*)(ox + 16 * dt) = wv; }
    }
}
__device__ __forceinline__ void p3_xatt_sample(Frame& F, int task) {
    const int lane = LANE_, b = task >> 2, h = task & 3, tok = NTOKP + b;
    LAS float* sh = (LAS float*)(F.lds + F.wave * 16384);
    const bf16* xq = WSP(bf16, WS_XQ) + (size_t)tok * 512 + h * 128;
    sh[lane] = bf2f(xq[lane]); sh[64 + lane] = bf2f(xq[64 + lane]);
    asm volatile("s_waitcnt lgkmcnt(0)" ::: "memory");
    const float* cm = F.in[I_CMEM] + (size_t)b * 256 * 1024 + h * 128;
    float s[4] = {0.f, 0.f, 0.f, 0.f};
    for (int d = 0; d < 128; d += 4) { const f32x4 qv = *(const LAS f32x4*)(sh + d);
#pragma unroll
        for (int k = 0; k < 4; ++k) { const f32x4 kv = *(const f32x4*)(cm + (size_t)(lane + 64 * k) * 1024 + d); s[k] += (qv[0] * kv[0] + qv[1] * kv[1]) + (qv[2] * kv[2] + qv[3] * kv[3]); } }
    const float m = wave_max(fmaxf(fmaxf(s[0], s[1]), fmaxf(s[2], s[3])));
    float l = 0.f;
#pragma unroll
    for (int k = 0; k < 4; ++k) { const float e = __builtin_amdgcn_exp2f(s[k] - m); sh[128 + lane + 64 * k] = e; l += e; }
    l = wave_sum(l);
    asm volatile("s_waitcnt lgkmcnt(0)" ::: "memory");
    float o0 = 0.f, o1 = 0.f; const float* vv = cm + 512;
#pragma unroll 4
    for (int mm = 0; mm < 256; ++mm) { const float p = sh[128 + mm]; o0 += p * vv[(size_t)mm * 1024 + lane]; o1 += p * vv[(size_t)mm * 1024 + 64 + lane]; }
    const float inv = 1.f / l;
    bf16* ox = WSP(bf16, WS_OX) + (size_t)tok * 512 + h * 128;
    ox[lane] = (bf16)f2bf(o0 * inv); ox[64 + lane] = (bf16)f2bf(o1 * inv);
}

constexpr int NL_Q = 0;
constexpr int NL_U = 16384;
constexpr int NL_OS = 81920;
constexpr int NL_TB = 16384;
constexpr int NL_SEL = 147456;
constexpr int NL_BT = 147968;
constexpr int NL_LINV = 152096;
constexpr int NL_END = 152608;
static_assert(NL_END <= LDS_BYTES, "NSA LDS map");

__device__ __forceinline__ void nsa_tables(Frame& F) {
    LAS float* bt = (LAS float*)(F.lds + NL_BT);
    for (int i = TID_; i < 129 * 8; i += NTHR) bt[i] = F.in[I_RB][t5_bucket(i >> 3) * 8 + (i & 7)] * LOG2E;
    __syncthreads();
}
__device__ __forceinline__ float nsa_bound(Frame& F) {
    const float gq = absmax_arr(F.in[I_GNQ], 64, LANE_), gk = absmax_arr(F.in[I_GNK], 192, LANE_), bm = absmax_arr(F.in[I_RB], 256, LANE_);
    return (8.0f * gq * gk * 1.02f + bm) * LOG2E;
}
__device__ __forceinline__ unsigned fkey(float x) { const unsigned u = __float_as_uint(x); return (u & 0x80000000u) ? ~u : (u | 0x80000000u); }

__device__ __forceinline__ int tile_off16(int row, int c16) { return row * 128 + ((c16 ^ (row & 7)) << 4); }
struct TileAddr { int kb[2]; int vb[2][2]; };
__device__ __forceinline__ TileAddr tile_addr(int r, int q) { TileAddr a;
    for (int ks = 0; ks < 2; ++ks) a.kb[ks] = r * 128 + (((4 * ks + q) ^ (r & 7)) << 4);
    for (int s = 0; s < 2; ++s) for (int pc = 0; pc < 2; ++pc) a.vb[s][pc] = r * 128 + (((4 * s + 2 * pc + (q >> 1)) ^ (r & 7)) << 4) + 8 * (q & 1);
    return a; }
__device__ __forceinline__ bf16x8 tile_kfrag(LAS const unsigned char* kb, const TileAddr& ta, int kt, int ks) { return as_frag(*(LAS const u32x4*)(kb + ta.kb[ks] + kt * 2048)); }
__device__ __forceinline__ bf16x8 tile_vfrag(LAS const unsigned char* vb, const TileAddr& ta, int dt, int s) {
    const u32x2 a = *(LAS const u32x2*)(vb + ta.vb[s][0] + dt * 2048), b = *(LAS const u32x2*)(vb + ta.vb[s][1] + dt * 2048);
    u32x4 w; w.x = a.x; w.y = a.y; w.z = b.x; w.w = b.y; return as_frag(w); }

#define OPAQUE_V(x) asm volatile("" : "+v"(x))
__device__ __forceinline__ void p3_nsa_prompt(Frame& F, int n, float mb, int dbg) {
    int lane0 = LANE_; OPAQUE_V(lane0);
    const int lane = lane0, r = lane & 15, q = lane >> 4, w = F.wave;
    int combo, ti;
    if (F.G == 256) { const int xcd = F.bid & 7, u = (F.bid >> 3) * 2 + (xcd & 1), rnd = n >> 8; combo = xcd >> 1; ti = rnd == 0 ? u : rnd == 1 ? 127 - u : rnd == 2 ? 128 + u : 255 - u; }
    else { const int idx = n & 255; combo = n >> 8; ti = (combo & 1) ? 255 - idx : idx; }
    const int b = combo >> 1, kv = combo & 1, t0 = 32 * ti, bk = b * 2 + kv;
    LAS bf16* Qs = (LAS bf16*)(F.lds + NL_Q); LAS float* U = (LAS float*)(F.lds + NL_U) + w * 2048; LAS unsigned* selm = (LAS unsigned*)(F.lds + NL_SEL);
    LAS const float* bt = (LAS const float*)(F.lds + NL_BT); LAS float* linv = (LAS float*)(F.lds + NL_LINV) + w * 16;
    LAS unsigned char* stA = F.lds + NL_OS;
    LAS unsigned char* stC = F.lds + NL_U;
    LAS unsigned char* stB = F.lds + NL_TB + w * 16384;
    const int tid_ = w * 64 + lane, srow = tid_ >> 3, sc16 = tid_ & 7, soff = tile_off16(srow, sc16);
    const TileAddr ta = tile_addr(r, q);
    __syncthreads();
    { const int tk = TID_ >> 4, ch = TID_ & 15; const bf16* src = WSP(bf16, WS_QN) + (size_t)(b * T + t0 + tk) * 512 + kv * 256 + ch * 16;
      const u32x4 a0 = *(const u32x4*)src, a1 = *(const u32x4*)(src + 8);
      *(LAS u32x4*)(Qs + tk * 256 + ch * 16) = a0; *(LAS u32x4*)(Qs + tk * 256 + ch * 16 + 8) = a1;
      if (TID_ < 128) selm[TID_] = 0u; }
    __syncthreads();
    const int tw = t0 + 4 * w, tr = tw + (r >> 2), h = kv * 4 + (r & 3);
    bf16x8 qf[2];
#pragma unroll
    for (int ks = 0; ks < 2; ++ks) qf[ks] = as_frag(*(LAS const u32x4*)(Qs + (16 * w + r) * 64 + 32 * ks + 8 * q));
    int ncvb = (t0 + 31 - 31) / 16 + 1; ncvb = ncvb < 511 ? ncvb : 511;
    const int nst = (ncvb + 63) >> 6;
    const int tlast = tw + 3; int ncv = tlast >= 31 ? (tlast - 31) / 16 + 1 : 0; ncv = ncv < 511 ? ncv : 511;
    const int nstw = (ncv + 63) >> 6;
    f32x4 oc[4]; float lc = 0.f, carry = 0.f;
#pragma unroll
    for (int dt = 0; dt < 4; ++dt) oc[dt] = (f32x4){0.f, 0.f, 0.f, 0.f};
    {
        const bf16* kc = WSP(bf16, WS_KCMP) + (size_t)bk * 512 * 64 + srow * 64 + sc16 * 8; const bf16* vc = WSP(bf16, WS_VCMPT) + (size_t)bk * 64 * 512 + srow * 512 + sc16 * 8;
        const int nst2 = (nst + 1) >> 1;
        u32x4 rk0 = *(const u32x4*)kc, rv0 = *(const u32x4*)vc, rk1 = *(const u32x4*)(kc + 4096), rv1 = *(const u32x4*)(vc + 64);
#pragma unroll 1
        for (int s2 = 0; s2 < nst2; ++s2) {
            LAS unsigned char* bb = stA + (s2 & 1) * 32768;
            *(LAS u32x4*)(bb + soff) = rk0; *(LAS u32x4*)(bb + 8192 + soff) = rv0; *(LAS u32x4*)(bb + 16384 + soff) = rk1; *(LAS u32x4*)(bb + 24576 + soff) = rv1;
            __syncthreads();
            if (s2 + 1 < nst2) { rk0 = *(const u32x4*)(kc + (size_t)(2 * s2 + 2) * 4096); rv0 = *(const u32x4*)(vc + (2 * s2 + 2) * 64);
                                 rk1 = *(const u32x4*)(kc + (size_t)(2 * s2 + 3) * 4096); rv1 = *(const u32x4*)(vc + (2 * s2 + 3) * 64); }
#pragma unroll
            for (int sub = 0; sub < 2; ++sub) { const int st = 2 * s2 + sub; LAS unsigned char* kb = bb + sub * 16384; LAS unsigned char* vb = kb + 8192;
            if (st < nstw && !(dbg & 1)) {
                f32x4 p[4];
#pragma unroll
                for (int kt = 0; kt < 4; ++kt) { const int tile = 4 * st + kt; p[kt] = (f32x4){0.f, 0.f, 0.f, 0.f};
                    p[kt] = MFMA16(tile_kfrag(kb, ta, kt, 0), qf[0], p[kt]); p[kt] = MFMA16(tile_kfrag(kb, ta, kt, 1), qf[1], p[kt]);
                    float G = 0.f;
#pragma unroll
                    for (int i = 0; i < 4; ++i) { const int c = 16 * tile + 4 * q + i, rel = tr - (16 * c + 31); const bool ok = rel >= 0 && c < 511;
                        const int rc = rel < 0 ? 0 : (rel > 128 ? 128 : rel);
                        const float xv = p[kt][i] + bt[rc * 8 + h] - mb;
                        const float e = __builtin_amdgcn_exp2f(ok ? xv : -1e30f); p[kt][i] = e; G += e; }
                    const float send = (q == 3) ? carry : p[kt][3]; const float prev = __shfl(send, (lane + 48) & 63); carry = p[kt][3];
                    U[r * 128 + 4 * tile + q] = G + prev; lc += G; }
                const bf16x8 pf0 = frag_pk(p[0], p[1]), pf1 = frag_pk(p[2], p[3]);
#pragma unroll
                for (int dt = 0; dt < 4; ++dt) { oc[dt] = MFMA16(tile_vfrag(vb, ta, dt, 0), pf0, oc[dt]); oc[dt] = MFMA16(tile_vfrag(vb, ta, dt, 1), pf1, oc[dt]); }
            } }
        }
    }
    lc += __shfl_xor(lc, 16); lc += __shfl_xor(lc, 32);
    const float lcinv = lc > 0.f ? 1.f / lc : 0.f;
    if (q == 0) linv[r] = lcinv;
    asm volatile("s_waitcnt lgkmcnt(0)" ::: "memory");
    if (!(dbg & 8)) {
        const int tk = lane >> 4, jr = lane & 15, t = tw + tk, tblk = t >> 6, jlim = 16 * nstw;
        const float li0 = linv[4 * tk], li1 = linv[4 * tk + 1], li2 = linv[4 * tk + 2], li3 = linv[4 * tk + 3];
        unsigned key[8];
#pragma unroll
        for (int m = 0; m < 8; ++m) { const int j = jr + 16 * m; float v = 0.f;
            if (j < jlim) v = U[(4 * tk) * 128 + j] * li0 + U[(4 * tk + 1) * 128 + j] * li1 + U[(4 * tk + 2) * 128 + j] * li2 + U[(4 * tk + 3) * 128 + j] * li3;
            const bool forced = (j == 0) || (j == tblk) || (j == tblk - 1);
            const float sc = (j <= tblk) ? v + (forced ? 1e4f : 0.f) : -1e30f;
            key[m] = fkey(sc); }
        unsigned pre = 0u;
#pragma unroll 1
        for (int bit = 31; bit >= 0; --bit) { const unsigned cand = pre | (1u << bit); int cnt = 0;
#pragma unroll
            for (int m = 0; m < 8; ++m) cnt += key[m] >= cand ? 1 : 0;
            cnt += __shfl_xor(cnt, 1); cnt += __shfl_xor(cnt, 2); cnt += __shfl_xor(cnt, 4); cnt += __shfl_xor(cnt, 8);
            if (cnt >= 16) pre = cand; }
        int ngt = 0;
#pragma unroll
        for (int m = 0; m < 8; ++m) ngt += key[m] > pre ? 1 : 0;
        ngt += __shfl_xor(ngt, 1); ngt += __shfl_xor(ngt, 2); ngt += __shfl_xor(ngt, 4); ngt += __shfl_xor(ngt, 8);
        const int need = 16 - ngt; int run = 0; const unsigned kinv = fkey(-1e30f);
#pragma unroll
        for (int m = 0; m < 8; ++m) { const bool tie = key[m] == pre; const unsigned long long bal = __ballot(tie);
            const unsigned grp = (unsigned)(bal >> (16 * tk)) & 0xffffu; const int rank = __popc(grp & ((1u << jr) - 1u));
            const bool sel = (key[m] > pre || (tie && run + rank < need)) && key[m] > kinv;
            run += __popc(grp);
            if (sel) atomicOr((unsigned*)(selm + jr + 16 * m), 1u << (4 * w + tk)); }
    }
    __syncthreads();
    f32x4 ow[4]; float lw = 0.f;
#pragma unroll
    for (int dt = 0; dt < 4; ++dt) ow[dt] = (f32x4){0.f, 0.f, 0.f, 0.f};
    {
        int lc_ = lane0; OPAQUE_V(lc_); const int lane = lc_, r = lane & 15, q = lane >> 4, tr = tw + (r >> 2), h = kv * 4 + (r & 3); const TileAddr ta = tile_addr(r, q);
        const int tid_ = w * 64 + lane, srow = tid_ >> 3, sc16 = tid_ & 7, soff = tile_off16(srow, sc16);
        const int jlob = (t0 - 511 > 0 ? t0 - 511 : 0) >> 6, jhib = (t0 + 31) >> 6, nstc = jhib - jlob + 1;
        const int jlo = (tw - 511 > 0 ? tw - 511 : 0) >> 6, jhi = (tw + 3) >> 6;
        const bf16* kwin = WSP(bf16, WS_KWIN) + (size_t)bk * T * 64 + srow * 64 + sc16 * 8; const bf16* vwin = WSP(bf16, WS_VWINT) + (size_t)bk * 128 * 4096 + srow * 64 + sc16 * 8;
        const int nstc2 = (nstc + 1) >> 1;
        u32x4 rk0 = *(const u32x4*)(kwin + (size_t)jlob * 4096), rv0 = *(const u32x4*)(vwin + (size_t)jlob * 4096), rk1 = *(const u32x4*)(kwin + (size_t)(jlob + 1) * 4096), rv1 = *(const u32x4*)(vwin + (size_t)(jlob + 1) * 4096);
#pragma unroll 1
        for (int s2 = 0; s2 < nstc2; ++s2) { const int j0 = jlob + 2 * s2;
            LAS unsigned char* bb = stC + (s2 & 1) * 32768;
            *(LAS u32x4*)(bb + soff) = rk0; *(LAS u32x4*)(bb + 8192 + soff) = rv0; *(LAS u32x4*)(bb + 16384 + soff) = rk1; *(LAS u32x4*)(bb + 24576 + soff) = rv1;
            __syncthreads();
            if (s2 + 1 < nstc2) { rk0 = *(const u32x4*)(kwin + (size_t)(j0 + 2) * 4096); rv0 = *(const u32x4*)(vwin + (size_t)(j0 + 2) * 4096);
                                  rk1 = *(const u32x4*)(kwin + (size_t)(j0 + 3) * 4096); rv1 = *(const u32x4*)(vwin + (size_t)(j0 + 3) * 4096); }
#pragma unroll
            for (int sub = 0; sub < 2; ++sub) { const int j = j0 + sub; LAS unsigned char* kb = bb + sub * 16384; LAS unsigned char* vb = kb + 8192;
            if (j >= jlo && j <= jhi && !(dbg & 2)) {
                f32x4 p[4];
#pragma unroll
                for (int kt = 0; kt < 4; ++kt) { p[kt] = (f32x4){0.f, 0.f, 0.f, 0.f};
                    p[kt] = MFMA16(tile_kfrag(kb, ta, kt, 0), qf[0], p[kt]); p[kt] = MFMA16(tile_kfrag(kb, ta, kt, 1), qf[1], p[kt]);
#pragma unroll
                    for (int i = 0; i < 4; ++i) { const int rel = tr - (64 * j + 16 * kt + 4 * q + i); const bool ok = rel >= 0 && rel < 512;
                        const int rc = rel < 0 ? 0 : (rel > 128 ? 128 : rel);
                        const float xv = p[kt][i] + bt[rc * 8 + h] - mb;
                        const float e = __builtin_amdgcn_exp2f(ok ? xv : -1e30f); p[kt][i] = e; lw += e; } }
                const bf16x8 pf0 = frag_pk(p[0], p[1]), pf1 = frag_pk(p[2], p[3]);
#pragma unroll
                for (int dt = 0; dt < 4; ++dt) { ow[dt] = MFMA16(tile_vfrag(vb, ta, dt, 0), pf0, ow[dt]); ow[dt] = MFMA16(tile_vfrag(vb, ta, dt, 1), pf1, ow[dt]); }
            } }
        }
        lw += __shfl_xor(lw, 16); lw += __shfl_xor(lw, 32);
    }
    f32x4 ocw[4];
    { const float* gt = WSP(float, WS_GATES) + (size_t)(b * T + tr) * 24 + h * 3;
      const float g0 = gt[0] * lcinv, g2 = gt[2] * (lw > 0.f ? 1.f / lw : 0.f);
#pragma unroll
      for (int dt = 0; dt < 4; ++dt) ocw[dt] = oc[dt] * g0 + ow[dt] * g2; }
    __syncthreads();
    f32x4 osf[4]; float lsf = 0.f;
    {
        int lb_ = lane0; OPAQUE_V(lb_); const int lane = lb_, r = lane & 15, q = lane >> 4, h = kv * 4 + (r & 3); const TileAddr ta = tile_addr(r, q);
        const int half = w >> 2, jw = w & 3;
        f32x4 osa[4][4]; float lsa[4];
#pragma unroll
        for (int x = 0; x < 4; ++x) { lsa[x] = 0.f;
#pragma unroll
            for (int dt = 0; dt < 4; ++dt) osa[x][dt] = (f32x4){0.f, 0.f, 0.f, 0.f}; }
        const int jmax = (t0 + 31) >> 6;
        const int brow = lane >> 3, bc16 = lane & 7, boff = brow * 64 + bc16 * 8, bsoff = tile_off16(brow, bc16); const float bfar = bt[128 * 8 + h];
        const bf16* ksel = WSP(bf16, WS_KSEL) + (size_t)bk * T * 64 + boff; const bf16* vsel = WSP(bf16, WS_VSELT) + (size_t)bk * 128 * 4096 + boff;
        LAS const bf16* Qh = Qs + (64 * half + r) * 64 + 8 * q;
        u32x4 gk[8], gv[8];
        if (jw <= jmax) {
#pragma unroll
            for (int i = 0; i < 8; ++i) { gk[i] = *(const u32x4*)(ksel + (size_t)jw * 4096 + i * 512); gv[i] = *(const u32x4*)(vsel + (size_t)jw * 4096 + i * 512); } }
#pragma unroll 1
        for (int j = jw; j <= jmax; j += 4) {
            const unsigned msel = ((unsigned)__builtin_amdgcn_readfirstlane((int)selm[j]) >> (16 * half)) & 0xffffu;
            const bool act = msel != 0u && !(dbg & 4);
            asm volatile("s_waitcnt lgkmcnt(0)" ::: "memory");
#pragma unroll
            for (int i = 0; i < 8; ++i) { *(LAS u32x4*)(stB + bsoff + i * 1024) = gk[i]; *(LAS u32x4*)(stB + 8192 + bsoff + i * 1024) = gv[i]; }
            if (j + 4 <= jmax) {
#pragma unroll
                for (int i = 0; i < 8; ++i) { gk[i] = *(const u32x4*)(ksel + (size_t)(j + 4) * 4096 + i * 512); gv[i] = *(const u32x4*)(vsel + (size_t)(j + 4) * 4096 + i * 512); } }
            if (!act) continue;
            asm volatile("s_waitcnt lgkmcnt(0)" ::: "memory");
            const bool far = (t0 - (64 * j + 63)) >= 128;
#pragma unroll 1
            for (int x = 0; x < 4; ++x) {
                const unsigned nib = (msel >> (4 * x)) & 15u;
                if (nib) {
                    asm volatile("" ::: "memory");
                    const bool tokv = (nib >> (r >> 2)) & 1u; const int t = t0 + 16 * half + 4 * x + (r >> 2);
                    const bf16x8 qs0 = as_frag(*(LAS const u32x4*)(Qh + x * 1024)), qs1 = as_frag(*(LAS const u32x4*)(Qh + x * 1024 + 32));
                    f32x4 p[4]; float ls = 0.f;
#pragma unroll
                    for (int kt = 0; kt < 4; ++kt) { p[kt] = (f32x4){0.f, 0.f, 0.f, 0.f};
                        p[kt] = MFMA16(tile_kfrag(stB, ta, kt, 0), qs0, p[kt]); p[kt] = MFMA16(tile_kfrag(stB, ta, kt, 1), qs1, p[kt]); }
                    if (dbg & 32) { ls = p[0][0]; } else
                    if (far) {
                        const float cb_ = bfar - mb;
#pragma unroll
                        for (int kt = 0; kt < 4; ++kt)
#pragma unroll
                            for (int i = 0; i < 4; ++i) { const float e = __builtin_amdgcn_exp2f(tokv ? p[kt][i] + cb_ : -1e30f); p[kt][i] = e; ls += e; }
                    } else {
#pragma unroll
                        for (int kt = 0; kt < 4; ++kt)
#pragma unroll
                            for (int i = 0; i < 4; ++i) { const int rel = t - (64 * j + 16 * kt + 4 * q + i); const bool ok = tokv && rel >= 0;
                                const int rc = rel < 0 ? 0 : (rel > 128 ? 128 : rel);
                                const float xv = p[kt][i] + bt[rc * 8 + h] - mb;
                                const float e = __builtin_amdgcn_exp2f(ok ? xv : -1e30f); p[kt][i] = e; ls += e; }
                    }
                    lsa[0] += ls;
                    const bf16x8 pf0 = frag_pk(p[0], p[1]), pf1 = frag_pk(p[2], p[3]);
#pragma unroll
                    for (int dt = 0; dt < 4; ++dt) if (!(dbg & 64)) { osa[0][dt] = MFMA16(tile_vfrag(stB + 8192, ta, dt, 0), pf0, osa[0][dt]); osa[0][dt] = MFMA16(tile_vfrag(stB + 8192, ta, dt, 1), pf1, osa[0][dt]); }
                }
                { const float l0 = lsa[0]; lsa[0] = lsa[1]; lsa[1] = lsa[2]; lsa[2] = lsa[3]; lsa[3] = l0;
#pragma unroll
                  for (int dt = 0; dt < 4; ++dt) { const f32x4 o0 = osa[0][dt]; osa[0][dt] = osa[1][dt]; osa[1][dt] = osa[2][dt]; osa[2][dt] = osa[3][dt]; osa[3][dt] = o0; } }
            }
        }
#pragma unroll
        for (int dt = 0; dt < 4; ++dt) osf[dt] = (f32x4){0.f, 0.f, 0.f, 0.f};
#pragma unroll
        for (int x = 0; x <= 4; ++x) {
            __syncthreads();
            if (x > 0 && jw == x - 1) {
#pragma unroll
                for (int w2 = 0; w2 < 4; ++w2) { LAS const float* rp = (LAS const float*)(F.lds + NL_U + ((x - 1) & 1) * 32768) + (4 * half + w2) * 1024 + lane * 16;
#pragma unroll
                    for (int dt = 0; dt < 4; ++dt) osf[dt] += *(LAS const f32x4*)(rp + 4 * dt);
                    lsf += ((LAS const float*)(F.lds + NL_Q + ((x - 1) & 1) * 2048))[(4 * half + w2) * 64 + lane]; } }
            if (x < 4) { LAS float* Rb = (LAS float*)(F.lds + NL_U + (x & 1) * 32768); LAS float* RLb = (LAS float*)(F.lds + NL_Q + (x & 1) * 2048);
#pragma unroll
                for (int dt = 0; dt < 4; ++dt) *(LAS f32x4*)(Rb + w * 1024 + lane * 16 + 4 * dt) = osa[x][dt];
                RLb[w * 64 + lane] = lsa[x]; }
        }
        lsf += __shfl_xor(lsf, 16); lsf += __shfl_xor(lsf, 32);
    }
    {
        int lf_ = lane0; OPAQUE_V(lf_); const int r = lf_ & 15, q = lf_ >> 4, tr = tw + (r >> 2), h = kv * 4 + (r & 3);
        const int tok = b * T + tr; const float g1 = WSP(float, WS_GATES)[(size_t)tok * 24 + h * 3 + 1] * (lsf > 0.f ? 1.f / lsf : 0.f);
        bf16* on = WSP(bf16, WS_ONSA) + (size_t)tok * 512 + h * 64 + 4 * q;
#pragma unroll
        for (int dt = 0; dt < 4; ++dt) { const f32x4 o = ocw[dt] + osf[dt] * g1;
            u32x2 wv; wv.x = pk2(o[0], o[1]); wv.y = pk2(o[2], o[3]); *(u32x2*)(on + 16 * dt) = wv; }
    }
}

constexpr int SL_Q = 0;
constexpr int SL_S = 1024;
constexpr int SL_O = 17408;
constexpr int SL_PART = 20480;
constexpr int SL_IMP = 28672;
constexpr int SL_IDX = 29200;
constexpr int SL_END = 29328;
static_assert(SL_END <= NL_SEL, "sample NSA LDS map must not overlap the tables");
template <class KP, class VP, class RELF>
__device__ __forceinline__ void sample_segment(Frame& F, int nk, int kv, KP kptr, VP vptr, RELF relf, LAS float* odst) {
    LAS const float* qs = (LAS const float*)(F.lds + SL_Q); LAS float* sc = (LAS float*)(F.lds + SL_S); LAS float* part = (LAS float*)(F.lds + SL_PART);
    LAS const float* bt = (LAS const float*)(F.lds + NL_BT);
    const int nkp = (nk + 63) & ~63;
    for (int n = TID_; n < nkp; n += NTHR) {
        float s0 = -INFINITY, s1 = -INFINITY, s2 = -INFINITY, s3 = -INFINITY;
        const float* kr = n < nk ? kptr(n) : nullptr;
        if (kr) { s0 = s1 = s2 = s3 = 0.f;
            for (int d = 0; d < 64; d += 4) { const f32x4 k4 = *(const f32x4*)(kr + d);
                const f32x4 q0 = *(LAS const f32x4*)(qs + d), q1 = *(LAS const f32x4*)(qs + 64 + d), q2 = *(LAS const f32x4*)(qs + 128 + d), q3 = *(LAS const f32x4*)(qs + 192 + d);
                s0 += (q0[0] * k4[0] + q0[1] * k4[1]) + (q0[2] * k4[2] + q0[3] * k4[3]); s1 += (q1[0] * k4[0] + q1[1] * k4[1]) + (q1[2] * k4[2] + q1[3] * k4[3]);
                s2 += (q2[0] * k4[0] + q2[1] * k4[1]) + (q2[2] * k4[2] + q2[3] * k4[3]); s3 += (q3[0] * k4[0] + q3[1] * k4[1]) + (q3[2] * k4[2] + q3[3] * k4[3]); }
            int rel = relf(n); rel = rel > 128 ? 128 : rel; const int bb = rel * 8 + kv * 4;
            s0 += bt[bb]; s1 += bt[bb + 1]; s2 += bt[bb + 2]; s3 += bt[bb + 3]; }
        sc[n] = s0; sc[1024 + n] = s1; sc[2048 + n] = s2; sc[3072 + n] = s3;
    }
    __syncthreads();
    if (F.wave < 4) { LAS float* row = sc + F.wave * 1024; float m = -INFINITY;
        for (int n = LANE_; n < nkp; n += 64) m = fmaxf(m, row[n]);
        m = wave_max(m); float l = 0.f;
        for (int n = LANE_; n < nkp; n += 64) { const float e = __builtin_amdgcn_exp2f(row[n] - m); row[n] = e; l += e; }
        l = wave_sum(l); const float inv = 1.f / l;
        for (int n = LANE_; n < nkp; n += 64) row[n] *= inv; }
    __syncthreads();
    {
        const int d = LANE_; float o0 = 0.f, o1 = 0.f, o2 = 0.f, o3 = 0.f;
        for (int n0 = F.wave; n0 < nkp; n0 += 32) {
            float v[4];
#pragma unroll
            for (int u = 0; u < 4; ++u) { const int n = n0 + 8 * u; v[u] = n < nk ? vptr(n)[d] : 0.f; }
#pragma unroll
            for (int u = 0; u < 4; ++u) { const int n = n0 + 8 * u; if (n < nkp) { o0 += sc[n] * v[u]; o1 += sc[1024 + n] * v[u]; o2 += sc[2048 + n] * v[u]; o3 += sc[3072 + n] * v[u]; } }
        }
        part[(F.wave * 4 + 0) * 64 + d] = o0; part[(F.wave * 4 + 1) * 64 + d] = o1; part[(F.wave * 4 + 2) * 64 + d] = o2; part[(F.wave * 4 + 3) * 64 + d] = o3; }
    __syncthreads();
    if (TID_ < 256) { float a = 0.f;
#pragma unroll
        for (int w8 = 0; w8 < 8; ++w8) a += part[w8 * 256 + TID_];
        odst[TID_] = a; }
    __syncthreads();
}
__device__ __forceinline__ void p3_nsa_sample(Frame& F, int task, int part) {
    const int b = task >> 1, kv = task & 1, tok = NTOKP + b, bk = b * 2 + kv;
    LAS float* qs = (LAS float*)(F.lds + SL_Q); LAS float* sc = (LAS float*)(F.lds + SL_S); LAS float* ob = (LAS float*)(F.lds + SL_O);
    LAS float* imp = (LAS float*)(F.lds + SL_IMP); LAS int* sidx = (LAS int*)(F.lds + SL_IDX);
    __syncthreads();
    if (TID_ < 256) qs[TID_] = bf2f(WSP(bf16, WS_QN)[(size_t)tok * 512 + kv * 256 + TID_]);
    __syncthreads();
    const float* kcs = WSP(float, WS_KCMPS) + (size_t)bk * 512 * 64; const float* vcs = WSP(float, WS_VCMPS) + (size_t)bk * 512 * 64;
    const float* nkv = WSP(float, WS_NEWKV) + (size_t)b * 4 * 2 * 64 + kv * 64;
    const float* ckv = F.in[I_CKV]; const int* pt = (const int*)F.in[I_PT] + b * 64; const float* cwin = F.in[I_CWIN] + (size_t)b * 512 * 256;
    if (part == 0) {
    sample_segment(F, 511, kv, [&](int n) { return kcs + (size_t)n * 64; }, [&](int n) { return vcs + (size_t)n * 64; }, [&](int n) { return T - (16 * n + 31); }, ob);
    if (TID_ < 129) { const int j = TID_; float v = 0.f;
        for (int c = 4 * j - 1; c <= 4 * j + 3; ++c) if (c >= 0 && c < 511) v += (sc[c] + sc[1024 + c]) + (sc[2048 + c] + sc[3072 + c]);
        imp[j] = v; }
    __syncthreads();
    if (F.wave == 0) { const int lane = LANE_; unsigned key[3];
#pragma unroll
        for (int m = 0; m < 3; ++m) { const int j = lane + 64 * m; float s = -1e30f;
            if (j < 129) { const bool forced = (j == 0) || (j == 128) || (j == 127); s = imp[j] + (forced ? 1e4f : 0.f); }
            key[m] = (j < 129) ? fkey(s) : 0u; }
        unsigned pre = 0u;
#pragma unroll 1
        for (int bit = 31; bit >= 0; --bit) { const unsigned cand = pre | (1u << bit); int cnt = 0;
#pragma unroll
            for (int m = 0; m < 3; ++m) cnt += __popcll(__ballot(key[m] >= cand));
            if (cnt >= 16) pre = cand; }
        int ngt = 0;
#pragma unroll
        for (int m = 0; m < 3; ++m) ngt += __popcll(__ballot(key[m] > pre));
        int need = 16 - ngt, cnt = 0;
#pragma unroll
        for (int m = 0; m < 3; ++m) { const bool gt = key[m] > pre, tie = key[m] == pre; const unsigned long long tb = __ballot(tie);
            const int trank = __popcll(tb & ((1ull << lane) - 1ull)); const bool sel = gt || (tie && trank < need);
            need -= __popcll(tb); need = need < 0 ? 0 : need;
            const unsigned long long sb = __ballot(sel); const int pos = cnt + __popcll(sb & ((1ull << lane) - 1ull));
            if (sel && pos < 16) sidx[pos] = lane + 64 * m; cnt += __popcll(sb); } }
    __syncthreads();
    sample_segment(F, 1024, kv,
        [&](int n) -> const float* { const int pos = 64 * sidx[n >> 6] + (n & 63); if (pos > T) return nullptr; if (pos == T) return nkv;
                                     return ckv + (((size_t)pt[pos >> 7] * 128 + (pos & 127)) * 4 + 2) * 128 + kv * 64; },
        [&](int n) -> const float* { const int pos = 64 * sidx[n >> 6] + (n & 63); if (pos >= T) return nkv + 128;
                                     return ckv + (((size_t)pt[pos >> 7] * 128 + (pos & 127)) * 4 + 3) * 128 + kv * 64; },
        [&](int n) { return T - (64 * sidx[n >> 6] + (n & 63)); }, ob + 256);
    } else {
    sample_segment(F, 512, kv,
        [&](int n) -> const float* { return n < 511 ? cwin + (size_t)(n + 1) * 256 + kv * 64 : nkv + 256; },
        [&](int n) -> const float* { return n < 511 ? cwin + (size_t)(n + 1) * 256 + 128 + kv * 64 : nkv + 384; },
        [&](int n) { return 511 - n; }, ob + 512);
    }
    if (TID_ < 256) { const int g = TID_ >> 6, d = TID_ & 63, h = kv * 4 + g; const float* gt = WSP(float, WS_GATES) + (size_t)tok * 24 + h * 3;
        const float v = part == 0 ? gt[0] * ob[TID_] + gt[1] * ob[256 + TID_] : gt[2] * ob[512 + TID_];
        atomicAdd(WSP(float, WS_ONS) + (size_t)b * 512 + h * 64 + d, v); }
}

__device__ __forceinline__ void p6_conv(Frame& F) {
    const bf16* ug = WSP(bf16, WS_UG); bf16* act = WSP(bf16, WS_ACT);
    const float* cw = F.in[I_CONVW]; const float* cb = F.in[I_CONVB]; const float* sconv = F.in[I_SCONV];
    constexpr int NG = DFF / 8, RSEG = 64, NSEGP = NTOKP / RSEG, NITEM = NG * (NSEGP + 1);
    { const float* x1s = WSP(float, WS_X1S); float* ys = F.out + O_YS; for (int i = F.bid * NTHR + TID_; i < SB * 1024; i += F.G * NTHR) ys[i] = x1s[i]; }
    for (int it = F.bid * NTHR + TID_; it < NITEM; it += F.G * NTHR) {
        const int seg = it / NG, c0 = 8 * (it % NG);
        float w0[8], w1[8], w2[8], bb[8];
#pragma unroll
        for (int i = 0; i < 8; ++i) { w0[i] = cw[c0 + i]; w1[i] = cw[DFF + c0 + i]; w2[i] = cw[2 * DFF + c0 + i]; bb[i] = cb[c0 + i]; }
        if (seg < NSEGP) {
            const int row0 = seg * RSEG, t0 = row0 & (T - 1);
            float g0[8], g1[8];
            if (t0 >= 2) { unpack8(*(const u32x4*)(ug + (size_t)(row0 - 2) * DUP + DFF + c0), g0); unpack8(*(const u32x4*)(ug + (size_t)(row0 - 1) * DUP + DFF + c0), g1); }
            else {
#pragma unroll
                for (int i = 0; i < 8; ++i) { g0[i] = 0.f; g1[i] = 0.f; } }
#pragma unroll 4
            for (int rr = 0; rr < RSEG; ++rr) { const int row = row0 + rr; float u[8], g2[8], a[8];
                unpack8(*(const u32x4*)(ug + (size_t)row * DUP + c0), u); unpack8(*(const u32x4*)(ug + (size_t)row * DUP + DFF + c0), g2);
#pragma unroll
                for (int i = 0; i < 8; ++i) { a[i] = gelu_tanh(bb[i] + w0[i] * g0[i] + w1[i] * g1[i] + w2[i] * g2[i]) * u[i]; g0[i] = g1[i]; g1[i] = g2[i]; }
                *(u32x4*)(act + (size_t)row * DFF + c0) = pack8(a); }
            if (t0 + RSEG == T) { float* o = F.out + O_CONVP + (size_t)(row0 >> 13) * 2 * DFF + c0;
#pragma unroll
                for (int i = 0; i < 8; ++i) { o[i] = g0[i]; o[DFF + i] = g1[i]; } }
        } else {
            for (int sb = 0; sb < SB; ++sb) { const int row = NTOKP + sb; float u[8], g2[8], g0[8], g1[8], a[8];
                unpack8(*(const u32x4*)(ug + (size_t)row * DUP + c0), u); unpack8(*(const u32x4*)(ug + (size_t)row * DUP + DFF + c0), g2);
#pragma unroll
                for (int i = 0; i < 8; ++i) { g0[i] = sconv[((size_t)sb * 2 + 0) * DFF + c0 + i]; g1[i] = sconv[((size_t)sb * 2 + 1) * DFF + c0 + i]; }
                float* o = F.out + O_CONVS + (size_t)sb * 2 * DFF + c0;
#pragma unroll
                for (int i = 0; i < 8; ++i) { o[i] = g1[i]; o[DFF + i] = g2[i]; a[i] = gelu_tanh(bb[i] + w0[i] * g0[i] + w1[i] * g1[i] + w2[i] * g2[i]) * u[i]; }
                *(u32x4*)(act + (size_t)row * DFF + c0) = pack8(a); }
            for (int row = NTOK; row < MPAD; ++row) *(u32x4*)(act + (size_t)row * DFF + c0) = (u32x4){0u, 0u, 0u, 0u};
        }
    }
}

template <bool A_F32>
__device__ __forceinline__ void skinny_mma(f32x4 (&acc)[2], float (&ssq)[2], const void* A, int lda, const bf16* Bt, int K, int n0, int k0, int nks, int r, int q) {
    acc[0] = (f32x4){0.f, 0.f, 0.f, 0.f}; acc[1] = acc[0]; ssq[0] = 0.f; ssq[1] = 0.f;
#pragma unroll 4
    for (int ks = 0; ks < nks; ++ks) { const int k = k0 + 32 * ks + 8 * q;
        const bf16x8 a = ldfrag(Bt + (size_t)(n0 + r) * K + k);
#pragma unroll
        for (int mt = 0; mt < 2; ++mt) { bf16x8 bfr;
            if (A_F32) { const float* p = (const float*)A + (size_t)(16 * mt + r) * lda + k; const f32x4 x0 = *(const f32x4*)p, x1 = *(const f32x4*)(p + 4);
                ssq[mt] += (x0[0] * x0[0] + x0[1] * x0[1]) + (x0[2] * x0[2] + x0[3] * x0[3]) + (x1[0] * x1[0] + x1[1] * x1[1]) + (x1[2] * x1[2] + x1[3] * x1[3]); bfr = frag_pk(x0, x1); }
            else bfr = ldfrag((const bf16*)A + (size_t)(16 * mt + r) * lda + k);
            acc[mt] = MFMA16(a, bfr, acc[mt]); } }
}
__device__ __forceinline__ void s5_merge(Frame& F, int t) {
    const int lane = LANE_, r = lane & 15, q = lane >> 4, br = t >> 7, nt = (t >> 1) & 63, kc = t & 1;
    const bf16* A = (br == 0 ? WSP(bf16, WS_ONSA) : br == 1 ? WSP(bf16, WS_OGLA) : WSP(bf16, WS_OX)) + (size_t)NTOKP * 512;
    const bf16* Bt = br == 0 ? WSP(bf16, WS_WTNSA) : br == 1 ? WSP(bf16, WS_WTGLA) : WSP(bf16, WS_WTX);
    f32x4 acc[2]; float ssq[2];
    if (br == 0) skinny_mma<true>(acc, ssq, WSP(float, WS_ONS), 512, Bt, 512, 16 * nt, 256 * kc, 8, r, q);
    else skinny_mma<false>(acc, ssq, A, 512, Bt, 512, 16 * nt, 256 * kc, 8, r, q);
    float* ms = WSP(float, WS_MS); const bf16* gate = WSP(bf16, WS_PROJ) + (size_t)NTOKP * DINP + C_MG + br * 1024;
#pragma unroll
    for (int mt = 0; mt < 2; ++mt) { const int m = 16 * mt + r; const u32x2 g = *(const u32x2*)(gate + (size_t)m * DINP + 16 * nt + 4 * q);
        float* d = ms + (size_t)m * 1024 + 16 * nt + 4 * q;
        atomicAdd(d + 0, acc[mt][0] * sigmoidf_(bflo(g.x))); atomicAdd(d + 1, acc[mt][1] * sigmoidf_(bfhi(g.x)));
        atomicAdd(d + 2, acc[mt][2] * sigmoidf_(bflo(g.y))); atomicAdd(d + 3, acc[mt][3] * sigmoidf_(bfhi(g.y))); }
}
__device__ __forceinline__ void s6_wo(Frame& F, int t) {
    const int lane = LANE_, r = lane & 15, q = lane >> 4, nt = t >> 2, kc = t & 3;
    f32x4 acc[2]; float ssq[2]; skinny_mma<true>(acc, ssq, WSP(float, WS_MS), 1024, WSP(bf16, WS_WTO), 1024, 16 * nt, 256 * kc, 8, r, q);
    float* x1s = WSP(float, WS_X1S);
#pragma unroll
    for (int mt = 0; mt < 2; ++mt) { float* d = x1s + (size_t)(16 * mt + r) * 1024 + 16 * nt + 4 * q;
#pragma unroll
        for (int i = 0; i < 4; ++i) atomicAdd(d + i, acc[mt][i]); }
}
__device__ __forceinline__ void s7_up(Frame& F, int t) {
    const int lane = LANE_, r = lane & 15, q = lane >> 4;
    f32x4 acc[2]; float ssq[2]; skinny_mma<true>(acc, ssq, WSP(float, WS_X1S), 1024, WSP(bf16, WS_WTUP), 1024, 16 * t, 0, 32, r, q);
    bf16* ug = WSP(bf16, WS_UG) + (size_t)NTOKP * DUP;
#pragma unroll
    for (int mt = 0; mt < 2; ++mt) { float s = ssq[mt]; s += __shfl_xor(s, 16); s += __shfl_xor(s, 32); const float rs = rsqrtf(s * (1.f / 1024.f) + EPS);
        u32x2 w; w.x = pk2(acc[mt][0] * rs, acc[mt][1] * rs); w.y = pk2(acc[mt][2] * rs, acc[mt][3] * rs);
        *(u32x2*)(ug + (size_t)(16 * mt + r) * DUP + 16 * t + 4 * q) = w; }
}
__device__ __forceinline__ void s9_down(Frame& F, int t) {
    const int lane = LANE_, r = lane & 15, q = lane >> 4, nt = t / 11, kc = t % 11;
    f32x4 acc[2]; float ssq[2]; skinny_mma<false>(acc, ssq, WSP(bf16, WS_ACT) + (size_t)NTOKP * DFF, DFF, WSP(bf16, WS_WTDOWN), DFF, 16 * nt, 256 * kc, 8, r, q);
    float* ys = F.out + O_YS;
#pragma unroll
    for (int mt = 0; mt < 2; ++mt) { float* d = ys + (size_t)(16 * mt + r) * 1024 + 16 * nt + 4 * q;
#pragma unroll
        for (int i = 0; i < 4; ++i) atomicAdd(d + i, acc[mt][i]); }
}

constexpr int N_PHASES = 10;
__global__ void __launch_bounds__(NTHR, 2) mega_fwd(Args args) {
    extern __shared__ __attribute__((aligned(16))) unsigned char lds_raw[];
    cg::grid_group grid = cg::this_grid();
    Frame F;
    F.lds = (LAS unsigned char*)lds_raw;
    F.wave = __builtin_amdgcn_readfirstlane((int)(threadIdx.x >> 6));
    F.G = gridDim.x; F.bid = blockIdx.x; F.gw = F.bid * NWAVES + F.wave; F.NGW = F.G * NWAVES;
    F.in = args.in; F.out = args.out; F.ws = args.ws;
    const int lo = args.ph_lo, hi = args.ph_hi, sub = args.sub;
    volatile LAS unsigned* xst = (volatile LAS unsigned*)(F.lds + 152640);
    if (threadIdx.x < 2) xst[threadIdx.x] = 0u;
    __syncthreads();
    XcdBarrier xbar; xbar.bar = (unsigned*)(args.ws + WS_CTL); xbar.x = 0; xbar.st = xst;
    if (lo == 0 && hi == N_PHASES) xbar = xcd_barrier_post((unsigned*)(args.ws + WS_CTL), xst);
#define SUB(i) ((sub >> (i)) & 1)
#ifndef PROBE_REP
#define PROBE_REP -1
#endif
#define IN(k) (lo <= (k) && (k) < hi)
#define REP(k) for (int rep_ = 0; rep_ < ((k) == PROBE_REP ? 2 : 1); ++rep_)
#define SEAM(k) do { if (IN(k) && IN((k) + 1)) { if ((k) == 0) grid.sync(); else xcd_barrier(xbar); } { unsigned char* w_ = F.ws; asm volatile("" : "+s"(w_)); F.ws = w_; float* o_ = F.out; asm volatile("" : "+s"(o_)); F.out = o_; } } while (0)
    typedef pg8::StaticOrder SO;
    int p2_gla_sample_task = -1;

    REP(0) if (IN(0)) { p0_prologue(F); }
    SEAM(0);
    if (IN(1)) {
        { pg8::Gemm g{WSP(bf16, WS_XN), WSP(bf16, WS_WTIN), MPAD, DINP, 1024}; SO S; S.init(MPAD, DINP, F.G, F.bid);
          pg8::EpiStore E{WSP(bf16, WS_PROJ), DINP, nullptr};
          pg8::gemm_phase<pg8::EpiStore, SO, true, true>(F.lds, g, S, E, F.wave); }
        __syncthreads();
        { pg8::Gemm g{WSP(bf16, WS_MN), WSP(bf16, WS_WTMEM), 512, 1024, 1024}; SO S; S.init(512, 1024, F.G, F.G - 1 - F.bid);
          pg8::EpiStore E{WSP(bf16, WS_MEMPROJ), 1024, nullptr};
          pg8::gemm_phase<pg8::EpiStore, SO, true, true>(F.lds, g, S, E, F.wave); }
    }
    SEAM(1);
    if (IN(2)) {
        if (F.G == 256) {
            const int bid = F.bid;
            if (bid >= 16) { const bool cblk = bid < 136; const int pidx = ((cblk ? bid - 16 : bid - 136) << 3) + F.wave;
                if (SUB(0)) { for (int k = cblk ? 0 : 5; k < (cblk ? 5 : 18); ++k) { const int tok = k * 960 + pidx; if (tok < NTOK) p2_token(F, tok); }
                    if (!cblk && pidx < 512) p2_memrow(F, pidx); }
                if (!cblk && SUB(3) && pidx < SB * 4) p2_gla_sample_task = pidx; }
            if (SUB(1) && bid < CMP_TASKS_S + CMP_TASKS_P) p2_compress(F, bid);
            if (SUB(2)) { if (bid < 16) { __syncthreads(); p2_gla_chunk(F, bid); }
                else if (bid >= 136) { for (int c2 = 0; c2 < 2; ++c2) { __syncthreads(); p2_gla_chunk(F, 16 + (bid - 136) * 2 + c2); } } }
            __syncthreads();
            if (p2_gla_sample_task >= 0) p2_gla_sample(F, p2_gla_sample_task);
        } else {
            if (SUB(0)) { for (int tok = F.gw; tok < NTOK; tok += F.NGW) p2_token(F, tok);
            for (int row = F.gw; row < 512; row += F.NGW) p2_memrow(F, row); }
            if (SUB(1)) for (int t = F.bid; t < CMP_TASKS_S + CMP_TASKS_P; t += F.G) p2_compress(F, t);
            if (SUB(2)) for (int bc = F.bid; bc < 256; bc += F.G) { __syncthreads(); p2_gla_chunk(F, bc); }
            __syncthreads();
            if (SUB(3)) for (int t = F.gw; t < SB * 4; t += F.NGW) p2_gla_sample(F, t);
        }
    }
    SEAM(2);
    REP(3) if (IN(3)) {
        nsa_tables(F);
        const float mb = nsa_bound(F);
        if (SUB(4)) for (int n = F.bid; n < 1024; n += F.G) p3_nsa_prompt(F, n, mb, (sub >> 8) & 255);
        __syncthreads();
        if (SUB(7)) for (int t = F.gw; t < 1024; t += F.NGW) p3_gla_scan(F, t);
    }
    SEAM(3);
    if (IN(4)) {
        nsa_tables(F);
        if (F.G == 256) { if (F.bid >= 192) { const int t = 255 - F.bid; p3_nsa_sample(F, t, 0); p3_nsa_sample(F, t, 1); } }
        else for (int t = F.bid; t < SB * 4; t += F.G) p3_nsa_sample(F, t >> 1, t & 1);
        __syncthreads();
        { const float gq = absmax_arr(F.in[I_GXQ], 128, LANE_), gk = absmax_arr(F.in[I_GXK], 128, LANE_);
          const float mbx = 11.313708498984761f * gq * gk * 1.02f * LOG2E;
          for (int t = F.bid; t < 256; t += F.G) p3_xatt(F, t, mbx); }
        __syncthreads();
        for (int t = F.gw; t < SB * 4; t += F.NGW) p3_xatt_sample(F, t);
        __syncthreads();
        if (F.G == 256) {
            if (F.bid < 192) for (int t = F.gw; t < 4096; t += 192 * NWAVES) p4_gla_out(F, t);
        } else for (int t = F.gw; t < 4096; t += F.NGW) p4_gla_out(F, t);
    }
    SEAM(4);
    if (IN(5)) {
        const bf16* gate = WSP(bf16, WS_PROJ) + C_MG;
        for (int t = F.gw; t < 384; t += F.NGW) s5_merge(F, t);
        { pg8::Gemm g{WSP(bf16, WS_ONSA), WSP(bf16, WS_WTNSA), NTOKP, 1024, 512}; SO S; S.init(NTOKP, 1024, F.G, F.bid);
          pg8::EpiMerge<0> E{gate, DINP, WSP(bf16, WS_MERGED), 1024};
          pg8::gemm_phase<pg8::EpiMerge<0>, SO, true, true>(F.lds, g, S, E, F.wave); }
        __syncthreads();
        { pg8::Gemm g{WSP(bf16, WS_OGLA), WSP(bf16, WS_WTGLA), NTOKP, 1024, 512}; SO S; S.init(NTOKP, 1024, F.G, F.bid);
          pg8::EpiMerge<1> E{gate + 1024, DINP, WSP(bf16, WS_MERGED), 1024};
          pg8::gemm_phase<pg8::EpiMerge<1>, SO, true, true>(F.lds, g, S, E, F.wave); }
        __syncthreads();
        { pg8::Gemm g{WSP(bf16, WS_OX), WSP(bf16, WS_WTX), NTOKP, 1024, 512}; SO S; S.init(NTOKP, 1024, F.G, F.bid);
          pg8::EpiMerge<1> E{gate + 2048, DINP, WSP(bf16, WS_MERGED), 1024};
          pg8::gemm_phase<pg8::EpiMerge<1>, SO, true, true>(F.lds, g, S, E, F.wave); }
    }
    SEAM(5);
    if (IN(6)) {
        for (int t = F.gw; t < 256; t += F.NGW) s6_wo(F, t);
        pg8::Gemm g{WSP(bf16, WS_MERGED), WSP(bf16, WS_WTO), NTOKP, 1024, 1024}; SO S; S.init(NTOKP, 1024, F.G, F.bid);
        pg8::EpiWo E{F.in[I_XP], F.in[I_XS], WSP(float, WS_X1), WSP(bf16, WS_X1B), WSP(float, WS_SSQ)};
        pg8::gemm_phase<pg8::EpiWo, SO, true, true>(F.lds, g, S, E, F.wave);
    }
    SEAM(6);
    if (IN(7)) {
        for (int t = F.gw; t < 352; t += F.NGW) s7_up(F, t);
        pg8::Gemm g{WSP(bf16, WS_X1B), WSP(bf16, WS_WTUP), NTOKP, DUP, 1024}; SO S; S.init(NTOKP, DUP, F.G, F.bid);
        pg8::EpiStore E{WSP(bf16, WS_UG), DUP, WSP(float, WS_SSQ)};
        pg8::gemm_phase<pg8::EpiStore, SO, true, true>(F.lds, g, S, E, F.wave);
    }
    SEAM(7);
    REP(8) if (IN(8)) { p6_conv(F); }
    SEAM(8);
    if (IN(9)) {
        for (int t = F.gw; t < 704; t += F.NGW) s9_down(F, t);
        pg8::Gemm g{WSP(bf16, WS_ACT), WSP(bf16, WS_WTDOWN), NTOKP, 1024, DFF}; SO S; S.init(NTOKP, 1024, F.G, F.bid);
        pg8::EpiDown E{WSP(float, WS_X1), F.out + O_Y, F.out + O_YS};
        pg8::gemm_phase<pg8::EpiDown, SO, true, true>(F.lds, g, S, E, F.wave);
    }
#undef IN
#undef SEAM
}

extern "C" void kernel_launch(void* const* d_in, const int* in_sizes, int n_in, void* d_out, int out_size, void* d_ws, size_t ws_size, hipStream_t stream) {
    static int grid = 0;
    if (grid == 0) {
        if (n_in != N_IN || (size_t)out_size != O_END || ws_size < WS_END) {
            fprintf(stderr, "kernel_launch: built for %d inputs, %zu outputs, >= %zu bytes of workspace; got %d, %d, %zu\n", (int)N_IN, (size_t)O_END, (size_t)WS_END, n_in, out_size, ws_size); grid = -1; return; }
        int dev = 0, cus = 0, per_cu = 0;
        if (hipGetDevice(&dev) != hipSuccess || hipDeviceGetAttribute(&cus, hipDeviceAttributeMultiprocessorCount, dev) != hipSuccess) { grid = -1; return; }
        if (hipFuncSetAttribute((const void*)mega_fwd, hipFuncAttributeMaxDynamicSharedMemorySize, LDS_BYTES) != hipSuccess) { fprintf(stderr, "kernel_launch: hipFuncSetAttribute failed\n"); grid = -1; return; }
        if (hipOccupancyMaxActiveBlocksPerMultiprocessor(&per_cu, (const void*)mega_fwd, NTHR, LDS_BYTES) != hipSuccess || per_cu < 1) { fprintf(stderr, "kernel_launch: occupancy query gave %d\n", per_cu); per_cu = 1; }
        (void)hipGetLastError();
        grid = cus * (per_cu < 1 ? 1 : 1);
    }
    if (grid < 0) return;
    Args a{};
    for (int i = 0; i < N_IN; ++i) a.in[i] = (const float*)d_in[i];
    a.out = (float*)d_out; a.ws = (unsigned char*)d_ws;
#if MK_N_LAUNCHES == 1
    a.ph_lo = 0; a.ph_hi = N_PHASES; a.sub = 0xff;
    (void)hipMemsetAsync((unsigned char*)d_ws + WS_CTL, 0, CTL_BYTES, stream);
    void* kargs[] = {&a};
    hipError_t e = hipLaunchCooperativeKernel((const void*)mega_fwd, dim3(grid), dim3(NTHR), kargs, LDS_BYTES, stream);
    if (e != hipSuccess) fprintf(stderr, "kernel_launch: cooperative launch failed: %s (grid %d)\n", hipGetErrorString(e), grid);
#ifdef PROBE_EXTRA
    a.ph_lo = PROBE_EXTRA; a.ph_hi = PROBE_EXTRA + 1;
#ifdef PROBE_SUB
    a.sub = PROBE_SUB;
#endif
    hipLaunchKernelGGL(mega_fwd, dim3(grid), dim3(NTHR), LDS_BYTES, stream, a);
#endif
#else
    a.sub = 0xff;
    for (int p = 0; p < N_PHASES; ++p) { a.ph_lo = p; a.ph_hi = p + 1; hipLaunchKernelGGL(mega_fwd, dim3(grid), dim3(NTHR), LDS_BYTES, stream, a); }
#endif
}
```

```cpp
#include <hip/hip_runtime.h>
#include <hip/hip_cooperative_groups.h>
#include <cstdio>
#include <cstdint>
namespace cg = cooperative_groups;
#ifndef MK_N_LAUNCHES
#define MK_N_LAUNCHES 1
#endif
namespace pg8 {
#define PG8_LAS __attribute__((address_space(3)))
typedef unsigned short bf16_t;
typedef short bf16x8 __attribute__((ext_vector_type(8)));
typedef float f32x4 __attribute__((ext_vector_type(4)));
typedef unsigned u32x4 __attribute__((ext_vector_type(4)));
constexpr int BM = 256, BK = 64, HALF = 128, HTB = HALF * BK * 2  , STAGE_BYTES = 8 * HTB, NXCD = 8, WGM = 8;

__host__ __device__ __forceinline__ int lds_byte(int r, int c) { const int st = (r >> 4) * 2 + (c >> 5), rr = r & 15, cc = c & 31, ob = rr * 64 + cc * 2; return st * 1024 + (ob ^ (((ob >> 9) & 1) << 5)); }
__host__ __device__ __forceinline__ void stage_rc(int b, int& R, int& C) { const int st = b / 1024, sb = b % 1024, swz = sb ^ (((sb >> 9) & 1) << 5); R = (st >> 1) * 16 + swz / 64; C = (st & 1) * 32 + (swz % 64) / 2; }
__host__ __device__ __forceinline__ int perm32(int rho) { const int n = rho >> 4, i = rho & 15; return 8 * (i >> 2) + 4 * n + (i & 3); }

struct Unit { int pm, pn; };
struct Gemm { const bf16_t* A; const bf16_t* Bt; int M, N, K; };

struct StaticOrder {
    int nM, nN, nwg, G, c;
    __host__ __device__ void init(int M, int N, int G_, int c_) { nM = M / BM; nN = N / BM; nwg = nM * nN; G = G_; c = c_; }
    __host__ __device__ bool next(int i, Unit& u) const {
        const long L = (long)i * G + c; if (L >= nwg) return false;
        int wgid = (int)L; { const int q = nwg / NXCD, r = nwg % NXCD, xcd = wgid % NXCD, off = wgid / NXCD; wgid = (xcd < r ? xcd * (q + 1) : r * (q + 1) + (xcd - r) * q) + off; }
        const int nig = WGM * nN, gid = wgid / nig, fm = gid * WGM, gsz = (nM - fm) < WGM ? (nM - fm) : WGM;
        u.pm = fm + ((wgid % nig) % gsz); u.pn = (wgid % nig) / gsz; return true;
    }
    __device__ __forceinline__ void a_ready(const Unit&) const {}
    __device__ __forceinline__ void done(const Unit&) const {}
};

__device__ __forceinline__ unsigned cvt_pk_bf16(float lo, float hi) { unsigned r; asm volatile("v_cvt_pk_bf16_f32 %0, %1, %2" : "=v"(r) : "v"(lo), "v"(hi)); return r; }
__device__ __forceinline__ float bflo(unsigned w) { return __uint_as_float(w << 16); }
__device__ __forceinline__ float bfhi(unsigned w) { return __uint_as_float(w & 0xffff0000u); }
__device__ __forceinline__ float sigm(float x) { return 1.0f / (1.0f + __expf(-x)); }
struct EpiStore {
    static constexpr bool PERM = true, AFTER_DRAIN = false;
    bf16_t* O; int ldc; const float* ssq;
    __device__ __forceinline__ void operator()(const f32x4 (&acc)[2][2][4][2], const Unit& u, int wr, int wc, int fr, int fq) const {
        const int row0 = u.pm * BM + wr * 64 + fr, col0 = u.pn * BM + wc * 32 + 8 * fq;
#pragma unroll
        for (int ai = 0; ai < 2; ++ai)
#pragma unroll
            for (int m = 0; m < 4; ++m) { const int row = row0 + ai * HALF + m * 16; bf16_t* rowp = O + (size_t)row * ldc + col0;
                const float sc = ssq ? rsqrtf(ssq[row] * (1.0f / 1024.0f) + 1e-6f) : 1.0f;
#pragma unroll
                for (int bj = 0; bj < 2; ++bj) { const f32x4 v0 = acc[ai][bj][m][0] * sc, v1 = acc[ai][bj][m][1] * sc;
                    u32x4 w; w.x = cvt_pk_bf16(v0[0], v0[1]); w.y = cvt_pk_bf16(v0[2], v0[3]); w.z = cvt_pk_bf16(v1[0], v1[1]); w.w = cvt_pk_bf16(v1[2], v1[3]);
                    *(u32x4*)(rowp + bj * HALF) = w; } }
    }
};
template <int ACCUM> struct EpiMerge {
    static constexpr bool PERM = true, AFTER_DRAIN = false;
    const bf16_t* gate; int ldg; bf16_t* O; int ldc;
    __device__ __forceinline__ void operator()(const f32x4 (&acc)[2][2][4][2], const Unit& u, int wr, int wc, int fr, int fq) const {
        const int row0 = u.pm * BM + wr * 64 + fr, col0 = u.pn * BM + wc * 32 + 8 * fq;
#pragma unroll
        for (int ai = 0; ai < 2; ++ai)
#pragma unroll
            for (int m = 0; m < 4; ++m) { const int row = row0 + ai * HALF + m * 16; bf16_t* rowp = O + (size_t)row * ldc + col0; const bf16_t* gp = gate + (size_t)row * ldg + col0;
#pragma unroll
                for (int bj = 0; bj < 2; ++bj) {
                    const u32x4 g = *(const u32x4*)(gp + bj * HALF);
                    f32x4 v0 = acc[ai][bj][m][0], v1 = acc[ai][bj][m][1];
                    v0[0] *= sigm(bflo(g.x)); v0[1] *= sigm(bfhi(g.x)); v0[2] *= sigm(bflo(g.y)); v0[3] *= sigm(bfhi(g.y));
                    v1[0] *= sigm(bflo(g.z)); v1[1] *= sigm(bfhi(g.z)); v1[2] *= sigm(bflo(g.w)); v1[3] *= sigm(bfhi(g.w));
                    if (ACCUM) { const u32x4 o = *(const u32x4*)(rowp + bj * HALF);
                        v0[0] += bflo(o.x); v0[1] += bfhi(o.x); v0[2] += bflo(o.y); v0[3] += bfhi(o.y);
                        v1[0] += bflo(o.z); v1[1] += bfhi(o.z); v1[2] += bflo(o.w); v1[3] += bfhi(o.w); }
                    u32x4 w; w.x = cvt_pk_bf16(v0[0], v0[1]); w.y = cvt_pk_bf16(v0[2], v0[3]); w.z = cvt_pk_bf16(v1[0], v1[1]); w.w = cvt_pk_bf16(v1[2], v1[3]);
                    *(u32x4*)(rowp + bj * HALF) = w; } }
    }
};
struct EpiWo {
    static constexpr bool PERM = true, AFTER_DRAIN = false;
    const float* xp; const float* xs; float* X1; bf16_t* X1B; float* ssq;
    __device__ __forceinline__ void operator()(const f32x4 (&acc)[2][2][4][2], const Unit& u, int wr, int wc, int fr, int fq) const {
        const int row0 = u.pm * BM + wr * 64 + fr, col0 = u.pn * BM + wc * 32 + 8 * fq;
#pragma unroll
        for (int ai = 0; ai < 2; ++ai)
#pragma unroll
            for (int m = 0; m < 4; ++m) { const int row = row0 + ai * HALF + m * 16;
                const float* xr = row < 16384 ? xp + (size_t)row * 1024 : (row < 16416 ? xs + (size_t)(row - 16384) * 1024 : nullptr);
                float ss = 0.f;
#pragma unroll
                for (int bj = 0; bj < 2; ++bj) { const int col = col0 + bj * HALF;
                    f32x4 x0 = (f32x4){0.f, 0.f, 0.f, 0.f}, x1 = x0;
                    if (xr) { x0 = *(const f32x4*)(xr + col); x1 = *(const f32x4*)(xr + col + 4); }
                    const f32x4 v0 = acc[ai][bj][m][0] + x0, v1 = acc[ai][bj][m][1] + x1;
                    *(f32x4*)(X1 + (size_t)row * 1024 + col) = v0; *(f32x4*)(X1 + (size_t)row * 1024 + col + 4) = v1;
                    u32x4 w; w.x = cvt_pk_bf16(v0[0], v0[1]); w.y = cvt_pk_bf16(v0[2], v0[3]); w.z = cvt_pk_bf16(v1[0], v1[1]); w.w = cvt_pk_bf16(v1[2], v1[3]);
                    *(u32x4*)(X1B + (size_t)row * 1024 + col) = w;
                    ss += (v0[0] * v0[0] + v0[1] * v0[1]) + (v0[2] * v0[2] + v0[3] * v0[3]) + (v1[0] * v1[0] + v1[1] * v1[1]) + (v1[2] * v1[2] + v1[3] * v1[3]); }
                ss += __shfl_xor(ss, 16); ss += __shfl_xor(ss, 32);
                if (fq == 0) atomicAdd(ssq + row, ss); }
    }
};
struct EpiDown {
    static constexpr bool PERM = true, AFTER_DRAIN = false;
    const float* X1; float* yp; float* ys;
    __device__ __forceinline__ void operator()(const f32x4 (&acc)[2][2][4][2], const Unit& u, int wr, int wc, int fr, int fq) const {
        const int row0 = u.pm * BM + wr * 64 + fr, col0 = u.pn * BM + wc * 32 + 8 * fq;
#pragma unroll
        for (int ai = 0; ai < 2; ++ai)
#pragma unroll
            for (int m = 0; m < 4; ++m) { const int row = row0 + ai * HALF + m * 16;
                float* yr = row < 16384 ? yp + (size_t)row * 1024 : (row < 16416 ? ys + (size_t)(row - 16384) * 1024 : nullptr);
                if (!yr) continue;
#pragma unroll
                for (int bj = 0; bj < 2; ++bj) { const int col = col0 + bj * HALF;
                    const f32x4 x0 = *(const f32x4*)(X1 + (size_t)row * 1024 + col), x1 = *(const f32x4*)(X1 + (size_t)row * 1024 + col + 4);
                    *(f32x4*)(yr + col) = acc[ai][bj][m][0] + x0; *(f32x4*)(yr + col + 4) = acc[ai][bj][m][1] + x1; } }
    }
};
template <class Epi, class Sched, bool ALIGN_EPI = false, bool SP2 = false>
__device__ __forceinline__ void gemm_phase(PG8_LAS unsigned char* lds, const Gemm g, const Sched& S, const Epi& E, const int wid) {
    unsigned z_ = 0u; asm volatile("" : "+v"(z_));
    const int lane = (int)__builtin_amdgcn_mbcnt_hi(~0u, __builtin_amdgcn_mbcnt_lo(~0u, z_)), tid = wid * 64 + lane, wr = wid >> 2, wc = wid & 3, fr = lane & 15, fq = lane >> 4;
    const int K = g.K, nt = K / BK;
    unsigned voffA[2], voffB[2];
#pragma unroll
    for (int i = 0; i < 2; ++i) { int R, C; stage_rc(tid * 16 + i * 8192, R, C); const int Rb = Epi::PERM ? ((R & ~31) + perm32(R & 31)) : R;
        voffA[i] = (unsigned)(R * K + C) * 2u; voffB[i] = (unsigned)(Rb * K + C) * 2u; }
    const size_t kstep = (size_t)(BK * 2);
    const size_t hstep = (size_t)HALF * K * 2;
    const size_t tstep = 2 * hstep;
    const unsigned ldsw = (unsigned)wid * 1024u;
    const int aoff = lds_byte(wr * 64 + fr, fq * 8), boff = lds_byte(wc * 32 + fr, fq * 8);
#define PG8_SA(b, h) (((b) * 2 + (h)) * HTB)
#define PG8_SB(b, h) ((4 + (b) * 2 + (h)) * HTB)
#define PG8_STAGE(bufoff, gbase, voff) do { _Pragma("unroll") for (int _i = 0; _i < 2; ++_i) \
        __builtin_amdgcn_global_load_lds((const unsigned*)((const char*)(gbase) + (voff)[_i]), (PG8_LAS unsigned*)(lds + (bufoff) + ldsw + _i * 8192), 16, 0, 0); } while (0)
#define PG8_LDA(dst, b, h) do { _Pragma("unroll") for (int m = 0; m < 4; ++m) _Pragma("unroll") for (int k = 0; k < 2; ++k) dst[m][k] = *(const PG8_LAS bf16x8*)(lds + PG8_SA(b, h) + aoff + m * 2048 + k * 1024); } while (0)
#define PG8_LDB(dst, b, h) do { _Pragma("unroll") for (int n = 0; n < 2; ++n) _Pragma("unroll") for (int k = 0; k < 2; ++k) dst[n][k] = *(const PG8_LAS bf16x8*)(lds + PG8_SB(b, h) + boff + n * 2048 + k * 1024); } while (0)
#define PG8_MMA(ai, bj, At, Bt) do { __builtin_amdgcn_s_setprio(1); _Pragma("unroll") for (int m = 0; m < 4; ++m) _Pragma("unroll") for (int n = 0; n < 2; ++n) _Pragma("unroll") for (int k = 0; k < 2; ++k) \
        acc[ai][bj][m][n] = __builtin_amdgcn_mfma_f32_16x16x32_bf16(Bt[n][k], At[m][k], acc[ai][bj][m][n], 0, 0, 0); __builtin_amdgcn_s_setprio(0); } while (0)
#define PG8_WAIT_V(n) asm volatile("s_waitcnt vmcnt(" #n ")" ::: "memory")
#define PG8_WAIT_L(n) asm volatile("s_waitcnt lgkmcnt(" #n ")" ::: "memory")
#define PG8_BAR __builtin_amdgcn_s_barrier()
#define PG8_SCHED __builtin_amdgcn_sched_barrier(0)
    Unit cur, nxt; int ui = 0;
    if (!S.next(0, cur)) return;
    f32x4 acc[2][2][4][2];
#pragma unroll
    for (int a = 0; a < 2; ++a)
#pragma unroll
        for (int b = 0; b < 2; ++b)
#pragma unroll
            for (int m = 0; m < 4; ++m)
#pragma unroll
                for (int n = 0; n < 2; ++n) acc[a][b][m][n] = (f32x4){0.f, 0.f, 0.f, 0.f};
    bf16x8 At[4][2], B0[2][2], B1[2][2];
    const char* cA = (const char*)g.A + (size_t)cur.pm * tstep; const char* cB = (const char*)g.Bt + (size_t)cur.pn * tstep;
    S.a_ready(cur);
    if constexpr (SP2) {
        PG8_STAGE(PG8_SB(0, 0), cB, voffB); PG8_STAGE(PG8_SB(0, 1), cB + hstep, voffB); PG8_STAGE(PG8_SA(0, 0), cA, voffA); PG8_STAGE(PG8_SA(0, 1), cA + hstep, voffA);
        if (wr == 1) PG8_BAR;
        PG8_WAIT_V(2); PG8_BAR;
        PG8_STAGE(PG8_SB(1, 0), cB + kstep, voffB); PG8_STAGE(PG8_SA(1, 0), cA + kstep, voffA); PG8_STAGE(PG8_SB(1, 1), cB + hstep + kstep, voffB);
        PG8_WAIT_V(6); PG8_BAR;
    } else {
        PG8_STAGE(PG8_SB(0, 0), cB, voffB); PG8_STAGE(PG8_SA(0, 0), cA, voffA); PG8_STAGE(PG8_SB(0, 1), cB + hstep, voffB); PG8_STAGE(PG8_SA(0, 1), cA + hstep, voffA);
        if (wr == 1) PG8_BAR;
        PG8_WAIT_V(4); PG8_BAR;
        PG8_STAGE(PG8_SB(1, 0), cB + kstep, voffB); PG8_STAGE(PG8_SA(1, 0), cA + kstep, voffA); PG8_STAGE(PG8_SB(1, 1), cB + hstep + kstep, voffB);
        PG8_WAIT_V(6); PG8_BAR;
    }
    for (;;) {
        const bool has_next = S.next(ui + 1, nxt);
        const char* nA = has_next ? (const char*)g.A + (size_t)nxt.pm * tstep : cA; const char* nB = has_next ? (const char*)g.Bt + (size_t)nxt.pn * tstep : cB;
        for (int t = 0; t < nt; t += 2) {
            const bool last = (t == nt - 2);
            const char* a1 = cA + (size_t)(t + 1) * kstep;
            const char* a2 = last ? nA : cA + (size_t)(t + 2) * kstep; const char* b2 = last ? nB : cB + (size_t)(t + 2) * kstep;
            const char* a3 = a2 + kstep; const char* b3 = b2 + kstep;
            if (last && has_next) S.a_ready(nxt);
            if constexpr (SP2) {
            PG8_LDB(B0, 0, 0); PG8_LDB(B1, 0, 1); PG8_SCHED; PG8_LDA(At, 0, 0); PG8_STAGE(PG8_SA(1, 1), a1 + hstep, voffA);
            PG8_WAIT_V(8); PG8_WAIT_L(0); PG8_BAR; PG8_MMA(0, 0, At, B0); PG8_MMA(0, 1, At, B1); PG8_BAR; PG8_SCHED;
            PG8_LDA(At, 0, 1); PG8_STAGE(PG8_SB(0, 0), b2, voffB); PG8_STAGE(PG8_SB(0, 1), b2 + hstep, voffB); PG8_STAGE(PG8_SA(0, 0), a2, voffA);
            PG8_WAIT_V(8); PG8_WAIT_L(0); PG8_BAR; PG8_MMA(1, 0, At, B0); PG8_MMA(1, 1, At, B1); PG8_BAR; PG8_SCHED;
            PG8_LDB(B0, 1, 0); PG8_LDB(B1, 1, 1); PG8_SCHED; PG8_LDA(At, 1, 0); PG8_STAGE(PG8_SA(0, 1), a2 + hstep, voffA);
            PG8_WAIT_V(8); PG8_WAIT_L(0); PG8_BAR; PG8_MMA(0, 0, At, B0); PG8_MMA(0, 1, At, B1); PG8_BAR; PG8_SCHED;
            PG8_LDA(At, 1, 1); PG8_STAGE(PG8_SB(1, 0), b3, voffB); PG8_STAGE(PG8_SB(1, 1), b3 + hstep, voffB); PG8_STAGE(PG8_SA(1, 0), a3, voffA);
            PG8_WAIT_V(8); PG8_WAIT_L(0); PG8_BAR; PG8_MMA(1, 0, At, B0); PG8_MMA(1, 1, At, B1); PG8_BAR; PG8_SCHED;
            } else {
            PG8_LDB(B0, 0, 0); PG8_SCHED; PG8_LDA(At, 0, 0); PG8_STAGE(PG8_SA(1, 1), a1 + hstep, voffA);
            PG8_WAIT_L(8); PG8_BAR; PG8_WAIT_L(0); PG8_MMA(0, 0, At, B0); PG8_BAR; PG8_SCHED;
            PG8_LDB(B1, 0, 1); PG8_STAGE(PG8_SB(0, 0), b2, voffB);
            PG8_BAR; PG8_WAIT_L(0); PG8_MMA(0, 1, At, B1); PG8_BAR;
            PG8_LDA(At, 0, 1); PG8_STAGE(PG8_SA(0, 0), a2, voffA);
            PG8_BAR; PG8_WAIT_L(0); PG8_MMA(1, 0, At, B0); PG8_BAR; PG8_SCHED;
            PG8_STAGE(PG8_SB(0, 1), b2 + hstep, voffB);
            PG8_WAIT_V(6); PG8_BAR; PG8_MMA(1, 1, At, B1); PG8_BAR;
            PG8_LDB(B0, 1, 0); PG8_SCHED; PG8_LDA(At, 1, 0); PG8_STAGE(PG8_SA(0, 1), a2 + hstep, voffA);
            PG8_WAIT_L(8); PG8_BAR; PG8_WAIT_L(0); PG8_MMA(0, 0, At, B0); PG8_BAR; PG8_SCHED;
            PG8_LDB(B1, 1, 1); PG8_STAGE(PG8_SB(1, 0), b3, voffB);
            PG8_BAR; PG8_WAIT_L(0); PG8_MMA(0, 1, At, B1); PG8_BAR;
            PG8_LDA(At, 1, 1); PG8_STAGE(PG8_SA(1, 0), a3, voffA);
            PG8_BAR; PG8_WAIT_L(0); PG8_MMA(1, 0, At, B0); PG8_BAR; PG8_SCHED;
            PG8_STAGE(PG8_SB(1, 1), b3 + hstep, voffB);
            PG8_WAIT_V(6); PG8_BAR; PG8_MMA(1, 1, At, B1); PG8_BAR;
            }
        }
        if constexpr (ALIGN_EPI) { if (wr == 0) PG8_BAR; }
        if constexpr (!Epi::AFTER_DRAIN) { E(acc, cur, wr, wc, fr, fq); S.done(cur); }
        if (!has_next) break;
#pragma unroll
        for (int a = 0; a < 2; ++a)
#pragma unroll
            for (int b = 0; b < 2; ++b)
#pragma unroll
                for (int m = 0; m < 4; ++m)
#pragma unroll
                    for (int n = 0; n < 2; ++n) acc[a][b][m][n] = (f32x4){0.f, 0.f, 0.f, 0.f};
        cur = nxt; cA = nA; cB = nB; ++ui;
        if constexpr (ALIGN_EPI) { if (wr == 1) PG8_BAR; }
    }
    PG8_WAIT_V(0);
    if constexpr (!ALIGN_EPI) { if (wr == 0) PG8_BAR; }
    PG8_BAR;
    if constexpr (Epi::AFTER_DRAIN) { E.fused(acc, cur, wr, wc, fr, fq, lds, wid, lane); S.done(cur); }
#undef PG8_SA
#undef PG8_SB
#undef PG8_STAGE
#undef PG8_LDA
#undef PG8_LDB
#undef PG8_MMA
#undef PG8_WAIT_V
#undef PG8_WAIT_L
#undef PG8_BAR
#undef PG8_SCHED
}
}

typedef unsigned short bf16;
typedef short bf16x8 __attribute__((ext_vector_type(8)));
typedef short bf16x4 __attribute__((ext_vector_type(4)));
typedef float f32x4 __attribute__((ext_vector_type(4)));
typedef unsigned u32x4 __attribute__((ext_vector_type(4)));
typedef unsigned u32x2 __attribute__((ext_vector_type(2)));
#define LAS __attribute__((address_space(3)))
constexpr int NWAVES = 8, NTHR = 512;
constexpr int DM = 1024, T = 8192, NB = 2, NTOKP = NB * T, SB = 32, NTOK = NTOKP + SB, MPAD = 16640;
constexpr int DIN = 6440, DINP = 6656, DFF = 2816, DUP = 2 * DFF;
constexpr int C_Q = 0, C_KV = 512, C_G = 1280, C_GQ = 1304, C_GK = 1560, C_GV = 1816, C_LR = 2328, C_GR = 2344, C_XQ = 2856, C_MG = 3368;
constexpr float EPS = 1e-6f, LOG2E = 1.4426950408889634f;
constexpr float QSCALE = 0.125f * LOG2E;
constexpr float XSCALE = 0.08838834764831845f * LOG2E;
constexpr size_t O_Y = 0, O_YS = 16777216, O_KVP = O_YS + 32768, O_WINP = O_KVP + 8388608, O_GLAP = O_WINP + 262144, O_CONVP = O_GLAP + 65536,
                 O_MEMP = O_CONVP + 11264, O_KVS = O_MEMP + 524288, O_WINS = O_KVS + 16384, O_GLAS = O_WINS + 4194304, O_CONVS = O_GLAS + 1048576, O_END = O_CONVS + 180224;
enum { I_XP = 0, I_XS, I_CKV, I_CWIN, I_SGLA, I_SCONV, I_CMEM, I_PT, I_MEMP, I_GMIX, I_WIN, I_GNQ, I_GNK, I_CKPE, I_CKW1, I_CKW2, I_CVPE, I_CVW1, I_CVW2,
       I_RB, I_WGG, I_BGG, I_GGO, I_GMEM, I_WMEM, I_GXQ, I_GXK, I_WNSA, I_WGLA, I_WX, I_WO, I_GFFN, I_WUP, I_CONVW, I_CONVB, I_WDOWN, N_IN };
constexpr size_t al_(size_t x) { return (x + 255) & ~(size_t)255; }
constexpr size_t WS_SSQ = 0;
constexpr size_t WS_C0 = al_(WS_SSQ + (size_t)MPAD * 4);
constexpr size_t WS_WTIN = al_(WS_C0 + 1024);
constexpr size_t WS_WTMEM = al_(WS_WTIN + (size_t)DINP * 1024 * 2);
constexpr size_t WS_WTNSA = al_(WS_WTMEM + (size_t)1024 * 1024 * 2);
constexpr size_t WS_WTGLA = al_(WS_WTNSA + (size_t)1024 * 512 * 2);
constexpr size_t WS_WTX = al_(WS_WTGLA + (size_t)1024 * 512 * 2);
constexpr size_t WS_WTO = al_(WS_WTX + (size_t)1024 * 512 * 2);
constexpr size_t WS_WTUP = al_(WS_WTO + (size_t)1024 * 1024 * 2);
constexpr size_t WS_WTDOWN = al_(WS_WTUP + (size_t)DUP * 1024 * 2);
constexpr size_t WS_W1T = al_(WS_WTDOWN + (size_t)1024 * DFF * 2);
constexpr size_t WS_W2T = al_(WS_W1T + (size_t)2 * 64 * 2048 * 2);
constexpr size_t WS_XN = al_(WS_W2T + (size_t)2 * 64 * 64 * 2);
constexpr size_t WS_MN = al_(WS_XN + (size_t)MPAD * 1024 * 2);
constexpr size_t WS_PROJ = al_(WS_MN + (size_t)512 * 1024 * 2);
constexpr size_t WS_MEMPROJ = al_(WS_PROJ + (size_t)MPAD * DINP * 2);
constexpr size_t WS_QN = al_(WS_MEMPROJ + (size_t)512 * 1024 * 2);
constexpr size_t WS_KSEL = al_(WS_QN + (size_t)NTOK * 512 * 2);
constexpr size_t WS_VSELT = al_(WS_KSEL + (size_t)4 * T * 64 * 2);
constexpr size_t WS_KWIN = al_(WS_VSELT + (size_t)4 * T * 64 * 2);
constexpr size_t WS_VWINT = al_(WS_KWIN + (size_t)4 * T * 64 * 2);
constexpr size_t WS_GATES = al_(WS_VWINT + (size_t)4 * T * 64 * 2);
constexpr size_t WS_NEWKV = al_(WS_GATES + (size_t)NTOK * 24 * 4);
constexpr size_t WS_KCMP = al_(WS_NEWKV + (size_t)SB * 4 * 2 * 64 * 4);
constexpr size_t WS_VCMPT = al_(WS_KCMP + (size_t)4 * 512 * 64 * 2);
constexpr size_t WS_KCMPS = al_(WS_VCMPT + (size_t)4 * 512 * 64 * 2);
constexpr size_t WS_VCMPS = al_(WS_KCMPS + (size_t)SB * 2 * 512 * 64 * 4);
constexpr size_t WS_QTG = al_(WS_VCMPS + (size_t)SB * 2 * 512 * 64 * 4);
constexpr size_t WS_KTG = al_(WS_QTG + (size_t)NTOKP * 256 * 2);
constexpr size_t WS_VTG = al_(WS_KTG + (size_t)NTOKP * 256 * 2);
constexpr size_t WS_UP = al_(WS_VTG + (size_t)256 * 4 * 128 * 64 * 2);
constexpr size_t WS_DEC = al_(WS_UP + (size_t)256 * 4 * 128 * 64 * 4);
constexpr size_t WS_SC = al_(WS_DEC + (size_t)256 * 4 * 64 * 4);
constexpr size_t WS_XQ = al_(WS_SC + (size_t)256 * 4 * 128 * 64 * 2);
constexpr size_t WS_KMEM = al_(WS_XQ + (size_t)NTOK * 512 * 2);
constexpr size_t WS_VMEMT = al_(WS_KMEM + (size_t)8 * 256 * 128 * 2);
constexpr size_t WS_ONSA = al_(WS_VMEMT + (size_t)8 * 256 * 128 * 2);
constexpr size_t WS_OGLA = al_(WS_ONSA + (size_t)MPAD * 512 * 2);
constexpr size_t WS_OX = al_(WS_OGLA + (size_t)MPAD * 512 * 2);
constexpr size_t WS_MERGED = al_(WS_OX + (size_t)MPAD * 512 * 2);
constexpr size_t WS_X1 = al_(WS_MERGED + (size_t)MPAD * 1024 * 2);
constexpr size_t WS_X1B = al_(WS_X1 + (size_t)MPAD * 1024 * 4);
constexpr size_t WS_UG = al_(WS_X1B + (size_t)MPAD * 1024 * 2);
constexpr size_t WS_ACT = al_(WS_UG + (size_t)MPAD * DUP * 2);
constexpr size_t WS_MS = al_(WS_ACT + (size_t)MPAD * DFF * 2);
constexpr size_t WS_X1S = al_(WS_MS + (size_t)SB * 1024 * 4);
constexpr size_t WS_ONS = al_(WS_X1S + (size_t)SB * 1024 * 4);
constexpr size_t WS_PARK = al_(WS_ONS + (size_t)SB * 512 * 4);
constexpr size_t WS_CTL = al_(WS_PARK + (size_t)2048 * 4096);
constexpr size_t CTL_BYTES = 16384;
constexpr size_t WS_END = al_(WS_CTL + CTL_BYTES);
constexpr int RING_BYTES = 131072, LDS_BYTES = 155648;

struct Args { const float* in[N_IN]; float* out; unsigned char* ws; int ph_lo, ph_hi, sub, pad; };

__device__ __forceinline__ unsigned f2bf(float f) { unsigned u = __float_as_uint(f); return (u + 0x7fffu + ((u >> 16) & 1u)) >> 16; }
__device__ __forceinline__ unsigned pk2(float lo, float hi) { return pg8::cvt_pk_bf16(lo, hi); }
__device__ __forceinline__ float bf2f(unsigned short u) { return __uint_as_float((unsigned)u << 16); }
__device__ __forceinline__ float bflo(unsigned w) { return __uint_as_float(w << 16); }
__device__ __forceinline__ float bfhi(unsigned w) { return __uint_as_float(w & 0xffff0000u); }
__device__ __forceinline__ void unpack8(const u32x4 w, float (&f)[8]) { f[0] = bflo(w.x); f[1] = bfhi(w.x); f[2] = bflo(w.y); f[3] = bfhi(w.y); f[4] = bflo(w.z); f[5] = bfhi(w.z); f[6] = bflo(w.w); f[7] = bfhi(w.w); }
__device__ __forceinline__ u32x4 pack8(const float (&f)[8]) { u32x4 w; w.x = pk2(f[0], f[1]); w.y = pk2(f[2], f[3]); w.z = pk2(f[4], f[5]); w.w = pk2(f[6], f[7]); return w; }
__device__ __forceinline__ bf16x8 as_frag(u32x4 w) { return __builtin_bit_cast(bf16x8, w); }
__device__ __forceinline__ bf16x8 frag_pk(f32x4 a, f32x4 b) { u32x4 w; w.x = pk2(a[0], a[1]); w.y = pk2(a[2], a[3]); w.z = pk2(b[0], b[1]); w.w = pk2(b[2], b[3]); return as_frag(w); }
__device__ __forceinline__ bf16x8 ldfrag(const bf16* p) { return as_frag(*(const u32x4*)p); }
__device__ __forceinline__ bf16x8 ldfrag2(const bf16* p0, const bf16* p1) { const u32x2 a = *(const u32x2*)p0, b = *(const u32x2*)p1; u32x4 w; w.x = a.x; w.y = a.y; w.z = b.x; w.w = b.y; return as_frag(w); }
__device__ __forceinline__ bf16x8 ldfrag_f32(const float* p) { const f32x4 a = *(const f32x4*)p, b = *(const f32x4*)(p + 4); return frag_pk(a, b); }
#define MFMA16(a, b, c) __builtin_amdgcn_mfma_f32_16x16x32_bf16((a), (b), (c), 0, 0, 0)
__device__ __forceinline__ float sigmoidf_(float x) { return 1.0f / (1.0f + __expf(-x)); }
__device__ __forceinline__ float gelu_tanh(float x) { const float u = 0.7978845608028654f * (x + 0.044715f * x * x * x); const float e = __expf(2.0f * u); return 0.5f * x * (2.0f - 2.0f / (e + 1.0f)); }
__device__ __forceinline__ float wave_sum(float v) {
#pragma unroll
    for (int o = 1; o < 64; o <<= 1) v += __shfl_xor(v, o);
    return v;
}
__device__ __forceinline__ float wave_max(float v) {
#pragma unroll
    for (int o = 1; o < 64; o <<= 1) v = fmaxf(v, __shfl_xor(v, o));
    return v;
}
__device__ __forceinline__ float absmax_arr(const float* g, int n, int lane) { float m = 0.f; for (int i = lane; i < n; i += 64) m = fmaxf(m, fabsf(g[i])); return wave_max(m); }
__device__ __forceinline__ int t5_bucket(int n) {
    if (n < 16) return n;
    if (n >= 128) return 31;
    const int v = 16 + (int)(__logf((float)n * 0.0625f) / 2.0794415416798357f * 16.0f);
    return v < 31 ? v : 31;
}

#define XB_TMO      128
#define XB_XCNT(j)  (256  + 64 * (j))
#define XB_XSUB(j)  (1280 + 64 * (j))
#define XB_XGEN(j)  (2304 + 64 * (j))
#define XB_TOP      3328
#define XB_TOPGEN   3392
#define XCD_BAR_WORDS 3456
#define XB_SPIN_CAP (1u << 18)

__device__ __forceinline__ unsigned xb_ld(unsigned* p)              { return __hip_atomic_load(p, __ATOMIC_RELAXED, __HIP_MEMORY_SCOPE_AGENT); }
__device__ __forceinline__ unsigned xb_add(unsigned* p, unsigned v) { return __hip_atomic_fetch_add(p, v, __ATOMIC_RELAXED, __HIP_MEMORY_SCOPE_AGENT); }
__device__ __forceinline__ unsigned xb_xcc_id() { return (unsigned)__builtin_amdgcn_s_getreg((3 << 11) | 20) & 0xFu; }
#define XB_SPIN(cond, bar) do { unsigned _sp = 0; while (cond) { __builtin_amdgcn_s_sleep(1); \
    if ((++_sp & 255u) == 0u) { if (xb_ld(&(bar)[XB_TMO])) break; if (_sp > XB_SPIN_CAP) { atomicAdd(&(bar)[XB_TMO], 1u); break; } } } } while (0)

struct XcdBarrier {
    unsigned* bar; unsigned x;
    volatile LAS unsigned* st;
};

__device__ __forceinline__ XcdBarrier xcd_barrier_post(unsigned* bar, volatile LAS unsigned* st) {
    XcdBarrier b; b.bar = bar; b.x = xb_xcc_id(); b.st = st;
    if (threadIdx.x == 0) (void)xb_add(&bar[XB_XCNT(b.x)], 1u);
    return b;
}
__device__ __forceinline__ void xcd_barrier_complete(unsigned* bar, unsigned x, unsigned& nloc, unsigned& nx) {
    const unsigned G = gridDim.x * gridDim.y * gridDim.z;
    unsigned sum, cnt, mine, sp = 0u;
    for (;;) {
        sum = 0u; cnt = 0u; mine = 0u;
#pragma unroll
        for (unsigned j = 0; j < 16; ++j) { const unsigned c = xb_ld(&bar[XB_XCNT(j)]); sum += c; cnt += (c > 0u) ? 1u : 0u; mine = (j == x) ? c : mine; }
        if (sum == G) break;
        __builtin_amdgcn_s_sleep(1);
        if ((++sp & 255u) == 0u) { if (xb_ld(&bar[XB_TMO])) break; if (sp > XB_SPIN_CAP) { atomicAdd(&bar[XB_TMO], 1u); break; } }
    }
    nloc = mine > 0u ? mine : 1u; nx = cnt > 0u ? cnt : 1u;
}

__device__ __forceinline__ void xcd_barrier(const XcdBarrier& b) {
    asm volatile("s_waitcnt vmcnt(0)" ::: "memory");
    __syncthreads();
    if (threadIdx.x == 0) {
        unsigned* bar = b.bar;
        __builtin_amdgcn_s_waitcnt(0);
        unsigned nloc = b.st[0], nx = b.st[1];
        if (nloc == 0u) { xcd_barrier_complete(bar, b.x, nloc, nx); b.st[0] = nloc; b.st[1] = nx; }
        const unsigned old = xb_add(&bar[XB_XSUB(b.x)], 1u);
        const unsigned gen = old / nloc;
        if (old + 1u == (gen + 1u) * nloc) {
            __builtin_amdgcn_fence(__ATOMIC_RELEASE, "agent");
            asm volatile("s_waitcnt vmcnt(0)" ::: "memory");
            const unsigned og = xb_add(&bar[XB_TOP], 1u);
            const unsigned tg = og / nx;
            if (og + 1u == (tg + 1u) * nx) xb_add(&bar[XB_TOPGEN], 1u);
            else XB_SPIN(xb_ld(&bar[XB_TOPGEN]) == tg, bar);
            __builtin_amdgcn_fence(__ATOMIC_ACQUIRE, "agent");
            xb_add(&bar[XB_XGEN(b.x)], 1u);
            asm volatile("s_waitcnt vmcnt(0)" ::: "memory");
        } else {
            XB_SPIN(xb_ld(&bar[XB_XGEN(b.x)]) == gen, bar);
            __builtin_amdgcn_fence(__ATOMIC_ACQUIRE, "agent");
            asm volatile("s_waitcnt vmcnt(0)" ::: "memory");
        }
    }
    __syncthreads();
}

struct Frame {
    LAS unsigned char* lds;
    int wave, G, bid, gw, NGW;
    const float* const* in; float* out; unsigned char* ws;
};
#define WSP(T_, off) ((T_*)(F.ws + (off)))
__device__ __forceinline__ int lane_id_() { unsigned z = 0u; asm volatile("" : "+v"(z)); return (int)__builtin_amdgcn_mbcnt_hi(~0u, __builtin_amdgcn_mbcnt_lo(~0u, z)); }
#define LANE_ lane_id_()
#define TID_ (F.wave * 64 + lane_id_())

__device__ __forceinline__ void transpose_item(const float* W, int K, int N, bf16* WT, const float* kscale, LAS float* scr, int item, int nblk, int lane) {
    const int kb = item / nblk, nb = item % nblk, k0 = 64 * kb, n0 = 32 * nb;
#pragma unroll
    for (int i = 0; i < 8; ++i) { const int kk = 8 * i + (lane >> 3); const int n = n0 + 4 * (lane & 7);
        f32x4 v = n < N ? *(const f32x4*)(W + (size_t)(k0 + kk) * N + n) : (f32x4){0.f, 0.f, 0.f, 0.f}; if (kscale) v = v * kscale[k0 + kk];
        LAS float* d = scr + kk * 33 + 4 * (lane & 7); d[0] = v[0]; d[1] = v[1]; d[2] = v[2]; d[3] = v[3]; }
    asm volatile("s_waitcnt lgkmcnt(0)" ::: "memory");
    const int c = lane & 7;
#pragma unroll
    for (int j = 0; j < 4; ++j) { const int n = (lane >> 3) + 8 * j; const LAS float* s = scr + (8 * c) * 33 + n;
        u32x4 o; o.x = pk2(s[0 * 33], s[1 * 33]); o.y = pk2(s[2 * 33], s[3 * 33]); o.z = pk2(s[4 * 33], s[5 * 33]); o.w = pk2(s[6 * 33], s[7 * 33]);
        *(u32x4*)(WT + (size_t)(n0 + n) * K + k0 + 8 * c) = o; }
    asm volatile("s_waitcnt lgkmcnt(0)" ::: "memory");
}
__device__ __forceinline__ void rms_row_to_bf16(const float* xrow, const float* g, bf16* orow, int lane) {
    unsigned long long* o8 = (unsigned long long*)orow + lane;
    if (!xrow) {
#pragma unroll
        for (int j = 0; j < 4; ++j) o8[64 * j] = 0ull;
        return; }
    const f32x4* xr = (const f32x4*)xrow + lane; const f32x4* gr = (const f32x4*)g + lane;
    f32x4 v[4]; float s = 0.f;
#pragma unroll
    for (int j = 0; j < 4; ++j) { v[j] = xr[64 * j]; s += (v[j].x * v[j].x + v[j].y * v[j].y) + (v[j].z * v[j].z + v[j].w * v[j].w); }
    const float rs = rsqrtf(wave_sum(s) * (1.f / 1024.f) + EPS);
#pragma unroll
    for (int j = 0; j < 4; ++j) { const f32x4 gg = gr[64 * j]; const f32x4 y = v[j] * rs * gg;
        o8[64 * j] = (unsigned long long)pk2(y.x, y.y) | ((unsigned long long)pk2(y.z, y.w) << 32); }
}
__device__ __forceinline__ void p0_prologue(Frame& F) {
    LAS float* scr = (LAS float*)(F.lds + F.wave * 16384);
    const int gw = F.gw, NGW = F.NGW;
    constexpr int IT_IN = 16 * 208, IT_MEM = 16 * 32, IT_BR = 8 * 32, IT_O = 16 * 32, IT_UP = 16 * 176, IT_DOWN = 44 * 32, IT_W1 = 32 * 2, IT_W2 = 1 * 2;
    constexpr int NITEMS = IT_IN + IT_MEM + 3 * IT_BR + IT_O + IT_UP + IT_DOWN + 2 * IT_W1 + 2 * IT_W2;
    const int ipw = (NITEMS + NGW - 1) / NGW;
    for (int it = gw * ipw; it < NITEMS && it < (gw + 1) * ipw; ++it) {
        int r = it;
        if (r < IT_UP) { transpose_item(F.in[I_WUP], 1024, DUP, WSP(bf16, WS_WTUP), F.in[I_GFFN], scr, r, 176, LANE_); continue; } r -= IT_UP;
        if (r < IT_IN) { transpose_item(F.in[I_WIN], 1024, DIN, WSP(bf16, WS_WTIN), nullptr, scr, r, 208, LANE_); continue; } r -= IT_IN;
        if (r < IT_DOWN) { transpose_item(F.in[I_WDOWN], DFF, 1024, WSP(bf16, WS_WTDOWN), nullptr, scr, r, 32, LANE_); continue; } r -= IT_DOWN;
        if (r < IT_MEM) { transpose_item(F.in[I_WMEM], 1024, 1024, WSP(bf16, WS_WTMEM), nullptr, scr, r, 32, LANE_); continue; } r -= IT_MEM;
        if (r < IT_O) { transpose_item(F.in[I_WO], 1024, 1024, WSP(bf16, WS_WTO), nullptr, scr, r, 32, LANE_); continue; } r -= IT_O;
        if (r < IT_BR) { transpose_item(F.in[I_WNSA], 512, 1024, WSP(bf16, WS_WTNSA), nullptr, scr, r, 32, LANE_); continue; } r -= IT_BR;
        if (r < IT_BR) { transpose_item(F.in[I_WGLA], 512, 1024, WSP(bf16, WS_WTGLA), nullptr, scr, r, 32, LANE_); continue; } r -= IT_BR;
        if (r < IT_BR) { transpose_item(F.in[I_WX], 512, 1024, WSP(bf16, WS_WTX), nullptr, scr, r, 32, LANE_); continue; } r -= IT_BR;
        if (r < IT_W1) { transpose_item(F.in[I_CKW1], 2048, 64, WSP(bf16, WS_W1T), nullptr, scr, r, 2, LANE_); continue; } r -= IT_W1;
        if (r < IT_W1) { transpose_item(F.in[I_CVW1], 2048, 64, WSP(bf16, WS_W1T) + 64 * 2048, nullptr, scr, r, 2, LANE_); continue; } r -= IT_W1;
        if (r < IT_W2) { transpose_item(F.in[I_CKW2], 64, 64, WSP(bf16, WS_W2T), nullptr, scr, r, 2, LANE_); continue; } r -= IT_W2;
        transpose_item(F.in[I_CVW2], 64, 64, WSP(bf16, WS_W2T) + 64 * 64, nullptr, scr, r, 2, LANE_);
    }
    for (int m = gw; m < MPAD + 512; m += NGW) {
        if (m < MPAD) { const float* xr = m < NTOKP ? F.in[I_XP] + (size_t)m * 1024 : (m < NTOK ? F.in[I_XS] + (size_t)(m - NTOKP) * 1024 : nullptr);
            rms_row_to_bf16(xr, F.in[I_GMIX], WSP(bf16, WS_XN) + (size_t)m * 1024, LANE_); }
        else { const int mm = m - MPAD; rms_row_to_bf16(F.in[I_MEMP] + (size_t)mm * 1024, F.in[I_GMEM], WSP(bf16, WS_MN) + (size_t)mm * 1024, LANE_); }
    }
    { float* ssq = WSP(float, WS_SSQ); for (int i = F.bid * NTHR + TID_; i < MPAD; i += F.G * NTHR) ssq[i] = 0.f; }
    { float* ms = WSP(float, WS_MS); float* x1s = WSP(float, WS_X1S); const float* xs = F.in[I_XS];
      for (int i = F.bid * NTHR + TID_; i < SB * 1024; i += F.G * NTHR) { ms[i] = 0.f; x1s[i] = xs[i]; }
      float* ons = WSP(float, WS_ONS); for (int i = F.bid * NTHR + TID_; i < SB * 512; i += F.G * NTHR) ons[i] = 0.f; }
    { const f32x4* src = (const f32x4*)F.in[I_CWIN]; f32x4* dst = (f32x4*)(F.out + O_WINS);
      for (int i = F.bid * NTHR + TID_; i < SB * 511 * 64; i += F.G * NTHR) { const int b = i / (511 * 64), r = i % (511 * 64); dst[(size_t)b * 512 * 64 + r] = src[(size_t)b * 512 * 64 + 64 + r]; } }
}

struct TokRaw { u32x4 q, kva, kvb, xq; unsigned short g; };
__device__ __forceinline__ TokRaw p2_token_load(Frame& F, int tok) {
    const int lane = LANE_; const bf16* pr = WSP(bf16, WS_PROJ) + (size_t)tok * DINP; TokRaw r;
    r.q = *(const u32x4*)(pr + C_Q + 8 * lane); r.kva = *(const u32x4*)(pr + C_KV + 8 * lane); r.kvb = *(const u32x4*)(pr + C_KV + 512 + 8 * lane);
    r.xq = *(const u32x4*)(pr + C_XQ + 8 * lane); r.g = pr[C_G + (lane < 24 ? lane : 0)]; return r; }
__device__ __forceinline__ void p2_token(Frame& F, int tok, const TokRaw& raw) {
    const int lane = LANE_;
    const bool prompt = tok < NTOKP; const int b = tok >> 13, t = tok & (T - 1), sb = tok - NTOKP;
    float f[8];
    { unpack8(raw.q, f); float ss = 0.f;
#pragma unroll
      for (int i = 0; i < 8; ++i) ss += f[i] * f[i];
      ss += __shfl_xor(ss, 1); ss += __shfl_xor(ss, 2); ss += __shfl_xor(ss, 4);
      const float rs = rsqrtf(ss * (1.f / 64.f) + EPS) * QSCALE; const float* g = F.in[I_GNQ] + 8 * (lane & 7);
#pragma unroll
      for (int i = 0; i < 8; ++i) f[i] *= rs * g[i];
      *(u32x4*)(WSP(bf16, WS_QN) + (size_t)tok * 512 + 8 * lane) = pack8(f); }
    { unpack8(raw.kva, f); float ss = 0.f;
#pragma unroll
      for (int i = 0; i < 8; ++i) ss += f[i] * f[i];
      ss += __shfl_xor(ss, 1); ss += __shfl_xor(ss, 2); ss += __shfl_xor(ss, 4);
      const int grp = lane >> 3, slot = grp >> 1, kv = grp & 1, d0 = 8 * (lane & 7);
      if (slot == 2) { const float rs = rsqrtf(ss * (1.f / 64.f) + EPS); const float* g = F.in[I_GNK] + 64 + d0;
#pragma unroll
          for (int i = 0; i < 8; ++i) f[i] *= rs * g[i]; }
      float* orow = prompt ? F.out + O_KVP + (size_t)tok * 512 + 8 * lane : F.out + O_KVS + (size_t)sb * 512 + 8 * lane;
      *(f32x4*)orow = (f32x4){f[0], f[1], f[2], f[3]}; *(f32x4*)(orow + 4) = (f32x4){f[4], f[5], f[6], f[7]};
      if (prompt) {
          if (slot == 2) *(u32x4*)(WSP(bf16, WS_KSEL) + ((size_t)(b * 2 + kv) * T + t) * 64 + d0) = pack8(f);
          if (slot == 3) { bf16* vt = WSP(bf16, WS_VSELT) + (((size_t)(b * 2 + kv) * 128 + (t >> 6)) * 64 + d0) * 64 + (t & 63);
#pragma unroll
              for (int i = 0; i < 8; ++i) vt[i * 64] = (bf16)f2bf(f[i]); }
      } else if (slot >= 2) { float* nk = WSP(float, WS_NEWKV) + ((size_t)(sb * 4 + (slot - 2)) * 2 + kv) * 64 + d0;
#pragma unroll
          for (int i = 0; i < 8; ++i) nk[i] = f[i]; }
    }
    { unpack8(raw.kvb, f); float ss = 0.f;
#pragma unroll
      for (int i = 0; i < 8; ++i) ss += f[i] * f[i];
      ss += __shfl_xor(ss, 1); ss += __shfl_xor(ss, 2); ss += __shfl_xor(ss, 4);
      const int grp = lane >> 3, slot = 4 + (grp >> 1), kv = grp & 1, d0 = 8 * (lane & 7);
      if (lane < 32) {
          if (slot == 4) { const float rs = rsqrtf(ss * (1.f / 64.f) + EPS); const float* g = F.in[I_GNK] + 128 + d0;
#pragma unroll
              for (int i = 0; i < 8; ++i) f[i] *= rs * g[i]; }
          if (prompt) {
              if (slot == 4) *(u32x4*)(WSP(bf16, WS_KWIN) + ((size_t)(b * 2 + kv) * T + t) * 64 + d0) = pack8(f);
              else { bf16* vt = WSP(bf16, WS_VWINT) + (((size_t)(b * 2 + kv) * 128 + (t >> 6)) * 64 + d0) * 64 + (t & 63);
#pragma unroll
                  for (int i = 0; i < 8; ++i) vt[i * 64] = (bf16)f2bf(f[i]); }
              if (t >= T - 512) { float* orow = F.out + O_WINP + ((size_t)b * 512 + (t - (T - 512))) * 256 + 8 * lane;
                  *(f32x4*)orow = (f32x4){f[0], f[1], f[2], f[3]}; *(f32x4*)(orow + 4) = (f32x4){f[4], f[5], f[6], f[7]}; }
          } else {
              float* nk = WSP(float, WS_NEWKV) + ((size_t)(sb * 4 + (slot - 2)) * 2 + kv) * 64 + d0;
#pragma unroll
              for (int i = 0; i < 8; ++i) nk[i] = f[i];
              float* orow = F.out + O_WINS + ((size_t)sb * 512 + 511) * 256 + 8 * lane;
              *(f32x4*)orow = (f32x4){f[0], f[1], f[2], f[3]}; *(f32x4*)(orow + 4) = (f32x4){f[4], f[5], f[6], f[7]};
          }
      }
    }
    if (lane < 24) WSP(float, WS_GATES)[(size_t)tok * 24 + lane] = sigmoidf_(bf2f(raw.g));
    { unpack8(raw.xq, f); float ss = 0.f;
#pragma unroll
      for (int i = 0; i < 8; ++i) ss += f[i] * f[i];
      ss += __shfl_xor(ss, 1); ss += __shfl_xor(ss, 2); ss += __shfl_xor(ss, 4); ss += __shfl_xor(ss, 8);
      const float rs = rsqrtf(ss * (1.f / 128.f) + EPS) * XSCALE; const float* g = F.in[I_GXQ] + 8 * (lane & 15);
#pragma unroll
      for (int i = 0; i < 8; ++i) f[i] *= rs * g[i];
      *(u32x4*)(WSP(bf16, WS_XQ) + (size_t)tok * 512 + 8 * lane) = pack8(f); }
}
__device__ __forceinline__ void p2_memrow(Frame& F, int row) {
    const int lane = LANE_, b = row >> 8, m = row & 255, head = lane >> 4, d0 = 8 * (lane & 15);
    const bf16* pr = WSP(bf16, WS_MEMPROJ) + (size_t)row * 1024; float f[8];
    { unpack8(*(const u32x4*)(pr + 8 * lane), f); float ss = 0.f;
#pragma unroll
      for (int i = 0; i < 8; ++i) ss += f[i] * f[i];
      ss += __shfl_xor(ss, 1); ss += __shfl_xor(ss, 2); ss += __shfl_xor(ss, 4); ss += __shfl_xor(ss, 8);
      const float rs = rsqrtf(ss * (1.f / 128.f) + EPS); const float* g = F.in[I_GXK] + d0;
#pragma unroll
      for (int i = 0; i < 8; ++i) f[i] *= rs * g[i];
      float* orow = F.out + O_MEMP + ((size_t)row * 2 + 0) * 512 + 8 * lane;
      *(f32x4*)orow = (f32x4){f[0], f[1], f[2], f[3]}; *(f32x4*)(orow + 4) = (f32x4){f[4], f[5], f[6], f[7]};
      *(u32x4*)(WSP(bf16, WS_KMEM) + ((size_t)(b * 4 + head) * 256 + m) * 128 + d0) = pack8(f); }
    { unpack8(*(const u32x4*)(pr + 512 + 8 * lane), f);
      float* orow = F.out + O_MEMP + ((size_t)row * 2 + 1) * 512 + 8 * lane;
      *(f32x4*)orow = (f32x4){f[0], f[1], f[2], f[3]}; *(f32x4*)(orow + 4) = (f32x4){f[4], f[5], f[6], f[7]};
      bf16* vt = WSP(bf16, WS_VMEMT) + ((size_t)(b * 4 + head) * 128 + d0) * 256 + m;
#pragma unroll
      for (int i = 0; i < 8; ++i) vt[i * 256] = (bf16)f2bf(f[i]); }
}

constexpr int CMP_TASKS_S = SB * 2 * 2, CMP_TASKS_P = NB * 2 * 2;
__device__ __forceinline__ int cmp_tile_off16(int row, int c16) { return row * 128 + ((c16 ^ (row & 7)) << 4); }
__device__ __forceinline__ void p2_compress(Frame& F, int task) {
    const int lane = LANE_, r = lane & 15, q = lane >> 4, w = F.wave, tid_ = w * 64 + lane;
    const bool smp = task < CMP_TASKS_S; const int x = smp ? task : task - CMP_TASKS_S;
    const int b = x >> 2, kv = (x >> 1) & 1, slot = x & 1, i0 = 64 * w;
    const bf16* W1t = WSP(bf16, WS_W1T) + (size_t)slot * 64 * 2048;
    const bf16* W2t = WSP(bf16, WS_W2T) + (size_t)slot * 64 * 64;
    const int* pt = (const int*)F.in[I_PT] + b * 64;
    const float* ckv = F.in[I_CKV]; const float* pe = F.in[slot ? I_CVPE : I_CKPE];
    const bf16* proj = WSP(bf16, WS_PROJ);
    LAS unsigned char* wb = F.lds;
    const int srow = tid_ >> 3, sc16 = tid_ & 7, soff = cmp_tile_off16(srow, sc16);
    int kb0[2]; kb0[0] = r * 128 + (((0 + q) ^ (r & 7)) << 4); kb0[1] = r * 128 + (((4 + q) ^ (r & 7)) << 4);
    f32x4 acc[4][4];
#pragma unroll
    for (int nt = 0; nt < 4; ++nt)
#pragma unroll
        for (int it = 0; it < 4; ++it) acc[nt][it] = (f32x4){0.f, 0.f, 0.f, 0.f};
    const bf16* wsrc = W1t + (size_t)srow * 2048 + sc16 * 8;
    u32x4 rw = *(const u32x4*)wsrc;
    LAS unsigned char* xt = F.lds + 16384 + w * 8192;
    u32x4 xr[16];
    const int xrow = smp ? (lane >> 4) : (lane >> 3), xch = smp ? (lane & 15) : (lane & 7);
#define CMP_LOAD_ROWS(KP) do { if (smp) { _Pragma("unroll") for (int i = 0; i < 16; ++i) { const int ib = i0 + 4 * i + xrow; int tok = 16 * ib + (KP); tok = tok < T ? tok : T - 1; \
            const int page = pt[tok >> 7]; xr[i] = *(const u32x4*)(ckv + (((size_t)page * 128 + (tok & 127)) * 4 + slot) * 128 + kv * 64 + 4 * xch); } } \
        else { _Pragma("unroll") for (int i = 0; i < 8; ++i) { const int ib = i0 + 8 * i + xrow; int tok = 16 * ib + (KP); tok = tok < T ? tok : T - 1; \
            xr[i] = *(const u32x4*)(proj + ((size_t)b * T + tok) * DINP + C_KV + slot * 128 + kv * 64 + 8 * xch); } } } while (0)
    CMP_LOAD_ROWS(0);
    __syncthreads();
#pragma unroll 1
    for (int kp = 0; kp < 32; ++kp) {
        if (smp) { const f32x4 p4 = *(const f32x4*)(pe + 64 * kp + 4 * xch);
#pragma unroll
            for (int i = 0; i < 16; ++i) { const f32x4 v = __builtin_bit_cast(f32x4, xr[i]) + p4; u32x2 wv; wv.x = pk2(v[0], v[1]); wv.y = pk2(v[2], v[3]);
                const int row = 4 * i + xrow; *(LAS u32x2*)(xt + cmp_tile_off16(row, xch >> 1) + 8 * (xch & 1)) = wv; } }
        else { const f32x4 p0 = *(const f32x4*)(pe + 64 * kp + 8 * xch), p1 = *(const f32x4*)(pe + 64 * kp + 8 * xch + 4);
#pragma unroll
            for (int i = 0; i < 8; ++i) { float f8[8]; unpack8(xr[i], f8);
                u32x4 wv; wv.x = pk2(f8[0] + p0[0], f8[1] + p0[1]); wv.y = pk2(f8[2] + p0[2], f8[3] + p0[3]); wv.z = pk2(f8[4] + p1[0], f8[5] + p1[1]); wv.w = pk2(f8[6] + p1[2], f8[7] + p1[3]);
                const int row = 8 * i + xrow; *(LAS u32x4*)(xt + cmp_tile_off16(row, xch)) = wv; } }
        if (kp + 1 < 32) CMP_LOAD_ROWS(kp + 1);
        *(LAS u32x4*)(wb + (kp & 1) * 8192 + soff) = rw;
        __syncthreads();
        if (kp + 1 < 32) rw = *(const u32x4*)(wsrc + 64 * (kp + 1));
        LAS const unsigned char* wt = wb + (kp & 1) * 8192;
#pragma unroll
        for (int ks2 = 0; ks2 < 2; ++ks2) {
            bf16x8 xf[4];
#pragma unroll
            for (int it = 0; it < 4; ++it) xf[it] = as_frag(*(LAS const u32x4*)(xt + kb0[ks2] + it * 2048));
#pragma unroll
            for (int nt = 0; nt < 4; ++nt) { const bf16x8 a = as_frag(*(LAS const u32x4*)(wt + kb0[ks2] + nt * 2048));
#pragma unroll
                for (int it = 0; it < 4; ++it) acc[nt][it] = MFMA16(a, xf[it], acc[nt][it]); } }
        asm volatile("s_waitcnt lgkmcnt(0)" ::: "memory");
    }
#undef CMP_LOAD_ROWS
    const float* gk0 = F.in[I_GNK];
#pragma unroll
    for (int it = 0; it < 4; ++it) {
        f32x4 g[4];
#pragma unroll
        for (int nt = 0; nt < 4; ++nt)
#pragma unroll
            for (int i = 0; i < 4; ++i) g[nt][i] = gelu_tanh(acc[nt][it][i]);
        const bf16x8 b0 = frag_pk(g[0], g[1]), b1 = frag_pk(g[2], g[3]);
        f32x4 o[4]; float ss = 0.f;
#pragma unroll
        for (int mt = 0; mt < 4; ++mt) { const bf16* wr = W2t + (size_t)(16 * mt + r) * 64 + 4 * q;
            o[mt] = MFMA16(ldfrag2(wr, wr + 16), b0, ((f32x4){0.f, 0.f, 0.f, 0.f}));
            o[mt] = MFMA16(ldfrag2(wr + 32, wr + 48), b1, o[mt]);
            ss += (o[mt][0] * o[mt][0] + o[mt][1] * o[mt][1]) + (o[mt][2] * o[mt][2] + o[mt][3] * o[mt][3]); }
        ss += __shfl_xor(ss, 16); ss += __shfl_xor(ss, 32);
        if (slot == 0) { const float rs = rsqrtf(ss * (1.f / 64.f) + EPS);
#pragma unroll
            for (int mt = 0; mt < 4; ++mt) { const f32x4 gg = *(const f32x4*)(gk0 + 16 * mt + 4 * q); o[mt] = o[mt] * rs * gg; } }
        const int i = i0 + 16 * it + r;
        if (smp) { float* dst = WSP(float, slot ? WS_VCMPS : WS_KCMPS) + ((size_t)(b * 2 + kv) * 512 + i) * 64 + 4 * q;
#pragma unroll
            for (int mt = 0; mt < 4; ++mt) *(f32x4*)(dst + 16 * mt) = o[mt]; }
        else if (slot == 0) { bf16* dst = WSP(bf16, WS_KCMP) + ((size_t)(b * 2 + kv) * 512 + i) * 64 + 4 * q;
#pragma unroll
            for (int mt = 0; mt < 4; ++mt) { u32x2 wv; wv.x = pk2(o[mt][0], o[mt][1]); wv.y = pk2(o[mt][2], o[mt][3]); *(u32x2*)(dst + 16 * mt) = wv; } }
        else { bf16* dst = WSP(bf16, WS_VCMPT) + ((size_t)(b * 2 + kv) * 64 + 4 * q) * 512 + i;
#pragma unroll
            for (int mt = 0; mt < 4; ++mt)
#pragma unroll
                for (int e = 0; e < 4; ++e) dst[(size_t)(16 * mt + e) * 512] = (bf16)f2bf(o[mt][e]); }
    }
}

__device__ __forceinline__ int swz64(int row, int col) { return row * 64 + ((((col >> 3) ^ (row & 7)) << 3) | (col & 7)); }
__device__ __forceinline__ float log_sigmoid_(float z) { return fminf(z, 0.f) - __logf(1.0f + __expf(-fabsf(z))); }
__device__ __forceinline__ void p2_gla_chunk(Frame& F, int bc) {
    const int lane = LANE_, r = lane & 15, q = lane >> 4, h = F.wave >> 1, eh = F.wave & 1;
    LAS bf16* ktT = (LAS bf16*)(F.lds + F.wave * 16384);
    LAS bf16* vT = ktT + 4096;
    const bf16* proj = WSP(bf16, WS_PROJ) + (size_t)bc * 64 * DINP;
    float wg[16];
#pragma unroll
    for (int j = 0; j < 16; ++j) wg[j] = F.in[I_WGG][j * 256 + h * 64 + lane];
    const float bg = F.in[I_BGG][h * 64 + lane];
    bf16* qtg = WSP(bf16, WS_QTG) + (size_t)bc * 64 * 256 + h * 64 + lane;
    bf16* ktg = WSP(bf16, WS_KTG) + (size_t)bc * 64 * 256 + h * 64 + lane;
    LAS float* lrs = (LAS float*)(F.lds + RING_BYTES);
    { const int tid_ = F.wave * 64 + lane; if (tid_ < 128) { float f8[8]; unpack8(*(const u32x4*)(proj + (size_t)(tid_ >> 1) * DINP + C_LR + 8 * (tid_ & 1)), f8);
#pragma unroll
        for (int i = 0; i < 8; ++i) lrs[(tid_ >> 1) * 16 + 8 * (tid_ & 1) + i] = f8[i]; } }
    __syncthreads();
    float cb = 0.f;
    bf16 kr[16], qr[16], vr[16], kn[16], qn[16], vn[16];
#pragma unroll
    for (int i = 0; i < 16; ++i) { const bf16* pr = proj + (size_t)i * DINP; kr[i] = pr[C_GK + h * 64 + lane]; qr[i] = pr[C_GQ + h * 64 + lane]; vr[i] = pr[C_GV + h * 128 + eh * 64 + lane]; }
#pragma unroll 1
    for (int tb = 0; tb < 4; ++tb) {
        const int tn = tb < 3 ? tb + 1 : 3;
#pragma unroll
        for (int i = 0; i < 16; ++i) { const bf16* pr = proj + (size_t)(16 * tn + i) * DINP; kn[i] = pr[C_GK + h * 64 + lane]; qn[i] = pr[C_GQ + h * 64 + lane]; vn[i] = pr[C_GV + h * 128 + eh * 64 + lane]; }
#pragma unroll
        for (int i = 0; i < 16; ++i) { const int t = 16 * tb + i;
            float z = bg;
#pragma unroll
            for (int j4 = 0; j4 < 4; ++j4) { const f32x4 l4 = *(LAS const f32x4*)(lrs + t * 16 + 4 * j4); z += l4[0] * wg[4 * j4] + l4[1] * wg[4 * j4 + 1] + l4[2] * wg[4 * j4 + 2] + l4[3] * wg[4 * j4 + 3]; }
            cb += log_sigmoid_(z) * 0.0625f;
            const float kk = bf2f(kr[i]) * __expf(-cb);
            const float qq = bf2f(qr[i]) * 0.125f * __expf(cb);
            const bf16 kb = (bf16)f2bf(kk);
            if (eh == 0) { qtg[(size_t)t * 256] = (bf16)f2bf(qq); ktg[(size_t)t * 256] = kb; }
            ktT[swz64(lane, t)] = kb;
            const bf16 vv = vr[i];
            vT[swz64(lane, t)] = vv; }
#pragma unroll
        for (int i = 0; i < 16; ++i) { kr[i] = kn[i]; qr[i] = qn[i]; vr[i] = vn[i]; }
    }
    const float dec = __expf(cb);
    if (eh == 0) WSP(float, WS_DEC)[(size_t)(bc * 4 + h) * 64 + lane] = dec;
    asm volatile("s_waitcnt lgkmcnt(0)" ::: "memory");
    {
        bf16* vrow = WSP(bf16, WS_VTG) + ((size_t)(bc * 4 + h) * 128 + eh * 64) * 64;
#pragma unroll
        for (int i = 0; i < 8; ++i) { const int e = 8 * i + (lane >> 3), c8 = lane & 7;
            *(u32x4*)(vrow + (size_t)e * 64 + c8 * 8) = *(const LAS u32x4*)(vT + swz64(e, c8 * 8)); } }
    f32x4 acc[4][4];
#pragma unroll
    for (int et = 0; et < 4; ++et)
#pragma unroll
        for (int dt = 0; dt < 4; ++dt) acc[et][dt] = (f32x4){0.f, 0.f, 0.f, 0.f};
#pragma unroll
    for (int ks = 0; ks < 2; ++ks) {
        bf16x8 bfr[4];
#pragma unroll
        for (int dt = 0; dt < 4; ++dt) bfr[dt] = as_frag(*(const LAS u32x4*)(ktT + swz64(16 * dt + r, 32 * ks + 8 * q)));
#pragma unroll
        for (int et = 0; et < 4; ++et) { const bf16x8 a = as_frag(*(const LAS u32x4*)(vT + swz64(16 * et + r, 32 * ks + 8 * q)));
#pragma unroll
            for (int dt = 0; dt < 4; ++dt) acc[et][dt] = MFMA16(a, bfr[dt], acc[et][dt]); }
    }
    float* up = WSP(float, WS_UP) + ((size_t)(bc * 4 + h) * 128 + eh * 64) * 64;
#pragma unroll
    for (int dt = 0; dt < 4; ++dt) { const float dd = __shfl(dec, 16 * dt + r);
#pragma unroll
        for (int et = 0; et < 4; ++et)
#pragma unroll
            for (int i = 0; i < 4; ++i) up[(size_t)(16 * et + 4 * q + i) * 64 + 16 * dt + r] = acc[et][dt][i] * dd; }
}

__device__ __forceinline__ void p2_gla_sample(Frame& F, int task) {
    const int lane = LANE_, b = task >> 2, h = task & 3, tok = NTOKP + b;
    const bf16* pr = WSP(bf16, WS_PROJ) + (size_t)tok * DINP;
    LAS float* sh = (LAS float*)(F.lds + F.wave * 16384);
    { float z = F.in[I_BGG][h * 64 + lane];
#pragma unroll
      for (int j = 0; j < 16; ++j) z += bf2f(pr[C_LR + j]) * F.in[I_WGG][j * 256 + h * 64 + lane];
      sh[lane] = __expf(log_sigmoid_(z) * 0.0625f); sh[64 + lane] = bf2f(pr[C_GK + h * 64 + lane]); sh[128 + lane] = bf2f(pr[C_GQ + h * 64 + lane]) * 0.125f; }
    asm volatile("s_waitcnt lgkmcnt(0)" ::: "memory");
    const float v0 = bf2f(pr[C_GV + h * 128 + lane]), v1 = bf2f(pr[C_GV + h * 128 + 64 + lane]);
    const float* s0 = F.in[I_SGLA] + (size_t)(b * 4 + h) * 64 * 128; float* s1 = F.out + O_GLAS + (size_t)(b * 4 + h) * 64 * 128;
    float o0 = 0.f, o1 = 0.f;
#pragma unroll 4
    for (int d = 0; d < 64; ++d) { const float a = sh[d], k = sh[64 + d], qq = sh[128 + d];
        const float n0 = a * s0[d * 128 + lane] + k * v0, n1 = a * s0[d * 128 + 64 + lane] + k * v1;
        s1[d * 128 + lane] = n0; s1[d * 128 + 64 + lane] = n1; o0 += qq * n0; o1 += qq * n1; }
    const float rs = rsqrtf(wave_sum(o0 * o0 + o1 * o1) * (1.f / 128.f) + EPS);
    const float r0 = bf2f(pr[C_GR + h * 128 + lane]), r1 = bf2f(pr[C_GR + h * 128 + 64 + lane]);
    bf16* og = WSP(bf16, WS_OGLA) + (size_t)tok * 512 + h * 128;
    og[lane] = (bf16)f2bf(o0 * rs * F.in[I_GGO][lane] * r0 * sigmoidf_(r0));
    og[64 + lane] = (bf16)f2bf(o1 * rs * F.in[I_GGO][64 + lane] * r1 * sigmoidf_(r1));
}

__device__ __forceinline__ void p3_gla_scan(Frame& F, int task) {
    const int lane = LANE_, b = task >> 9, h = (task >> 7) & 3, e = task & 127;
    const float* up = WSP(float, WS_UP); const float* dec = WSP(float, WS_DEC); bf16* sc = WSP(bf16, WS_SC);
    float S = 0.f;
#pragma unroll 1
    for (int c0 = 0; c0 < 128; c0 += 32) {
        float uu[32], dd[32];
#pragma unroll
        for (int i = 0; i < 32; ++i) { const int bc = b * 128 + c0 + i; uu[i] = up[((size_t)(bc * 4 + h) * 128 + e) * 64 + lane]; dd[i] = dec[(size_t)(bc * 4 + h) * 64 + lane]; }
#pragma unroll
        for (int i = 0; i < 32; ++i) { const int bc = b * 128 + c0 + i; sc[((size_t)(bc * 4 + h) * 128 + e) * 64 + lane] = (bf16)f2bf(S); S = dd[i] * S + uu[i]; } }
    F.out[O_GLAP + ((size_t)(b * 4 + h) * 64 + lane) * 128 + e] = S;
}

__device__ __forceinline__ void p4_gla_out(Frame& F, int task) {
    const int lane = LANE_, r = lane & 15, q = lane >> 4, bc = task >> 4, h = (task >> 2) & 3, tt = task & 3;
    const bf16* qtg = WSP(bf16, WS_QTG) + (size_t)bc * 64 * 256 + h * 64;
    const bf16* ktg = WSP(bf16, WS_KTG) + (size_t)bc * 64 * 256 + h * 64;
    const bf16* vtg = WSP(bf16, WS_VTG) + (size_t)(bc * 4 + h) * 128 * 64;
    const bf16* sc = WSP(bf16, WS_SC) + (size_t)(bc * 4 + h) * 128 * 64;
    const bf16* proj = WSP(bf16, WS_PROJ) + (size_t)bc * 64 * DINP;
    bf16* og = WSP(bf16, WS_OGLA) + (size_t)bc * 64 * 512 + h * 128;
    const float* ggo = F.in[I_GGO];
    {
        bf16x8 qf[2];
#pragma unroll
        for (int ks = 0; ks < 2; ++ks) qf[ks] = ldfrag(qtg + (size_t)(16 * tt + r) * 256 + 32 * ks + 8 * q);
        f32x4 sT[4];
#pragma unroll
        for (int st = 0; st < 4; ++st) { sT[st] = (f32x4){0.f, 0.f, 0.f, 0.f};
            if (st <= tt) {
#pragma unroll
                for (int ks = 0; ks < 2; ++ks) sT[st] = MFMA16(ldfrag(ktg + (size_t)(16 * st + r) * 256 + 32 * ks + 8 * q), qf[ks], sT[st]);
                if (st == tt) {
#pragma unroll
                    for (int i = 0; i < 4; ++i) if (4 * q + i > r) sT[st][i] = 0.f; } } }
        const bf16x8 p01 = frag_pk(sT[0], sT[1]), p23 = frag_pk(sT[2], sT[3]);
        f32x4 acc[8]; float ss = 0.f;
#pragma unroll
        for (int et = 0; et < 8; ++et) { acc[et] = (f32x4){0.f, 0.f, 0.f, 0.f};
            const bf16* srow = sc + (size_t)(16 * et + r) * 64 + 8 * q;
            acc[et] = MFMA16(ldfrag(srow), qf[0], acc[et]); acc[et] = MFMA16(ldfrag(srow + 32), qf[1], acc[et]);
            const bf16* vrow = vtg + (size_t)(16 * et + r) * 64 + 4 * q;
            acc[et] = MFMA16(ldfrag2(vrow, vrow + 16), p01, acc[et]);
            if (tt >= 2) acc[et] = MFMA16(ldfrag2(vrow + 32, vrow + 48), p23, acc[et]);
            ss += (acc[et][0] * acc[et][0] + acc[et][1] * acc[et][1]) + (acc[et][2] * acc[et][2] + acc[et][3] * acc[et][3]); }
        ss += __shfl_xor(ss, 16); ss += __shfl_xor(ss, 32);
        const float rs = rsqrtf(ss * (1.f / 128.f) + EPS);
        const bf16* pr = proj + (size_t)(16 * tt + r) * DINP + C_GR + h * 128 + 4 * q;
        bf16* orow = og + (size_t)(16 * tt + r) * 512 + 4 * q;
#pragma unroll
        for (int et = 0; et < 8; ++et) { const u32x2 rw = *(const u32x2*)(pr + 16 * et); const f32x4 gg = *(const f32x4*)(ggo + 16 * et + 4 * q);
            const float r0 = bflo(rw.x), r1 = bfhi(rw.x), r2 = bflo(rw.y), r3 = bfhi(rw.y);
            u32x2 w; w.x = pk2(acc[et][0] * rs * gg[0] * r0 * sigmoidf_(r0), acc[et][1] * rs * gg[1] * r1 * sigmoidf_(r1));
            w.y = pk2(acc[et][2] * rs * gg[2] * r2 * sigmoidf_(r2), acc[et][3] * rs * gg[3] * r3 * sigmoidf_(r3));
            *(u32x2*)(orow + 16 * et) = w; }
    }
}

__device__ __forceinline__ void p3_xatt(Frame& F, int n, float mb) {
    const int lane = LANE_, r = lane & 15, q = lane >> 4, w = F.wave, tid_ = w * 64 + lane;
    const int b = n >> 7, h = (n >> 5) & 3, chunk = n & 31;
    const bf16* km = WSP(bf16, WS_KMEM) + (size_t)(b * 4 + h) * 256 * 128;
    const bf16* vm = WSP(bf16, WS_VMEMT) + (size_t)(b * 4 + h) * 128 * 256;
    LAS unsigned char* kl = F.lds; LAS unsigned char* vl = F.lds + 65536;
    __syncthreads();
    { u32x4 gk[8], gv[8];
#pragma unroll
      for (int i = 0; i < 8; ++i) { gk[i] = *(const u32x4*)(km + (size_t)(i * 512 + tid_) * 8); gv[i] = *(const u32x4*)(vm + (size_t)(i * 512 + tid_) * 8); }
#pragma unroll
      for (int i = 0; i < 8; ++i) { const int id = i * 512 + tid_;
          *(LAS u32x4*)(kl + (id >> 4) * 256 + ((((id & 15) ^ ((id >> 4) & 15))) << 4)) = gk[i];
          *(LAS u32x4*)(vl + (id >> 5) * 512 + ((((id & 31) ^ ((id >> 5) & 15))) << 4)) = gv[i]; } }
    __syncthreads();
    int kb4[4];
#pragma unroll
    for (int ks = 0; ks < 4; ++ks) kb4[ks] = r * 256 + (((4 * ks + q) ^ r) << 4);
#pragma unroll 1
    for (int tile = 0; tile < 2; ++tile) {
        const int tok0 = b * T + chunk * 256 + w * 32 + tile * 16;
        const bf16* xq = WSP(bf16, WS_XQ) + (size_t)(tok0 + r) * 512 + h * 128 + 8 * q;
        bf16x8 qf[4];
#pragma unroll
        for (int ks = 0; ks < 4; ++ks) qf[ks] = ldfrag(xq + 32 * ks);
        f32x4 o[8]; float l = 0.f;
#pragma unroll
        for (int dt = 0; dt < 8; ++dt) o[dt] = (f32x4){0.f, 0.f, 0.f, 0.f};
#pragma unroll 2
        for (int kk = 0; kk < 8; ++kk) {
            f32x4 p[2];
#pragma unroll
            for (int a = 0; a < 2; ++a) { p[a] = (f32x4){0.f, 0.f, 0.f, 0.f};
#pragma unroll
                for (int ks = 0; ks < 4; ++ks) p[a] = MFMA16(as_frag(*(LAS const u32x4*)(kl + kb4[ks] + (2 * kk + a) * 4096)), qf[ks], p[a]);
#pragma unroll
                for (int i = 0; i < 4; ++i) { p[a][i] = __builtin_amdgcn_exp2f(p[a][i] - mb); l += p[a][i]; } }
            const bf16x8 pf = frag_pk(p[0], p[1]);
            const int v0 = r * 512 + (((4 * kk + (q >> 1)) ^ r) << 4) + 8 * (q & 1), v1 = r * 512 + (((4 * kk + 2 + (q >> 1)) ^ r) << 4) + 8 * (q & 1);
#pragma unroll
            for (int dt = 0; dt < 8; ++dt) { const u32x2 x0 = *(LAS const u32x2*)(vl + v0 + dt * 8192), x1 = *(LAS const u32x2*)(vl + v1 + dt * 8192);
                u32x4 wv; wv.x = x0.x; wv.y = x0.y; wv.z = x1.x; wv.w = x1.y; o[dt] = MFMA16(as_frag(wv), pf, o[dt]); }
        }
        l += __shfl_xor(l, 16); l += __shfl_xor(l, 32);
        const float inv = 1.f / l;
        bf16* ox = WSP(bf16, WS_OX) + (size_t)(tok0 + r) * 512 + h * 128 + 4 * q;
#pragma unroll
        for (int dt = 0; dt < 8; ++dt) { u32x2 wv; wv.x = pk2(o[dt][0] * inv, o[dt][1] * inv); wv.y = pk2(o[dt][2] * inv, o[dt][3] * inv); *(u32x2*)(ox + 16 * dt) = wv; }
    }
}
__device__ __forceinline__ void p3_xatt_sample(Frame& F, int task) {
    const int lane = LANE_, w = F.wave, tid_ = w * 64 + lane, b = task >> 2, h = task & 3, tok = NTOKP + b;
    LAS float* qs = (LAS float*)F.lds; LAS float* sc = qs + 128; LAS float* part = qs + 384;
    const float* cm = F.in[I_CMEM] + (size_t)b * 256 * 1024 + h * 128;
    __syncthreads();
    if (tid_ < 128) qs[tid_] = bf2f(WSP(bf16, WS_XQ)[(size_t)tok * 512 + h * 128 + tid_]);
    __syncthreads();
    {
        const int l8 = lane & 7, kq = lane >> 3;
#pragma unroll
        for (int ps = 0; ps < 4; ++ps) { const int key = 32 * w + 8 * ps + kq; const float* kr = cm + (size_t)key * 1024; float s = 0.f;
#pragma unroll
            for (int j = 0; j < 4; ++j) { const int d = (j * 8 + l8) * 4; const f32x4 kv = *(const f32x4*)(kr + d); const f32x4 qv = *(LAS const f32x4*)(qs + d);
                s += (qv[0] * kv[0] + qv[1] * kv[1]) + (qv[2] * kv[2] + qv[3] * kv[3]); }
            s += __shfl_xor(s, 1); s += __shfl_xor(s, 2); s += __shfl_xor(s, 4);
            if (l8 == 0) sc[key] = s; }
    }
    __syncthreads();
    if (w == 0) { float s[4]; float m = -INFINITY;
#pragma unroll
        for (int k = 0; k < 4; ++k) { s[k] = sc[lane + 64 * k]; m = fmaxf(m, s[k]); }
        m = wave_max(m); float l = 0.f;
#pragma unroll
        for (int k = 0; k < 4; ++k) { s[k] = __builtin_amdgcn_exp2f(s[k] - m); l += s[k]; }
        l = wave_sum(l); const float inv = 1.f / l;
#pragma unroll
        for (int k = 0; k < 4; ++k) sc[lane + 64 * k] = s[k] * inv; }
    __syncthreads();
    { float o0 = 0.f, o1 = 0.f; const float* vv = cm + 512 + (size_t)(32 * w) * 1024;
#pragma unroll 8
      for (int mm = 0; mm < 32; ++mm) { const float p = sc[32 * w + mm]; o0 += p * vv[(size_t)mm * 1024 + lane]; o1 += p * vv[(size_t)mm * 1024 + 64 + lane]; }
      part[w * 128 + lane] = o0; part[w * 128 + 64 + lane] = o1; }
    __syncthreads();
    if (tid_ < 128) { float o = 0.f;
#pragma unroll
        for (int w2 = 0; w2 < 8; ++w2) o += part[w2 * 128 + tid_];
        WSP(bf16, WS_OX)[(size_t)tok * 512 + h * 128 + tid_] = (bf16)f2bf(o); }
}

constexpr int NL_Q = 0;
constexpr int NL_U = 16384;
constexpr int NL_OS = 81920;
constexpr int NL_TB = 16384;
constexpr int NL_SEL = 147456;
constexpr int NL_BT = 147968;
constexpr int NL_LINV = 152096;
constexpr int NL_END = 152608;
static_assert(NL_END <= LDS_BYTES, "NSA LDS map");

__device__ __forceinline__ void nsa_tables(Frame& F) {
    LAS float* bt = (LAS float*)(F.lds + NL_BT);
    for (int i = TID_; i < 129 * 8; i += NTHR) bt[i] = F.in[I_RB][t5_bucket(i >> 3) * 8 + (i & 7)] * LOG2E;
    __syncthreads();
}
__device__ __forceinline__ float nsa_bound(Frame& F) {
    const float gq = absmax_arr(F.in[I_GNQ], 64, LANE_), gk = absmax_arr(F.in[I_GNK], 192, LANE_), bm = absmax_arr(F.in[I_RB], 256, LANE_);
    return (8.0f * gq * gk * 1.02f + bm) * LOG2E;
}
__device__ __forceinline__ unsigned fkey(float x) { const unsigned u = __float_as_uint(x); return (u & 0x80000000u) ? ~u : (u | 0x80000000u); }

__device__ __forceinline__ int tile_off16(int row, int c16) { return row * 128 + ((c16 ^ (row & 7)) << 4); }
struct TileAddr { int kb[2]; int vb[2][2]; };
__device__ __forceinline__ TileAddr tile_addr(int r, int q) { TileAddr a;
    for (int ks = 0; ks < 2; ++ks) a.kb[ks] = r * 128 + (((4 * ks + q) ^ (r & 7)) << 4);
    for (int s = 0; s < 2; ++s) for (int pc = 0; pc < 2; ++pc) a.vb[s][pc] = r * 128 + (((4 * s + 2 * pc + (q >> 1)) ^ (r & 7)) << 4) + 8 * (q & 1);
    return a; }
__device__ __forceinline__ bf16x8 tile_kfrag(LAS const unsigned char* kb, const TileAddr& ta, int kt, int ks) { return as_frag(*(LAS const u32x4*)(kb + ta.kb[ks] + kt * 2048)); }
__device__ __forceinline__ bf16x8 tile_vfrag(LAS const unsigned char* vb, const TileAddr& ta, int dt, int s) {
    const u32x2 a = *(LAS const u32x2*)(vb + ta.vb[s][0] + dt * 2048), b = *(LAS const u32x2*)(vb + ta.vb[s][1] + dt * 2048);
    u32x4 w; w.x = a.x; w.y = a.y; w.z = b.x; w.w = b.y; return as_frag(w); }

#define OPAQUE_V(x) asm volatile("" : "+v"(x))
__device__ __forceinline__ void p3_nsa_prompt(Frame& F, int n, float mb, int dbg) {
    int lane0 = LANE_; OPAQUE_V(lane0);
    const int lane = lane0, r = lane & 15, q = lane >> 4, w = F.wave;
    int combo, ti;
    if (F.G == 256) { const int xcd = F.bid & 7, u = (F.bid >> 3) * 2 + (xcd & 1), rnd = n >> 8; combo = xcd >> 1; ti = rnd == 0 ? u : rnd == 1 ? 127 - u : rnd == 2 ? 128 + u : 255 - u; }
    else { const int idx = n & 255; combo = n >> 8; ti = (combo & 1) ? 255 - idx : idx; }
    const int b = combo >> 1, kv = combo & 1, t0 = 32 * ti, bk = b * 2 + kv;
    LAS bf16* Qs = (LAS bf16*)(F.lds + NL_Q); LAS float* U = (LAS float*)(F.lds + NL_U) + w * 2048; LAS unsigned* selm = (LAS unsigned*)(F.lds + NL_SEL);
    LAS const float* bt = (LAS const float*)(F.lds + NL_BT); LAS float* linv = (LAS float*)(F.lds + NL_LINV) + w * 16;
    LAS unsigned char* stA = F.lds + NL_OS;
    LAS unsigned char* stC = F.lds + NL_U;
    LAS unsigned char* stB = F.lds + NL_TB + w * 16384;
    const int tid_ = w * 64 + lane, srow = tid_ >> 3, sc16 = tid_ & 7, soff = tile_off16(srow, sc16);
    const TileAddr ta = tile_addr(r, q);
    __syncthreads();
    { const int tk = TID_ >> 4, ch = TID_ & 15; const bf16* src = WSP(bf16, WS_QN) + (size_t)(b * T + t0 + tk) * 512 + kv * 256 + ch * 16;
      const u32x4 a0 = *(const u32x4*)src, a1 = *(const u32x4*)(src + 8);
      *(LAS u32x4*)(Qs + tk * 256 + ch * 16) = a0; *(LAS u32x4*)(Qs + tk * 256 + ch * 16 + 8) = a1;
      if (TID_ < 128) selm[TID_] = 0u; }
    __syncthreads();
    const int tw = t0 + 4 * w, tr = tw + (r >> 2), h = kv * 4 + (r & 3);
    bf16x8 qf[2];
#pragma unroll
    for (int ks = 0; ks < 2; ++ks) qf[ks] = as_frag(*(LAS const u32x4*)(Qs + (16 * w + r) * 64 + 32 * ks + 8 * q));
    int ncvb = (t0 + 31 - 31) / 16 + 1; ncvb = ncvb < 511 ? ncvb : 511;
    const int nst = (ncvb + 63) >> 6;
    const int tlast = tw + 3; int ncv = tlast >= 31 ? (tlast - 31) / 16 + 1 : 0; ncv = ncv < 511 ? ncv : 511;
    const int nstw = (ncv + 63) >> 6;
    f32x4 oc[4]; float lc = 0.f, carry = 0.f;
#pragma unroll
    for (int dt = 0; dt < 4; ++dt) oc[dt] = (f32x4){0.f, 0.f, 0.f, 0.f};
    {
        const bf16* kc = WSP(bf16, WS_KCMP) + (size_t)bk * 512 * 64 + srow * 64 + sc16 * 8; const bf16* vc = WSP(bf16, WS_VCMPT) + (size_t)bk * 64 * 512 + srow * 512 + sc16 * 8;
        const int nst2 = (nst + 1) >> 1;
        u32x4 rk0 = *(const u32x4*)kc, rv0 = *(const u32x4*)vc, rk1 = *(const u32x4*)(kc + 4096), rv1 = *(const u32x4*)(vc + 64);
#pragma unroll 1
        for (int s2 = 0; s2 < nst2; ++s2) {
            LAS unsigned char* bb = stA + (s2 & 1) * 32768;
            *(LAS u32x4*)(bb + soff) = rk0; *(LAS u32x4*)(bb + 8192 + soff) = rv0; *(LAS u32x4*)(bb + 16384 + soff) = rk1; *(LAS u32x4*)(bb + 24576 + soff) = rv1;
            __syncthreads();
            if (s2 + 1 < nst2) { rk0 = *(const u32x4*)(kc + (size_t)(2 * s2 + 2) * 4096); rv0 = *(const u32x4*)(vc + (2 * s2 + 2) * 64);
                                 rk1 = *(const u32x4*)(kc + (size_t)(2 * s2 + 3) * 4096); rv1 = *(const u32x4*)(vc + (2 * s2 + 3) * 64); }
#pragma unroll
            for (int sub = 0; sub < 2; ++sub) { const int st = 2 * s2 + sub; LAS unsigned char* kb = bb + sub * 16384; LAS unsigned char* vb = kb + 8192;
            if (st < nstw && !(dbg & 1)) {
                f32x4 p[4];
#pragma unroll
                for (int kt = 0; kt < 4; ++kt) { const int tile = 4 * st + kt; p[kt] = (f32x4){0.f, 0.f, 0.f, 0.f};
                    p[kt] = MFMA16(tile_kfrag(kb, ta, kt, 0), qf[0], p[kt]); p[kt] = MFMA16(tile_kfrag(kb, ta, kt, 1), qf[1], p[kt]);
                    float G = 0.f;
#pragma unroll
                    for (int i = 0; i < 4; ++i) { const int c = 16 * tile + 4 * q + i, rel = tr - (16 * c + 31); const bool ok = rel >= 0 && c < 511;
                        const int rc = rel < 0 ? 0 : (rel > 128 ? 128 : rel);
                        const float xv = p[kt][i] + bt[rc * 8 + h] - mb;
                        const float e = __builtin_amdgcn_exp2f(ok ? xv : -1e30f); p[kt][i] = e; G += e; }
                    const float send = (q == 3) ? carry : p[kt][3]; const float prev = __shfl(send, (lane + 48) & 63); carry = p[kt][3];
                    U[r * 128 + 4 * tile + q] = G + prev; lc += G; }
                const bf16x8 pf0 = frag_pk(p[0], p[1]), pf1 = frag_pk(p[2], p[3]);
#pragma unroll
                for (int dt = 0; dt < 4; ++dt) { oc[dt] = MFMA16(tile_vfrag(vb, ta, dt, 0), pf0, oc[dt]); oc[dt] = MFMA16(tile_vfrag(vb, ta, dt, 1), pf1, oc[dt]); }
            } }
        }
    }
    lc += __shfl_xor(lc, 16); lc += __shfl_xor(lc, 32);
    const float lcinv = lc > 0.f ? 1.f / lc : 0.f;
    if (q == 0) linv[r] = lcinv;
    asm volatile("s_waitcnt lgkmcnt(0)" ::: "memory");
    if (!(dbg & 8)) {
        const int tk = lane >> 4, jr = lane & 15, t = tw + tk, tblk = t >> 6, jlim = 16 * nstw;
        const float li0 = linv[4 * tk], li1 = linv[4 * tk + 1], li2 = linv[4 * tk + 2], li3 = linv[4 * tk + 3];
        unsigned key[8];
#pragma unroll
        for (int m = 0; m < 8; ++m) { const int j = jr + 16 * m; float v = 0.f;
            if (j < jlim) v = U[(4 * tk) * 128 + j] * li0 + U[(4 * tk + 1) * 128 + j] * li1 + U[(4 * tk + 2) * 128 + j] * li2 + U[(4 * tk + 3) * 128 + j] * li3;
            const bool forced = (j == 0) || (j == tblk) || (j == tblk - 1);
            const float sc = (j <= tblk) ? v + (forced ? 1e4f : 0.f) : -1e30f;
            key[m] = fkey(sc); }
        unsigned pre = 0u;
#pragma unroll 1
        for (int bit = 31; bit >= 0; --bit) { const unsigned cand = pre | (1u << bit); int cnt = 0;
#pragma unroll
            for (int m = 0; m < 8; ++m) cnt += key[m] >= cand ? 1 : 0;
            cnt += __shfl_xor(cnt, 1); cnt += __shfl_xor(cnt, 2); cnt += __shfl_xor(cnt, 4); cnt += __shfl_xor(cnt, 8);
            if (cnt >= 16) pre = cand; }
        int ngt = 0;
#pragma unroll
        for (int m = 0; m < 8; ++m) ngt += key[m] > pre ? 1 : 0;
        ngt += __shfl_xor(ngt, 1); ngt += __shfl_xor(ngt, 2); ngt += __shfl_xor(ngt, 4); ngt += __shfl_xor(ngt, 8);
        const int need = 16 - ngt; int run = 0; const unsigned kinv = fkey(-1e30f);
#pragma unroll
        for (int m = 0; m < 8; ++m) { const bool tie = key[m] == pre; const unsigned long long bal = __ballot(tie);
            const unsigned grp = (unsigned)(bal >> (16 * tk)) & 0xffffu; const int rank = __popc(grp & ((1u << jr) - 1u));
            const bool sel = (key[m] > pre || (tie && run + rank < need)) && key[m] > kinv;
            run += __popc(grp);
            if (sel) atomicOr((unsigned*)(selm + jr + 16 * m), 1u << (4 * w + tk)); }
    }
    __syncthreads();
    f32x4 ow[4]; float lw = 0.f;
#pragma unroll
    for (int dt = 0; dt < 4; ++dt) ow[dt] = (f32x4){0.f, 0.f, 0.f, 0.f};
    {
        int lc_ = lane0; OPAQUE_V(lc_); const int lane = lc_, r = lane & 15, q = lane >> 4, tr = tw + (r >> 2), h = kv * 4 + (r & 3); const TileAddr ta = tile_addr(r, q);
        const int tid_ = w * 64 + lane, srow = tid_ >> 3, sc16 = tid_ & 7, soff = tile_off16(srow, sc16);
        const int jlob = (t0 - 511 > 0 ? t0 - 511 : 0) >> 6, jhib = (t0 + 31) >> 6, nstc = jhib - jlob + 1;
        const int jlo = (tw - 511 > 0 ? tw - 511 : 0) >> 6, jhi = (tw + 3) >> 6;
        const bf16* kwin = WSP(bf16, WS_KWIN) + (size_t)bk * T * 64 + srow * 64 + sc16 * 8; const bf16* vwin = WSP(bf16, WS_VWINT) + (size_t)bk * 128 * 4096 + srow * 64 + sc16 * 8;
        const int nstc2 = (nstc + 1) >> 1;
        u32x4 rk0 = *(const u32x4*)(kwin + (size_t)jlob * 4096), rv0 = *(const u32x4*)(vwin + (size_t)jlob * 4096), rk1 = *(const u32x4*)(kwin + (size_t)(jlob + 1) * 4096), rv1 = *(const u32x4*)(vwin + (size_t)(jlob + 1) * 4096);
#pragma unroll 1
        for (int s2 = 0; s2 < nstc2; ++s2) { const int j0 = jlob + 2 * s2;
            LAS unsigned char* bb = stC + (s2 & 1) * 32768;
            *(LAS u32x4*)(bb + soff) = rk0; *(LAS u32x4*)(bb + 8192 + soff) = rv0; *(LAS u32x4*)(bb + 16384 + soff) = rk1; *(LAS u32x4*)(bb + 24576 + soff) = rv1;
            __syncthreads();
            if (s2 + 1 < nstc2) { rk0 = *(const u32x4*)(kwin + (size_t)(j0 + 2) * 4096); rv0 = *(const u32x4*)(vwin + (size_t)(j0 + 2) * 4096);
                                  rk1 = *(const u32x4*)(kwin + (size_t)(j0 + 3) * 4096); rv1 = *(const u32x4*)(vwin + (size_t)(j0 + 3) * 4096); }
#pragma unroll
            for (int sub = 0; sub < 2; ++sub) { const int j = j0 + sub; LAS unsigned char* kb = bb + sub * 16384; LAS unsigned char* vb = kb + 8192;
            if (j >= jlo && j <= jhi && !(dbg & 2)) {
                f32x4 p[4];
#pragma unroll
                for (int kt = 0; kt < 4; ++kt) { p[kt] = (f32x4){0.f, 0.f, 0.f, 0.f};
                    p[kt] = MFMA16(tile_kfrag(kb, ta, kt, 0), qf[0], p[kt]); p[kt] = MFMA16(tile_kfrag(kb, ta, kt, 1), qf[1], p[kt]);
#pragma unroll
                    for (int i = 0; i < 4; ++i) { const int rel = tr - (64 * j + 16 * kt + 4 * q + i); const bool ok = rel >= 0 && rel < 512;
                        const int rc = rel < 0 ? 0 : (rel > 128 ? 128 : rel);
                        const float xv = p[kt][i] + bt[rc * 8 + h] - mb;
                        const float e = __builtin_amdgcn_exp2f(ok ? xv : -1e30f); p[kt][i] = e; lw += e; } }
                const bf16x8 pf0 = frag_pk(p[0], p[1]), pf1 = frag_pk(p[2], p[3]);
#pragma unroll
                for (int dt = 0; dt < 4; ++dt) { ow[dt] = MFMA16(tile_vfrag(vb, ta, dt, 0), pf0, ow[dt]); ow[dt] = MFMA16(tile_vfrag(vb, ta, dt, 1), pf1, ow[dt]); }
            } }
        }
        lw += __shfl_xor(lw, 16); lw += __shfl_xor(lw, 32);
    }
    f32x4 ocw[4];
    { const float* gt = WSP(float, WS_GATES) + (size_t)(b * T + tr) * 24 + h * 3;
      const float g0 = gt[0] * lcinv, g2 = gt[2] * (lw > 0.f ? 1.f / lw : 0.f);
#pragma unroll
      for (int dt = 0; dt < 4; ++dt) ocw[dt] = oc[dt] * g0 + ow[dt] * g2; }
    __syncthreads();
    f32x4 osf[4]; float lsf = 0.f;
    {
        int lb_ = lane0; OPAQUE_V(lb_); const int lane = lb_, r = lane & 15, q = lane >> 4, h = kv * 4 + (r & 3); const TileAddr ta = tile_addr(r, q);
        const int half = w >> 2, jw = w & 3;
        f32x4 osa[4][4]; float lsa[4];
#pragma unroll
        for (int x = 0; x < 4; ++x) { lsa[x] = 0.f;
#pragma unroll
            for (int dt = 0; dt < 4; ++dt) osa[x][dt] = (f32x4){0.f, 0.f, 0.f, 0.f}; }
        const int jmax = (t0 + 31) >> 6;
        const int brow = lane >> 3, bc16 = lane & 7, boff = brow * 64 + bc16 * 8, bsoff = tile_off16(brow, bc16); const float bfar = bt[128 * 8 + h];
        const bf16* ksel = WSP(bf16, WS_KSEL) + (size_t)bk * T * 64 + boff; const bf16* vsel = WSP(bf16, WS_VSELT) + (size_t)bk * 128 * 4096 + boff;
        LAS const bf16* Qh = Qs + (64 * half + r) * 64 + 8 * q;
        u32x4 gk[8], gv[8];
        if (jw <= jmax) {
#pragma unroll
            for (int i = 0; i < 8; ++i) { gk[i] = *(const u32x4*)(ksel + (size_t)jw * 4096 + i * 512); gv[i] = *(const u32x4*)(vsel + (size_t)jw * 4096 + i * 512); } }
#pragma unroll 1
        for (int j = jw; j <= jmax; j += 4) {
            const unsigned msel = ((unsigned)__builtin_amdgcn_readfirstlane((int)selm[j]) >> (16 * half)) & 0xffffu;
            const bool act = msel != 0u && !(dbg & 4);
            asm volatile("s_waitcnt lgkmcnt(0)" ::: "memory");
#pragma unroll
            for (int i = 0; i < 8; ++i) { *(LAS u32x4*)(stB + bsoff + i * 1024) = gk[i]; *(LAS u32x4*)(stB + 8192 + bsoff + i * 1024) = gv[i]; }
            if (j + 4 <= jmax) {
#pragma unroll
                for (int i = 0; i < 8; ++i) { gk[i] = *(const u32x4*)(ksel + (size_t)(j + 4) * 4096 + i * 512); gv[i] = *(const u32x4*)(vsel + (size_t)(j + 4) * 4096 + i * 512); } }
            if (!act) continue;
            asm volatile("s_waitcnt lgkmcnt(0)" ::: "memory");
            const bool far = (t0 - (64 * j + 63)) >= 128;
#pragma unroll 1
            for (int x = 0; x < 4; ++x) {
                const unsigned nib = (msel >> (4 * x)) & 15u;
                if (nib) {
                    asm volatile("" ::: "memory");
                    const bool tokv = (nib >> (r >> 2)) & 1u; const int t = t0 + 16 * half + 4 * x + (r >> 2);
                    const bf16x8 qs0 = as_frag(*(LAS const u32x4*)(Qh + x * 1024)), qs1 = as_frag(*(LAS const u32x4*)(Qh + x * 1024 + 32));
                    f32x4 p[4]; float ls = 0.f;
#pragma unroll
                    for (int kt = 0; kt < 4; ++kt) { p[kt] = (f32x4){0.f, 0.f, 0.f, 0.f};
                        p[kt] = MFMA16(tile_kfrag(stB, ta, kt, 0), qs0, p[kt]); p[kt] = MFMA16(tile_kfrag(stB, ta, kt, 1), qs1, p[kt]); }
                    if (dbg & 32) { ls = p[0][0]; } else
                    if (far) {
                        const float cb_ = bfar - mb;
#pragma unroll
                        for (int kt = 0; kt < 4; ++kt)
#pragma unroll
                            for (int i = 0; i < 4; ++i) { const float e = __builtin_amdgcn_exp2f(tokv ? p[kt][i] + cb_ : -1e30f); p[kt][i] = e; ls += e; }
                    } else {
#pragma unroll
                        for (int kt = 0; kt < 4; ++kt)
#pragma unroll
                            for (int i = 0; i < 4; ++i) { const int rel = t - (64 * j + 16 * kt + 4 * q + i); const bool ok = tokv && rel >= 0;
                                const int rc = rel < 0 ? 0 : (rel > 128 ? 128 : rel);
                                const float xv = p[kt][i] + bt[rc * 8 + h] - mb;
                                const float e = __builtin_amdgcn_exp2f(ok ? xv : -1e30f); p[kt][i] = e; ls += e; }
                    }
                    lsa[0] += ls;
                    const bf16x8 pf0 = frag_pk(p[0], p[1]), pf1 = frag_pk(p[2], p[3]);
#pragma unroll
                    for (int dt = 0; dt < 4; ++dt) if (!(dbg & 64)) { osa[0][dt] = MFMA16(tile_vfrag(stB + 8192, ta, dt, 0), pf0, osa[0][dt]); osa[0][dt] = MFMA16(tile_vfrag(stB + 8192, ta, dt, 1), pf1, osa[0][dt]); }
                }
                { const float l0 = lsa[0]; lsa[0] = lsa[1]; lsa[1] = lsa[2]; lsa[2] = lsa[3]; lsa[3] = l0;
#pragma unroll
                  for (int dt = 0; dt < 4; ++dt) { const f32x4 o0 = osa[0][dt]; osa[0][dt] = osa[1][dt]; osa[1][dt] = osa[2][dt]; osa[2][dt] = osa[3][dt]; osa[3][dt] = o0; } }
            }
        }
#pragma unroll
        for (int dt = 0; dt < 4; ++dt) osf[dt] = (f32x4){0.f, 0.f, 0.f, 0.f};
#pragma unroll
        for (int x = 0; x <= 4; ++x) {
            __syncthreads();
            if (x > 0 && jw == x - 1) {
#pragma unroll
                for (int w2 = 0; w2 < 4; ++w2) { LAS const float* rp = (LAS const float*)(F.lds + NL_U + ((x - 1) & 1) * 32768) + (4 * half + w2) * 1024 + lane * 16;
#pragma unroll
                    for (int dt = 0; dt < 4; ++dt) osf[dt] += *(LAS const f32x4*)(rp + 4 * dt);
                    lsf += ((LAS const float*)(F.lds + NL_Q + ((x - 1) & 1) * 2048))[(4 * half + w2) * 64 + lane]; } }
            if (x < 4) { LAS float* Rb = (LAS float*)(F.lds + NL_U + (x & 1) * 32768); LAS float* RLb = (LAS float*)(F.lds + NL_Q + (x & 1) * 2048);
#pragma unroll
                for (int dt = 0; dt < 4; ++dt) *(LAS f32x4*)(Rb + w * 1024 + lane * 16 + 4 * dt) = osa[x][dt];
                RLb[w * 64 + lane] = lsa[x]; }
        }
        lsf += __shfl_xor(lsf, 16); lsf += __shfl_xor(lsf, 32);
    }
    {
        int lf_ = lane0; OPAQUE_V(lf_); const int r = lf_ & 15, q = lf_ >> 4, tr = tw + (r >> 2), h = kv * 4 + (r & 3);
        const int tok = b * T + tr; const float g1 = WSP(float, WS_GATES)[(size_t)tok * 24 + h * 3 + 1] * (lsf > 0.f ? 1.f / lsf : 0.f);
        bf16* on = WSP(bf16, WS_ONSA) + (size_t)tok * 512 + h * 64 + 4 * q;
#pragma unroll
        for (int dt = 0; dt < 4; ++dt) { const f32x4 o = ocw[dt] + osf[dt] * g1;
            u32x2 wv; wv.x = pk2(o[0], o[1]); wv.y = pk2(o[2], o[3]); *(u32x2*)(on + 16 * dt) = wv; }
    }
}

constexpr int SL_Q = 0;
constexpr int SL_S = 1024;
constexpr int SL_O = 17408;
constexpr int SL_PART = 20480;
constexpr int SL_IMP = 28672;
constexpr int SL_IDX = 29200;
constexpr int SL_END = 29328;
static_assert(SL_END <= NL_SEL, "sample NSA LDS map must not overlap the tables");
template <class KP, class VP, class RELF>
__device__ __forceinline__ void sample_segment(Frame& F, int nk, int kv, KP kptr, VP vptr, RELF relf, LAS float* odst) {
    LAS const float* qs = (LAS const float*)(F.lds + SL_Q); LAS float* sc = (LAS float*)(F.lds + SL_S); LAS float* part = (LAS float*)(F.lds + SL_PART);
    LAS const float* bt = (LAS const float*)(F.lds + NL_BT);
    const int nkp = (nk + 63) & ~63;
    for (int n = TID_; n < nkp; n += NTHR) {
        float s0 = -INFINITY, s1 = -INFINITY, s2 = -INFINITY, s3 = -INFINITY;
        const float* kr = n < nk ? kptr(n) : nullptr;
        if (kr) { s0 = s1 = s2 = s3 = 0.f;
            for (int d = 0; d < 64; d += 4) { const f32x4 k4 = *(const f32x4*)(kr + d);
                const f32x4 q0 = *(LAS const f32x4*)(qs + d), q1 = *(LAS const f32x4*)(qs + 64 + d), q2 = *(LAS const f32x4*)(qs + 128 + d), q3 = *(LAS const f32x4*)(qs + 192 + d);
                s0 += (q0[0] * k4[0] + q0[1] * k4[1]) + (q0[2] * k4[2] + q0[3] * k4[3]); s1 += (q1[0] * k4[0] + q1[1] * k4[1]) + (q1[2] * k4[2] + q1[3] * k4[3]);
                s2 += (q2[0] * k4[0] + q2[1] * k4[1]) + (q2[2] * k4[2] + q2[3] * k4[3]); s3 += (q3[0] * k4[0] + q3[1] * k4[1]) + (q3[2] * k4[2] + q3[3] * k4[3]); }
            int rel = relf(n); rel = rel > 128 ? 128 : rel; const int bb = rel * 8 + kv * 4;
            s0 += bt[bb]; s1 += bt[bb + 1]; s2 += bt[bb + 2]; s3 += bt[bb + 3]; }
        sc[n] = s0; sc[1024 + n] = s1; sc[2048 + n] = s2; sc[3072 + n] = s3;
    }
    __syncthreads();
    if (F.wave < 4) { LAS float* row = sc + F.wave * 1024; float m = -INFINITY;
        for (int n = LANE_; n < nkp; n += 64) m = fmaxf(m, row[n]);
        m = wave_max(m); float l = 0.f;
        for (int n = LANE_; n < nkp; n += 64) { const float e = __builtin_amdgcn_exp2f(row[n] - m); row[n] = e; l += e; }
        l = wave_sum(l); const float inv = 1.f / l;
        for (int n = LANE_; n < nkp; n += 64) row[n] *= inv; }
    __syncthreads();
    {
        const int d = LANE_; float o0 = 0.f, o1 = 0.f, o2 = 0.f, o3 = 0.f;
        for (int n0 = F.wave; n0 < nkp; n0 += 128) {
            float v[16];
#pragma unroll
            for (int u = 0; u < 16; ++u) { const int n = n0 + 8 * u; v[u] = n < nk ? vptr(n)[d] : 0.f; }
#pragma unroll
            for (int u = 0; u < 16; ++u) { const int n = n0 + 8 * u; if (n < nkp) { o0 += sc[n] * v[u]; o1 += sc[1024 + n] * v[u]; o2 += sc[2048 + n] * v[u]; o3 += sc[3072 + n] * v[u]; } }
        }
        part[(F.wave * 4 + 0) * 64 + d] = o0; part[(F.wave * 4 + 1) * 64 + d] = o1; part[(F.wave * 4 + 2) * 64 + d] = o2; part[(F.wave * 4 + 3) * 64 + d] = o3; }
    __syncthreads();
    if (TID_ < 256) { float a = 0.f;
#pragma unroll
        for (int w8 = 0; w8 < 8; ++w8) a += part[w8 * 256 + TID_];
        odst[TID_] = a; }
    __syncthreads();
}
__device__ __forceinline__ void p3_nsa_sample(Frame& F, int task, int part) {
    const int b = task >> 1, kv = task & 1, tok = NTOKP + b, bk = b * 2 + kv;
    LAS float* qs = (LAS float*)(F.lds + SL_Q); LAS float* sc = (LAS float*)(F.lds + SL_S); LAS float* ob = (LAS float*)(F.lds + SL_O);
    LAS float* imp = (LAS float*)(F.lds + SL_IMP); LAS int* sidx = (LAS int*)(F.lds + SL_IDX);
    __syncthreads();
    if (TID_ < 256) qs[TID_] = bf2f(WSP(bf16, WS_QN)[(size_t)tok * 512 + kv * 256 + TID_]);
    __syncthreads();
    const float* kcs = WSP(float, WS_KCMPS) + (size_t)bk * 512 * 64; const float* vcs = WSP(float, WS_VCMPS) + (size_t)bk * 512 * 64;
    const float* nkv = WSP(float, WS_NEWKV) + (size_t)b * 4 * 2 * 64 + kv * 64;
    const float* ckv = F.in[I_CKV]; const int* pt = (const int*)F.in[I_PT] + b * 64; const float* cwin = F.in[I_CWIN] + (size_t)b * 512 * 256;
    if (part == 0) {
    sample_segment(F, 511, kv, [&](int n) { return kcs + (size_t)n * 64; }, [&](int n) { return vcs + (size_t)n * 64; }, [&](int n) { return T - (16 * n + 31); }, ob);
    if (TID_ < 129) { const int j = TID_; float v = 0.f;
        for (int c = 4 * j - 1; c <= 4 * j + 3; ++c) if (c >= 0 && c < 511) v += (sc[c] + sc[1024 + c]) + (sc[2048 + c] + sc[3072 + c]);
        imp[j] = v; }
    __syncthreads();
    if (F.wave == 0) { const int lane = LANE_; unsigned key[3];
#pragma unroll
        for (int m = 0; m < 3; ++m) { const int j = lane + 64 * m; float s = -1e30f;
            if (j < 129) { const bool forced = (j == 0) || (j == 128) || (j == 127); s = imp[j] + (forced ? 1e4f : 0.f); }
            key[m] = (j < 129) ? fkey(s) : 0u; }
        unsigned pre = 0u;
#pragma unroll 1
        for (int bit = 31; bit >= 0; --bit) { const unsigned cand = pre | (1u << bit); int cnt = 0;
#pragma unroll
            for (int m = 0; m < 3; ++m) cnt += __popcll(__ballot(key[m] >= cand));
            if (cnt >= 16) pre = cand; }
        int ngt = 0;
#pragma unroll
        for (int m = 0; m < 3; ++m) ngt += __popcll(__ballot(key[m] > pre));
        int need = 16 - ngt, cnt = 0;
#pragma unroll
        for (int m = 0; m < 3; ++m) { const bool gt = key[m] > pre, tie = key[m] == pre; const unsigned long long tb = __ballot(tie);
            const int trank = __popcll(tb & ((1ull << lane) - 1ull)); const bool sel = gt || (tie && trank < need);
            need -= __popcll(tb); need = need < 0 ? 0 : need;
            const unsigned long long sb = __ballot(sel); const int pos = cnt + __popcll(sb & ((1ull << lane) - 1ull));
            if (sel && pos < 16) sidx[pos] = lane + 64 * m; cnt += __popcll(sb); } }
    __syncthreads();
    sample_segment(F, 1024, kv,
        [&](int n) -> const float* { const int pos = 64 * sidx[n >> 6] + (n & 63); if (pos > T) return nullptr; if (pos == T) return nkv;
                                     return ckv + (((size_t)pt[pos >> 7] * 128 + (pos & 127)) * 4 + 2) * 128 + kv * 64; },
        [&](int n) -> const float* { const int pos = 64 * sidx[n >> 6] + (n & 63); if (pos >= T) return nkv + 128;
                                     return ckv + (((size_t)pt[pos >> 7] * 128 + (pos & 127)) * 4 + 3) * 128 + kv * 64; },
        [&](int n) { return T - (64 * sidx[n >> 6] + (n & 63)); }, ob + 256);
    } else {
    sample_segment(F, 512, kv,
        [&](int n) -> const float* { return n < 511 ? cwin + (size_t)(n + 1) * 256 + kv * 64 : nkv + 256; },
        [&](int n) -> const float* { return n < 511 ? cwin + (size_t)(n + 1) * 256 + 128 + kv * 64 : nkv + 384; },
        [&](int n) { return 511 - n; }, ob + 512);
    }
    if (TID_ < 256) { const int g = TID_ >> 6, d = TID_ & 63, h = kv * 4 + g; const float* gt = WSP(float, WS_GATES) + (size_t)tok * 24 + h * 3;
        const float v = part == 0 ? gt[0] * ob[TID_] + gt[1] * ob[256 + TID_] : gt[2] * ob[512 + TID_];
        atomicAdd(WSP(float, WS_ONS) + (size_t)b * 512 + h * 64 + d, v); }
}

__device__ __forceinline__ void p6_conv(Frame& F) {
    const bf16* ug = WSP(bf16, WS_UG); bf16* act = WSP(bf16, WS_ACT);
    const float* cw = F.in[I_CONVW]; const float* cb = F.in[I_CONVB]; const float* sconv = F.in[I_SCONV];
    constexpr int NG = DFF / 8, RSEG = 64, NSEGP = NTOKP / RSEG, NITEM = NG * (NSEGP + 1);
    { const float* x1s = WSP(float, WS_X1S); float* ys = F.out + O_YS; for (int i = F.bid * NTHR + TID_; i < SB * 1024; i += F.G * NTHR) ys[i] = x1s[i]; }
    for (int it = F.bid * NTHR + TID_; it < NITEM; it += F.G * NTHR) {
        const int seg = it / NG, c0 = 8 * (it % NG);
        float w0[8], w1[8], w2[8], bb[8];
#pragma unroll
        for (int i = 0; i < 8; ++i) { w0[i] = cw[c0 + i]; w1[i] = cw[DFF + c0 + i]; w2[i] = cw[2 * DFF + c0 + i]; bb[i] = cb[c0 + i]; }
        if (seg < NSEGP) {
            const int row0 = seg * RSEG, t0 = row0 & (T - 1);
            float g0[8], g1[8];
            if (t0 >= 2) { unpack8(*(const u32x4*)(ug + (size_t)(row0 - 2) * DUP + DFF + c0), g0); unpack8(*(const u32x4*)(ug + (size_t)(row0 - 1) * DUP + DFF + c0), g1); }
            else {
#pragma unroll
                for (int i = 0; i < 8; ++i) { g0[i] = 0.f; g1[i] = 0.f; } }
#pragma unroll 4
            for (int rr = 0; rr < RSEG; ++rr) { const int row = row0 + rr; float u[8], g2[8], a[8];
                unpack8(*(const u32x4*)(ug + (size_t)row * DUP + c0), u); unpack8(*(const u32x4*)(ug + (size_t)row * DUP + DFF + c0), g2);
#pragma unroll
                for (int i = 0; i < 8; ++i) { a[i] = gelu_tanh(bb[i] + w0[i] * g0[i] + w1[i] * g1[i] + w2[i] * g2[i]) * u[i]; g0[i] = g1[i]; g1[i] = g2[i]; }
                *(u32x4*)(act + (size_t)row * DFF + c0) = pack8(a); }
            if (t0 + RSEG == T) { float* o = F.out + O_CONVP + (size_t)(row0 >> 13) * 2 * DFF + c0;
#pragma unroll
                for (int i = 0; i < 8; ++i) { o[i] = g0[i]; o[DFF + i] = g1[i]; } }
        } else {
            for (int sb = 0; sb < SB; ++sb) { const int row = NTOKP + sb; float u[8], g2[8], g0[8], g1[8], a[8];
                unpack8(*(const u32x4*)(ug + (size_t)row * DUP + c0), u); unpack8(*(const u32x4*)(ug + (size_t)row * DUP + DFF + c0), g2);
#pragma unroll
                for (int i = 0; i < 8; ++i) { g0[i] = sconv[((size_t)sb * 2 + 0) * DFF + c0 + i]; g1[i] = sconv[((size_t)sb * 2 + 1) * DFF + c0 + i]; }
                float* o = F.out + O_CONVS + (size_t)sb * 2 * DFF + c0;
#pragma unroll
                for (int i = 0; i < 8; ++i) { o[i] = g1[i]; o[DFF + i] = g2[i]; a[i] = gelu_tanh(bb[i] + w0[i] * g0[i] + w1[i] * g1[i] + w2[i] * g2[i]) * u[i]; }
                *(u32x4*)(act + (size_t)row * DFF + c0) = pack8(a); }
            for (int row = NTOK; row < MPAD; ++row) *(u32x4*)(act + (size_t)row * DFF + c0) = (u32x4){0u, 0u, 0u, 0u};
        }
    }
}

template <bool A_F32>
__device__ __forceinline__ void skinny_mma(f32x4 (&acc)[2], float (&ssq)[2], const void* A, int lda, const bf16* Bt, int K, int n0, int k0, int nks, int r, int q) {
    acc[0] = (f32x4){0.f, 0.f, 0.f, 0.f}; acc[1] = acc[0]; ssq[0] = 0.f; ssq[1] = 0.f;
#pragma unroll 4
    for (int ks = 0; ks < nks; ++ks) { const int k = k0 + 32 * ks + 8 * q;
        const bf16x8 a = ldfrag(Bt + (size_t)(n0 + r) * K + k);
#pragma unroll
        for (int mt = 0; mt < 2; ++mt) { bf16x8 bfr;
            if (A_F32) { const float* p = (const float*)A + (size_t)(16 * mt + r) * lda + k; const f32x4 x0 = *(const f32x4*)p, x1 = *(const f32x4*)(p + 4);
                ssq[mt] += (x0[0] * x0[0] + x0[1] * x0[1]) + (x0[2] * x0[2] + x0[3] * x0[3]) + (x1[0] * x1[0] + x1[1] * x1[1]) + (x1[2] * x1[2] + x1[3] * x1[3]); bfr = frag_pk(x0, x1); }
            else bfr = ldfrag((const bf16*)A + (size_t)(16 * mt + r) * lda + k);
            acc[mt] = MFMA16(a, bfr, acc[mt]); } }
}
__device__ __forceinline__ void s5_merge(Frame& F, int t) {
    const int lane = LANE_, r = lane & 15, q = lane >> 4, br = t >> 7, nt = (t >> 1) & 63, kc = t & 1;
    const bf16* A = (br == 0 ? WSP(bf16, WS_ONSA) : br == 1 ? WSP(bf16, WS_OGLA) : WSP(bf16, WS_OX)) + (size_t)NTOKP * 512;
    const bf16* Bt = br == 0 ? WSP(bf16, WS_WTNSA) : br == 1 ? WSP(bf16, WS_WTGLA) : WSP(bf16, WS_WTX);
    f32x4 acc[2]; float ssq[2];
    if (br == 0) skinny_mma<true>(acc, ssq, WSP(float, WS_ONS), 512, Bt, 512, 16 * nt, 256 * kc, 8, r, q);
    else skinny_mma<false>(acc, ssq, A, 512, Bt, 512, 16 * nt, 256 * kc, 8, r, q);
    float* ms = WSP(float, WS_MS); const bf16* gate = WSP(bf16, WS_PROJ) + (size_t)NTOKP * DINP + C_MG + br * 1024;
#pragma unroll
    for (int mt = 0; mt < 2; ++mt) { const int m = 16 * mt + r; const u32x2 g = *(const u32x2*)(gate + (size_t)m * DINP + 16 * nt + 4 * q);
        float* d = ms + (size_t)m * 1024 + 16 * nt + 4 * q;
        atomicAdd(d + 0, acc[mt][0] * sigmoidf_(bflo(g.x))); atomicAdd(d + 1, acc[mt][1] * sigmoidf_(bfhi(g.x)));
        atomicAdd(d + 2, acc[mt][2] * sigmoidf_(bflo(g.y))); atomicAdd(d + 3, acc[mt][3] * sigmoidf_(bfhi(g.y))); }
}
__device__ __forceinline__ void s6_wo(Frame& F, int t) {
    const int lane = LANE_, r = lane & 15, q = lane >> 4, nt = t >> 2, kc = t & 3;
    f32x4 acc[2]; float ssq[2]; skinny_mma<true>(acc, ssq, WSP(float, WS_MS), 1024, WSP(bf16, WS_WTO), 1024, 16 * nt, 256 * kc, 8, r, q);
    float* x1s = WSP(float, WS_X1S);
#pragma unroll
    for (int mt = 0; mt < 2; ++mt) { float* d = x1s + (size_t)(16 * mt + r) * 1024 + 16 * nt + 4 * q;
#pragma unroll
        for (int i = 0; i < 4; ++i) atomicAdd(d + i, acc[mt][i]); }
}
__device__ __forceinline__ void s7_up(Frame& F, int t) {
    const int lane = LANE_, r = lane & 15, q = lane >> 4;
    f32x4 acc[2]; float ssq[2]; skinny_mma<true>(acc, ssq, WSP(float, WS_X1S), 1024, WSP(bf16, WS_WTUP), 1024, 16 * t, 0, 32, r, q);
    bf16* ug = WSP(bf16, WS_UG) + (size_t)NTOKP * DUP;
#pragma unroll
    for (int mt = 0; mt < 2; ++mt) { float s = ssq[mt]; s += __shfl_xor(s, 16); s += __shfl_xor(s, 32); const float rs = rsqrtf(s * (1.f / 1024.f) + EPS);
        u32x2 w; w.x = pk2(acc[mt][0] * rs, acc[mt][1] * rs); w.y = pk2(acc[mt][2] * rs, acc[mt][3] * rs);
        *(u32x2*)(ug + (size_t)(16 * mt + r) * DUP + 16 * t + 4 * q) = w; }
}
__device__ __forceinline__ void s9_down(Frame& F, int t) {
    const int lane = LANE_, r = lane & 15, q = lane >> 4, nt = t / 11, kc = t % 11;
    f32x4 acc[2]; float ssq[2]; skinny_mma<false>(acc, ssq, WSP(bf16, WS_ACT) + (size_t)NTOKP * DFF, DFF, WSP(bf16, WS_WTDOWN), DFF, 16 * nt, 256 * kc, 8, r, q);
    float* ys = F.out + O_YS;
#pragma unroll
    for (int mt = 0; mt < 2; ++mt) { float* d = ys + (size_t)(16 * mt + r) * 1024 + 16 * nt + 4 * q;
#pragma unroll
        for (int i = 0; i < 4; ++i) atomicAdd(d + i, acc[mt][i]); }
}

constexpr int N_PHASES = 10;
__global__ void __launch_bounds__(NTHR, 2) mega_fwd(Args args) {
    extern __shared__ __attribute__((aligned(16))) unsigned char lds_raw[];
    cg::grid_group grid = cg::this_grid();
    Frame F;
    F.lds = (LAS unsigned char*)lds_raw;
    F.wave = __builtin_amdgcn_readfirstlane((int)(threadIdx.x >> 6));
    F.G = gridDim.x; F.bid = blockIdx.x; F.gw = F.bid * NWAVES + F.wave; F.NGW = F.G * NWAVES;
    F.in = args.in; F.out = args.out; F.ws = args.ws;
    const int lo = args.ph_lo, hi = args.ph_hi, sub = args.sub;
    volatile LAS unsigned* xst = (volatile LAS unsigned*)(F.lds + 152640);
    if (threadIdx.x < 2) xst[threadIdx.x] = 0u;
    __syncthreads();
    XcdBarrier xbar; xbar.bar = (unsigned*)(args.ws + WS_CTL); xbar.x = 0; xbar.st = xst;
    if (lo == 0 && hi == N_PHASES) xbar = xcd_barrier_post((unsigned*)(args.ws + WS_CTL), xst);
#define SUB(i) ((sub >> (i)) & 1)
#ifndef PROBE_REP
#define PROBE_REP -1
#endif
#define IN(k) (lo <= (k) && (k) < hi)
#define REP(k) for (int rep_ = 0; rep_ < ((k) == PROBE_REP ? 2 : 1); ++rep_)
#define SEAM(k) do { if (IN(k) && IN((k) + 1)) { if ((k) == 0) grid.sync(); else xcd_barrier(xbar); } { unsigned char* w_ = F.ws; asm volatile("" : "+s"(w_)); F.ws = w_; float* o_ = F.out; asm volatile("" : "+s"(o_)); F.out = o_; } } while (0)
    typedef pg8::StaticOrder SO;
    int p2_gla_sample_task = -1;
    constexpr int KSPLIT = 9;

    REP(0) if (IN(0)) { p0_prologue(F); }
    SEAM(0);
    if (IN(1)) {
        { pg8::Gemm g{WSP(bf16, WS_XN), WSP(bf16, WS_WTIN), MPAD, DINP, 1024}; SO S; S.init(MPAD, DINP, F.G, F.bid);
          pg8::EpiStore E{WSP(bf16, WS_PROJ), DINP, nullptr};
          pg8::gemm_phase<pg8::EpiStore, SO, true, true>(F.lds, g, S, E, F.wave); }
        __syncthreads();
        { pg8::Gemm g{WSP(bf16, WS_MN), WSP(bf16, WS_WTMEM), 512, 1024, 1024}; SO S; S.init(512, 1024, F.G, F.G - 1 - F.bid);
          pg8::EpiStore E{WSP(bf16, WS_MEMPROJ), 1024, nullptr};
          pg8::gemm_phase<pg8::EpiStore, SO, true, true>(F.lds, g, S, E, F.wave); }
    }
    SEAM(1);
    if (IN(2)) {
        if (F.G == 256) {
            const int bid = F.bid;
            if (bid >= 16) { const bool cblk = bid < 136; const int pidx = ((cblk ? bid - 16 : bid - 136) << 3) + F.wave;
                if (SUB(0)) { const int k0 = cblk ? 0 : KSPLIT, k1 = cblk ? KSPLIT : 18; TokRaw raw = p2_token_load(F, k0 * 960 + pidx);
                    for (int k = k0; k < k1; ++k) { const int tok = k * 960 + pidx; if (tok >= NTOK) break; const int tn = (k + 1 < k1 && tok + 960 < NTOK) ? tok + 960 : tok; const TokRaw nxt = p2_token_load(F, tn); p2_token(F, tok, raw); raw = nxt; }
                    if (!cblk && pidx < 512) p2_memrow(F, pidx); }
                if (!cblk && SUB(3) && pidx < SB * 4) p2_gla_sample_task = pidx; }
            if (SUB(1) && bid < CMP_TASKS_S + CMP_TASKS_P) p2_compress(F, bid);
            if (SUB(2)) { if (bid < 16) { __syncthreads(); p2_gla_chunk(F, bid); }
                else if (bid >= 136) { for (int c2 = 0; c2 < 2; ++c2) { __syncthreads(); p2_gla_chunk(F, 16 + (bid - 136) * 2 + c2); } } }
            __syncthreads();
            if (p2_gla_sample_task >= 0) p2_gla_sample(F, p2_gla_sample_task);
        } else {
            if (SUB(0)) { for (int tok = F.gw; tok < NTOK; tok += F.NGW) p2_token(F, tok, p2_token_load(F, tok));
            for (int row = F.gw; row < 512; row += F.NGW) p2_memrow(F, row); }
            if (SUB(1)) for (int t = F.bid; t < CMP_TASKS_S + CMP_TASKS_P; t += F.G) p2_compress(F, t);
            if (SUB(2)) for (int bc = F.bid; bc < 256; bc += F.G) { __syncthreads(); p2_gla_chunk(F, bc); }
            __syncthreads();
            if (SUB(3)) for (int t = F.gw; t < SB * 4; t += F.NGW) p2_gla_sample(F, t);
        }
    }
    SEAM(2);
    REP(3) if (IN(3)) {
        nsa_tables(F);
        const float mb = nsa_bound(F);
        if (SUB(4)) for (int n = F.bid; n < 1024; n += F.G) p3_nsa_prompt(F, n, mb, (sub >> 8) & 255);
        __syncthreads();
        if (SUB(7)) for (int t = F.gw; t < 1024; t += F.NGW) p3_gla_scan(F, t);
    }
    SEAM(3);
    if (IN(4)) {
        nsa_tables(F);
        if (!SUB(5)) {} else if (F.G == 256) { if (F.bid >= 192) p3_nsa_sample(F, 255 - F.bid, 0); else if (F.bid >= 128) p3_nsa_sample(F, 191 - F.bid, 1); }
        else for (int t = F.bid; t < SB * 4; t += F.G) p3_nsa_sample(F, t >> 1, t & 1);
        __syncthreads();
        { const float gq = absmax_arr(F.in[I_GXQ], 128, LANE_), gk = absmax_arr(F.in[I_GXK], 128, LANE_);
          const float mbx = 11.313708498984761f * gq * gk * 1.02f * LOG2E;
          if (SUB(6)) for (int t = F.bid; t < 256; t += F.G) p3_xatt(F, t, mbx); }
        __syncthreads();
        if (!SUB(0)) {} else if (F.G == 256) { if (F.bid >= 64 && F.bid < 192) p3_xatt_sample(F, F.bid - 64); } else for (int t = F.bid; t < SB * 4; t += F.G) p3_xatt_sample(F, t);
        __syncthreads();
        if (!SUB(1)) {} else if (F.G == 256) {
            if (F.bid < 128) { for (int k = 0; k < 3; ++k) p4_gla_out(F, k * 1024 + F.gw); }
            else if (F.bid < 192) { const int wi = ((F.bid - 128) << 3) + F.wave; for (int k = 0; k < 2; ++k) p4_gla_out(F, 3072 + k * 512 + wi); }
        } else for (int t = F.gw; t < 4096; t += F.NGW) p4_gla_out(F, t);
    }
    SEAM(4);
    if (IN(5)) {
        const bf16* gate = WSP(bf16, WS_PROJ) + C_MG;
        for (int t = F.gw; t < 384; t += F.NGW) s5_merge(F, t);
        { pg8::Gemm g{WSP(bf16, WS_ONSA), WSP(bf16, WS_WTNSA), NTOKP, 1024, 512}; SO S; S.init(NTOKP, 1024, F.G, F.bid);
          pg8::EpiMerge<0> E{gate, DINP, WSP(bf16, WS_MERGED), 1024};
          pg8::gemm_phase<pg8::EpiMerge<0>, SO, true, true>(F.lds, g, S, E, F.wave); }
        __syncthreads();
        { pg8::Gemm g{WSP(bf16, WS_OGLA), WSP(bf16, WS_WTGLA), NTOKP, 1024, 512}; SO S; S.init(NTOKP, 1024, F.G, F.bid);
          pg8::EpiMerge<1> E{gate + 1024, DINP, WSP(bf16, WS_MERGED), 1024};
          pg8::gemm_phase<pg8::EpiMerge<1>, SO, true, true>(F.lds, g, S, E, F.wave); }
        __syncthreads();
        { pg8::Gemm g{WSP(bf16, WS_OX), WSP(bf16, WS_WTX), NTOKP, 1024, 512}; SO S; S.init(NTOKP, 1024, F.G, F.bid);
          pg8::EpiMerge<1> E{gate + 2048, DINP, WSP(bf16, WS_MERGED), 1024};
          pg8::gemm_phase<pg8::EpiMerge<1>, SO, true, true>(F.lds, g, S, E, F.wave); }
    }
    SEAM(5);
    if (IN(6)) {
        for (int t = F.gw; t < 256; t += F.NGW) s6_wo(F, t);
        pg8::Gemm g{WSP(bf16, WS_MERGED), WSP(bf16, WS_WTO), NTOKP, 1024, 1024}; SO S; S.init(NTOKP, 1024, F.G, F.bid);
        pg8::EpiWo E{F.in[I_XP], F.in[I_XS], WSP(float, WS_X1), WSP(bf16, WS_X1B), WSP(float, WS_SSQ)};
        pg8::gemm_phase<pg8::EpiWo, SO, true, true>(F.lds, g, S, E, F.wave);
    }
    SEAM(6);
    if (IN(7)) {
        for (int t = F.gw; t < 352; t += F.NGW) s7_up(F, t);
        pg8::Gemm g{WSP(bf16, WS_X1B), WSP(bf16, WS_WTUP), NTOKP, DUP, 1024}; SO S; S.init(NTOKP, DUP, F.G, F.bid);
        pg8::EpiStore E{WSP(bf16, WS_UG), DUP, WSP(float, WS_SSQ)};
        pg8::gemm_phase<pg8::EpiStore, SO, true, true>(F.lds, g, S, E, F.wave);
    }
    SEAM(7);
    REP(8) if (IN(8)) { p6_conv(F); }
    SEAM(8);
    if (IN(9)) {
        for (int t = F.gw; t < 704; t += F.NGW) s9_down(F, t);
        pg8::Gemm g{WSP(bf16, WS_ACT), WSP(bf16, WS_WTDOWN), NTOKP, 1024, DFF}; SO S; S.init(NTOKP, 1024, F.G, F.bid);
        pg8::EpiDown E{WSP(float, WS_X1), F.out + O_Y, F.out + O_YS};
        pg8::gemm_phase<pg8::EpiDown, SO, true, true>(F.lds, g, S, E, F.wave);
    }
#undef IN
#undef SEAM
}

extern "C" void kernel_launch(void* const* d_in, const int* in_sizes, int n_in, void* d_out, int out_size, void* d_ws, size_t ws_size, hipStream_t stream) {
    static int grid = 0;
    if (grid == 0) {
        if (n_in != N_IN || (size_t)out_size != O_END || ws_size < WS_END) {
            fprintf(stderr, "kernel_launch: built for %d inputs, %zu outputs, >= %zu bytes of workspace; got %d, %d, %zu\n", (int)N_IN, (size_t)O_END, (size_t)WS_END, n_in, out_size, ws_size); grid = -1; return; }
        int dev = 0, cus = 0, per_cu = 0;
        if (hipGetDevice(&dev) != hipSuccess || hipDeviceGetAttribute(&cus, hipDeviceAttributeMultiprocessorCount, dev) != hipSuccess) { grid = -1; return; }
        if (hipFuncSetAttribute((const void*)mega_fwd, hipFuncAttributeMaxDynamicSharedMemorySize, LDS_BYTES) != hipSuccess) { fprintf(stderr, "kernel_launch: hipFuncSetAttribute failed\n"); grid = -1; return; }
        if (hipOccupancyMaxActiveBlocksPerMultiprocessor(&per_cu, (const void*)mega_fwd, NTHR, LDS_BYTES) != hipSuccess || per_cu < 1) { fprintf(stderr, "kernel_launch: occupancy query gave %d\n", per_cu); per_cu = 1; }
        (void)hipGetLastError();
        grid = cus * (per_cu < 1 ? 1 : 1);
    }
    if (grid < 0) return;
    Args a{};
    for (int i = 0; i < N_IN; ++i) a.in[i] = (const float*)d_in[i];
    a.out = (float*)d_out; a.ws = (unsigned char*)d_ws;
#if MK_N_LAUNCHES == 1
    a.ph_lo = 0; a.ph_hi = N_PHASES; a.sub = 0xff;
    (void)hipMemsetAsync((unsigned char*)d_ws + WS_CTL, 0, CTL_BYTES, stream);
    void* kargs[] = {&a};
    hipError_t e = hipLaunchCooperativeKernel((const void*)mega_fwd, dim3(grid), dim3(NTHR), kargs, LDS_BYTES, stream);
    if (e != hipSuccess) fprintf(stderr, "kernel_launch: cooperative launch failed: %s (grid %d)\n", hipGetErrorString(e), grid);
#ifdef PROBE_EXTRA
    a.ph_lo = PROBE_EXTRA; a.ph_hi = PROBE_EXTRA + 1;
#ifdef PROBE_SUB
    a.sub = PROBE_SUB;
#endif
    hipLaunchKernelGGL(mega_fwd, dim3(grid), dim3(NTHR), LDS_BYTES, stream, a);
#endif
#else
    a.sub = 0xff;
    for (int p = 0; p < N_PHASES; ++p) { a.ph_lo = p; a.ph_hi = p + 1; hipLaunchKernelGGL(mega_fwd, dim3(grid), dim3(NTHR), LDS_BYTES, stream, a); }
#endif
}
```

```cpp
#include <hip/hip_runtime.h>
#include <hip/hip_cooperative_groups.h>
#include <cstdio>
#include <cstdint>
namespace cg = cooperative_groups;
#ifndef MK_N_LAUNCHES
#define MK_N_LAUNCHES 1
#endif
namespace pg8 {
#define PG8_LAS __attribute__((address_space(3)))
typedef unsigned short bf16_t;
typedef short bf16x8 __attribute__((ext_vector_type(8)));
typedef float f32x4 __attribute__((ext_vector_type(4)));
typedef unsigned u32x4 __attribute__((ext_vector_type(4)));
constexpr int BM = 256, BK = 64, HALF = 128, HTB = HALF * BK * 2  , STAGE_BYTES = 8 * HTB, NXCD = 8, WGM = 8;

__host__ __device__ __forceinline__ int lds_byte(int r, int c) { const int st = (r >> 4) * 2 + (c >> 5), rr = r & 15, cc = c & 31, ob = rr * 64 + cc * 2; return st * 1024 + (ob ^ (((ob >> 9) & 1) << 5)); }
__host__ __device__ __forceinline__ void stage_rc(int b, int& R, int& C) { const int st = b / 1024, sb = b % 1024, swz = sb ^ (((sb >> 9) & 1) << 5); R = (st >> 1) * 16 + swz / 64; C = (st & 1) * 32 + (swz % 64) / 2; }
__host__ __device__ __forceinline__ int perm32(int rho) { const int n = rho >> 4, i = rho & 15; return 8 * (i >> 2) + 4 * n + (i & 3); }

struct Unit { int pm, pn; };
struct Gemm { const bf16_t* A; const bf16_t* Bt; int M, N, K; };

struct StaticOrder {
    int nM, nN, nwg, G, c;
    __host__ __device__ void init(int M, int N, int G_, int c_) { nM = M / BM; nN = N / BM; nwg = nM * nN; G = G_; c = c_; }
    __host__ __device__ bool next(int i, Unit& u) const {
        const long L = (long)i * G + c; if (L >= nwg) return false;
        int wgid = (int)L; { const int q = nwg / NXCD, r = nwg % NXCD, xcd = wgid % NXCD, off = wgid / NXCD; wgid = (xcd < r ? xcd * (q + 1) : r * (q + 1) + (xcd - r) * q) + off; }
        const int nig = WGM * nN, gid = wgid / nig, fm = gid * WGM, gsz = (nM - fm) < WGM ? (nM - fm) : WGM;
        u.pm = fm + ((wgid % nig) % gsz); u.pn = (wgid % nig) / gsz; return true;
    }
    __device__ __forceinline__ void a_ready(const Unit&) const {}
    __device__ __forceinline__ void done(const Unit&) const {}
};

__device__ __forceinline__ unsigned cvt_pk_bf16(float lo, float hi) { unsigned r; asm volatile("v_cvt_pk_bf16_f32 %0, %1, %2" : "=v"(r) : "v"(lo), "v"(hi)); return r; }
__device__ __forceinline__ float bflo(unsigned w) { return __uint_as_float(w << 16); }
__device__ __forceinline__ float bfhi(unsigned w) { return __uint_as_float(w & 0xffff0000u); }
__device__ __forceinline__ float sigm(float x) { return 1.0f / (1.0f + __expf(-x)); }
struct EpiStore {
    static constexpr bool PERM = true, AFTER_DRAIN = false;
    bf16_t* O; int ldc; const float* ssq;
    __device__ __forceinline__ void operator()(const f32x4 (&acc)[2][2][4][2], const Unit& u, int wr, int wc, int fr, int fq) const {
        const int row0 = u.pm * BM + wr * 64 + fr, col0 = u.pn * BM + wc * 32 + 8 * fq;
#pragma unroll
        for (int ai = 0; ai < 2; ++ai)
#pragma unroll
            for (int m = 0; m < 4; ++m) { const int row = row0 + ai * HALF + m * 16; bf16_t* rowp = O + (size_t)row * ldc + col0;
                const float sc = ssq ? rsqrtf(ssq[row] * (1.0f / 1024.0f) + 1e-6f) : 1.0f;
#pragma unroll
                for (int bj = 0; bj < 2; ++bj) { const f32x4 v0 = acc[ai][bj][m][0] * sc, v1 = acc[ai][bj][m][1] * sc;
                    u32x4 w; w.x = cvt_pk_bf16(v0[0], v0[1]); w.y = cvt_pk_bf16(v0[2], v0[3]); w.z = cvt_pk_bf16(v1[0], v1[1]); w.w = cvt_pk_bf16(v1[2], v1[3]);
                    *(u32x4*)(rowp + bj * HALF) = w; } }
    }
};
template <int ACCUM> struct EpiMerge {
    static constexpr bool PERM = true, AFTER_DRAIN = false;
    const bf16_t* gate; int ldg; bf16_t* O; int ldc;
    __device__ __forceinline__ void operator()(const f32x4 (&acc)[2][2][4][2], const Unit& u, int wr, int wc, int fr, int fq) const {
        const int row0 = u.pm * BM + wr * 64 + fr, col0 = u.pn * BM + wc * 32 + 8 * fq;
#pragma unroll
        for (int ai = 0; ai < 2; ++ai)
#pragma unroll
            for (int m = 0; m < 4; ++m) { const int row = row0 + ai * HALF + m * 16; bf16_t* rowp = O + (size_t)row * ldc + col0; const bf16_t* gp = gate + (size_t)row * ldg + col0;
#pragma unroll
                for (int bj = 0; bj < 2; ++bj) {
                    const u32x4 g = *(const u32x4*)(gp + bj * HALF);
                    f32x4 v0 = acc[ai][bj][m][0], v1 = acc[ai][bj][m][1];
                    v0[0] *= sigm(bflo(g.x)); v0[1] *= sigm(bfhi(g.x)); v0[2] *= sigm(bflo(g.y)); v0[3] *= sigm(bfhi(g.y));
                    v1[0] *= sigm(bflo(g.z)); v1[1] *= sigm(bfhi(g.z)); v1[2] *= sigm(bflo(g.w)); v1[3] *= sigm(bfhi(g.w));
                    if (ACCUM) { const u32x4 o = *(const u32x4*)(rowp + bj * HALF);
                        v0[0] += bflo(o.x); v0[1] += bfhi(o.x); v0[2] += bflo(o.y); v0[3] += bfhi(o.y);
                        v1[0] += bflo(o.z); v1[1] += bfhi(o.z); v1[2] += bflo(o.w); v1[3] += bfhi(o.w); }
                    u32x4 w; w.x = cvt_pk_bf16(v0[0], v0[1]); w.y = cvt_pk_bf16(v0[2], v0[3]); w.z = cvt_pk_bf16(v1[0], v1[1]); w.w = cvt_pk_bf16(v1[2], v1[3]);
                    *(u32x4*)(rowp + bj * HALF) = w; } }
    }
};
struct EpiWo {
    static constexpr bool PERM = true, AFTER_DRAIN = false;
    const float* xp; const float* xs; float* X1; bf16_t* X1B; float* ssq;
    __device__ __forceinline__ void operator()(const f32x4 (&acc)[2][2][4][2], const Unit& u, int wr, int wc, int fr, int fq) const {
        const int row0 = u.pm * BM + wr * 64 + fr, col0 = u.pn * BM + wc * 32 + 8 * fq;
#pragma unroll
        for (int ai = 0; ai < 2; ++ai)
#pragma unroll
            for (int m = 0; m < 4; ++m) { const int row = row0 + ai * HALF + m * 16;
                const float* xr = row < 16384 ? xp + (size_t)row * 1024 : (row < 16416 ? xs + (size_t)(row - 16384) * 1024 : nullptr);
                float ss = 0.f;
#pragma unroll
                for (int bj = 0; bj < 2; ++bj) { const int col = col0 + bj * HALF;
                    f32x4 x0 = (f32x4){0.f, 0.f, 0.f, 0.f}, x1 = x0;
                    if (xr) { x0 = *(const f32x4*)(xr + col); x1 = *(const f32x4*)(xr + col + 4); }
                    const f32x4 v0 = acc[ai][bj][m][0] + x0, v1 = acc[ai][bj][m][1] + x1;
                    *(f32x4*)(X1 + (size_t)row * 1024 + col) = v0; *(f32x4*)(X1 + (size_t)row * 1024 + col + 4) = v1;
                    u32x4 w; w.x = cvt_pk_bf16(v0[0], v0[1]); w.y = cvt_pk_bf16(v0[2], v0[3]); w.z = cvt_pk_bf16(v1[0], v1[1]); w.w = cvt_pk_bf16(v1[2], v1[3]);
                    *(u32x4*)(X1B + (size_t)row * 1024 + col) = w;
                    ss += (v0[0] * v0[0] + v0[1] * v0[1]) + (v0[2] * v0[2] + v0[3] * v0[3]) + (v1[0] * v1[0] + v1[1] * v1[1]) + (v1[2] * v1[2] + v1[3] * v1[3]); }
                ss += __shfl_xor(ss, 16); ss += __shfl_xor(ss, 32);
                if (fq == 0) atomicAdd(ssq + row, ss); }
    }
};
struct EpiDown {
    static constexpr bool PERM = true, AFTER_DRAIN = false;
    const float* X1; float* yp; float* ys;
    __device__ __forceinline__ void operator()(const f32x4 (&acc)[2][2][4][2], const Unit& u, int wr, int wc, int fr, int fq) const {
        const int row0 = u.pm * BM + wr * 64 + fr, col0 = u.pn * BM + wc * 32 + 8 * fq;
#pragma unroll
        for (int ai = 0; ai < 2; ++ai)
#pragma unroll
            for (int m = 0; m < 4; ++m) { const int row = row0 + ai * HALF + m * 16;
                float* yr = row < 16384 ? yp + (size_t)row * 1024 : (row < 16416 ? ys + (size_t)(row - 16384) * 1024 : nullptr);
                if (!yr) continue;
#pragma unroll
                for (int bj = 0; bj < 2; ++bj) { const int col = col0 + bj * HALF;
                    const f32x4 x0 = *(const f32x4*)(X1 + (size_t)row * 1024 + col), x1 = *(const f32x4*)(X1 + (size_t)row * 1024 + col + 4);
                    *(f32x4*)(yr + col) = acc[ai][bj][m][0] + x0; *(f32x4*)(yr + col + 4) = acc[ai][bj][m][1] + x1; } }
    }
};
template <class Epi, class Sched, bool ALIGN_EPI = false, bool SP2 = false>
__device__ __forceinline__ void gemm_phase(PG8_LAS unsigned char* lds, const Gemm g, const Sched& S, const Epi& E, const int wid) {
    unsigned z_ = 0u; asm volatile("" : "+v"(z_));
    const int lane = (int)__builtin_amdgcn_mbcnt_hi(~0u, __builtin_amdgcn_mbcnt_lo(~0u, z_)), tid = wid * 64 + lane, wr = wid >> 2, wc = wid & 3, fr = lane & 15, fq = lane >> 4;
    const int K = g.K, nt = K / BK;
    unsigned voffA[2], voffB[2];
#pragma unroll
    for (int i = 0; i < 2; ++i) { int R, C; stage_rc(tid * 16 + i * 8192, R, C); const int Rb = Epi::PERM ? ((R & ~31) + perm32(R & 31)) : R;
        voffA[i] = (unsigned)(R * K + C) * 2u; voffB[i] = (unsigned)(Rb * K + C) * 2u; }
    const size_t kstep = (size_t)(BK * 2);
    const size_t hstep = (size_t)HALF * K * 2;
    const size_t tstep = 2 * hstep;
    const unsigned ldsw = (unsigned)wid * 1024u;
    const int aoff = lds_byte(wr * 64 + fr, fq * 8), boff = lds_byte(wc * 32 + fr, fq * 8);
#define PG8_SA(b, h) (((b) * 2 + (h)) * HTB)
#define PG8_SB(b, h) ((4 + (b) * 2 + (h)) * HTB)
#define PG8_STAGE(bufoff, gbase, voff) do { _Pragma("unroll") for (int _i = 0; _i < 2; ++_i) \
        __builtin_amdgcn_global_load_lds((const unsigned*)((const char*)(gbase) + (voff)[_i]), (PG8_LAS unsigned*)(lds + (bufoff) + ldsw + _i * 8192), 16, 0, 0); } while (0)
#define PG8_LDA(dst, b, h) do { _Pragma("unroll") for (int m = 0; m < 4; ++m) _Pragma("unroll") for (int k = 0; k < 2; ++k) dst[m][k] = *(const PG8_LAS bf16x8*)(lds + PG8_SA(b, h) + aoff + m * 2048 + k * 1024); } while (0)
#define PG8_LDB(dst, b, h) do { _Pragma("unroll") for (int n = 0; n < 2; ++n) _Pragma("unroll") for (int k = 0; k < 2; ++k) dst[n][k] = *(const PG8_LAS bf16x8*)(lds + PG8_SB(b, h) + boff + n * 2048 + k * 1024); } while (0)
#define PG8_MMA(ai, bj, At, Bt) do { __builtin_amdgcn_s_setprio(1); _Pragma("unroll") for (int m = 0; m < 4; ++m) _Pragma("unroll") for (int n = 0; n < 2; ++n) _Pragma("unroll") for (int k = 0; k < 2; ++k) \
        acc[ai][bj][m][n] = __builtin_amdgcn_mfma_f32_16x16x32_bf16(Bt[n][k], At[m][k], acc[ai][bj][m][n], 0, 0, 0); __builtin_amdgcn_s_setprio(0); } while (0)
#define PG8_WAIT_V(n) asm volatile("s_waitcnt vmcnt(" #n ")" ::: "memory")
#define PG8_WAIT_L(n) asm volatile("s_waitcnt lgkmcnt(" #n ")" ::: "memory")
#define PG8_BAR __builtin_amdgcn_s_barrier()
#define PG8_SCHED __builtin_amdgcn_sched_barrier(0)
    Unit cur, nxt; int ui = 0;
    if (!S.next(0, cur)) return;
    f32x4 acc[2][2][4][2];
#pragma unroll
    for (int a = 0; a < 2; ++a)
#pragma unroll
        for (int b = 0; b < 2; ++b)
#pragma unroll
            for (int m = 0; m < 4; ++m)
#pragma unroll
                for (int n = 0; n < 2; ++n) acc[a][b][m][n] = (f32x4){0.f, 0.f, 0.f, 0.f};
    bf16x8 At[4][2], B0[2][2], B1[2][2];
    const char* cA = (const char*)g.A + (size_t)cur.pm * tstep; const char* cB = (const char*)g.Bt + (size_t)cur.pn * tstep;
    S.a_ready(cur);
    if constexpr (SP2) {
        PG8_STAGE(PG8_SB(0, 0), cB, voffB); PG8_STAGE(PG8_SB(0, 1), cB + hstep, voffB); PG8_STAGE(PG8_SA(0, 0), cA, voffA); PG8_STAGE(PG8_SA(0, 1), cA + hstep, voffA);
        if (wr == 1) PG8_BAR;
        PG8_WAIT_V(2); PG8_BAR;
        PG8_STAGE(PG8_SB(1, 0), cB + kstep, voffB); PG8_STAGE(PG8_SA(1, 0), cA + kstep, voffA); PG8_STAGE(PG8_SB(1, 1), cB + hstep + kstep, voffB);
        PG8_WAIT_V(6); PG8_BAR;
    } else {
        PG8_STAGE(PG8_SB(0, 0), cB, voffB); PG8_STAGE(PG8_SA(0, 0), cA, voffA); PG8_STAGE(PG8_SB(0, 1), cB + hstep, voffB); PG8_STAGE(PG8_SA(0, 1), cA + hstep, voffA);
        if (wr == 1) PG8_BAR;
        PG8_WAIT_V(4); PG8_BAR;
        PG8_STAGE(PG8_SB(1, 0), cB + kstep, voffB); PG8_STAGE(PG8_SA(1, 0), cA + kstep, voffA); PG8_STAGE(PG8_SB(1, 1), cB + hstep + kstep, voffB);
        PG8_WAIT_V(6); PG8_BAR;
    }
    for (;;) {
        const bool has_next = S.next(ui + 1, nxt);
        const char* nA = has_next ? (const char*)g.A + (size_t)nxt.pm * tstep : cA; const char* nB = has_next ? (const char*)g.Bt + (size_t)nxt.pn * tstep : cB;
        for (int t = 0; t < nt; t += 2) {
            const bool last = (t == nt - 2);
            const char* a1 = cA + (size_t)(t + 1) * kstep;
            const char* a2 = last ? nA : cA + (size_t)(t + 2) * kstep; const char* b2 = last ? nB : cB + (size_t)(t + 2) * kstep;
            const char* a3 = a2 + kstep; const char* b3 = b2 + kstep;
            if (last && has_next) S.a_ready(nxt);
            if constexpr (SP2) {
            PG8_LDB(B0, 0, 0); PG8_LDB(B1, 0, 1); PG8_SCHED; PG8_LDA(At, 0, 0); PG8_STAGE(PG8_SA(1, 1), a1 + hstep, voffA);
            PG8_WAIT_V(8); PG8_WAIT_L(0); PG8_BAR; PG8_MMA(0, 0, At, B0); PG8_MMA(0, 1, At, B1); PG8_BAR; PG8_SCHED;
            PG8_LDA(At, 0, 1); PG8_STAGE(PG8_SB(0, 0), b2, voffB); PG8_STAGE(PG8_SB(0, 1), b2 + hstep, voffB); PG8_STAGE(PG8_SA(0, 0), a2, voffA);
            PG8_WAIT_V(8); PG8_WAIT_L(0); PG8_BAR; PG8_MMA(1, 0, At, B0); PG8_MMA(1, 1, At, B1); PG8_BAR; PG8_SCHED;
            PG8_LDB(B0, 1, 0); PG8_LDB(B1, 1, 1); PG8_SCHED; PG8_LDA(At, 1, 0); PG8_STAGE(PG8_SA(0, 1), a2 + hstep, voffA);
            PG8_WAIT_V(8); PG8_WAIT_L(0); PG8_BAR; PG8_MMA(0, 0, At, B0); PG8_MMA(0, 1, At, B1); PG8_BAR; PG8_SCHED;
            PG8_LDA(At, 1, 1); PG8_STAGE(PG8_SB(1, 0), b3, voffB); PG8_STAGE(PG8_SB(1, 1), b3 + hstep, voffB); PG8_STAGE(PG8_SA(1, 0), a3, voffA);
            PG8_WAIT_V(8); PG8_WAIT_L(0); PG8_BAR; PG8_MMA(1, 0, At, B0); PG8_MMA(1, 1, At, B1); PG8_BAR; PG8_SCHED;
            } else {
            PG8_LDB(B0, 0, 0); PG8_SCHED; PG8_LDA(At, 0, 0); PG8_STAGE(PG8_SA(1, 1), a1 + hstep, voffA);
            PG8_WAIT_L(8); PG8_BAR; PG8_WAIT_L(0); PG8_MMA(0, 0, At, B0); PG8_BAR; PG8_SCHED;
            PG8_LDB(B1, 0, 1); PG8_STAGE(PG8_SB(0, 0), b2, voffB);
            PG8_BAR; PG8_WAIT_L(0); PG8_MMA(0, 1, At, B1); PG8_BAR;
            PG8_LDA(At, 0, 1); PG8_STAGE(PG8_SA(0, 0), a2, voffA);
            PG8_BAR; PG8_WAIT_L(0); PG8_MMA(1, 0, At, B0); PG8_BAR; PG8_SCHED;
            PG8_STAGE(PG8_SB(0, 1), b2 + hstep, voffB);
            PG8_WAIT_V(6); PG8_BAR; PG8_MMA(1, 1, At, B1); PG8_BAR;
            PG8_LDB(B0, 1, 0); PG8_SCHED; PG8_LDA(At, 1, 0); PG8_STAGE(PG8_SA(0, 1), a2 + hstep, voffA);
            PG8_WAIT_L(8); PG8_BAR; PG8_WAIT_L(0); PG8_MMA(0, 0, At, B0); PG8_BAR; PG8_SCHED;
            PG8_LDB(B1, 1, 1); PG8_STAGE(PG8_SB(1, 0), b3, voffB);
            PG8_BAR; PG8_WAIT_L(0); PG8_MMA(0, 1, At, B1); PG8_BAR;
            PG8_LDA(At, 1, 1); PG8_STAGE(PG8_SA(1, 0), a3, voffA);
            PG8_BAR; PG8_WAIT_L(0); PG8_MMA(1, 0, At, B0); PG8_BAR; PG8_SCHED;
            PG8_STAGE(PG8_SB(1, 1), b3 + hstep, voffB);
            PG8_WAIT_V(6); PG8_BAR; PG8_MMA(1, 1, At, B1); PG8_BAR;
            }
        }
        if constexpr (ALIGN_EPI) { if (wr == 0) PG8_BAR; }
        if constexpr (!Epi::AFTER_DRAIN) { E(acc, cur, wr, wc, fr, fq); S.done(cur); }
        if (!has_next) break;
#pragma unroll
        for (int a = 0; a < 2; ++a)
#pragma unroll
            for (int b = 0; b < 2; ++b)
#pragma unroll
                for (int m = 0; m < 4; ++m)
#pragma unroll
                    for (int n = 0; n < 2; ++n) acc[a][b][m][n] = (f32x4){0.f, 0.f, 0.f, 0.f};
        cur = nxt; cA = nA; cB = nB; ++ui;
        if constexpr (ALIGN_EPI) { if (wr == 1) PG8_BAR; }
    }
    PG8_WAIT_V(0);
    if constexpr (!ALIGN_EPI) { if (wr == 0) PG8_BAR; }
    PG8_BAR;
    if constexpr (Epi::AFTER_DRAIN) { E.fused(acc, cur, wr, wc, fr, fq, lds, wid, lane); S.done(cur); }
#undef PG8_SA
#undef PG8_SB
#undef PG8_STAGE
#undef PG8_LDA
#undef PG8_LDB
#undef PG8_MMA
#undef PG8_WAIT_V
#undef PG8_WAIT_L
#undef PG8_BAR
#undef PG8_SCHED
}
}

typedef unsigned short bf16;
typedef short bf16x8 __attribute__((ext_vector_type(8)));
typedef short bf16x4 __attribute__((ext_vector_type(4)));
typedef float f32x4 __attribute__((ext_vector_type(4)));
typedef unsigned u32x4 __attribute__((ext_vector_type(4)));
typedef unsigned u32x2 __attribute__((ext_vector_type(2)));
#define LAS __attribute__((address_space(3)))
constexpr int NWAVES = 8, NTHR = 512;
constexpr int DM = 1024, T = 8192, NB = 2, NTOKP = NB * T, SB = 32, NTOK = NTOKP + SB, MPAD = 16640;
constexpr int DIN = 6440, DINP = 6656, DFF = 2816, DUP = 2 * DFF;
constexpr int C_Q = 0, C_KV = 512, C_G = 1280, C_GQ = 1304, C_GK = 1560, C_GV = 1816, C_LR = 2328, C_GR = 2344, C_XQ = 2856, C_MG = 3368;
constexpr float EPS = 1e-6f, LOG2E = 1.4426950408889634f;
constexpr float QSCALE = 0.125f * LOG2E;
constexpr float XSCALE = 0.08838834764831845f * LOG2E;
constexpr size_t O_Y = 0, O_YS = 16777216, O_KVP = O_YS + 32768, O_WINP = O_KVP + 8388608, O_GLAP = O_WINP + 262144, O_CONVP = O_GLAP + 65536,
                 O_MEMP = O_CONVP + 11264, O_KVS = O_MEMP + 524288, O_WINS = O_KVS + 16384, O_GLAS = O_WINS + 4194304, O_CONVS = O_GLAS + 1048576, O_END = O_CONVS + 180224;
enum { I_XP = 0, I_XS, I_CKV, I_CWIN, I_SGLA, I_SCONV, I_CMEM, I_PT, I_MEMP, I_GMIX, I_WIN, I_GNQ, I_GNK, I_CKPE, I_CKW1, I_CKW2, I_CVPE, I_CVW1, I_CVW2,
       I_RB, I_WGG, I_BGG, I_GGO, I_GMEM, I_WMEM, I_GXQ, I_GXK, I_WNSA, I_WGLA, I_WX, I_WO, I_GFFN, I_WUP, I_CONVW, I_CONVB, I_WDOWN, N_IN };
constexpr size_t al_(size_t x) { return (x + 255) & ~(size_t)255; }
constexpr size_t WS_SSQ = 0;
constexpr size_t WS_C0 = al_(WS_SSQ + (size_t)MPAD * 4);
constexpr size_t WS_WTIN = al_(WS_C0 + 1024);
constexpr size_t WS_WTMEM = al_(WS_WTIN + (size_t)DINP * 1024 * 2);
constexpr size_t WS_WTNSA = al_(WS_WTMEM + (size_t)1024 * 1024 * 2);
constexpr size_t WS_WTGLA = al_(WS_WTNSA + (size_t)1024 * 512 * 2);
constexpr size_t WS_WTX = al_(WS_WTGLA + (size_t)1024 * 512 * 2);
constexpr size_t WS_WTO = al_(WS_WTX + (size_t)1024 * 512 * 2);
constexpr size_t WS_WTUP = al_(WS_WTO + (size_t)1024 * 1024 * 2);
constexpr size_t WS_WTDOWN = al_(WS_WTUP + (size_t)DUP * 1024 * 2);
constexpr size_t WS_W1T = al_(WS_WTDOWN + (size_t)1024 * DFF * 2);
constexpr size_t WS_W2T = al_(WS_W1T + (size_t)2 * 64 * 2048 * 2);
constexpr size_t WS_XN = al_(WS_W2T + (size_t)2 * 64 * 64 * 2);
constexpr size_t WS_MN = al_(WS_XN + (size_t)MPAD * 1024 * 2);
constexpr size_t WS_PROJ = al_(WS_MN + (size_t)512 * 1024 * 2);
constexpr size_t WS_MEMPROJ = al_(WS_PROJ + (size_t)MPAD * DINP * 2);
constexpr size_t WS_QN = al_(WS_MEMPROJ + (size_t)512 * 1024 * 2);
constexpr size_t WS_KSEL = al_(WS_QN + (size_t)NTOK * 512 * 2);
constexpr size_t WS_VSELT = al_(WS_KSEL + (size_t)4 * T * 64 * 2);
constexpr size_t WS_KWIN = al_(WS_VSELT + (size_t)4 * T * 64 * 2);
constexpr size_t WS_VWINT = al_(WS_KWIN + (size_t)4 * T * 64 * 2);
constexpr size_t WS_GATES = al_(WS_VWINT + (size_t)4 * T * 64 * 2);
constexpr size_t WS_NEWKV = al_(WS_GATES + (size_t)NTOK * 24 * 4);
constexpr size_t WS_KCMP = al_(WS_NEWKV + (size_t)SB * 4 * 2 * 64 * 4);
constexpr size_t WS_VCMPT = al_(WS_KCMP + (size_t)4 * 512 * 64 * 2);
constexpr size_t WS_KCMPS = al_(WS_VCMPT + (size_t)4 * 512 * 64 * 2);
constexpr size_t WS_VCMPS = al_(WS_KCMPS + (size_t)SB * 2 * 512 * 64 * 4);
constexpr size_t WS_QTG = al_(WS_VCMPS + (size_t)SB * 2 * 512 * 64 * 4);
constexpr size_t WS_KTG = al_(WS_QTG + (size_t)NTOKP * 256 * 2);
constexpr size_t WS_VTG = al_(WS_KTG + (size_t)NTOKP * 256 * 2);
constexpr size_t WS_UP = al_(WS_VTG + (size_t)256 * 4 * 128 * 64 * 2);
constexpr size_t WS_DEC = al_(WS_UP + (size_t)256 * 4 * 128 * 64 * 4);
constexpr size_t WS_SC = al_(WS_DEC + (size_t)256 * 4 * 64 * 4);
constexpr size_t WS_XQ = al_(WS_SC + (size_t)256 * 4 * 128 * 64 * 2);
constexpr size_t WS_KMEM = al_(WS_XQ + (size_t)NTOK * 512 * 2);
constexpr size_t WS_VMEMT = al_(WS_KMEM + (size_t)8 * 256 * 128 * 2);
constexpr size_t WS_ONSA = al_(WS_VMEMT + (size_t)8 * 256 * 128 * 2);
constexpr size_t WS_OGLA = al_(WS_ONSA + (size_t)MPAD * 512 * 2);
constexpr size_t WS_OX = al_(WS_OGLA + (size_t)MPAD * 512 * 2);
constexpr size_t WS_MERGED = al_(WS_OX + (size_t)MPAD * 512 * 2);
constexpr size_t WS_X1 = al_(WS_MERGED + (size_t)MPAD * 1024 * 2);
constexpr size_t WS_X1B = al_(WS_X1 + (size_t)MPAD * 1024 * 4);
constexpr size_t WS_UG = al_(WS_X1B + (size_t)MPAD * 1024 * 2);
constexpr size_t WS_ACT = al_(WS_UG + (size_t)MPAD * DUP * 2);
constexpr size_t WS_MS = al_(WS_ACT + (size_t)MPAD * DFF * 2);
constexpr size_t WS_X1S = al_(WS_MS + (size_t)SB * 1024 * 4);
constexpr size_t WS_ONS = al_(WS_X1S + (size_t)SB * 1024 * 4);
constexpr size_t WS_PARK = al_(WS_ONS + (size_t)SB * 512 * 4);
constexpr size_t WS_CTL = al_(WS_PARK + (size_t)2048 * 4096);
constexpr size_t CTL_BYTES = 16384;
constexpr size_t WS_END = al_(WS_CTL + CTL_BYTES);
constexpr int RING_BYTES = 131072, LDS_BYTES = 155648;

struct Args { const float* in[N_IN]; float* out; unsigned char* ws; int ph_lo, ph_hi, sub, pad; };

__device__ __forceinline__ unsigned f2bf(float f) { unsigned u = __float_as_uint(f); return (u + 0x7fffu + ((u >> 16) & 1u)) >> 16; }
__device__ __forceinline__ unsigned pk2(float lo, float hi) { return pg8::cvt_pk_bf16(lo, hi); }
__device__ __forceinline__ float bf2f(unsigned short u) { return __uint_as_float((unsigned)u << 16); }
__device__ __forceinline__ float bflo(unsigned w) { return __uint_as_float(w << 16); }
__device__ __forceinline__ float bfhi(unsigned w) { return __uint_as_float(w & 0xffff0000u); }
__device__ __forceinline__ void unpack8(const u32x4 w, float (&f)[8]) { f[0] = bflo(w.x); f[1] = bfhi(w.x); f[2] = bflo(w.y); f[3] = bfhi(w.y); f[4] = bflo(w.z); f[5] = bfhi(w.z); f[6] = bflo(w.w); f[7] = bfhi(w.w); }
__device__ __forceinline__ u32x4 pack8(const float (&f)[8]) { u32x4 w; w.x = pk2(f[0], f[1]); w.y = pk2(f[2], f[3]); w.z = pk2(f[4], f[5]); w.w = pk2(f[6], f[7]); return w; }
__device__ __forceinline__ bf16x8 as_frag(u32x4 w) { return __builtin_bit_cast(bf16x8, w); }
__device__ __forceinline__ bf16x8 frag_pk(f32x4 a, f32x4 b) { u32x4 w; w.x = pk2(a[0], a[1]); w.y = pk2(a[2], a[3]); w.z = pk2(b[0], b[1]); w.w = pk2(b[2], b[3]); return as_frag(w); }
__device__ __forceinline__ bf16x8 ldfrag(const bf16* p) { return as_frag(*(const u32x4*)p); }
__device__ __forceinline__ bf16x8 ldfrag2(const bf16* p0, const bf16* p1) { const u32x2 a = *(const u32x2*)p0, b = *(const u32x2*)p1; u32x4 w; w.x = a.x; w.y = a.y; w.z = b.x; w.w = b.y; return as_frag(w); }
__device__ __forceinline__ bf16x8 ldfrag_f32(const float* p) { const f32x4 a = *(const f32x4*)p, b = *(const f32x4*)(p + 4); return frag_pk(a, b); }
#define MFMA16(a, b, c) __builtin_amdgcn_mfma_f32_16x16x32_bf16((a), (b), (c), 0, 0, 0)
__device__ __forceinline__ float sigmoidf_(float x) { return 1.0f / (1.0f + __expf(-x)); }
__device__ __forceinline__ float gelu_tanh(float x) { const float u = 0.7978845608028654f * (x + 0.044715f * x * x * x); const float e = __expf(2.0f * u); return 0.5f * x * (2.0f - 2.0f / (e + 1.0f)); }
__device__ __forceinline__ float wave_sum(float v) {
#pragma unroll
    for (int o = 1; o < 64; o <<= 1) v += __shfl_xor(v, o);
    return v;
}
__device__ __forceinline__ float wave_max(float v) {
#pragma unroll
    for (int o = 1; o < 64; o <<= 1) v = fmaxf(v, __shfl_xor(v, o));
    return v;
}
__device__ __forceinline__ float absmax_arr(const float* g, int n, int lane) { float m = 0.f; for (int i = lane; i < n; i += 64) m = fmaxf(m, fabsf(g[i])); return wave_max(m); }
__device__ __forceinline__ int t5_bucket(int n) {
    if (n < 16) return n;
    if (n >= 128) return 31;
    const int v = 16 + (int)(__logf((float)n * 0.0625f) / 2.0794415416798357f * 16.0f);
    return v < 31 ? v : 31;
}

#define XB_TMO      128
#define XB_XCNT(j)  (256  + 64 * (j))
#define XB_XSUB(j)  (1280 + 64 * (j))
#define XB_XGEN(j)  (2304 + 64 * (j))
#define XB_TOP      3328
#define XB_TOPGEN   3392
#define XCD_BAR_WORDS 3456
#define XB_SPIN_CAP (1u << 18)

__device__ __forceinline__ unsigned xb_ld(unsigned* p)              { return __hip_atomic_load(p, __ATOMIC_RELAXED, __HIP_MEMORY_SCOPE_AGENT); }
__device__ __forceinline__ unsigned xb_add(unsigned* p, unsigned v) { return __hip_atomic_fetch_add(p, v, __ATOMIC_RELAXED, __HIP_MEMORY_SCOPE_AGENT); }
__device__ __forceinline__ unsigned xb_xcc_id() { return (unsigned)__builtin_amdgcn_s_getreg((3 << 11) | 20) & 0xFu; }
#define XB_SPIN(cond, bar) do { unsigned _sp = 0; while (cond) { __builtin_amdgcn_s_sleep(1); \
    if ((++_sp & 255u) == 0u) { if (xb_ld(&(bar)[XB_TMO])) break; if (_sp > XB_SPIN_CAP) { atomicAdd(&(bar)[XB_TMO], 1u); break; } } } } while (0)

struct XcdBarrier {
    unsigned* bar; unsigned x;
    volatile LAS unsigned* st;
};

__device__ __forceinline__ XcdBarrier xcd_barrier_post(unsigned* bar, volatile LAS unsigned* st) {
    XcdBarrier b; b.bar = bar; b.x = xb_xcc_id(); b.st = st;
    if (threadIdx.x == 0) (void)xb_add(&bar[XB_XCNT(b.x)], 1u);
    return b;
}
__device__ __forceinline__ void xcd_barrier_complete(unsigned* bar, unsigned x, unsigned& nloc, unsigned& nx) {
    const unsigned G = gridDim.x * gridDim.y * gridDim.z;
    unsigned sum, cnt, mine, sp = 0u;
    for (;;) {
        sum = 0u; cnt = 0u; mine = 0u;
#pragma unroll
        for (unsigned j = 0; j < 16; ++j) { const unsigned c = xb_ld(&bar[XB_XCNT(j)]); sum += c; cnt += (c > 0u) ? 1u : 0u; mine = (j == x) ? c : mine; }
        if (sum == G) break;
        __builtin_amdgcn_s_sleep(1);
        if ((++sp & 255u) == 0u) { if (xb_ld(&bar[XB_TMO])) break; if (sp > XB_SPIN_CAP) { atomicAdd(&bar[XB_TMO], 1u); break; } }
    }
    nloc = mine > 0u ? mine : 1u; nx = cnt > 0u ? cnt : 1u;
}

__device__ __forceinline__ void xcd_barrier(const XcdBarrier& b) {
    asm volatile("s_waitcnt vmcnt(0)" ::: "memory");
    __syncthreads();
    if (threadIdx.x == 0) {
        unsigned* bar = b.bar;
        __builtin_amdgcn_s_waitcnt(0);
        unsigned nloc = b.st[0], nx = b.st[1];
        if (nloc == 0u) { xcd_barrier_complete(bar, b.x, nloc, nx); b.st[0] = nloc; b.st[1] = nx; }
        const unsigned old = xb_add(&bar[XB_XSUB(b.x)], 1u);
        const unsigned gen = old / nloc;
        if (old + 1u == (gen + 1u) * nloc) {
            __builtin_amdgcn_fence(__ATOMIC_RELEASE, "agent");
            asm volatile("s_waitcnt vmcnt(0)" ::: "memory");
            const unsigned og = xb_add(&bar[XB_TOP], 1u);
            const unsigned tg = og / nx;
            if (og + 1u == (tg + 1u) * nx) xb_add(&bar[XB_TOPGEN], 1u);
            else XB_SPIN(xb_ld(&bar[XB_TOPGEN]) == tg, bar);
            __builtin_amdgcn_fence(__ATOMIC_ACQUIRE, "agent");
            xb_add(&bar[XB_XGEN(b.x)], 1u);
            asm volatile("s_waitcnt vmcnt(0)" ::: "memory");
        } else {
            XB_SPIN(xb_ld(&bar[XB_XGEN(b.x)]) == gen, bar);
            __builtin_amdgcn_fence(__ATOMIC_ACQUIRE, "agent");
            asm volatile("s_waitcnt vmcnt(0)" ::: "memory");
        }
    }
    __syncthreads();
}

struct Frame {
    LAS unsigned char* lds;
    int wave, G, bid, gw, NGW;
    const float* const* in; float* out; unsigned char* ws;
};
#define WSP(T_, off) ((T_*)(F.ws + (off)))
__device__ __forceinline__ int lane_id_() { unsigned z = 0u; asm volatile("" : "+v"(z)); return (int)__builtin_amdgcn_mbcnt_hi(~0u, __builtin_amdgcn_mbcnt_lo(~0u, z)); }
#define LANE_ lane_id_()
#define TID_ (F.wave * 64 + lane_id_())

__device__ __forceinline__ void transpose_item(const float* W, int K, int N, bf16* WT, const float* kscale, LAS float* scr, int item, int nblk, int lane) {
    const int kb = item / nblk, nb = item % nblk, k0 = 64 * kb, n0 = 32 * nb;
#pragma unroll
    for (int i = 0; i < 8; ++i) { const int kk = 8 * i + (lane >> 3); const int n = n0 + 4 * (lane & 7);
        f32x4 v = n < N ? *(const f32x4*)(W + (size_t)(k0 + kk) * N + n) : (f32x4){0.f, 0.f, 0.f, 0.f}; if (kscale) v = v * kscale[k0 + kk];
        LAS float* d = scr + kk * 33 + 4 * (lane & 7); d[0] = v[0]; d[1] = v[1]; d[2] = v[2]; d[3] = v[3]; }
    asm volatile("s_waitcnt lgkmcnt(0)" ::: "memory");
    const int c = lane & 7;
#pragma unroll
    for (int j = 0; j < 4; ++j) { const int n = (lane >> 3) + 8 * j; const LAS float* s = scr + (8 * c) * 33 + n;
        u32x4 o; o.x = pk2(s[0 * 33], s[1 * 33]); o.y = pk2(s[2 * 33], s[3 * 33]); o.z = pk2(s[4 * 33], s[5 * 33]); o.w = pk2(s[6 * 33], s[7 * 33]);
        *(u32x4*)(WT + (size_t)(n0 + n) * K + k0 + 8 * c) = o; }
    asm volatile("s_waitcnt lgkmcnt(0)" ::: "memory");
}
__device__ __forceinline__ void rms_row_to_bf16(const float* xrow, const float* g, bf16* orow, int lane) {
    unsigned long long* o8 = (unsigned long long*)orow + lane;
    if (!xrow) {
#pragma unroll
        for (int j = 0; j < 4; ++j) o8[64 * j] = 0ull;
        return; }
    const f32x4* xr = (const f32x4*)xrow + lane; const f32x4* gr = (const f32x4*)g + lane;
    f32x4 v[4]; float s = 0.f;
#pragma unroll
    for (int j = 0; j < 4; ++j) { v[j] = xr[64 * j]; s += (v[j].x * v[j].x + v[j].y * v[j].y) + (v[j].z * v[j].z + v[j].w * v[j].w); }
    const float rs = rsqrtf(wave_sum(s) * (1.f / 1024.f) + EPS);
#pragma unroll
    for (int j = 0; j < 4; ++j) { const f32x4 gg = gr[64 * j]; const f32x4 y = v[j] * rs * gg;
        o8[64 * j] = (unsigned long long)pk2(y.x, y.y) | ((unsigned long long)pk2(y.z, y.w) << 32); }
}
__device__ __forceinline__ void p0_prologue(Frame& F) {
    LAS float* scr = (LAS float*)(F.lds + F.wave * 16384);
    const int gw = F.gw, NGW = F.NGW;
    constexpr int IT_IN = 16 * 208, IT_MEM = 16 * 32, IT_BR = 8 * 32, IT_O = 16 * 32, IT_UP = 16 * 176, IT_DOWN = 44 * 32, IT_W1 = 32 * 2, IT_W2 = 1 * 2;
    constexpr int NITEMS = IT_IN + IT_MEM + 3 * IT_BR + IT_O + IT_UP + IT_DOWN + 2 * IT_W1 + 2 * IT_W2;
    const int ipw = (NITEMS + NGW - 1) / NGW;
    for (int it = gw * ipw; it < NITEMS && it < (gw + 1) * ipw; ++it) {
        int r = it;
        if (r < IT_UP) { transpose_item(F.in[I_WUP], 1024, DUP, WSP(bf16, WS_WTUP), F.in[I_GFFN], scr, r, 176, LANE_); continue; } r -= IT_UP;
        if (r < IT_IN) { transpose_item(F.in[I_WIN], 1024, DIN, WSP(bf16, WS_WTIN), nullptr, scr, r, 208, LANE_); continue; } r -= IT_IN;
        if (r < IT_DOWN) { transpose_item(F.in[I_WDOWN], DFF, 1024, WSP(bf16, WS_WTDOWN), nullptr, scr, r, 32, LANE_); continue; } r -= IT_DOWN;
        if (r < IT_MEM) { transpose_item(F.in[I_WMEM], 1024, 1024, WSP(bf16, WS_WTMEM), nullptr, scr, r, 32, LANE_); continue; } r -= IT_MEM;
        if (r < IT_O) { transpose_item(F.in[I_WO], 1024, 1024, WSP(bf16, WS_WTO), nullptr, scr, r, 32, LANE_); continue; } r -= IT_O;
        if (r < IT_BR) { transpose_item(F.in[I_WNSA], 512, 1024, WSP(bf16, WS_WTNSA), nullptr, scr, r, 32, LANE_); continue; } r -= IT_BR;
        if (r < IT_BR) { transpose_item(F.in[I_WGLA], 512, 1024, WSP(bf16, WS_WTGLA), nullptr, scr, r, 32, LANE_); continue; } r -= IT_BR;
        if (r < IT_BR) { transpose_item(F.in[I_WX], 512, 1024, WSP(bf16, WS_WTX), nullptr, scr, r, 32, LANE_); continue; } r -= IT_BR;
        if (r < IT_W1) { transpose_item(F.in[I_CKW1], 2048, 64, WSP(bf16, WS_W1T), nullptr, scr, r, 2, LANE_); continue; } r -= IT_W1;
        if (r < IT_W1) { transpose_item(F.in[I_CVW1], 2048, 64, WSP(bf16, WS_W1T) + 64 * 2048, nullptr, scr, r, 2, LANE_); continue; } r -= IT_W1;
        if (r < IT_W2) { transpose_item(F.in[I_CKW2], 64, 64, WSP(bf16, WS_W2T), nullptr, scr, r, 2, LANE_); continue; } r -= IT_W2;
        transpose_item(F.in[I_CVW2], 64, 64, WSP(bf16, WS_W2T) + 64 * 64, nullptr, scr, r, 2, LANE_);
    }
    for (int m = gw; m < MPAD + 512; m += NGW) {
        if (m < MPAD) { const float* xr = m < NTOKP ? F.in[I_XP] + (size_t)m * 1024 : (m < NTOK ? F.in[I_XS] + (size_t)(m - NTOKP) * 1024 : nullptr);
            rms_row_to_bf16(xr, F.in[I_GMIX], WSP(bf16, WS_XN) + (size_t)m * 1024, LANE_); }
        else { const int mm = m - MPAD; rms_row_to_bf16(F.in[I_MEMP] + (size_t)mm * 1024, F.in[I_GMEM], WSP(bf16, WS_MN) + (size_t)mm * 1024, LANE_); }
    }
    { float* ssq = WSP(float, WS_SSQ); for (int i = F.bid * NTHR + TID_; i < MPAD; i += F.G * NTHR) ssq[i] = 0.f; }
    { float* ms = WSP(float, WS_MS); float* x1s = WSP(float, WS_X1S); const float* xs = F.in[I_XS];
      for (int i = F.bid * NTHR + TID_; i < SB * 1024; i += F.G * NTHR) { ms[i] = 0.f; x1s[i] = xs[i]; }
      float* ons = WSP(float, WS_ONS); for (int i = F.bid * NTHR + TID_; i < SB * 512; i += F.G * NTHR) ons[i] = 0.f; }
    { const f32x4* src = (const f32x4*)F.in[I_CWIN]; f32x4* dst = (f32x4*)(F.out + O_WINS);
      for (int i = F.bid * NTHR + TID_; i < SB * 511 * 64; i += F.G * NTHR) { const int b = i / (511 * 64), r = i % (511 * 64); dst[(size_t)b * 512 * 64 + r] = src[(size_t)b * 512 * 64 + 64 + r]; } }
}

struct TokRaw { u32x4 q, kva, kvb, xq; unsigned short g; };
__device__ __forceinline__ TokRaw p2_token_load(Frame& F, int tok) {
    const int lane = LANE_; const bf16* pr = WSP(bf16, WS_PROJ) + (size_t)tok * DINP; TokRaw r;
    r.q = *(const u32x4*)(pr + C_Q + 8 * lane); r.kva = *(const u32x4*)(pr + C_KV + 8 * lane); r.kvb = *(const u32x4*)(pr + C_KV + 512 + 8 * lane);
    r.xq = *(const u32x4*)(pr + C_XQ + 8 * lane); r.g = pr[C_G + (lane < 24 ? lane : 0)]; return r; }
__device__ __forceinline__ void p2_token(Frame& F, int tok, const TokRaw& raw) {
    const int lane = LANE_;
    const bool prompt = tok < NTOKP; const int b = tok >> 13, t = tok & (T - 1), sb = tok - NTOKP;
    float f[8];
    { unpack8(raw.q, f); float ss = 0.f;
#pragma unroll
      for (int i = 0; i < 8; ++i) ss += f[i] * f[i];
      ss += __shfl_xor(ss, 1); ss += __shfl_xor(ss, 2); ss += __shfl_xor(ss, 4);
      const float rs = rsqrtf(ss * (1.f / 64.f) + EPS) * QSCALE; const float* g = F.in[I_GNQ] + 8 * (lane & 7);
#pragma unroll
      for (int i = 0; i < 8; ++i) f[i] *= rs * g[i];
      *(u32x4*)(WSP(bf16, WS_QN) + (size_t)tok * 512 + 8 * lane) = pack8(f); }
    { unpack8(raw.kva, f); float ss = 0.f;
#pragma unroll
      for (int i = 0; i < 8; ++i) ss += f[i] * f[i];
      ss += __shfl_xor(ss, 1); ss += __shfl_xor(ss, 2); ss += __shfl_xor(ss, 4);
      const int grp = lane >> 3, slot = grp >> 1, kv = grp & 1, d0 = 8 * (lane & 7);
      if (slot == 2) { const float rs = rsqrtf(ss * (1.f / 64.f) + EPS); const float* g = F.in[I_GNK] + 64 + d0;
#pragma unroll
          for (int i = 0; i < 8; ++i) f[i] *= rs * g[i]; }
      float* orow = prompt ? F.out + O_KVP + (size_t)tok * 512 + 8 * lane : F.out + O_KVS + (size_t)sb * 512 + 8 * lane;
      *(f32x4*)orow = (f32x4){f[0], f[1], f[2], f[3]}; *(f32x4*)(orow + 4) = (f32x4){f[4], f[5], f[6], f[7]};
      if (prompt) {
          if (slot == 2) *(u32x4*)(WSP(bf16, WS_KSEL) + ((size_t)(b * 2 + kv) * T + t) * 64 + d0) = pack8(f);
          if (slot == 3) { bf16* vt = WSP(bf16, WS_VSELT) + (((size_t)(b * 2 + kv) * 128 + (t >> 6)) * 64 + d0) * 64 + (t & 63);
#pragma unroll
              for (int i = 0; i < 8; ++i) vt[i * 64] = (bf16)f2bf(f[i]); }
      } else if (slot >= 2) { float* nk = WSP(float, WS_NEWKV) + ((size_t)(sb * 4 + (slot - 2)) * 2 + kv) * 64 + d0;
#pragma unroll
          for (int i = 0; i < 8; ++i) nk[i] = f[i]; }
    }
    { unpack8(raw.kvb, f); float ss = 0.f;
#pragma unroll
      for (int i = 0; i < 8; ++i) ss += f[i] * f[i];
      ss += __shfl_xor(ss, 1); ss += __shfl_xor(ss, 2); ss += __shfl_xor(ss, 4);
      const int grp = lane >> 3, slot = 4 + (grp >> 1), kv = grp & 1, d0 = 8 * (lane & 7);
      if (lane < 32) {
          if (slot == 4) { const float rs = rsqrtf(ss * (1.f / 64.f) + EPS); const float* g = F.in[I_GNK] + 128 + d0;
#pragma unroll
              for (int i = 0; i < 8; ++i) f[i] *= rs * g[i]; }
          if (prompt) {
              if (slot == 4) *(u32x4*)(WSP(bf16, WS_KWIN) + ((size_t)(b * 2 + kv) * T + t) * 64 + d0) = pack8(f);
              else { bf16* vt = WSP(bf16, WS_VWINT) + (((size_t)(b * 2 + kv) * 128 + (t >> 6)) * 64 + d0) * 64 + (t & 63);
#pragma unroll
                  for (int i = 0; i < 8; ++i) vt[i * 64] = (bf16)f2bf(f[i]); }
              if (t >= T - 512) { float* orow = F.out + O_WINP + ((size_t)b * 512 + (t - (T - 512))) * 256 + 8 * lane;
                  *(f32x4*)orow = (f32x4){f[0], f[1], f[2], f[3]}; *(f32x4*)(orow + 4) = (f32x4){f[4], f[5], f[6], f[7]}; }
          } else {
              float* nk = WSP(float, WS_NEWKV) + ((size_t)(sb * 4 + (slot - 2)) * 2 + kv) * 64 + d0;
#pragma unroll
              for (int i = 0; i < 8; ++i) nk[i] = f[i];
              float* orow = F.out + O_WINS + ((size_t)sb * 512 + 511) * 256 + 8 * lane;
              *(f32x4*)orow = (f32x4){f[0], f[1], f[2], f[3]}; *(f32x4*)(orow + 4) = (f32x4){f[4], f[5], f[6], f[7]};
          }
      }
    }
    if (lane < 24) WSP(float, WS_GATES)[(size_t)tok * 24 + lane] = sigmoidf_(bf2f(raw.g));
    { unpack8(raw.xq, f); float ss = 0.f;
#pragma unroll
      for (int i = 0; i < 8; ++i) ss += f[i] * f[i];
      ss += __shfl_xor(ss, 1); ss += __shfl_xor(ss, 2); ss += __shfl_xor(ss, 4); ss += __shfl_xor(ss, 8);
      const float rs = rsqrtf(ss * (1.f / 128.f) + EPS) * XSCALE; const float* g = F.in[I_GXQ] + 8 * (lane & 15);
#pragma unroll
      for (int i = 0; i < 8; ++i) f[i] *= rs * g[i];
      *(u32x4*)(WSP(bf16, WS_XQ) + (size_t)tok * 512 + 8 * lane) = pack8(f); }
}
__device__ __forceinline__ void p2_memrow(Frame& F, int row) {
    const int lane = LANE_, b = row >> 8, m = row & 255, head = lane >> 4, d0 = 8 * (lane & 15);
    const bf16* pr = WSP(bf16, WS_MEMPROJ) + (size_t)row * 1024; float f[8];
    { unpack8(*(const u32x4*)(pr + 8 * lane), f); float ss = 0.f;
#pragma unroll
      for (int i = 0; i < 8; ++i) ss += f[i] * f[i];
      ss += __shfl_xor(ss, 1); ss += __shfl_xor(ss, 2); ss += __shfl_xor(ss, 4); ss += __shfl_xor(ss, 8);
      const float rs = rsqrtf(ss * (1.f / 128.f) + EPS); const float* g = F.in[I_GXK] + d0;
#pragma unroll
      for (int i = 0; i < 8; ++i) f[i] *= rs * g[i];
      float* orow = F.out + O_MEMP + ((size_t)row * 2 + 0) * 512 + 8 * lane;
      *(f32x4*)orow = (f32x4){f[0], f[1], f[2], f[3]}; *(f32x4*)(orow + 4) = (f32x4){f[4], f[5], f[6], f[7]};
      *(u32x4*)(WSP(bf16, WS_KMEM) + ((size_t)(b * 4 + head) * 256 + m) * 128 + d0) = pack8(f); }
    { unpack8(*(const u32x4*)(pr + 512 + 8 * lane), f);
      float* orow = F.out + O_MEMP + ((size_t)row * 2 + 1) * 512 + 8 * lane;
      *(f32x4*)orow = (f32x4){f[0], f[1], f[2], f[3]}; *(f32x4*)(orow + 4) = (f32x4){f[4], f[5], f[6], f[7]};
      bf16* vt = WSP(bf16, WS_VMEMT) + ((size_t)(b * 4 + head) * 128 + d0) * 256 + m;
#pragma unroll
      for (int i = 0; i < 8; ++i) vt[i * 256] = (bf16)f2bf(f[i]); }
}

constexpr int CMP_TASKS_S = SB * 2 * 2, CMP_TASKS_P = NB * 2 * 2;
__device__ __forceinline__ int cmp_tile_off16(int row, int c16) { return row * 128 + ((c16 ^ (row & 7)) << 4); }
__device__ __forceinline__ void p2_compress(Frame& F, int task) {
    const int lane = LANE_, r = lane & 15, q = lane >> 4, w = F.wave, tid_ = w * 64 + lane;
    const bool smp = task < CMP_TASKS_S; const int x = smp ? task : task - CMP_TASKS_S;
    const int b = x >> 2, kv = (x >> 1) & 1, slot = x & 1, i0 = 64 * w;
    const bf16* W1t = WSP(bf16, WS_W1T) + (size_t)slot * 64 * 2048;
    const bf16* W2t = WSP(bf16, WS_W2T) + (size_t)slot * 64 * 64;
    const int* pt = (const int*)F.in[I_PT] + b * 64;
    const float* ckv = F.in[I_CKV]; const float* pe = F.in[slot ? I_CVPE : I_CKPE];
    const bf16* proj = WSP(bf16, WS_PROJ);
    LAS unsigned char* wb = F.lds;
    const int srow = tid_ >> 3, sc16 = tid_ & 7, soff = cmp_tile_off16(srow, sc16);
    int kb0[2]; kb0[0] = r * 128 + (((0 + q) ^ (r & 7)) << 4); kb0[1] = r * 128 + (((4 + q) ^ (r & 7)) << 4);
    f32x4 acc[4][4];
#pragma unroll
    for (int nt = 0; nt < 4; ++nt)
#pragma unroll
        for (int it = 0; it < 4; ++it) acc[nt][it] = (f32x4){0.f, 0.f, 0.f, 0.f};
    const bf16* wsrc = W1t + (size_t)srow * 2048 + sc16 * 8;
    u32x4 rw = *(const u32x4*)wsrc;
    LAS unsigned char* xt = F.lds + 16384 + w * 8192;
    u32x4 xr[16];
    const int xrow = smp ? (lane >> 4) : (lane >> 3), xch = smp ? (lane & 15) : (lane & 7);
#define CMP_LOAD_ROWS(KP) do { if (smp) { _Pragma("unroll") for (int i = 0; i < 16; ++i) { const int ib = i0 + 4 * i + xrow; int tok = 16 * ib + (KP); tok = tok < T ? tok : T - 1; \
            const int page = pt[tok >> 7]; xr[i] = *(const u32x4*)(ckv + (((size_t)page * 128 + (tok & 127)) * 4 + slot) * 128 + kv * 64 + 4 * xch); } } \
        else { _Pragma("unroll") for (int i = 0; i < 8; ++i) { const int ib = i0 + 8 * i + xrow; int tok = 16 * ib + (KP); tok = tok < T ? tok : T - 1; \
            xr[i] = *(const u32x4*)(proj + ((size_t)b * T + tok) * DINP + C_KV + slot * 128 + kv * 64 + 8 * xch); } } } while (0)
    CMP_LOAD_ROWS(0);
    __syncthreads();
#pragma unroll 1
    for (int kp = 0; kp < 32; ++kp) {
        if (smp) { const f32x4 p4 = *(const f32x4*)(pe + 64 * kp + 4 * xch);
#pragma unroll
            for (int i = 0; i < 16; ++i) { const f32x4 v = __builtin_bit_cast(f32x4, xr[i]) + p4; u32x2 wv; wv.x = pk2(v[0], v[1]); wv.y = pk2(v[2], v[3]);
                const int row = 4 * i + xrow; *(LAS u32x2*)(xt + cmp_tile_off16(row, xch >> 1) + 8 * (xch & 1)) = wv; } }
        else { const f32x4 p0 = *(const f32x4*)(pe + 64 * kp + 8 * xch), p1 = *(const f32x4*)(pe + 64 * kp + 8 * xch + 4);
#pragma unroll
            for (int i = 0; i < 8; ++i) { float f8[8]; unpack8(xr[i], f8);
                u32x4 wv; wv.x = pk2(f8[0] + p0[0], f8[1] + p0[1]); wv.y = pk2(f8[2] + p0[2], f8[3] + p0[3]); wv.z = pk2(f8[4] + p1[0], f8[5] + p1[1]); wv.w = pk2(f8[6] + p1[2], f8[7] + p1[3]);
                const int row = 8 * i + xrow; *(LAS u32x4*)(xt + cmp_tile_off16(row, xch)) = wv; } }
        if (kp + 1 < 32) CMP_LOAD_ROWS(kp + 1);
        *(LAS u32x4*)(wb + (kp & 1) * 8192 + soff) = rw;
        __syncthreads();
        if (kp + 1 < 32) rw = *(const u32x4*)(wsrc + 64 * (kp + 1));
        LAS const unsigned char* wt = wb + (kp & 1) * 8192;
#pragma unroll
        for (int ks2 = 0; ks2 < 2; ++ks2) {
            bf16x8 xf[4];
#pragma unroll
            for (int it = 0; it < 4; ++it) xf[it] = as_frag(*(LAS const u32x4*)(xt + kb0[ks2] + it * 2048));
#pragma unroll
            for (int nt = 0; nt < 4; ++nt) { const bf16x8 a = as_frag(*(LAS const u32x4*)(wt + kb0[ks2] + nt * 2048));
#pragma unroll
                for (int it = 0; it < 4; ++it) acc[nt][it] = MFMA16(a, xf[it], acc[nt][it]); } }
        asm volatile("s_waitcnt lgkmcnt(0)" ::: "memory");
    }
#undef CMP_LOAD_ROWS
    const float* gk0 = F.in[I_GNK];
#pragma unroll
    for (int it = 0; it < 4; ++it) {
        f32x4 g[4];
#pragma unroll
        for (int nt = 0; nt < 4; ++nt)
#pragma unroll
            for (int i = 0; i < 4; ++i) g[nt][i] = gelu_tanh(acc[nt][it][i]);
        const bf16x8 b0 = frag_pk(g[0], g[1]), b1 = frag_pk(g[2], g[3]);
        f32x4 o[4]; float ss = 0.f;
#pragma unroll
        for (int mt = 0; mt < 4; ++mt) { const bf16* wr = W2t + (size_t)(16 * mt + r) * 64 + 4 * q;
            o[mt] = MFMA16(ldfrag2(wr, wr + 16), b0, ((f32x4){0.f, 0.f, 0.f, 0.f}));
            o[mt] = MFMA16(ldfrag2(wr + 32, wr + 48), b1, o[mt]);
            ss += (o[mt][0] * o[mt][0] + o[mt][1] * o[mt][1]) + (o[mt][2] * o[mt][2] + o[mt][3] * o[mt][3]); }
        ss += __shfl_xor(ss, 16); ss += __shfl_xor(ss, 32);
        if (slot == 0) { const float rs = rsqrtf(ss * (1.f / 64.f) + EPS);
#pragma unroll
            for (int mt = 0; mt < 4; ++mt) { const f32x4 gg = *(const f32x4*)(gk0 + 16 * mt + 4 * q); o[mt] = o[mt] * rs * gg; } }
        const int i = i0 + 16 * it + r;
        if (smp) { float* dst = WSP(float, slot ? WS_VCMPS : WS_KCMPS) + ((size_t)(b * 2 + kv) * 512 + i) * 64 + 4 * q;
#pragma unroll
            for (int mt = 0; mt < 4; ++mt) *(f32x4*)(dst + 16 * mt) = o[mt]; }
        else if (slot == 0) { bf16* dst = WSP(bf16, WS_KCMP) + ((size_t)(b * 2 + kv) * 512 + i) * 64 + 4 * q;
#pragma unroll
            for (int mt = 0; mt < 4; ++mt) { u32x2 wv; wv.x = pk2(o[mt][0], o[mt][1]); wv.y = pk2(o[mt][2], o[mt][3]); *(u32x2*)(dst + 16 * mt) = wv; } }
        else { bf16* dst = WSP(bf16, WS_VCMPT) + ((size_t)(b * 2 + kv) * 64 + 4 * q) * 512 + i;
#pragma unroll
            for (int mt = 0; mt < 4; ++mt)
#pragma unroll
                for (int e = 0; e < 4; ++e) dst[(size_t)(16 * mt + e) * 512] = (bf16)f2bf(o[mt][e]); }
    }
}

__device__ __forceinline__ int swz64(int row, int col) { return row * 64 + ((((col >> 3) ^ (row & 7)) << 3) | (col & 7)); }
__device__ __forceinline__ float log_sigmoid_(float z) { return fminf(z, 0.f) - __logf(1.0f + __expf(-fabsf(z))); }
__device__ __forceinline__ void p2_gla_chunk(Frame& F, int bc) {
    const int lane = LANE_, r = lane & 15, q = lane >> 4, h = F.wave >> 1, eh = F.wave & 1;
    LAS bf16* ktT = (LAS bf16*)(F.lds + F.wave * 16384);
    LAS bf16* vT = ktT + 4096;
    const bf16* proj = WSP(bf16, WS_PROJ) + (size_t)bc * 64 * DINP;
    float wg[16];
#pragma unroll
    for (int j = 0; j < 16; ++j) wg[j] = F.in[I_WGG][j * 256 + h * 64 + lane];
    const float bg = F.in[I_BGG][h * 64 + lane];
    bf16* qtg = WSP(bf16, WS_QTG) + (size_t)bc * 64 * 256 + h * 64 + lane;
    bf16* ktg = WSP(bf16, WS_KTG) + (size_t)bc * 64 * 256 + h * 64 + lane;
    LAS float* lrs = (LAS float*)(F.lds + RING_BYTES);
    { const int tid_ = F.wave * 64 + lane; if (tid_ < 128) { float f8[8]; unpack8(*(const u32x4*)(proj + (size_t)(tid_ >> 1) * DINP + C_LR + 8 * (tid_ & 1)), f8);
#pragma unroll
        for (int i = 0; i < 8; ++i) lrs[(tid_ >> 1) * 16 + 8 * (tid_ & 1) + i] = f8[i]; } }
    __syncthreads();
    float cb = 0.f;
    bf16 kr[16], qr[16], vr[16], kn[16], qn[16], vn[16];
#pragma unroll
    for (int i = 0; i < 16; ++i) { const bf16* pr = proj + (size_t)i * DINP; kr[i] = pr[C_GK + h * 64 + lane]; qr[i] = pr[C_GQ + h * 64 + lane]; vr[i] = pr[C_GV + h * 128 + eh * 64 + lane]; }
#pragma unroll 1
    for (int tb = 0; tb < 4; ++tb) {
        const int tn = tb < 3 ? tb + 1 : 3;
#pragma unroll
        for (int i = 0; i < 16; ++i) { const bf16* pr = proj + (size_t)(16 * tn + i) * DINP; kn[i] = pr[C_GK + h * 64 + lane]; qn[i] = pr[C_GQ + h * 64 + lane]; vn[i] = pr[C_GV + h * 128 + eh * 64 + lane]; }
#pragma unroll
        for (int i = 0; i < 16; ++i) { const int t = 16 * tb + i;
            float z = bg;
#pragma unroll
            for (int j4 = 0; j4 < 4; ++j4) { const f32x4 l4 = *(LAS const f32x4*)(lrs + t * 16 + 4 * j4); z += l4[0] * wg[4 * j4] + l4[1] * wg[4 * j4 + 1] + l4[2] * wg[4 * j4 + 2] + l4[3] * wg[4 * j4 + 3]; }
            cb += log_sigmoid_(z) * 0.0625f;
            const float kk = bf2f(kr[i]) * __expf(-cb);
            const float qq = bf2f(qr[i]) * 0.125f * __expf(cb);
            const bf16 kb = (bf16)f2bf(kk);
            if (eh == 0) { qtg[(size_t)t * 256] = (bf16)f2bf(qq); ktg[(size_t)t * 256] = kb; }
            ktT[swz64(lane, t)] = kb;
            const bf16 vv = vr[i];
            vT[swz64(lane, t)] = vv; }
#pragma unroll
        for (int i = 0; i < 16; ++i) { kr[i] = kn[i]; qr[i] = qn[i]; vr[i] = vn[i]; }
    }
    const float dec = __expf(cb);
    if (eh == 0) WSP(float, WS_DEC)[(size_t)(bc * 4 + h) * 64 + lane] = dec;
    asm volatile("s_waitcnt lgkmcnt(0)" ::: "memory");
    {
        bf16* vrow = WSP(bf16, WS_VTG) + ((size_t)(bc * 4 + h) * 128 + eh * 64) * 64;
#pragma unroll
        for (int i = 0; i < 8; ++i) { const int e = 8 * i + (lane >> 3), c8 = lane & 7;
            *(u32x4*)(vrow + (size_t)e * 64 + c8 * 8) = *(const LAS u32x4*)(vT + swz64(e, c8 * 8)); } }
    f32x4 acc[4][4];
#pragma unroll
    for (int et = 0; et < 4; ++et)
#pragma unroll
        for (int dt = 0; dt < 4; ++dt) acc[et][dt] = (f32x4){0.f, 0.f, 0.f, 0.f};
#pragma unroll
    for (int ks = 0; ks < 2; ++ks) {
        bf16x8 bfr[4];
#pragma unroll
        for (int dt = 0; dt < 4; ++dt) bfr[dt] = as_frag(*(const LAS u32x4*)(ktT + swz64(16 * dt + r, 32 * ks + 8 * q)));
#pragma unroll
        for (int et = 0; et < 4; ++et) { const bf16x8 a = as_frag(*(const LAS u32x4*)(vT + swz64(16 * et + r, 32 * ks + 8 * q)));
#pragma unroll
            for (int dt = 0; dt < 4; ++dt) acc[et][dt] = MFMA16(a, bfr[dt], acc[et][dt]); }
    }
    float* up = WSP(float, WS_UP) + ((size_t)(bc * 4 + h) * 128 + eh * 64) * 64;
#pragma unroll
    for (int dt = 0; dt < 4; ++dt) { const float dd = __shfl(dec, 16 * dt + r);
#pragma unroll
        for (int et = 0; et < 4; ++et)
#pragma unroll
            for (int i = 0; i < 4; ++i) up[(size_t)(16 * et + 4 * q + i) * 64 + 16 * dt + r] = acc[et][dt][i] * dd; }
}

__device__ __forceinline__ void p2_gla_sample(Frame& F, int task) {
    const int lane = LANE_, b = task >> 2, h = task & 3, tok = NTOKP + b;
    const bf16* pr = WSP(bf16, WS_PROJ) + (size_t)tok * DINP;
    LAS float* sh = (LAS float*)(F.lds + F.wave * 16384);
    { float z = F.in[I_BGG][h * 64 + lane];
#pragma unroll
      for (int j = 0; j < 16; ++j) z += bf2f(pr[C_LR + j]) * F.in[I_WGG][j * 256 + h * 64 + lane];
      sh[lane] = __expf(log_sigmoid_(z) * 0.0625f); sh[64 + lane] = bf2f(pr[C_GK + h * 64 + lane]); sh[128 + lane] = bf2f(pr[C_GQ + h * 64 + lane]) * 0.125f; }
    asm volatile("s_waitcnt lgkmcnt(0)" ::: "memory");
    const float v0 = bf2f(pr[C_GV + h * 128 + lane]), v1 = bf2f(pr[C_GV + h * 128 + 64 + lane]);
    const float* s0 = F.in[I_SGLA] + (size_t)(b * 4 + h) * 64 * 128; float* s1 = F.out + O_GLAS + (size_t)(b * 4 + h) * 64 * 128;
    float o0 = 0.f, o1 = 0.f;
#pragma unroll 4
    for (int d = 0; d < 64; ++d) { const float a = sh[d], k = sh[64 + d], qq = sh[128 + d];
        const float n0 = a * s0[d * 128 + lane] + k * v0, n1 = a * s0[d * 128 + 64 + lane] + k * v1;
        s1[d * 128 + lane] = n0; s1[d * 128 + 64 + lane] = n1; o0 += qq * n0; o1 += qq * n1; }
    const float rs = rsqrtf(wave_sum(o0 * o0 + o1 * o1) * (1.f / 128.f) + EPS);
    const float r0 = bf2f(pr[C_GR + h * 128 + lane]), r1 = bf2f(pr[C_GR + h * 128 + 64 + lane]);
    bf16* og = WSP(bf16, WS_OGLA) + (size_t)tok * 512 + h * 128;
    og[lane] = (bf16)f2bf(o0 * rs * F.in[I_GGO][lane] * r0 * sigmoidf_(r0));
    og[64 + lane] = (bf16)f2bf(o1 * rs * F.in[I_GGO][64 + lane] * r1 * sigmoidf_(r1));
}

__device__ __forceinline__ void p3_gla_scan(Frame& F, int task) {
    const int lane = LANE_, b = task >> 9, h = (task >> 7) & 3, e = task & 127;
    const float* up = WSP(float, WS_UP); const float* dec = WSP(float, WS_DEC); bf16* sc = WSP(bf16, WS_SC);
    float S = 0.f;
#pragma unroll 1
    for (int c0 = 0; c0 < 128; c0 += 32) {
        float uu[32], dd[32];
#pragma unroll
        for (int i = 0; i < 32; ++i) { const int bc = b * 128 + c0 + i; uu[i] = up[((size_t)(bc * 4 + h) * 128 + e) * 64 + lane]; dd[i] = dec[(size_t)(bc * 4 + h) * 64 + lane]; }
#pragma unroll
        for (int i = 0; i < 32; ++i) { const int bc = b * 128 + c0 + i; sc[((size_t)(bc * 4 + h) * 128 + e) * 64 + lane] = (bf16)f2bf(S); S = dd[i] * S + uu[i]; } }
    F.out[O_GLAP + ((size_t)(b * 4 + h) * 64 + lane) * 128 + e] = S;
}

__device__ __forceinline__ void p4_gla_out(Frame& F, int task) {
    const int lane = LANE_, r = lane & 15, q = lane >> 4, bc = task >> 4, h = (task >> 2) & 3, tt = task & 3;
    const bf16* qtg = WSP(bf16, WS_QTG) + (size_t)bc * 64 * 256 + h * 64;
    const bf16* ktg = WSP(bf16, WS_KTG) + (size_t)bc * 64 * 256 + h * 64;
    const bf16* vtg = WSP(bf16, WS_VTG) + (size_t)(bc * 4 + h) * 128 * 64;
    const bf16* sc = WSP(bf16, WS_SC) + (size_t)(bc * 4 + h) * 128 * 64;
    const bf16* proj = WSP(bf16, WS_PROJ) + (size_t)bc * 64 * DINP;
    bf16* og = WSP(bf16, WS_OGLA) + (size_t)bc * 64 * 512 + h * 128;
    const float* ggo = F.in[I_GGO];
    {
        bf16x8 qf[2];
#pragma unroll
        for (int ks = 0; ks < 2; ++ks) qf[ks] = ldfrag(qtg + (size_t)(16 * tt + r) * 256 + 32 * ks + 8 * q);
        f32x4 sT[4];
#pragma unroll
        for (int st = 0; st < 4; ++st) { sT[st] = (f32x4){0.f, 0.f, 0.f, 0.f};
            if (st <= tt) {
#pragma unroll
                for (int ks = 0; ks < 2; ++ks) sT[st] = MFMA16(ldfrag(ktg + (size_t)(16 * st + r) * 256 + 32 * ks + 8 * q), qf[ks], sT[st]);
                if (st == tt) {
#pragma unroll
                    for (int i = 0; i < 4; ++i) if (4 * q + i > r) sT[st][i] = 0.f; } } }
        const bf16x8 p01 = frag_pk(sT[0], sT[1]), p23 = frag_pk(sT[2], sT[3]);
        f32x4 acc[8]; float ss = 0.f;
#pragma unroll
        for (int et = 0; et < 8; ++et) { acc[et] = (f32x4){0.f, 0.f, 0.f, 0.f};
            const bf16* srow = sc + (size_t)(16 * et + r) * 64 + 8 * q;
            acc[et] = MFMA16(ldfrag(srow), qf[0], acc[et]); acc[et] = MFMA16(ldfrag(srow + 32), qf[1], acc[et]);
            const bf16* vrow = vtg + (size_t)(16 * et + r) * 64 + 4 * q;
            acc[et] = MFMA16(ldfrag2(vrow, vrow + 16), p01, acc[et]);
            if (tt >= 2) acc[et] = MFMA16(ldfrag2(vrow + 32, vrow + 48), p23, acc[et]);
            ss += (acc[et][0] * acc[et][0] + acc[et][1] * acc[et][1]) + (acc[et][2] * acc[et][2] + acc[et][3] * acc[et][3]); }
        ss += __shfl_xor(ss, 16); ss += __shfl_xor(ss, 32);
        const float rs = rsqrtf(ss * (1.f / 128.f) + EPS);
        const bf16* pr = proj + (size_t)(16 * tt + r) * DINP + C_GR + h * 128 + 4 * q;
        bf16* orow = og + (size_t)(16 * tt + r) * 512 + 4 * q;
#pragma unroll
        for (int et = 0; et < 8; ++et) { const u32x2 rw = *(const u32x2*)(pr + 16 * et); const f32x4 gg = *(const f32x4*)(ggo + 16 * et + 4 * q);
            const float r0 = bflo(rw.x), r1 = bfhi(rw.x), r2 = bflo(rw.y), r3 = bfhi(rw.y);
            u32x2 w; w.x = pk2(acc[et][0] * rs * gg[0] * r0 * sigmoidf_(r0), acc[et][1] * rs * gg[1] * r1 * sigmoidf_(r1));
            w.y = pk2(acc[et][2] * rs * gg[2] * r2 * sigmoidf_(r2), acc[et][3] * rs * gg[3] * r3 * sigmoidf_(r3));
            *(u32x2*)(orow + 16 * et) = w; }
    }
}

__device__ __forceinline__ void p3_xatt(Frame& F, int n, float mb) {
    const int lane = LANE_, r = lane & 15, q = lane >> 4, w = F.wave, tid_ = w * 64 + lane;
    const int b = n >> 7, h = (n >> 5) & 3, chunk = n & 31;
    const bf16* km = WSP(bf16, WS_KMEM) + (size_t)(b * 4 + h) * 256 * 128;
    const bf16* vm = WSP(bf16, WS_VMEMT) + (size_t)(b * 4 + h) * 128 * 256;
    LAS unsigned char* kl = F.lds; LAS unsigned char* vl = F.lds + 65536;
    __syncthreads();
    { u32x4 gk[8], gv[8];
#pragma unroll
      for (int i = 0; i < 8; ++i) { gk[i] = *(const u32x4*)(km + (size_t)(i * 512 + tid_) * 8); gv[i] = *(const u32x4*)(vm + (size_t)(i * 512 + tid_) * 8); }
#pragma unroll
      for (int i = 0; i < 8; ++i) { const int id = i * 512 + tid_;
          *(LAS u32x4*)(kl + (id >> 4) * 256 + ((((id & 15) ^ ((id >> 4) & 15))) << 4)) = gk[i];
          *(LAS u32x4*)(vl + (id >> 5) * 512 + ((((id & 31) ^ ((id >> 5) & 15))) << 4)) = gv[i]; } }
    __syncthreads();
    int kb4[4];
#pragma unroll
    for (int ks = 0; ks < 4; ++ks) kb4[ks] = r * 256 + (((4 * ks + q) ^ r) << 4);
#pragma unroll 1
    for (int tile = 0; tile < 2; ++tile) {
        const int tok0 = b * T + chunk * 256 + w * 32 + tile * 16;
        const bf16* xq = WSP(bf16, WS_XQ) + (size_t)(tok0 + r) * 512 + h * 128 + 8 * q;
        bf16x8 qf[4];
#pragma unroll
        for (int ks = 0; ks < 4; ++ks) qf[ks] = ldfrag(xq + 32 * ks);
        f32x4 o[8]; float l = 0.f;
#pragma unroll
        for (int dt = 0; dt < 8; ++dt) o[dt] = (f32x4){0.f, 0.f, 0.f, 0.f};
#pragma unroll 2
        for (int kk = 0; kk < 8; ++kk) {
            f32x4 p[2];
#pragma unroll
            for (int a = 0; a < 2; ++a) { p[a] = (f32x4){0.f, 0.f, 0.f, 0.f};
#pragma unroll
                for (int ks = 0; ks < 4; ++ks) p[a] = MFMA16(as_frag(*(LAS const u32x4*)(kl + kb4[ks] + (2 * kk + a) * 4096)), qf[ks], p[a]);
#pragma unroll
                for (int i = 0; i < 4; ++i) { p[a][i] = __builtin_amdgcn_exp2f(p[a][i] - mb); l += p[a][i]; } }
            const bf16x8 pf = frag_pk(p[0], p[1]);
            const int v0 = r * 512 + (((4 * kk + (q >> 1)) ^ r) << 4) + 8 * (q & 1), v1 = r * 512 + (((4 * kk + 2 + (q >> 1)) ^ r) << 4) + 8 * (q & 1);
#pragma unroll
            for (int dt = 0; dt < 8; ++dt) { const u32x2 x0 = *(LAS const u32x2*)(vl + v0 + dt * 8192), x1 = *(LAS const u32x2*)(vl + v1 + dt * 8192);
                u32x4 wv; wv.x = x0.x; wv.y = x0.y; wv.z = x1.x; wv.w = x1.y; o[dt] = MFMA16(as_frag(wv), pf, o[dt]); }
        }
        l += __shfl_xor(l, 16); l += __shfl_xor(l, 32);
        const float inv = 1.f / l;
        bf16* ox = WSP(bf16, WS_OX) + (size_t)(tok0 + r) * 512 + h * 128 + 4 * q;
#pragma unroll
        for (int dt = 0; dt < 8; ++dt) { u32x2 wv; wv.x = pk2(o[dt][0] * inv, o[dt][1] * inv); wv.y = pk2(o[dt][2] * inv, o[dt][3] * inv); *(u32x2*)(ox + 16 * dt) = wv; }
    }
}
__device__ __forceinline__ void p3_xatt_sample(Frame& F, int task) {
    const int lane = LANE_, w = F.wave, tid_ = w * 64 + lane, b = task >> 2, h = task & 3, tok = NTOKP + b;
    LAS float* qs = (LAS float*)F.lds; LAS float* sc = qs + 128; LAS float* part = qs + 384;
    const float* cm = F.in[I_CMEM] + (size_t)b * 256 * 1024 + h * 128;
    __syncthreads();
    if (tid_ < 128) qs[tid_] = bf2f(WSP(bf16, WS_XQ)[(size_t)tok * 512 + h * 128 + tid_]);
    __syncthreads();
    {
        const int l8 = lane & 7, kq = lane >> 3;
#pragma unroll
        for (int ps = 0; ps < 4; ++ps) { const int key = 32 * w + 8 * ps + kq; const float* kr = cm + (size_t)key * 1024; float s = 0.f;
#pragma unroll
            for (int j = 0; j < 4; ++j) { const int d = (j * 8 + l8) * 4; const f32x4 kv = *(const f32x4*)(kr + d); const f32x4 qv = *(LAS const f32x4*)(qs + d);
                s += (qv[0] * kv[0] + qv[1] * kv[1]) + (qv[2] * kv[2] + qv[3] * kv[3]); }
            s += __shfl_xor(s, 1); s += __shfl_xor(s, 2); s += __shfl_xor(s, 4);
            if (l8 == 0) sc[key] = s; }
    }
    __syncthreads();
    if (w == 0) { float s[4]; float m = -INFINITY;
#pragma unroll
        for (int k = 0; k < 4; ++k) { s[k] = sc[lane + 64 * k]; m = fmaxf(m, s[k]); }
        m = wave_max(m); float l = 0.f;
#pragma unroll
        for (int k = 0; k < 4; ++k) { s[k] = __builtin_amdgcn_exp2f(s[k] - m); l += s[k]; }
        l = wave_sum(l); const float inv = 1.f / l;
#pragma unroll
        for (int k = 0; k < 4; ++k) sc[lane + 64 * k] = s[k] * inv; }
    __syncthreads();
    { float o0 = 0.f, o1 = 0.f; const float* vv = cm + 512 + (size_t)(32 * w) * 1024;
#pragma unroll 8
      for (int mm = 0; mm < 32; ++mm) { const float p = sc[32 * w + mm]; o0 += p * vv[(size_t)mm * 1024 + lane]; o1 += p * vv[(size_t)mm * 1024 + 64 + lane]; }
      part[w * 128 + lane] = o0; part[w * 128 + 64 + lane] = o1; }
    __syncthreads();
    if (tid_ < 128) { float o = 0.f;
#pragma unroll
        for (int w2 = 0; w2 < 8; ++w2) o += part[w2 * 128 + tid_];
        WSP(bf16, WS_OX)[(size_t)tok * 512 + h * 128 + tid_] = (bf16)f2bf(o); }
}

constexpr int NL_Q = 0;
constexpr int NL_U = 16384;
constexpr int NL_OS = 81920;
constexpr int NL_TB = 16384;
constexpr int NL_SEL = 147456;
constexpr int NL_BT = 147968;
constexpr int NL_LINV = 152096;
constexpr int NL_END = 152608;
static_assert(NL_END <= LDS_BYTES, "NSA LDS map");

__device__ __forceinline__ void nsa_tables(Frame& F) {
    LAS float* bt = (LAS float*)(F.lds + NL_BT);
    for (int i = TID_; i < 129 * 8; i += NTHR) bt[i] = F.in[I_RB][t5_bucket(i >> 3) * 8 + (i & 7)] * LOG2E;
    __syncthreads();
}
__device__ __forceinline__ float nsa_bound(Frame& F) {
    const float gq = absmax_arr(F.in[I_GNQ], 64, LANE_), gk = absmax_arr(F.in[I_GNK], 192, LANE_), bm = absmax_arr(F.in[I_RB], 256, LANE_);
    return (8.0f * gq * gk * 1.02f + bm) * LOG2E;
}
__device__ __forceinline__ unsigned fkey(float x) { const unsigned u = __float_as_uint(x); return (u & 0x80000000u) ? ~u : (u | 0x80000000u); }

__device__ __forceinline__ int tile_off16(int row, int c16) { return row * 128 + ((c16 ^ (row & 7)) << 4); }
struct TileAddr { int kb[2]; int vb[2][2]; };
__device__ __forceinline__ TileAddr tile_addr(int r, int q) { TileAddr a;
    for (int ks = 0; ks < 2; ++ks) a.kb[ks] = r * 128 + (((4 * ks + q) ^ (r & 7)) << 4);
    for (int s = 0; s < 2; ++s) for (int pc = 0; pc < 2; ++pc) a.vb[s][pc] = r * 128 + (((4 * s + 2 * pc + (q >> 1)) ^ (r & 7)) << 4) + 8 * (q & 1);
    return a; }
__device__ __forceinline__ bf16x8 tile_kfrag(LAS const unsigned char* kb, const TileAddr& ta, int kt, int ks) { return as_frag(*(LAS const u32x4*)(kb + ta.kb[ks] + kt * 2048)); }
__device__ __forceinline__ bf16x8 tile_vfrag(LAS const unsigned char* vb, const TileAddr& ta, int dt, int s) {
    const u32x2 a = *(LAS const u32x2*)(vb + ta.vb[s][0] + dt * 2048), b = *(LAS const u32x2*)(vb + ta.vb[s][1] + dt * 2048);
    u32x4 w; w.x = a.x; w.y = a.y; w.z = b.x; w.w = b.y; return as_frag(w); }

#define OPAQUE_V(x) asm volatile("" : "+v"(x))
__device__ __forceinline__ void p3_nsa_prompt(Frame& F, int n, float mb, int dbg) {
    int lane0 = LANE_; OPAQUE_V(lane0);
    const int lane = lane0, r = lane & 15, q = lane >> 4, w = F.wave;
    int combo, ti;
    if (F.G == 256) { const int xcd = F.bid & 7, u = (F.bid >> 3) * 2 + (xcd & 1), rnd = n >> 8; combo = xcd >> 1; ti = rnd == 0 ? u : rnd == 1 ? 127 - u : rnd == 2 ? 128 + u : 255 - u; }
    else { const int idx = n & 255; combo = n >> 8; ti = (combo & 1) ? 255 - idx : idx; }
    const int b = combo >> 1, kv = combo & 1, t0 = 32 * ti, bk = b * 2 + kv;
    LAS bf16* Qs = (LAS bf16*)(F.lds + NL_Q); LAS float* U = (LAS float*)(F.lds + NL_U) + w * 2048; LAS unsigned* selm = (LAS unsigned*)(F.lds + NL_SEL);
    LAS const float* bt = (LAS const float*)(F.lds + NL_BT); LAS float* linv = (LAS float*)(F.lds + NL_LINV) + w * 16;
    LAS unsigned char* stA = F.lds + NL_OS;
    LAS unsigned char* stC = F.lds + NL_U;
    LAS unsigned char* stB = F.lds + NL_TB + w * 16384;
    const int tid_ = w * 64 + lane, srow = tid_ >> 3, sc16 = tid_ & 7, soff = tile_off16(srow, sc16);
    const TileAddr ta = tile_addr(r, q);
    __syncthreads();
    { const int tk = TID_ >> 4, ch = TID_ & 15; const bf16* src = WSP(bf16, WS_QN) + (size_t)(b * T + t0 + tk) * 512 + kv * 256 + ch * 16;
      const u32x4 a0 = *(const u32x4*)src, a1 = *(const u32x4*)(src + 8);
      *(LAS u32x4*)(Qs + tk * 256 + ch * 16) = a0; *(LAS u32x4*)(Qs + tk * 256 + ch * 16 + 8) = a1;
      if (TID_ < 128) selm[TID_] = 0u; }
    __syncthreads();
    const int tw = t0 + 4 * w, tr = tw + (r >> 2), h = kv * 4 + (r & 3);
    bf16x8 qf[2];
#pragma unroll
    for (int ks = 0; ks < 2; ++ks) qf[ks] = as_frag(*(LAS const u32x4*)(Qs + (16 * w + r) * 64 + 32 * ks + 8 * q));
    int ncvb = (t0 + 31 - 31) / 16 + 1; ncvb = ncvb < 511 ? ncvb : 511;
    const int nst = (ncvb + 63) >> 6;
    const int tlast = tw + 3; int ncv = tlast >= 31 ? (tlast - 31) / 16 + 1 : 0; ncv = ncv < 511 ? ncv : 511;
    const int nstw = (ncv + 63) >> 6;
    f32x4 oc[4]; float lc = 0.f, carry = 0.f;
#pragma unroll
    for (int dt = 0; dt < 4; ++dt) oc[dt] = (f32x4){0.f, 0.f, 0.f, 0.f};
    {
        const bf16* kc = WSP(bf16, WS_KCMP) + (size_t)bk * 512 * 64 + srow * 64 + sc16 * 8; const bf16* vc = WSP(bf16, WS_VCMPT) + (size_t)bk * 64 * 512 + srow * 512 + sc16 * 8;
        const int nst2 = (nst + 1) >> 1;
        u32x4 rk0 = *(const u32x4*)kc, rv0 = *(const u32x4*)vc, rk1 = *(const u32x4*)(kc + 4096), rv1 = *(const u32x4*)(vc + 64);
#pragma unroll 1
        for (int s2 = 0; s2 < nst2; ++s2) {
            LAS unsigned char* bb = stA + (s2 & 1) * 32768;
            *(LAS u32x4*)(bb + soff) = rk0; *(LAS u32x4*)(bb + 8192 + soff) = rv0; *(LAS u32x4*)(bb + 16384 + soff) = rk1; *(LAS u32x4*)(bb + 24576 + soff) = rv1;
            __syncthreads();
            if (s2 + 1 < nst2) { rk0 = *(const u32x4*)(kc + (size_t)(2 * s2 + 2) * 4096); rv0 = *(const u32x4*)(vc + (2 * s2 + 2) * 64);
                                 rk1 = *(const u32x4*)(kc + (size_t)(2 * s2 + 3) * 4096); rv1 = *(const u32x4*)(vc + (2 * s2 + 3) * 64); }
#pragma unroll
            for (int sub = 0; sub < 2; ++sub) { const int st = 2 * s2 + sub; LAS unsigned char* kb = bb + sub * 16384; LAS unsigned char* vb = kb + 8192;
            if (st < nstw && !(dbg & 1)) {
                f32x4 p[4];
#pragma unroll
                for (int kt = 0; kt < 4; ++kt) { const int tile = 4 * st + kt; p[kt] = (f32x4){0.f, 0.f, 0.f, 0.f};
                    p[kt] = MFMA16(tile_kfrag(kb, ta, kt, 0), qf[0], p[kt]); p[kt] = MFMA16(tile_kfrag(kb, ta, kt, 1), qf[1], p[kt]);
                    float G = 0.f;
#pragma unroll
                    for (int i = 0; i < 4; ++i) { const int c = 16 * tile + 4 * q + i, rel = tr - (16 * c + 31); const bool ok = rel >= 0 && c < 511;
                        const int rc = rel < 0 ? 0 : (rel > 128 ? 128 : rel);
                        const float xv = p[kt][i] + bt[rc * 8 + h] - mb;
                        const float e = __builtin_amdgcn_exp2f(ok ? xv : -1e30f); p[kt][i] = e; G += e; }
                    const float send = (q == 3) ? carry : p[kt][3]; const float prev = __shfl(send, (lane + 48) & 63); carry = p[kt][3];
                    U[r * 128 + 4 * tile + q] = G + prev; lc += G; }
                const bf16x8 pf0 = frag_pk(p[0], p[1]), pf1 = frag_pk(p[2], p[3]);
#pragma unroll
                for (int dt = 0; dt < 4; ++dt) { oc[dt] = MFMA16(tile_vfrag(vb, ta, dt, 0), pf0, oc[dt]); oc[dt] = MFMA16(tile_vfrag(vb, ta, dt, 1), pf1, oc[dt]); }
            } }
        }
    }
    lc += __shfl_xor(lc, 16); lc += __shfl_xor(lc, 32);
    const float lcinv = lc > 0.f ? 1.f / lc : 0.f;
    if (q == 0) linv[r] = lcinv;
    asm volatile("s_waitcnt lgkmcnt(0)" ::: "memory");
    if (!(dbg & 8)) {
        const int tk = lane >> 4, jr = lane & 15, t = tw + tk, tblk = t >> 6, jlim = 16 * nstw;
        const float li0 = linv[4 * tk], li1 = linv[4 * tk + 1], li2 = linv[4 * tk + 2], li3 = linv[4 * tk + 3];
        unsigned key[8];
#pragma unroll
        for (int m = 0; m < 8; ++m) { const int j = jr + 16 * m; float v = 0.f;
            if (j < jlim) v = U[(4 * tk) * 128 + j] * li0 + U[(4 * tk + 1) * 128 + j] * li1 + U[(4 * tk + 2) * 128 + j] * li2 + U[(4 * tk + 3) * 128 + j] * li3;
            const bool forced = (j == 0) || (j == tblk) || (j == tblk - 1);
            const float sc = (j <= tblk) ? v + (forced ? 1e4f : 0.f) : -1e30f;
            key[m] = fkey(sc); }
        unsigned pre = 0u;
#pragma unroll 1
        for (int bit = 31; bit >= 0; --bit) { const unsigned cand = pre | (1u << bit); int cnt = 0;
#pragma unroll
            for (int m = 0; m < 8; ++m) cnt += key[m] >= cand ? 1 : 0;
            cnt += __shfl_xor(cnt, 1); cnt += __shfl_xor(cnt, 2); cnt += __shfl_xor(cnt, 4); cnt += __shfl_xor(cnt, 8);
            if (cnt >= 16) pre = cand; }
        int ngt = 0;
#pragma unroll
        for (int m = 0; m < 8; ++m) ngt += key[m] > pre ? 1 : 0;
        ngt += __shfl_xor(ngt, 1); ngt += __shfl_xor(ngt, 2); ngt += __shfl_xor(ngt, 4); ngt += __shfl_xor(ngt, 8);
        const int need = 16 - ngt; int run = 0; const unsigned kinv = fkey(-1e30f);
#pragma unroll
        for (int m = 0; m < 8; ++m) { const bool tie = key[m] == pre; const unsigned long long bal = __ballot(tie);
            const unsigned grp = (unsigned)(bal >> (16 * tk)) & 0xffffu; const int rank = __popc(grp & ((1u << jr) - 1u));
            const bool sel = (key[m] > pre || (tie && run + rank < need)) && key[m] > kinv;
            run += __popc(grp);
            if (sel) atomicOr((unsigned*)(selm + jr + 16 * m), 1u << (4 * w + tk)); }
    }
    __syncthreads();
    f32x4 ow[4]; float lw = 0.f;
#pragma unroll
    for (int dt = 0; dt < 4; ++dt) ow[dt] = (f32x4){0.f, 0.f, 0.f, 0.f};
    {
        int lc_ = lane0; OPAQUE_V(lc_); const int lane = lc_, r = lane & 15, q = lane >> 4, tr = tw + (r >> 2), h = kv * 4 + (r & 3); const TileAddr ta = tile_addr(r, q);
        const int tid_ = w * 64 + lane, srow = tid_ >> 3, sc16 = tid_ & 7, soff = tile_off16(srow, sc16);
        const int jlob = (t0 - 511 > 0 ? t0 - 511 : 0) >> 6, jhib = (t0 + 31) >> 6, nstc = jhib - jlob + 1;
        const int jlo = (tw - 511 > 0 ? tw - 511 : 0) >> 6, jhi = (tw + 3) >> 6;
        const bf16* kwin = WSP(bf16, WS_KWIN) + (size_t)bk * T * 64 + srow * 64 + sc16 * 8; const bf16* vwin = WSP(bf16, WS_VWINT) + (size_t)bk * 128 * 4096 + srow * 64 + sc16 * 8;
        const int nstc2 = (nstc + 1) >> 1;
        u32x4 rk0 = *(const u32x4*)(kwin + (size_t)jlob * 4096), rv0 = *(const u32x4*)(vwin + (size_t)jlob * 4096), rk1 = *(const u32x4*)(kwin + (size_t)(jlob + 1) * 4096), rv1 = *(const u32x4*)(vwin + (size_t)(jlob + 1) * 4096);
#pragma unroll 1
        for (int s2 = 0; s2 < nstc2; ++s2) { const int j0 = jlob + 2 * s2;
            LAS unsigned char* bb = stC + (s2 & 1) * 32768;
            *(LAS u32x4*)(bb + soff) = rk0; *(LAS u32x4*)(bb + 8192 + soff) = rv0; *(LAS u32x4*)(bb + 16384 + soff) = rk1; *(LAS u32x4*)(bb + 24576 + soff) = rv1;
            __syncthreads();
            if (s2 + 1 < nstc2) { rk0 = *(const u32x4*)(kwin + (size_t)(j0 + 2) * 4096); rv0 = *(const u32x4*)(vwin + (size_t)(j0 + 2) * 4096);
                                  rk1 = *(const u32x4*)(kwin + (size_t)(j0 + 3) * 4096); rv1 = *(const u32x4*)(vwin + (size_t)(j0 + 3) * 4096); }
#pragma unroll
            for (int sub = 0; sub < 2; ++sub) { const int j = j0 + sub; LAS unsigned char* kb = bb + sub * 16384; LAS unsigned char* vb = kb + 8192;
            if (j >= jlo && j <= jhi && !(dbg & 2)) {
                f32x4 p[4];
#pragma unroll
                for (int kt = 0; kt < 4; ++kt) { p[kt] = (f32x4){0.f, 0.f, 0.f, 0.f};
                    p[kt] = MFMA16(tile_kfrag(kb, ta, kt, 0), qf[0], p[kt]); p[kt] = MFMA16(tile_kfrag(kb, ta, kt, 1), qf[1], p[kt]);
#pragma unroll
                    for (int i = 0; i < 4; ++i) { const int rel = tr - (64 * j + 16 * kt + 4 * q + i); const bool ok = rel >= 0 && rel < 512;
                        const int rc = rel < 0 ? 0 : (rel > 128 ? 128 : rel);
                        const float xv = p[kt][i] + bt[rc * 8 + h] - mb;
                        const float e = __builtin_amdgcn_exp2f(ok ? xv : -1e30f); p[kt][i] = e; lw += e; } }
                const bf16x8 pf0 = frag_pk(p[0], p[1]), pf1 = frag_pk(p[2], p[3]);
#pragma unroll
                for (int dt = 0; dt < 4; ++dt) { ow[dt] = MFMA16(tile_vfrag(vb, ta, dt, 0), pf0, ow[dt]); ow[dt] = MFMA16(tile_vfrag(vb, ta, dt, 1), pf1, ow[dt]); }
            } }
        }
        lw += __shfl_xor(lw, 16); lw += __shfl_xor(lw, 32);
    }
    f32x4 ocw[4];
    { const float* gt = WSP(float, WS_GATES) + (size_t)(b * T + tr) * 24 + h * 3;
      const float g0 = gt[0] * lcinv, g2 = gt[2] * (lw > 0.f ? 1.f / lw : 0.f);
#pragma unroll
      for (int dt = 0; dt < 4; ++dt) ocw[dt] = oc[dt] * g0 + ow[dt] * g2; }
    __syncthreads();
    f32x4 osf[4]; float lsf = 0.f;
    {
        int lb_ = lane0; OPAQUE_V(lb_); const int lane = lb_, r = lane & 15, q = lane >> 4, h = kv * 4 + (r & 3); const TileAddr ta = tile_addr(r, q);
        const int half = w >> 2, jw = w & 3;
        f32x4 osa[4][4]; float lsa[4];
#pragma unroll
        for (int x = 0; x < 4; ++x) { lsa[x] = 0.f;
#pragma unroll
            for (int dt = 0; dt < 4; ++dt) osa[x][dt] = (f32x4){0.f, 0.f, 0.f, 0.f}; }
        const int jmax = (t0 + 31) >> 6;
        const int brow = lane >> 3, bc16 = lane & 7, boff = brow * 64 + bc16 * 8, bsoff = tile_off16(brow, bc16); const float bfar = bt[128 * 8 + h];
        const bf16* ksel = WSP(bf16, WS_KSEL) + (size_t)bk * T * 64 + boff; const bf16* vsel = WSP(bf16, WS_VSELT) + (size_t)bk * 128 * 4096 + boff;
        LAS const bf16* Qh = Qs + (64 * half + r) * 64 + 8 * q;
        u32x4 gk[8], gv[8];
        if (jw <= jmax) {
#pragma unroll
            for (int i = 0; i < 8; ++i) { gk[i] = *(const u32x4*)(ksel + (size_t)jw * 4096 + i * 512); gv[i] = *(const u32x4*)(vsel + (size_t)jw * 4096 + i * 512); } }
#pragma unroll 1
        for (int j = jw; j <= jmax; j += 4) {
            const unsigned msel = ((unsigned)__builtin_amdgcn_readfirstlane((int)selm[j]) >> (16 * half)) & 0xffffu;
            const bool act = msel != 0u && !(dbg & 4);
            asm volatile("s_waitcnt lgkmcnt(0)" ::: "memory");
#pragma unroll
            for (int i = 0; i < 8; ++i) { *(LAS u32x4*)(stB + bsoff + i * 1024) = gk[i]; *(LAS u32x4*)(stB + 8192 + bsoff + i * 1024) = gv[i]; }
            if (j + 4 <= jmax) {
#pragma unroll
                for (int i = 0; i < 8; ++i) { gk[i] = *(const u32x4*)(ksel + (size_t)(j + 4) * 4096 + i * 512); gv[i] = *(const u32x4*)(vsel + (size_t)(j + 4) * 4096 + i * 512); } }
            if (!act) continue;
            asm volatile("s_waitcnt lgkmcnt(0)" ::: "memory");
            const bool far = (t0 - (64 * j + 63)) >= 128;
#pragma unroll 1
            for (int x = 0; x < 4; ++x) {
                const unsigned nib = (msel >> (4 * x)) & 15u;
                if (nib) {
                    asm volatile("" ::: "memory");
                    const bool tokv = (nib >> (r >> 2)) & 1u; const int t = t0 + 16 * half + 4 * x + (r >> 2);
                    const bf16x8 qs0 = as_frag(*(LAS const u32x4*)(Qh + x * 1024)), qs1 = as_frag(*(LAS const u32x4*)(Qh + x * 1024 + 32));
                    f32x4 p[4]; float ls = 0.f;
#pragma unroll
                    for (int kt = 0; kt < 4; ++kt) { p[kt] = (f32x4){0.f, 0.f, 0.f, 0.f};
                        p[kt] = MFMA16(tile_kfrag(stB, ta, kt, 0), qs0, p[kt]); p[kt] = MFMA16(tile_kfrag(stB, ta, kt, 1), qs1, p[kt]); }
                    if (dbg & 32) { ls = p[0][0]; } else
                    if (far) {
                        const float cb_ = bfar - mb;
#pragma unroll
                        for (int kt = 0; kt < 4; ++kt)
#pragma unroll
                            for (int i = 0; i < 4; ++i) { const float e = __builtin_amdgcn_exp2f(tokv ? p[kt][i] + cb_ : -1e30f); p[kt][i] = e; ls += e; }
                    } else {
#pragma unroll
                        for (int kt = 0; kt < 4; ++kt)
#pragma unroll
                            for (int i = 0; i < 4; ++i) { const int rel = t - (64 * j + 16 * kt + 4 * q + i); const bool ok = tokv && rel >= 0;
                                const int rc = rel < 0 ? 0 : (rel > 128 ? 128 : rel);
                                const float xv = p[kt][i] + bt[rc * 8 + h] - mb;
                                const float e = __builtin_amdgcn_exp2f(ok ? xv : -1e30f); p[kt][i] = e; ls += e; }
                    }
                    lsa[0] += ls;
                    const bf16x8 pf0 = frag_pk(p[0], p[1]), pf1 = frag_pk(p[2], p[3]);
#pragma unroll
                    for (int dt = 0; dt < 4; ++dt) if (!(dbg & 64)) { osa[0][dt] = MFMA16(tile_vfrag(stB + 8192, ta, dt, 0), pf0, osa[0][dt]); osa[0][dt] = MFMA16(tile_vfrag(stB + 8192, ta, dt, 1), pf1, osa[0][dt]); }
                }
                { const float l0 = lsa[0]; lsa[0] = lsa[1]; lsa[1] = lsa[2]; lsa[2] = lsa[3]; lsa[3] = l0;
#pragma unroll
                  for (int dt = 0; dt < 4; ++dt) { const f32x4 o0 = osa[0][dt]; osa[0][dt] = osa[1][dt]; osa[1][dt] = osa[2][dt]; osa[2][dt] = osa[3][dt]; osa[3][dt] = o0; } }
            }
        }
#pragma unroll
        for (int dt = 0; dt < 4; ++dt) osf[dt] = (f32x4){0.f, 0.f, 0.f, 0.f};
#pragma unroll
        for (int x = 0; x <= 4; ++x) {
            __syncthreads();
            if (x > 0 && jw == x - 1) {
#pragma unroll
                for (int w2 = 0; w2 < 4; ++w2) { LAS const float* rp = (LAS const float*)(F.lds + NL_U + ((x - 1) & 1) * 32768) + (4 * half + w2) * 1024 + lane * 16;
#pragma unroll
                    for (int dt = 0; dt < 4; ++dt) osf[dt] += *(LAS const f32x4*)(rp + 4 * dt);
                    lsf += ((LAS const float*)(F.lds + NL_Q + ((x - 1) & 1) * 2048))[(4 * half + w2) * 64 + lane]; } }
            if (x < 4) { LAS float* Rb = (LAS float*)(F.lds + NL_U + (x & 1) * 32768); LAS float* RLb = (LAS float*)(F.lds + NL_Q + (x & 1) * 2048);
#pragma unroll
                for (int dt = 0; dt < 4; ++dt) *(LAS f32x4*)(Rb + w * 1024 + lane * 16 + 4 * dt) = osa[x][dt];
                RLb[w * 64 + lane] = lsa[x]; }
        }
        lsf += __shfl_xor(lsf, 16); lsf += __shfl_xor(lsf, 32);
    }
    {
        int lf_ = lane0; OPAQUE_V(lf_); const int r = lf_ & 15, q = lf_ >> 4, tr = tw + (r >> 2), h = kv * 4 + (r & 3);
        const int tok = b * T + tr; const float g1 = WSP(float, WS_GATES)[(size_t)tok * 24 + h * 3 + 1] * (lsf > 0.f ? 1.f / lsf : 0.f);
        bf16* on = WSP(bf16, WS_ONSA) + (size_t)tok * 512 + h * 64 + 4 * q;
#pragma unroll
        for (int dt = 0; dt < 4; ++dt) { const f32x4 o = ocw[dt] + osf[dt] * g1;
            u32x2 wv; wv.x = pk2(o[0], o[1]); wv.y = pk2(o[2], o[3]); *(u32x2*)(on + 16 * dt) = wv; }
    }
}

constexpr int SL_Q = 0;
constexpr int SL_S = 1024;
constexpr int SL_O = 17408;
constexpr int SL_PART = 20480;
constexpr int SL_IMP = 28672;
constexpr int SL_IDX = 29200;
constexpr int SL_END = 29328;
static_assert(SL_END <= NL_SEL, "sample NSA LDS map must not overlap the tables");
template <class KP, class VP, class RELF>
__device__ __forceinline__ void sample_segment(Frame& F, int nk, int kv, KP kptr, VP vptr, RELF relf, LAS float* odst) {
    LAS const float* qs = (LAS const float*)(F.lds + SL_Q); LAS float* sc = (LAS float*)(F.lds + SL_S); LAS float* part = (LAS float*)(F.lds + SL_PART);
    LAS const float* bt = (LAS const float*)(F.lds + NL_BT);
    const int nkp = (nk + 63) & ~63;
    for (int n = TID_; n < nkp; n += NTHR) {
        float s0 = -INFINITY, s1 = -INFINITY, s2 = -INFINITY, s3 = -INFINITY;
        const float* kr = n < nk ? kptr(n) : nullptr;
        if (kr) { s0 = s1 = s2 = s3 = 0.f;
            for (int d = 0; d < 64; d += 4) { const f32x4 k4 = *(const f32x4*)(kr + d);
                const f32x4 q0 = *(LAS const f32x4*)(qs + d), q1 = *(LAS const f32x4*)(qs + 64 + d), q2 = *(LAS const f32x4*)(qs + 128 + d), q3 = *(LAS const f32x4*)(qs + 192 + d);
                s0 += (q0[0] * k4[0] + q0[1] * k4[1]) + (q0[2] * k4[2] + q0[3] * k4[3]); s1 += (q1[0] * k4[0] + q1[1] * k4[1]) + (q1[2] * k4[2] + q1[3] * k4[3]);
                s2 += (q2[0] * k4[0] + q2[1] * k4[1]) + (q2[2] * k4[2] + q2[3] * k4[3]); s3 += (q3[0] * k4[0] + q3[1] * k4[1]) + (q3[2] * k4[2] + q3[3] * k4[3]); }
            int rel = relf(n); rel = rel > 128 ? 128 : rel; const int bb = rel * 8 + kv * 4;
            s0 += bt[bb]; s1 += bt[bb + 1]; s2 += bt[bb + 2]; s3 += bt[bb + 3]; }
        sc[n] = s0; sc[1024 + n] = s1; sc[2048 + n] = s2; sc[3072 + n] = s3;
    }
    __syncthreads();
    if (F.wave < 4) { LAS float* row = sc + F.wave * 1024; float m = -INFINITY;
        for (int n = LANE_; n < nkp; n += 64) m = fmaxf(m, row[n]);
        m = wave_max(m); float l = 0.f;
        for (int n = LANE_; n < nkp; n += 64) { const float e = __builtin_amdgcn_exp2f(row[n] - m); row[n] = e; l += e; }
        l = wave_sum(l); const float inv = 1.f / l;
        for (int n = LANE_; n < nkp; n += 64) row[n] *= inv; }
    __syncthreads();
    {
        const int d = LANE_; float o0 = 0.f, o1 = 0.f, o2 = 0.f, o3 = 0.f;
        for (int n0 = F.wave; n0 < nkp; n0 += 128) {
            float v[16];
#pragma unroll
            for (int u = 0; u < 16; ++u) { const int n = n0 + 8 * u; v[u] = n < nk ? vptr(n)[d] : 0.f; }
#pragma unroll
            for (int u = 0; u < 16; ++u) { const int n = n0 + 8 * u; if (n < nkp) { o0 += sc[n] * v[u]; o1 += sc[1024 + n] * v[u]; o2 += sc[2048 + n] * v[u]; o3 += sc[3072 + n] * v[u]; } }
        }
        part[(F.wave * 4 + 0) * 64 + d] = o0; part[(F.wave * 4 + 1) * 64 + d] = o1; part[(F.wave * 4 + 2) * 64 + d] = o2; part[(F.wave * 4 + 3) * 64 + d] = o3; }
    __syncthreads();
    if (TID_ < 256) { float a = 0.f;
#pragma unroll
        for (int w8 = 0; w8 < 8; ++w8) a += part[w8 * 256 + TID_];
        odst[TID_] = a; }
    __syncthreads();
}
__device__ __forceinline__ void p3_nsa_sample(Frame& F, int task, int part) {
    const int b = task >> 1, kv = task & 1, tok = NTOKP + b, bk = b * 2 + kv;
    LAS float* qs = (LAS float*)(F.lds + SL_Q); LAS float* sc = (LAS float*)(F.lds + SL_S); LAS float* ob = (LAS float*)(F.lds + SL_O);
    LAS float* imp = (LAS float*)(F.lds + SL_IMP); LAS int* sidx = (LAS int*)(F.lds + SL_IDX);
    __syncthreads();
    if (TID_ < 256) qs[TID_] = bf2f(WSP(bf16, WS_QN)[(size_t)tok * 512 + kv * 256 + TID_]);
    __syncthreads();
    const float* kcs = WSP(float, WS_KCMPS) + (size_t)bk * 512 * 64; const float* vcs = WSP(float, WS_VCMPS) + (size_t)bk * 512 * 64;
    const float* nkv = WSP(float, WS_NEWKV) + (size_t)b * 4 * 2 * 64 + kv * 64;
    const float* ckv = F.in[I_CKV]; const int* pt = (const int*)F.in[I_PT] + b * 64; const float* cwin = F.in[I_CWIN] + (size_t)b * 512 * 256;
    if (part == 0) {
    sample_segment(F, 511, kv, [&](int n) { return kcs + (size_t)n * 64; }, [&](int n) { return vcs + (size_t)n * 64; }, [&](int n) { return T - (16 * n + 31); }, ob);
    if (TID_ < 129) { const int j = TID_; float v = 0.f;
        for (int c = 4 * j - 1; c <= 4 * j + 3; ++c) if (c >= 0 && c < 511) v += (sc[c] + sc[1024 + c]) + (sc[2048 + c] + sc[3072 + c]);
        imp[j] = v; }
    __syncthreads();
    if (F.wave == 0) { const int lane = LANE_; unsigned key[3];
#pragma unroll
        for (int m = 0; m < 3; ++m) { const int j = lane + 64 * m; float s = -1e30f;
            if (j < 129) { const bool forced = (j == 0) || (j == 128) || (j == 127); s = imp[j] + (forced ? 1e4f : 0.f); }
            key[m] = (j < 129) ? fkey(s) : 0u; }
        unsigned pre = 0u;
#pragma unroll 1
        for (int bit = 31; bit >= 0; --bit) { const unsigned cand = pre | (1u << bit); int cnt = 0;
#pragma unroll
            for (int m = 0; m < 3; ++m) cnt += __popcll(__ballot(key[m] >= cand));
            if (cnt >= 16) pre = cand; }
        int ngt = 0;
#pragma unroll
        for (int m = 0; m < 3; ++m) ngt += __popcll(__ballot(key[m] > pre));
        int need = 16 - ngt, cnt = 0;
#pragma unroll
        for (int m = 0; m < 3; ++m) { const bool gt = key[m] > pre, tie = key[m] == pre; const unsigned long long tb = __ballot(tie);
            const int trank = __popcll(tb & ((1ull << lane) - 1ull)); const bool sel = gt || (tie && trank < need);
            need -= __popcll(tb); need = need < 0 ? 0 : need;
            const unsigned long long sb = __ballot(sel); const int pos = cnt + __popcll(sb & ((1ull << lane) - 1ull));
            if (sel && pos < 16) sidx[pos] = lane + 64 * m; cnt += __popcll(sb); } }
    __syncthreads();
    sample_segment(F, 1024, kv,
        [&](int n) -> const float* { const int pos = 64 * sidx[n >> 6] + (n & 63); if (pos > T) return nullptr; if (pos == T) return nkv;
                                     return ckv + (((size_t)pt[pos >> 7] * 128 + (pos & 127)) * 4 + 2) * 128 + kv * 64; },
        [&](int n) -> const float* { const int pos = 64 * sidx[n >> 6] + (n & 63); if (pos >= T) return nkv + 128;
                                     return ckv + (((size_t)pt[pos >> 7] * 128 + (pos & 127)) * 4 + 3) * 128 + kv * 64; },
        [&](int n) { return T - (64 * sidx[n >> 6] + (n & 63)); }, ob + 256);
    } else {
    sample_segment(F, 512, kv,
        [&](int n) -> const float* { return n < 511 ? cwin + (size_t)(n + 1) * 256 + kv * 64 : nkv + 256; },
        [&](int n) -> const float* { return n < 511 ? cwin + (size_t)(n + 1) * 256 + 128 + kv * 64 : nkv + 384; },
        [&](int n) { return 511 - n; }, ob + 512);
    }
    if (TID_ < 256) { const int g = TID_ >> 6, d = TID_ & 63, h = kv * 4 + g; const float* gt = WSP(float, WS_GATES) + (size_t)tok * 24 + h * 3;
        const float v = part == 0 ? gt[0] * ob[TID_] + gt[1] * ob[256 + TID_] : gt[2] * ob[512 + TID_];
        atomicAdd(WSP(float, WS_ONS) + (size_t)b * 512 + h * 64 + d, v); }
}

__device__ __forceinline__ void p6_conv(Frame& F) {
    const bf16* ug = WSP(bf16, WS_UG); bf16* act = WSP(bf16, WS_ACT);
    const float* cw = F.in[I_CONVW]; const float* cb = F.in[I_CONVB]; const float* sconv = F.in[I_SCONV];
    constexpr int NG = DFF / 8, RSEG = 64, NSEGP = NTOKP / RSEG, NITEM = NG * (NSEGP + 1);
    { const float* x1s = WSP(float, WS_X1S); float* ys = F.out + O_YS; for (int i = F.bid * NTHR + TID_; i < SB * 1024; i += F.G * NTHR) ys[i] = x1s[i]; }
    for (int it = F.bid * NTHR + TID_; it < NITEM; it += F.G * NTHR) {
        const int seg = it / NG, c0 = 8 * (it % NG);
        float w0[8], w1[8], w2[8], bb[8];
#pragma unroll
        for (int i = 0; i < 8; ++i) { w0[i] = cw[c0 + i]; w1[i] = cw[DFF + c0 + i]; w2[i] = cw[2 * DFF + c0 + i]; bb[i] = cb[c0 + i]; }
        if (seg < NSEGP) {
            const int row0 = seg * RSEG, t0 = row0 & (T - 1);
            float g0[8], g1[8];
            if (t0 >= 2) { unpack8(*(const u32x4*)(ug + (size_t)(row0 - 2) * DUP + DFF + c0), g0); unpack8(*(const u32x4*)(ug + (size_t)(row0 - 1) * DUP + DFF + c0), g1); }
            else {
#pragma unroll
                for (int i = 0; i < 8; ++i) { g0[i] = 0.f; g1[i] = 0.f; } }
#pragma unroll 4
            for (int rr = 0; rr < RSEG; ++rr) { const int row = row0 + rr; float u[8], g2[8], a[8];
                unpack8(*(const u32x4*)(ug + (size_t)row * DUP + c0), u); unpack8(*(const u32x4*)(ug + (size_t)row * DUP + DFF + c0), g2);
#pragma unroll
                for (int i = 0; i < 8; ++i) { a[i] = gelu_tanh(bb[i] + w0[i] * g0[i] + w1[i] * g1[i] + w2[i] * g2[i]) * u[i]; g0[i] = g1[i]; g1[i] = g2[i]; }
                *(u32x4*)(act + (size_t)row * DFF + c0) = pack8(a); }
            if (t0 + RSEG == T) { float* o = F.out + O_CONVP + (size_t)(row0 >> 13) * 2 * DFF + c0;
#pragma unroll
                for (int i = 0; i < 8; ++i) { o[i] = g0[i]; o[DFF + i] = g1[i]; } }
        } else {
            for (int sb = 0; sb < SB; ++sb) { const int row = NTOKP + sb; float u[8], g2[8], g0[8], g1[8], a[8];
                unpack8(*(const u32x4*)(ug + (size_t)row * DUP + c0), u); unpack8(*(const u32x4*)(ug + (size_t)row * DUP + DFF + c0), g2);
#pragma unroll
                for (int i = 0; i < 8; ++i) { g0[i] = sconv[((size_t)sb * 2 + 0) * DFF + c0 + i]; g1[i] = sconv[((size_t)sb * 2 + 1) * DFF + c0 + i]; }
                float* o = F.out + O_CONVS + (size_t)sb * 2 * DFF + c0;
#pragma unroll
                for (int i = 0; i < 8; ++i) { o[i] = g1[i]; o[DFF + i] = g2[i]; a[i] = gelu_tanh(bb[i] + w0[i] * g0[i] + w1[i] * g1[i] + w2[i] * g2[i]) * u[i]; }
                *(u32x4*)(act + (size_t)row * DFF + c0) = pack8(a); }
            for (int row = NTOK; row < MPAD; ++row) *(u32x4*)(act + (size_t)row * DFF + c0) = (u32x4){0u, 0u, 0u, 0u};
        }
    }
}

template <bool A_F32>
__device__ __forceinline__ void skinny_mma(f32x4 (&acc)[2], float (&ssq)[2], const void* A, int lda, const bf16* Bt, int K, int n0, int k0, int nks, int r, int q) {
    acc[0] = (f32x4){0.f, 0.f, 0.f, 0.f}; acc[1] = acc[0]; ssq[0] = 0.f; ssq[1] = 0.f;
#pragma unroll 4
    for (int ks = 0; ks < nks; ++ks) { const int k = k0 + 32 * ks + 8 * q;
        const bf16x8 a = ldfrag(Bt + (size_t)(n0 + r) * K + k);
#pragma unroll
        for (int mt = 0; mt < 2; ++mt) { bf16x8 bfr;
            if (A_F32) { const float* p = (const float*)A + (size_t)(16 * mt + r) * lda + k; const f32x4 x0 = *(const f32x4*)p, x1 = *(const f32x4*)(p + 4);
                ssq[mt] += (x0[0] * x0[0] + x0[1] * x0[1]) + (x0[2] * x0[2] + x0[3] * x0[3]) + (x1[0] * x1[0] + x1[1] * x1[1]) + (x1[2] * x1[2] + x1[3] * x1[3]); bfr = frag_pk(x0, x1); }
            else bfr = ldfrag((const bf16*)A + (size_t)(16 * mt + r) * lda + k);
            acc[mt] = MFMA16(a, bfr, acc[mt]); } }
}
__device__ __forceinline__ void s5_merge(Frame& F, int t) {
    const int lane = LANE_, r = lane & 15, q = lane >> 4, br = t >> 7, nt = (t >> 1) & 63, kc = t & 1;
    const bf16* A = (br == 0 ? WSP(bf16, WS_ONSA) : br == 1 ? WSP(bf16, WS_OGLA) : WSP(bf16, WS_OX)) + (size_t)NTOKP * 512;
    const bf16* Bt = br == 0 ? WSP(bf16, WS_WTNSA) : br == 1 ? WSP(bf16, WS_WTGLA) : WSP(bf16, WS_WTX);
    f32x4 acc[2]; float ssq[2];
    if (br == 0) skinny_mma<true>(acc, ssq, WSP(float, WS_ONS), 512, Bt, 512, 16 * nt, 256 * kc, 8, r, q);
    else skinny_mma<false>(acc, ssq, A, 512, Bt, 512, 16 * nt, 256 * kc, 8, r, q);
    float* ms = WSP(float, WS_MS); const bf16* gate = WSP(bf16, WS_PROJ) + (size_t)NTOKP * DINP + C_MG + br * 1024;
#pragma unroll
    for (int mt = 0; mt < 2; ++mt) { const int m = 16 * mt + r; const u32x2 g = *(const u32x2*)(gate + (size_t)m * DINP + 16 * nt + 4 * q);
        float* d = ms + (size_t)m * 1024 + 16 * nt + 4 * q;
        atomicAdd(d + 0, acc[mt][0] * sigmoidf_(bflo(g.x))); atomicAdd(d + 1, acc[mt][1] * sigmoidf_(bfhi(g.x)));
        atomicAdd(d + 2, acc[mt][2] * sigmoidf_(bflo(g.y))); atomicAdd(d + 3, acc[mt][3] * sigmoidf_(bfhi(g.y))); }
}
__device__ __forceinline__ void s6_wo(Frame& F, int t) {
    const int lane = LANE_, r = lane & 15, q = lane >> 4, nt = t >> 2, kc = t & 3;
    f32x4 acc[2]; float ssq[2]; skinny_mma<true>(acc, ssq, WSP(float, WS_MS), 1024, WSP(bf16, WS_WTO), 1024, 16 * nt, 256 * kc, 8, r, q);
    float* x1s = WSP(float, WS_X1S);
#pragma unroll
    for (int mt = 0; mt < 2; ++mt) { float* d = x1s + (size_t)(16 * mt + r) * 1024 + 16 * nt + 4 * q;
#pragma unroll
        for (int i = 0; i < 4; ++i) atomicAdd(d + i, acc[mt][i]); }
}
__device__ __forceinline__ void s7_up(Frame& F, int t) {
    const int lane = LANE_, r = lane & 15, q = lane >> 4;
    f32x4 acc[2]; float ssq[2]; skinny_mma<true>(acc, ssq, WSP(float, WS_X1S), 1024, WSP(bf16, WS_WTUP), 1024, 16 * t, 0, 32, r, q);
    bf16* ug = WSP(bf16, WS_UG) + (size_t)NTOKP * DUP;
#pragma unroll
    for (int mt = 0; mt < 2; ++mt) { float s = ssq[mt]; s += __shfl_xor(s, 16); s += __shfl_xor(s, 32); const float rs = rsqrtf(s * (1.f / 1024.f) + EPS);
        u32x2 w; w.x = pk2(acc[mt][0] * rs, acc[mt][1] * rs); w.y = pk2(acc[mt][2] * rs, acc[mt][3] * rs);
        *(u32x2*)(ug + (size_t)(16 * mt + r) * DUP + 16 * t + 4 * q) = w; }
}
__device__ __forceinline__ void s9_down(Frame& F, int t) {
    const int lane = LANE_, r = lane & 15, q = lane >> 4, nt = t / 11, kc = t % 11;
    f32x4 acc[2]; float ssq[2]; skinny_mma<false>(acc, ssq, WSP(bf16, WS_ACT) + (size_t)NTOKP * DFF, DFF, WSP(bf16, WS_WTDOWN), DFF, 16 * nt, 256 * kc, 8, r, q);
    float* ys = F.out + O_YS;
#pragma unroll
    for (int mt = 0; mt < 2; ++mt) { float* d = ys + (size_t)(16 * mt + r) * 1024 + 16 * nt + 4 * q;
#pragma unroll
        for (int i = 0; i < 4; ++i) atomicAdd(d + i, acc[mt][i]); }
}

constexpr int N_PHASES = 10;
__global__ void __launch_bounds__(NTHR, 2) mega_fwd(Args args) {
    extern __shared__ __attribute__((aligned(16))) unsigned char lds_raw[];
    cg::grid_group grid = cg::this_grid();
    Frame F;
    F.lds = (LAS unsigned char*)lds_raw;
    F.wave = __builtin_amdgcn_readfirstlane((int)(threadIdx.x >> 6));
    F.G = gridDim.x; F.bid = blockIdx.x; F.gw = F.bid * NWAVES + F.wave; F.NGW = F.G * NWAVES;
    F.in = args.in; F.out = args.out; F.ws = args.ws;
    const int lo = args.ph_lo, hi = args.ph_hi, sub = args.sub;
    volatile LAS unsigned* xst = (volatile LAS unsigned*)(F.lds + 152640);
    if (threadIdx.x < 2) xst[threadIdx.x] = 0u;
    __syncthreads();
    XcdBarrier xbar; xbar.bar = (unsigned*)(args.ws + WS_CTL); xbar.x = 0; xbar.st = xst;
    if (lo == 0 && hi == N_PHASES) xbar = xcd_barrier_post((unsigned*)(args.ws + WS_CTL), xst);
#define SUB(i) ((sub >> (i)) & 1)
#ifndef PROBE_REP
#define PROBE_REP -1
#endif
#define IN(k) (lo <= (k) && (k) < hi)
#define REP(k) for (int rep_ = 0; rep_ < ((k) == PROBE_REP ? 2 : 1); ++rep_)
#define SEAM(k) do { if (IN(k) && IN((k) + 1)) { xcd_barrier(xbar); } { unsigned char* w_ = F.ws; asm volatile("" : "+s"(w_)); F.ws = w_; float* o_ = F.out; asm volatile("" : "+s"(o_)); F.out = o_; } } while (0)
    typedef pg8::StaticOrder SO;
    if (lo < 0) grid.sync();
    int p2_gla_sample_task = -1;
    constexpr int KSPLIT = 9;

    REP(0) if (IN(0)) { p0_prologue(F); }
    SEAM(0);
    if (IN(1)) {
        { pg8::Gemm g{WSP(bf16, WS_XN), WSP(bf16, WS_WTIN), MPAD, DINP, 1024}; SO S; S.init(MPAD, DINP, F.G, F.bid);
          pg8::EpiStore E{WSP(bf16, WS_PROJ), DINP, nullptr};
          pg8::gemm_phase<pg8::EpiStore, SO, true, true>(F.lds, g, S, E, F.wave); }
        __syncthreads();
        { pg8::Gemm g{WSP(bf16, WS_MN), WSP(bf16, WS_WTMEM), 512, 1024, 1024}; SO S; S.init(512, 1024, F.G, F.G - 1 - F.bid);
          pg8::EpiStore E{WSP(bf16, WS_MEMPROJ), 1024, nullptr};
          pg8::gemm_phase<pg8::EpiStore, SO, true, true>(F.lds, g, S, E, F.wave); }
    }
    SEAM(1);
    if (IN(2)) {
        if (F.G == 256) {
            const int bid = F.bid;
            if (bid >= 16) { const bool cblk = bid < 136; const int pidx = ((cblk ? bid - 16 : bid - 136) << 3) + F.wave;
                if (SUB(0)) { const int k0 = cblk ? 0 : KSPLIT, k1 = cblk ? KSPLIT : 18; TokRaw raw = p2_token_load(F, k0 * 960 + pidx);
                    for (int k = k0; k < k1; ++k) { const int tok = k * 960 + pidx; if (tok >= NTOK) break; const int tn = (k + 1 < k1 && tok + 960 < NTOK) ? tok + 960 : tok; const TokRaw nxt = p2_token_load(F, tn); p2_token(F, tok, raw); raw = nxt; }
                    if (!cblk && pidx < 512) p2_memrow(F, pidx); }
                if (!cblk && SUB(3) && pidx < SB * 4) p2_gla_sample_task = pidx; }
            if (SUB(1) && bid < CMP_TASKS_S + CMP_TASKS_P) p2_compress(F, bid);
            if (SUB(2)) { if (bid < 16) { __syncthreads(); p2_gla_chunk(F, bid); }
                else if (bid >= 136) { for (int c2 = 0; c2 < 2; ++c2) { __syncthreads(); p2_gla_chunk(F, 16 + (bid - 136) * 2 + c2); } } }
            __syncthreads();
            if (p2_gla_sample_task >= 0) p2_gla_sample(F, p2_gla_sample_task);
        } else {
            if (SUB(0)) { for (int tok = F.gw; tok < NTOK; tok += F.NGW) p2_token(F, tok, p2_token_load(F, tok));
            for (int row = F.gw; row < 512; row += F.NGW) p2_memrow(F, row); }
            if (SUB(1)) for (int t = F.bid; t < CMP_TASKS_S + CMP_TASKS_P; t += F.G) p2_compress(F, t);
            if (SUB(2)) for (int bc = F.bid; bc < 256; bc += F.G) { __syncthreads(); p2_gla_chunk(F, bc); }
            __syncthreads();
            if (SUB(3)) for (int t = F.gw; t < SB * 4; t += F.NGW) p2_gla_sample(F, t);
        }
    }
    SEAM(2);
    REP(3) if (IN(3)) {
        nsa_tables(F);
        const float mb = nsa_bound(F);
        if (SUB(4)) for (int n = F.bid; n < 1024; n += F.G) p3_nsa_prompt(F, n, mb, (sub >> 8) & 255);
        __syncthreads();
        if (SUB(7)) for (int t = F.gw; t < 1024; t += F.NGW) p3_gla_scan(F, t);
    }
    SEAM(3);
    if (IN(4)) {
        nsa_tables(F);
        if (!SUB(5)) {} else if (F.G == 256) { if (F.bid >= 192) p3_nsa_sample(F, 255 - F.bid, 0); else if (F.bid >= 128) p3_nsa_sample(F, 191 - F.bid, 1); }
        else for (int t = F.bid; t < SB * 4; t += F.G) p3_nsa_sample(F, t >> 1, t & 1);
        __syncthreads();
        { const float gq = absmax_arr(F.in[I_GXQ], 128, LANE_), gk = absmax_arr(F.in[I_GXK], 128, LANE_);
          const float mbx = 11.313708498984761f * gq * gk * 1.02f * LOG2E;
          if (SUB(6)) for (int t = F.bid; t < 256; t += F.G) p3_xatt(F, t, mbx); }
        __syncthreads();
        if (!SUB(0)) {} else if (F.G == 256) { if (F.bid >= 64 && F.bid < 192) p3_xatt_sample(F, F.bid - 64); } else for (int t = F.bid; t < SB * 4; t += F.G) p3_xatt_sample(F, t);
        __syncthreads();
        if (!SUB(1)) {} else if (F.G == 256) {
            if (F.bid < 128) { for (int k = 0; k < 3; ++k) p4_gla_out(F, k * 1024 + F.gw); }
            else if (F.bid < 192) { const int wi = ((F.bid - 128) << 3) + F.wave; for (int k = 0; k < 2; ++k) p4_gla_out(F, 3072 + k * 512 + wi); }
        } else for (int t = F.gw; t < 4096; t += F.NGW) p4_gla_out(F, t);
    }
    SEAM(4);
    if (IN(5)) {
        const bf16* gate = WSP(bf16, WS_PROJ) + C_MG;
        for (int t = F.gw; t < 384; t += F.NGW) s5_merge(F, t);
        { pg8::Gemm g{WSP(bf16, WS_ONSA), WSP(bf16, WS_WTNSA), NTOKP, 1024, 512}; SO S; S.init(NTOKP, 1024, F.G, F.bid);
          pg8::EpiMerge<0> E{gate, DINP, WSP(bf16, WS_MERGED), 1024};
          pg8::gemm_phase<pg8::EpiMerge<0>, SO, true, true>(F.lds, g, S, E, F.wave); }
        __syncthreads();
        { pg8::Gemm g{WSP(bf16, WS_OGLA), WSP(bf16, WS_WTGLA), NTOKP, 1024, 512}; SO S; S.init(NTOKP, 1024, F.G, F.bid);
          pg8::EpiMerge<1> E{gate + 1024, DINP, WSP(bf16, WS_MERGED), 1024};
          pg8::gemm_phase<pg8::EpiMerge<1>, SO, true, true>(F.lds, g, S, E, F.wave); }
        __syncthreads();
        { pg8::Gemm g{WSP(bf16, WS_OX), WSP(bf16, WS_WTX), NTOKP, 1024, 512}; SO S; S.init(NTOKP, 1024, F.G, F.bid);
          pg8::EpiMerge<1> E{gate + 2048, DINP, WSP(bf16, WS_MERGED), 1024};
          pg8::gemm_phase<pg8::EpiMerge<1>, SO, true, true>(F.lds, g, S, E, F.wave); }
    }
    SEAM(5);
    if (IN(6)) {
        for (int t = F.gw; t < 256; t += F.NGW) s6_wo(F, t);
        pg8::Gemm g{WSP(bf16, WS_MERGED), WSP(bf16, WS_WTO), NTOKP, 1024, 1024}; SO S; S.init(NTOKP, 1024, F.G, F.bid);
        pg8::EpiWo E{F.in[I_XP], F.in[I_XS], WSP(float, WS_X1), WSP(bf16, WS_X1B), WSP(float, WS_SSQ)};
        pg8::gemm_phase<pg8::EpiWo, SO, true, true>(F.lds, g, S, E, F.wave);
    }
    SEAM(6);
    if (IN(7)) {
        for (int t = F.gw; t < 352; t += F.NGW) s7_up(F, t);
        pg8::Gemm g{WSP(bf16, WS_X1B), WSP(bf16, WS_WTUP), NTOKP, DUP, 1024}; SO S; S.init(NTOKP, DUP, F.G, F.bid);
        pg8::EpiStore E{WSP(bf16, WS_UG), DUP, WSP(float, WS_SSQ)};
        pg8::gemm_phase<pg8::EpiStore, SO, true, true>(F.lds, g, S, E, F.wave);
    }
    SEAM(7);
    REP(8) if (IN(8)) { p6_conv(F); }
    SEAM(8);
    if (IN(9)) {
        for (int t = F.gw; t < 704; t += F.NGW) s9_down(F, t);
        pg8::Gemm g{WSP(bf16, WS_ACT), WSP(bf16, WS_WTDOWN), NTOKP, 1024, DFF}; SO S; S.init(NTOKP, 1024, F.G, F.bid);
        pg8::EpiDown E{WSP(float, WS_X1), F.out + O_Y, F.out + O_YS};
        pg8::gemm_phase<pg8::EpiDown, SO, true, true>(F.lds, g, S, E, F.wave);
    }
#undef IN
#undef SEAM
}

extern "C" void kernel_launch(void* const* d_in, const int* in_sizes, int n_in, void* d_out, int out_size, void* d_ws, size_t ws_size, hipStream_t stream) {
    static int grid = 0;
    if (grid == 0) {
        if (n_in != N_IN || (size_t)out_size != O_END || ws_size < WS_END) {
            fprintf(stderr, "kernel_launch: built for %d inputs, %zu outputs, >= %zu bytes of workspace; got %d, %d, %zu\n", (int)N_IN, (size_t)O_END, (size_t)WS_END, n_in, out_size, ws_size); grid = -1; return; }
        int dev = 0, cus = 0, per_cu = 0;
        if (hipGetDevice(&dev) != hipSuccess || hipDeviceGetAttribute(&cus, hipDeviceAttributeMultiprocessorCount, dev) != hipSuccess) { grid = -1; return; }
        if (hipFuncSetAttribute((const void*)mega_fwd, hipFuncAttributeMaxDynamicSharedMemorySize, LDS_BYTES) != hipSuccess) { fprintf(stderr, "kernel_launch: hipFuncSetAttribute failed\n"); grid = -1; return; }
        if (hipOccupancyMaxActiveBlocksPerMultiprocessor(&per_cu, (const void*)mega_fwd, NTHR, LDS_BYTES) != hipSuccess || per_cu < 1) { fprintf(stderr, "kernel_launch: occupancy query gave %d\n", per_cu); per_cu = 1; }
        (void)hipGetLastError();
        grid = cus * (per_cu < 1 ? 1 : 1);
    }
    if (grid < 0) return;
    Args a{};
    for (int i = 0; i < N_IN; ++i) a.in[i] = (const float*)d_in[i];
    a.out = (float*)d_out; a.ws = (unsigned char*)d_ws;
#if MK_N_LAUNCHES == 1
    a.ph_lo = 0; a.ph_hi = N_PHASES; a.sub = 0xff;
    (void)hipMemsetAsync((unsigned char*)d_ws + WS_CTL, 0, CTL_BYTES, stream);
    void* kargs[] = {&a};
    hipError_t e = hipLaunchCooperativeKernel((const void*)mega_fwd, dim3(grid), dim3(NTHR), kargs, LDS_BYTES, stream);
    if (e != hipSuccess) fprintf(stderr, "kernel_launch: cooperative launch failed: %s (grid %d)\n", hipGetErrorString(e), grid);
#ifdef PROBE_EXTRA
    a.ph_lo = PROBE_EXTRA; a.ph_hi = PROBE_EXTRA + 1;
#ifdef PROBE_SUB
    a.sub = PROBE_SUB;
#endif
    hipLaunchKernelGGL(mega_fwd, dim3(grid), dim3(NTHR), LDS_BYTES, stream, a);
#endif
#else
    a.sub = 0xff;
    for (int p = 0; p < N_PHASES; ++p) { a.ph_lo = p; a.ph_hi = p + 1; hipLaunchKernelGGL(mega_fwd, dim3(grid), dim3(NTHR), LDS_BYTES, stream, a); }
#endif
}
```

```cpp
#include <hip/hip_runtime.h>
#include <hip/hip_cooperative_groups.h>
#include <cstdio>
#include <cstdint>
namespace cg = cooperative_groups;
#ifndef MK_N_LAUNCHES
#define MK_N_LAUNCHES 1
#endif
namespace pg8 {
#define PG8_LAS __attribute__((address_space(3)))
typedef unsigned short bf16_t;
typedef short bf16x8 __attribute__((ext_vector_type(8)));
typedef float f32x4 __attribute__((ext_vector_type(4)));
typedef unsigned u32x4 __attribute__((ext_vector_type(4)));
constexpr int BM = 256, BK = 64, HALF = 128, HTB = HALF * BK * 2  , STAGE_BYTES = 8 * HTB, NXCD = 8, WGM = 8;

__host__ __device__ __forceinline__ int lds_byte(int r, int c) { const int st = (r >> 4) * 2 + (c >> 5), rr = r & 15, cc = c & 31, ob = rr * 64 + cc * 2; return st * 1024 + (ob ^ (((ob >> 9) & 1) << 5)); }
__host__ __device__ __forceinline__ void stage_rc(int b, int& R, int& C) { const int st = b / 1024, sb = b % 1024, swz = sb ^ (((sb >> 9) & 1) << 5); R = (st >> 1) * 16 + swz / 64; C = (st & 1) * 32 + (swz % 64) / 2; }
__host__ __device__ __forceinline__ int perm32(int rho) { const int n = rho >> 4, i = rho & 15; return 8 * (i >> 2) + 4 * n + (i & 3); }

struct Unit { int pm, pn; };
struct Gemm { const bf16_t* A; const bf16_t* Bt; int M, N, K; int rstep = 256; };

struct StaticOrder {
    int nM, nN, nwg, G, c;
    __host__ __device__ void init(int M, int N, int G_, int c_) { nM = M / BM; nN = N / BM; nwg = nM * nN; G = G_; c = c_; }
    __host__ __device__ bool next(int i, Unit& u) const {
        const long L = (long)i * G + c; if (L >= nwg) return false;
        int wgid = (int)L; { const int q = nwg / NXCD, r = nwg % NXCD, xcd = wgid % NXCD, off = wgid / NXCD; wgid = (xcd < r ? xcd * (q + 1) : r * (q + 1) + (xcd - r) * q) + off; }
        const int nig = WGM * nN, gid = wgid / nig, fm = gid * WGM, gsz = (nM - fm) < WGM ? (nM - fm) : WGM;
        u.pm = fm + ((wgid % nig) % gsz); u.pn = (wgid % nig) / gsz; return true;
    }
    __device__ __forceinline__ void a_ready(const Unit&) const {}
    __device__ __forceinline__ void done(const Unit&) const {}
};

__device__ __forceinline__ unsigned cvt_pk_bf16(float lo, float hi) { unsigned r; asm volatile("v_cvt_pk_bf16_f32 %0, %1, %2" : "=v"(r) : "v"(lo), "v"(hi)); return r; }
__device__ __forceinline__ float bflo(unsigned w) { return __uint_as_float(w << 16); }
__device__ __forceinline__ float bfhi(unsigned w) { return __uint_as_float(w & 0xffff0000u); }
__device__ __forceinline__ float sigm(float x) { return 1.0f / (1.0f + __expf(-x)); }
struct EpiStore {
    static constexpr bool PERM = true, AFTER_DRAIN = false;
    bf16_t* O; int ldc; const float* ssq;
    __device__ __forceinline__ void operator()(const f32x4 (&acc)[2][2][4][2], const Unit& u, int wr, int wc, int fr, int fq) const {
        const int row0 = u.pm * BM + wr * 64 + fr, col0 = u.pn * BM + wc * 32 + 8 * fq;
#pragma unroll
        for (int ai = 0; ai < 2; ++ai)
#pragma unroll
            for (int m = 0; m < 4; ++m) { const int row = row0 + ai * HALF + m * 16; bf16_t* rowp = O + (size_t)row * ldc + col0;
                const float sc = ssq ? rsqrtf(ssq[row] * (1.0f / 1024.0f) + 1e-6f) : 1.0f;
#pragma unroll
                for (int bj = 0; bj < 2; ++bj) { const f32x4 v0 = acc[ai][bj][m][0] * sc, v1 = acc[ai][bj][m][1] * sc;
                    u32x4 w; w.x = cvt_pk_bf16(v0[0], v0[1]); w.y = cvt_pk_bf16(v0[2], v0[3]); w.z = cvt_pk_bf16(v1[0], v1[1]); w.w = cvt_pk_bf16(v1[2], v1[3]);
                    *(u32x4*)(rowp + bj * HALF) = w; } }
    }
};
template <int ACCUM> struct EpiMerge {
    static constexpr bool PERM = true, AFTER_DRAIN = false;
    const bf16_t* gate; int ldg; bf16_t* O; int ldc;
    __device__ __forceinline__ void operator()(const f32x4 (&acc)[2][2][4][2], const Unit& u, int wr, int wc, int fr, int fq) const {
        const int row0 = u.pm * BM + wr * 64 + fr, col0 = u.pn * BM + wc * 32 + 8 * fq;
#pragma unroll
        for (int ai = 0; ai < 2; ++ai)
#pragma unroll
            for (int m = 0; m < 4; ++m) { const int row = row0 + ai * HALF + m * 16; bf16_t* rowp = O + (size_t)row * ldc + col0; const bf16_t* gp = gate + (size_t)row * ldg + col0;
#pragma unroll
                for (int bj = 0; bj < 2; ++bj) {
                    const u32x4 g = *(const u32x4*)(gp + bj * HALF);
                    f32x4 v0 = acc[ai][bj][m][0], v1 = acc[ai][bj][m][1];
                    v0[0] *= sigm(bflo(g.x)); v0[1] *= sigm(bfhi(g.x)); v0[2] *= sigm(bflo(g.y)); v0[3] *= sigm(bfhi(g.y));
                    v1[0] *= sigm(bflo(g.z)); v1[1] *= sigm(bfhi(g.z)); v1[2] *= sigm(bflo(g.w)); v1[3] *= sigm(bfhi(g.w));
                    if (ACCUM) { const u32x4 o = *(const u32x4*)(rowp + bj * HALF);
                        v0[0] += bflo(o.x); v0[1] += bfhi(o.x); v0[2] += bflo(o.y); v0[3] += bfhi(o.y);
                        v1[0] += bflo(o.z); v1[1] += bfhi(o.z); v1[2] += bflo(o.w); v1[3] += bfhi(o.w); }
                    u32x4 w; w.x = cvt_pk_bf16(v0[0], v0[1]); w.y = cvt_pk_bf16(v0[2], v0[3]); w.z = cvt_pk_bf16(v1[0], v1[1]); w.w = cvt_pk_bf16(v1[2], v1[3]);
                    *(u32x4*)(rowp + bj * HALF) = w; } }
    }
};
struct EpiWo {
    static constexpr bool PERM = true, AFTER_DRAIN = false;
    const float* xp; const float* xs; float* X1; bf16_t* X1B; float* ssq;
    __device__ __forceinline__ void operator()(const f32x4 (&acc)[2][2][4][2], const Unit& u, int wr, int wc, int fr, int fq) const {
        const int row0 = u.pm * BM + wr * 64 + fr, col0 = u.pn * BM + wc * 32 + 8 * fq;
#pragma unroll
        for (int ai = 0; ai < 2; ++ai)
#pragma unroll
            for (int m = 0; m < 4; ++m) { const int row = row0 + ai * HALF + m * 16;
                const float* xr = row < 16384 ? xp + (size_t)row * 1024 : (row < 16416 ? xs + (size_t)(row - 16384) * 1024 : nullptr);
                float ss = 0.f;
#pragma unroll
                for (int bj = 0; bj < 2; ++bj) { const int col = col0 + bj * HALF;
                    f32x4 x0 = (f32x4){0.f, 0.f, 0.f, 0.f}, x1 = x0;
                    if (xr) { x0 = *(const f32x4*)(xr + col); x1 = *(const f32x4*)(xr + col + 4); }
                    const f32x4 v0 = acc[ai][bj][m][0] + x0, v1 = acc[ai][bj][m][1] + x1;
                    *(f32x4*)(X1 + (size_t)row * 1024 + col) = v0; *(f32x4*)(X1 + (size_t)row * 1024 + col + 4) = v1;
                    u32x4 w; w.x = cvt_pk_bf16(v0[0], v0[1]); w.y = cvt_pk_bf16(v0[2], v0[3]); w.z = cvt_pk_bf16(v1[0], v1[1]); w.w = cvt_pk_bf16(v1[2], v1[3]);
                    *(u32x4*)(X1B + (size_t)row * 1024 + col) = w;
                    ss += (v0[0] * v0[0] + v0[1] * v0[1]) + (v0[2] * v0[2] + v0[3] * v0[3]) + (v1[0] * v1[0] + v1[1] * v1[1]) + (v1[2] * v1[2] + v1[3] * v1[3]); }
                ss += __shfl_xor(ss, 16); ss += __shfl_xor(ss, 32);
                if (fq == 0) atomicAdd(ssq + row, ss); }
    }
};
struct EpiDown {
    static constexpr bool PERM = true, AFTER_DRAIN = false;
    const float* X1; float* yp; float* ys;
    __device__ __forceinline__ void operator()(const f32x4 (&acc)[2][2][4][2], const Unit& u, int wr, int wc, int fr, int fq) const {
        const int row0 = u.pm * BM + wr * 64 + fr, col0 = u.pn * BM + wc * 32 + 8 * fq;
#pragma unroll
        for (int ai = 0; ai < 2; ++ai)
#pragma unroll
            for (int m = 0; m < 4; ++m) { const int row = row0 + ai * HALF + m * 16;
                float* yr = row < 16384 ? yp + (size_t)row * 1024 : (row < 16416 ? ys + (size_t)(row - 16384) * 1024 : nullptr);
                if (!yr) continue;
#pragma unroll
                for (int bj = 0; bj < 2; ++bj) { const int col = col0 + bj * HALF;
                    const f32x4 x0 = *(const f32x4*)(X1 + (size_t)row * 1024 + col), x1 = *(const f32x4*)(X1 + (size_t)row * 1024 + col + 4);
                    *(f32x4*)(yr + col) = acc[ai][bj][m][0] + x0; *(f32x4*)(yr + col + 4) = acc[ai][bj][m][1] + x1; } }
    }
};

__device__ __forceinline__ float gelu_tanh_e(float x) { const float u = 0.7978845608028654f * (x + 0.044715f * x * x * x); const float ex = __expf(2.0f * u); return 0.5f * x * (2.0f - 2.0f / (ex + 1.0f)); }
typedef unsigned u32x2_e __attribute__((ext_vector_type(2)));
struct EpiUpConv {
    static constexpr bool PERM = true, AFTER_DRAIN = false;
    bf16_t* ACT; const float* ssq; const float* cw; const float* cb; float* convp; PG8_LAS u32x4* xbuf;
    __device__ __forceinline__ void operator()(const f32x4 (&acc)[2][2][4][2], const Unit& u, int wr, int wc, int fr, int fq) const {
        constexpr int DFF_ = 2816, T_ = 8192, NTOK_ = 16384;
        const int base = 254 * u.pm, c0 = 128 * u.pn + 32 * wc + 8 * fq, lane = fq * 16 + fr;
        u32x4 gp[2][4]; float rs[2][4];
#pragma unroll
        for (int ai = 0; ai < 2; ++ai)
#pragma unroll
            for (int m = 0; m < 4; ++m) { const int t = base + ai * HALF + wr * 64 + m * 16 + fr;
                const float rsv = t < NTOK_ ? rsqrtf(ssq[t] * (1.0f / 1024.0f) + 1e-6f) : 0.f; rs[ai][m] = rsv;
                const f32x4 g0 = acc[ai][1][m][0] * rsv, g1 = acc[ai][1][m][1] * rsv;
                gp[ai][m].x = cvt_pk_bf16(g0[0], g0[1]); gp[ai][m].y = cvt_pk_bf16(g0[2], g0[3]); gp[ai][m].z = cvt_pk_bf16(g1[0], g1[1]); gp[ai][m].w = cvt_pk_bf16(g1[2], g1[3]); }
        if (fr >= 14) {
#pragma unroll
            for (int ai = 0; ai < 2; ++ai) xbuf[((ai * 2 + wr) * 2 + (fr - 14)) * 16 + 4 * wc + fq] = gp[ai][3]; }
        asm volatile("s_waitcnt lgkmcnt(0)" ::: "memory"); __builtin_amdgcn_s_barrier(); asm volatile("" ::: "memory");
#define ROR1(v) ((unsigned)__builtin_amdgcn_update_dpp(0, (int)(v), 0x121, 0xf, 0xf, false))
#define ROR2(v) ((unsigned)__builtin_amdgcn_update_dpp(0, (int)(v), 0x122, 0xf, 0xf, false))
#pragma unroll
        for (int hf = 0; hf < 2; ++hf) {
            const int ch = c0 + 4 * hf;
            const f32x4 w0 = *(const f32x4*)(cw + ch), w1 = *(const f32x4*)(cw + DFF_ + ch), w2 = *(const f32x4*)(cw + 2 * DFF_ + ch), bb = *(const f32x4*)(cb + ch);
#pragma unroll
            for (int ai = 0; ai < 2; ++ai)
#pragma unroll
                for (int m = 0; m < 4; ++m) { const int lr = ai * HALF + wr * 64 + m * 16 + fr, t = base + lr, tt = t & (T_ - 1), grp = ai * 2 + wr;
                    const unsigned cx = hf ? gp[ai][m].z : gp[ai][m].x, cy = hf ? gp[ai][m].w : gp[ai][m].y;
                    const unsigned sAx = ROR1(cx), sAy = ROR1(cy), sBx = ROR2(cx), sBy = ROR2(cy);
                    unsigned pAx = 0u, pAy = 0u, pBx = 0u, pBy = 0u;
                    if (m > 0) { const unsigned px = hf ? gp[ai][m > 0 ? m - 1 : 0].z : gp[ai][m > 0 ? m - 1 : 0].x, py = hf ? gp[ai][m > 0 ? m - 1 : 0].w : gp[ai][m > 0 ? m - 1 : 0].y;
                        pAx = ROR1(px); pAy = ROR1(py); pBx = ROR2(px); pBy = ROR2(py); }
                    else if (grp > 0) { const u32x4 xa = xbuf[((grp - 1) * 2 + 1) * 16 + 4 * wc + fq], xb = xbuf[((grp - 1) * 2 + (fr == 0 ? 0 : 1)) * 16 + 4 * wc + fq];
                        pAx = hf ? xa.z : xa.x; pAy = hf ? xa.w : xa.y; pBx = hf ? xb.z : xb.x; pBy = hf ? xb.w : xb.y; }
                    unsigned h1x = fr >= 1 ? sAx : pAx, h1y = fr >= 1 ? sAy : pAy, h2x = fr >= 2 ? sBx : pBx, h2y = fr >= 2 ? sBy : pBy;
                    if (tt == 0) { h1x = 0u; h1y = 0u; h2x = 0u; h2y = 0u; } else if (tt == 1) { h2x = 0u; h2y = 0u; }
                    const float rsv = rs[ai][m];
                    const f32x4 uu = acc[ai][0][m][hf] * rsv;
                    const f32x4 g2 = (f32x4){bflo(cx), bfhi(cx), bflo(cy), bfhi(cy)}, g1 = (f32x4){bflo(h1x), bfhi(h1x), bflo(h1y), bfhi(h1y)}, g0 = (f32x4){bflo(h2x), bfhi(h2x), bflo(h2y), bfhi(h2y)};
                    const f32x4 gc = bb + w0 * g0 + w1 * g1 + w2 * g2;
                    const bool live = t < NTOK_ && !(u.pm > 0 && lr < 2);
                    if (live) { u32x2_e w; w.x = cvt_pk_bf16(gelu_tanh_e(gc[0]) * uu[0], gelu_tanh_e(gc[1]) * uu[1]); w.y = cvt_pk_bf16(gelu_tanh_e(gc[2]) * uu[2], gelu_tanh_e(gc[3]) * uu[3]);
                        *(u32x2_e*)(ACT + (size_t)t * DFF_ + ch) = w;
                        if (tt >= T_ - 2) *(f32x4*)(convp + ((size_t)(t >> 13) * 2 + (tt - (T_ - 2))) * DFF_ + ch) = acc[ai][1][m][hf] * rsv; } }
        }
#undef ROR1
#undef ROR2
    }
};
template <class Epi, class Sched, bool ALIGN_EPI = false, bool SP2 = false>
__device__ __forceinline__ void gemm_phase(PG8_LAS unsigned char* lds, const Gemm g, const Sched& S, const Epi& E, const int wid) {
    unsigned z_ = 0u; asm volatile("" : "+v"(z_));
    const int lane = (int)__builtin_amdgcn_mbcnt_hi(~0u, __builtin_amdgcn_mbcnt_lo(~0u, z_)), tid = wid * 64 + lane, wr = wid >> 2, wc = wid & 3, fr = lane & 15, fq = lane >> 4;
    const int K = g.K, nt = K / BK;
    unsigned voffA[2], voffB[2];
#pragma unroll
    for (int i = 0; i < 2; ++i) { int R, C; stage_rc(tid * 16 + i * 8192, R, C); const int Rb = Epi::PERM ? ((R & ~31) + perm32(R & 31)) : R;
        voffA[i] = (unsigned)(R * K + C) * 2u; voffB[i] = (unsigned)(Rb * K + C) * 2u; }
    const size_t kstep = (size_t)(BK * 2);
    const size_t hstep = (size_t)HALF * K * 2;
    const size_t tstep = 2 * hstep;
    const size_t tstepA = (size_t)g.rstep * K * 2;
    const unsigned ldsw = (unsigned)wid * 1024u;
    const int aoff = lds_byte(wr * 64 + fr, fq * 8), boff = lds_byte(wc * 32 + fr, fq * 8);
#define PG8_SA(b, h) (((b) * 2 + (h)) * HTB)
#define PG8_SB(b, h) ((4 + (b) * 2 + (h)) * HTB)
#define PG8_STAGE(bufoff, gbase, voff) do { _Pragma("unroll") for (int _i = 0; _i < 2; ++_i) \
        __builtin_amdgcn_global_load_lds((const unsigned*)((const char*)(gbase) + (voff)[_i]), (PG8_LAS unsigned*)(lds + (bufoff) + ldsw + _i * 8192), 16, 0, 0); } while (0)
#define PG8_LDA(dst, b, h) do { _Pragma("unroll") for (int m = 0; m < 4; ++m) _Pragma("unroll") for (int k = 0; k < 2; ++k) dst[m][k] = *(const PG8_LAS bf16x8*)(lds + PG8_SA(b, h) + aoff + m * 2048 + k * 1024); } while (0)
#define PG8_LDB(dst, b, h) do { _Pragma("unroll") for (int n = 0; n < 2; ++n) _Pragma("unroll") for (int k = 0; k < 2; ++k) dst[n][k] = *(const PG8_LAS bf16x8*)(lds + PG8_SB(b, h) + boff + n * 2048 + k * 1024); } while (0)
#define PG8_MMA(ai, bj, At, Bt) do { __builtin_amdgcn_s_setprio(1); _Pragma("unroll") for (int m = 0; m < 4; ++m) _Pragma("unroll") for (int n = 0; n < 2; ++n) _Pragma("unroll") for (int k = 0; k < 2; ++k) \
        acc[ai][bj][m][n] = __builtin_amdgcn_mfma_f32_16x16x32_bf16(Bt[n][k], At[m][k], acc[ai][bj][m][n], 0, 0, 0); __builtin_amdgcn_s_setprio(0); } while (0)
#define PG8_WAIT_V(n) asm volatile("s_waitcnt vmcnt(" #n ")" ::: "memory")
#define PG8_WAIT_L(n) asm volatile("s_waitcnt lgkmcnt(" #n ")" ::: "memory")
#define PG8_BAR __builtin_amdgcn_s_barrier()
#define PG8_SCHED __builtin_amdgcn_sched_barrier(0)
    Unit cur, nxt; int ui = 0;
    if (!S.next(0, cur)) return;
    f32x4 acc[2][2][4][2];
#pragma unroll
    for (int a = 0; a < 2; ++a)
#pragma unroll
        for (int b = 0; b < 2; ++b)
#pragma unroll
            for (int m = 0; m < 4; ++m)
#pragma unroll
                for (int n = 0; n < 2; ++n) acc[a][b][m][n] = (f32x4){0.f, 0.f, 0.f, 0.f};
    bf16x8 At[4][2], B0[2][2], B1[2][2];
    const char* cA = (const char*)g.A + (size_t)cur.pm * tstepA; const char* cB = (const char*)g.Bt + (size_t)cur.pn * tstep;
    S.a_ready(cur);
    if constexpr (SP2) {
        PG8_STAGE(PG8_SB(0, 0), cB, voffB); PG8_STAGE(PG8_SB(0, 1), cB + hstep, voffB); PG8_STAGE(PG8_SA(0, 0), cA, voffA); PG8_STAGE(PG8_SA(0, 1), cA + hstep, voffA);
        if (wr == 1) PG8_BAR;
        PG8_WAIT_V(2); PG8_BAR;
        PG8_STAGE(PG8_SB(1, 0), cB + kstep, voffB); PG8_STAGE(PG8_SA(1, 0), cA + kstep, voffA); PG8_STAGE(PG8_SB(1, 1), cB + hstep + kstep, voffB);
        PG8_WAIT_V(6); PG8_BAR;
    } else {
        PG8_STAGE(PG8_SB(0, 0), cB, voffB); PG8_STAGE(PG8_SA(0, 0), cA, voffA); PG8_STAGE(PG8_SB(0, 1), cB + hstep, voffB); PG8_STAGE(PG8_SA(0, 1), cA + hstep, voffA);
        if (wr == 1) PG8_BAR;
        PG8_WAIT_V(4); PG8_BAR;
        PG8_STAGE(PG8_SB(1, 0), cB + kstep, voffB); PG8_STAGE(PG8_SA(1, 0), cA + kstep, voffA); PG8_STAGE(PG8_SB(1, 1), cB + hstep + kstep, voffB);
        PG8_WAIT_V(6); PG8_BAR;
    }
    for (;;) {
        const bool has_next = S.next(ui + 1, nxt);
        const char* nA = has_next ? (const char*)g.A + (size_t)nxt.pm * tstepA : cA; const char* nB = has_next ? (const char*)g.Bt + (size_t)nxt.pn * tstep : cB;
        for (int t = 0; t < nt; t += 2) {
            const bool last = (t == nt - 2);
            const char* a1 = cA + (size_t)(t + 1) * kstep;
            const char* a2 = last ? nA : cA + (size_t)(t + 2) * kstep; const char* b2 = last ? nB : cB + (size_t)(t + 2) * kstep;
            const char* a3 = a2 + kstep; const char* b3 = b2 + kstep;
            if (last && has_next) S.a_ready(nxt);
            if constexpr (SP2) {
            PG8_LDB(B0, 0, 0); PG8_LDB(B1, 0, 1); PG8_SCHED; PG8_LDA(At, 0, 0); PG8_STAGE(PG8_SA(1, 1), a1 + hstep, voffA);
            PG8_WAIT_V(8); PG8_WAIT_L(0); PG8_BAR; PG8_MMA(0, 0, At, B0); PG8_MMA(0, 1, At, B1); PG8_BAR; PG8_SCHED;
            PG8_LDA(At, 0, 1); PG8_STAGE(PG8_SB(0, 0), b2, voffB); PG8_STAGE(PG8_SB(0, 1), b2 + hstep, voffB); PG8_STAGE(PG8_SA(0, 0), a2, voffA);
            PG8_WAIT_V(8); PG8_WAIT_L(0); PG8_BAR; PG8_MMA(1, 0, At, B0); PG8_MMA(1, 1, At, B1); PG8_BAR; PG8_SCHED;
            PG8_LDB(B0, 1, 0); PG8_LDB(B1, 1, 1); PG8_SCHED; PG8_LDA(At, 1, 0); PG8_STAGE(PG8_SA(0, 1), a2 + hstep, voffA);
            PG8_WAIT_V(8); PG8_WAIT_L(0); PG8_BAR; PG8_MMA(0, 0, At, B0); PG8_MMA(0, 1, At, B1); PG8_BAR; PG8_SCHED;
            PG8_LDA(At, 1, 1); PG8_STAGE(PG8_SB(1, 0), b3, voffB); PG8_STAGE(PG8_SB(1, 1), b3 + hstep, voffB); PG8_STAGE(PG8_SA(1, 0), a3, voffA);
            PG8_WAIT_V(8); PG8_WAIT_L(0); PG8_BAR; PG8_MMA(1, 0, At, B0); PG8_MMA(1, 1, At, B1); PG8_BAR; PG8_SCHED;
            } else {
            PG8_LDB(B0, 0, 0); PG8_SCHED; PG8_LDA(At, 0, 0); PG8_STAGE(PG8_SA(1, 1), a1 + hstep, voffA);
            PG8_WAIT_L(8); PG8_BAR; PG8_WAIT_L(0); PG8_MMA(0, 0, At, B0); PG8_BAR; PG8_SCHED;
            PG8_LDB(B1, 0, 1); PG8_STAGE(PG8_SB(0, 0), b2, voffB);
            PG8_BAR; PG8_WAIT_L(0); PG8_MMA(0, 1, At, B1); PG8_BAR;
            PG8_LDA(At, 0, 1); PG8_STAGE(PG8_SA(0, 0), a2, voffA);
            PG8_BAR; PG8_WAIT_L(0); PG8_MMA(1, 0, At, B0); PG8_BAR; PG8_SCHED;
            PG8_STAGE(PG8_SB(0, 1), b2 + hstep, voffB);
            PG8_WAIT_V(6); PG8_BAR; PG8_MMA(1, 1, At, B1); PG8_BAR;
            PG8_LDB(B0, 1, 0); PG8_SCHED; PG8_LDA(At, 1, 0); PG8_STAGE(PG8_SA(0, 1), a2 + hstep, voffA);
            PG8_WAIT_L(8); PG8_BAR; PG8_WAIT_L(0); PG8_MMA(0, 0, At, B0); PG8_BAR; PG8_SCHED;
            PG8_LDB(B1, 1, 1); PG8_STAGE(PG8_SB(1, 0), b3, voffB);
            PG8_BAR; PG8_WAIT_L(0); PG8_MMA(0, 1, At, B1); PG8_BAR;
            PG8_LDA(At, 1, 1); PG8_STAGE(PG8_SA(1, 0), a3, voffA);
            PG8_BAR; PG8_WAIT_L(0); PG8_MMA(1, 0, At, B0); PG8_BAR; PG8_SCHED;
            PG8_STAGE(PG8_SB(1, 1), b3 + hstep, voffB);
            PG8_WAIT_V(6); PG8_BAR; PG8_MMA(1, 1, At, B1); PG8_BAR;
            }
        }
        if constexpr (ALIGN_EPI) { if (wr == 0) PG8_BAR; }
        if constexpr (!Epi::AFTER_DRAIN) { E(acc, cur, wr, wc, fr, fq); S.done(cur); }
        if (!has_next) break;
#pragma unroll
        for (int a = 0; a < 2; ++a)
#pragma unroll
            for (int b = 0; b < 2; ++b)
#pragma unroll
                for (int m = 0; m < 4; ++m)
#pragma unroll
                    for (int n = 0; n < 2; ++n) acc[a][b][m][n] = (f32x4){0.f, 0.f, 0.f, 0.f};
        cur = nxt; cA = nA; cB = nB; ++ui;
        if constexpr (ALIGN_EPI) { if (wr == 1) PG8_BAR; }
    }
    PG8_WAIT_V(0);
    if constexpr (!ALIGN_EPI) { if (wr == 0) PG8_BAR; }
    PG8_BAR;
    if constexpr (Epi::AFTER_DRAIN) { E.fused(acc, cur, wr, wc, fr, fq, lds, wid, lane); S.done(cur); }
#undef PG8_SA
#undef PG8_SB
#undef PG8_STAGE
#undef PG8_LDA
#undef PG8_LDB
#undef PG8_MMA
#undef PG8_WAIT_V
#undef PG8_WAIT_L
#undef PG8_BAR
#undef PG8_SCHED
}
}

typedef unsigned short bf16;
typedef short bf16x8 __attribute__((ext_vector_type(8)));
typedef short bf16x4 __attribute__((ext_vector_type(4)));
typedef float f32x4 __attribute__((ext_vector_type(4)));
typedef unsigned u32x4 __attribute__((ext_vector_type(4)));
typedef unsigned u32x2 __attribute__((ext_vector_type(2)));
#define LAS __attribute__((address_space(3)))
constexpr int NWAVES = 8, NTHR = 512;
constexpr int DM = 1024, T = 8192, NB = 2, NTOKP = NB * T, SB = 32, NTOK = NTOKP + SB, MPAD = 16640;
constexpr int DIN = 6440, DINP = 6656, DFF = 2816, DUP = 2 * DFF;
constexpr int C_Q = 0, C_KV = 512, C_G = 1280, C_GQ = 1304, C_GK = 1560, C_GV = 1816, C_LR = 2328, C_GR = 2344, C_XQ = 2856, C_MG = 3368;
constexpr float EPS = 1e-6f, LOG2E = 1.4426950408889634f;
constexpr float QSCALE = 0.125f * LOG2E;
constexpr float XSCALE = 0.08838834764831845f * LOG2E;
constexpr size_t O_Y = 0, O_YS = 16777216, O_KVP = O_YS + 32768, O_WINP = O_KVP + 8388608, O_GLAP = O_WINP + 262144, O_CONVP = O_GLAP + 65536,
                 O_MEMP = O_CONVP + 11264, O_KVS = O_MEMP + 524288, O_WINS = O_KVS + 16384, O_GLAS = O_WINS + 4194304, O_CONVS = O_GLAS + 1048576, O_END = O_CONVS + 180224;
enum { I_XP = 0, I_XS, I_CKV, I_CWIN, I_SGLA, I_SCONV, I_CMEM, I_PT, I_MEMP, I_GMIX, I_WIN, I_GNQ, I_GNK, I_CKPE, I_CKW1, I_CKW2, I_CVPE, I_CVW1, I_CVW2,
       I_RB, I_WGG, I_BGG, I_GGO, I_GMEM, I_WMEM, I_GXQ, I_GXK, I_WNSA, I_WGLA, I_WX, I_WO, I_GFFN, I_WUP, I_CONVW, I_CONVB, I_WDOWN, N_IN };
constexpr size_t al_(size_t x) { return (x + 255) & ~(size_t)255; }
constexpr size_t WS_SSQ = 0;
constexpr size_t WS_C0 = al_(WS_SSQ + (size_t)MPAD * 4);
constexpr size_t WS_WTIN = al_(WS_C0 + 1024);
constexpr size_t WS_WTMEM = al_(WS_WTIN + (size_t)DINP * 1024 * 2);
constexpr size_t WS_WTNSA = al_(WS_WTMEM + (size_t)1024 * 1024 * 2);
constexpr size_t WS_WTGLA = al_(WS_WTNSA + (size_t)1024 * 512 * 2);
constexpr size_t WS_WTX = al_(WS_WTGLA + (size_t)1024 * 512 * 2);
constexpr size_t WS_WTO = al_(WS_WTX + (size_t)1024 * 512 * 2);
constexpr size_t WS_WTUP = al_(WS_WTO + (size_t)1024 * 1024 * 2);
constexpr size_t WS_WTDOWN = al_(WS_WTUP + (size_t)DUP * 1024 * 2);
constexpr size_t WS_W1T = al_(WS_WTDOWN + (size_t)1024 * DFF * 2);
constexpr size_t WS_W2T = al_(WS_W1T + (size_t)2 * 64 * 2048 * 2);
constexpr size_t WS_XN = al_(WS_W2T + (size_t)2 * 64 * 64 * 2);
constexpr size_t WS_MN = al_(WS_XN + (size_t)MPAD * 1024 * 2);
constexpr size_t WS_PROJ = al_(WS_MN + (size_t)512 * 1024 * 2);
constexpr size_t WS_MEMPROJ = al_(WS_PROJ + (size_t)MPAD * DINP * 2);
constexpr size_t WS_QN = al_(WS_MEMPROJ + (size_t)512 * 1024 * 2);
constexpr size_t WS_KSEL = al_(WS_QN + (size_t)NTOK * 512 * 2);
constexpr size_t WS_VSELT = al_(WS_KSEL + (size_t)4 * T * 64 * 2);
constexpr size_t WS_KWIN = al_(WS_VSELT + (size_t)4 * T * 64 * 2);
constexpr size_t WS_VWINT = al_(WS_KWIN + (size_t)4 * T * 64 * 2);
constexpr size_t WS_GATES = al_(WS_VWINT + (size_t)4 * T * 64 * 2);
constexpr size_t WS_NEWKV = al_(WS_GATES + (size_t)NTOK * 24 * 4);
constexpr size_t WS_KCMP = al_(WS_NEWKV + (size_t)SB * 4 * 2 * 64 * 4);
constexpr size_t WS_VCMPT = al_(WS_KCMP + (size_t)4 * 512 * 64 * 2);
constexpr size_t WS_KCMPS = al_(WS_VCMPT + (size_t)4 * 512 * 64 * 2);
constexpr size_t WS_VCMPS = al_(WS_KCMPS + (size_t)SB * 2 * 512 * 64 * 4);
constexpr size_t WS_QTG = al_(WS_VCMPS + (size_t)SB * 2 * 512 * 64 * 4);
constexpr size_t WS_KTG = al_(WS_QTG + (size_t)NTOKP * 256 * 2);
constexpr size_t WS_VTG = al_(WS_KTG + (size_t)NTOKP * 256 * 2);
constexpr size_t WS_UP = al_(WS_VTG + (size_t)256 * 4 * 128 * 64 * 2);
constexpr size_t WS_DEC = al_(WS_UP + (size_t)256 * 4 * 128 * 64 * 4);
constexpr size_t WS_SC = al_(WS_DEC + (size_t)256 * 4 * 64 * 4);
constexpr size_t WS_XQ = al_(WS_SC + (size_t)256 * 4 * 128 * 64 * 2);
constexpr size_t WS_KMEM = al_(WS_XQ + (size_t)NTOK * 512 * 2);
constexpr size_t WS_VMEMT = al_(WS_KMEM + (size_t)8 * 256 * 128 * 2);
constexpr size_t WS_ONSA = al_(WS_VMEMT + (size_t)8 * 256 * 128 * 2);
constexpr size_t WS_OGLA = al_(WS_ONSA + (size_t)MPAD * 512 * 2);
constexpr size_t WS_OX = al_(WS_OGLA + (size_t)MPAD * 512 * 2);
constexpr size_t WS_MERGED = al_(WS_OX + (size_t)MPAD * 512 * 2);
constexpr size_t WS_X1 = al_(WS_MERGED + (size_t)MPAD * 1024 * 2);
constexpr size_t WS_X1B = al_(WS_X1 + (size_t)MPAD * 1024 * 4);
constexpr size_t WS_UG = al_(WS_X1B + (size_t)MPAD * 1024 * 2);
constexpr size_t WS_ACT = al_(WS_UG + (size_t)MPAD * DUP * 2);
constexpr size_t WS_MS = al_(WS_ACT + (size_t)MPAD * DFF * 2);
constexpr size_t WS_X1S = al_(WS_MS + (size_t)SB * 1024 * 4);
constexpr size_t WS_ONS = al_(WS_X1S + (size_t)SB * 1024 * 4);
constexpr size_t WS_PARK = al_(WS_ONS + (size_t)SB * 512 * 4);
constexpr size_t WS_CTL = al_(WS_PARK + (size_t)2048 * 4096);
constexpr size_t CTL_BYTES = 16384;
constexpr size_t WS_END = al_(WS_CTL + CTL_BYTES);
constexpr int RING_BYTES = 131072, LDS_BYTES = 155648;

struct Args { const float* in[N_IN]; float* out; unsigned char* ws; int ph_lo, ph_hi, sub, pad; };

__device__ __forceinline__ unsigned f2bf(float f) { unsigned u = __float_as_uint(f); return (u + 0x7fffu + ((u >> 16) & 1u)) >> 16; }
__device__ __forceinline__ unsigned pk2(float lo, float hi) { return pg8::cvt_pk_bf16(lo, hi); }
__device__ __forceinline__ float bf2f(unsigned short u) { return __uint_as_float((unsigned)u << 16); }
__device__ __forceinline__ float bflo(unsigned w) { return __uint_as_float(w << 16); }
__device__ __forceinline__ float bfhi(unsigned w) { return __uint_as_float(w & 0xffff0000u); }
__device__ __forceinline__ void unpack8(const u32x4 w, float (&f)[8]) { f[0] = bflo(w.x); f[1] = bfhi(w.x); f[2] = bflo(w.y); f[3] = bfhi(w.y); f[4] = bflo(w.z); f[5] = bfhi(w.z); f[6] = bflo(w.w); f[7] = bfhi(w.w); }
__device__ __forceinline__ u32x4 pack8(const float (&f)[8]) { u32x4 w; w.x = pk2(f[0], f[1]); w.y = pk2(f[2], f[3]); w.z = pk2(f[4], f[5]); w.w = pk2(f[6], f[7]); return w; }
__device__ __forceinline__ bf16x8 as_frag(u32x4 w) { return __builtin_bit_cast(bf16x8, w); }
__device__ __forceinline__ bf16x8 frag_pk(f32x4 a, f32x4 b) { u32x4 w; w.x = pk2(a[0], a[1]); w.y = pk2(a[2], a[3]); w.z = pk2(b[0], b[1]); w.w = pk2(b[2], b[3]); return as_frag(w); }
__device__ __forceinline__ bf16x8 ldfrag(const bf16* p) { return as_frag(*(const u32x4*)p); }
__device__ __forceinline__ bf16x8 ldfrag2(const bf16* p0, const bf16* p1) { const u32x2 a = *(const u32x2*)p0, b = *(const u32x2*)p1; u32x4 w; w.x = a.x; w.y = a.y; w.z = b.x; w.w = b.y; return as_frag(w); }
__device__ __forceinline__ bf16x8 ldfrag_f32(const float* p) { const f32x4 a = *(const f32x4*)p, b = *(const f32x4*)(p + 4); return frag_pk(a, b); }
#define MFMA16(a, b, c) __builtin_amdgcn_mfma_f32_16x16x32_bf16((a), (b), (c), 0, 0, 0)
__device__ __forceinline__ float sigmoidf_(float x) { return 1.0f / (1.0f + __expf(-x)); }
__device__ __forceinline__ float gelu_tanh(float x) { const float u = 0.7978845608028654f * (x + 0.044715f * x * x * x); const float e = __expf(2.0f * u); return 0.5f * x * (2.0f - 2.0f / (e + 1.0f)); }
__device__ __forceinline__ float wave_sum(float v) {
#pragma unroll
    for (int o = 1; o < 64; o <<= 1) v += __shfl_xor(v, o);
    return v;
}
__device__ __forceinline__ float wave_max(float v) {
#pragma unroll
    for (int o = 1; o < 64; o <<= 1) v = fmaxf(v, __shfl_xor(v, o));
    return v;
}
__device__ __forceinline__ float absmax_arr(const float* g, int n, int lane) { float m = 0.f; for (int i = lane; i < n; i += 64) m = fmaxf(m, fabsf(g[i])); return wave_max(m); }
__device__ __forceinline__ int t5_bucket(int n) {
    if (n < 16) return n;
    if (n >= 128) return 31;
    const int v = 16 + (int)(__logf((float)n * 0.0625f) / 2.0794415416798357f * 16.0f);
    return v < 31 ? v : 31;
}

#define XB_TMO      128
#define XB_XCNT(j)  (256  + 64 * (j))
#define XB_XSUB(j)  (1280 + 64 * (j))
#define XB_XGEN(j)  (2304 + 64 * (j))
#define XB_TOP      3328
#define XB_TOPGEN   3392
#define XCD_BAR_WORDS 3456
#define XB_SPIN_CAP (1u << 18)

__device__ __forceinline__ unsigned xb_ld(unsigned* p)              { return __hip_atomic_load(p, __ATOMIC_RELAXED, __HIP_MEMORY_SCOPE_AGENT); }
__device__ __forceinline__ unsigned xb_add(unsigned* p, unsigned v) { return __hip_atomic_fetch_add(p, v, __ATOMIC_RELAXED, __HIP_MEMORY_SCOPE_AGENT); }
__device__ __forceinline__ unsigned xb_xcc_id() { return (unsigned)__builtin_amdgcn_s_getreg((3 << 11) | 20) & 0xFu; }
#define XB_SPIN(cond, bar) do { unsigned _sp = 0; while (cond) { __builtin_amdgcn_s_sleep(1); \
    if ((++_sp & 255u) == 0u) { if (xb_ld(&(bar)[XB_TMO])) break; if (_sp > XB_SPIN_CAP) { atomicAdd(&(bar)[XB_TMO], 1u); break; } } } } while (0)

struct XcdBarrier {
    unsigned* bar; unsigned x;
    volatile LAS unsigned* st;
};

__device__ __forceinline__ XcdBarrier xcd_barrier_post(unsigned* bar, volatile LAS unsigned* st) {
    XcdBarrier b; b.bar = bar; b.x = xb_xcc_id(); b.st = st;
    if (threadIdx.x == 0) (void)xb_add(&bar[XB_XCNT(b.x)], 1u);
    return b;
}
__device__ __forceinline__ void xcd_barrier_complete(unsigned* bar, unsigned x, unsigned& nloc, unsigned& nx) {
    const unsigned G = gridDim.x * gridDim.y * gridDim.z;
    unsigned sum, cnt, mine, sp = 0u;
    for (;;) {
        sum = 0u; cnt = 0u; mine = 0u;
#pragma unroll
        for (unsigned j = 0; j < 16; ++j) { const unsigned c = xb_ld(&bar[XB_XCNT(j)]); sum += c; cnt += (c > 0u) ? 1u : 0u; mine = (j == x) ? c : mine; }
        if (sum == G) break;
        __builtin_amdgcn_s_sleep(1);
        if ((++sp & 255u) == 0u) { if (xb_ld(&bar[XB_TMO])) break; if (sp > XB_SPIN_CAP) { atomicAdd(&bar[XB_TMO], 1u); break; } }
    }
    nloc = mine > 0u ? mine : 1u; nx = cnt > 0u ? cnt : 1u;
}

__device__ __forceinline__ void xcd_barrier(const XcdBarrier& b) {
    asm volatile("s_waitcnt vmcnt(0)" ::: "memory");
    __syncthreads();
    if (threadIdx.x == 0) {
        unsigned* bar = b.bar;
        __builtin_amdgcn_s_waitcnt(0);
        unsigned nloc = b.st[0], nx = b.st[1];
        if (nloc == 0u) { xcd_barrier_complete(bar, b.x, nloc, nx); b.st[0] = nloc; b.st[1] = nx; }
        const unsigned old = xb_add(&bar[XB_XSUB(b.x)], 1u);
        const unsigned gen = old / nloc;
        if (old + 1u == (gen + 1u) * nloc) {
            __builtin_amdgcn_fence(__ATOMIC_RELEASE, "agent");
            asm volatile("s_waitcnt vmcnt(0)" ::: "memory");
            const unsigned og = xb_add(&bar[XB_TOP], 1u);
            const unsigned tg = og / nx;
            if (og + 1u == (tg + 1u) * nx) xb_add(&bar[XB_TOPGEN], 1u);
            else XB_SPIN(xb_ld(&bar[XB_TOPGEN]) == tg, bar);
            __builtin_amdgcn_fence(__ATOMIC_ACQUIRE, "agent");
            xb_add(&bar[XB_XGEN(b.x)], 1u);
            asm volatile("s_waitcnt vmcnt(0)" ::: "memory");
        } else {
            XB_SPIN(xb_ld(&bar[XB_XGEN(b.x)]) == gen, bar);
            __builtin_amdgcn_fence(__ATOMIC_ACQUIRE, "agent");
            asm volatile("s_waitcnt vmcnt(0)" ::: "memory");
        }
    }
    __syncthreads();
}

struct Frame {
    LAS unsigned char* lds;
    int wave, G, bid, gw, NGW;
    const float* const* in; float* out; unsigned char* ws;
};
#define WSP(T_, off) ((T_*)(F.ws + (off)))
__device__ __forceinline__ int lane_id_() { unsigned z = 0u; asm volatile("" : "+v"(z)); return (int)__builtin_amdgcn_mbcnt_hi(~0u, __builtin_amdgcn_mbcnt_lo(~0u, z)); }
#define LANE_ lane_id_()
#define TID_ (F.wave * 64 + lane_id_())

__device__ __host__ __forceinline__ int upmap(int n) { return n < 2816 ? (n >> 7) * 256 + (n & 127) : ((n - 2816) >> 7) * 256 + 128 + ((n - 2816) & 127); }
template <bool UPMAP = false>
__device__ __forceinline__ void transpose_item(const float* W, int K, int N, bf16* WT, const float* kscale, LAS float* scr, int item, int nblk, int lane) {
    const int kb = item / nblk, nb = item % nblk, k0 = 64 * kb, n0 = 32 * nb, n0d = UPMAP ? upmap(n0) : n0;
#pragma unroll
    for (int i = 0; i < 8; ++i) { const int kk = 8 * i + (lane >> 3); const int n = n0 + 4 * (lane & 7);
        f32x4 v = n < N ? *(const f32x4*)(W + (size_t)(k0 + kk) * N + n) : (f32x4){0.f, 0.f, 0.f, 0.f}; if (kscale) v = v * kscale[k0 + kk];
        LAS float* d = scr + kk * 33 + 4 * (lane & 7); d[0] = v[0]; d[1] = v[1]; d[2] = v[2]; d[3] = v[3]; }
    asm volatile("s_waitcnt lgkmcnt(0)" ::: "memory");
    const int c = lane & 7;
#pragma unroll
    for (int j = 0; j < 4; ++j) { const int n = (lane >> 3) + 8 * j; const LAS float* s = scr + (8 * c) * 33 + n;
        u32x4 o; o.x = pk2(s[0 * 33], s[1 * 33]); o.y = pk2(s[2 * 33], s[3 * 33]); o.z = pk2(s[4 * 33], s[5 * 33]); o.w = pk2(s[6 * 33], s[7 * 33]);
        *(u32x4*)(WT + (size_t)(n0d + n) * K + k0 + 8 * c) = o; }
    asm volatile("s_waitcnt lgkmcnt(0)" ::: "memory");
}
__device__ __forceinline__ void rms_row_to_bf16(const float* xrow, const float* g, bf16* orow, int lane) {
    unsigned long long* o8 = (unsigned long long*)orow + lane;
    if (!xrow) {
#pragma unroll
        for (int j = 0; j < 4; ++j) o8[64 * j] = 0ull;
        return; }
    const f32x4* xr = (const f32x4*)xrow + lane; const f32x4* gr = (const f32x4*)g + lane;
    f32x4 v[4]; float s = 0.f;
#pragma unroll
    for (int j = 0; j < 4; ++j) { v[j] = xr[64 * j]; s += (v[j].x * v[j].x + v[j].y * v[j].y) + (v[j].z * v[j].z + v[j].w * v[j].w); }
    const float rs = rsqrtf(wave_sum(s) * (1.f / 1024.f) + EPS);
#pragma unroll
    for (int j = 0; j < 4; ++j) { const f32x4 gg = gr[64 * j]; const f32x4 y = v[j] * rs * gg;
        o8[64 * j] = (unsigned long long)pk2(y.x, y.y) | ((unsigned long long)pk2(y.z, y.w) << 32); }
}
__device__ __forceinline__ void p0_prologue(Frame& F) {
    LAS float* scr = (LAS float*)(F.lds + F.wave * 16384);
    const int gw = F.gw, NGW = F.NGW;
    constexpr int IT_IN = 16 * 208, IT_MEM = 16 * 32, IT_BR = 8 * 32, IT_O = 16 * 32, IT_UP = 16 * 176, IT_DOWN = 44 * 32, IT_W1 = 32 * 2, IT_W2 = 1 * 2;
    constexpr int NITEMS = IT_IN + IT_MEM + 3 * IT_BR + IT_O + IT_UP + IT_DOWN + 2 * IT_W1 + 2 * IT_W2;
    const int ipw = (NITEMS + NGW - 1) / NGW;
    for (int it = gw * ipw; it < NITEMS && it < (gw + 1) * ipw; ++it) {
        int r = it;
        if (r < IT_UP) { transpose_item<true>(F.in[I_WUP], 1024, DUP, WSP(bf16, WS_WTUP), F.in[I_GFFN], scr, r, 176, LANE_); continue; } r -= IT_UP;
        if (r < IT_IN) { transpose_item(F.in[I_WIN], 1024, DIN, WSP(bf16, WS_WTIN), nullptr, scr, r, 208, LANE_); continue; } r -= IT_IN;
        if (r < IT_DOWN) { transpose_item(F.in[I_WDOWN], DFF, 1024, WSP(bf16, WS_WTDOWN), nullptr, scr, r, 32, LANE_); continue; } r -= IT_DOWN;
        if (r < IT_MEM) { transpose_item(F.in[I_WMEM], 1024, 1024, WSP(bf16, WS_WTMEM), nullptr, scr, r, 32, LANE_); continue; } r -= IT_MEM;
        if (r < IT_O) { transpose_item(F.in[I_WO], 1024, 1024, WSP(bf16, WS_WTO), nullptr, scr, r, 32, LANE_); continue; } r -= IT_O;
        if (r < IT_BR) { transpose_item(F.in[I_WNSA], 512, 1024, WSP(bf16, WS_WTNSA), nullptr, scr, r, 32, LANE_); continue; } r -= IT_BR;
        if (r < IT_BR) { transpose_item(F.in[I_WGLA], 512, 1024, WSP(bf16, WS_WTGLA), nullptr, scr, r, 32, LANE_); continue; } r -= IT_BR;
        if (r < IT_BR) { transpose_item(F.in[I_WX], 512, 1024, WSP(bf16, WS_WTX), nullptr, scr, r, 32, LANE_); continue; } r -= IT_BR;
        if (r < IT_W1) { transpose_item(F.in[I_CKW1], 2048, 64, WSP(bf16, WS_W1T), nullptr, scr, r, 2, LANE_); continue; } r -= IT_W1;
        if (r < IT_W1) { transpose_item(F.in[I_CVW1], 2048, 64, WSP(bf16, WS_W1T) + 64 * 2048, nullptr, scr, r, 2, LANE_); continue; } r -= IT_W1;
        if (r < IT_W2) { transpose_item(F.in[I_CKW2], 64, 64, WSP(bf16, WS_W2T), nullptr, scr, r, 2, LANE_); continue; } r -= IT_W2;
        transpose_item(F.in[I_CVW2], 64, 64, WSP(bf16, WS_W2T) + 64 * 64, nullptr, scr, r, 2, LANE_);
    }
    for (int m = gw; m < MPAD + 512; m += NGW) {
        if (m < MPAD) { const float* xr = m < NTOKP ? F.in[I_XP] + (size_t)m * 1024 : (m < NTOK ? F.in[I_XS] + (size_t)(m - NTOKP) * 1024 : nullptr);
            rms_row_to_bf16(xr, F.in[I_GMIX], WSP(bf16, WS_XN) + (size_t)m * 1024, LANE_); }
        else { const int mm = m - MPAD; rms_row_to_bf16(F.in[I_MEMP] + (size_t)mm * 1024, F.in[I_GMEM], WSP(bf16, WS_MN) + (size_t)mm * 1024, LANE_); }
    }
    { float* ssq = WSP(float, WS_SSQ); for (int i = F.bid * NTHR + TID_; i < MPAD; i += F.G * NTHR) ssq[i] = 0.f; }
    { float* ms = WSP(float, WS_MS); float* x1s = WSP(float, WS_X1S); const float* xs = F.in[I_XS];
      for (int i = F.bid * NTHR + TID_; i < SB * 1024; i += F.G * NTHR) { ms[i] = 0.f; x1s[i] = xs[i]; }
      float* ons = WSP(float, WS_ONS); for (int i = F.bid * NTHR + TID_; i < SB * 512; i += F.G * NTHR) ons[i] = 0.f; }
    { const f32x4* src = (const f32x4*)F.in[I_CWIN]; f32x4* dst = (f32x4*)(F.out + O_WINS);
      for (int i = F.bid * NTHR + TID_; i < SB * 511 * 64; i += F.G * NTHR) { const int b = i / (511 * 64), r = i % (511 * 64); dst[(size_t)b * 512 * 64 + r] = src[(size_t)b * 512 * 64 + 64 + r]; } }
}

struct TokRaw { u32x4 q, kva, kvb, xq; unsigned short g; };
__device__ __forceinline__ TokRaw p2_token_load(Frame& F, int tok) {
    const int lane = LANE_; const bf16* pr = WSP(bf16, WS_PROJ) + (size_t)tok * DINP; TokRaw r;
    r.q = *(const u32x4*)(pr + C_Q + 8 * lane); r.kva = *(const u32x4*)(pr + C_KV + 8 * lane); r.kvb = *(const u32x4*)(pr + C_KV + 512 + 8 * lane);
    r.xq = *(const u32x4*)(pr + C_XQ + 8 * lane); r.g = pr[C_G + (lane < 24 ? lane : 0)]; return r; }
__device__ __forceinline__ void p2_token(Frame& F, int tok, const TokRaw& raw) {
    const int lane = LANE_;
    const bool prompt = tok < NTOKP; const int b = tok >> 13, t = tok & (T - 1), sb = tok - NTOKP;
    float f[8];
    { unpack8(raw.q, f); float ss = 0.f;
#pragma unroll
      for (int i = 0; i < 8; ++i) ss += f[i] * f[i];
      ss += __shfl_xor(ss, 1); ss += __shfl_xor(ss, 2); ss += __shfl_xor(ss, 4);
      const float rs = rsqrtf(ss * (1.f / 64.f) + EPS) * QSCALE; const float* g = F.in[I_GNQ] + 8 * (lane & 7);
#pragma unroll
      for (int i = 0; i < 8; ++i) f[i] *= rs * g[i];
      *(u32x4*)(WSP(bf16, WS_QN) + (size_t)tok * 512 + 8 * lane) = pack8(f); }
    { unpack8(raw.kva, f); float ss = 0.f;
#pragma unroll
      for (int i = 0; i < 8; ++i) ss += f[i] * f[i];
      ss += __shfl_xor(ss, 1); ss += __shfl_xor(ss, 2); ss += __shfl_xor(ss, 4);
      const int grp = lane >> 3, slot = grp >> 1, kv = grp & 1, d0 = 8 * (lane & 7);
      if (slot == 2) { const float rs = rsqrtf(ss * (1.f / 64.f) + EPS); const float* g = F.in[I_GNK] + 64 + d0;
#pragma unroll
          for (int i = 0; i < 8; ++i) f[i] *= rs * g[i]; }
      float* orow = prompt ? F.out + O_KVP + (size_t)tok * 512 + 8 * lane : F.out + O_KVS + (size_t)sb * 512 + 8 * lane;
      *(f32x4*)orow = (f32x4){f[0], f[1], f[2], f[3]}; *(f32x4*)(orow + 4) = (f32x4){f[4], f[5], f[6], f[7]};
      if (prompt) {
          if (slot == 2) *(u32x4*)(WSP(bf16, WS_KSEL) + ((size_t)(b * 2 + kv) * T + t) * 64 + d0) = pack8(f);
          if (slot == 3) { bf16* vt = WSP(bf16, WS_VSELT) + (((size_t)(b * 2 + kv) * 128 + (t >> 6)) * 64 + d0) * 64 + (t & 63);
#pragma unroll
              for (int i = 0; i < 8; ++i) vt[i * 64] = (bf16)f2bf(f[i]); }
      } else if (slot >= 2) { float* nk = WSP(float, WS_NEWKV) + ((size_t)(sb * 4 + (slot - 2)) * 2 + kv) * 64 + d0;
#pragma unroll
          for (int i = 0; i < 8; ++i) nk[i] = f[i]; }
    }
    { unpack8(raw.kvb, f); float ss = 0.f;
#pragma unroll
      for (int i = 0; i < 8; ++i) ss += f[i] * f[i];
      ss += __shfl_xor(ss, 1); ss += __shfl_xor(ss, 2); ss += __shfl_xor(ss, 4);
      const int grp = lane >> 3, slot = 4 + (grp >> 1), kv = grp & 1, d0 = 8 * (lane & 7);
      if (lane < 32) {
          if (slot == 4) { const float rs = rsqrtf(ss * (1.f / 64.f) + EPS); const float* g = F.in[I_GNK] + 128 + d0;
#pragma unroll
              for (int i = 0; i < 8; ++i) f[i] *= rs * g[i]; }
          if (prompt) {
              if (slot == 4) *(u32x4*)(WSP(bf16, WS_KWIN) + ((size_t)(b * 2 + kv) * T + t) * 64 + d0) = pack8(f);
              else { bf16* vt = WSP(bf16, WS_VWINT) + (((size_t)(b * 2 + kv) * 128 + (t >> 6)) * 64 + d0) * 64 + (t & 63);
#pragma unroll
                  for (int i = 0; i < 8; ++i) vt[i * 64] = (bf16)f2bf(f[i]); }
              if (t >= T - 512) { float* orow = F.out + O_WINP + ((size_t)b * 512 + (t - (T - 512))) * 256 + 8 * lane;
                  *(f32x4*)orow = (f32x4){f[0], f[1], f[2], f[3]}; *(f32x4*)(orow + 4) = (f32x4){f[4], f[5], f[6], f[7]}; }
          } else {
              float* nk = WSP(float, WS_NEWKV) + ((size_t)(sb * 4 + (slot - 2)) * 2 + kv) * 64 + d0;
#pragma unroll
              for (int i = 0; i < 8; ++i) nk[i] = f[i];
              float* orow = F.out + O_WINS + ((size_t)sb * 512 + 511) * 256 + 8 * lane;
              *(f32x4*)orow = (f32x4){f[0], f[1], f[2], f[3]}; *(f32x4*)(orow + 4) = (f32x4){f[4], f[5], f[6], f[7]};
          }
      }
    }
    if (lane < 24) WSP(float, WS_GATES)[(size_t)tok * 24 + lane] = sigmoidf_(bf2f(raw.g));
    { unpack8(raw.xq, f); float ss = 0.f;
#pragma unroll
      for (int i = 0; i < 8; ++i) ss += f[i] * f[i];
      ss += __shfl_xor(ss, 1); ss += __shfl_xor(ss, 2); ss += __shfl_xor(ss, 4); ss += __shfl_xor(ss, 8);
      const float rs = rsqrtf(ss * (1.f / 128.f) + EPS) * XSCALE; const float* g = F.in[I_GXQ] + 8 * (lane & 15);
#pragma unroll
      for (int i = 0; i < 8; ++i) f[i] *= rs * g[i];
      *(u32x4*)(WSP(bf16, WS_XQ) + (size_t)tok * 512 + 8 * lane) = pack8(f); }
}
__device__ __forceinline__ void p2_memrow(Frame& F, int row) {
    const int lane = LANE_, b = row >> 8, m = row & 255, head = lane >> 4, d0 = 8 * (lane & 15);
    const bf16* pr = WSP(bf16, WS_MEMPROJ) + (size_t)row * 1024; float f[8];
    { unpack8(*(const u32x4*)(pr + 8 * lane), f); float ss = 0.f;
#pragma unroll
      for (int i = 0; i < 8; ++i) ss += f[i] * f[i];
      ss += __shfl_xor(ss, 1); ss += __shfl_xor(ss, 2); ss += __shfl_xor(ss, 4); ss += __shfl_xor(ss, 8);
      const float rs = rsqrtf(ss * (1.f / 128.f) + EPS); const float* g = F.in[I_GXK] + d0;
#pragma unroll
      for (int i = 0; i < 8; ++i) f[i] *= rs * g[i];
      float* orow = F.out + O_MEMP + ((size_t)row * 2 + 0) * 512 + 8 * lane;
      *(f32x4*)orow = (f32x4){f[0], f[1], f[2], f[3]}; *(f32x4*)(orow + 4) = (f32x4){f[4], f[5], f[6], f[7]};
      *(u32x4*)(WSP(bf16, WS_KMEM) + ((size_t)(b * 4 + head) * 256 + m) * 128 + d0) = pack8(f); }
    { unpack8(*(const u32x4*)(pr + 512 + 8 * lane), f);
      float* orow = F.out + O_MEMP + ((size_t)row * 2 + 1) * 512 + 8 * lane;
      *(f32x4*)orow = (f32x4){f[0], f[1], f[2], f[3]}; *(f32x4*)(orow + 4) = (f32x4){f[4], f[5], f[6], f[7]};
      bf16* vt = WSP(bf16, WS_VMEMT) + ((size_t)(b * 4 + head) * 128 + d0) * 256 + m;
#pragma unroll
      for (int i = 0; i < 8; ++i) vt[i * 256] = (bf16)f2bf(f[i]); }
}

constexpr int CMP_TASKS_S = SB * 2 * 2, CMP_TASKS_P = NB * 2 * 2;
__device__ __forceinline__ int cmp_tile_off16(int row, int c16) { return row * 128 + ((c16 ^ (row & 7)) << 4); }
__device__ __forceinline__ void p2_compress(Frame& F, int task) {
    const int lane = LANE_, r = lane & 15, q = lane >> 4, w = F.wave, tid_ = w * 64 + lane;
    const bool smp = task < CMP_TASKS_S; const int x = smp ? task : task - CMP_TASKS_S;
    const int b = x >> 2, kv = (x >> 1) & 1, slot = x & 1, i0 = 64 * w;
    const bf16* W1t = WSP(bf16, WS_W1T) + (size_t)slot * 64 * 2048;
    const bf16* W2t = WSP(bf16, WS_W2T) + (size_t)slot * 64 * 64;
    const int* pt = (const int*)F.in[I_PT] + b * 64;
    const float* ckv = F.in[I_CKV]; const float* pe = F.in[slot ? I_CVPE : I_CKPE];
    const bf16* proj = WSP(bf16, WS_PROJ);
    LAS unsigned char* wb = F.lds;
    const int srow = tid_ >> 3, sc16 = tid_ & 7, soff = cmp_tile_off16(srow, sc16);
    int kb0[2]; kb0[0] = r * 128 + (((0 + q) ^ (r & 7)) << 4); kb0[1] = r * 128 + (((4 + q) ^ (r & 7)) << 4);
    f32x4 acc[4][4];
#pragma unroll
    for (int nt = 0; nt < 4; ++nt)
#pragma unroll
        for (int it = 0; it < 4; ++it) acc[nt][it] = (f32x4){0.f, 0.f, 0.f, 0.f};
    const bf16* wsrc = W1t + (size_t)srow * 2048 + sc16 * 8;
    u32x4 rw = *(const u32x4*)wsrc;
    LAS unsigned char* xt = F.lds + 16384 + w * 8192;
    u32x4 xr[16];
    const int xrow = smp ? (lane >> 4) : (lane >> 3), xch = smp ? (lane & 15) : (lane & 7);
#define CMP_LOAD_ROWS(KP) do { if (smp) { _Pragma("unroll") for (int i = 0; i < 16; ++i) { const int ib = i0 + 4 * i + xrow; int tok = 16 * ib + (KP); tok = tok < T ? tok : T - 1; \
            const int page = pt[tok >> 7]; xr[i] = *(const u32x4*)(ckv + (((size_t)page * 128 + (tok & 127)) * 4 + slot) * 128 + kv * 64 + 4 * xch); } } \
        else { _Pragma("unroll") for (int i = 0; i < 8; ++i) { const int ib = i0 + 8 * i + xrow; int tok = 16 * ib + (KP); tok = tok < T ? tok : T - 1; \
            xr[i] = *(const u32x4*)(proj + ((size_t)b * T + tok) * DINP + C_KV + slot * 128 + kv * 64 + 8 * xch); } } } while (0)
    CMP_LOAD_ROWS(0);
    __syncthreads();
#pragma unroll 1
    for (int kp = 0; kp < 32; ++kp) {
        if (smp) { const f32x4 p4 = *(const f32x4*)(pe + 64 * kp + 4 * xch);
#pragma unroll
            for (int i = 0; i < 16; ++i) { const f32x4 v = __builtin_bit_cast(f32x4, xr[i]) + p4; u32x2 wv; wv.x = pk2(v[0], v[1]); wv.y = pk2(v[2], v[3]);
                const int row = 4 * i + xrow; *(LAS u32x2*)(xt + cmp_tile_off16(row, xch >> 1) + 8 * (xch & 1)) = wv; } }
        else { const f32x4 p0 = *(const f32x4*)(pe + 64 * kp + 8 * xch), p1 = *(const f32x4*)(pe + 64 * kp + 8 * xch + 4);
#pragma unroll
            for (int i = 0; i < 8; ++i) { float f8[8]; unpack8(xr[i], f8);
                u32x4 wv; wv.x = pk2(f8[0] + p0[0], f8[1] + p0[1]); wv.y = pk2(f8[2] + p0[2], f8[3] + p0[3]); wv.z = pk2(f8[4] + p1[0], f8[5] + p1[1]); wv.w = pk2(f8[6] + p1[2], f8[7] + p1[3]);
                const int row = 8 * i + xrow; *(LAS u32x4*)(xt + cmp_tile_off16(row, xch)) = wv; } }
        if (kp + 1 < 32) CMP_LOAD_ROWS(kp + 1);
        *(LAS u32x4*)(wb + (kp & 1) * 8192 + soff) = rw;
        __syncthreads();
        if (kp + 1 < 32) rw = *(const u32x4*)(wsrc + 64 * (kp + 1));
        LAS const unsigned char* wt = wb + (kp & 1) * 8192;
#pragma unroll
        for (int ks2 = 0; ks2 < 2; ++ks2) {
            bf16x8 xf[4];
#pragma unroll
            for (int it = 0; it < 4; ++it) xf[it] = as_frag(*(LAS const u32x4*)(xt + kb0[ks2] + it * 2048));
#pragma unroll
            for (int nt = 0; nt < 4; ++nt) { const bf16x8 a = as_frag(*(LAS const u32x4*)(wt + kb0[ks2] + nt * 2048));
#pragma unroll
                for (int it = 0; it < 4; ++it) acc[nt][it] = MFMA16(a, xf[it], acc[nt][it]); } }
        asm volatile("s_waitcnt lgkmcnt(0)" ::: "memory");
    }
#undef CMP_LOAD_ROWS
    const float* gk0 = F.in[I_GNK];
#pragma unroll
    for (int it = 0; it < 4; ++it) {
        f32x4 g[4];
#pragma unroll
        for (int nt = 0; nt < 4; ++nt)
#pragma unroll
            for (int i = 0; i < 4; ++i) g[nt][i] = gelu_tanh(acc[nt][it][i]);
        const bf16x8 b0 = frag_pk(g[0], g[1]), b1 = frag_pk(g[2], g[3]);
        f32x4 o[4]; float ss = 0.f;
#pragma unroll
        for (int mt = 0; mt < 4; ++mt) { const bf16* wr = W2t + (size_t)(16 * mt + r) * 64 + 4 * q;
            o[mt] = MFMA16(ldfrag2(wr, wr + 16), b0, ((f32x4){0.f, 0.f, 0.f, 0.f}));
            o[mt] = MFMA16(ldfrag2(wr + 32, wr + 48), b1, o[mt]);
            ss += (o[mt][0] * o[mt][0] + o[mt][1] * o[mt][1]) + (o[mt][2] * o[mt][2] + o[mt][3] * o[mt][3]); }
        ss += __shfl_xor(ss, 16); ss += __shfl_xor(ss, 32);
        if (slot == 0) { const float rs = rsqrtf(ss * (1.f / 64.f) + EPS);
#pragma unroll
            for (int mt = 0; mt < 4; ++mt) { const f32x4 gg = *(const f32x4*)(gk0 + 16 * mt + 4 * q); o[mt] = o[mt] * rs * gg; } }
        const int i = i0 + 16 * it + r;
        if (smp) { float* dst = WSP(float, slot ? WS_VCMPS : WS_KCMPS) + ((size_t)(b * 2 + kv) * 512 + i) * 64 + 4 * q;
#pragma unroll
            for (int mt = 0; mt < 4; ++mt) *(f32x4*)(dst + 16 * mt) = o[mt]; }
        else if (slot == 0) { bf16* dst = WSP(bf16, WS_KCMP) + ((size_t)(b * 2 + kv) * 512 + i) * 64 + 4 * q;
#pragma unroll
            for (int mt = 0; mt < 4; ++mt) { u32x2 wv; wv.x = pk2(o[mt][0], o[mt][1]); wv.y = pk2(o[mt][2], o[mt][3]); *(u32x2*)(dst + 16 * mt) = wv; } }
        else { bf16* dst = WSP(bf16, WS_VCMPT) + ((size_t)(b * 2 + kv) * 64 + 4 * q) * 512 + i;
#pragma unroll
            for (int mt = 0; mt < 4; ++mt)
#pragma unroll
                for (int e = 0; e < 4; ++e) dst[(size_t)(16 * mt + e) * 512] = (bf16)f2bf(o[mt][e]); }
    }
}

__device__ __forceinline__ int swz64(int row, int col) { return row * 64 + ((((col >> 3) ^ (row & 7)) << 3) | (col & 7)); }
__device__ __forceinline__ float log_sigmoid_(float z) { return fminf(z, 0.f) - __logf(1.0f + __expf(-fabsf(z))); }
__device__ __forceinline__ void p2_gla_chunk(Frame& F, int bc) {
    const int lane = LANE_, r = lane & 15, q = lane >> 4, h = F.wave >> 1, eh = F.wave & 1;
    LAS bf16* ktT = (LAS bf16*)(F.lds + F.wave * 16384);
    LAS bf16* vT = ktT + 4096;
    const bf16* proj = WSP(bf16, WS_PROJ) + (size_t)bc * 64 * DINP;
    float wg[16];
#pragma unroll
    for (int j = 0; j < 16; ++j) wg[j] = F.in[I_WGG][j * 256 + h * 64 + lane];
    const float bg = F.in[I_BGG][h * 64 + lane];
    bf16* qtg = WSP(bf16, WS_QTG) + (size_t)bc * 64 * 256 + h * 64 + lane;
    bf16* ktg = WSP(bf16, WS_KTG) + (size_t)bc * 64 * 256 + h * 64 + lane;
    LAS float* lrs = (LAS float*)(F.lds + RING_BYTES);
    { const int tid_ = F.wave * 64 + lane; if (tid_ < 128) { float f8[8]; unpack8(*(const u32x4*)(proj + (size_t)(tid_ >> 1) * DINP + C_LR + 8 * (tid_ & 1)), f8);
#pragma unroll
        for (int i = 0; i < 8; ++i) lrs[(tid_ >> 1) * 16 + 8 * (tid_ & 1) + i] = f8[i]; } }
    __syncthreads();
    float cb = 0.f;
    bf16 kr[16], qr[16], vr[16], kn[16], qn[16], vn[16];
#pragma unroll
    for (int i = 0; i < 16; ++i) { const bf16* pr = proj + (size_t)i * DINP; kr[i] = pr[C_GK + h * 64 + lane]; qr[i] = pr[C_GQ + h * 64 + lane]; vr[i] = pr[C_GV + h * 128 + eh * 64 + lane]; }
#pragma unroll 1
    for (int tb = 0; tb < 4; ++tb) {
        const int tn = tb < 3 ? tb + 1 : 3;
#pragma unroll
        for (int i = 0; i < 16; ++i) { const bf16* pr = proj + (size_t)(16 * tn + i) * DINP; kn[i] = pr[C_GK + h * 64 + lane]; qn[i] = pr[C_GQ + h * 64 + lane]; vn[i] = pr[C_GV + h * 128 + eh * 64 + lane]; }
#pragma unroll
        for (int i = 0; i < 16; ++i) { const int t = 16 * tb + i;
            float z = bg;
#pragma unroll
            for (int j4 = 0; j4 < 4; ++j4) { const f32x4 l4 = *(LAS const f32x4*)(lrs + t * 16 + 4 * j4); z += l4[0] * wg[4 * j4] + l4[1] * wg[4 * j4 + 1] + l4[2] * wg[4 * j4 + 2] + l4[3] * wg[4 * j4 + 3]; }
            cb += log_sigmoid_(z) * 0.0625f;
            const float kk = bf2f(kr[i]) * __expf(-cb);
            const float qq = bf2f(qr[i]) * 0.125f * __expf(cb);
            const bf16 kb = (bf16)f2bf(kk);
            if (eh == 0) { qtg[(size_t)t * 256] = (bf16)f2bf(qq); ktg[(size_t)t * 256] = kb; }
            ktT[swz64(lane, t)] = kb;
            const bf16 vv = vr[i];
            vT[swz64(lane, t)] = vv; }
#pragma unroll
        for (int i = 0; i < 16; ++i) { kr[i] = kn[i]; qr[i] = qn[i]; vr[i] = vn[i]; }
    }
    const float dec = __expf(cb);
    if (eh == 0) WSP(float, WS_DEC)[(size_t)(bc * 4 + h) * 64 + lane] = dec;
    asm volatile("s_waitcnt lgkmcnt(0)" ::: "memory");
    {
        bf16* vrow = WSP(bf16, WS_VTG) + ((size_t)(bc * 4 + h) * 128 + eh * 64) * 64;
#pragma unroll
        for (int i = 0; i < 8; ++i) { const int e = 8 * i + (lane >> 3), c8 = lane & 7;
            *(u32x4*)(vrow + (size_t)e * 64 + c8 * 8) = *(const LAS u32x4*)(vT + swz64(e, c8 * 8)); } }
    f32x4 acc[4][4];
#pragma unroll
    for (int et = 0; et < 4; ++et)
#pragma unroll
        for (int dt = 0; dt < 4; ++dt) acc[et][dt] = (f32x4){0.f, 0.f, 0.f, 0.f};
#pragma unroll
    for (int ks = 0; ks < 2; ++ks) {
        bf16x8 bfr[4];
#pragma unroll
        for (int dt = 0; dt < 4; ++dt) bfr[dt] = as_frag(*(const LAS u32x4*)(ktT + swz64(16 * dt + r, 32 * ks + 8 * q)));
#pragma unroll
        for (int et = 0; et < 4; ++et) { const bf16x8 a = as_frag(*(const LAS u32x4*)(vT + swz64(16 * et + r, 32 * ks + 8 * q)));
#pragma unroll
            for (int dt = 0; dt < 4; ++dt) acc[et][dt] = MFMA16(a, bfr[dt], acc[et][dt]); }
    }
    float* up = WSP(float, WS_UP) + ((size_t)(bc * 4 + h) * 128 + eh * 64) * 64;
#pragma unroll
    for (int dt = 0; dt < 4; ++dt) { const float dd = __shfl(dec, 16 * dt + r);
#pragma unroll
        for (int et = 0; et < 4; ++et)
#pragma unroll
            for (int i = 0; i < 4; ++i) up[(size_t)(16 * et + 4 * q + i) * 64 + 16 * dt + r] = acc[et][dt][i] * dd; }
}

__device__ __forceinline__ void p2_gla_sample(Frame& F, int task) {
    const int lane = LANE_, b = task >> 2, h = task & 3, tok = NTOKP + b;
    const bf16* pr = WSP(bf16, WS_PROJ) + (size_t)tok * DINP;
    LAS float* sh = (LAS float*)(F.lds + F.wave * 16384);
    { float z = F.in[I_BGG][h * 64 + lane];
#pragma unroll
      for (int j = 0; j < 16; ++j) z += bf2f(pr[C_LR + j]) * F.in[I_WGG][j * 256 + h * 64 + lane];
      sh[lane] = __expf(log_sigmoid_(z) * 0.0625f); sh[64 + lane] = bf2f(pr[C_GK + h * 64 + lane]); sh[128 + lane] = bf2f(pr[C_GQ + h * 64 + lane]) * 0.125f; }
    asm volatile("s_waitcnt lgkmcnt(0)" ::: "memory");
    const float v0 = bf2f(pr[C_GV + h * 128 + lane]), v1 = bf2f(pr[C_GV + h * 128 + 64 + lane]);
    const float* s0 = F.in[I_SGLA] + (size_t)(b * 4 + h) * 64 * 128; float* s1 = F.out + O_GLAS + (size_t)(b * 4 + h) * 64 * 128;
    float o0 = 0.f, o1 = 0.f;
#pragma unroll 4
    for (int d = 0; d < 64; ++d) { const float a = sh[d], k = sh[64 + d], qq = sh[128 + d];
        const float n0 = a * s0[d * 128 + lane] + k * v0, n1 = a * s0[d * 128 + 64 + lane] + k * v1;
        s1[d * 128 + lane] = n0; s1[d * 128 + 64 + lane] = n1; o0 += qq * n0; o1 += qq * n1; }
    const float rs = rsqrtf(wave_sum(o0 * o0 + o1 * o1) * (1.f / 128.f) + EPS);
    const float r0 = bf2f(pr[C_GR + h * 128 + lane]), r1 = bf2f(pr[C_GR + h * 128 + 64 + lane]);
    bf16* og = WSP(bf16, WS_OGLA) + (size_t)tok * 512 + h * 128;
    og[lane] = (bf16)f2bf(o0 * rs * F.in[I_GGO][lane] * r0 * sigmoidf_(r0));
    og[64 + lane] = (bf16)f2bf(o1 * rs * F.in[I_GGO][64 + lane] * r1 * sigmoidf_(r1));
}

__device__ __forceinline__ void p3_gla_scan(Frame& F, int task) {
    const int lane = LANE_, b = task >> 9, h = (task >> 7) & 3, e = task & 127;
    const float* up = WSP(float, WS_UP); const float* dec = WSP(float, WS_DEC); bf16* sc = WSP(bf16, WS_SC);
    float S = 0.f;
#pragma unroll 1
    for (int c0 = 0; c0 < 128; c0 += 32) {
        float uu[32], dd[32];
#pragma unroll
        for (int i = 0; i < 32; ++i) { const int bc = b * 128 + c0 + i; uu[i] = up[((size_t)(bc * 4 + h) * 128 + e) * 64 + lane]; dd[i] = dec[(size_t)(bc * 4 + h) * 64 + lane]; }
#pragma unroll
        for (int i = 0; i < 32; ++i) { const int bc = b * 128 + c0 + i; sc[((size_t)(bc * 4 + h) * 128 + e) * 64 + lane] = (bf16)f2bf(S); S = dd[i] * S + uu[i]; } }
    F.out[O_GLAP + ((size_t)(b * 4 + h) * 64 + lane) * 128 + e] = S;
}

__device__ __forceinline__ void p4_gla_out(Frame& F, int task) {
    const int lane = LANE_, r = lane & 15, q = lane >> 4, bc = task >> 4, h = (task >> 2) & 3, tt = task & 3;
    const bf16* qtg = WSP(bf16, WS_QTG) + (size_t)bc * 64 * 256 + h * 64;
    const bf16* ktg = WSP(bf16, WS_KTG) + (size_t)bc * 64 * 256 + h * 64;
    const bf16* vtg = WSP(bf16, WS_VTG) + (size_t)(bc * 4 + h) * 128 * 64;
    const bf16* sc = WSP(bf16, WS_SC) + (size_t)(bc * 4 + h) * 128 * 64;
    const bf16* proj = WSP(bf16, WS_PROJ) + (size_t)bc * 64 * DINP;
    bf16* og = WSP(bf16, WS_OGLA) + (size_t)bc * 64 * 512 + h * 128;
    const float* ggo = F.in[I_GGO];
    {
        bf16x8 qf[2];
#pragma unroll
        for (int ks = 0; ks < 2; ++ks) qf[ks] = ldfrag(qtg + (size_t)(16 * tt + r) * 256 + 32 * ks + 8 * q);
        f32x4 sT[4];
#pragma unroll
        for (int st = 0; st < 4; ++st) { sT[st] = (f32x4){0.f, 0.f, 0.f, 0.f};
            if (st <= tt) {
#pragma unroll
                for (int ks = 0; ks < 2; ++ks) sT[st] = MFMA16(ldfrag(ktg + (size_t)(16 * st + r) * 256 + 32 * ks + 8 * q), qf[ks], sT[st]);
                if (st == tt) {
#pragma unroll
                    for (int i = 0; i < 4; ++i) if (4 * q + i > r) sT[st][i] = 0.f; } } }
        const bf16x8 p01 = frag_pk(sT[0], sT[1]), p23 = frag_pk(sT[2], sT[3]);
        f32x4 acc[8]; float ss = 0.f;
#pragma unroll
        for (int et = 0; et < 8; ++et) { acc[et] = (f32x4){0.f, 0.f, 0.f, 0.f};
            const bf16* srow = sc + (size_t)(16 * et + r) * 64 + 8 * q;
            acc[et] = MFMA16(ldfrag(srow), qf[0], acc[et]); acc[et] = MFMA16(ldfrag(srow + 32), qf[1], acc[et]);
            const bf16* vrow = vtg + (size_t)(16 * et + r) * 64 + 4 * q;
            acc[et] = MFMA16(ldfrag2(vrow, vrow + 16), p01, acc[et]);
            if (tt >= 2) acc[et] = MFMA16(ldfrag2(vrow + 32, vrow + 48), p23, acc[et]);
            ss += (acc[et][0] * acc[et][0] + acc[et][1] * acc[et][1]) + (acc[et][2] * acc[et][2] + acc[et][3] * acc[et][3]); }
        ss += __shfl_xor(ss, 16); ss += __shfl_xor(ss, 32);
        const float rs = rsqrtf(ss * (1.f / 128.f) + EPS);
        const bf16* pr = proj + (size_t)(16 * tt + r) * DINP + C_GR + h * 128 + 4 * q;
        bf16* orow = og + (size_t)(16 * tt + r) * 512 + 4 * q;
#pragma unroll
        for (int et = 0; et < 8; ++et) { const u32x2 rw = *(const u32x2*)(pr + 16 * et); const f32x4 gg = *(const f32x4*)(ggo + 16 * et + 4 * q);
            const float r0 = bflo(rw.x), r1 = bfhi(rw.x), r2 = bflo(rw.y), r3 = bfhi(rw.y);
            u32x2 w; w.x = pk2(acc[et][0] * rs * gg[0] * r0 * sigmoidf_(r0), acc[et][1] * rs * gg[1] * r1 * sigmoidf_(r1));
            w.y = pk2(acc[et][2] * rs * gg[2] * r2 * sigmoidf_(r2), acc[et][3] * rs * gg[3] * r3 * sigmoidf_(r3));
            *(u32x2*)(orow + 16 * et) = w; }
    }
}

__device__ __forceinline__ void p3_xatt(Frame& F, int n, float mb) {
    const int lane = LANE_, r = lane & 15, q = lane >> 4, w = F.wave, tid_ = w * 64 + lane;
    const int b = n >> 7, h = (n >> 5) & 3, chunk = n & 31;
    const bf16* km = WSP(bf16, WS_KMEM) + (size_t)(b * 4 + h) * 256 * 128;
    const bf16* vm = WSP(bf16, WS_VMEMT) + (size_t)(b * 4 + h) * 128 * 256;
    LAS unsigned char* kl = F.lds; LAS unsigned char* vl = F.lds + 65536;
    __syncthreads();
    { u32x4 gk[8], gv[8];
#pragma unroll
      for (int i = 0; i < 8; ++i) { gk[i] = *(const u32x4*)(km + (size_t)(i * 512 + tid_) * 8); gv[i] = *(const u32x4*)(vm + (size_t)(i * 512 + tid_) * 8); }
#pragma unroll
      for (int i = 0; i < 8; ++i) { const int id = i * 512 + tid_;
          *(LAS u32x4*)(kl + (id >> 4) * 256 + ((((id & 15) ^ ((id >> 4) & 15))) << 4)) = gk[i];
          *(LAS u32x4*)(vl + (id >> 5) * 512 + ((((id & 31) ^ ((id >> 5) & 15))) << 4)) = gv[i]; } }
    __syncthreads();
    int kb4[4];
#pragma unroll
    for (int ks = 0; ks < 4; ++ks) kb4[ks] = r * 256 + (((4 * ks + q) ^ r) << 4);
#pragma unroll 1
    for (int tile = 0; tile < 2; ++tile) {
        const int tok0 = b * T + chunk * 256 + w * 32 + tile * 16;
        const bf16* xq = WSP(bf16, WS_XQ) + (size_t)(tok0 + r) * 512 + h * 128 + 8 * q;
        bf16x8 qf[4];
#pragma unroll
        for (int ks = 0; ks < 4; ++ks) qf[ks] = ldfrag(xq + 32 * ks);
        f32x4 o[8]; float l = 0.f;
#pragma unroll
        for (int dt = 0; dt < 8; ++dt) o[dt] = (f32x4){0.f, 0.f, 0.f, 0.f};
#pragma unroll 2
        for (int kk = 0; kk < 8; ++kk) {
            f32x4 p[2];
#pragma unroll
            for (int a = 0; a < 2; ++a) { p[a] = (f32x4){0.f, 0.f, 0.f, 0.f};
#pragma unroll
                for (int ks = 0; ks < 4; ++ks) p[a] = MFMA16(as_frag(*(LAS const u32x4*)(kl + kb4[ks] + (2 * kk + a) * 4096)), qf[ks], p[a]);
#pragma unroll
                for (int i = 0; i < 4; ++i) { p[a][i] = __builtin_amdgcn_exp2f(p[a][i] - mb); l += p[a][i]; } }
            const bf16x8 pf = frag_pk(p[0], p[1]);
            const int v0 = r * 512 + (((4 * kk + (q >> 1)) ^ r) << 4) + 8 * (q & 1), v1 = r * 512 + (((4 * kk + 2 + (q >> 1)) ^ r) << 4) + 8 * (q & 1);
#pragma unroll
            for (int dt = 0; dt < 8; ++dt) { const u32x2 x0 = *(LAS const u32x2*)(vl + v0 + dt * 8192), x1 = *(LAS const u32x2*)(vl + v1 + dt * 8192);
                u32x4 wv; wv.x = x0.x; wv.y = x0.y; wv.z = x1.x; wv.w = x1.y; o[dt] = MFMA16(as_frag(wv), pf, o[dt]); }
        }
        l += __shfl_xor(l, 16); l += __shfl_xor(l, 32);
        const float inv = 1.f / l;
        bf16* ox = WSP(bf16, WS_OX) + (size_t)(tok0 + r) * 512 + h * 128 + 4 * q;
#pragma unroll
        for (int dt = 0; dt < 8; ++dt) { u32x2 wv; wv.x = pk2(o[dt][0] * inv, o[dt][1] * inv); wv.y = pk2(o[dt][2] * inv, o[dt][3] * inv); *(u32x2*)(ox + 16 * dt) = wv; }
    }
}
__device__ __forceinline__ void p3_xatt_sample(Frame& F, int task) {
    const int lane = LANE_, w = F.wave, tid_ = w * 64 + lane, b = task >> 2, h = task & 3, tok = NTOKP + b;
    LAS float* qs = (LAS float*)F.lds; LAS float* sc = qs + 128; LAS float* part = qs + 384;
    const float* cm = F.in[I_CMEM] + (size_t)b * 256 * 1024 + h * 128;
    __syncthreads();
    if (tid_ < 128) qs[tid_] = bf2f(WSP(bf16, WS_XQ)[(size_t)tok * 512 + h * 128 + tid_]);
    __syncthreads();
    {
        const int l8 = lane & 7, kq = lane >> 3;
#pragma unroll
        for (int ps = 0; ps < 4; ++ps) { const int key = 32 * w + 8 * ps + kq; const float* kr = cm + (size_t)key * 1024; float s = 0.f;
#pragma unroll
            for (int j = 0; j < 4; ++j) { const int d = (j * 8 + l8) * 4; const f32x4 kv = *(const f32x4*)(kr + d); const f32x4 qv = *(LAS const f32x4*)(qs + d);
                s += (qv[0] * kv[0] + qv[1] * kv[1]) + (qv[2] * kv[2] + qv[3] * kv[3]); }
            s += __shfl_xor(s, 1); s += __shfl_xor(s, 2); s += __shfl_xor(s, 4);
            if (l8 == 0) sc[key] = s; }
    }
    __syncthreads();
    if (w == 0) { float s[4]; float m = -INFINITY;
#pragma unroll
        for (int k = 0; k < 4; ++k) { s[k] = sc[lane + 64 * k]; m = fmaxf(m, s[k]); }
        m = wave_max(m); float l = 0.f;
#pragma unroll
        for (int k = 0; k < 4; ++k) { s[k] = __builtin_amdgcn_exp2f(s[k] - m); l += s[k]; }
        l = wave_sum(l); const float inv = 1.f / l;
#pragma unroll
        for (int k = 0; k < 4; ++k) sc[lane + 64 * k] = s[k] * inv; }
    __syncthreads();
    { float o0 = 0.f, o1 = 0.f; const float* vv = cm + 512 + (size_t)(32 * w) * 1024;
#pragma unroll 8
      for (int mm = 0; mm < 32; ++mm) { const float p = sc[32 * w + mm]; o0 += p * vv[(size_t)mm * 1024 + lane]; o1 += p * vv[(size_t)mm * 1024 + 64 + lane]; }
      part[w * 128 + lane] = o0; part[w * 128 + 64 + lane] = o1; }
    __syncthreads();
    if (tid_ < 128) { float o = 0.f;
#pragma unroll
        for (int w2 = 0; w2 < 8; ++w2) o += part[w2 * 128 + tid_];
        WSP(bf16, WS_OX)[(size_t)tok * 512 + h * 128 + tid_] = (bf16)f2bf(o); }
}

constexpr int NL_Q = 0;
constexpr int NL_U = 16384;
constexpr int NL_OS = 81920;
constexpr int NL_TB = 16384;
constexpr int NL_SEL = 147456;
constexpr int NL_BT = 147968;
constexpr int NL_LINV = 152096;
constexpr int NL_END = 152608;
static_assert(NL_END <= LDS_BYTES, "NSA LDS map");

__device__ __forceinline__ void nsa_tables(Frame& F) {
    LAS float* bt = (LAS float*)(F.lds + NL_BT);
    for (int i = TID_; i < 129 * 8; i += NTHR) bt[i] = F.in[I_RB][t5_bucket(i >> 3) * 8 + (i & 7)] * LOG2E;
    __syncthreads();
}
__device__ __forceinline__ float nsa_bound(Frame& F) {
    const float gq = absmax_arr(F.in[I_GNQ], 64, LANE_), gk = absmax_arr(F.in[I_GNK], 192, LANE_), bm = absmax_arr(F.in[I_RB], 256, LANE_);
    return (8.0f * gq * gk * 1.02f + bm) * LOG2E;
}
__device__ __forceinline__ unsigned fkey(float x) { const unsigned u = __float_as_uint(x); return (u & 0x80000000u) ? ~u : (u | 0x80000000u); }

__device__ __forceinline__ int tile_off16(int row, int c16) { return row * 128 + ((c16 ^ (row & 7)) << 4); }
struct TileAddr { int kb[2]; int vb[2][2]; };
__device__ __forceinline__ TileAddr tile_addr(int r, int q) { TileAddr a;
    for (int ks = 0; ks < 2; ++ks) a.kb[ks] = r * 128 + (((4 * ks + q) ^ (r & 7)) << 4);
    for (int s = 0; s < 2; ++s) for (int pc = 0; pc < 2; ++pc) a.vb[s][pc] = r * 128 + (((4 * s + 2 * pc + (q >> 1)) ^ (r & 7)) << 4) + 8 * (q & 1);
    return a; }
__device__ __forceinline__ bf16x8 tile_kfrag(LAS const unsigned char* kb, const TileAddr& ta, int kt, int ks) { return as_frag(*(LAS const u32x4*)(kb + ta.kb[ks] + kt * 2048)); }
__device__ __forceinline__ bf16x8 tile_vfrag(LAS const unsigned char* vb, const TileAddr& ta, int dt, int s) {
    const u32x2 a = *(LAS const u32x2*)(vb + ta.vb[s][0] + dt * 2048), b = *(LAS const u32x2*)(vb + ta.vb[s][1] + dt * 2048);
    u32x4 w; w.x = a.x; w.y = a.y; w.z = b.x; w.w = b.y; return as_frag(w); }

#define OPAQUE_V(x) asm volatile("" : "+v"(x))
__device__ __forceinline__ void p3_nsa_prompt(Frame& F, int n, float mb, int dbg) {
    int lane0 = LANE_; OPAQUE_V(lane0);
    const int lane = lane0, r = lane & 15, q = lane >> 4, w = F.wave;
    int combo, ti;
    if (F.G == 256) { const int xcd = F.bid & 7, u = (F.bid >> 3) * 2 + (xcd & 1), rnd = n >> 8; combo = xcd >> 1; ti = rnd == 0 ? u : rnd == 1 ? 127 - u : rnd == 2 ? 128 + u : 255 - u; }
    else { const int idx = n & 255; combo = n >> 8; ti = (combo & 1) ? 255 - idx : idx; }
    const int b = combo >> 1, kv = combo & 1, t0 = 32 * ti, bk = b * 2 + kv;
    LAS bf16* Qs = (LAS bf16*)(F.lds + NL_Q); LAS float* U = (LAS float*)(F.lds + NL_U) + w * 2048; LAS unsigned* selm = (LAS unsigned*)(F.lds + NL_SEL);
    LAS const float* bt = (LAS const float*)(F.lds + NL_BT); LAS float* linv = (LAS float*)(F.lds + NL_LINV) + w * 16;
    LAS unsigned char* stA = F.lds + NL_OS;
    LAS unsigned char* stC = F.lds + NL_U;
    LAS unsigned char* stB = F.lds + NL_TB + w * 16384;
    const int tid_ = w * 64 + lane, srow = tid_ >> 3, sc16 = tid_ & 7, soff = tile_off16(srow, sc16);
    const TileAddr ta = tile_addr(r, q);
    __syncthreads();
    { const int tk = TID_ >> 4, ch = TID_ & 15; const bf16* src = WSP(bf16, WS_QN) + (size_t)(b * T + t0 + tk) * 512 + kv * 256 + ch * 16;
      const u32x4 a0 = *(const u32x4*)src, a1 = *(const u32x4*)(src + 8);
      *(LAS u32x4*)(Qs + tk * 256 + ch * 16) = a0; *(LAS u32x4*)(Qs + tk * 256 + ch * 16 + 8) = a1;
      if (TID_ < 128) selm[TID_] = 0u; }
    __syncthreads();
    const int tw = t0 + 4 * w, tr = tw + (r >> 2), h = kv * 4 + (r & 3);
    bf16x8 qf[2];
#pragma unroll
    for (int ks = 0; ks < 2; ++ks) qf[ks] = as_frag(*(LAS const u32x4*)(Qs + (16 * w + r) * 64 + 32 * ks + 8 * q));
    int ncvb = (t0 + 31 - 31) / 16 + 1; ncvb = ncvb < 511 ? ncvb : 511;
    const int nst = (ncvb + 63) >> 6;
    const int tlast = tw + 3; int ncv = tlast >= 31 ? (tlast - 31) / 16 + 1 : 0; ncv = ncv < 511 ? ncv : 511;
    const int nstw = (ncv + 63) >> 6;
    f32x4 oc[4]; float lc = 0.f, carry = 0.f;
#pragma unroll
    for (int dt = 0; dt < 4; ++dt) oc[dt] = (f32x4){0.f, 0.f, 0.f, 0.f};
    {
        const bf16* kc = WSP(bf16, WS_KCMP) + (size_t)bk * 512 * 64 + srow * 64 + sc16 * 8; const bf16* vc = WSP(bf16, WS_VCMPT) + (size_t)bk * 64 * 512 + srow * 512 + sc16 * 8;
        const int nst2 = (nst + 1) >> 1;
        u32x4 rk0 = *(const u32x4*)kc, rv0 = *(const u32x4*)vc, rk1 = *(const u32x4*)(kc + 4096), rv1 = *(const u32x4*)(vc + 64);
#pragma unroll 1
        for (int s2 = 0; s2 < nst2; ++s2) {
            LAS unsigned char* bb = stA + (s2 & 1) * 32768;
            *(LAS u32x4*)(bb + soff) = rk0; *(LAS u32x4*)(bb + 8192 + soff) = rv0; *(LAS u32x4*)(bb + 16384 + soff) = rk1; *(LAS u32x4*)(bb + 24576 + soff) = rv1;
            __syncthreads();
            if (s2 + 1 < nst2) { rk0 = *(const u32x4*)(kc + (size_t)(2 * s2 + 2) * 4096); rv0 = *(const u32x4*)(vc + (2 * s2 + 2) * 64);
                                 rk1 = *(const u32x4*)(kc + (size_t)(2 * s2 + 3) * 4096); rv1 = *(const u32x4*)(vc + (2 * s2 + 3) * 64); }
#pragma unroll
            for (int sub = 0; sub < 2; ++sub) { const int st = 2 * s2 + sub; LAS unsigned char* kb = bb + sub * 16384; LAS unsigned char* vb = kb + 8192;
            if (st < nstw && !(dbg & 1)) {
                f32x4 p[4];
#pragma unroll
                for (int kt = 0; kt < 4; ++kt) { const int tile = 4 * st + kt; p[kt] = (f32x4){0.f, 0.f, 0.f, 0.f};
                    p[kt] = MFMA16(tile_kfrag(kb, ta, kt, 0), qf[0], p[kt]); p[kt] = MFMA16(tile_kfrag(kb, ta, kt, 1), qf[1], p[kt]);
                    float G = 0.f;
#pragma unroll
                    for (int i = 0; i < 4; ++i) { const int c = 16 * tile + 4 * q + i, rel = tr - (16 * c + 31); const bool ok = rel >= 0 && c < 511;
                        const int rc = rel < 0 ? 0 : (rel > 128 ? 128 : rel);
                        const float xv = p[kt][i] + bt[rc * 8 + h] - mb;
                        const float e = __builtin_amdgcn_exp2f(ok ? xv : -1e30f); p[kt][i] = e; G += e; }
                    const float send = (q == 3) ? carry : p[kt][3]; const float prev = __shfl(send, (lane + 48) & 63); carry = p[kt][3];
                    U[r * 128 + 4 * tile + q] = G + prev; lc += G; }
                const bf16x8 pf0 = frag_pk(p[0], p[1]), pf1 = frag_pk(p[2], p[3]);
#pragma unroll
                for (int dt = 0; dt < 4; ++dt) { oc[dt] = MFMA16(tile_vfrag(vb, ta, dt, 0), pf0, oc[dt]); oc[dt] = MFMA16(tile_vfrag(vb, ta, dt, 1), pf1, oc[dt]); }
            } }
        }
    }
    lc += __shfl_xor(lc, 16); lc += __shfl_xor(lc, 32);
    const float lcinv = lc > 0.f ? 1.f / lc : 0.f;
    if (q == 0) linv[r] = lcinv;
    asm volatile("s_waitcnt lgkmcnt(0)" ::: "memory");
    if (!(dbg & 8)) {
        const int tk = lane >> 4, jr = lane & 15, t = tw + tk, tblk = t >> 6, jlim = 16 * nstw;
        const float li0 = linv[4 * tk], li1 = linv[4 * tk + 1], li2 = linv[4 * tk + 2], li3 = linv[4 * tk + 3];
        unsigned key[8];
#pragma unroll
        for (int m = 0; m < 8; ++m) { const int j = jr + 16 * m; float v = 0.f;
            if (j < jlim) v = U[(4 * tk) * 128 + j] * li0 + U[(4 * tk + 1) * 128 + j] * li1 + U[(4 * tk + 2) * 128 + j] * li2 + U[(4 * tk + 3) * 128 + j] * li3;
            const bool forced = (j == 0) || (j == tblk) || (j == tblk - 1);
            const float sc = (j <= tblk) ? v + (forced ? 1e4f : 0.f) : -1e30f;
            key[m] = fkey(sc); }
        unsigned pre = 0u;
#pragma unroll 1
        for (int bit = 31; bit >= 0; --bit) { const unsigned cand = pre | (1u << bit); int cnt = 0;
#pragma unroll
            for (int m = 0; m < 8; ++m) cnt += key[m] >= cand ? 1 : 0;
            cnt += __shfl_xor(cnt, 1); cnt += __shfl_xor(cnt, 2); cnt += __shfl_xor(cnt, 4); cnt += __shfl_xor(cnt, 8);
            if (cnt >= 16) pre = cand; }
        int ngt = 0;
#pragma unroll
        for (int m = 0; m < 8; ++m) ngt += key[m] > pre ? 1 : 0;
        ngt += __shfl_xor(ngt, 1); ngt += __shfl_xor(ngt, 2); ngt += __shfl_xor(ngt, 4); ngt += __shfl_xor(ngt, 8);
        const int need = 16 - ngt; int run = 0; const unsigned kinv = fkey(-1e30f);
#pragma unroll
        for (int m = 0; m < 8; ++m) { const bool tie = key[m] == pre; const unsigned long long bal = __ballot(tie);
            const unsigned grp = (unsigned)(bal >> (16 * tk)) & 0xffffu; const int rank = __popc(grp & ((1u << jr) - 1u));
            const bool sel = (key[m] > pre || (tie && run + rank < need)) && key[m] > kinv;
            run += __popc(grp);
            if (sel) atomicOr((unsigned*)(selm + jr + 16 * m), 1u << (4 * w + tk)); }
    }
    __syncthreads();
    f32x4 ow[4]; float lw = 0.f;
#pragma unroll
    for (int dt = 0; dt < 4; ++dt) ow[dt] = (f32x4){0.f, 0.f, 0.f, 0.f};
    {
        int lc_ = lane0; OPAQUE_V(lc_); const int lane = lc_, r = lane & 15, q = lane >> 4, tr = tw + (r >> 2), h = kv * 4 + (r & 3); const TileAddr ta = tile_addr(r, q);
        const int tid_ = w * 64 + lane, srow = tid_ >> 3, sc16 = tid_ & 7, soff = tile_off16(srow, sc16);
        const int jlob = (t0 - 511 > 0 ? t0 - 511 : 0) >> 6, jhib = (t0 + 31) >> 6, nstc = jhib - jlob + 1;
        const int jlo = (tw - 511 > 0 ? tw - 511 : 0) >> 6, jhi = (tw + 3) >> 6;
        const bf16* kwin = WSP(bf16, WS_KWIN) + (size_t)bk * T * 64 + srow * 64 + sc16 * 8; const bf16* vwin = WSP(bf16, WS_VWINT) + (size_t)bk * 128 * 4096 + srow * 64 + sc16 * 8;
        const int nstc2 = (nstc + 1) >> 1;
        u32x4 rk0 = *(const u32x4*)(kwin + (size_t)jlob * 4096), rv0 = *(const u32x4*)(vwin + (size_t)jlob * 4096), rk1 = *(const u32x4*)(kwin + (size_t)(jlob + 1) * 4096), rv1 = *(const u32x4*)(vwin + (size_t)(jlob + 1) * 4096);
#pragma unroll 1
        for (int s2 = 0; s2 < nstc2; ++s2) { const int j0 = jlob + 2 * s2;
            LAS unsigned char* bb = stC + (s2 & 1) * 32768;
            *(LAS u32x4*)(bb + soff) = rk0; *(LAS u32x4*)(bb + 8192 + soff) = rv0; *(LAS u32x4*)(bb + 16384 + soff) = rk1; *(LAS u32x4*)(bb + 24576 + soff) = rv1;
            __syncthreads();
            if (s2 + 1 < nstc2) { rk0 = *(const u32x4*)(kwin + (size_t)(j0 + 2) * 4096); rv0 = *(const u32x4*)(vwin + (size_t)(j0 + 2) * 4096);
                                  rk1 = *(const u32x4*)(kwin + (size_t)(j0 + 3) * 4096); rv1 = *(const u32x4*)(vwin + (size_t)(j0 + 3) * 4096); }
#pragma unroll
            for (int sub = 0; sub < 2; ++sub) { const int j = j0 + sub; LAS unsigned char* kb = bb + sub * 16384; LAS unsigned char* vb = kb + 8192;
            if (j >= jlo && j <= jhi && !(dbg & 2)) {
                f32x4 p[4];
#pragma unroll
                for (int kt = 0; kt < 4; ++kt) { p[kt] = (f32x4){0.f, 0.f, 0.f, 0.f};
                    p[kt] = MFMA16(tile_kfrag(kb, ta, kt, 0), qf[0], p[kt]); p[kt] = MFMA16(tile_kfrag(kb, ta, kt, 1), qf[1], p[kt]);
#pragma unroll
                    for (int i = 0; i < 4; ++i) { const int rel = tr - (64 * j + 16 * kt + 4 * q + i); const bool ok = rel >= 0 && rel < 512;
                        const int rc = rel < 0 ? 0 : (rel > 128 ? 128 : rel);
                        const float xv = p[kt][i] + bt[rc * 8 + h] - mb;
                        const float e = __builtin_amdgcn_exp2f(ok ? xv : -1e30f); p[kt][i] = e; lw += e; } }
                const bf16x8 pf0 = frag_pk(p[0], p[1]), pf1 = frag_pk(p[2], p[3]);
#pragma unroll
                for (int dt = 0; dt < 4; ++dt) { ow[dt] = MFMA16(tile_vfrag(vb, ta, dt, 0), pf0, ow[dt]); ow[dt] = MFMA16(tile_vfrag(vb, ta, dt, 1), pf1, ow[dt]); }
            } }
        }
        lw += __shfl_xor(lw, 16); lw += __shfl_xor(lw, 32);
    }
    f32x4 ocw[4];
    { const float* gt = WSP(float, WS_GATES) + (size_t)(b * T + tr) * 24 + h * 3;
      const float g0 = gt[0] * lcinv, g2 = gt[2] * (lw > 0.f ? 1.f / lw : 0.f);
#pragma unroll
      for (int dt = 0; dt < 4; ++dt) ocw[dt] = oc[dt] * g0 + ow[dt] * g2; }
    __syncthreads();
    f32x4 osf[4]; float lsf = 0.f;
    {
        int lb_ = lane0; OPAQUE_V(lb_); const int lane = lb_, r = lane & 15, q = lane >> 4, h = kv * 4 + (r & 3); const TileAddr ta = tile_addr(r, q);
        const int half = w >> 2, jw = w & 3;
        f32x4 osa[4][4]; float lsa[4];
#pragma unroll
        for (int x = 0; x < 4; ++x) { lsa[x] = 0.f;
#pragma unroll
            for (int dt = 0; dt < 4; ++dt) osa[x][dt] = (f32x4){0.f, 0.f, 0.f, 0.f}; }
        const int jmax = (t0 + 31) >> 6;
        const int brow = lane >> 3, bc16 = lane & 7, boff = brow * 64 + bc16 * 8, bsoff = tile_off16(brow, bc16); const float bfar = bt[128 * 8 + h];
        const bf16* ksel = WSP(bf16, WS_KSEL) + (size_t)bk * T * 64 + boff; const bf16* vsel = WSP(bf16, WS_VSELT) + (size_t)bk * 128 * 4096 + boff;
        LAS const bf16* Qh = Qs + (64 * half + r) * 64 + 8 * q;
        u32x4 gk[8], gv[8];
        if (jw <= jmax) {
#pragma unroll
            for (int i = 0; i < 8; ++i) { gk[i] = *(const u32x4*)(ksel + (size_t)jw * 4096 + i * 512); gv[i] = *(const u32x4*)(vsel + (size_t)jw * 4096 + i * 512); } }
#pragma unroll 1
        for (int j = jw; j <= jmax; j += 4) {
            const unsigned msel = ((unsigned)__builtin_amdgcn_readfirstlane((int)selm[j]) >> (16 * half)) & 0xffffu;
            const bool act = msel != 0u && !(dbg & 4);
            asm volatile("s_waitcnt lgkmcnt(0)" ::: "memory");
#pragma unroll
            for (int i = 0; i < 8; ++i) { *(LAS u32x4*)(stB + bsoff + i * 1024) = gk[i]; *(LAS u32x4*)(stB + 8192 + bsoff + i * 1024) = gv[i]; }
            if (j + 4 <= jmax) {
#pragma unroll
                for (int i = 0; i < 8; ++i) { gk[i] = *(const u32x4*)(ksel + (size_t)(j + 4) * 4096 + i * 512); gv[i] = *(const u32x4*)(vsel + (size_t)(j + 4) * 4096 + i * 512); } }
            if (!act) continue;
            asm volatile("s_waitcnt lgkmcnt(0)" ::: "memory");
            const bool far = (t0 - (64 * j + 63)) >= 128;
#pragma unroll 1
            for (int x = 0; x < 4; ++x) {
                const unsigned nib = (msel >> (4 * x)) & 15u;
                if (nib) {
                    asm volatile("" ::: "memory");
                    const bool tokv = (nib >> (r >> 2)) & 1u; const int t = t0 + 16 * half + 4 * x + (r >> 2);
                    const bf16x8 qs0 = as_frag(*(LAS const u32x4*)(Qh + x * 1024)), qs1 = as_frag(*(LAS const u32x4*)(Qh + x * 1024 + 32));
                    f32x4 p[4]; float ls = 0.f;
#pragma unroll
                    for (int kt = 0; kt < 4; ++kt) { p[kt] = (f32x4){0.f, 0.f, 0.f, 0.f};
                        p[kt] = MFMA16(tile_kfrag(stB, ta, kt, 0), qs0, p[kt]); p[kt] = MFMA16(tile_kfrag(stB, ta, kt, 1), qs1, p[kt]); }
                    if (dbg & 32) { ls = p[0][0]; } else
                    if (far) {
                        const float cb_ = bfar - mb;
#pragma unroll
                        for (int kt = 0; kt < 4; ++kt)
#pragma unroll
                            for (int i = 0; i < 4; ++i) { const float e = __builtin_amdgcn_exp2f(tokv ? p[kt][i] + cb_ : -1e30f); p[kt][i] = e; ls += e; }
                    } else {
#pragma unroll
                        for (int kt = 0; kt < 4; ++kt)
#pragma unroll
                            for (int i = 0; i < 4; ++i) { const int rel = t - (64 * j + 16 * kt + 4 * q + i); const bool ok = tokv && rel >= 0;
                                const int rc = rel < 0 ? 0 : (rel > 128 ? 128 : rel);
                                const float xv = p[kt][i] + bt[rc * 8 + h] - mb;
                                const float e = __builtin_amdgcn_exp2f(ok ? xv : -1e30f); p[kt][i] = e; ls += e; }
                    }
                    lsa[0] += ls;
                    const bf16x8 pf0 = frag_pk(p[0], p[1]), pf1 = frag_pk(p[2], p[3]);
#pragma unroll
                    for (int dt = 0; dt < 4; ++dt) if (!(dbg & 64)) { osa[0][dt] = MFMA16(tile_vfrag(stB + 8192, ta, dt, 0), pf0, osa[0][dt]); osa[0][dt] = MFMA16(tile_vfrag(stB + 8192, ta, dt, 1), pf1, osa[0][dt]); }
                }
                { const float l0 = lsa[0]; lsa[0] = lsa[1]; lsa[1] = lsa[2]; lsa[2] = lsa[3]; lsa[3] = l0;
#pragma unroll
                  for (int dt = 0; dt < 4; ++dt) { const f32x4 o0 = osa[0][dt]; osa[0][dt] = osa[1][dt]; osa[1][dt] = osa[2][dt]; osa[2][dt] = osa[3][dt]; osa[3][dt] = o0; } }
            }
        }
#pragma unroll
        for (int dt = 0; dt < 4; ++dt) osf[dt] = (f32x4){0.f, 0.f, 0.f, 0.f};
#pragma unroll
        for (int x = 0; x <= 4; ++x) {
            __syncthreads();
            if (x > 0 && jw == x - 1) {
#pragma unroll
                for (int w2 = 0; w2 < 4; ++w2) { LAS const float* rp = (LAS const float*)(F.lds + NL_U + ((x - 1) & 1) * 32768) + (4 * half + w2) * 1024 + lane * 16;
#pragma unroll
                    for (int dt = 0; dt < 4; ++dt) osf[dt] += *(LAS const f32x4*)(rp + 4 * dt);
                    lsf += ((LAS const float*)(F.lds + NL_Q + ((x - 1) & 1) * 2048))[(4 * half + w2) * 64 + lane]; } }
            if (x < 4) { LAS float* Rb = (LAS float*)(F.lds + NL_U + (x & 1) * 32768); LAS float* RLb = (LAS float*)(F.lds + NL_Q + (x & 1) * 2048);
#pragma unroll
                for (int dt = 0; dt < 4; ++dt) *(LAS f32x4*)(Rb + w * 1024 + lane * 16 + 4 * dt) = osa[x][dt];
                RLb[w * 64 + lane] = lsa[x]; }
        }
        lsf += __shfl_xor(lsf, 16); lsf += __shfl_xor(lsf, 32);
    }
    {
        int lf_ = lane0; OPAQUE_V(lf_); const int r = lf_ & 15, q = lf_ >> 4, tr = tw + (r >> 2), h = kv * 4 + (r & 3);
        const int tok = b * T + tr; const float g1 = WSP(float, WS_GATES)[(size_t)tok * 24 + h * 3 + 1] * (lsf > 0.f ? 1.f / lsf : 0.f);
        bf16* on = WSP(bf16, WS_ONSA) + (size_t)tok * 512 + h * 64 + 4 * q;
#pragma unroll
        for (int dt = 0; dt < 4; ++dt) { const f32x4 o = ocw[dt] + osf[dt] * g1;
            u32x2 wv; wv.x = pk2(o[0], o[1]); wv.y = pk2(o[2], o[3]); *(u32x2*)(on + 16 * dt) = wv; }
    }
}

constexpr int SL_Q = 0;
constexpr int SL_S = 1024;
constexpr int SL_O = 17408;
constexpr int SL_PART = 20480;
constexpr int SL_IMP = 28672;
constexpr int SL_IDX = 29200;
constexpr int SL_END = 29328;
static_assert(SL_END <= NL_SEL, "sample NSA LDS map must not overlap the tables");
template <class KP, class VP, class RELF>
__device__ __forceinline__ void sample_segment(Frame& F, int nk, int kv, KP kptr, VP vptr, RELF relf, LAS float* odst) {
    LAS const float* qs = (LAS const float*)(F.lds + SL_Q); LAS float* sc = (LAS float*)(F.lds + SL_S); LAS float* part = (LAS float*)(F.lds + SL_PART);
    LAS const float* bt = (LAS const float*)(F.lds + NL_BT);
    const int nkp = (nk + 63) & ~63;
    for (int n = TID_; n < nkp; n += NTHR) {
        float s0 = -INFINITY, s1 = -INFINITY, s2 = -INFINITY, s3 = -INFINITY;
        const float* kr = n < nk ? kptr(n) : nullptr;
        if (kr) { s0 = s1 = s2 = s3 = 0.f;
            for (int d = 0; d < 64; d += 4) { const f32x4 k4 = *(const f32x4*)(kr + d);
                const f32x4 q0 = *(LAS const f32x4*)(qs + d), q1 = *(LAS const f32x4*)(qs + 64 + d), q2 = *(LAS const f32x4*)(qs + 128 + d), q3 = *(LAS const f32x4*)(qs + 192 + d);
                s0 += (q0[0] * k4[0] + q0[1] * k4[1]) + (q0[2] * k4[2] + q0[3] * k4[3]); s1 += (q1[0] * k4[0] + q1[1] * k4[1]) + (q1[2] * k4[2] + q1[3] * k4[3]);
                s2 += (q2[0] * k4[0] + q2[1] * k4[1]) + (q2[2] * k4[2] + q2[3] * k4[3]); s3 += (q3[0] * k4[0] + q3[1] * k4[1]) + (q3[2] * k4[2] + q3[3] * k4[3]); }
            int rel = relf(n); rel = rel > 128 ? 128 : rel; const int bb = rel * 8 + kv * 4;
            s0 += bt[bb]; s1 += bt[bb + 1]; s2 += bt[bb + 2]; s3 += bt[bb + 3]; }
        sc[n] = s0; sc[1024 + n] = s1; sc[2048 + n] = s2; sc[3072 + n] = s3;
    }
    __syncthreads();
    if (F.wave < 4) { LAS float* row = sc + F.wave * 1024; float m = -INFINITY;
        for (int n = LANE_; n < nkp; n += 64) m = fmaxf(m, row[n]);
        m = wave_max(m); float l = 0.f;
        for (int n = LANE_; n < nkp; n += 64) { const float e = __builtin_amdgcn_exp2f(row[n] - m); row[n] = e; l += e; }
        l = wave_sum(l); const float inv = 1.f / l;
        for (int n = LANE_; n < nkp; n += 64) row[n] *= inv; }
    __syncthreads();
    {
        const int d = LANE_; float o0 = 0.f, o1 = 0.f, o2 = 0.f, o3 = 0.f;
        for (int n0 = F.wave; n0 < nkp; n0 += 128) {
            float v[16];
#pragma unroll
            for (int u = 0; u < 16; ++u) { const int n = n0 + 8 * u; v[u] = n < nk ? vptr(n)[d] : 0.f; }
#pragma unroll
            for (int u = 0; u < 16; ++u) { const int n = n0 + 8 * u; if (n < nkp) { o0 += sc[n] * v[u]; o1 += sc[1024 + n] * v[u]; o2 += sc[2048 + n] * v[u]; o3 += sc[3072 + n] * v[u]; } }
        }
        part[(F.wave * 4 + 0) * 64 + d] = o0; part[(F.wave * 4 + 1) * 64 + d] = o1; part[(F.wave * 4 + 2) * 64 + d] = o2; part[(F.wave * 4 + 3) * 64 + d] = o3; }
    __syncthreads();
    if (TID_ < 256) { float a = 0.f;
#pragma unroll
        for (int w8 = 0; w8 < 8; ++w8) a += part[w8 * 256 + TID_];
        odst[TID_] = a; }
    __syncthreads();
}
__device__ __forceinline__ void p3_nsa_sample(Frame& F, int task, int part) {
    const int b = task >> 1, kv = task & 1, tok = NTOKP + b, bk = b * 2 + kv;
    LAS float* qs = (LAS float*)(F.lds + SL_Q); LAS float* sc = (LAS float*)(F.lds + SL_S); LAS float* ob = (LAS float*)(F.lds + SL_O);
    LAS float* imp = (LAS float*)(F.lds + SL_IMP); LAS int* sidx = (LAS int*)(F.lds + SL_IDX);
    __syncthreads();
    if (TID_ < 256) qs[TID_] = bf2f(WSP(bf16, WS_QN)[(size_t)tok * 512 + kv * 256 + TID_]);
    __syncthreads();
    const float* kcs = WSP(float, WS_KCMPS) + (size_t)bk * 512 * 64; const float* vcs = WSP(float, WS_VCMPS) + (size_t)bk * 512 * 64;
    const float* nkv = WSP(float, WS_NEWKV) + (size_t)b * 4 * 2 * 64 + kv * 64;
    const float* ckv = F.in[I_CKV]; const int* pt = (const int*)F.in[I_PT] + b * 64; const float* cwin = F.in[I_CWIN] + (size_t)b * 512 * 256;
    if (part == 0) {
    sample_segment(F, 511, kv, [&](int n) { return kcs + (size_t)n * 64; }, [&](int n) { return vcs + (size_t)n * 64; }, [&](int n) { return T - (16 * n + 31); }, ob);
    if (TID_ < 129) { const int j = TID_; float v = 0.f;
        for (int c = 4 * j - 1; c <= 4 * j + 3; ++c) if (c >= 0 && c < 511) v += (sc[c] + sc[1024 + c]) + (sc[2048 + c] + sc[3072 + c]);
        imp[j] = v; }
    __syncthreads();
    if (F.wave == 0) { const int lane = LANE_; unsigned key[3];
#pragma unroll
        for (int m = 0; m < 3; ++m) { const int j = lane + 64 * m; float s = -1e30f;
            if (j < 129) { const bool forced = (j == 0) || (j == 128) || (j == 127); s = imp[j] + (forced ? 1e4f : 0.f); }
            key[m] = (j < 129) ? fkey(s) : 0u; }
        unsigned pre = 0u;
#pragma unroll 1
        for (int bit = 31; bit >= 0; --bit) { const unsigned cand = pre | (1u << bit); int cnt = 0;
#pragma unroll
            for (int m = 0; m < 3; ++m) cnt += __popcll(__ballot(key[m] >= cand));
            if (cnt >= 16) pre = cand; }
        int ngt = 0;
#pragma unroll
        for (int m = 0; m < 3; ++m) ngt += __popcll(__ballot(key[m] > pre));
        int need = 16 - ngt, cnt = 0;
#pragma unroll
        for (int m = 0; m < 3; ++m) { const bool gt = key[m] > pre, tie = key[m] == pre; const unsigned long long tb = __ballot(tie);
            const int trank = __popcll(tb & ((1ull << lane) - 1ull)); const bool sel = gt || (tie && trank < need);
            need -= __popcll(tb); need = need < 0 ? 0 : need;
            const unsigned long long sb = __ballot(sel); const int pos = cnt + __popcll(sb & ((1ull << lane) - 1ull));
            if (sel && pos < 16) sidx[pos] = lane + 64 * m; cnt += __popcll(sb); } }
    __syncthreads();
    sample_segment(F, 1024, kv,
        [&](int n) -> const float* { const int pos = 64 * sidx[n >> 6] + (n & 63); if (pos > T) return nullptr; if (pos == T) return nkv;
                                     return ckv + (((size_t)pt[pos >> 7] * 128 + (pos & 127)) * 4 + 2) * 128 + kv * 64; },
        [&](int n) -> const float* { const int pos = 64 * sidx[n >> 6] + (n & 63); if (pos >= T) return nkv + 128;
                                     return ckv + (((size_t)pt[pos >> 7] * 128 + (pos & 127)) * 4 + 3) * 128 + kv * 64; },
        [&](int n) { return T - (64 * sidx[n >> 6] + (n & 63)); }, ob + 256);
    } else {
    sample_segment(F, 512, kv,
        [&](int n) -> const float* { return n < 511 ? cwin + (size_t)(n + 1) * 256 + kv * 64 : nkv + 256; },
        [&](int n) -> const float* { return n < 511 ? cwin + (size_t)(n + 1) * 256 + 128 + kv * 64 : nkv + 384; },
        [&](int n) { return 511 - n; }, ob + 512);
    }
    if (TID_ < 256) { const int g = TID_ >> 6, d = TID_ & 63, h = kv * 4 + g; const float* gt = WSP(float, WS_GATES) + (size_t)tok * 24 + h * 3;
        const float v = part == 0 ? gt[0] * ob[TID_] + gt[1] * ob[256 + TID_] : gt[2] * ob[512 + TID_];
        atomicAdd(WSP(float, WS_ONS) + (size_t)b * 512 + h * 64 + d, v); }
}

template <bool A_F32>
__device__ __forceinline__ void skinny_mma(f32x4 (&acc)[2], float (&ssq)[2], const void* A, int lda, const bf16* Bt, int K, int n0, int k0, int nks, int r, int q) {
    acc[0] = (f32x4){0.f, 0.f, 0.f, 0.f}; acc[1] = acc[0]; ssq[0] = 0.f; ssq[1] = 0.f;
#pragma unroll 4
    for (int ks = 0; ks < nks; ++ks) { const int k = k0 + 32 * ks + 8 * q;
        const bf16x8 a = ldfrag(Bt + (size_t)(n0 + r) * K + k);
#pragma unroll
        for (int mt = 0; mt < 2; ++mt) { bf16x8 bfr;
            if (A_F32) { const float* p = (const float*)A + (size_t)(16 * mt + r) * lda + k; const f32x4 x0 = *(const f32x4*)p, x1 = *(const f32x4*)(p + 4);
                ssq[mt] += (x0[0] * x0[0] + x0[1] * x0[1]) + (x0[2] * x0[2] + x0[3] * x0[3]) + (x1[0] * x1[0] + x1[1] * x1[1]) + (x1[2] * x1[2] + x1[3] * x1[3]); bfr = frag_pk(x0, x1); }
            else bfr = ldfrag((const bf16*)A + (size_t)(16 * mt + r) * lda + k);
            acc[mt] = MFMA16(a, bfr, acc[mt]); } }
}
__device__ __forceinline__ void s5_merge(Frame& F, int t) {
    const int lane = LANE_, r = lane & 15, q = lane >> 4, br = t >> 7, nt = (t >> 1) & 63, kc = t & 1;
    const bf16* A = (br == 0 ? WSP(bf16, WS_ONSA) : br == 1 ? WSP(bf16, WS_OGLA) : WSP(bf16, WS_OX)) + (size_t)NTOKP * 512;
    const bf16* Bt = br == 0 ? WSP(bf16, WS_WTNSA) : br == 1 ? WSP(bf16, WS_WTGLA) : WSP(bf16, WS_WTX);
    f32x4 acc[2]; float ssq[2];
    if (br == 0) skinny_mma<true>(acc, ssq, WSP(float, WS_ONS), 512, Bt, 512, 16 * nt, 256 * kc, 8, r, q);
    else skinny_mma<false>(acc, ssq, A, 512, Bt, 512, 16 * nt, 256 * kc, 8, r, q);
    float* ms = WSP(float, WS_MS); const bf16* gate = WSP(bf16, WS_PROJ) + (size_t)NTOKP * DINP + C_MG + br * 1024;
#pragma unroll
    for (int mt = 0; mt < 2; ++mt) { const int m = 16 * mt + r; const u32x2 g = *(const u32x2*)(gate + (size_t)m * DINP + 16 * nt + 4 * q);
        float* d = ms + (size_t)m * 1024 + 16 * nt + 4 * q;
        atomicAdd(d + 0, acc[mt][0] * sigmoidf_(bflo(g.x))); atomicAdd(d + 1, acc[mt][1] * sigmoidf_(bfhi(g.x)));
        atomicAdd(d + 2, acc[mt][2] * sigmoidf_(bflo(g.y))); atomicAdd(d + 3, acc[mt][3] * sigmoidf_(bfhi(g.y))); }
}
__device__ __forceinline__ void s6_wo(Frame& F, int t) {
    const int lane = LANE_, r = lane & 15, q = lane >> 4, nt = t >> 2, kc = t & 3;
    f32x4 acc[2]; float ssq[2]; skinny_mma<true>(acc, ssq, WSP(float, WS_MS), 1024, WSP(bf16, WS_WTO), 1024, 16 * nt, 256 * kc, 8, r, q);
    float* x1s = WSP(float, WS_X1S);
#pragma unroll
    for (int mt = 0; mt < 2; ++mt) { float* d = x1s + (size_t)(16 * mt + r) * 1024 + 16 * nt + 4 * q;
#pragma unroll
        for (int i = 0; i < 4; ++i) atomicAdd(d + i, acc[mt][i]); }
}
__device__ __forceinline__ void s7_up(Frame& F, int t) {
    const int lane = LANE_, r = lane & 15, q = lane >> 4, c0 = 16 * t + 4 * q;
    f32x4 au[2], ag[2]; float ssq[2], ssq2[2];
    skinny_mma<true>(au, ssq, WSP(float, WS_X1S), 1024, WSP(bf16, WS_WTUP), 1024, upmap(16 * t), 0, 32, r, q);
    skinny_mma<true>(ag, ssq2, WSP(float, WS_X1S), 1024, WSP(bf16, WS_WTUP), 1024, upmap(DFF + 16 * t), 0, 32, r, q);
    const float* cw = F.in[I_CONVW]; const float* cb = F.in[I_CONVB]; const float* sconv = F.in[I_SCONV];
    const f32x4 w0 = *(const f32x4*)(cw + c0), w1 = *(const f32x4*)(cw + DFF + c0), w2 = *(const f32x4*)(cw + 2 * DFF + c0), bb = *(const f32x4*)(cb + c0);
#pragma unroll
    for (int mt = 0; mt < 2; ++mt) { const int sb = 16 * mt + r; float s = ssq[mt]; s += __shfl_xor(s, 16); s += __shfl_xor(s, 32); const float rs = rsqrtf(s * (1.f / 1024.f) + EPS);
        const f32x4 g2 = ag[mt] * rs, uu = au[mt] * rs;
        const f32x4 g0 = *(const f32x4*)(sconv + ((size_t)sb * 2 + 0) * DFF + c0), g1 = *(const f32x4*)(sconv + ((size_t)sb * 2 + 1) * DFF + c0);
        float* o = F.out + O_CONVS + (size_t)sb * 2 * DFF + c0; *(f32x4*)o = g1; *(f32x4*)(o + DFF) = g2;
        float a[4];
#pragma unroll
        for (int i = 0; i < 4; ++i) a[i] = gelu_tanh(bb[i] + w0[i] * g0[i] + w1[i] * g1[i] + w2[i] * g2[i]) * uu[i];
        u32x2 w; w.x = pk2(a[0], a[1]); w.y = pk2(a[2], a[3]);
        *(u32x2*)(WSP(bf16, WS_ACT) + (size_t)(NTOKP + sb) * DFF + c0) = w; }
}
__device__ __forceinline__ void s9_down(Frame& F, int t) {
    const int lane = LANE_, r = lane & 15, q = lane >> 4, nt = t / 11, kc = t % 11;
    f32x4 acc[2]; float ssq[2]; skinny_mma<false>(acc, ssq, WSP(bf16, WS_ACT) + (size_t)NTOKP * DFF, DFF, WSP(bf16, WS_WTDOWN), DFF, 16 * nt, 256 * kc, 8, r, q);
    float* ys = F.out + O_YS;
#pragma unroll
    for (int mt = 0; mt < 2; ++mt) { float* d = ys + (size_t)(16 * mt + r) * 1024 + 16 * nt + 4 * q;
#pragma unroll
        for (int i = 0; i < 4; ++i) atomicAdd(d + i, acc[mt][i]); }
}

constexpr int N_PHASES = 9;
__global__ void __launch_bounds__(NTHR, 2) mega_fwd(Args args) {
    extern __shared__ __attribute__((aligned(16))) unsigned char lds_raw[];
    cg::grid_group grid = cg::this_grid();
    Frame F;
    F.lds = (LAS unsigned char*)lds_raw;
    F.wave = __builtin_amdgcn_readfirstlane((int)(threadIdx.x >> 6));
    F.G = gridDim.x; F.bid = blockIdx.x; F.gw = F.bid * NWAVES + F.wave; F.NGW = F.G * NWAVES;
    F.in = args.in; F.out = args.out; F.ws = args.ws;
    const int lo = args.ph_lo, hi = args.ph_hi, sub = args.sub;
    volatile LAS unsigned* xst = (volatile LAS unsigned*)(F.lds + 152640);
    if (threadIdx.x < 2) xst[threadIdx.x] = 0u;
    __syncthreads();
    XcdBarrier xbar; xbar.bar = (unsigned*)(args.ws + WS_CTL); xbar.x = 0; xbar.st = xst;
    if (lo == 0 && hi == N_PHASES) xbar = xcd_barrier_post((unsigned*)(args.ws + WS_CTL), xst);
#define SUB(i) ((sub >> (i)) & 1)
#ifndef PROBE_REP
#define PROBE_REP -1
#endif
#define IN(k) (lo <= (k) && (k) < hi)
#define REP(k) for (int rep_ = 0; rep_ < ((k) == PROBE_REP ? 2 : 1); ++rep_)
#define SEAM(k) do { if (IN(k) && IN((k) + 1)) { xcd_barrier(xbar); } { unsigned char* w_ = F.ws; asm volatile("" : "+s"(w_)); F.ws = w_; float* o_ = F.out; asm volatile("" : "+s"(o_)); F.out = o_; } } while (0)
    typedef pg8::StaticOrder SO;
    if (lo < 0) grid.sync();
    int p2_gla_sample_task = -1;
    constexpr int KSPLIT = 9;

    REP(0) if (IN(0)) { p0_prologue(F); }
    SEAM(0);
    if (IN(1)) {
        { pg8::Gemm g{WSP(bf16, WS_XN), WSP(bf16, WS_WTIN), MPAD, DINP, 1024}; SO S; S.init(MPAD, DINP, F.G, F.bid);
          pg8::EpiStore E{WSP(bf16, WS_PROJ), DINP, nullptr};
          pg8::gemm_phase<pg8::EpiStore, SO, true, true>(F.lds, g, S, E, F.wave); }
        __syncthreads();
        { pg8::Gemm g{WSP(bf16, WS_MN), WSP(bf16, WS_WTMEM), 512, 1024, 1024}; SO S; S.init(512, 1024, F.G, F.G - 1 - F.bid);
          pg8::EpiStore E{WSP(bf16, WS_MEMPROJ), 1024, nullptr};
          pg8::gemm_phase<pg8::EpiStore, SO, true, true>(F.lds, g, S, E, F.wave); }
    }
    SEAM(1);
    if (IN(2)) {
        if (F.G == 256) {
            const int bid = F.bid;
            if (bid >= 16) { const bool cblk = bid < 136; const int pidx = ((cblk ? bid - 16 : bid - 136) << 3) + F.wave;
                if (SUB(0)) { const int k0 = cblk ? 0 : KSPLIT, k1 = cblk ? KSPLIT : 18; TokRaw raw = p2_token_load(F, k0 * 960 + pidx);
                    for (int k = k0; k < k1; ++k) { const int tok = k * 960 + pidx; if (tok >= NTOK) break; const int tn = (k + 1 < k1 && tok + 960 < NTOK) ? tok + 960 : tok; const TokRaw nxt = p2_token_load(F, tn); p2_token(F, tok, raw); raw = nxt; }
                    if (!cblk && pidx < 512) p2_memrow(F, pidx); }
                if (!cblk && SUB(3) && pidx < SB * 4) p2_gla_sample_task = pidx; }
            if (SUB(1) && bid < CMP_TASKS_S + CMP_TASKS_P) p2_compress(F, bid);
            if (SUB(2)) { if (bid < 16) { __syncthreads(); p2_gla_chunk(F, bid); }
                else if (bid >= 136) { for (int c2 = 0; c2 < 2; ++c2) { __syncthreads(); p2_gla_chunk(F, 16 + (bid - 136) * 2 + c2); } } }
            __syncthreads();
            if (p2_gla_sample_task >= 0) p2_gla_sample(F, p2_gla_sample_task);
        } else {
            if (SUB(0)) { for (int tok = F.gw; tok < NTOK; tok += F.NGW) p2_token(F, tok, p2_token_load(F, tok));
            for (int row = F.gw; row < 512; row += F.NGW) p2_memrow(F, row); }
            if (SUB(1)) for (int t = F.bid; t < CMP_TASKS_S + CMP_TASKS_P; t += F.G) p2_compress(F, t);
            if (SUB(2)) for (int bc = F.bid; bc < 256; bc += F.G) { __syncthreads(); p2_gla_chunk(F, bc); }
            __syncthreads();
            if (SUB(3)) for (int t = F.gw; t < SB * 4; t += F.NGW) p2_gla_sample(F, t);
        }
    }
    SEAM(2);
    REP(3) if (IN(3)) {
        nsa_tables(F);
        const float mb = nsa_bound(F);
        if (SUB(4)) for (int n = F.bid; n < 1024; n += F.G) p3_nsa_prompt(F, n, mb, (sub >> 8) & 255);
        __syncthreads();
        if (SUB(7)) for (int t = F.gw; t < 1024; t += F.NGW) p3_gla_scan(F, t);
    }
    SEAM(3);
    if (IN(4)) {
        nsa_tables(F);
        if (!SUB(5)) {} else if (F.G == 256) { if (F.bid >= 192) p3_nsa_sample(F, 255 - F.bid, 0); else if (F.bid >= 128) p3_nsa_sample(F, 191 - F.bid, 1); }
        else for (int t = F.bid; t < SB * 4; t += F.G) p3_nsa_sample(F, t >> 1, t & 1);
        __syncthreads();
        { const float gq = absmax_arr(F.in[I_GXQ], 128, LANE_), gk = absmax_arr(F.in[I_GXK], 128, LANE_);
          const float mbx = 11.313708498984761f * gq * gk * 1.02f * LOG2E;
          if (SUB(6)) for (int t = F.bid; t < 256; t += F.G) p3_xatt(F, t, mbx); }
        __syncthreads();
        if (!SUB(0)) {} else if (F.G == 256) { if (F.bid >= 64 && F.bid < 192) p3_xatt_sample(F, F.bid - 64); } else for (int t = F.bid; t < SB * 4; t += F.G) p3_xatt_sample(F, t);
        __syncthreads();
        if (!SUB(1)) {} else if (F.G == 256) {
            if (F.bid < 128) { for (int k = 0; k < 3; ++k) p4_gla_out(F, k * 1024 + F.gw); }
            else if (F.bid < 192) { const int wi = ((F.bid - 128) << 3) + F.wave; for (int k = 0; k < 2; ++k) p4_gla_out(F, 3072 + k * 512 + wi); }
        } else for (int t = F.gw; t < 4096; t += F.NGW) p4_gla_out(F, t);
    }
    SEAM(4);
    if (IN(5)) {
        const bf16* gate = WSP(bf16, WS_PROJ) + C_MG;
        for (int t = F.gw; t < 384; t += F.NGW) s5_merge(F, t);
        { pg8::Gemm g{WSP(bf16, WS_ONSA), WSP(bf16, WS_WTNSA), NTOKP, 1024, 512}; SO S; S.init(NTOKP, 1024, F.G, F.bid);
          pg8::EpiMerge<0> E{gate, DINP, WSP(bf16, WS_MERGED), 1024};
          pg8::gemm_phase<pg8::EpiMerge<0>, SO, true, true>(F.lds, g, S, E, F.wave); }
        __syncthreads();
        { pg8::Gemm g{WSP(bf16, WS_OGLA), WSP(bf16, WS_WTGLA), NTOKP, 1024, 512}; SO S; S.init(NTOKP, 1024, F.G, F.bid);
          pg8::EpiMerge<1> E{gate + 1024, DINP, WSP(bf16, WS_MERGED), 1024};
          pg8::gemm_phase<pg8::EpiMerge<1>, SO, true, true>(F.lds, g, S, E, F.wave); }
        __syncthreads();
        { pg8::Gemm g{WSP(bf16, WS_OX), WSP(bf16, WS_WTX), NTOKP, 1024, 512}; SO S; S.init(NTOKP, 1024, F.G, F.bid);
          pg8::EpiMerge<1> E{gate + 2048, DINP, WSP(bf16, WS_MERGED), 1024};
          pg8::gemm_phase<pg8::EpiMerge<1>, SO, true, true>(F.lds, g, S, E, F.wave); }
    }
    SEAM(5);
    if (IN(6)) {
        for (int t = F.gw; t < 256; t += F.NGW) s6_wo(F, t);
        pg8::Gemm g{WSP(bf16, WS_MERGED), WSP(bf16, WS_WTO), NTOKP, 1024, 1024}; SO S; S.init(NTOKP, 1024, F.G, F.bid);
        pg8::EpiWo E{F.in[I_XP], F.in[I_XS], WSP(float, WS_X1), WSP(bf16, WS_X1B), WSP(float, WS_SSQ)};
        pg8::gemm_phase<pg8::EpiWo, SO, true, true>(F.lds, g, S, E, F.wave);
    }
    SEAM(6);
    if (IN(7)) {
        { const float* x1s = WSP(float, WS_X1S); float* ys = F.out + O_YS; for (int i = F.bid * NTHR + TID_; i < SB * 1024; i += F.G * NTHR) ys[i] = x1s[i]; }
        for (int t = F.gw; t < 176; t += F.NGW) s7_up(F, t);
        pg8::Gemm g{WSP(bf16, WS_X1B), WSP(bf16, WS_WTUP), 65 * 256, DUP, 1024, 254}; SO S; S.init(65 * 256, DUP, F.G, F.bid);
        pg8::EpiUpConv E{WSP(bf16, WS_ACT), WSP(float, WS_SSQ), F.in[I_CONVW], F.in[I_CONVB], F.out + O_CONVP, (LAS pg8::u32x4*)(F.lds + RING_BYTES)};
        pg8::gemm_phase<pg8::EpiUpConv, SO, true, true>(F.lds, g, S, E, F.wave);
    }
    SEAM(7);
    if (IN(8)) {
        for (int t = F.gw; t < 704; t += F.NGW) s9_down(F, t);
        pg8::Gemm g{WSP(bf16, WS_ACT), WSP(bf16, WS_WTDOWN), NTOKP, 1024, DFF}; SO S; S.init(NTOKP, 1024, F.G, F.bid);
        pg8::EpiDown E{WSP(float, WS_X1), F.out + O_Y, F.out + O_YS};
        pg8::gemm_phase<pg8::EpiDown, SO, true, true>(F.lds, g, S, E, F.wave);
    }
#undef IN
#undef SEAM
}

extern "C" void kernel_launch(void* const* d_in, const int* in_sizes, int n_in, void* d_out, int out_size, void* d_ws, size_t ws_size, hipStream_t stream) {
    static int grid = 0;
    if (grid == 0) {
        if (n_in != N_IN || (size_t)out_size != O_END || ws_size < WS_END) {
            fprintf(stderr, "kernel_launch: built for %d inputs, %zu outputs, >= %zu bytes of workspace; got %d, %d, %zu\n", (int)N_IN, (size_t)O_END, (size_t)WS_END, n_in, out_size, ws_size); grid = -1; return; }
        int dev = 0, cus = 0, per_cu = 0;
        if (hipGetDevice(&dev) != hipSuccess || hipDeviceGetAttribute(&cus, hipDeviceAttributeMultiprocessorCount, dev) != hipSuccess) { grid = -1; return; }
        if (hipFuncSetAttribute((const void*)mega_fwd, hipFuncAttributeMaxDynamicSharedMemorySize, LDS_BYTES) != hipSuccess) { fprintf(stderr, "kernel_launch: hipFuncSetAttribute failed\n"); grid = -1; return; }
        if (hipOccupancyMaxActiveBlocksPerMultiprocessor(&per_cu, (const void*)mega_fwd, NTHR, LDS_BYTES) != hipSuccess || per_cu < 1) { fprintf(stderr, "kernel_launch: occupancy query gave %d\n", per_cu); per_cu = 1; }
        (void)hipGetLastError();
        grid = cus * (per_cu < 1 ? 1 : 1);
    }
    if (grid < 0) return;
    Args a{};
    for (int i = 0; i < N_IN; ++i) a.in[i] = (const float*)d_in[i];
    a.out = (float*)d_out; a.ws = (unsigned char*)d_ws;
#if MK_N_LAUNCHES == 1
    a.ph_lo = 0; a.ph_hi = N_PHASES; a.sub = 0xff;
    (void)hipMemsetAsync((unsigned char*)d_ws + WS_CTL, 0, CTL_BYTES, stream);
    void* kargs[] = {&a};
    hipError_t e = hipLaunchCooperativeKernel((const void*)mega_fwd, dim3(grid), dim3(NTHR), kargs, LDS_BYTES, stream);
    if (e != hipSuccess) fprintf(stderr, "kernel_launch: cooperative launch failed: %s (grid %d)\n", hipGetErrorString(e), grid);
#ifdef PROBE_EXTRA
    a.ph_lo = PROBE_EXTRA; a.ph_hi = PROBE_EXTRA + 1;
#ifdef PROBE_SUB
    a.sub = PROBE_SUB;
#endif
    hipLaunchKernelGGL(mega_fwd, dim3(grid), dim3(NTHR), LDS_BYTES, stream, a);
#endif
#else
    a.sub = 0xff;
    for (int p = 0; p < N_PHASES; ++p) { a.ph_lo = p; a.ph_hi = p + 1; hipLaunchKernelGGL(mega_fwd, dim3(grid), dim3(NTHR), LDS_BYTES, stream, a); }
#endif
}
```

```cpp
#include <hip/hip_runtime.h>
#include <hip/hip_cooperative_groups.h>
#include <cstdio>
#include <cstdint>
namespace cg = cooperative_groups;
#ifndef MK_N_LAUNCHES
#define MK_N_LAUNCHES 1
#endif
namespace pg8 {
#define PG8_LAS __attribute__((address_space(3)))
typedef unsigned short bf16_t;
typedef short bf16x8 __attribute__((ext_vector_type(8)));
typedef float f32x4 __attribute__((ext_vector_type(4)));
typedef unsigned u32x4 __attribute__((ext_vector_type(4)));
constexpr int BM = 256, BK = 64, HALF = 128, HTB = HALF * BK * 2  , STAGE_BYTES = 8 * HTB, NXCD = 8, WGM = 8;

__host__ __device__ __forceinline__ int lds_byte(int r, int c) { const int st = (r >> 4) * 2 + (c >> 5), rr = r & 15, cc = c & 31, ob = rr * 64 + cc * 2; return st * 1024 + (ob ^ (((ob >> 9) & 1) << 5)); }
__host__ __device__ __forceinline__ void stage_rc(int b, int& R, int& C) { const int st = b / 1024, sb = b % 1024, swz = sb ^ (((sb >> 9) & 1) << 5); R = (st >> 1) * 16 + swz / 64; C = (st & 1) * 32 + (swz % 64) / 2; }
__host__ __device__ __forceinline__ int perm32(int rho) { const int n = rho >> 4, i = rho & 15; return 8 * (i >> 2) + 4 * n + (i & 3); }

struct Unit { int pm, pn; };
struct Gemm { const bf16_t* A; const bf16_t* Bt; int M, N, K; int rstep = 256; };

struct StaticOrder {
    int nM, nN, nwg, G, c;
    __host__ __device__ void init(int M, int N, int G_, int c_) { nM = M / BM; nN = N / BM; nwg = nM * nN; G = G_; c = c_; }
    __host__ __device__ bool next(int i, Unit& u) const {
        const long L = (long)i * G + c; if (L >= nwg) return false;
        int wgid = (int)L; { const int q = nwg / NXCD, r = nwg % NXCD, xcd = wgid % NXCD, off = wgid / NXCD; wgid = (xcd < r ? xcd * (q + 1) : r * (q + 1) + (xcd - r) * q) + off; }
        const int nig = WGM * nN, gid = wgid / nig, fm = gid * WGM, gsz = (nM - fm) < WGM ? (nM - fm) : WGM;
        u.pm = fm + ((wgid % nig) % gsz); u.pn = (wgid % nig) / gsz; return true;
    }
    __device__ __forceinline__ void a_ready(const Unit&) const {}
    __device__ __forceinline__ void done(const Unit&) const {}
};

__device__ __forceinline__ unsigned cvt_pk_bf16(float lo, float hi) { unsigned r; asm volatile("v_cvt_pk_bf16_f32 %0, %1, %2" : "=v"(r) : "v"(lo), "v"(hi)); return r; }
__device__ __forceinline__ float bflo(unsigned w) { return __uint_as_float(w << 16); }
__device__ __forceinline__ float bfhi(unsigned w) { return __uint_as_float(w & 0xffff0000u); }
__device__ __forceinline__ float sigm(float x) { return 1.0f / (1.0f + __expf(-x)); }
struct EpiStore {
    static constexpr bool PERM = true, AFTER_DRAIN = false;
    bf16_t* O; int ldc; const float* ssq;
    __device__ __forceinline__ void operator()(const f32x4 (&acc)[2][2][4][2], const Unit& u, int wr, int wc, int fr, int fq) const {
        const int row0 = u.pm * BM + wr * 64 + fr, col0 = u.pn * BM + wc * 32 + 8 * fq;
#pragma unroll
        for (int ai = 0; ai < 2; ++ai)
#pragma unroll
            for (int m = 0; m < 4; ++m) { const int row = row0 + ai * HALF + m * 16; bf16_t* rowp = O + (size_t)row * ldc + col0;
                const float sc = ssq ? rsqrtf(ssq[row] * (1.0f / 1024.0f) + 1e-6f) : 1.0f;
#pragma unroll
                for (int bj = 0; bj < 2; ++bj) { const f32x4 v0 = acc[ai][bj][m][0] * sc, v1 = acc[ai][bj][m][1] * sc;
                    u32x4 w; w.x = cvt_pk_bf16(v0[0], v0[1]); w.y = cvt_pk_bf16(v0[2], v0[3]); w.z = cvt_pk_bf16(v1[0], v1[1]); w.w = cvt_pk_bf16(v1[2], v1[3]);
                    *(u32x4*)(rowp + bj * HALF) = w; } }
    }
};
template <int ACCUM> struct EpiMerge {
    static constexpr bool PERM = true, AFTER_DRAIN = false;
    const bf16_t* gate; int ldg; bf16_t* O; int ldc;
    __device__ __forceinline__ void operator()(const f32x4 (&acc)[2][2][4][2], const Unit& u, int wr, int wc, int fr, int fq) const {
        const int row0 = u.pm * BM + wr * 64 + fr, col0 = u.pn * BM + wc * 32 + 8 * fq;
#pragma unroll
        for (int ai = 0; ai < 2; ++ai)
#pragma unroll
            for (int m = 0; m < 4; ++m) { const int row = row0 + ai * HALF + m * 16; bf16_t* rowp = O + (size_t)row * ldc + col0; const bf16_t* gp = gate + (size_t)row * ldg + col0;
#pragma unroll
                for (int bj = 0; bj < 2; ++bj) {
                    const u32x4 g = *(const u32x4*)(gp + bj * HALF);
                    f32x4 v0 = acc[ai][bj][m][0], v1 = acc[ai][bj][m][1];
                    v0[0] *= sigm(bflo(g.x)); v0[1] *= sigm(bfhi(g.x)); v0[2] *= sigm(bflo(g.y)); v0[3] *= sigm(bfhi(g.y));
                    v1[0] *= sigm(bflo(g.z)); v1[1] *= sigm(bfhi(g.z)); v1[2] *= sigm(bflo(g.w)); v1[3] *= sigm(bfhi(g.w));
                    if (ACCUM) { const u32x4 o = *(const u32x4*)(rowp + bj * HALF);
                        v0[0] += bflo(o.x); v0[1] += bfhi(o.x); v0[2] += bflo(o.y); v0[3] += bfhi(o.y);
                        v1[0] += bflo(o.z); v1[1] += bfhi(o.z); v1[2] += bflo(o.w); v1[3] += bfhi(o.w); }
                    u32x4 w; w.x = cvt_pk_bf16(v0[0], v0[1]); w.y = cvt_pk_bf16(v0[2], v0[3]); w.z = cvt_pk_bf16(v1[0], v1[1]); w.w = cvt_pk_bf16(v1[2], v1[3]);
                    *(u32x4*)(rowp + bj * HALF) = w; } }
    }
};
struct MergeOrder {
    StaticOrder S0;
    __host__ __device__ void init(int G_, int c_) { S0.init(16384, 1024, G_, c_); }
    __host__ __device__ bool next(int i, Unit& u) const { Unit b; if (!S0.next(i / 3, b)) return false; const int br = i % 3; u.pm = 65 * br + b.pm; u.pn = 4 * br + b.pn; return true; }
    __device__ __forceinline__ void a_ready(const Unit&) const {}
    __device__ __forceinline__ void done(const Unit&) const {}
};
struct EpiMergeAll {
    static constexpr bool PERM = true, AFTER_DRAIN = false;
    const bf16_t* gate; int ldg; bf16_t* O; int ldc;
    __device__ __forceinline__ void operator()(const f32x4 (&acc)[2][2][4][2], const Unit& u, int wr, int wc, int fr, int fq) const {
        const int br = u.pn >> 2; Unit r; r.pm = u.pm - 65 * br; r.pn = u.pn & 3;
        if (br == 0) { EpiMerge<0> E{gate, ldg, O, ldc}; E(acc, r, wr, wc, fr, fq); }
        else { EpiMerge<1> E{gate + br * 1024, ldg, O, ldc}; E(acc, r, wr, wc, fr, fq); }
    }
};
struct EpiWo {
    static constexpr bool PERM = true, AFTER_DRAIN = false;
    const float* xp; const float* xs; bf16_t* X1B; float* ssq;
    __device__ __forceinline__ void operator()(const f32x4 (&acc)[2][2][4][2], const Unit& u, int wr, int wc, int fr, int fq) const {
        const int row0 = u.pm * BM + wr * 64 + fr, col0 = u.pn * BM + wc * 32 + 8 * fq;
#pragma unroll
        for (int ai = 0; ai < 2; ++ai)
#pragma unroll
            for (int m = 0; m < 4; ++m) { const int row = row0 + ai * HALF + m * 16;
                const float* xr = row < 16384 ? xp + (size_t)row * 1024 : (row < 16416 ? xs + (size_t)(row - 16384) * 1024 : nullptr);
                float ss = 0.f;
#pragma unroll
                for (int bj = 0; bj < 2; ++bj) { const int col = col0 + bj * HALF;
                    f32x4 x0 = (f32x4){0.f, 0.f, 0.f, 0.f}, x1 = x0;
                    if (xr) { x0 = *(const f32x4*)(xr + col); x1 = *(const f32x4*)(xr + col + 4); }
                    const f32x4 v0 = acc[ai][bj][m][0] + x0, v1 = acc[ai][bj][m][1] + x1;
                    u32x4 w; w.x = cvt_pk_bf16(v0[0], v0[1]); w.y = cvt_pk_bf16(v0[2], v0[3]); w.z = cvt_pk_bf16(v1[0], v1[1]); w.w = cvt_pk_bf16(v1[2], v1[3]);
                    *(u32x4*)(X1B + (size_t)row * 1024 + col) = w;
                    ss += (v0[0] * v0[0] + v0[1] * v0[1]) + (v0[2] * v0[2] + v0[3] * v0[3]) + (v1[0] * v1[0] + v1[1] * v1[1]) + (v1[2] * v1[2] + v1[3] * v1[3]); }
                ss += __shfl_xor(ss, 16); ss += __shfl_xor(ss, 32);
                if (fq == 0) atomicAdd(ssq + row, ss); }
    }
};
struct EpiDown {
    static constexpr bool PERM = true, AFTER_DRAIN = false;
    const bf16_t* X1B; float* yp;
    __device__ __forceinline__ void operator()(const f32x4 (&acc)[2][2][4][2], const Unit& u, int wr, int wc, int fr, int fq) const {
        const int row0 = u.pm * BM + wr * 64 + fr, col0 = u.pn * BM + wc * 32 + 8 * fq;
#pragma unroll
        for (int ai = 0; ai < 2; ++ai)
#pragma unroll
            for (int m = 0; m < 4; ++m) { const int row = row0 + ai * HALF + m * 16;
#pragma unroll
                for (int bj = 0; bj < 2; ++bj) { const int col = col0 + bj * HALF; const u32x4 x = *(const u32x4*)(X1B + (size_t)row * 1024 + col);
                    const f32x4 x0 = (f32x4){bflo(x.x), bfhi(x.x), bflo(x.y), bfhi(x.y)}, x1 = (f32x4){bflo(x.z), bfhi(x.z), bflo(x.w), bfhi(x.w)};
                    *(f32x4*)(yp + (size_t)row * 1024 + col) = acc[ai][bj][m][0] + x0; *(f32x4*)(yp + (size_t)row * 1024 + col + 4) = acc[ai][bj][m][1] + x1; } }
    }
};

__device__ __forceinline__ float gelu_tanh_e(float x) { const float u = 0.7978845608028654f * (x + 0.044715f * x * x * x); const float ex = __expf(2.0f * u); return 0.5f * x * (2.0f - 2.0f / (ex + 1.0f)); }
typedef unsigned u32x2_e __attribute__((ext_vector_type(2)));
struct EpiUpConv {
    static constexpr bool PERM = true, AFTER_DRAIN = false;
    bf16_t* ACT; const float* ssq; const float* cw; const float* cb; float* convp; PG8_LAS u32x4* xbuf;
    __device__ __forceinline__ void operator()(const f32x4 (&acc)[2][2][4][2], const Unit& u, int wr, int wc, int fr, int fq) const {
        constexpr int DFF_ = 2816, T_ = 8192, NTOK_ = 16384;
        const int base = 254 * u.pm, c0 = 128 * u.pn + 32 * wc + 8 * fq, lane = fq * 16 + fr;
        u32x4 gp[2][4]; float rs[2][4];
#pragma unroll
        for (int ai = 0; ai < 2; ++ai)
#pragma unroll
            for (int m = 0; m < 4; ++m) { const int t = base + ai * HALF + wr * 64 + m * 16 + fr;
                const float rsv = t < NTOK_ ? rsqrtf(ssq[t] * (1.0f / 1024.0f) + 1e-6f) : 0.f; rs[ai][m] = rsv;
                const f32x4 g0 = acc[ai][1][m][0] * rsv, g1 = acc[ai][1][m][1] * rsv;
                gp[ai][m].x = cvt_pk_bf16(g0[0], g0[1]); gp[ai][m].y = cvt_pk_bf16(g0[2], g0[3]); gp[ai][m].z = cvt_pk_bf16(g1[0], g1[1]); gp[ai][m].w = cvt_pk_bf16(g1[2], g1[3]); }
        if (fr >= 14) {
#pragma unroll
            for (int ai = 0; ai < 2; ++ai) xbuf[((ai * 2 + wr) * 2 + (fr - 14)) * 16 + 4 * wc + fq] = gp[ai][3]; }
        asm volatile("s_waitcnt lgkmcnt(0)" ::: "memory"); __builtin_amdgcn_s_barrier(); asm volatile("" ::: "memory");
#define ROR1(v) ((unsigned)__builtin_amdgcn_update_dpp(0, (int)(v), 0x121, 0xf, 0xf, false))
#define ROR2(v) ((unsigned)__builtin_amdgcn_update_dpp(0, (int)(v), 0x122, 0xf, 0xf, false))
#pragma unroll
        for (int hf = 0; hf < 2; ++hf) {
            const int ch = c0 + 4 * hf;
            const f32x4 w0 = *(const f32x4*)(cw + ch), w1 = *(const f32x4*)(cw + DFF_ + ch), w2 = *(const f32x4*)(cw + 2 * DFF_ + ch), bb = *(const f32x4*)(cb + ch);
#pragma unroll
            for (int ai = 0; ai < 2; ++ai)
#pragma unroll
                for (int m = 0; m < 4; ++m) { const int lr = ai * HALF + wr * 64 + m * 16 + fr, t = base + lr, tt = t & (T_ - 1), grp = ai * 2 + wr;
                    const unsigned cx = hf ? gp[ai][m].z : gp[ai][m].x, cy = hf ? gp[ai][m].w : gp[ai][m].y;
                    const unsigned sAx = ROR1(cx), sAy = ROR1(cy), sBx = ROR2(cx), sBy = ROR2(cy);
                    unsigned pAx = 0u, pAy = 0u, pBx = 0u, pBy = 0u;
                    if (m > 0) { const unsigned px = hf ? gp[ai][m > 0 ? m - 1 : 0].z : gp[ai][m > 0 ? m - 1 : 0].x, py = hf ? gp[ai][m > 0 ? m - 1 : 0].w : gp[ai][m > 0 ? m - 1 : 0].y;
                        pAx = ROR1(px); pAy = ROR1(py); pBx = ROR2(px); pBy = ROR2(py); }
                    else if (grp > 0) { const u32x4 xa = xbuf[((grp - 1) * 2 + 1) * 16 + 4 * wc + fq], xb = xbuf[((grp - 1) * 2 + (fr == 0 ? 0 : 1)) * 16 + 4 * wc + fq];
                        pAx = hf ? xa.z : xa.x; pAy = hf ? xa.w : xa.y; pBx = hf ? xb.z : xb.x; pBy = hf ? xb.w : xb.y; }
                    unsigned h1x = fr >= 1 ? sAx : pAx, h1y = fr >= 1 ? sAy : pAy, h2x = fr >= 2 ? sBx : pBx, h2y = fr >= 2 ? sBy : pBy;
                    if (tt == 0) { h1x = 0u; h1y = 0u; h2x = 0u; h2y = 0u; } else if (tt == 1) { h2x = 0u; h2y = 0u; }
                    const float rsv = rs[ai][m];
                    const f32x4 uu = acc[ai][0][m][hf] * rsv;
                    const f32x4 g2 = (f32x4){bflo(cx), bfhi(cx), bflo(cy), bfhi(cy)}, g1 = (f32x4){bflo(h1x), bfhi(h1x), bflo(h1y), bfhi(h1y)}, g0 = (f32x4){bflo(h2x), bfhi(h2x), bflo(h2y), bfhi(h2y)};
                    const f32x4 gc = bb + w0 * g0 + w1 * g1 + w2 * g2;
                    const bool live = t < NTOK_ && !(u.pm > 0 && lr < 2);
                    if (live) { u32x2_e w; w.x = cvt_pk_bf16(gelu_tanh_e(gc[0]) * uu[0], gelu_tanh_e(gc[1]) * uu[1]); w.y = cvt_pk_bf16(gelu_tanh_e(gc[2]) * uu[2], gelu_tanh_e(gc[3]) * uu[3]);
                        *(u32x2_e*)(ACT + (size_t)t * DFF_ + ch) = w;
                        if (tt >= T_ - 2) *(f32x4*)(convp + ((size_t)(t >> 13) * 2 + (tt - (T_ - 2))) * DFF_ + ch) = acc[ai][1][m][hf] * rsv; } }
        }
#undef ROR1
#undef ROR2
    }
};
template <class Epi, class Sched, bool ALIGN_EPI = false, bool SP2 = false>
__device__ __forceinline__ void gemm_phase(PG8_LAS unsigned char* lds, const Gemm g, const Sched& S, const Epi& E, const int wid) {
    unsigned z_ = 0u; asm volatile("" : "+v"(z_));
    const int lane = (int)__builtin_amdgcn_mbcnt_hi(~0u, __builtin_amdgcn_mbcnt_lo(~0u, z_)), tid = wid * 64 + lane, wr = wid >> 2, wc = wid & 3, fr = lane & 15, fq = lane >> 4;
    const int K = g.K, nt = K / BK;
    unsigned voffA[2], voffB[2];
#pragma unroll
    for (int i = 0; i < 2; ++i) { int R, C; stage_rc(tid * 16 + i * 8192, R, C); const int Rb = Epi::PERM ? ((R & ~31) + perm32(R & 31)) : R;
        voffA[i] = (unsigned)(R * K + C) * 2u; voffB[i] = (unsigned)(Rb * K + C) * 2u; }
    const size_t kstep = (size_t)(BK * 2);
    const size_t hstep = (size_t)HALF * K * 2;
    const size_t tstep = 2 * hstep;
    const size_t tstepA = (size_t)g.rstep * K * 2;
    const unsigned ldsw = (unsigned)wid * 1024u;
    const int aoff = lds_byte(wr * 64 + fr, fq * 8), boff = lds_byte(wc * 32 + fr, fq * 8);
#define PG8_SA(b, h) (((b) * 2 + (h)) * HTB)
#define PG8_SB(b, h) ((4 + (b) * 2 + (h)) * HTB)
#define PG8_STAGE(bufoff, gbase, voff) do { _Pragma("unroll") for (int _i = 0; _i < 2; ++_i) \
        __builtin_amdgcn_global_load_lds((const unsigned*)((const char*)(gbase) + (voff)[_i]), (PG8_LAS unsigned*)(lds + (bufoff) + ldsw + _i * 8192), 16, 0, 0); } while (0)
#define PG8_LDA(dst, b, h) do { _Pragma("unroll") for (int m = 0; m < 4; ++m) _Pragma("unroll") for (int k = 0; k < 2; ++k) dst[m][k] = *(const PG8_LAS bf16x8*)(lds + PG8_SA(b, h) + aoff + m * 2048 + k * 1024); } while (0)
#define PG8_LDB(dst, b, h) do { _Pragma("unroll") for (int n = 0; n < 2; ++n) _Pragma("unroll") for (int k = 0; k < 2; ++k) dst[n][k] = *(const PG8_LAS bf16x8*)(lds + PG8_SB(b, h) + boff + n * 2048 + k * 1024); } while (0)
#define PG8_MMA(ai, bj, At, Bt) do { __builtin_amdgcn_s_setprio(1); _Pragma("unroll") for (int m = 0; m < 4; ++m) _Pragma("unroll") for (int n = 0; n < 2; ++n) _Pragma("unroll") for (int k = 0; k < 2; ++k) \
        acc[ai][bj][m][n] = __builtin_amdgcn_mfma_f32_16x16x32_bf16(Bt[n][k], At[m][k], acc[ai][bj][m][n], 0, 0, 0); __builtin_amdgcn_s_setprio(0); } while (0)
#define PG8_WAIT_V(n) asm volatile("s_waitcnt vmcnt(" #n ")" ::: "memory")
#define PG8_WAIT_L(n) asm volatile("s_waitcnt lgkmcnt(" #n ")" ::: "memory")
#define PG8_BAR __builtin_amdgcn_s_barrier()
#define PG8_SCHED __builtin_amdgcn_sched_barrier(0)
    Unit cur, nxt; int ui = 0;
    if (!S.next(0, cur)) return;
    f32x4 acc[2][2][4][2];
#pragma unroll
    for (int a = 0; a < 2; ++a)
#pragma unroll
        for (int b = 0; b < 2; ++b)
#pragma unroll
            for (int m = 0; m < 4; ++m)
#pragma unroll
                for (int n = 0; n < 2; ++n) acc[a][b][m][n] = (f32x4){0.f, 0.f, 0.f, 0.f};
    bf16x8 At[4][2], B0[2][2], B1[2][2];
    const char* cA = (const char*)g.A + (size_t)cur.pm * tstepA; const char* cB = (const char*)g.Bt + (size_t)cur.pn * tstep;
    S.a_ready(cur);
    if constexpr (SP2) {
        PG8_STAGE(PG8_SB(0, 0), cB, voffB); PG8_STAGE(PG8_SB(0, 1), cB + hstep, voffB); PG8_STAGE(PG8_SA(0, 0), cA, voffA); PG8_STAGE(PG8_SA(0, 1), cA + hstep, voffA);
        if (wr == 1) PG8_BAR;
        PG8_WAIT_V(2); PG8_BAR;
        PG8_STAGE(PG8_SB(1, 0), cB + kstep, voffB); PG8_STAGE(PG8_SA(1, 0), cA + kstep, voffA); PG8_STAGE(PG8_SB(1, 1), cB + hstep + kstep, voffB);
        PG8_WAIT_V(6); PG8_BAR;
    } else {
        PG8_STAGE(PG8_SB(0, 0), cB, voffB); PG8_STAGE(PG8_SA(0, 0), cA, voffA); PG8_STAGE(PG8_SB(0, 1), cB + hstep, voffB); PG8_STAGE(PG8_SA(0, 1), cA + hstep, voffA);
        if (wr == 1) PG8_BAR;
        PG8_WAIT_V(4); PG8_BAR;
        PG8_STAGE(PG8_SB(1, 0), cB + kstep, voffB); PG8_STAGE(PG8_SA(1, 0), cA + kstep, voffA); PG8_STAGE(PG8_SB(1, 1), cB + hstep + kstep, voffB);
        PG8_WAIT_V(6); PG8_BAR;
    }
    for (;;) {
        const bool has_next = S.next(ui + 1, nxt);
        const char* nA = has_next ? (const char*)g.A + (size_t)nxt.pm * tstepA : cA; const char* nB = has_next ? (const char*)g.Bt + (size_t)nxt.pn * tstep : cB;
        for (int t = 0; t < nt; t += 2) {
            const bool last = (t == nt - 2);
            const char* a1 = cA + (size_t)(t + 1) * kstep;
            const char* a2 = last ? nA : cA + (size_t)(t + 2) * kstep; const char* b2 = last ? nB : cB + (size_t)(t + 2) * kstep;
            const char* a3 = a2 + kstep; const char* b3 = b2 + kstep;
            if (last && has_next) S.a_ready(nxt);
            if constexpr (SP2) {
            PG8_LDB(B0, 0, 0); PG8_LDB(B1, 0, 1); PG8_SCHED; PG8_LDA(At, 0, 0); PG8_STAGE(PG8_SA(1, 1), a1 + hstep, voffA);
            PG8_WAIT_V(8); PG8_WAIT_L(0); PG8_BAR; PG8_MMA(0, 0, At, B0); PG8_MMA(0, 1, At, B1); PG8_BAR; PG8_SCHED;
            PG8_LDA(At, 0, 1); PG8_STAGE(PG8_SB(0, 0), b2, voffB); PG8_STAGE(PG8_SB(0, 1), b2 + hstep, voffB); PG8_STAGE(PG8_SA(0, 0), a2, voffA);
            PG8_WAIT_V(8); PG8_WAIT_L(0); PG8_BAR; PG8_MMA(1, 0, At, B0); PG8_MMA(1, 1, At, B1); PG8_BAR; PG8_SCHED;
            PG8_LDB(B0, 1, 0); PG8_LDB(B1, 1, 1); PG8_SCHED; PG8_LDA(At, 1, 0); PG8_STAGE(PG8_SA(0, 1), a2 + hstep, voffA);
            PG8_WAIT_V(8); PG8_WAIT_L(0); PG8_BAR; PG8_MMA(0, 0, At, B0); PG8_MMA(0, 1, At, B1); PG8_BAR; PG8_SCHED;
            PG8_LDA(At, 1, 1); PG8_STAGE(PG8_SB(1, 0), b3, voffB); PG8_STAGE(PG8_SB(1, 1), b3 + hstep, voffB); PG8_STAGE(PG8_SA(1, 0), a3, voffA);
            PG8_WAIT_V(8); PG8_WAIT_L(0); PG8_BAR; PG8_MMA(1, 0, At, B0); PG8_MMA(1, 1, At, B1); PG8_BAR; PG8_SCHED;
            } else {
            PG8_LDB(B0, 0, 0); PG8_SCHED; PG8_LDA(At, 0, 0); PG8_STAGE(PG8_SA(1, 1), a1 + hstep, voffA);
            PG8_WAIT_L(8); PG8_BAR; PG8_WAIT_L(0); PG8_MMA(0, 0, At, B0); PG8_BAR; PG8_SCHED;
            PG8_LDB(B1, 0, 1); PG8_STAGE(PG8_SB(0, 0), b2, voffB);
            PG8_BAR; PG8_WAIT_L(0); PG8_MMA(0, 1, At, B1); PG8_BAR;
            PG8_LDA(At, 0, 1); PG8_STAGE(PG8_SA(0, 0), a2, voffA);
            PG8_BAR; PG8_WAIT_L(0); PG8_MMA(1, 0, At, B0); PG8_BAR; PG8_SCHED;
            PG8_STAGE(PG8_SB(0, 1), b2 + hstep, voffB);
            PG8_WAIT_V(6); PG8_BAR; PG8_MMA(1, 1, At, B1); PG8_BAR;
            PG8_LDB(B0, 1, 0); PG8_SCHED; PG8_LDA(At, 1, 0); PG8_STAGE(PG8_SA(0, 1), a2 + hstep, voffA);
            PG8_WAIT_L(8); PG8_BAR; PG8_WAIT_L(0); PG8_MMA(0, 0, At, B0); PG8_BAR; PG8_SCHED;
            PG8_LDB(B1, 1, 1); PG8_STAGE(PG8_SB(1, 0), b3, voffB);
            PG8_BAR; PG8_WAIT_L(0); PG8_MMA(0, 1, At, B1); PG8_BAR;
            PG8_LDA(At, 1, 1); PG8_STAGE(PG8_SA(1, 0), a3, voffA);
            PG8_BAR; PG8_WAIT_L(0); PG8_MMA(1, 0, At, B0); PG8_BAR; PG8_SCHED;
            PG8_STAGE(PG8_SB(1, 1), b3 + hstep, voffB);
            PG8_WAIT_V(6); PG8_BAR; PG8_MMA(1, 1, At, B1); PG8_BAR;
            }
        }
        if constexpr (ALIGN_EPI) { if (wr == 0) PG8_BAR; }
        if constexpr (!Epi::AFTER_DRAIN) { E(acc, cur, wr, wc, fr, fq); S.done(cur); }
        if (!has_next) break;
#pragma unroll
        for (int a = 0; a < 2; ++a)
#pragma unroll
            for (int b = 0; b < 2; ++b)
#pragma unroll
                for (int m = 0; m < 4; ++m)
#pragma unroll
                    for (int n = 0; n < 2; ++n) acc[a][b][m][n] = (f32x4){0.f, 0.f, 0.f, 0.f};
        cur = nxt; cA = nA; cB = nB; ++ui;
        if constexpr (ALIGN_EPI) { if (wr == 1) PG8_BAR; }
    }
    PG8_WAIT_V(0);
    if constexpr (!ALIGN_EPI) { if (wr == 0) PG8_BAR; }
    PG8_BAR;
    if constexpr (Epi::AFTER_DRAIN) { E.fused(acc, cur, wr, wc, fr, fq, lds, wid, lane); S.done(cur); }
#undef PG8_SA
#undef PG8_SB
#undef PG8_STAGE
#undef PG8_LDA
#undef PG8_LDB
#undef PG8_MMA
#undef PG8_WAIT_V
#undef PG8_WAIT_L
#undef PG8_BAR
#undef PG8_SCHED
}
}

typedef unsigned short bf16;
typedef short bf16x8 __attribute__((ext_vector_type(8)));
typedef short bf16x4 __attribute__((ext_vector_type(4)));
typedef float f32x4 __attribute__((ext_vector_type(4)));
typedef unsigned u32x4 __attribute__((ext_vector_type(4)));
typedef unsigned u32x2 __attribute__((ext_vector_type(2)));
#define LAS __attribute__((address_space(3)))
constexpr int NWAVES = 8, NTHR = 512;
constexpr int DM = 1024, T = 8192, NB = 2, NTOKP = NB * T, SB = 32, NTOK = NTOKP + SB, MPAD = 16640;
constexpr int DIN = 6440, DINP = 6656, DFF = 2816, DUP = 2 * DFF;
constexpr int C_Q = 0, C_KV = 512, C_G = 1280, C_GQ = 1304, C_GK = 1560, C_GV = 1816, C_LR = 2328, C_GR = 2344, C_XQ = 2856, C_MG = 3368;
constexpr float EPS = 1e-6f, LOG2E = 1.4426950408889634f;
constexpr float QSCALE = 0.125f * LOG2E;
constexpr float XSCALE = 0.08838834764831845f * LOG2E;
constexpr size_t O_Y = 0, O_YS = 16777216, O_KVP = O_YS + 32768, O_WINP = O_KVP + 8388608, O_GLAP = O_WINP + 262144, O_CONVP = O_GLAP + 65536,
                 O_MEMP = O_CONVP + 11264, O_KVS = O_MEMP + 524288, O_WINS = O_KVS + 16384, O_GLAS = O_WINS + 4194304, O_CONVS = O_GLAS + 1048576, O_END = O_CONVS + 180224;
enum { I_XP = 0, I_XS, I_CKV, I_CWIN, I_SGLA, I_SCONV, I_CMEM, I_PT, I_MEMP, I_GMIX, I_WIN, I_GNQ, I_GNK, I_CKPE, I_CKW1, I_CKW2, I_CVPE, I_CVW1, I_CVW2,
       I_RB, I_WGG, I_BGG, I_GGO, I_GMEM, I_WMEM, I_GXQ, I_GXK, I_WNSA, I_WGLA, I_WX, I_WO, I_GFFN, I_WUP, I_CONVW, I_CONVB, I_WDOWN, N_IN };
constexpr size_t al_(size_t x) { return (x + 255) & ~(size_t)255; }
constexpr size_t WS_SSQ = 0;
constexpr size_t WS_C0 = al_(WS_SSQ + (size_t)MPAD * 4);
constexpr size_t WS_WTIN = al_(WS_C0 + 1024);
constexpr size_t WS_WTMEM = al_(WS_WTIN + (size_t)DINP * 1024 * 2);
constexpr size_t WS_WTNSA = al_(WS_WTMEM + (size_t)1024 * 1024 * 2);
constexpr size_t WS_WTGLA = al_(WS_WTNSA + (size_t)1024 * 512 * 2);
constexpr size_t WS_WTX = al_(WS_WTGLA + (size_t)1024 * 512 * 2);
constexpr size_t WS_WTO = al_(WS_WTX + (size_t)1024 * 512 * 2);
constexpr size_t WS_WTUP = al_(WS_WTO + (size_t)1024 * 1024 * 2);
constexpr size_t WS_WTDOWN = al_(WS_WTUP + (size_t)DUP * 1024 * 2);
constexpr size_t WS_W1T = al_(WS_WTDOWN + (size_t)1024 * DFF * 2);
constexpr size_t WS_W2T = al_(WS_W1T + (size_t)2 * 64 * 2048 * 2);
constexpr size_t WS_XN = al_(WS_W2T + (size_t)2 * 64 * 64 * 2);
constexpr size_t WS_MN = al_(WS_XN + (size_t)MPAD * 1024 * 2);
constexpr size_t WS_PROJ = al_(WS_MN + (size_t)512 * 1024 * 2);
constexpr size_t WS_MEMPROJ = al_(WS_PROJ + (size_t)MPAD * DINP * 2);
constexpr size_t WS_QN = al_(WS_MEMPROJ + (size_t)512 * 1024 * 2);
constexpr size_t WS_KSEL = al_(WS_QN + (size_t)NTOK * 512 * 2);
constexpr size_t WS_VSELT = al_(WS_KSEL + (size_t)4 * T * 64 * 2);
constexpr size_t WS_KWIN = al_(WS_VSELT + (size_t)4 * T * 64 * 2);
constexpr size_t WS_VWINT = al_(WS_KWIN + (size_t)4 * T * 64 * 2);
constexpr size_t WS_GATES = al_(WS_VWINT + (size_t)4 * T * 64 * 2);
constexpr size_t WS_NEWKV = al_(WS_GATES + (size_t)NTOK * 24 * 4);
constexpr size_t WS_KCMP = al_(WS_NEWKV + (size_t)SB * 4 * 2 * 64 * 4);
constexpr size_t WS_VCMPT = al_(WS_KCMP + (size_t)4 * 512 * 64 * 2);
constexpr size_t WS_KCMPS = al_(WS_VCMPT + (size_t)4 * 512 * 64 * 2);
constexpr size_t WS_VCMPS = al_(WS_KCMPS + (size_t)SB * 2 * 512 * 64 * 4);
constexpr size_t WS_QTG = al_(WS_VCMPS + (size_t)SB * 2 * 512 * 64 * 4);
constexpr size_t WS_KTG = al_(WS_QTG + (size_t)NTOKP * 256 * 2);
constexpr size_t WS_VTG = al_(WS_KTG + (size_t)NTOKP * 256 * 2);
constexpr size_t WS_UP = al_(WS_VTG + (size_t)256 * 4 * 128 * 64 * 2);
constexpr size_t WS_DEC = al_(WS_UP + (size_t)256 * 4 * 128 * 64 * 4);
constexpr size_t WS_SC = al_(WS_DEC + (size_t)256 * 4 * 64 * 4);
constexpr size_t WS_XQ = al_(WS_SC + (size_t)256 * 4 * 128 * 64 * 2);
constexpr size_t WS_KMEM = al_(WS_XQ + (size_t)NTOK * 512 * 2);
constexpr size_t WS_VMEMT = al_(WS_KMEM + (size_t)8 * 256 * 128 * 2);
constexpr size_t WS_ONSA = al_(WS_VMEMT + (size_t)8 * 256 * 128 * 2);
constexpr size_t WS_OGLA = al_(WS_ONSA + (size_t)MPAD * 512 * 2);
constexpr size_t WS_OX = al_(WS_OGLA + (size_t)MPAD * 512 * 2);
constexpr size_t WS_MERGED = al_(WS_OX + (size_t)MPAD * 512 * 2);
constexpr size_t WS_X1 = al_(WS_MERGED + (size_t)MPAD * 1024 * 2);
constexpr size_t WS_X1B = al_(WS_X1 + (size_t)MPAD * 1024 * 4);
constexpr size_t WS_UG = al_(WS_X1B + (size_t)MPAD * 1024 * 2);
constexpr size_t WS_ACT = al_(WS_UG + (size_t)MPAD * DUP * 2);
constexpr size_t WS_MS = al_(WS_ACT + (size_t)MPAD * DFF * 2);
constexpr size_t WS_X1S = al_(WS_MS + (size_t)SB * 1024 * 4);
constexpr size_t WS_ONS = al_(WS_X1S + (size_t)SB * 1024 * 4);
constexpr size_t WS_PARK = al_(WS_ONS + (size_t)SB * 512 * 4);
constexpr size_t WS_CTL = al_(WS_PARK + (size_t)2048 * 4096);
constexpr size_t CTL_BYTES = 16384;
constexpr size_t WS_END = al_(WS_CTL + CTL_BYTES);
constexpr int RING_BYTES = 131072, LDS_BYTES = 155648;

struct Args { const float* in[N_IN]; float* out; unsigned char* ws; int ph_lo, ph_hi, sub, pad; };

__device__ __forceinline__ unsigned f2bf(float f) { unsigned u = __float_as_uint(f); return (u + 0x7fffu + ((u >> 16) & 1u)) >> 16; }
__device__ __forceinline__ unsigned pk2(float lo, float hi) { return pg8::cvt_pk_bf16(lo, hi); }
__device__ __forceinline__ float bf2f(unsigned short u) { return __uint_as_float((unsigned)u << 16); }
__device__ __forceinline__ float bflo(unsigned w) { return __uint_as_float(w << 16); }
__device__ __forceinline__ float bfhi(unsigned w) { return __uint_as_float(w & 0xffff0000u); }
__device__ __forceinline__ void unpack8(const u32x4 w, float (&f)[8]) { f[0] = bflo(w.x); f[1] = bfhi(w.x); f[2] = bflo(w.y); f[3] = bfhi(w.y); f[4] = bflo(w.z); f[5] = bfhi(w.z); f[6] = bflo(w.w); f[7] = bfhi(w.w); }
__device__ __forceinline__ u32x4 pack8(const float (&f)[8]) { u32x4 w; w.x = pk2(f[0], f[1]); w.y = pk2(f[2], f[3]); w.z = pk2(f[4], f[5]); w.w = pk2(f[6], f[7]); return w; }
__device__ __forceinline__ bf16x8 as_frag(u32x4 w) { return __builtin_bit_cast(bf16x8, w); }
__device__ __forceinline__ bf16x8 frag_pk(f32x4 a, f32x4 b) { u32x4 w; w.x = pk2(a[0], a[1]); w.y = pk2(a[2], a[3]); w.z = pk2(b[0], b[1]); w.w = pk2(b[2], b[3]); return as_frag(w); }
__device__ __forceinline__ bf16x8 ldfrag(const bf16* p) { return as_frag(*(const u32x4*)p); }
__device__ __forceinline__ bf16x8 ldfrag2(const bf16* p0, const bf16* p1) { const u32x2 a = *(const u32x2*)p0, b = *(const u32x2*)p1; u32x4 w; w.x = a.x; w.y = a.y; w.z = b.x; w.w = b.y; return as_frag(w); }
__device__ __forceinline__ bf16x8 ldfrag_f32(const float* p) { const f32x4 a = *(const f32x4*)p, b = *(const f32x4*)(p + 4); return frag_pk(a, b); }
#define MFMA16(a, b, c) __builtin_amdgcn_mfma_f32_16x16x32_bf16((a), (b), (c), 0, 0, 0)
__device__ __forceinline__ float sigmoidf_(float x) { return 1.0f / (1.0f + __expf(-x)); }
__device__ __forceinline__ float gelu_tanh(float x) { const float u = 0.7978845608028654f * (x + 0.044715f * x * x * x); const float e = __expf(2.0f * u); return 0.5f * x * (2.0f - 2.0f / (e + 1.0f)); }
__device__ __forceinline__ float wave_sum(float v) {
#pragma unroll
    for (int o = 1; o < 64; o <<= 1) v += __shfl_xor(v, o);
    return v;
}
__device__ __forceinline__ float wave_max(float v) {
#pragma unroll
    for (int o = 1; o < 64; o <<= 1) v = fmaxf(v, __shfl_xor(v, o));
    return v;
}
__device__ __forceinline__ float absmax_arr(const float* g, int n, int lane) { float m = 0.f; for (int i = lane; i < n; i += 64) m = fmaxf(m, fabsf(g[i])); return wave_max(m); }
__device__ __forceinline__ int t5_bucket(int n) {
    if (n < 16) return n;
    if (n >= 128) return 31;
    const int v = 16 + (int)(__logf((float)n * 0.0625f) / 2.0794415416798357f * 16.0f);
    return v < 31 ? v : 31;
}

#define XB_TMO      128
#define XB_XCNT(j)  (256  + 64 * (j))
#define XB_XSUB(j)  (1280 + 64 * (j))
#define XB_XGEN(j)  (2304 + 64 * (j))
#define XB_TOP      3328
#define XB_TOPGEN   3392
#define XCD_BAR_WORDS 3456
#define XB_SPIN_CAP (1u << 18)

__device__ __forceinline__ unsigned xb_ld(unsigned* p)              { return __hip_atomic_load(p, __ATOMIC_RELAXED, __HIP_MEMORY_SCOPE_AGENT); }
__device__ __forceinline__ unsigned xb_add(unsigned* p, unsigned v) { return __hip_atomic_fetch_add(p, v, __ATOMIC_RELAXED, __HIP_MEMORY_SCOPE_AGENT); }
__device__ __forceinline__ unsigned xb_xcc_id() { return (unsigned)__builtin_amdgcn_s_getreg((3 << 11) | 20) & 0xFu; }
#define XB_SPIN(cond, bar) do { unsigned _sp = 0; while (cond) { __builtin_amdgcn_s_sleep(1); \
    if ((++_sp & 255u) == 0u) { if (xb_ld(&(bar)[XB_TMO])) break; if (_sp > XB_SPIN_CAP) { atomicAdd(&(bar)[XB_TMO], 1u); break; } } } } while (0)

struct XcdBarrier {
    unsigned* bar; unsigned x;
    volatile LAS unsigned* st;
};

__device__ __forceinline__ XcdBarrier xcd_barrier_post(unsigned* bar, volatile LAS unsigned* st) {
    XcdBarrier b; b.bar = bar; b.x = xb_xcc_id(); b.st = st;
    if (threadIdx.x == 0) (void)xb_add(&bar[XB_XCNT(b.x)], 1u);
    return b;
}
__device__ __forceinline__ void xcd_barrier_complete(unsigned* bar, unsigned x, unsigned& nloc, unsigned& nx) {
    const unsigned G = gridDim.x * gridDim.y * gridDim.z;
    unsigned sum, cnt, mine, sp = 0u;
    for (;;) {
        sum = 0u; cnt = 0u; mine = 0u;
#pragma unroll
        for (unsigned j = 0; j < 16; ++j) { const unsigned c = xb_ld(&bar[XB_XCNT(j)]); sum += c; cnt += (c > 0u) ? 1u : 0u; mine = (j == x) ? c : mine; }
        if (sum == G) break;
        __builtin_amdgcn_s_sleep(1);
        if ((++sp & 255u) == 0u) { if (xb_ld(&bar[XB_TMO])) break; if (sp > XB_SPIN_CAP) { atomicAdd(&bar[XB_TMO], 1u); break; } }
    }
    nloc = mine > 0u ? mine : 1u; nx = cnt > 0u ? cnt : 1u;
}

__device__ __forceinline__ void xcd_barrier(const XcdBarrier& b) {
    asm volatile("s_waitcnt vmcnt(0)" ::: "memory");
    __syncthreads();
    if (threadIdx.x == 0) {
        unsigned* bar = b.bar;
        __builtin_amdgcn_s_waitcnt(0);
        unsigned nloc = b.st[0], nx = b.st[1];
        if (nloc == 0u) { xcd_barrier_complete(bar, b.x, nloc, nx); b.st[0] = nloc; b.st[1] = nx; }
        const unsigned old = xb_add(&bar[XB_XSUB(b.x)], 1u);
        const unsigned gen = old / nloc;
        if (old + 1u == (gen + 1u) * nloc) {
            __builtin_amdgcn_fence(__ATOMIC_RELEASE, "agent");
            asm volatile("s_waitcnt vmcnt(0)" ::: "memory");
            const unsigned og = xb_add(&bar[XB_TOP], 1u);
            const unsigned tg = og / nx;
            if (og + 1u == (tg + 1u) * nx) xb_add(&bar[XB_TOPGEN], 1u);
            else XB_SPIN(xb_ld(&bar[XB_TOPGEN]) == tg, bar);
            __builtin_amdgcn_fence(__ATOMIC_ACQUIRE, "agent");
            xb_add(&bar[XB_XGEN(b.x)], 1u);
            asm volatile("s_waitcnt vmcnt(0)" ::: "memory");
        } else {
            XB_SPIN(xb_ld(&bar[XB_XGEN(b.x)]) == gen, bar);
            __builtin_amdgcn_fence(__ATOMIC_ACQUIRE, "agent");
            asm volatile("s_waitcnt vmcnt(0)" ::: "memory");
        }
    }
    __syncthreads();
}

struct Frame {
    LAS unsigned char* lds;
    int wave, G, bid, gw, NGW;
    const float* const* in; float* out; unsigned char* ws;
};
#define WSP(T_, off) ((T_*)(F.ws + (off)))
__device__ __forceinline__ int lane_id_() { unsigned z = 0u; asm volatile("" : "+v"(z)); return (int)__builtin_amdgcn_mbcnt_hi(~0u, __builtin_amdgcn_mbcnt_lo(~0u, z)); }
#define LANE_ lane_id_()
#define TID_ (F.wave * 64 + lane_id_())

__device__ __host__ __forceinline__ int upmap(int n) { return n < 2816 ? (n >> 7) * 256 + (n & 127) : ((n - 2816) >> 7) * 256 + 128 + ((n - 2816) & 127); }
template <bool UPMAP = false>
__device__ __forceinline__ void transpose_item(const float* W, int K, int N, bf16* WT, const float* kscale, LAS float* scr, int item, int nblk, int lane) {
    const int kb = item / nblk, nb = item % nblk, k0 = 64 * kb, n0 = 32 * nb, n0d = UPMAP ? upmap(n0) : n0;
#pragma unroll
    for (int i = 0; i < 8; ++i) { const int kk = 8 * i + (lane >> 3); const int n = n0 + 4 * (lane & 7);
        f32x4 v = n < N ? *(const f32x4*)(W + (size_t)(k0 + kk) * N + n) : (f32x4){0.f, 0.f, 0.f, 0.f}; if (kscale) v = v * kscale[k0 + kk];
        LAS float* d = scr + kk * 33 + 4 * (lane & 7); d[0] = v[0]; d[1] = v[1]; d[2] = v[2]; d[3] = v[3]; }
    asm volatile("s_waitcnt lgkmcnt(0)" ::: "memory");
    const int c = lane & 7;
#pragma unroll
    for (int j = 0; j < 4; ++j) { const int n = (lane >> 3) + 8 * j; const LAS float* s = scr + (8 * c) * 33 + n;
        u32x4 o; o.x = pk2(s[0 * 33], s[1 * 33]); o.y = pk2(s[2 * 33], s[3 * 33]); o.z = pk2(s[4 * 33], s[5 * 33]); o.w = pk2(s[6 * 33], s[7 * 33]);
        *(u32x4*)(WT + (size_t)(n0d + n) * K + k0 + 8 * c) = o; }
    asm volatile("s_waitcnt lgkmcnt(0)" ::: "memory");
}
__device__ __forceinline__ void rms_row_to_bf16(const float* xrow, const float* g, bf16* orow, int lane) {
    unsigned long long* o8 = (unsigned long long*)orow + lane;
    if (!xrow) {
#pragma unroll
        for (int j = 0; j < 4; ++j) o8[64 * j] = 0ull;
        return; }
    const f32x4* xr = (const f32x4*)xrow + lane; const f32x4* gr = (const f32x4*)g + lane;
    f32x4 v[4]; float s = 0.f;
#pragma unroll
    for (int j = 0; j < 4; ++j) { v[j] = xr[64 * j]; s += (v[j].x * v[j].x + v[j].y * v[j].y) + (v[j].z * v[j].z + v[j].w * v[j].w); }
    const float rs = rsqrtf(wave_sum(s) * (1.f / 1024.f) + EPS);
#pragma unroll
    for (int j = 0; j < 4; ++j) { const f32x4 gg = gr[64 * j]; const f32x4 y = v[j] * rs * gg;
        o8[64 * j] = (unsigned long long)pk2(y.x, y.y) | ((unsigned long long)pk2(y.z, y.w) << 32); }
}
__device__ __forceinline__ void p0_prologue(Frame& F) {
    LAS float* scr = (LAS float*)(F.lds + F.wave * 16384);
    const int gw = F.gw, NGW = F.NGW;
    constexpr int IT_IN = 16 * 208, IT_MEM = 16 * 32, IT_BR = 8 * 32, IT_O = 16 * 32, IT_UP = 16 * 176, IT_DOWN = 44 * 32, IT_W1 = 32 * 2, IT_W2 = 1 * 2;
    constexpr int NITEMS = IT_IN + IT_MEM + 3 * IT_BR + IT_O + IT_UP + IT_DOWN + 2 * IT_W1 + 2 * IT_W2;
    const int ipw = (NITEMS + NGW - 1) / NGW;
    for (int it = gw * ipw; it < NITEMS && it < (gw + 1) * ipw; ++it) {
        int r = it;
        if (r < IT_UP) { transpose_item<true>(F.in[I_WUP], 1024, DUP, WSP(bf16, WS_WTUP), F.in[I_GFFN], scr, r, 176, LANE_); continue; } r -= IT_UP;
        if (r < IT_IN) { transpose_item(F.in[I_WIN], 1024, DIN, WSP(bf16, WS_WTIN), nullptr, scr, r, 208, LANE_); continue; } r -= IT_IN;
        if (r < IT_DOWN) { transpose_item(F.in[I_WDOWN], DFF, 1024, WSP(bf16, WS_WTDOWN), nullptr, scr, r, 32, LANE_); continue; } r -= IT_DOWN;
        if (r < IT_MEM) { transpose_item(F.in[I_WMEM], 1024, 1024, WSP(bf16, WS_WTMEM), nullptr, scr, r, 32, LANE_); continue; } r -= IT_MEM;
        if (r < IT_O) { transpose_item(F.in[I_WO], 1024, 1024, WSP(bf16, WS_WTO), nullptr, scr, r, 32, LANE_); continue; } r -= IT_O;
        if (r < IT_BR) { transpose_item(F.in[I_WNSA], 512, 1024, WSP(bf16, WS_WTNSA), nullptr, scr, r, 32, LANE_); continue; } r -= IT_BR;
        if (r < IT_BR) { transpose_item(F.in[I_WGLA], 512, 1024, WSP(bf16, WS_WTGLA), nullptr, scr, r, 32, LANE_); continue; } r -= IT_BR;
        if (r < IT_BR) { transpose_item(F.in[I_WX], 512, 1024, WSP(bf16, WS_WTX), nullptr, scr, r, 32, LANE_); continue; } r -= IT_BR;
        if (r < IT_W1) { transpose_item(F.in[I_CKW1], 2048, 64, WSP(bf16, WS_W1T), nullptr, scr, r, 2, LANE_); continue; } r -= IT_W1;
        if (r < IT_W1) { transpose_item(F.in[I_CVW1], 2048, 64, WSP(bf16, WS_W1T) + 64 * 2048, nullptr, scr, r, 2, LANE_); continue; } r -= IT_W1;
        if (r < IT_W2) { transpose_item(F.in[I_CKW2], 64, 64, WSP(bf16, WS_W2T), nullptr, scr, r, 2, LANE_); continue; } r -= IT_W2;
        transpose_item(F.in[I_CVW2], 64, 64, WSP(bf16, WS_W2T) + 64 * 64, nullptr, scr, r, 2, LANE_);
    }
    for (int m = gw; m < MPAD + 512; m += NGW) {
        if (m < MPAD) { const float* xr = m < NTOKP ? F.in[I_XP] + (size_t)m * 1024 : (m < NTOK ? F.in[I_XS] + (size_t)(m - NTOKP) * 1024 : nullptr);
            rms_row_to_bf16(xr, F.in[I_GMIX], WSP(bf16, WS_XN) + (size_t)m * 1024, LANE_); }
        else { const int mm = m - MPAD; rms_row_to_bf16(F.in[I_MEMP] + (size_t)mm * 1024, F.in[I_GMEM], WSP(bf16, WS_MN) + (size_t)mm * 1024, LANE_); }
    }
    { float* ssq = WSP(float, WS_SSQ); for (int i = F.bid * NTHR + TID_; i < MPAD; i += F.G * NTHR) ssq[i] = 0.f; }
    { float* ms = WSP(float, WS_MS); float* x1s = WSP(float, WS_X1S); const float* xs = F.in[I_XS];
      for (int i = F.bid * NTHR + TID_; i < SB * 1024; i += F.G * NTHR) { ms[i] = 0.f; x1s[i] = xs[i]; }
      float* ons = WSP(float, WS_ONS); for (int i = F.bid * NTHR + TID_; i < SB * 512; i += F.G * NTHR) ons[i] = 0.f; }
    { const f32x4* src = (const f32x4*)F.in[I_CWIN]; f32x4* dst = (f32x4*)(F.out + O_WINS);
      for (int i = F.bid * NTHR + TID_; i < SB * 511 * 64; i += F.G * NTHR) { const int b = i / (511 * 64), r = i % (511 * 64); dst[(size_t)b * 512 * 64 + r] = src[(size_t)b * 512 * 64 + 64 + r]; } }
}

struct TokRaw { u32x4 q, kva, kvb, xq; unsigned short g; };
__device__ __forceinline__ TokRaw p2_token_load(Frame& F, int tok) {
    const int lane = LANE_; const bf16* pr = WSP(bf16, WS_PROJ) + (size_t)tok * DINP; TokRaw r;
    r.q = *(const u32x4*)(pr + C_Q + 8 * lane); r.kva = *(const u32x4*)(pr + C_KV + 8 * lane); r.kvb = *(const u32x4*)(pr + C_KV + 512 + 8 * lane);
    r.xq = *(const u32x4*)(pr + C_XQ + 8 * lane); r.g = pr[C_G + (lane < 24 ? lane : 0)]; return r; }
struct VtAcc { unsigned s[8][4]; unsigned w[8][4]; };
template <int J>
__device__ __forceinline__ void p2_token(Frame& F, int tok, const TokRaw& raw, VtAcc& va) {
    const int lane = LANE_;
    const bool prompt = tok < NTOKP; const int b = tok >> 13, t = tok & (T - 1), sb = tok - NTOKP;
    float f[8];
    { unpack8(raw.q, f); float ss = 0.f;
#pragma unroll
      for (int i = 0; i < 8; ++i) ss += f[i] * f[i];
      ss += __shfl_xor(ss, 1); ss += __shfl_xor(ss, 2); ss += __shfl_xor(ss, 4);
      const float rs = rsqrtf(ss * (1.f / 64.f) + EPS) * QSCALE; const float* g = F.in[I_GNQ] + 8 * (lane & 7);
#pragma unroll
      for (int i = 0; i < 8; ++i) f[i] *= rs * g[i];
      *(u32x4*)(WSP(bf16, WS_QN) + (size_t)tok * 512 + 8 * lane) = pack8(f); }
    { unpack8(raw.kva, f); float ss = 0.f;
#pragma unroll
      for (int i = 0; i < 8; ++i) ss += f[i] * f[i];
      ss += __shfl_xor(ss, 1); ss += __shfl_xor(ss, 2); ss += __shfl_xor(ss, 4);
      const int grp = lane >> 3, slot = grp >> 1, kv = grp & 1, d0 = 8 * (lane & 7);
      if (slot == 2) { const float rs = rsqrtf(ss * (1.f / 64.f) + EPS); const float* g = F.in[I_GNK] + 64 + d0;
#pragma unroll
          for (int i = 0; i < 8; ++i) f[i] *= rs * g[i]; }
      float* orow = prompt ? F.out + O_KVP + (size_t)tok * 512 + 8 * lane : F.out + O_KVS + (size_t)sb * 512 + 8 * lane;
      *(f32x4*)orow = (f32x4){f[0], f[1], f[2], f[3]}; *(f32x4*)(orow + 4) = (f32x4){f[4], f[5], f[6], f[7]};
      if (prompt) {
          if (slot == 2) *(u32x4*)(WSP(bf16, WS_KSEL) + ((size_t)(b * 2 + kv) * T + t) * 64 + d0) = pack8(f);
          if (J < 0) { if (slot == 3) { bf16* vt = WSP(bf16, WS_VSELT) + (((size_t)(b * 2 + kv) * 128 + (t >> 6)) * 64 + d0) * 64 + (t & 63);
#pragma unroll
              for (int i = 0; i < 8; ++i) vt[i * 64] = (bf16)f2bf(f[i]); } }
          else {
#pragma unroll
              for (int i = 0; i < 8; ++i) { const unsigned hv = f2bf(f[i]); if ((J & 1) == 0) va.s[i][(J >> 1) & 3] = hv; else va.s[i][(J >> 1) & 3] |= hv << 16; }
              if (J == 7 && slot == 3) { bf16* vt = WSP(bf16, WS_VSELT) + (((size_t)(b * 2 + kv) * 128 + (t >> 6)) * 64 + d0) * 64 + ((t & 63) - 7);
#pragma unroll
                  for (int i = 0; i < 8; ++i) *(u32x4*)(vt + i * 64) = (u32x4){va.s[i][0], va.s[i][1], va.s[i][2], va.s[i][3]}; } }
      } else if (slot >= 2) { float* nk = WSP(float, WS_NEWKV) + ((size_t)(sb * 4 + (slot - 2)) * 2 + kv) * 64 + d0;
#pragma unroll
          for (int i = 0; i < 8; ++i) nk[i] = f[i]; }
    }
    { unpack8(raw.kvb, f); float ss = 0.f;
#pragma unroll
      for (int i = 0; i < 8; ++i) ss += f[i] * f[i];
      ss += __shfl_xor(ss, 1); ss += __shfl_xor(ss, 2); ss += __shfl_xor(ss, 4);
      const int grp = lane >> 3, slot = 4 + (grp >> 1), kv = grp & 1, d0 = 8 * (lane & 7);
      if (lane < 32) {
          if (slot == 4) { const float rs = rsqrtf(ss * (1.f / 64.f) + EPS); const float* g = F.in[I_GNK] + 128 + d0;
#pragma unroll
              for (int i = 0; i < 8; ++i) f[i] *= rs * g[i]; }
          if (prompt) {
              if (slot == 4) *(u32x4*)(WSP(bf16, WS_KWIN) + ((size_t)(b * 2 + kv) * T + t) * 64 + d0) = pack8(f);
              else if (J < 0) { bf16* vt = WSP(bf16, WS_VWINT) + (((size_t)(b * 2 + kv) * 128 + (t >> 6)) * 64 + d0) * 64 + (t & 63);
#pragma unroll
                  for (int i = 0; i < 8; ++i) vt[i * 64] = (bf16)f2bf(f[i]); }
              else {
#pragma unroll
                  for (int i = 0; i < 8; ++i) { const unsigned hv = f2bf(f[i]); if ((J & 1) == 0) va.w[i][(J >> 1) & 3] = hv; else va.w[i][(J >> 1) & 3] |= hv << 16; }
                  if (J == 7) { bf16* vt = WSP(bf16, WS_VWINT) + (((size_t)(b * 2 + kv) * 128 + (t >> 6)) * 64 + d0) * 64 + ((t & 63) - 7);
#pragma unroll
                      for (int i = 0; i < 8; ++i) *(u32x4*)(vt + i * 64) = (u32x4){va.w[i][0], va.w[i][1], va.w[i][2], va.w[i][3]}; } }
              if (t >= T - 512) { float* orow = F.out + O_WINP + ((size_t)b * 512 + (t - (T - 512))) * 256 + 8 * lane;
                  *(f32x4*)orow = (f32x4){f[0], f[1], f[2], f[3]}; *(f32x4*)(orow + 4) = (f32x4){f[4], f[5], f[6], f[7]}; }
          } else {
              float* nk = WSP(float, WS_NEWKV) + ((size_t)(sb * 4 + (slot - 2)) * 2 + kv) * 64 + d0;
#pragma unroll
              for (int i = 0; i < 8; ++i) nk[i] = f[i];
              float* orow = F.out + O_WINS + ((size_t)sb * 512 + 511) * 256 + 8 * lane;
              *(f32x4*)orow = (f32x4){f[0], f[1], f[2], f[3]}; *(f32x4*)(orow + 4) = (f32x4){f[4], f[5], f[6], f[7]};
          }
      }
    }
    if (lane < 24) WSP(float, WS_GATES)[(size_t)tok * 24 + lane] = sigmoidf_(bf2f(raw.g));
    { unpack8(raw.xq, f); float ss = 0.f;
#pragma unroll
      for (int i = 0; i < 8; ++i) ss += f[i] * f[i];
      ss += __shfl_xor(ss, 1); ss += __shfl_xor(ss, 2); ss += __shfl_xor(ss, 4); ss += __shfl_xor(ss, 8);
      const float rs = rsqrtf(ss * (1.f / 128.f) + EPS) * XSCALE; const float* g = F.in[I_GXQ] + 8 * (lane & 15);
#pragma unroll
      for (int i = 0; i < 8; ++i) f[i] *= rs * g[i];
      *(u32x4*)(WSP(bf16, WS_XQ) + (size_t)tok * 512 + 8 * lane) = pack8(f); }
}
__device__ __forceinline__ void p2_memrow(Frame& F, int row) {
    const int lane = LANE_, b = row >> 8, m = row & 255, head = lane >> 4, d0 = 8 * (lane & 15);
    const bf16* pr = WSP(bf16, WS_MEMPROJ) + (size_t)row * 1024; float f[8];
    { unpack8(*(const u32x4*)(pr + 8 * lane), f); float ss = 0.f;
#pragma unroll
      for (int i = 0; i < 8; ++i) ss += f[i] * f[i];
      ss += __shfl_xor(ss, 1); ss += __shfl_xor(ss, 2); ss += __shfl_xor(ss, 4); ss += __shfl_xor(ss, 8);
      const float rs = rsqrtf(ss * (1.f / 128.f) + EPS); const float* g = F.in[I_GXK] + d0;
#pragma unroll
      for (int i = 0; i < 8; ++i) f[i] *= rs * g[i];
      float* orow = F.out + O_MEMP + ((size_t)row * 2 + 0) * 512 + 8 * lane;
      *(f32x4*)orow = (f32x4){f[0], f[1], f[2], f[3]}; *(f32x4*)(orow + 4) = (f32x4){f[4], f[5], f[6], f[7]};
      *(u32x4*)(WSP(bf16, WS_KMEM) + ((size_t)(b * 4 + head) * 256 + m) * 128 + d0) = pack8(f); }
    { unpack8(*(const u32x4*)(pr + 512 + 8 * lane), f);
      float* orow = F.out + O_MEMP + ((size_t)row * 2 + 1) * 512 + 8 * lane;
      *(f32x4*)orow = (f32x4){f[0], f[1], f[2], f[3]}; *(f32x4*)(orow + 4) = (f32x4){f[4], f[5], f[6], f[7]};
      bf16* vt = WSP(bf16, WS_VMEMT) + ((size_t)(b * 4 + head) * 128 + d0) * 256 + m;
#pragma unroll
      for (int i = 0; i < 8; ++i) vt[i * 256] = (bf16)f2bf(f[i]); }
}

constexpr int CMP_TASKS_S = SB * 2 * 2, CMP_TASKS_P = NB * 2 * 2;
__device__ __forceinline__ int cmp_tile_off16(int row, int c16) { return row * 128 + ((c16 ^ (row & 7)) << 4); }
__device__ __forceinline__ void p2_compress(Frame& F, int task) {
    const int lane = LANE_, r = lane & 15, q = lane >> 4, w = F.wave, tid_ = w * 64 + lane;
    const bool smp = task < CMP_TASKS_S; const int x = smp ? task : task - CMP_TASKS_S;
    const int b = x >> 2, iq = x & 3, kv = (w >> 1) & 1, slot = w & 1, i0 = 128 * iq + 64 * (w >> 2);
    const bf16* W1t = WSP(bf16, WS_W1T) + (size_t)slot * 64 * 2048;
    const bf16* W2t = WSP(bf16, WS_W2T) + (size_t)slot * 64 * 64;
    const int* pt = (const int*)F.in[I_PT] + b * 64;
    const float* ckv = F.in[I_CKV]; const float* pe = F.in[slot ? I_CVPE : I_CKPE];
    const bf16* proj = WSP(bf16, WS_PROJ);
    LAS unsigned char* wb = F.lds;
    const int srow = tid_ >> 3, sc16 = tid_ & 7, soff = cmp_tile_off16(srow, sc16);
    int kb0[2]; kb0[0] = r * 128 + (((0 + q) ^ (r & 7)) << 4); kb0[1] = r * 128 + (((4 + q) ^ (r & 7)) << 4);
    f32x4 acc[4][4];
#pragma unroll
    for (int nt = 0; nt < 4; ++nt)
#pragma unroll
        for (int it = 0; it < 4; ++it) acc[nt][it] = (f32x4){0.f, 0.f, 0.f, 0.f};
    const bf16* wsrc = WSP(bf16, WS_W1T) + (size_t)srow * 2048 + sc16 * 8;
    u32x4 rw = *(const u32x4*)wsrc, rw1 = *(const u32x4*)(wsrc + 64 * 2048);
    LAS unsigned char* xt = F.lds + 32768 + w * 8192;
    u32x4 xr[16];
    const int xrow = smp ? (lane >> 4) : (lane >> 3), xch = smp ? (lane & 15) : (lane & 7);
#define CMP_LOAD_ROWS(KP) do { if (smp) { _Pragma("unroll") for (int i = 0; i < 16; ++i) { const int ib = i0 + 4 * i + xrow; int tok = 16 * ib + (KP); tok = tok < T ? tok : T - 1; \
            const int page = pt[tok >> 7]; xr[i] = *(const u32x4*)(ckv + (((size_t)page * 128 + (tok & 127)) * 4 + slot) * 128 + kv * 64 + 4 * xch); } } \
        else { _Pragma("unroll") for (int i = 0; i < 8; ++i) { const int ib = i0 + 8 * i + xrow; int tok = 16 * ib + (KP); tok = tok < T ? tok : T - 1; \
            xr[i] = *(const u32x4*)(proj + ((size_t)b * T + tok) * DINP + C_KV + slot * 128 + kv * 64 + 8 * xch); } } } while (0)
    CMP_LOAD_ROWS(0);
    __syncthreads();
#pragma unroll 1
    for (int kp = 0; kp < 32; ++kp) {
        if (smp) { const f32x4 p4 = *(const f32x4*)(pe + 64 * kp + 4 * xch);
#pragma unroll
            for (int i = 0; i < 16; ++i) { const f32x4 v = __builtin_bit_cast(f32x4, xr[i]) + p4; u32x2 wv; wv.x = pk2(v[0], v[1]); wv.y = pk2(v[2], v[3]);
                const int row = 4 * i + xrow; *(LAS u32x2*)(xt + cmp_tile_off16(row, xch >> 1) + 8 * (xch & 1)) = wv; } }
        else { const f32x4 p0 = *(const f32x4*)(pe + 64 * kp + 8 * xch), p1 = *(const f32x4*)(pe + 64 * kp + 8 * xch + 4);
#pragma unroll
            for (int i = 0; i < 8; ++i) { float f8[8]; unpack8(xr[i], f8);
                u32x4 wv; wv.x = pk2(f8[0] + p0[0], f8[1] + p0[1]); wv.y = pk2(f8[2] + p0[2], f8[3] + p0[3]); wv.z = pk2(f8[4] + p1[0], f8[5] + p1[1]); wv.w = pk2(f8[6] + p1[2], f8[7] + p1[3]);
                const int row = 8 * i + xrow; *(LAS u32x4*)(xt + cmp_tile_off16(row, xch)) = wv; } }
        if (kp + 1 < 32) CMP_LOAD_ROWS(kp + 1);
        *(LAS u32x4*)(wb + (kp & 1) * 16384 + soff) = rw; *(LAS u32x4*)(wb + (kp & 1) * 16384 + 8192 + soff) = rw1;
        __syncthreads();
        if (kp + 1 < 32) { rw = *(const u32x4*)(wsrc + 64 * (kp + 1)); rw1 = *(const u32x4*)(wsrc + 64 * 2048 + 64 * (kp + 1)); }
        LAS const unsigned char* wt = wb + (kp & 1) * 16384 + slot * 8192;
#pragma unroll
        for (int ks2 = 0; ks2 < 2; ++ks2) {
            bf16x8 xf[4];
#pragma unroll
            for (int it = 0; it < 4; ++it) xf[it] = as_frag(*(LAS const u32x4*)(xt + kb0[ks2] + it * 2048));
#pragma unroll
            for (int nt = 0; nt < 4; ++nt) { const bf16x8 a = as_frag(*(LAS const u32x4*)(wt + kb0[ks2] + nt * 2048));
#pragma unroll
                for (int it = 0; it < 4; ++it) acc[nt][it] = MFMA16(a, xf[it], acc[nt][it]); } }
        asm volatile("s_waitcnt lgkmcnt(0)" ::: "memory");
    }
#undef CMP_LOAD_ROWS
    const float* gk0 = F.in[I_GNK];
#pragma unroll
    for (int it = 0; it < 4; ++it) {
        f32x4 g[4];
#pragma unroll
        for (int nt = 0; nt < 4; ++nt)
#pragma unroll
            for (int i = 0; i < 4; ++i) g[nt][i] = gelu_tanh(acc[nt][it][i]);
        const bf16x8 b0 = frag_pk(g[0], g[1]), b1 = frag_pk(g[2], g[3]);
        f32x4 o[4]; float ss = 0.f;
#pragma unroll
        for (int mt = 0; mt < 4; ++mt) { const bf16* wr = W2t + (size_t)(16 * mt + r) * 64 + 4 * q;
            o[mt] = MFMA16(ldfrag2(wr, wr + 16), b0, ((f32x4){0.f, 0.f, 0.f, 0.f}));
            o[mt] = MFMA16(ldfrag2(wr + 32, wr + 48), b1, o[mt]);
            ss += (o[mt][0] * o[mt][0] + o[mt][1] * o[mt][1]) + (o[mt][2] * o[mt][2] + o[mt][3] * o[mt][3]); }
        ss += __shfl_xor(ss, 16); ss += __shfl_xor(ss, 32);
        if (slot == 0) { const float rs = rsqrtf(ss * (1.f / 64.f) + EPS);
#pragma unroll
            for (int mt = 0; mt < 4; ++mt) { const f32x4 gg = *(const f32x4*)(gk0 + 16 * mt + 4 * q); o[mt] = o[mt] * rs * gg; } }
        const int i = i0 + 16 * it + r;
        if (smp) { float* dst = WSP(float, slot ? WS_VCMPS : WS_KCMPS) + ((size_t)(b * 2 + kv) * 512 + i) * 64 + 4 * q;
#pragma unroll
            for (int mt = 0; mt < 4; ++mt) *(f32x4*)(dst + 16 * mt) = o[mt]; }
        else if (slot == 0) { bf16* dst = WSP(bf16, WS_KCMP) + ((size_t)(b * 2 + kv) * 512 + i) * 64 + 4 * q;
#pragma unroll
            for (int mt = 0; mt < 4; ++mt) { u32x2 wv; wv.x = pk2(o[mt][0], o[mt][1]); wv.y = pk2(o[mt][2], o[mt][3]); *(u32x2*)(dst + 16 * mt) = wv; } }
        else { bf16* dst = WSP(bf16, WS_VCMPT) + ((size_t)(b * 2 + kv) * 64 + 4 * q) * 512 + i;
#pragma unroll
            for (int mt = 0; mt < 4; ++mt)
#pragma unroll
                for (int e = 0; e < 4; ++e) dst[(size_t)(16 * mt + e) * 512] = (bf16)f2bf(o[mt][e]); }
    }
}

__device__ __forceinline__ int swz64(int row, int col) { return row * 64 + ((((col >> 3) ^ (row & 7)) << 3) | (col & 7)); }
__device__ __forceinline__ float log_sigmoid_(float z) { return fminf(z, 0.f) - __logf(1.0f + __expf(-fabsf(z))); }
__device__ __forceinline__ void p2_gla_chunk(Frame& F, int bc) {
    const int lane = LANE_, r = lane & 15, q = lane >> 4, h = F.wave >> 1, eh = F.wave & 1;
    LAS bf16* ktT = (LAS bf16*)(F.lds + F.wave * 16384);
    LAS bf16* vT = ktT + 4096;
    const bf16* proj = WSP(bf16, WS_PROJ) + (size_t)bc * 64 * DINP;
    float wg[16];
#pragma unroll
    for (int j = 0; j < 16; ++j) wg[j] = F.in[I_WGG][j * 256 + h * 64 + lane];
    const float bg = F.in[I_BGG][h * 64 + lane];
    bf16* qtg = WSP(bf16, WS_QTG) + (size_t)bc * 64 * 256 + h * 64 + lane;
    bf16* ktg = WSP(bf16, WS_KTG) + (size_t)bc * 64 * 256 + h * 64 + lane;
    LAS float* lrs = (LAS float*)(F.lds + RING_BYTES);
    { const int tid_ = F.wave * 64 + lane; if (tid_ < 128) { float f8[8]; unpack8(*(const u32x4*)(proj + (size_t)(tid_ >> 1) * DINP + C_LR + 8 * (tid_ & 1)), f8);
#pragma unroll
        for (int i = 0; i < 8; ++i) lrs[(tid_ >> 1) * 16 + 8 * (tid_ & 1) + i] = f8[i]; } }
    __syncthreads();
    float cb = 0.f;
    bf16 kr[16], qr[16], vr[16], kn[16], qn[16], vn[16];
#pragma unroll
    for (int i = 0; i < 16; ++i) { const bf16* pr = proj + (size_t)i * DINP; kr[i] = pr[C_GK + h * 64 + lane]; qr[i] = pr[C_GQ + h * 64 + lane]; vr[i] = pr[C_GV + h * 128 + eh * 64 + lane]; }
#pragma unroll 1
    for (int tb = 0; tb < 4; ++tb) {
        const int tn = tb < 3 ? tb + 1 : 3;
#pragma unroll
        for (int i = 0; i < 16; ++i) { const bf16* pr = proj + (size_t)(16 * tn + i) * DINP; kn[i] = pr[C_GK + h * 64 + lane]; qn[i] = pr[C_GQ + h * 64 + lane]; vn[i] = pr[C_GV + h * 128 + eh * 64 + lane]; }
#pragma unroll
        for (int i = 0; i < 16; ++i) { const int t = 16 * tb + i;
            float z = bg;
#pragma unroll
            for (int j4 = 0; j4 < 4; ++j4) { const f32x4 l4 = *(LAS const f32x4*)(lrs + t * 16 + 4 * j4); z += l4[0] * wg[4 * j4] + l4[1] * wg[4 * j4 + 1] + l4[2] * wg[4 * j4 + 2] + l4[3] * wg[4 * j4 + 3]; }
            cb += log_sigmoid_(z) * 0.0625f;
            const float kk = bf2f(kr[i]) * __expf(-cb);
            const float qq = bf2f(qr[i]) * 0.125f * __expf(cb);
            const bf16 kb = (bf16)f2bf(kk);
            if (eh == 0) { qtg[(size_t)t * 256] = (bf16)f2bf(qq); ktg[(size_t)t * 256] = kb; }
            ktT[swz64(lane, t)] = kb;
            const bf16 vv = vr[i];
            vT[swz64(lane, t)] = vv; }
#pragma unroll
        for (int i = 0; i < 16; ++i) { kr[i] = kn[i]; qr[i] = qn[i]; vr[i] = vn[i]; }
    }
    const float dec = __expf(cb);
    if (eh == 0) WSP(float, WS_DEC)[(size_t)(bc * 4 + h) * 64 + lane] = dec;
    asm volatile("s_waitcnt lgkmcnt(0)" ::: "memory");
    {
        bf16* vrow = WSP(bf16, WS_VTG) + ((size_t)(bc * 4 + h) * 128 + eh * 64) * 64;
#pragma unroll
        for (int i = 0; i < 8; ++i) { const int e = 8 * i + (lane >> 3), c8 = lane & 7;
            *(u32x4*)(vrow + (size_t)e * 64 + c8 * 8) = *(const LAS u32x4*)(vT + swz64(e, c8 * 8)); } }
    f32x4 acc[4][4];
#pragma unroll
    for (int et = 0; et < 4; ++et)
#pragma unroll
        for (int dt = 0; dt < 4; ++dt) acc[et][dt] = (f32x4){0.f, 0.f, 0.f, 0.f};
#pragma unroll
    for (int ks = 0; ks < 2; ++ks) {
        bf16x8 bfr[4];
#pragma unroll
        for (int dt = 0; dt < 4; ++dt) bfr[dt] = as_frag(*(const LAS u32x4*)(ktT + swz64(16 * dt + r, 32 * ks + 8 * q)));
#pragma unroll
        for (int et = 0; et < 4; ++et) { const bf16x8 a = as_frag(*(const LAS u32x4*)(vT + swz64(16 * et + r, 32 * ks + 8 * q)));
#pragma unroll
            for (int dt = 0; dt < 4; ++dt) acc[et][dt] = MFMA16(a, bfr[dt], acc[et][dt]); }
    }
    float* up = WSP(float, WS_UP) + ((size_t)(bc * 4 + h) * 128 + eh * 64) * 64;
#pragma unroll
    for (int dt = 0; dt < 4; ++dt) { const float dd = __shfl(dec, 16 * dt + r);
#pragma unroll
        for (int et = 0; et < 4; ++et)
#pragma unroll
            for (int i = 0; i < 4; ++i) up[(size_t)(16 * et + 4 * q + i) * 64 + 16 * dt + r] = acc[et][dt][i] * dd; }
}

__device__ __forceinline__ void p2_gla_sample(Frame& F, int task) {
    const int lane = LANE_, b = task >> 2, h = task & 3, tok = NTOKP + b;
    const bf16* pr = WSP(bf16, WS_PROJ) + (size_t)tok * DINP;
    LAS float* sh = (LAS float*)(F.lds + F.wave * 16384);
    { float z = F.in[I_BGG][h * 64 + lane];
#pragma unroll
      for (int j = 0; j < 16; ++j) z += bf2f(pr[C_LR + j]) * F.in[I_WGG][j * 256 + h * 64 + lane];
      sh[lane] = __expf(log_sigmoid_(z) * 0.0625f); sh[64 + lane] = bf2f(pr[C_GK + h * 64 + lane]); sh[128 + lane] = bf2f(pr[C_GQ + h * 64 + lane]) * 0.125f; }
    asm volatile("s_waitcnt lgkmcnt(0)" ::: "memory");
    const float v0 = bf2f(pr[C_GV + h * 128 + lane]), v1 = bf2f(pr[C_GV + h * 128 + 64 + lane]);
    const float* s0 = F.in[I_SGLA] + (size_t)(b * 4 + h) * 64 * 128; float* s1 = F.out + O_GLAS + (size_t)(b * 4 + h) * 64 * 128;
    float o0 = 0.f, o1 = 0.f;
#pragma unroll 4
    for (int d = 0; d < 64; ++d) { const float a = sh[d], k = sh[64 + d], qq = sh[128 + d];
        const float n0 = a * s0[d * 128 + lane] + k * v0, n1 = a * s0[d * 128 + 64 + lane] + k * v1;
        s1[d * 128 + lane] = n0; s1[d * 128 + 64 + lane] = n1; o0 += qq * n0; o1 += qq * n1; }
    const float rs = rsqrtf(wave_sum(o0 * o0 + o1 * o1) * (1.f / 128.f) + EPS);
    const float r0 = bf2f(pr[C_GR + h * 128 + lane]), r1 = bf2f(pr[C_GR + h * 128 + 64 + lane]);
    bf16* og = WSP(bf16, WS_OGLA) + (size_t)tok * 512 + h * 128;
    og[lane] = (bf16)f2bf(o0 * rs * F.in[I_GGO][lane] * r0 * sigmoidf_(r0));
    og[64 + lane] = (bf16)f2bf(o1 * rs * F.in[I_GGO][64 + lane] * r1 * sigmoidf_(r1));
}

__device__ __forceinline__ void p3_gla_scan(Frame& F, int task) {
    const int lane = LANE_, b = task >> 9, h = (task >> 7) & 3, e = task & 127;
    const float* up = WSP(float, WS_UP); const float* dec = WSP(float, WS_DEC); bf16* sc = WSP(bf16, WS_SC);
    float S = 0.f;
#pragma unroll 1
    for (int c0 = 0; c0 < 128; c0 += 32) {
        float uu[32], dd[32];
#pragma unroll
        for (int i = 0; i < 32; ++i) { const int bc = b * 128 + c0 + i; uu[i] = up[((size_t)(bc * 4 + h) * 128 + e) * 64 + lane]; dd[i] = dec[(size_t)(bc * 4 + h) * 64 + lane]; }
#pragma unroll
        for (int i = 0; i < 32; ++i) { const int bc = b * 128 + c0 + i; sc[((size_t)(bc * 4 + h) * 128 + e) * 64 + lane] = (bf16)f2bf(S); S = dd[i] * S + uu[i]; } }
    F.out[O_GLAP + ((size_t)(b * 4 + h) * 64 + lane) * 128 + e] = S;
}

__device__ __forceinline__ void p4_gla_out(Frame& F, int task) {
    const int lane = LANE_, r = lane & 15, q = lane >> 4, bc = task >> 4, h = (task >> 2) & 3, tt = task & 3;
    const bf16* qtg = WSP(bf16, WS_QTG) + (size_t)bc * 64 * 256 + h * 64;
    const bf16* ktg = WSP(bf16, WS_KTG) + (size_t)bc * 64 * 256 + h * 64;
    const bf16* vtg = WSP(bf16, WS_VTG) + (size_t)(bc * 4 + h) * 128 * 64;
    const bf16* sc = WSP(bf16, WS_SC) + (size_t)(bc * 4 + h) * 128 * 64;
    const bf16* proj = WSP(bf16, WS_PROJ) + (size_t)bc * 64 * DINP;
    bf16* og = WSP(bf16, WS_OGLA) + (size_t)bc * 64 * 512 + h * 128;
    const float* ggo = F.in[I_GGO];
    {
        bf16x8 qf[2];
#pragma unroll
        for (int ks = 0; ks < 2; ++ks) qf[ks] = ldfrag(qtg + (size_t)(16 * tt + r) * 256 + 32 * ks + 8 * q);
        f32x4 sT[4];
#pragma unroll
        for (int st = 0; st < 4; ++st) { sT[st] = (f32x4){0.f, 0.f, 0.f, 0.f};
            if (st <= tt) {
#pragma unroll
                for (int ks = 0; ks < 2; ++ks) sT[st] = MFMA16(ldfrag(ktg + (size_t)(16 * st + r) * 256 + 32 * ks + 8 * q), qf[ks], sT[st]);
                if (st == tt) {
#pragma unroll
                    for (int i = 0; i < 4; ++i) if (4 * q + i > r) sT[st][i] = 0.f; } } }
        const bf16x8 p01 = frag_pk(sT[0], sT[1]), p23 = frag_pk(sT[2], sT[3]);
        f32x4 acc[8]; float ss = 0.f;
#pragma unroll
        for (int et = 0; et < 8; ++et) { acc[et] = (f32x4){0.f, 0.f, 0.f, 0.f};
            const bf16* srow = sc + (size_t)(16 * et + r) * 64 + 8 * q;
            acc[et] = MFMA16(ldfrag(srow), qf[0], acc[et]); acc[et] = MFMA16(ldfrag(srow + 32), qf[1], acc[et]);
            const bf16* vrow = vtg + (size_t)(16 * et + r) * 64 + 4 * q;
            acc[et] = MFMA16(ldfrag2(vrow, vrow + 16), p01, acc[et]);
            if (tt >= 2) acc[et] = MFMA16(ldfrag2(vrow + 32, vrow + 48), p23, acc[et]);
            ss += (acc[et][0] * acc[et][0] + acc[et][1] * acc[et][1]) + (acc[et][2] * acc[et][2] + acc[et][3] * acc[et][3]); }
        ss += __shfl_xor(ss, 16); ss += __shfl_xor(ss, 32);
        const float rs = rsqrtf(ss * (1.f / 128.f) + EPS);
        const bf16* pr = proj + (size_t)(16 * tt + r) * DINP + C_GR + h * 128 + 4 * q;
        bf16* orow = og + (size_t)(16 * tt + r) * 512 + 4 * q;
#pragma unroll
        for (int et = 0; et < 8; ++et) { const u32x2 rw = *(const u32x2*)(pr + 16 * et); const f32x4 gg = *(const f32x4*)(ggo + 16 * et + 4 * q);
            const float r0 = bflo(rw.x), r1 = bfhi(rw.x), r2 = bflo(rw.y), r3 = bfhi(rw.y);
            u32x2 w; w.x = pk2(acc[et][0] * rs * gg[0] * r0 * sigmoidf_(r0), acc[et][1] * rs * gg[1] * r1 * sigmoidf_(r1));
            w.y = pk2(acc[et][2] * rs * gg[2] * r2 * sigmoidf_(r2), acc[et][3] * rs * gg[3] * r3 * sigmoidf_(r3));
            *(u32x2*)(orow + 16 * et) = w; }
    }
}

__device__ __forceinline__ void p3_xatt(Frame& F, int n, float mb) {
    const int lane = LANE_, r = lane & 15, q = lane >> 4, w = F.wave, tid_ = w * 64 + lane;
    const int b = n >> 7, h = (n >> 5) & 3, chunk = n & 31;
    const bf16* km = WSP(bf16, WS_KMEM) + (size_t)(b * 4 + h) * 256 * 128;
    const bf16* vm = WSP(bf16, WS_VMEMT) + (size_t)(b * 4 + h) * 128 * 256;
    LAS unsigned char* kl = F.lds; LAS unsigned char* vl = F.lds + 65536;
    __syncthreads();
    { u32x4 gk[8], gv[8];
#pragma unroll
      for (int i = 0; i < 8; ++i) { gk[i] = *(const u32x4*)(km + (size_t)(i * 512 + tid_) * 8); gv[i] = *(const u32x4*)(vm + (size_t)(i * 512 + tid_) * 8); }
#pragma unroll
      for (int i = 0; i < 8; ++i) { const int id = i * 512 + tid_;
          *(LAS u32x4*)(kl + (id >> 4) * 256 + ((((id & 15) ^ ((id >> 4) & 15))) << 4)) = gk[i];
          *(LAS u32x4*)(vl + (id >> 5) * 512 + ((((id & 31) ^ ((id >> 5) & 15))) << 4)) = gv[i]; } }
    __syncthreads();
    int kb4[4];
#pragma unroll
    for (int ks = 0; ks < 4; ++ks) kb4[ks] = r * 256 + (((4 * ks + q) ^ r) << 4);
#pragma unroll 1
    for (int tile = 0; tile < 2; ++tile) {
        const int tok0 = b * T + chunk * 256 + w * 32 + tile * 16;
        const bf16* xq = WSP(bf16, WS_XQ) + (size_t)(tok0 + r) * 512 + h * 128 + 8 * q;
        bf16x8 qf[4];
#pragma unroll
        for (int ks = 0; ks < 4; ++ks) qf[ks] = ldfrag(xq + 32 * ks);
        f32x4 o[8]; float l = 0.f;
#pragma unroll
        for (int dt = 0; dt < 8; ++dt) o[dt] = (f32x4){0.f, 0.f, 0.f, 0.f};
#pragma unroll 2
        for (int kk = 0; kk < 8; ++kk) {
            f32x4 p[2];
#pragma unroll
            for (int a = 0; a < 2; ++a) { p[a] = (f32x4){0.f, 0.f, 0.f, 0.f};
#pragma unroll
                for (int ks = 0; ks < 4; ++ks) p[a] = MFMA16(as_frag(*(LAS const u32x4*)(kl + kb4[ks] + (2 * kk + a) * 4096)), qf[ks], p[a]);
#pragma unroll
                for (int i = 0; i < 4; ++i) { p[a][i] = __builtin_amdgcn_exp2f(p[a][i] - mb); l += p[a][i]; } }
            const bf16x8 pf = frag_pk(p[0], p[1]);
            const int v0 = r * 512 + (((4 * kk + (q >> 1)) ^ r) << 4) + 8 * (q & 1), v1 = r * 512 + (((4 * kk + 2 + (q >> 1)) ^ r) << 4) + 8 * (q & 1);
#pragma unroll
            for (int dt = 0; dt < 8; ++dt) { const u32x2 x0 = *(LAS const u32x2*)(vl + v0 + dt * 8192), x1 = *(LAS const u32x2*)(vl + v1 + dt * 8192);
                u32x4 wv; wv.x = x0.x; wv.y = x0.y; wv.z = x1.x; wv.w = x1.y; o[dt] = MFMA16(as_frag(wv), pf, o[dt]); }
        }
        l += __shfl_xor(l, 16); l += __shfl_xor(l, 32);
        const float inv = 1.f / l;
        bf16* ox = WSP(bf16, WS_OX) + (size_t)(tok0 + r) * 512 + h * 128 + 4 * q;
#pragma unroll
        for (int dt = 0; dt < 8; ++dt) { u32x2 wv; wv.x = pk2(o[dt][0] * inv, o[dt][1] * inv); wv.y = pk2(o[dt][2] * inv, o[dt][3] * inv); *(u32x2*)(ox + 16 * dt) = wv; }
    }
}
__device__ __forceinline__ void p3_xatt_sample(Frame& F, int task) {
    const int lane = LANE_, w = F.wave, tid_ = w * 64 + lane, b = task >> 2, h = task & 3, tok = NTOKP + b;
    LAS float* qs = (LAS float*)F.lds; LAS float* sc = qs + 128; LAS float* part = qs + 384;
    const float* cm = F.in[I_CMEM] + (size_t)b * 256 * 1024 + h * 128;
    __syncthreads();
    if (tid_ < 128) qs[tid_] = bf2f(WSP(bf16, WS_XQ)[(size_t)tok * 512 + h * 128 + tid_]);
    __syncthreads();
    {
        const int l8 = lane & 7, kq = lane >> 3;
#pragma unroll
        for (int ps = 0; ps < 4; ++ps) { const int key = 32 * w + 8 * ps + kq; const float* kr = cm + (size_t)key * 1024; float s = 0.f;
#pragma unroll
            for (int j = 0; j < 4; ++j) { const int d = (j * 8 + l8) * 4; const f32x4 kv = *(const f32x4*)(kr + d); const f32x4 qv = *(LAS const f32x4*)(qs + d);
                s += (qv[0] * kv[0] + qv[1] * kv[1]) + (qv[2] * kv[2] + qv[3] * kv[3]); }
            s += __shfl_xor(s, 1); s += __shfl_xor(s, 2); s += __shfl_xor(s, 4);
            if (l8 == 0) sc[key] = s; }
    }
    __syncthreads();
    if (w == 0) { float s[4]; float m = -INFINITY;
#pragma unroll
        for (int k = 0; k < 4; ++k) { s[k] = sc[lane + 64 * k]; m = fmaxf(m, s[k]); }
        m = wave_max(m); float l = 0.f;
#pragma unroll
        for (int k = 0; k < 4; ++k) { s[k] = __builtin_amdgcn_exp2f(s[k] - m); l += s[k]; }
        l = wave_sum(l); const float inv = 1.f / l;
#pragma unroll
        for (int k = 0; k < 4; ++k) sc[lane + 64 * k] = s[k] * inv; }
    __syncthreads();
    { float o0 = 0.f, o1 = 0.f; const float* vv = cm + 512 + (size_t)(32 * w) * 1024;
#pragma unroll 8
      for (int mm = 0; mm < 32; ++mm) { const float p = sc[32 * w + mm]; o0 += p * vv[(size_t)mm * 1024 + lane]; o1 += p * vv[(size_t)mm * 1024 + 64 + lane]; }
      part[w * 128 + lane] = o0; part[w * 128 + 64 + lane] = o1; }
    __syncthreads();
    if (tid_ < 128) { float o = 0.f;
#pragma unroll
        for (int w2 = 0; w2 < 8; ++w2) o += part[w2 * 128 + tid_];
        WSP(bf16, WS_OX)[(size_t)tok * 512 + h * 128 + tid_] = (bf16)f2bf(o); }
}

constexpr int NL_Q = 0;
constexpr int NL_U = 16384;
constexpr int NL_OS = 81920;
constexpr int NL_TB = 16384;
constexpr int NL_SEL = 147456;
constexpr int NL_BT = 147968;
constexpr int NL_LINV = 152096;
constexpr int NL_END = 152608;
static_assert(NL_END <= LDS_BYTES, "NSA LDS map");

__device__ __forceinline__ void nsa_tables(Frame& F) {
    LAS float* bt = (LAS float*)(F.lds + NL_BT);
    for (int i = TID_; i < 129 * 8; i += NTHR) bt[i] = F.in[I_RB][t5_bucket(i >> 3) * 8 + (i & 7)] * LOG2E;
    __syncthreads();
}
__device__ __forceinline__ float nsa_bound(Frame& F) {
    const float gq = absmax_arr(F.in[I_GNQ], 64, LANE_), gk = absmax_arr(F.in[I_GNK], 192, LANE_), bm = absmax_arr(F.in[I_RB], 256, LANE_);
    return (8.0f * gq * gk * 1.02f + bm) * LOG2E;
}
__device__ __forceinline__ unsigned fkey(float x) { const unsigned u = __float_as_uint(x); return (u & 0x80000000u) ? ~u : (u | 0x80000000u); }

__device__ __forceinline__ int tile_off16(int row, int c16) { return row * 128 + ((c16 ^ (row & 7)) << 4); }
struct TileAddr { int kb[2]; int vb[2][2]; };
__device__ __forceinline__ TileAddr tile_addr(int r, int q) { TileAddr a;
    for (int ks = 0; ks < 2; ++ks) a.kb[ks] = r * 128 + (((4 * ks + q) ^ (r & 7)) << 4);
    for (int s = 0; s < 2; ++s) for (int pc = 0; pc < 2; ++pc) a.vb[s][pc] = r * 128 + (((4 * s + 2 * pc + (q >> 1)) ^ (r & 7)) << 4) + 8 * (q & 1);
    return a; }
__device__ __forceinline__ bf16x8 tile_kfrag(LAS const unsigned char* kb, const TileAddr& ta, int kt, int ks) { return as_frag(*(LAS const u32x4*)(kb + ta.kb[ks] + kt * 2048)); }
__device__ __forceinline__ bf16x8 tile_vfrag(LAS const unsigned char* vb, const TileAddr& ta, int dt, int s) {
    const u32x2 a = *(LAS const u32x2*)(vb + ta.vb[s][0] + dt * 2048), b = *(LAS const u32x2*)(vb + ta.vb[s][1] + dt * 2048);
    u32x4 w; w.x = a.x; w.y = a.y; w.z = b.x; w.w = b.y; return as_frag(w); }

#define OPAQUE_V(x) asm volatile("" : "+v"(x))
__device__ __forceinline__ void p3_nsa_prompt(Frame& F, int n, float mb, int dbg) {
    int lane0 = LANE_; OPAQUE_V(lane0);
    const int lane = lane0, r = lane & 15, q = lane >> 4, w = F.wave;
    int combo, ti;
    if (F.G == 256) { const int xcd = F.bid & 7, u = (F.bid >> 3) * 2 + (xcd & 1), rnd = n >> 8; combo = xcd >> 1; ti = rnd == 0 ? u : rnd == 1 ? 127 - u : rnd == 2 ? 128 + u : 255 - u; }
    else { const int idx = n & 255; combo = n >> 8; ti = (combo & 1) ? 255 - idx : idx; }
    const int b = combo >> 1, kv = combo & 1, t0 = 32 * ti, bk = b * 2 + kv;
    LAS bf16* Qs = (LAS bf16*)(F.lds + NL_Q); LAS float* U = (LAS float*)(F.lds + NL_U) + w * 2048; LAS unsigned* selm = (LAS unsigned*)(F.lds + NL_SEL);
    LAS const float* bt = (LAS const float*)(F.lds + NL_BT); LAS float* linv = (LAS float*)(F.lds + NL_LINV) + w * 16;
    LAS unsigned char* stA = F.lds + NL_OS;
    LAS unsigned char* stC = F.lds + NL_U;
    LAS unsigned char* stB = F.lds + NL_TB + w * 16384;
    const int tid_ = w * 64 + lane, srow = tid_ >> 3, sc16 = tid_ & 7, soff = tile_off16(srow, sc16);
    const TileAddr ta = tile_addr(r, q);
    __syncthreads();
    { const int tk = TID_ >> 4, ch = TID_ & 15; const bf16* src = WSP(bf16, WS_QN) + (size_t)(b * T + t0 + tk) * 512 + kv * 256 + ch * 16;
      const u32x4 a0 = *(const u32x4*)src, a1 = *(const u32x4*)(src + 8);
      *(LAS u32x4*)(Qs + tk * 256 + ch * 16) = a0; *(LAS u32x4*)(Qs + tk * 256 + ch * 16 + 8) = a1;
      if (TID_ < 128) selm[TID_] = 0u; }
    __syncthreads();
    const int tw = t0 + 4 * w, tr = tw + (r >> 2), h = kv * 4 + (r & 3);
    bf16x8 qf[2];
#pragma unroll
    for (int ks = 0; ks < 2; ++ks) qf[ks] = as_frag(*(LAS const u32x4*)(Qs + (16 * w + r) * 64 + 32 * ks + 8 * q));
    int ncvb = (t0 + 31 - 31) / 16 + 1; ncvb = ncvb < 511 ? ncvb : 511;
    const int nst = (ncvb + 63) >> 6;
    const int tlast = tw + 3; int ncv = tlast >= 31 ? (tlast - 31) / 16 + 1 : 0; ncv = ncv < 511 ? ncv : 511;
    const int nstw = (ncv + 63) >> 6;
    f32x4 oc[4]; float lc = 0.f, carry = 0.f;
#pragma unroll
    for (int dt = 0; dt < 4; ++dt) oc[dt] = (f32x4){0.f, 0.f, 0.f, 0.f};
    {
        const bf16* kc = WSP(bf16, WS_KCMP) + (size_t)bk * 512 * 64 + srow * 64 + sc16 * 8; const bf16* vc = WSP(bf16, WS_VCMPT) + (size_t)bk * 64 * 512 + srow * 512 + sc16 * 8;
        const int nst2 = (nst + 1) >> 1;
        u32x4 rk0 = *(const u32x4*)kc, rv0 = *(const u32x4*)vc, rk1 = *(const u32x4*)(kc + 4096), rv1 = *(const u32x4*)(vc + 64);
#pragma unroll 1
        for (int s2 = 0; s2 < nst2; ++s2) {
            LAS unsigned char* bb = stA + (s2 & 1) * 32768;
            *(LAS u32x4*)(bb + soff) = rk0; *(LAS u32x4*)(bb + 8192 + soff) = rv0; *(LAS u32x4*)(bb + 16384 + soff) = rk1; *(LAS u32x4*)(bb + 24576 + soff) = rv1;
            __syncthreads();
            if (s2 + 1 < nst2) { rk0 = *(const u32x4*)(kc + (size_t)(2 * s2 + 2) * 4096); rv0 = *(const u32x4*)(vc + (2 * s2 + 2) * 64);
                                 rk1 = *(const u32x4*)(kc + (size_t)(2 * s2 + 3) * 4096); rv1 = *(const u32x4*)(vc + (2 * s2 + 3) * 64); }
#pragma unroll
            for (int sub = 0; sub < 2; ++sub) { const int st = 2 * s2 + sub; LAS unsigned char* kb = bb + sub * 16384; LAS unsigned char* vb = kb + 8192;
            if (st < nstw && !(dbg & 1)) {
                f32x4 p[4];
#pragma unroll
                for (int kt = 0; kt < 4; ++kt) { const int tile = 4 * st + kt; p[kt] = (f32x4){0.f, 0.f, 0.f, 0.f};
                    p[kt] = MFMA16(tile_kfrag(kb, ta, kt, 0), qf[0], p[kt]); p[kt] = MFMA16(tile_kfrag(kb, ta, kt, 1), qf[1], p[kt]);
                    float G = 0.f;
#pragma unroll
                    for (int i = 0; i < 4; ++i) { const int c = 16 * tile + 4 * q + i, rel = tr - (16 * c + 31); const bool ok = rel >= 0 && c < 511;
                        const int rc = rel < 0 ? 0 : (rel > 128 ? 128 : rel);
                        const float xv = p[kt][i] + bt[rc * 8 + h] - mb;
                        const float e = __builtin_amdgcn_exp2f(ok ? xv : -1e30f); p[kt][i] = e; G += e; }
                    const float send = (q == 3) ? carry : p[kt][3]; const float prev = __shfl(send, (lane + 48) & 63); carry = p[kt][3];
                    U[r * 128 + 4 * tile + q] = G + prev; lc += G; }
                const bf16x8 pf0 = frag_pk(p[0], p[1]), pf1 = frag_pk(p[2], p[3]);
#pragma unroll
                for (int dt = 0; dt < 4; ++dt) { oc[dt] = MFMA16(tile_vfrag(vb, ta, dt, 0), pf0, oc[dt]); oc[dt] = MFMA16(tile_vfrag(vb, ta, dt, 1), pf1, oc[dt]); }
            } }
        }
    }
    lc += __shfl_xor(lc, 16); lc += __shfl_xor(lc, 32);
    const float lcinv = lc > 0.f ? 1.f / lc : 0.f;
    if (q == 0) linv[r] = lcinv;
    asm volatile("s_waitcnt lgkmcnt(0)" ::: "memory");
    if (!(dbg & 8)) {
        const int tk = lane >> 4, jr = lane & 15, t = tw + tk, tblk = t >> 6, jlim = 16 * nstw;
        const float li0 = linv[4 * tk], li1 = linv[4 * tk + 1], li2 = linv[4 * tk + 2], li3 = linv[4 * tk + 3];
        unsigned key[8];
#pragma unroll
        for (int m = 0; m < 8; ++m) { const int j = jr + 16 * m; float v = 0.f;
            if (j < jlim) v = U[(4 * tk) * 128 + j] * li0 + U[(4 * tk + 1) * 128 + j] * li1 + U[(4 * tk + 2) * 128 + j] * li2 + U[(4 * tk + 3) * 128 + j] * li3;
            const bool forced = (j == 0) || (j == tblk) || (j == tblk - 1);
            const float sc = (j <= tblk) ? v + (forced ? 1e4f : 0.f) : -1e30f;
            key[m] = fkey(sc); }
        unsigned pre = 0u;
#pragma unroll 1
        for (int bit = 31; bit >= 0; --bit) { const unsigned cand = pre | (1u << bit); int cnt = 0;
#pragma unroll
            for (int m = 0; m < 8; ++m) cnt += key[m] >= cand ? 1 : 0;
            cnt += __shfl_xor(cnt, 1); cnt += __shfl_xor(cnt, 2); cnt += __shfl_xor(cnt, 4); cnt += __shfl_xor(cnt, 8);
            if (cnt >= 16) pre = cand; }
        int ngt = 0;
#pragma unroll
        for (int m = 0; m < 8; ++m) ngt += key[m] > pre ? 1 : 0;
        ngt += __shfl_xor(ngt, 1); ngt += __shfl_xor(ngt, 2); ngt += __shfl_xor(ngt, 4); ngt += __shfl_xor(ngt, 8);
        const int need = 16 - ngt; int run = 0; const unsigned kinv = fkey(-1e30f);
#pragma unroll
        for (int m = 0; m < 8; ++m) { const bool tie = key[m] == pre; const unsigned long long bal = __ballot(tie);
            const unsigned grp = (unsigned)(bal >> (16 * tk)) & 0xffffu; const int rank = __popc(grp & ((1u << jr) - 1u));
            const bool sel = (key[m] > pre || (tie && run + rank < need)) && key[m] > kinv;
            run += __popc(grp);
            if (sel) atomicOr((unsigned*)(selm + jr + 16 * m), 1u << (4 * w + tk)); }
    }
    __syncthreads();
    f32x4 ow[4]; float lw = 0.f;
#pragma unroll
    for (int dt = 0; dt < 4; ++dt) ow[dt] = (f32x4){0.f, 0.f, 0.f, 0.f};
    {
        int lc_ = lane0; OPAQUE_V(lc_); const int lane = lc_, r = lane & 15, q = lane >> 4, tr = tw + (r >> 2), h = kv * 4 + (r & 3); const TileAddr ta = tile_addr(r, q);
        const int tid_ = w * 64 + lane, srow = tid_ >> 3, sc16 = tid_ & 7, soff = tile_off16(srow, sc16);
        const int jlob = (t0 - 511 > 0 ? t0 - 511 : 0) >> 6, jhib = (t0 + 31) >> 6, nstc = jhib - jlob + 1;
        const int jlo = (tw - 511 > 0 ? tw - 511 : 0) >> 6, jhi = (tw + 3) >> 6;
        const bf16* kwin = WSP(bf16, WS_KWIN) + (size_t)bk * T * 64 + srow * 64 + sc16 * 8; const bf16* vwin = WSP(bf16, WS_VWINT) + (size_t)bk * 128 * 4096 + srow * 64 + sc16 * 8;
        const int nstc2 = (nstc + 1) >> 1;
        u32x4 rk0 = *(const u32x4*)(kwin + (size_t)jlob * 4096), rv0 = *(const u32x4*)(vwin + (size_t)jlob * 4096), rk1 = *(const u32x4*)(kwin + (size_t)(jlob + 1) * 4096), rv1 = *(const u32x4*)(vwin + (size_t)(jlob + 1) * 4096);
#pragma unroll 1
        for (int s2 = 0; s2 < nstc2; ++s2) { const int j0 = jlob + 2 * s2;
            LAS unsigned char* bb = stC + (s2 & 1) * 32768;
            *(LAS u32x4*)(bb + soff) = rk0; *(LAS u32x4*)(bb + 8192 + soff) = rv0; *(LAS u32x4*)(bb + 16384 + soff) = rk1; *(LAS u32x4*)(bb + 24576 + soff) = rv1;
            __syncthreads();
            if (s2 + 1 < nstc2) { rk0 = *(const u32x4*)(kwin + (size_t)(j0 + 2) * 4096); rv0 = *(const u32x4*)(vwin + (size_t)(j0 + 2) * 4096);
                                  rk1 = *(const u32x4*)(kwin + (size_t)(j0 + 3) * 4096); rv1 = *(const u32x4*)(vwin + (size_t)(j0 + 3) * 4096); }
#pragma unroll
            for (int sub = 0; sub < 2; ++sub) { const int j = j0 + sub; LAS unsigned char* kb = bb + sub * 16384; LAS unsigned char* vb = kb + 8192;
            if (j >= jlo && j <= jhi && !(dbg & 2)) {
                f32x4 p[4];
#pragma unroll
                for (int kt = 0; kt < 4; ++kt) { p[kt] = (f32x4){0.f, 0.f, 0.f, 0.f};
                    p[kt] = MFMA16(tile_kfrag(kb, ta, kt, 0), qf[0], p[kt]); p[kt] = MFMA16(tile_kfrag(kb, ta, kt, 1), qf[1], p[kt]);
#pragma unroll
                    for (int i = 0; i < 4; ++i) { const int rel = tr - (64 * j + 16 * kt + 4 * q + i); const bool ok = rel >= 0 && rel < 512;
                        const int rc = rel < 0 ? 0 : (rel > 128 ? 128 : rel);
                        const float xv = p[kt][i] + bt[rc * 8 + h] - mb;
                        const float e = __builtin_amdgcn_exp2f(ok ? xv : -1e30f); p[kt][i] = e; lw += e; } }
                const bf16x8 pf0 = frag_pk(p[0], p[1]), pf1 = frag_pk(p[2], p[3]);
#pragma unroll
                for (int dt = 0; dt < 4; ++dt) { ow[dt] = MFMA16(tile_vfrag(vb, ta, dt, 0), pf0, ow[dt]); ow[dt] = MFMA16(tile_vfrag(vb, ta, dt, 1), pf1, ow[dt]); }
            } }
        }
        lw += __shfl_xor(lw, 16); lw += __shfl_xor(lw, 32);
    }
    f32x4 ocw[4];
    { const float* gt = WSP(float, WS_GATES) + (size_t)(b * T + tr) * 24 + h * 3;
      const float g0 = gt[0] * lcinv, g2 = gt[2] * (lw > 0.f ? 1.f / lw : 0.f);
#pragma unroll
      for (int dt = 0; dt < 4; ++dt) ocw[dt] = oc[dt] * g0 + ow[dt] * g2; }
    __syncthreads();
    f32x4 osf[4]; float lsf = 0.f;
    {
        int lb_ = lane0; OPAQUE_V(lb_); const int lane = lb_, r = lane & 15, q = lane >> 4, h = kv * 4 + (r & 3); const TileAddr ta = tile_addr(r, q);
        const int half = w >> 2, jw = w & 3;
        f32x4 osa[4][4]; float lsa[4];
#pragma unroll
        for (int x = 0; x < 4; ++x) { lsa[x] = 0.f;
#pragma unroll
            for (int dt = 0; dt < 4; ++dt) osa[x][dt] = (f32x4){0.f, 0.f, 0.f, 0.f}; }
        const int jmax = (t0 + 31) >> 6;
        const int brow = lane >> 3, bc16 = lane & 7, boff = brow * 64 + bc16 * 8, bsoff = tile_off16(brow, bc16); const float bfar = bt[128 * 8 + h];
        const bf16* ksel = WSP(bf16, WS_KSEL) + (size_t)bk * T * 64 + boff; const bf16* vsel = WSP(bf16, WS_VSELT) + (size_t)bk * 128 * 4096 + boff;
        LAS const bf16* Qh = Qs + (64 * half + r) * 64 + 8 * q;
        u32x4 gk[8], gv[8];
        if (jw <= jmax) {
#pragma unroll
            for (int i = 0; i < 8; ++i) { gk[i] = *(const u32x4*)(ksel + (size_t)jw * 4096 + i * 512); gv[i] = *(const u32x4*)(vsel + (size_t)jw * 4096 + i * 512); } }
#pragma unroll 1
        for (int j = jw; j <= jmax; j += 4) {
            const unsigned msel = ((unsigned)__builtin_amdgcn_readfirstlane((int)selm[j]) >> (16 * half)) & 0xffffu;
            const bool act = msel != 0u && !(dbg & 4);
            asm volatile("s_waitcnt lgkmcnt(0)" ::: "memory");
#pragma unroll
            for (int i = 0; i < 8; ++i) { *(LAS u32x4*)(stB + bsoff + i * 1024) = gk[i]; *(LAS u32x4*)(stB + 8192 + bsoff + i * 1024) = gv[i]; }
            if (j + 4 <= jmax) {
#pragma unroll
                for (int i = 0; i < 8; ++i) { gk[i] = *(const u32x4*)(ksel + (size_t)(j + 4) * 4096 + i * 512); gv[i] = *(const u32x4*)(vsel + (size_t)(j + 4) * 4096 + i * 512); } }
            if (!act) continue;
            asm volatile("s_waitcnt lgkmcnt(0)" ::: "memory");
            const bool far = (t0 - (64 * j + 63)) >= 128;
#pragma unroll 1
            for (int x = 0; x < 4; ++x) {
                const unsigned nib = (msel >> (4 * x)) & 15u;
                if (nib) {
                    asm volatile("" ::: "memory");
                    const bool tokv = (nib >> (r >> 2)) & 1u; const int t = t0 + 16 * half + 4 * x + (r >> 2);
                    const bf16x8 qs0 = as_frag(*(LAS const u32x4*)(Qh + x * 1024)), qs1 = as_frag(*(LAS const u32x4*)(Qh + x * 1024 + 32));
                    f32x4 p[4]; float ls = 0.f;
#pragma unroll
                    for (int kt = 0; kt < 4; ++kt) { p[kt] = (f32x4){0.f, 0.f, 0.f, 0.f};
                        p[kt] = MFMA16(tile_kfrag(stB, ta, kt, 0), qs0, p[kt]); p[kt] = MFMA16(tile_kfrag(stB, ta, kt, 1), qs1, p[kt]); }
                    if (dbg & 32) { ls = p[0][0]; } else
                    if (far) {
                        const float cb_ = bfar - mb;
#pragma unroll
                        for (int kt = 0; kt < 4; ++kt)
#pragma unroll
                            for (int i = 0; i < 4; ++i) { const float e = __builtin_amdgcn_exp2f(tokv ? p[kt][i] + cb_ : -1e30f); p[kt][i] = e; ls += e; }
                    } else {
#pragma unroll
                        for (int kt = 0; kt < 4; ++kt)
#pragma unroll
                            for (int i = 0; i < 4; ++i) { const int rel = t - (64 * j + 16 * kt + 4 * q + i); const bool ok = tokv && rel >= 0;
                                const int rc = rel < 0 ? 0 : (rel > 128 ? 128 : rel);
                                const float xv = p[kt][i] + bt[rc * 8 + h] - mb;
                                const float e = __builtin_amdgcn_exp2f(ok ? xv : -1e30f); p[kt][i] = e; ls += e; }
                    }
                    lsa[0] += ls;
                    const bf16x8 pf0 = frag_pk(p[0], p[1]), pf1 = frag_pk(p[2], p[3]);
#pragma unroll
                    for (int dt = 0; dt < 4; ++dt) if (!(dbg & 64)) { osa[0][dt] = MFMA16(tile_vfrag(stB + 8192, ta, dt, 0), pf0, osa[0][dt]); osa[0][dt] = MFMA16(tile_vfrag(stB + 8192, ta, dt, 1), pf1, osa[0][dt]); }
                }
                { const float l0 = lsa[0]; lsa[0] = lsa[1]; lsa[1] = lsa[2]; lsa[2] = lsa[3]; lsa[3] = l0;
#pragma unroll
                  for (int dt = 0; dt < 4; ++dt) { const f32x4 o0 = osa[0][dt]; osa[0][dt] = osa[1][dt]; osa[1][dt] = osa[2][dt]; osa[2][dt] = osa[3][dt]; osa[3][dt] = o0; } }
            }
        }
#pragma unroll
        for (int dt = 0; dt < 4; ++dt) osf[dt] = (f32x4){0.f, 0.f, 0.f, 0.f};
#pragma unroll
        for (int x = 0; x <= 4; ++x) {
            __syncthreads();
            if (x > 0 && jw == x - 1) {
#pragma unroll
                for (int w2 = 0; w2 < 4; ++w2) { LAS const float* rp = (LAS const float*)(F.lds + NL_U + ((x - 1) & 1) * 32768) + (4 * half + w2) * 1024 + lane * 16;
#pragma unroll
                    for (int dt = 0; dt < 4; ++dt) osf[dt] += *(LAS const f32x4*)(rp + 4 * dt);
                    lsf += ((LAS const float*)(F.lds + NL_Q + ((x - 1) & 1) * 2048))[(4 * half + w2) * 64 + lane]; } }
            if (x < 4) { LAS float* Rb = (LAS float*)(F.lds + NL_U + (x & 1) * 32768); LAS float* RLb = (LAS float*)(F.lds + NL_Q + (x & 1) * 2048);
#pragma unroll
                for (int dt = 0; dt < 4; ++dt) *(LAS f32x4*)(Rb + w * 1024 + lane * 16 + 4 * dt) = osa[x][dt];
                RLb[w * 64 + lane] = lsa[x]; }
        }
        lsf += __shfl_xor(lsf, 16); lsf += __shfl_xor(lsf, 32);
    }
    {
        int lf_ = lane0; OPAQUE_V(lf_); const int r = lf_ & 15, q = lf_ >> 4, tr = tw + (r >> 2), h = kv * 4 + (r & 3);
        const int tok = b * T + tr; const float g1 = WSP(float, WS_GATES)[(size_t)tok * 24 + h * 3 + 1] * (lsf > 0.f ? 1.f / lsf : 0.f);
        bf16* on = WSP(bf16, WS_ONSA) + (size_t)tok * 512 + h * 64 + 4 * q;
#pragma unroll
        for (int dt = 0; dt < 4; ++dt) { const f32x4 o = ocw[dt] + osf[dt] * g1;
            u32x2 wv; wv.x = pk2(o[0], o[1]); wv.y = pk2(o[2], o[3]); *(u32x2*)(on + 16 * dt) = wv; }
    }
}

constexpr int SL_Q = 0;
constexpr int SL_S = 1024;
constexpr int SL_O = 17408;
constexpr int SL_PART = 20480;
constexpr int SL_IMP = 28672;
constexpr int SL_IDX = 29200;
constexpr int SL_END = 29328;
static_assert(SL_END <= NL_SEL, "sample NSA LDS map must not overlap the tables");
template <class KP, class VP, class RELF>
__device__ __forceinline__ void sample_segment(Frame& F, int nk, int kv, KP kptr, VP vptr, RELF relf, LAS float* odst) {
    LAS const float* qs = (LAS const float*)(F.lds + SL_Q); LAS float* sc = (LAS float*)(F.lds + SL_S); LAS float* part = (LAS float*)(F.lds + SL_PART);
    LAS const float* bt = (LAS const float*)(F.lds + NL_BT);
    const int nkp = (nk + 63) & ~63;
    for (int n = TID_; n < nkp; n += NTHR) {
        float s0 = -INFINITY, s1 = -INFINITY, s2 = -INFINITY, s3 = -INFINITY;
        const float* kr = n < nk ? kptr(n) : nullptr;
        if (kr) { s0 = s1 = s2 = s3 = 0.f;
            for (int d = 0; d < 64; d += 4) { const f32x4 k4 = *(const f32x4*)(kr + d);
                const f32x4 q0 = *(LAS const f32x4*)(qs + d), q1 = *(LAS const f32x4*)(qs + 64 + d), q2 = *(LAS const f32x4*)(qs + 128 + d), q3 = *(LAS const f32x4*)(qs + 192 + d);
                s0 += (q0[0] * k4[0] + q0[1] * k4[1]) + (q0[2] * k4[2] + q0[3] * k4[3]); s1 += (q1[0] * k4[0] + q1[1] * k4[1]) + (q1[2] * k4[2] + q1[3] * k4[3]);
                s2 += (q2[0] * k4[0] + q2[1] * k4[1]) + (q2[2] * k4[2] + q2[3] * k4[3]); s3 += (q3[0] * k4[0] + q3[1] * k4[1]) + (q3[2] * k4[2] + q3[3] * k4[3]); }
            int rel = relf(n); rel = rel > 128 ? 128 : rel; const int bb = rel * 8 + kv * 4;
            s0 += bt[bb]; s1 += bt[bb + 1]; s2 += bt[bb + 2]; s3 += bt[bb + 3]; }
        sc[n] = s0; sc[1024 + n] = s1; sc[2048 + n] = s2; sc[3072 + n] = s3;
    }
    __syncthreads();
    if (F.wave < 4) { LAS float* row = sc + F.wave * 1024; float m = -INFINITY;
        for (int n = LANE_; n < nkp; n += 64) m = fmaxf(m, row[n]);
        m = wave_max(m); float l = 0.f;
        for (int n = LANE_; n < nkp; n += 64) { const float e = __builtin_amdgcn_exp2f(row[n] - m); row[n] = e; l += e; }
        l = wave_sum(l); const float inv = 1.f / l;
        for (int n = LANE_; n < nkp; n += 64) row[n] *= inv; }
    __syncthreads();
    {
        const int d = LANE_; float o0 = 0.f, o1 = 0.f, o2 = 0.f, o3 = 0.f;
        for (int n0 = F.wave; n0 < nkp; n0 += 128) {
            float v[16];
#pragma unroll
            for (int u = 0; u < 16; ++u) { const int n = n0 + 8 * u; v[u] = n < nk ? vptr(n)[d] : 0.f; }
#pragma unroll
            for (int u = 0; u < 16; ++u) { const int n = n0 + 8 * u; if (n < nkp) { o0 += sc[n] * v[u]; o1 += sc[1024 + n] * v[u]; o2 += sc[2048 + n] * v[u]; o3 += sc[3072 + n] * v[u]; } }
        }
        part[(F.wave * 4 + 0) * 64 + d] = o0; part[(F.wave * 4 + 1) * 64 + d] = o1; part[(F.wave * 4 + 2) * 64 + d] = o2; part[(F.wave * 4 + 3) * 64 + d] = o3; }
    __syncthreads();
    if (TID_ < 256) { float a = 0.f;
#pragma unroll
        for (int w8 = 0; w8 < 8; ++w8) a += part[w8 * 256 + TID_];
        odst[TID_] = a; }
    __syncthreads();
}
__device__ __forceinline__ void p3_nsa_sample(Frame& F, int task, int part) {
    const int b = task >> 1, kv = task & 1, tok = NTOKP + b, bk = b * 2 + kv;
    LAS float* qs = (LAS float*)(F.lds + SL_Q); LAS float* sc = (LAS float*)(F.lds + SL_S); LAS float* ob = (LAS float*)(F.lds + SL_O);
    LAS float* imp = (LAS float*)(F.lds + SL_IMP); LAS int* sidx = (LAS int*)(F.lds + SL_IDX);
    __syncthreads();
    if (TID_ < 256) qs[TID_] = bf2f(WSP(bf16, WS_QN)[(size_t)tok * 512 + kv * 256 + TID_]);
    __syncthreads();
    const float* kcs = WSP(float, WS_KCMPS) + (size_t)bk * 512 * 64; const float* vcs = WSP(float, WS_VCMPS) + (size_t)bk * 512 * 64;
    const float* nkv = WSP(float, WS_NEWKV) + (size_t)b * 4 * 2 * 64 + kv * 64;
    const float* ckv = F.in[I_CKV]; const int* pt = (const int*)F.in[I_PT] + b * 64; const float* cwin = F.in[I_CWIN] + (size_t)b * 512 * 256;
    if (part == 0) {
    sample_segment(F, 511, kv, [&](int n) { return kcs + (size_t)n * 64; }, [&](int n) { return vcs + (size_t)n * 64; }, [&](int n) { return T - (16 * n + 31); }, ob);
    if (TID_ < 129) { const int j = TID_; float v = 0.f;
        for (int c = 4 * j - 1; c <= 4 * j + 3; ++c) if (c >= 0 && c < 511) v += (sc[c] + sc[1024 + c]) + (sc[2048 + c] + sc[3072 + c]);
        imp[j] = v; }
    __syncthreads();
    if (F.wave == 0) { const int lane = LANE_; unsigned key[3];
#pragma unroll
        for (int m = 0; m < 3; ++m) { const int j = lane + 64 * m; float s = -1e30f;
            if (j < 129) { const bool forced = (j == 0) || (j == 128) || (j == 127); s = imp[j] + (forced ? 1e4f : 0.f); }
            key[m] = (j < 129) ? fkey(s) : 0u; }
        unsigned pre = 0u;
#pragma unroll 1
        for (int bit = 31; bit >= 0; --bit) { const unsigned cand = pre | (1u << bit); int cnt = 0;
#pragma unroll
            for (int m = 0; m < 3; ++m) cnt += __popcll(__ballot(key[m] >= cand));
            if (cnt >= 16) pre = cand; }
        int ngt = 0;
#pragma unroll
        for (int m = 0; m < 3; ++m) ngt += __popcll(__ballot(key[m] > pre));
        int need = 16 - ngt, cnt = 0;
#pragma unroll
        for (int m = 0; m < 3; ++m) { const bool gt = key[m] > pre, tie = key[m] == pre; const unsigned long long tb = __ballot(tie);
            const int trank = __popcll(tb & ((1ull << lane) - 1ull)); const bool sel = gt || (tie && trank < need);
            need -= __popcll(tb); need = need < 0 ? 0 : need;
            const unsigned long long sb = __ballot(sel); const int pos = cnt + __popcll(sb & ((1ull << lane) - 1ull));
            if (sel && pos < 16) sidx[pos] = lane + 64 * m; cnt += __popcll(sb); } }
    __syncthreads();
    sample_segment(F, 1024, kv,
        [&](int n) -> const float* { const int pos = 64 * sidx[n >> 6] + (n & 63); if (pos > T) return nullptr; if (pos == T) return nkv;
                                     return ckv + (((size_t)pt[pos >> 7] * 128 + (pos & 127)) * 4 + 2) * 128 + kv * 64; },
        [&](int n) -> const float* { const int pos = 64 * sidx[n >> 6] + (n & 63); if (pos >= T) return nkv + 128;
                                     return ckv + (((size_t)pt[pos >> 7] * 128 + (pos & 127)) * 4 + 3) * 128 + kv * 64; },
        [&](int n) { return T - (64 * sidx[n >> 6] + (n & 63)); }, ob + 256);
    } else {
    sample_segment(F, 512, kv,
        [&](int n) -> const float* { return n < 511 ? cwin + (size_t)(n + 1) * 256 + kv * 64 : nkv + 256; },
        [&](int n) -> const float* { return n < 511 ? cwin + (size_t)(n + 1) * 256 + 128 + kv * 64 : nkv + 384; },
        [&](int n) { return 511 - n; }, ob + 512);
    }
    if (TID_ < 256) { const int g = TID_ >> 6, d = TID_ & 63, h = kv * 4 + g; const float* gt = WSP(float, WS_GATES) + (size_t)tok * 24 + h * 3;
        const float v = part == 0 ? gt[0] * ob[TID_] + gt[1] * ob[256 + TID_] : gt[2] * ob[512 + TID_];
        atomicAdd(WSP(float, WS_ONS) + (size_t)b * 512 + h * 64 + d, v); }
}

template <bool A_F32>
__device__ __forceinline__ void skinny_mma(f32x4 (&acc)[2], float (&ssq)[2], const void* A, int lda, const bf16* Bt, int K, int n0, int k0, int nks, int r, int q) {
    acc[0] = (f32x4){0.f, 0.f, 0.f, 0.f}; acc[1] = acc[0]; ssq[0] = 0.f; ssq[1] = 0.f;
#pragma unroll 4
    for (int ks = 0; ks < nks; ++ks) { const int k = k0 + 32 * ks + 8 * q;
        const bf16x8 a = ldfrag(Bt + (size_t)(n0 + r) * K + k);
#pragma unroll
        for (int mt = 0; mt < 2; ++mt) { bf16x8 bfr;
            if (A_F32) { const float* p = (const float*)A + (size_t)(16 * mt + r) * lda + k; const f32x4 x0 = *(const f32x4*)p, x1 = *(const f32x4*)(p + 4);
                ssq[mt] += (x0[0] * x0[0] + x0[1] * x0[1]) + (x0[2] * x0[2] + x0[3] * x0[3]) + (x1[0] * x1[0] + x1[1] * x1[1]) + (x1[2] * x1[2] + x1[3] * x1[3]); bfr = frag_pk(x0, x1); }
            else bfr = ldfrag((const bf16*)A + (size_t)(16 * mt + r) * lda + k);
            acc[mt] = MFMA16(a, bfr, acc[mt]); } }
}
__device__ __forceinline__ void s5_merge(Frame& F, int t) {
    const int lane = LANE_, r = lane & 15, q = lane >> 4, br = t >> 7, nt = (t >> 1) & 63, kc = t & 1;
    const bf16* A = (br == 0 ? WSP(bf16, WS_ONSA) : br == 1 ? WSP(bf16, WS_OGLA) : WSP(bf16, WS_OX)) + (size_t)NTOKP * 512;
    const bf16* Bt = br == 0 ? WSP(bf16, WS_WTNSA) : br == 1 ? WSP(bf16, WS_WTGLA) : WSP(bf16, WS_WTX);
    f32x4 acc[2]; float ssq[2];
    if (br == 0) skinny_mma<true>(acc, ssq, WSP(float, WS_ONS), 512, Bt, 512, 16 * nt, 256 * kc, 8, r, q);
    else skinny_mma<false>(acc, ssq, A, 512, Bt, 512, 16 * nt, 256 * kc, 8, r, q);
    float* ms = WSP(float, WS_MS); const bf16* gate = WSP(bf16, WS_PROJ) + (size_t)NTOKP * DINP + C_MG + br * 1024;
#pragma unroll
    for (int mt = 0; mt < 2; ++mt) { const int m = 16 * mt + r; const u32x2 g = *(const u32x2*)(gate + (size_t)m * DINP + 16 * nt + 4 * q);
        float* d = ms + (size_t)m * 1024 + 16 * nt + 4 * q;
        atomicAdd(d + 0, acc[mt][0] * sigmoidf_(bflo(g.x))); atomicAdd(d + 1, acc[mt][1] * sigmoidf_(bfhi(g.x)));
        atomicAdd(d + 2, acc[mt][2] * sigmoidf_(bflo(g.y))); atomicAdd(d + 3, acc[mt][3] * sigmoidf_(bfhi(g.y))); }
}
__device__ __forceinline__ void s6_wo(Frame& F, int t) {
    const int lane = LANE_, r = lane & 15, q = lane >> 4, nt = t >> 2, kc = t & 3;
    f32x4 acc[2]; float ssq[2]; skinny_mma<true>(acc, ssq, WSP(float, WS_MS), 1024, WSP(bf16, WS_WTO), 1024, 16 * nt, 256 * kc, 8, r, q);
    float* x1s = WSP(float, WS_X1S);
#pragma unroll
    for (int mt = 0; mt < 2; ++mt) { float* d = x1s + (size_t)(16 * mt + r) * 1024 + 16 * nt + 4 * q;
#pragma unroll
        for (int i = 0; i < 4; ++i) atomicAdd(d + i, acc[mt][i]); }
}
__device__ __forceinline__ void s7_up(Frame& F, int t) {
    const int lane = LANE_, r = lane & 15, q = lane >> 4, c0 = 16 * t + 4 * q;
    f32x4 au[2], ag[2]; float ssq[2], ssq2[2];
    skinny_mma<true>(au, ssq, WSP(float, WS_X1S), 1024, WSP(bf16, WS_WTUP), 1024, upmap(16 * t), 0, 32, r, q);
    skinny_mma<true>(ag, ssq2, WSP(float, WS_X1S), 1024, WSP(bf16, WS_WTUP), 1024, upmap(DFF + 16 * t), 0, 32, r, q);
    const float* cw = F.in[I_CONVW]; const float* cb = F.in[I_CONVB]; const float* sconv = F.in[I_SCONV];
    const f32x4 w0 = *(const f32x4*)(cw + c0), w1 = *(const f32x4*)(cw + DFF + c0), w2 = *(const f32x4*)(cw + 2 * DFF + c0), bb = *(const f32x4*)(cb + c0);
#pragma unroll
    for (int mt = 0; mt < 2; ++mt) { const int sb = 16 * mt + r; float s = ssq[mt]; s += __shfl_xor(s, 16); s += __shfl_xor(s, 32); const float rs = rsqrtf(s * (1.f / 1024.f) + EPS);
        const f32x4 g2 = ag[mt] * rs, uu = au[mt] * rs;
        const f32x4 g0 = *(const f32x4*)(sconv + ((size_t)sb * 2 + 0) * DFF + c0), g1 = *(const f32x4*)(sconv + ((size_t)sb * 2 + 1) * DFF + c0);
        float* o = F.out + O_CONVS + (size_t)sb * 2 * DFF + c0; *(f32x4*)o = g1; *(f32x4*)(o + DFF) = g2;
        float a[4];
#pragma unroll
        for (int i = 0; i < 4; ++i) a[i] = gelu_tanh(bb[i] + w0[i] * g0[i] + w1[i] * g1[i] + w2[i] * g2[i]) * uu[i];
        u32x2 w; w.x = pk2(a[0], a[1]); w.y = pk2(a[2], a[3]);
        *(u32x2*)(WSP(bf16, WS_ACT) + (size_t)(NTOKP + sb) * DFF + c0) = w; }
}
__device__ __forceinline__ void s9_down(Frame& F, int t) {
    const int lane = LANE_, r = lane & 15, q = lane >> 4, nt = t / 11, kc = t % 11;
    f32x4 acc[2]; float ssq[2]; skinny_mma<false>(acc, ssq, WSP(bf16, WS_ACT) + (size_t)NTOKP * DFF, DFF, WSP(bf16, WS_WTDOWN), DFF, 16 * nt, 256 * kc, 8, r, q);
    float* ys = F.out + O_YS;
#pragma unroll
    for (int mt = 0; mt < 2; ++mt) { float* d = ys + (size_t)(16 * mt + r) * 1024 + 16 * nt + 4 * q;
#pragma unroll
        for (int i = 0; i < 4; ++i) atomicAdd(d + i, acc[mt][i]); }
}

constexpr int N_PHASES = 9;
__global__ void __launch_bounds__(NTHR, 2) mega_fwd(Args args) {
    extern __shared__ __attribute__((aligned(16))) unsigned char lds_raw[];
    cg::grid_group grid = cg::this_grid();
    Frame F;
    F.lds = (LAS unsigned char*)lds_raw;
    F.wave = __builtin_amdgcn_readfirstlane((int)(threadIdx.x >> 6));
    F.G = gridDim.x; F.bid = blockIdx.x; F.gw = F.bid * NWAVES + F.wave; F.NGW = F.G * NWAVES;
    F.in = args.in; F.out = args.out; F.ws = args.ws;
    const int lo = args.ph_lo, hi = args.ph_hi, sub = args.sub;
    volatile LAS unsigned* xst = (volatile LAS unsigned*)(F.lds + 152640);
    if (threadIdx.x < 2) xst[threadIdx.x] = 0u;
    __syncthreads();
    XcdBarrier xbar; xbar.bar = (unsigned*)(args.ws + WS_CTL); xbar.x = 0; xbar.st = xst;
    if (lo == 0 && hi == N_PHASES) xbar = xcd_barrier_post((unsigned*)(args.ws + WS_CTL), xst);
#define SUB(i) ((sub >> (i)) & 1)
#ifndef PROBE_REP
#define PROBE_REP -1
#endif
#define IN(k) (lo <= (k) && (k) < hi)
#define REP(k) for (int rep_ = 0; rep_ < ((k) == PROBE_REP ? 2 : 1); ++rep_)
#define SEAM(k) do { if (IN(k) && IN((k) + 1)) { xcd_barrier(xbar); } { unsigned char* w_ = F.ws; asm volatile("" : "+s"(w_)); F.ws = w_; float* o_ = F.out; asm volatile("" : "+s"(o_)); F.out = o_; } } while (0)
    typedef pg8::StaticOrder SO;
    if (lo < 0) grid.sync();
    int p2_gla_sample_task = -1;
    constexpr int KSPLIT = 9;

    REP(0) if (IN(0)) { p0_prologue(F); }
    SEAM(0);
    if (IN(1)) {
        { pg8::Gemm g{WSP(bf16, WS_XN), WSP(bf16, WS_WTIN), MPAD, DINP, 1024}; SO S; S.init(MPAD, DINP, F.G, F.bid);
          pg8::EpiStore E{WSP(bf16, WS_PROJ), DINP, nullptr};
          pg8::gemm_phase<pg8::EpiStore, SO, true, true>(F.lds, g, S, E, F.wave); }
        __syncthreads();
        { pg8::Gemm g{WSP(bf16, WS_MN), WSP(bf16, WS_WTMEM), 512, 1024, 1024}; SO S; S.init(512, 1024, F.G, F.G - 1 - F.bid);
          pg8::EpiStore E{WSP(bf16, WS_MEMPROJ), 1024, nullptr};
          pg8::gemm_phase<pg8::EpiStore, SO, true, true>(F.lds, g, S, E, F.wave); }
    }
    SEAM(1);
    if (IN(2)) {
        if (F.G == 256) {
            const int bid = F.bid;
            { const bool cblk = bid < 136; const int pidx = cblk ? -1 : ((bid - 136) << 3) + F.wave;
                if (SUB(0)) { const int tok0 = 8 * F.gw; VtAcc va; TokRaw raw = p2_token_load(F, tok0), nxt;
#define P2_TOK8(J) nxt = p2_token_load(F, tok0 + ((J) < 7 ? (J) + 1 : 7)); p2_token<J>(F, tok0 + (J), raw, va); raw = nxt;
                    P2_TOK8(0) P2_TOK8(1) P2_TOK8(2) P2_TOK8(3) P2_TOK8(4) P2_TOK8(5) P2_TOK8(6) P2_TOK8(7)
#undef P2_TOK8
                    if (!cblk && pidx >= 512 && pidx < 512 + SB) { const int tok = NTOKP + pidx - 512; p2_token<-1>(F, tok, p2_token_load(F, tok), va); }
                    if (!cblk && pidx < 512) p2_memrow(F, pidx); }
                if (!cblk && SUB(3) && pidx >= 832) p2_gla_sample_task = pidx - 832; }
            if (SUB(1) && bid < CMP_TASKS_S + CMP_TASKS_P) p2_compress(F, bid);
            if (SUB(2) && bid >= 136) { for (int bc = bid - 136; bc < 256; bc += 120) { __syncthreads(); p2_gla_chunk(F, bc); } }
            __syncthreads();
            if (p2_gla_sample_task >= 0) p2_gla_sample(F, p2_gla_sample_task);
        } else {
            if (SUB(0)) { VtAcc va; for (int tok = F.gw; tok < NTOK; tok += F.NGW) p2_token<-1>(F, tok, p2_token_load(F, tok), va);
            for (int row = F.gw; row < 512; row += F.NGW) p2_memrow(F, row); }
            if (SUB(1)) for (int t = F.bid; t < CMP_TASKS_S + CMP_TASKS_P; t += F.G) p2_compress(F, t);
            if (SUB(2)) for (int bc = F.bid; bc < 256; bc += F.G) { __syncthreads(); p2_gla_chunk(F, bc); }
            __syncthreads();
            if (SUB(3)) for (int t = F.gw; t < SB * 4; t += F.NGW) p2_gla_sample(F, t);
        }
    }
    SEAM(2);
    REP(3) if (IN(3)) {
        nsa_tables(F);
        const float mb = nsa_bound(F);
        if (SUB(4)) for (int n = F.bid; n < 1024; n += F.G) p3_nsa_prompt(F, n, mb, (sub >> 8) & 255);
        __syncthreads();
        if (SUB(7)) for (int t = F.gw; t < 1024; t += F.NGW) p3_gla_scan(F, t);
    }
    SEAM(3);
    if (IN(4)) {
        nsa_tables(F);
        if (!SUB(5)) {} else if (F.G == 256) { if (F.bid >= 192) p3_nsa_sample(F, 255 - F.bid, 0); else if (F.bid >= 128) p3_nsa_sample(F, 191 - F.bid, 1); }
        else for (int t = F.bid; t < SB * 4; t += F.G) p3_nsa_sample(F, t >> 1, t & 1);
        __syncthreads();
        { const float gq = absmax_arr(F.in[I_GXQ], 128, LANE_), gk = absmax_arr(F.in[I_GXK], 128, LANE_);
          const float mbx = 11.313708498984761f * gq * gk * 1.02f * LOG2E;
          if (SUB(6)) for (int t = F.bid; t < 256; t += F.G) p3_xatt(F, t, mbx); }
        __syncthreads();
        if (!SUB(0)) {} else if (F.G == 256) { if (F.bid >= 64 && F.bid < 192) p3_xatt_sample(F, F.bid - 64); } else for (int t = F.bid; t < SB * 4; t += F.G) p3_xatt_sample(F, t);
        __syncthreads();
        if (!SUB(1)) {} else if (F.G == 256) {
            if (F.bid < 128) { for (int k = 0; k < 3; ++k) p4_gla_out(F, k * 1024 + F.gw); }
            else if (F.bid < 192) { const int wi = ((F.bid - 128) << 3) + F.wave; for (int k = 0; k < 2; ++k) p4_gla_out(F, 3072 + k * 512 + wi); }
        } else for (int t = F.gw; t < 4096; t += F.NGW) p4_gla_out(F, t);
    }
    SEAM(4);
    if (IN(5)) {
        const bf16* gate = WSP(bf16, WS_PROJ) + C_MG;
        for (int t = F.gw; t < 384; t += F.NGW) s5_merge(F, t);
        static_assert(WS_OGLA - WS_ONSA == (size_t)MPAD * 512 * 2 && WS_OX - WS_OGLA == (size_t)MPAD * 512 * 2 && WS_WTGLA - WS_WTNSA == (size_t)1024 * 512 * 2 && WS_WTX - WS_WTGLA == (size_t)1024 * 512 * 2 && MPAD == 65 * 256, "branch operands contiguous");
        { pg8::Gemm g{WSP(bf16, WS_ONSA), WSP(bf16, WS_WTNSA), 3 * MPAD, 3 * 1024, 512}; pg8::MergeOrder S; S.init(F.G, F.bid);
          pg8::EpiMergeAll E{gate, DINP, WSP(bf16, WS_MERGED), 1024};
          pg8::gemm_phase<pg8::EpiMergeAll, pg8::MergeOrder, true, true>(F.lds, g, S, E, F.wave); }
    }
    SEAM(5);
    if (IN(6)) {
        for (int t = F.gw; t < 256; t += F.NGW) s6_wo(F, t);
        pg8::Gemm g{WSP(bf16, WS_MERGED), WSP(bf16, WS_WTO), NTOKP, 1024, 1024}; SO S; S.init(NTOKP, 1024, F.G, F.bid);
        pg8::EpiWo E{F.in[I_XP], F.in[I_XS], WSP(bf16, WS_X1B), WSP(float, WS_SSQ)};
        pg8::gemm_phase<pg8::EpiWo, SO, true, true>(F.lds, g, S, E, F.wave);
    }
    SEAM(6);
    if (IN(7)) {
        { const float* x1s = WSP(float, WS_X1S); float* ys = F.out + O_YS; for (int i = F.bid * NTHR + TID_; i < SB * 1024; i += F.G * NTHR) ys[i] = x1s[i]; }
        for (int t = F.gw; t < 176; t += F.NGW) s7_up(F, t);
        pg8::Gemm g{WSP(bf16, WS_X1B), WSP(bf16, WS_WTUP), 65 * 256, DUP, 1024, 254}; SO S; S.init(65 * 256, DUP, F.G, F.bid);
        pg8::EpiUpConv E{WSP(bf16, WS_ACT), WSP(float, WS_SSQ), F.in[I_CONVW], F.in[I_CONVB], F.out + O_CONVP, (LAS pg8::u32x4*)(F.lds + RING_BYTES)};
        pg8::gemm_phase<pg8::EpiUpConv, SO, true, true>(F.lds, g, S, E, F.wave);
    }
    SEAM(7);
    if (IN(8)) {
        for (int t = F.gw; t < 704; t += F.NGW) s9_down(F, t);
        pg8::Gemm g{WSP(bf16, WS_ACT), WSP(bf16, WS_WTDOWN), NTOKP, 1024, DFF}; SO S; S.init(NTOKP, 1024, F.G, F.bid);
        pg8::EpiDown E{WSP(bf16, WS_X1B), F.out + O_Y};
        pg8::gemm_phase<pg8::EpiDown, SO, true, true>(F.lds, g, S, E, F.wave);
    }
#undef IN
#undef SEAM
}

extern "C" void kernel_launch(void* const* d_in, const int* in_sizes, int n_in, void* d_out, int out_size, void* d_ws, size_t ws_size, hipStream_t stream) {
    static int grid = 0;
    if (grid == 0) {
        if (n_in != N_IN || (size_t)out_size != O_END || ws_size < WS_END) {
            fprintf(stderr, "kernel_launch: built for %d inputs, %zu outputs, >= %zu bytes of workspace; got %d, %d, %zu\n", (int)N_IN, (size_t)O_END, (size_t)WS_END, n_in, out_size, ws_size); grid = -1; return; }
        int dev = 0, cus = 0, per_cu = 0;
        if (hipGetDevice(&dev) != hipSuccess || hipDeviceGetAttribute(&cus, hipDeviceAttributeMultiprocessorCount, dev) != hipSuccess) { grid = -1; return; }
        if (hipFuncSetAttribute((const void*)mega_fwd, hipFuncAttributeMaxDynamicSharedMemorySize, LDS_BYTES) != hipSuccess) { fprintf(stderr, "kernel_launch: hipFuncSetAttribute failed\n"); grid = -1; return; }
        if (hipOccupancyMaxActiveBlocksPerMultiprocessor(&per_cu, (const void*)mega_fwd, NTHR, LDS_BYTES) != hipSuccess || per_cu < 1) { fprintf(stderr, "kernel_launch: occupancy query gave %d\n", per_cu); per_cu = 1; }
        (void)hipGetLastError();
        grid = cus * (per_cu < 1 ? 1 : 1);
    }
    if (grid < 0) return;
    Args a{};
    for (int i = 0; i < N_IN; ++i) a.in[i] = (const float*)d_in[i];
    a.out = (float*)d_out; a.ws = (unsigned char*)d_ws;
#if MK_N_LAUNCHES == 1
    a.ph_lo = 0; a.ph_hi = N_PHASES; a.sub = 0xff;
    (void)hipMemsetAsync((unsigned char*)d_ws + WS_CTL, 0, CTL_BYTES, stream);
    void* kargs[] = {&a};
    hipError_t e = hipLaunchCooperativeKernel((const void*)mega_fwd, dim3(grid), dim3(NTHR), kargs, LDS_BYTES, stream);
    if (e != hipSuccess) fprintf(stderr, "kernel_launch: cooperative launch failed: %s (grid %d)\n", hipGetErrorString(e), grid);
#ifdef PROBE_EXTRA
    a.ph_lo = PROBE_EXTRA; a.ph_hi = PROBE_EXTRA + 1;
#ifdef PROBE_SUB
    a.sub = PROBE_SUB;
#endif
    hipLaunchKernelGGL(mega_fwd, dim3(grid), dim3(NTHR), LDS_BYTES, stream, a);
#endif
#else
    a.sub = 0xff;
    for (int p = 0; p < N_PHASES; ++p) { a.ph_lo = p; a.ph_hi = p + 1; hipLaunchKernelGGL(mega_fwd, dim3(grid), dim3(NTHR), LDS_BYTES, stream, a); }
#endif
}
```

```cpp
#include <hip/hip_runtime.h>
#include <hip/hip_cooperative_groups.h>
#include <cstdio>
#include <cstdint>
namespace cg = cooperative_groups;
#ifndef MK_N_LAUNCHES
#define MK_N_LAUNCHES 1
#endif
namespace pg8 {
#define PG8_LAS __attribute__((address_space(3)))
typedef unsigned short bf16_t;
typedef short bf16x8 __attribute__((ext_vector_type(8)));
typedef float f32x4 __attribute__((ext_vector_type(4)));
typedef unsigned u32x4 __attribute__((ext_vector_type(4)));
constexpr int BM = 256, BK = 64, HALF = 128, HTB = HALF * BK * 2  , STAGE_BYTES = 8 * HTB, NXCD = 8, WGM = 8;

__host__ __device__ __forceinline__ int lds_byte(int r, int c) { const int st = (r >> 4) * 2 + (c >> 5), rr = r & 15, cc = c & 31, ob = rr * 64 + cc * 2; return st * 1024 + (ob ^ (((ob >> 9) & 1) << 5)); }
__host__ __device__ __forceinline__ void stage_rc(int b, int& R, int& C) { const int st = b / 1024, sb = b % 1024, swz = sb ^ (((sb >> 9) & 1) << 5); R = (st >> 1) * 16 + swz / 64; C = (st & 1) * 32 + (swz % 64) / 2; }
__host__ __device__ __forceinline__ int perm32(int rho) { const int n = rho >> 4, i = rho & 15; return 8 * (i >> 2) + 4 * n + (i & 3); }

struct Unit { int pm, pn; };
struct Gemm { const bf16_t* A; const bf16_t* Bt; int M, N, K; int rstep = 256; };

struct StaticOrder {
    int nM, nN, nwg, G, c;
    __host__ __device__ void init(int M, int N, int G_, int c_) { nM = M / BM; nN = N / BM; nwg = nM * nN; G = G_; c = c_; }
    __host__ __device__ bool next(int i, Unit& u) const {
        const long L = (long)i * G + c; if (L >= nwg) return false;
        int wgid = (int)L; { const int q = nwg / NXCD, r = nwg % NXCD, xcd = wgid % NXCD, off = wgid / NXCD; wgid = (xcd < r ? xcd * (q + 1) : r * (q + 1) + (xcd - r) * q) + off; }
        const int nig = WGM * nN, gid = wgid / nig, fm = gid * WGM, gsz = (nM - fm) < WGM ? (nM - fm) : WGM;
        u.pm = fm + ((wgid % nig) % gsz); u.pn = (wgid % nig) / gsz; return true;
    }
    __device__ __forceinline__ void a_ready(const Unit&) const {}
    __device__ __forceinline__ void done(const Unit&) const {}
};

__device__ __forceinline__ unsigned cvt_pk_bf16(float lo, float hi) { unsigned r; asm volatile("v_cvt_pk_bf16_f32 %0, %1, %2" : "=v"(r) : "v"(lo), "v"(hi)); return r; }
__device__ __forceinline__ float bflo(unsigned w) { return __uint_as_float(w << 16); }
__device__ __forceinline__ float bfhi(unsigned w) { return __uint_as_float(w & 0xffff0000u); }
__device__ __forceinline__ float sigm(float x) { return __builtin_amdgcn_rcpf(1.0f + __expf(-x)); }
struct EpiStore {
    static constexpr bool PERM = true, AFTER_DRAIN = false;
    bf16_t* O; int ldc; const float* ssq;
    __device__ __forceinline__ void operator()(const f32x4 (&acc)[2][2][4][2], const Unit& u, int wr, int wc, int fr, int fq) const {
        const int row0 = u.pm * BM + wr * 64 + fr, col0 = u.pn * BM + wc * 32 + 8 * fq;
#pragma unroll
        for (int ai = 0; ai < 2; ++ai)
#pragma unroll
            for (int m = 0; m < 4; ++m) { const int row = row0 + ai * HALF + m * 16; bf16_t* rowp = O + (size_t)row * ldc + col0;
                const float sc = ssq ? rsqrtf(ssq[row] * (1.0f / 1024.0f) + 1e-6f) : 1.0f;
#pragma unroll
                for (int bj = 0; bj < 2; ++bj) { const f32x4 v0 = acc[ai][bj][m][0] * sc, v1 = acc[ai][bj][m][1] * sc;
                    u32x4 w; w.x = cvt_pk_bf16(v0[0], v0[1]); w.y = cvt_pk_bf16(v0[2], v0[3]); w.z = cvt_pk_bf16(v1[0], v1[1]); w.w = cvt_pk_bf16(v1[2], v1[3]);
                    *(u32x4*)(rowp + bj * HALF) = w; } }
    }
};
template <int ACCUM> struct EpiMerge {
    static constexpr bool PERM = true, AFTER_DRAIN = false;
    const bf16_t* gate; int ldg; bf16_t* O; int ldc;
    __device__ __forceinline__ void operator()(const f32x4 (&acc)[2][2][4][2], const Unit& u, int wr, int wc, int fr, int fq) const {
        const int row0 = u.pm * BM + wr * 64 + fr, col0 = u.pn * BM + wc * 32 + 8 * fq;
#pragma unroll
        for (int ai = 0; ai < 2; ++ai) {
            u32x4 g[4][2], o[4][2];
#pragma unroll
            for (int m = 0; m < 4; ++m)
#pragma unroll
                for (int bj = 0; bj < 2; ++bj) g[m][bj] = __builtin_nontemporal_load((const u32x4*)(gate + (size_t)(row0 + ai * HALF + m * 16) * ldg + col0 + bj * HALF));
            if (ACCUM) {
#pragma unroll
                for (int m = 0; m < 4; ++m)
#pragma unroll
                    for (int bj = 0; bj < 2; ++bj) o[m][bj] = *(const u32x4*)(O + (size_t)(row0 + ai * HALF + m * 16) * ldc + col0 + bj * HALF); }
#pragma unroll
            for (int m = 0; m < 4; ++m) { const int row = row0 + ai * HALF + m * 16; bf16_t* rowp = O + (size_t)row * ldc + col0;
#pragma unroll
                for (int bj = 0; bj < 2; ++bj) {
                    const u32x4 gg = g[m][bj];
                    f32x4 v0 = acc[ai][bj][m][0], v1 = acc[ai][bj][m][1];
                    v0[0] *= sigm(bflo(gg.x)); v0[1] *= sigm(bfhi(gg.x)); v0[2] *= sigm(bflo(gg.y)); v0[3] *= sigm(bfhi(gg.y));
                    v1[0] *= sigm(bflo(gg.z)); v1[1] *= sigm(bfhi(gg.z)); v1[2] *= sigm(bflo(gg.w)); v1[3] *= sigm(bfhi(gg.w));
                    if (ACCUM) { const u32x4 oo = o[m][bj];
                        v0[0] += bflo(oo.x); v0[1] += bfhi(oo.x); v0[2] += bflo(oo.y); v0[3] += bfhi(oo.y);
                        v1[0] += bflo(oo.z); v1[1] += bfhi(oo.z); v1[2] += bflo(oo.w); v1[3] += bfhi(oo.w); }
                    u32x4 w; w.x = cvt_pk_bf16(v0[0], v0[1]); w.y = cvt_pk_bf16(v0[2], v0[3]); w.z = cvt_pk_bf16(v1[0], v1[1]); w.w = cvt_pk_bf16(v1[2], v1[3]);
                    *(u32x4*)(rowp + bj * HALF) = w; } }
        }
    }
};
struct MergeOrder {
    StaticOrder S0;
    __host__ __device__ void init(int G_, int c_) { S0.init(16384, 1024, G_, c_); }
    __host__ __device__ bool next(int i, Unit& u) const { Unit b; if (!S0.next(i / 3, b)) return false; const int br = i % 3; u.pm = 65 * br + b.pm; u.pn = 4 * br + b.pn; return true; }
    __device__ __forceinline__ void a_ready(const Unit&) const {}
    __device__ __forceinline__ void done(const Unit&) const {}
};
struct EpiMergeAll {
    static constexpr bool PERM = true, AFTER_DRAIN = false;
    const bf16_t* gate; int ldg; bf16_t* O; int ldc;
    __device__ __forceinline__ void operator()(const f32x4 (&acc)[2][2][4][2], const Unit& u, int wr, int wc, int fr, int fq) const {
        const int br = u.pn >> 2; Unit r; r.pm = u.pm - 65 * br; r.pn = u.pn & 3;
        if (br == 0) { EpiMerge<0> E{gate, ldg, O, ldc}; E(acc, r, wr, wc, fr, fq); }
        else { EpiMerge<1> E{gate + br * 1024, ldg, O, ldc}; E(acc, r, wr, wc, fr, fq); }
    }
};
struct EpiWo {
    static constexpr bool PERM = true, AFTER_DRAIN = false;
    const float* xp; const float* xs; bf16_t* X1B; float* ssq;
    __device__ __forceinline__ void operator()(const f32x4 (&acc)[2][2][4][2], const Unit& u, int wr, int wc, int fr, int fq) const {
        const int row0 = u.pm * BM + wr * 64 + fr, col0 = u.pn * BM + wc * 32 + 8 * fq;
#pragma unroll
        for (int ai = 0; ai < 2; ++ai)
#pragma unroll
            for (int m = 0; m < 4; ++m) { const int row = row0 + ai * HALF + m * 16;
                const float* xr = row < 16384 ? xp + (size_t)row * 1024 : (row < 16416 ? xs + (size_t)(row - 16384) * 1024 : nullptr);
                float ss = 0.f;
#pragma unroll
                for (int bj = 0; bj < 2; ++bj) { const int col = col0 + bj * HALF;
                    f32x4 x0 = (f32x4){0.f, 0.f, 0.f, 0.f}, x1 = x0;
                    if (xr) { x0 = __builtin_nontemporal_load((const f32x4*)(xr + col)); x1 = __builtin_nontemporal_load((const f32x4*)(xr + col + 4)); }
                    const f32x4 v0 = acc[ai][bj][m][0] + x0, v1 = acc[ai][bj][m][1] + x1;
                    u32x4 w; w.x = cvt_pk_bf16(v0[0], v0[1]); w.y = cvt_pk_bf16(v0[2], v0[3]); w.z = cvt_pk_bf16(v1[0], v1[1]); w.w = cvt_pk_bf16(v1[2], v1[3]);
                    *(u32x4*)(X1B + (size_t)row * 1024 + col) = w;
                    ss += (v0[0] * v0[0] + v0[1] * v0[1]) + (v0[2] * v0[2] + v0[3] * v0[3]) + (v1[0] * v1[0] + v1[1] * v1[1]) + (v1[2] * v1[2] + v1[3] * v1[3]); }
                ss += __shfl_xor(ss, 16); ss += __shfl_xor(ss, 32);
                if (fq == 0) atomicAdd(ssq + row, ss); }
    }
};
struct EpiDown {
    static constexpr bool PERM = true, AFTER_DRAIN = false;
    const bf16_t* X1B; float* yp;
    __device__ __forceinline__ void operator()(const f32x4 (&acc)[2][2][4][2], const Unit& u, int wr, int wc, int fr, int fq) const {
        const int row0 = u.pm * BM + wr * 64 + fr, col0 = u.pn * BM + wc * 32 + 8 * fq;
#pragma unroll
        for (int ai = 0; ai < 2; ++ai)
#pragma unroll
            for (int m = 0; m < 4; ++m) { const int row = row0 + ai * HALF + m * 16;
#pragma unroll
                for (int bj = 0; bj < 2; ++bj) { const int col = col0 + bj * HALF; const u32x4 x = *(const u32x4*)(X1B + (size_t)row * 1024 + col);
                    const f32x4 x0 = (f32x4){bflo(x.x), bfhi(x.x), bflo(x.y), bfhi(x.y)}, x1 = (f32x4){bflo(x.z), bfhi(x.z), bflo(x.w), bfhi(x.w)};
                    __builtin_nontemporal_store(acc[ai][bj][m][0] + x0, (f32x4*)(yp + (size_t)row * 1024 + col)); __builtin_nontemporal_store(acc[ai][bj][m][1] + x1, (f32x4*)(yp + (size_t)row * 1024 + col + 4)); } }
    }
};

__device__ __forceinline__ float gelu_tanh_e(float x) { const float u = 0.7978845608028654f * (x + 0.044715f * x * x * x); const float ex = __expf(2.0f * u); return x * (1.0f - __builtin_amdgcn_rcpf(ex + 1.0f)); }
typedef unsigned u32x2_e __attribute__((ext_vector_type(2)));
struct EpiUpConv {
    static constexpr bool PERM = true, AFTER_DRAIN = false;
    bf16_t* ACT; const float* ssq; const float* cw; const float* cb; float* convp; PG8_LAS u32x4* xbuf;
    __device__ __forceinline__ void operator()(const f32x4 (&acc)[2][2][4][2], const Unit& u, int wr, int wc, int fr, int fq) const {
        constexpr int DFF_ = 2816, T_ = 8192, NTOK_ = 16384;
        const int base = 254 * u.pm, c0 = 128 * u.pn + 32 * wc + 8 * fq, lane = fq * 16 + fr;
        u32x4 gp[2][4]; float rs[2][4];
#pragma unroll
        for (int ai = 0; ai < 2; ++ai)
#pragma unroll
            for (int m = 0; m < 4; ++m) { const int t = base + ai * HALF + wr * 64 + m * 16 + fr;
                const float rsv = t < NTOK_ ? rsqrtf(ssq[t] * (1.0f / 1024.0f) + 1e-6f) : 0.f; rs[ai][m] = rsv;
                const f32x4 g0 = acc[ai][1][m][0] * rsv, g1 = acc[ai][1][m][1] * rsv;
                gp[ai][m].x = cvt_pk_bf16(g0[0], g0[1]); gp[ai][m].y = cvt_pk_bf16(g0[2], g0[3]); gp[ai][m].z = cvt_pk_bf16(g1[0], g1[1]); gp[ai][m].w = cvt_pk_bf16(g1[2], g1[3]); }
        if (fr >= 14) {
#pragma unroll
            for (int ai = 0; ai < 2; ++ai) xbuf[((ai * 2 + wr) * 2 + (fr - 14)) * 16 + 4 * wc + fq] = gp[ai][3]; }
        asm volatile("s_waitcnt lgkmcnt(0)" ::: "memory"); __builtin_amdgcn_s_barrier(); asm volatile("" ::: "memory");
#define ROR1(v) ((unsigned)__builtin_amdgcn_update_dpp(0, (int)(v), 0x121, 0xf, 0xf, false))
#define ROR2(v) ((unsigned)__builtin_amdgcn_update_dpp(0, (int)(v), 0x122, 0xf, 0xf, false))
#pragma unroll
        for (int hf = 0; hf < 2; ++hf) {
            const int ch = c0 + 4 * hf;
            const f32x4 w0 = *(const f32x4*)(cw + ch), w1 = *(const f32x4*)(cw + DFF_ + ch), w2 = *(const f32x4*)(cw + 2 * DFF_ + ch), bb = *(const f32x4*)(cb + ch);
#pragma unroll
            for (int ai = 0; ai < 2; ++ai)
#pragma unroll
                for (int m = 0; m < 4; ++m) { const int lr = ai * HALF + wr * 64 + m * 16 + fr, t = base + lr, tt = t & (T_ - 1), grp = ai * 2 + wr;
                    const unsigned cx = hf ? gp[ai][m].z : gp[ai][m].x, cy = hf ? gp[ai][m].w : gp[ai][m].y;
                    const unsigned sAx = ROR1(cx), sAy = ROR1(cy), sBx = ROR2(cx), sBy = ROR2(cy);
                    unsigned pAx = 0u, pAy = 0u, pBx = 0u, pBy = 0u;
                    if (m > 0) { const unsigned px = hf ? gp[ai][m > 0 ? m - 1 : 0].z : gp[ai][m > 0 ? m - 1 : 0].x, py = hf ? gp[ai][m > 0 ? m - 1 : 0].w : gp[ai][m > 0 ? m - 1 : 0].y;
                        pAx = ROR1(px); pAy = ROR1(py); pBx = ROR2(px); pBy = ROR2(py); }
                    else if (grp > 0) { const u32x4 xa = xbuf[((grp - 1) * 2 + 1) * 16 + 4 * wc + fq], xb = xbuf[((grp - 1) * 2 + (fr == 0 ? 0 : 1)) * 16 + 4 * wc + fq];
                        pAx = hf ? xa.z : xa.x; pAy = hf ? xa.w : xa.y; pBx = hf ? xb.z : xb.x; pBy = hf ? xb.w : xb.y; }
                    unsigned h1x = fr >= 1 ? sAx : pAx, h1y = fr >= 1 ? sAy : pAy, h2x = fr >= 2 ? sBx : pBx, h2y = fr >= 2 ? sBy : pBy;
                    if (tt == 0) { h1x = 0u; h1y = 0u; h2x = 0u; h2y = 0u; } else if (tt == 1) { h2x = 0u; h2y = 0u; }
                    const float rsv = rs[ai][m];
                    const f32x4 uu = acc[ai][0][m][hf] * rsv;
                    const f32x4 g2 = (f32x4){bflo(cx), bfhi(cx), bflo(cy), bfhi(cy)}, g1 = (f32x4){bflo(h1x), bfhi(h1x), bflo(h1y), bfhi(h1y)}, g0 = (f32x4){bflo(h2x), bfhi(h2x), bflo(h2y), bfhi(h2y)};
                    const f32x4 gc = bb + w0 * g0 + w1 * g1 + w2 * g2;
                    const bool live = t < NTOK_ && !(u.pm > 0 && lr < 2);
                    if (live) { u32x2_e w; w.x = cvt_pk_bf16(gelu_tanh_e(gc[0]) * uu[0], gelu_tanh_e(gc[1]) * uu[1]); w.y = cvt_pk_bf16(gelu_tanh_e(gc[2]) * uu[2], gelu_tanh_e(gc[3]) * uu[3]);
                        *(u32x2_e*)(ACT + (size_t)t * DFF_ + ch) = w;
                        if (tt >= T_ - 2) *(f32x4*)(convp + ((size_t)(t >> 13) * 2 + (tt - (T_ - 2))) * DFF_ + ch) = acc[ai][1][m][hf] * rsv; } }
        }
#undef ROR1
#undef ROR2
    }
};
template <class Epi, class Sched, bool ALIGN_EPI = false, bool SP2 = false>
__device__ __forceinline__ void gemm_phase(PG8_LAS unsigned char* lds, const Gemm g, const Sched& S, const Epi& E, const int wid) {
    unsigned z_ = 0u; asm volatile("" : "+v"(z_));
    const int lane = (int)__builtin_amdgcn_mbcnt_hi(~0u, __builtin_amdgcn_mbcnt_lo(~0u, z_)), tid = wid * 64 + lane, wr = wid >> 2, wc = wid & 3, fr = lane & 15, fq = lane >> 4;
    const int K = g.K, nt = K / BK;
    unsigned voffA[2], voffB[2];
#pragma unroll
    for (int i = 0; i < 2; ++i) { int R, C; stage_rc(tid * 16 + i * 8192, R, C); const int Rb = Epi::PERM ? ((R & ~31) + perm32(R & 31)) : R;
        voffA[i] = (unsigned)(R * K + C) * 2u; voffB[i] = (unsigned)(Rb * K + C) * 2u; }
    const size_t kstep = (size_t)(BK * 2);
    const size_t hstep = (size_t)HALF * K * 2;
    const size_t tstep = 2 * hstep;
    const size_t tstepA = (size_t)g.rstep * K * 2;
    const unsigned ldsw = (unsigned)wid * 1024u;
    const int aoff = lds_byte(wr * 64 + fr, fq * 8), boff = lds_byte(wc * 32 + fr, fq * 8);
#define PG8_SA(b, h) (((b) * 2 + (h)) * HTB)
#define PG8_SB(b, h) ((4 + (b) * 2 + (h)) * HTB)
#define PG8_STAGE(bufoff, gbase, voff) do { _Pragma("unroll") for (int _i = 0; _i < 2; ++_i) \
        __builtin_amdgcn_global_load_lds((const unsigned*)((const char*)(gbase) + (voff)[_i]), (PG8_LAS unsigned*)(lds + (bufoff) + ldsw + _i * 8192), 16, 0, 0); } while (0)
#define PG8_LDA(dst, b, h) do { _Pragma("unroll") for (int m = 0; m < 4; ++m) _Pragma("unroll") for (int k = 0; k < 2; ++k) dst[m][k] = *(const PG8_LAS bf16x8*)(lds + PG8_SA(b, h) + aoff + m * 2048 + k * 1024); } while (0)
#define PG8_LDB(dst, b, h) do { _Pragma("unroll") for (int n = 0; n < 2; ++n) _Pragma("unroll") for (int k = 0; k < 2; ++k) dst[n][k] = *(const PG8_LAS bf16x8*)(lds + PG8_SB(b, h) + boff + n * 2048 + k * 1024); } while (0)
#define PG8_MMA(ai, bj, At, Bt) do { __builtin_amdgcn_s_setprio(1); _Pragma("unroll") for (int m = 0; m < 4; ++m) _Pragma("unroll") for (int n = 0; n < 2; ++n) _Pragma("unroll") for (int k = 0; k < 2; ++k) \
        acc[ai][bj][m][n] = __builtin_amdgcn_mfma_f32_16x16x32_bf16(Bt[n][k], At[m][k], acc[ai][bj][m][n], 0, 0, 0); __builtin_amdgcn_s_setprio(0); } while (0)
#define PG8_WAIT_V(n) asm volatile("s_waitcnt vmcnt(" #n ")" ::: "memory")
#define PG8_WAIT_L(n) asm volatile("s_waitcnt lgkmcnt(" #n ")" ::: "memory")
#define PG8_BAR __builtin_amdgcn_s_barrier()
#define PG8_SCHED __builtin_amdgcn_sched_barrier(0)
    Unit cur, nxt; int ui = 0;
    if (!S.next(0, cur)) return;
    f32x4 acc[2][2][4][2];
#pragma unroll
    for (int a = 0; a < 2; ++a)
#pragma unroll
        for (int b = 0; b < 2; ++b)
#pragma unroll
            for (int m = 0; m < 4; ++m)
#pragma unroll
                for (int n = 0; n < 2; ++n) acc[a][b][m][n] = (f32x4){0.f, 0.f, 0.f, 0.f};
    bf16x8 At[4][2], B0[2][2], B1[2][2];
    const char* cA = (const char*)g.A + (size_t)cur.pm * tstepA; const char* cB = (const char*)g.Bt + (size_t)cur.pn * tstep;
    S.a_ready(cur);
    if constexpr (SP2) {
        PG8_STAGE(PG8_SB(0, 0), cB, voffB); PG8_STAGE(PG8_SB(0, 1), cB + hstep, voffB); PG8_STAGE(PG8_SA(0, 0), cA, voffA); PG8_STAGE(PG8_SA(0, 1), cA + hstep, voffA);
        if (wr == 1) PG8_BAR;
        PG8_WAIT_V(2); PG8_BAR;
        PG8_STAGE(PG8_SB(1, 0), cB + kstep, voffB); PG8_STAGE(PG8_SA(1, 0), cA + kstep, voffA); PG8_STAGE(PG8_SB(1, 1), cB + hstep + kstep, voffB);
        PG8_WAIT_V(6); PG8_BAR;
    } else {
        PG8_STAGE(PG8_SB(0, 0), cB, voffB); PG8_STAGE(PG8_SA(0, 0), cA, voffA); PG8_STAGE(PG8_SB(0, 1), cB + hstep, voffB); PG8_STAGE(PG8_SA(0, 1), cA + hstep, voffA);
        if (wr == 1) PG8_BAR;
        PG8_WAIT_V(4); PG8_BAR;
        PG8_STAGE(PG8_SB(1, 0), cB + kstep, voffB); PG8_STAGE(PG8_SA(1, 0), cA + kstep, voffA); PG8_STAGE(PG8_SB(1, 1), cB + hstep + kstep, voffB);
        PG8_WAIT_V(6); PG8_BAR;
    }
    for (;;) {
        const bool has_next = S.next(ui + 1, nxt);
        const char* nA = has_next ? (const char*)g.A + (size_t)nxt.pm * tstepA : cA; const char* nB = has_next ? (const char*)g.Bt + (size_t)nxt.pn * tstep : cB;
        for (int t = 0; t < nt; t += 2) {
            const bool last = (t == nt - 2);
            const char* a1 = cA + (size_t)(t + 1) * kstep;
            const char* a2 = last ? nA : cA + (size_t)(t + 2) * kstep; const char* b2 = last ? nB : cB + (size_t)(t + 2) * kstep;
            const char* a3 = a2 + kstep; const char* b3 = b2 + kstep;
            if (last && has_next) S.a_ready(nxt);
            if constexpr (SP2) {
            PG8_LDB(B0, 0, 0); PG8_LDB(B1, 0, 1); PG8_SCHED; PG8_LDA(At, 0, 0); PG8_STAGE(PG8_SA(1, 1), a1 + hstep, voffA);
            PG8_WAIT_V(8); PG8_WAIT_L(0); PG8_BAR; PG8_MMA(0, 0, At, B0); PG8_MMA(0, 1, At, B1); PG8_BAR; PG8_SCHED;
            PG8_LDA(At, 0, 1); PG8_STAGE(PG8_SB(0, 0), b2, voffB); PG8_STAGE(PG8_SB(0, 1), b2 + hstep, voffB); PG8_STAGE(PG8_SA(0, 0), a2, voffA);
            PG8_WAIT_V(8); PG8_WAIT_L(0); PG8_BAR; PG8_MMA(1, 0, At, B0); PG8_MMA(1, 1, At, B1); PG8_BAR; PG8_SCHED;
            PG8_LDB(B0, 1, 0); PG8_LDB(B1, 1, 1); PG8_SCHED; PG8_LDA(At, 1, 0); PG8_STAGE(PG8_SA(0, 1), a2 + hstep, voffA);
            PG8_WAIT_V(8); PG8_WAIT_L(0); PG8_BAR; PG8_MMA(0, 0, At, B0); PG8_MMA(0, 1, At, B1); PG8_BAR; PG8_SCHED;
            PG8_LDA(At, 1, 1); PG8_STAGE(PG8_SB(1, 0), b3, voffB); PG8_STAGE(PG8_SB(1, 1), b3 + hstep, voffB); PG8_STAGE(PG8_SA(1, 0), a3, voffA);
            PG8_WAIT_V(8); PG8_WAIT_L(0); PG8_BAR; PG8_MMA(1, 0, At, B0); PG8_MMA(1, 1, At, B1); PG8_BAR; PG8_SCHED;
            } else {
            PG8_LDB(B0, 0, 0); PG8_SCHED; PG8_LDA(At, 0, 0); PG8_STAGE(PG8_SA(1, 1), a1 + hstep, voffA);
            PG8_WAIT_L(8); PG8_BAR; PG8_WAIT_L(0); PG8_MMA(0, 0, At, B0); PG8_BAR; PG8_SCHED;
            PG8_LDB(B1, 0, 1); PG8_STAGE(PG8_SB(0, 0), b2, voffB);
            PG8_BAR; PG8_WAIT_L(0); PG8_MMA(0, 1, At, B1); PG8_BAR;
            PG8_LDA(At, 0, 1); PG8_STAGE(PG8_SA(0, 0), a2, voffA);
            PG8_BAR; PG8_WAIT_L(0); PG8_MMA(1, 0, At, B0); PG8_BAR; PG8_SCHED;
            PG8_STAGE(PG8_SB(0, 1), b2 + hstep, voffB);
            PG8_WAIT_V(6); PG8_BAR; PG8_MMA(1, 1, At, B1); PG8_BAR;
            PG8_LDB(B0, 1, 0); PG8_SCHED; PG8_LDA(At, 1, 0); PG8_STAGE(PG8_SA(0, 1), a2 + hstep, voffA);
            PG8_WAIT_L(8); PG8_BAR; PG8_WAIT_L(0); PG8_MMA(0, 0, At, B0); PG8_BAR; PG8_SCHED;
            PG8_LDB(B1, 1, 1); PG8_STAGE(PG8_SB(1, 0), b3, voffB);
            PG8_BAR; PG8_WAIT_L(0); PG8_MMA(0, 1, At, B1); PG8_BAR;
            PG8_LDA(At, 1, 1); PG8_STAGE(PG8_SA(1, 0), a3, voffA);
            PG8_BAR; PG8_WAIT_L(0); PG8_MMA(1, 0, At, B0); PG8_BAR; PG8_SCHED;
            PG8_STAGE(PG8_SB(1, 1), b3 + hstep, voffB);
            PG8_WAIT_V(6); PG8_BAR; PG8_MMA(1, 1, At, B1); PG8_BAR;
            }
        }
        if constexpr (ALIGN_EPI) { if (wr == 0) PG8_BAR; }
        if constexpr (!Epi::AFTER_DRAIN) { E(acc, cur, wr, wc, fr, fq); S.done(cur); }
        if (!has_next) break;
#pragma unroll
        for (int a = 0; a < 2; ++a)
#pragma unroll
            for (int b = 0; b < 2; ++b)
#pragma unroll
                for (int m = 0; m < 4; ++m)
#pragma unroll
                    for (int n = 0; n < 2; ++n) acc[a][b][m][n] = (f32x4){0.f, 0.f, 0.f, 0.f};
        cur = nxt; cA = nA; cB = nB; ++ui;
        if constexpr (ALIGN_EPI) { if (wr == 1) PG8_BAR; }
    }
    PG8_WAIT_V(0);
    if constexpr (!ALIGN_EPI) { if (wr == 0) PG8_BAR; }
    PG8_BAR;
    if constexpr (Epi::AFTER_DRAIN) { E.fused(acc, cur, wr, wc, fr, fq, lds, wid, lane); S.done(cur); }
#undef PG8_SA
#undef PG8_SB
#undef PG8_STAGE
#undef PG8_LDA
#undef PG8_LDB
#undef PG8_MMA
#undef PG8_WAIT_V
#undef PG8_WAIT_L
#undef PG8_BAR
#undef PG8_SCHED
}
}

typedef unsigned short bf16;
typedef short bf16x8 __attribute__((ext_vector_type(8)));
typedef short bf16x4 __attribute__((ext_vector_type(4)));
typedef float f32x4 __attribute__((ext_vector_type(4)));
typedef unsigned u32x4 __attribute__((ext_vector_type(4)));
typedef unsigned u32x2 __attribute__((ext_vector_type(2)));
#define LAS __attribute__((address_space(3)))
constexpr int NWAVES = 8, NTHR = 512;
constexpr int DM = 1024, T = 8192, NB = 2, NTOKP = NB * T, SB = 32, NTOK = NTOKP + SB, MPAD = 16640;
constexpr int DIN = 6440, DINP = 6656, DFF = 2816, DUP = 2 * DFF;
constexpr int C_Q = 0, C_KV = 512, C_G = 1280, C_GQ = 1304, C_GK = 1560, C_GV = 1816, C_LR = 2328, C_GR = 2344, C_XQ = 2856, C_MG = 3368;
constexpr float EPS = 1e-6f, LOG2E = 1.4426950408889634f;
constexpr float QSCALE = 0.125f * LOG2E;
constexpr float XSCALE = 0.08838834764831845f * LOG2E;
constexpr size_t O_Y = 0, O_YS = 16777216, O_KVP = O_YS + 32768, O_WINP = O_KVP + 8388608, O_GLAP = O_WINP + 262144, O_CONVP = O_GLAP + 65536,
                 O_MEMP = O_CONVP + 11264, O_KVS = O_MEMP + 524288, O_WINS = O_KVS + 16384, O_GLAS = O_WINS + 4194304, O_CONVS = O_GLAS + 1048576, O_END = O_CONVS + 180224;
enum { I_XP = 0, I_XS, I_CKV, I_CWIN, I_SGLA, I_SCONV, I_CMEM, I_PT, I_MEMP, I_GMIX, I_WIN, I_GNQ, I_GNK, I_CKPE, I_CKW1, I_CKW2, I_CVPE, I_CVW1, I_CVW2,
       I_RB, I_WGG, I_BGG, I_GGO, I_GMEM, I_WMEM, I_GXQ, I_GXK, I_WNSA, I_WGLA, I_WX, I_WO, I_GFFN, I_WUP, I_CONVW, I_CONVB, I_WDOWN, N_IN };
constexpr size_t al_(size_t x) { return (x + 255) & ~(size_t)255; }
constexpr size_t WS_SSQ = 0;
constexpr size_t WS_C0 = al_(WS_SSQ + (size_t)MPAD * 4);
constexpr size_t WS_WTIN = al_(WS_C0 + 1024);
constexpr size_t WS_WTMEM = al_(WS_WTIN + (size_t)DINP * 1024 * 2);
constexpr size_t WS_WTNSA = al_(WS_WTMEM + (size_t)1024 * 1024 * 2);
constexpr size_t WS_WTGLA = al_(WS_WTNSA + (size_t)1024 * 512 * 2);
constexpr size_t WS_WTX = al_(WS_WTGLA + (size_t)1024 * 512 * 2);
constexpr size_t WS_WTO = al_(WS_WTX + (size_t)1024 * 512 * 2);
constexpr size_t WS_WTUP = al_(WS_WTO + (size_t)1024 * 1024 * 2);
constexpr size_t WS_WTDOWN = al_(WS_WTUP + (size_t)DUP * 1024 * 2);
constexpr size_t WS_W1T = al_(WS_WTDOWN + (size_t)1024 * DFF * 2);
constexpr size_t WS_W2T = al_(WS_W1T + (size_t)2 * 64 * 2048 * 2);
constexpr size_t WS_XN = al_(WS_W2T + (size_t)2 * 64 * 64 * 2);
constexpr size_t WS_MN = al_(WS_XN + (size_t)MPAD * 1024 * 2);
constexpr size_t WS_PROJ = al_(WS_MN + (size_t)512 * 1024 * 2);
constexpr size_t WS_MEMPROJ = al_(WS_PROJ + (size_t)MPAD * DINP * 2);
constexpr size_t WS_QN = al_(WS_MEMPROJ + (size_t)512 * 1024 * 2);
constexpr size_t WS_KSEL = al_(WS_QN + (size_t)NTOK * 512 * 2);
constexpr size_t WS_VSELT = al_(WS_KSEL + (size_t)4 * T * 64 * 2);
constexpr size_t WS_KWIN = al_(WS_VSELT + (size_t)4 * T * 64 * 2);
constexpr size_t WS_VWINT = al_(WS_KWIN + (size_t)4 * T * 64 * 2);
constexpr size_t WS_GATES = al_(WS_VWINT + (size_t)4 * T * 64 * 2);
constexpr size_t WS_NEWKV = al_(WS_GATES + (size_t)NTOK * 24 * 4);
constexpr size_t WS_KCMP = al_(WS_NEWKV + (size_t)SB * 4 * 2 * 64 * 4);
constexpr size_t WS_VCMPT = al_(WS_KCMP + (size_t)4 * 512 * 64 * 2);
constexpr size_t WS_KCMPS = al_(WS_VCMPT + (size_t)4 * 512 * 64 * 2);
constexpr size_t WS_VCMPS = al_(WS_KCMPS + (size_t)SB * 2 * 512 * 64 * 4);
constexpr size_t WS_QTG = al_(WS_VCMPS + (size_t)SB * 2 * 512 * 64 * 4);
constexpr size_t WS_KTG = al_(WS_QTG + (size_t)NTOKP * 256 * 2);
constexpr size_t WS_VTG = al_(WS_KTG + (size_t)NTOKP * 256 * 2);
constexpr size_t WS_UP = al_(WS_VTG + (size_t)256 * 4 * 128 * 64 * 2);
constexpr size_t WS_DEC = al_(WS_UP + (size_t)256 * 4 * 128 * 64 * 4);
constexpr size_t WS_SC = al_(WS_DEC + (size_t)256 * 4 * 64 * 4);
constexpr size_t WS_XQ = al_(WS_SC + (size_t)256 * 4 * 128 * 64 * 2);
constexpr size_t WS_KMEM = al_(WS_XQ + (size_t)NTOK * 512 * 2);
constexpr size_t WS_VMEMT = al_(WS_KMEM + (size_t)8 * 256 * 128 * 2);
constexpr size_t WS_ONSA = al_(WS_VMEMT + (size_t)8 * 256 * 128 * 2);
constexpr size_t WS_OGLA = al_(WS_ONSA + (size_t)MPAD * 512 * 2);
constexpr size_t WS_OX = al_(WS_OGLA + (size_t)MPAD * 512 * 2);
constexpr size_t WS_MERGED = al_(WS_OX + (size_t)MPAD * 512 * 2);
constexpr size_t WS_X1 = al_(WS_MERGED + (size_t)MPAD * 1024 * 2);
constexpr size_t WS_X1B = al_(WS_X1 + (size_t)MPAD * 1024 * 4);
constexpr size_t WS_UG = al_(WS_X1B + (size_t)MPAD * 1024 * 2);
constexpr size_t WS_ACT = al_(WS_UG + (size_t)MPAD * DUP * 2);
constexpr size_t WS_MS = al_(WS_ACT + (size_t)MPAD * DFF * 2);
constexpr size_t WS_X1S = al_(WS_MS + (size_t)SB * 1024 * 4);
constexpr size_t WS_ONS = al_(WS_X1S + (size_t)SB * 1024 * 4);
constexpr size_t WS_PARK = al_(WS_ONS + (size_t)SB * 512 * 4);
constexpr size_t WS_CTL = al_(WS_PARK + (size_t)2048 * 4096);
constexpr size_t CTL_BYTES = 16384;
constexpr size_t WS_END = al_(WS_CTL + CTL_BYTES);
constexpr int RING_BYTES = 131072, LDS_BYTES = 155648;

#define GAS __attribute__((address_space(1)))
struct Args { GAS const float* in[N_IN]; GAS float* out; GAS unsigned char* ws; int ph_lo, ph_hi, sub, pad; };
struct ArgsHost { const float* in[N_IN]; float* out; unsigned char* ws; int ph_lo, ph_hi, sub, pad; };
static_assert(sizeof(Args) == sizeof(ArgsHost), "argument block layout");

__device__ __forceinline__ unsigned f2bf(float f) { unsigned u = __float_as_uint(f); return (u + 0x7fffu + ((u >> 16) & 1u)) >> 16; }
__device__ __forceinline__ unsigned pk2(float lo, float hi) { return pg8::cvt_pk_bf16(lo, hi); }
__device__ __forceinline__ float bf2f(unsigned short u) { return __uint_as_float((unsigned)u << 16); }
__device__ __forceinline__ float bflo(unsigned w) { return __uint_as_float(w << 16); }
__device__ __forceinline__ float bfhi(unsigned w) { return __uint_as_float(w & 0xffff0000u); }
__device__ __forceinline__ void unpack8(const u32x4 w, float (&f)[8]) { f[0] = bflo(w.x); f[1] = bfhi(w.x); f[2] = bflo(w.y); f[3] = bfhi(w.y); f[4] = bflo(w.z); f[5] = bfhi(w.z); f[6] = bflo(w.w); f[7] = bfhi(w.w); }
__device__ __forceinline__ u32x4 pack8(const float (&f)[8]) { u32x4 w; w.x = pk2(f[0], f[1]); w.y = pk2(f[2], f[3]); w.z = pk2(f[4], f[5]); w.w = pk2(f[6], f[7]); return w; }
__device__ __forceinline__ bf16x8 as_frag(u32x4 w) { return __builtin_bit_cast(bf16x8, w); }
__device__ __forceinline__ bf16x8 frag_pk(f32x4 a, f32x4 b) { u32x4 w; w.x = pk2(a[0], a[1]); w.y = pk2(a[2], a[3]); w.z = pk2(b[0], b[1]); w.w = pk2(b[2], b[3]); return as_frag(w); }
__device__ __forceinline__ bf16x8 ldfrag(const bf16* p) { return as_frag(*(const u32x4*)p); }
__device__ __forceinline__ bf16x8 ldfrag2(const bf16* p0, const bf16* p1) { const u32x2 a = *(const u32x2*)p0, b = *(const u32x2*)p1; u32x4 w; w.x = a.x; w.y = a.y; w.z = b.x; w.w = b.y; return as_frag(w); }
__device__ __forceinline__ bf16x8 ldfrag_f32(const float* p) { const f32x4 a = *(const f32x4*)p, b = *(const f32x4*)(p + 4); return frag_pk(a, b); }
#define MFMA16(a, b, c) __builtin_amdgcn_mfma_f32_16x16x32_bf16((a), (b), (c), 0, 0, 0)
__device__ __forceinline__ float sigmoidf_(float x) { return __builtin_amdgcn_rcpf(1.0f + __expf(-x)); }
__device__ __forceinline__ float gelu_tanh(float x) { const float u = 0.7978845608028654f * (x + 0.044715f * x * x * x); const float e = __expf(2.0f * u); return x * (1.0f - __builtin_amdgcn_rcpf(e + 1.0f)); }
__device__ __forceinline__ float wave_sum(float v) {
#pragma unroll
    for (int o = 1; o < 64; o <<= 1) v += __shfl_xor(v, o);
    return v;
}
__device__ __forceinline__ float wave_max(float v) {
#pragma unroll
    for (int o = 1; o < 64; o <<= 1) v = fmaxf(v, __shfl_xor(v, o));
    return v;
}
__device__ __forceinline__ float absmax_arr(const float* g, int n, int lane) { float m = 0.f; for (int i = lane; i < n; i += 64) m = fmaxf(m, fabsf(g[i])); return wave_max(m); }
__device__ __forceinline__ int t5_bucket(int n) {
    if (n < 16) return n;
    if (n >= 128) return 31;
    const int v = 16 + (int)(__logf((float)n * 0.0625f) / 2.0794415416798357f * 16.0f);
    return v < 31 ? v : 31;
}

#define XB_TMO      128
#define XB_XCNT(j)  (256  + 64 * (j))
#define XB_XSUB(j)  (1280 + 64 * (j))
#define XB_XGEN(j)  (2304 + 64 * (j))
#define XB_TOP      3328
#define XB_TOPGEN   3392
#define XCD_BAR_WORDS 3456
#define XB_SPIN_CAP (1u << 18)

__device__ __forceinline__ unsigned xb_ld(unsigned* p)              { return __hip_atomic_load(p, __ATOMIC_RELAXED, __HIP_MEMORY_SCOPE_AGENT); }
__device__ __forceinline__ unsigned xb_add(unsigned* p, unsigned v) { return __hip_atomic_fetch_add(p, v, __ATOMIC_RELAXED, __HIP_MEMORY_SCOPE_AGENT); }
__device__ __forceinline__ unsigned xb_xcc_id() { return (unsigned)__builtin_amdgcn_s_getreg((3 << 11) | 20) & 0xFu; }
#define XB_SPIN(cond, bar) do { unsigned _sp = 0; while (cond) { __builtin_amdgcn_s_sleep(1); \
    if ((++_sp & 255u) == 0u) { if (xb_ld(&(bar)[XB_TMO])) break; if (_sp > XB_SPIN_CAP) { atomicAdd(&(bar)[XB_TMO], 1u); break; } } } } while (0)

struct XcdBarrier {
    unsigned* bar; unsigned x;
    volatile LAS unsigned* st;
};

__device__ __forceinline__ XcdBarrier xcd_barrier_post(unsigned* bar, volatile LAS unsigned* st) {
    XcdBarrier b; b.bar = bar; b.x = xb_xcc_id(); b.st = st;
    if (threadIdx.x == 0) (void)xb_add(&bar[XB_XCNT(b.x)], 1u);
    return b;
}
__device__ __forceinline__ void xcd_barrier_complete(unsigned* bar, unsigned x, unsigned& nloc, unsigned& nx) {
    const unsigned G = gridDim.x * gridDim.y * gridDim.z;
    unsigned sum, cnt, mine, sp = 0u;
    for (;;) {
        sum = 0u; cnt = 0u; mine = 0u;
#pragma unroll
        for (unsigned j = 0; j < 16; ++j) { const unsigned c = xb_ld(&bar[XB_XCNT(j)]); sum += c; cnt += (c > 0u) ? 1u : 0u; mine = (j == x) ? c : mine; }
        if (sum == G) break;
        __builtin_amdgcn_s_sleep(1);
        if ((++sp & 255u) == 0u) { if (xb_ld(&bar[XB_TMO])) break; if (sp > XB_SPIN_CAP) { atomicAdd(&bar[XB_TMO], 1u); break; } }
    }
    nloc = mine > 0u ? mine : 1u; nx = cnt > 0u ? cnt : 1u;
}

__device__ __forceinline__ void xcd_barrier(const XcdBarrier& b) {
    asm volatile("s_waitcnt vmcnt(0)" ::: "memory");
    __syncthreads();
    if (threadIdx.x == 0) {
        unsigned* bar = b.bar;
        __builtin_amdgcn_s_waitcnt(0);
        unsigned nloc = b.st[0], nx = b.st[1];
        if (nloc == 0u) { xcd_barrier_complete(bar, b.x, nloc, nx); b.st[0] = nloc; b.st[1] = nx; }
        const unsigned old = xb_add(&bar[XB_XSUB(b.x)], 1u);
        const unsigned gen = old / nloc;
        if (old + 1u == (gen + 1u) * nloc) {
            __builtin_amdgcn_fence(__ATOMIC_RELEASE, "agent");
            asm volatile("s_waitcnt vmcnt(0)" ::: "memory");
            const unsigned og = xb_add(&bar[XB_TOP], 1u);
            const unsigned tg = og / nx;
            if (og + 1u == (tg + 1u) * nx) xb_add(&bar[XB_TOPGEN], 1u);
            else XB_SPIN(xb_ld(&bar[XB_TOPGEN]) == tg, bar);
            __builtin_amdgcn_fence(__ATOMIC_ACQUIRE, "agent");
            xb_add(&bar[XB_XGEN(b.x)], 1u);
            asm volatile("s_waitcnt vmcnt(0)" ::: "memory");
        } else {
            XB_SPIN(xb_ld(&bar[XB_XGEN(b.x)]) == gen, bar);
            __builtin_amdgcn_fence(__ATOMIC_ACQUIRE, "agent");
            asm volatile("s_waitcnt vmcnt(0)" ::: "memory");
        }
    }
    __syncthreads();
}

struct Frame {
    LAS unsigned char* lds;
    int wave, G, bid, gw, NGW;
    GAS const float* const* in; GAS float* out; GAS unsigned char* ws;
};
#define WSP(T_, off) ((T_*)(GAS T_*)(F.ws + (off)))
#define FIN(i) ((const float*)F.in[i])
#define FOUT ((float*)F.out)
__device__ __forceinline__ int lane_id_() { unsigned z = 0u; asm volatile("" : "+v"(z)); return (int)__builtin_amdgcn_mbcnt_hi(~0u, __builtin_amdgcn_mbcnt_lo(~0u, z)); }
#define LANE_ lane_id_()
#define TID_ (F.wave * 64 + lane_id_())

__device__ __host__ __forceinline__ int upmap(int n) { return n < 2816 ? (n >> 7) * 256 + (n & 127) : ((n - 2816) >> 7) * 256 + 128 + ((n - 2816) & 127); }
struct TrItem { const float* W; bf16* WT; const float* kscale; int K, N, k0, n0, n0d; };
__device__ __forceinline__ TrItem tr_desc(Frame& F, int it) {
    constexpr int IT_IN = 16 * 208, IT_MEM = 16 * 32, IT_BR = 8 * 32, IT_O = 16 * 32, IT_UP = 16 * 176, IT_DOWN = 44 * 32, IT_W1 = 32 * 2, IT_W2 = 1 * 2;
    TrItem d; d.kscale = nullptr; int r = it, nblk = 32; bool up = false;
    if (r < IT_UP) { d.W = FIN(I_WUP); d.K = 1024; d.N = DUP; d.WT = WSP(bf16, WS_WTUP); d.kscale = FIN(I_GFFN); nblk = 176; up = true; }
    else if ((r -= IT_UP) < IT_IN) { d.W = FIN(I_WIN); d.K = 1024; d.N = DIN; d.WT = WSP(bf16, WS_WTIN); nblk = 208; }
    else if ((r -= IT_IN) < IT_DOWN) { d.W = FIN(I_WDOWN); d.K = DFF; d.N = 1024; d.WT = WSP(bf16, WS_WTDOWN); }
    else if ((r -= IT_DOWN) < IT_MEM) { d.W = FIN(I_WMEM); d.K = 1024; d.N = 1024; d.WT = WSP(bf16, WS_WTMEM); }
    else if ((r -= IT_MEM) < IT_O) { d.W = FIN(I_WO); d.K = 1024; d.N = 1024; d.WT = WSP(bf16, WS_WTO); }
    else if ((r -= IT_O) < IT_BR) { d.W = FIN(I_WNSA); d.K = 512; d.N = 1024; d.WT = WSP(bf16, WS_WTNSA); }
    else if ((r -= IT_BR) < IT_BR) { d.W = FIN(I_WGLA); d.K = 512; d.N = 1024; d.WT = WSP(bf16, WS_WTGLA); }
    else if ((r -= IT_BR) < IT_BR) { d.W = FIN(I_WX); d.K = 512; d.N = 1024; d.WT = WSP(bf16, WS_WTX); }
    else if ((r -= IT_BR) < IT_W1) { d.W = FIN(I_CKW1); d.K = 2048; d.N = 64; d.WT = WSP(bf16, WS_W1T); nblk = 2; }
    else if ((r -= IT_W1) < IT_W1) { d.W = FIN(I_CVW1); d.K = 2048; d.N = 64; d.WT = WSP(bf16, WS_W1T) + 64 * 2048; nblk = 2; }
    else if ((r -= IT_W1) < IT_W2) { d.W = FIN(I_CKW2); d.K = 64; d.N = 64; d.WT = WSP(bf16, WS_W2T); nblk = 2; }
    else { r -= IT_W2; d.W = FIN(I_CVW2); d.K = 64; d.N = 64; d.WT = WSP(bf16, WS_W2T) + 64 * 64; nblk = 2; }
    const int kb = r / nblk, nb = r % nblk; d.k0 = 64 * kb; d.n0 = 32 * nb; d.n0d = up ? upmap(d.n0) : d.n0; return d; }
struct TrRegs { f32x4 v[8]; float ks[8]; };
__device__ __forceinline__ void tr_load(const TrItem& d, TrRegs& t, int lane) {
#pragma unroll
    for (int i = 0; i < 8; ++i) { const int kk = 8 * i + (lane >> 3); const int n = d.n0 + 4 * (lane & 7);
        t.v[i] = n < d.N ? __builtin_nontemporal_load((const f32x4*)(d.W + (size_t)(d.k0 + kk) * d.N + n)) : (f32x4){0.f, 0.f, 0.f, 0.f}; t.ks[i] = d.kscale ? d.kscale[d.k0 + kk] : 1.f; } }
__device__ __forceinline__ void tr_store(const TrItem& d, const TrRegs& t, LAS float* scr, int lane) {
#pragma unroll
    for (int i = 0; i < 8; ++i) { const int kk = 8 * i + (lane >> 3); const f32x4 v = t.v[i] * t.ks[i];
        LAS float* p = scr + kk * 33 + 4 * (lane & 7); p[0] = v[0]; p[1] = v[1]; p[2] = v[2]; p[3] = v[3]; }
    asm volatile("s_waitcnt lgkmcnt(0)" ::: "memory");
    const int c = lane & 7;
#pragma unroll
    for (int j = 0; j < 4; ++j) { const int n = (lane >> 3) + 8 * j; const LAS float* s = scr + (8 * c) * 33 + n;
        u32x4 o; o.x = pk2(s[0 * 33], s[1 * 33]); o.y = pk2(s[2 * 33], s[3 * 33]); o.z = pk2(s[4 * 33], s[5 * 33]); o.w = pk2(s[6 * 33], s[7 * 33]);
        *(u32x4*)(d.WT + (size_t)(d.n0d + n) * d.K + d.k0 + 8 * c) = o; }
    asm volatile("s_waitcnt lgkmcnt(0)" ::: "memory");
}
template <int SET>
__device__ __forceinline__ void tr_items(Frame& F, LAS float* scr, int wv, int nwv) {
    constexpr int IT_IN = 16 * 208, IT_MEM = 16 * 32, IT_BR = 8 * 32, IT_O = 16 * 32, IT_UP = 16 * 176, IT_DOWN = 44 * 32, IT_W1 = 32 * 2, IT_W2 = 1 * 2;
    constexpr int NITEMS = IT_IN + IT_MEM + 3 * IT_BR + IT_O + IT_UP + IT_DOWN + 2 * IT_W1 + 2 * IT_W2;
    constexpr int N = SET == 0 ? NITEMS - IT_UP - IT_DOWN : (SET == 1 ? IT_UP + IT_DOWN : NITEMS);
#define TR_ID(k) (SET == 0 ? ((k) < IT_IN ? IT_UP + (k) : IT_UP + IT_DOWN + (k)) : (SET == 1 ? ((k) < IT_UP ? (k) : IT_IN + (k)) : (k)))
    const int ipw = (N + nwv - 1) / nwv, it0 = wv * ipw, it1 = min(N, (wv + 1) * ipw);
    if (it0 < it1) { TrItem dc = tr_desc(F, TR_ID(it0)); TrRegs tc; tr_load(dc, tc, LANE_);
#pragma unroll 1
        for (int it = it0; it < it1; ++it) { TrItem dn = dc; TrRegs tn = tc; const bool more = it + 1 < it1;
            if (more) { dn = tr_desc(F, TR_ID(it + 1)); tr_load(dn, tn, LANE_); }
            tr_store(dc, tc, scr, LANE_); dc = dn; tc = tn; } }
#undef TR_ID
}
struct RowSrc { const float* x; const float* g; bf16* o; };
__device__ __forceinline__ RowSrc row_src(Frame& F, int m) { RowSrc s;
    if (m < MPAD) { s.x = m < NTOKP ? FIN(I_XP) + (size_t)m * 1024 : (m < NTOK ? FIN(I_XS) + (size_t)(m - NTOKP) * 1024 : nullptr); s.g = FIN(I_GMIX); s.o = WSP(bf16, WS_XN) + (size_t)m * 1024; }
    else { const int mm = m - MPAD; s.x = FIN(I_MEMP) + (size_t)mm * 1024; s.g = FIN(I_GMEM); s.o = WSP(bf16, WS_MN) + (size_t)mm * 1024; }
    return s; }
struct RowRegs { f32x4 v[4]; };
__device__ __forceinline__ void row_load(const RowSrc& s, RowRegs& r, int lane) {
#pragma unroll
    for (int j = 0; j < 4; ++j) r.v[j] = s.x ? __builtin_nontemporal_load((const f32x4*)s.x + lane + 64 * j) : (f32x4){0.f, 0.f, 0.f, 0.f}; }
__device__ __forceinline__ void row_finish(const RowSrc& s, const RowRegs& r, int lane) {
    unsigned long long* o8 = (unsigned long long*)s.o + lane; const f32x4* gr = (const f32x4*)s.g + lane; float ss = 0.f;
#pragma unroll
    for (int j = 0; j < 4; ++j) ss += (r.v[j].x * r.v[j].x + r.v[j].y * r.v[j].y) + (r.v[j].z * r.v[j].z + r.v[j].w * r.v[j].w);
    const float rs = rsqrtf(wave_sum(ss) * (1.f / 1024.f) + EPS);
#pragma unroll
    for (int j = 0; j < 4; ++j) { const f32x4 gg = gr[64 * j]; const f32x4 y = r.v[j] * rs * gg;
        o8[64 * j] = (unsigned long long)pk2(y.x, y.y) | ((unsigned long long)pk2(y.z, y.w) << 32); } }
__device__ __forceinline__ void p0_prologue(Frame& F) {
    LAS float* scr = (LAS float*)(F.lds + F.wave * 16384);
    const int gw = F.gw, NGW = F.NGW;
    if (F.G == 256) tr_items<0>(F, scr, gw, NGW); else tr_items<2>(F, scr, gw, NGW);
    if (gw < MPAD + 512) { RowSrc sc = row_src(F, gw); RowRegs rc; row_load(sc, rc, LANE_);
#pragma unroll 1
        for (int m = gw; m < MPAD + 512; m += NGW) { RowSrc sn = sc; RowRegs rn = rc; if (m + NGW < MPAD + 512) { sn = row_src(F, m + NGW); row_load(sn, rn, LANE_); }
            row_finish(sc, rc, LANE_); sc = sn; rc = rn; } }
    { float* ssq = WSP(float, WS_SSQ); for (int i = F.bid * NTHR + TID_; i < MPAD; i += F.G * NTHR) ssq[i] = 0.f; }
    { float* ms = WSP(float, WS_MS); float* x1s = WSP(float, WS_X1S); const float* xs = FIN(I_XS);
      for (int i = F.bid * NTHR + TID_; i < SB * 1024; i += F.G * NTHR) { ms[i] = 0.f; x1s[i] = xs[i]; }
      float* ons = WSP(float, WS_ONS); for (int i = F.bid * NTHR + TID_; i < SB * 512; i += F.G * NTHR) ons[i] = 0.f; }
}
__device__ __forceinline__ void win_copy(Frame& F, int part, int nparts) {
    const f32x4* src = (const f32x4*)FIN(I_CWIN); f32x4* dst = (f32x4*)(FOUT + O_WINS); constexpr int NW = SB * 511 * 64; const int st = nparts * NTHR;
    for (int i = part * NTHR + TID_; i < NW; i += 4 * st) { f32x4 v[4]; size_t o[4];
#pragma unroll
        for (int u = 0; u < 4; ++u) { const int ii = min(i + u * st, NW - 1); const int b = ii / (511 * 64), r = ii % (511 * 64); o[u] = (size_t)b * 512 * 64 + r; v[u] = __builtin_nontemporal_load(src + o[u] + 64); }
#pragma unroll
        for (int u = 0; u < 4; ++u) if (i + u * st < NW) __builtin_nontemporal_store(v[u], dst + o[u]); }
}

struct TokRaw { u32x4 q, kva, kvb, xq; unsigned short g; };
__device__ __forceinline__ TokRaw p2_token_load(Frame& F, int tok) {
    const int lane = LANE_; const bf16* pr = WSP(bf16, WS_PROJ) + (size_t)tok * DINP; TokRaw r;
    r.q = *(const u32x4*)(pr + C_Q + 8 * lane); r.kva = *(const u32x4*)(pr + C_KV + 8 * lane); r.kvb = *(const u32x4*)(pr + C_KV + 512 + 8 * lane);
    r.xq = *(const u32x4*)(pr + C_XQ + 8 * lane); r.g = pr[C_G + (lane < 24 ? lane : 0)]; return r; }
struct VtAcc { unsigned s[8][4]; unsigned w[8][4]; };
struct TokG { float q[8], k1[8], k2[8], xq[8]; };
__device__ __forceinline__ TokG p2_token_gains(Frame& F) { const int lane = LANE_; TokG g;
    const float* a = FIN(I_GNQ) + 8 * (lane & 7); const float* k = FIN(I_GNK) + 8 * (lane & 7); const float* x = FIN(I_GXQ) + 8 * (lane & 15);
#pragma unroll
    for (int i = 0; i < 8; ++i) { g.q[i] = a[i]; g.k1[i] = k[64 + i]; g.k2[i] = k[128 + i]; g.xq[i] = x[i]; }
    return g; }
template <int J>
__device__ __forceinline__ void p2_token(Frame& F, int tok, const TokRaw& raw, VtAcc& va, const TokG& tg) {
    const int lane = LANE_;
    const bool prompt = tok < NTOKP; const int b = tok >> 13, t = tok & (T - 1), sb = tok - NTOKP;
    float f[8];
    { unpack8(raw.q, f); float ss = 0.f;
#pragma unroll
      for (int i = 0; i < 8; ++i) ss += f[i] * f[i];
      ss += __shfl_xor(ss, 1); ss += __shfl_xor(ss, 2); ss += __shfl_xor(ss, 4);
      const float rs = rsqrtf(ss * (1.f / 64.f) + EPS) * QSCALE;
#pragma unroll
      for (int i = 0; i < 8; ++i) f[i] *= rs * tg.q[i];
      *(u32x4*)(WSP(bf16, WS_QN) + (size_t)tok * 512 + 8 * lane) = pack8(f); }
    { unpack8(raw.kva, f); float ss = 0.f;
#pragma unroll
      for (int i = 0; i < 8; ++i) ss += f[i] * f[i];
      ss += __shfl_xor(ss, 1); ss += __shfl_xor(ss, 2); ss += __shfl_xor(ss, 4);
      const int grp = lane >> 3, slot = grp >> 1, kv = grp & 1, d0 = 8 * (lane & 7);
      if (slot == 2) { const float rs = rsqrtf(ss * (1.f / 64.f) + EPS);
#pragma unroll
          for (int i = 0; i < 8; ++i) f[i] *= rs * tg.k1[i]; }
      float* orow = prompt ? FOUT + O_KVP + (size_t)tok * 512 + 8 * lane : FOUT + O_KVS + (size_t)sb * 512 + 8 * lane;
      __builtin_nontemporal_store((f32x4){f[0], f[1], f[2], f[3]}, (f32x4*)orow); __builtin_nontemporal_store((f32x4){f[4], f[5], f[6], f[7]}, (f32x4*)(orow + 4));
      if (prompt) {
          if (slot == 2) *(u32x4*)(WSP(bf16, WS_KSEL) + ((size_t)(b * 2 + kv) * T + t) * 64 + d0) = pack8(f);
          if (J < 0) { if (slot == 3) { bf16* vt = WSP(bf16, WS_VSELT) + (((size_t)(b * 2 + kv) * 128 + (t >> 6)) * 64 + d0) * 64 + (t & 63);
#pragma unroll
              for (int i = 0; i < 8; ++i) vt[i * 64] = (bf16)f2bf(f[i]); } }
          else {
#pragma unroll
              for (int i = 0; i < 8; ++i) { const unsigned hv = f2bf(f[i]); if ((J & 1) == 0) va.s[i][(J >> 1) & 3] = hv; else va.s[i][(J >> 1) & 3] |= hv << 16; }
              if (J == 7 && slot == 3) { bf16* vt = WSP(bf16, WS_VSELT) + (((size_t)(b * 2 + kv) * 128 + (t >> 6)) * 64 + d0) * 64 + ((t & 63) - 7);
#pragma unroll
                  for (int i = 0; i < 8; ++i) *(u32x4*)(vt + i * 64) = (u32x4){va.s[i][0], va.s[i][1], va.s[i][2], va.s[i][3]}; } }
      } else if (slot >= 2) { float* nk = WSP(float, WS_NEWKV) + ((size_t)(sb * 4 + (slot - 2)) * 2 + kv) * 64 + d0;
#pragma unroll
          for (int i = 0; i < 8; ++i) nk[i] = f[i]; }
    }
    { unpack8(raw.kvb, f); float ss = 0.f;
#pragma unroll
      for (int i = 0; i < 8; ++i) ss += f[i] * f[i];
      ss += __shfl_xor(ss, 1); ss += __shfl_xor(ss, 2); ss += __shfl_xor(ss, 4);
      const int grp = lane >> 3, slot = 4 + (grp >> 1), kv = grp & 1, d0 = 8 * (lane & 7);
      if (lane < 32) {
          if (slot == 4) { const float rs = rsqrtf(ss * (1.f / 64.f) + EPS);
#pragma unroll
              for (int i = 0; i < 8; ++i) f[i] *= rs * tg.k2[i]; }
          if (prompt) {
              if (slot == 4) *(u32x4*)(WSP(bf16, WS_KWIN) + ((size_t)(b * 2 + kv) * T + t) * 64 + d0) = pack8(f);
              else if (J < 0) { bf16* vt = WSP(bf16, WS_VWINT) + (((size_t)(b * 2 + kv) * 128 + (t >> 6)) * 64 + d0) * 64 + (t & 63);
#pragma unroll
                  for (int i = 0; i < 8; ++i) vt[i * 64] = (bf16)f2bf(f[i]); }
              else {
#pragma unroll
                  for (int i = 0; i < 8; ++i) { const unsigned hv = f2bf(f[i]); if ((J & 1) == 0) va.w[i][(J >> 1) & 3] = hv; else va.w[i][(J >> 1) & 3] |= hv << 16; }
                  if (J == 7) { bf16* vt = WSP(bf16, WS_VWINT) + (((size_t)(b * 2 + kv) * 128 + (t >> 6)) * 64 + d0) * 64 + ((t & 63) - 7);
#pragma unroll
                      for (int i = 0; i < 8; ++i) *(u32x4*)(vt + i * 64) = (u32x4){va.w[i][0], va.w[i][1], va.w[i][2], va.w[i][3]}; } }
              if (t >= T - 512) { float* orow = FOUT + O_WINP + ((size_t)b * 512 + (t - (T - 512))) * 256 + 8 * lane;
                  *(f32x4*)orow = (f32x4){f[0], f[1], f[2], f[3]}; *(f32x4*)(orow + 4) = (f32x4){f[4], f[5], f[6], f[7]}; }
          } else {
              float* nk = WSP(float, WS_NEWKV) + ((size_t)(sb * 4 + (slot - 2)) * 2 + kv) * 64 + d0;
#pragma unroll
              for (int i = 0; i < 8; ++i) nk[i] = f[i];
              float* orow = FOUT + O_WINS + ((size_t)sb * 512 + 511) * 256 + 8 * lane;
              *(f32x4*)orow = (f32x4){f[0], f[1], f[2], f[3]}; *(f32x4*)(orow + 4) = (f32x4){f[4], f[5], f[6], f[7]};
          }
      }
    }
    if (lane < 24) WSP(float, WS_GATES)[(size_t)tok * 24 + lane] = sigmoidf_(bf2f(raw.g));
    { unpack8(raw.xq, f); float ss = 0.f;
#pragma unroll
      for (int i = 0; i < 8; ++i) ss += f[i] * f[i];
      ss += __shfl_xor(ss, 1); ss += __shfl_xor(ss, 2); ss += __shfl_xor(ss, 4); ss += __shfl_xor(ss, 8);
      const float rs = rsqrtf(ss * (1.f / 128.f) + EPS) * XSCALE;
#pragma unroll
      for (int i = 0; i < 8; ++i) f[i] *= rs * tg.xq[i];
      *(u32x4*)(WSP(bf16, WS_XQ) + (size_t)tok * 512 + 8 * lane) = pack8(f); }
}
__device__ __forceinline__ void p2_memrow(Frame& F, int row) {
    const int lane = LANE_, b = row >> 8, m = row & 255, head = lane >> 4, d0 = 8 * (lane & 15);
    const bf16* pr = WSP(bf16, WS_MEMPROJ) + (size_t)row * 1024; float f[8];
    { unpack8(*(const u32x4*)(pr + 8 * lane), f); float ss = 0.f;
#pragma unroll
      for (int i = 0; i < 8; ++i) ss += f[i] * f[i];
      ss += __shfl_xor(ss, 1); ss += __shfl_xor(ss, 2); ss += __shfl_xor(ss, 4); ss += __shfl_xor(ss, 8);
      const float rs = rsqrtf(ss * (1.f / 128.f) + EPS); const float* g = FIN(I_GXK) + d0;
#pragma unroll
      for (int i = 0; i < 8; ++i) f[i] *= rs * g[i];
      float* orow = FOUT + O_MEMP + ((size_t)row * 2 + 0) * 512 + 8 * lane;
      *(f32x4*)orow = (f32x4){f[0], f[1], f[2], f[3]}; *(f32x4*)(orow + 4) = (f32x4){f[4], f[5], f[6], f[7]};
      *(u32x4*)(WSP(bf16, WS_KMEM) + ((size_t)(b * 4 + head) * 256 + m) * 128 + d0) = pack8(f); }
    { unpack8(*(const u32x4*)(pr + 512 + 8 * lane), f);
      float* orow = FOUT + O_MEMP + ((size_t)row * 2 + 1) * 512 + 8 * lane;
      *(f32x4*)orow = (f32x4){f[0], f[1], f[2], f[3]}; *(f32x4*)(orow + 4) = (f32x4){f[4], f[5], f[6], f[7]};
      bf16* vt = WSP(bf16, WS_VMEMT) + ((size_t)(b * 4 + head) * 128 + d0) * 256 + m;
#pragma unroll
      for (int i = 0; i < 8; ++i) vt[i * 256] = (bf16)f2bf(f[i]); }
}

constexpr int CMP_TASKS_S = SB * 2 * 2, CMP_TASKS_P = NB * 2 * 2;
__device__ __forceinline__ int cmp_tile_off16(int row, int c16) { return row * 128 + ((c16 ^ (row & 7)) << 4); }
__device__ __forceinline__ void p2_compress(Frame& F, int task) {
    const int lane = LANE_, r = lane & 15, q = lane >> 4, w = F.wave, tid_ = w * 64 + lane;
    const bool smp = task < CMP_TASKS_S; const int x = smp ? task : task - CMP_TASKS_S;
    const int b = x >> 2, iq = x & 3, kv = (w >> 1) & 1, slot = w & 1, i0 = 128 * iq + 64 * (w >> 2);
    const bf16* W1t = WSP(bf16, WS_W1T) + (size_t)slot * 64 * 2048;
    const bf16* W2t = WSP(bf16, WS_W2T) + (size_t)slot * 64 * 64;
    const int* pt = (const int*)FIN(I_PT) + b * 64;
    const float* ckv = FIN(I_CKV); const float* pe = FIN(slot ? I_CVPE : I_CKPE);
    const bf16* proj = WSP(bf16, WS_PROJ);
    LAS unsigned char* wb = F.lds;
    const int srow = tid_ >> 3, sc16 = tid_ & 7, soff = cmp_tile_off16(srow, sc16);
    int kb0[2]; kb0[0] = r * 128 + (((0 + q) ^ (r & 7)) << 4); kb0[1] = r * 128 + (((4 + q) ^ (r & 7)) << 4);
    f32x4 acc[4][4];
#pragma unroll
    for (int nt = 0; nt < 4; ++nt)
#pragma unroll
        for (int it = 0; it < 4; ++it) acc[nt][it] = (f32x4){0.f, 0.f, 0.f, 0.f};
    const bf16* wsrc = WSP(bf16, WS_W1T) + (size_t)srow * 2048 + sc16 * 8;
    u32x4 rw[2][2];
#pragma unroll
    for (int sb = 0; sb < 2; ++sb) { rw[sb][0] = *(const u32x4*)(wsrc + 64 * 16 * sb); rw[sb][1] = *(const u32x4*)(wsrc + 64 * 2048 + 64 * 16 * sb); }
    LAS unsigned char* xt = F.lds + 65536 + w * 8704;
    u32x4 xr[17];
    const int xrow = smp ? (lane >> 4) : (lane >> 3), xch = smp ? (lane & 15) : (lane & 7);
#define CMP_LOAD_ROWS(S) do { if (smp) { _Pragma("unroll") for (int i = 0; i < 17; ++i) { const int ib = i0 + 4 * i + xrow; int tok = 16 * ib + (S); tok = tok < T ? tok : T - 1; \
            const int page = ptl[tok >> 7]; xr[i] = __builtin_nontemporal_load((const u32x4*)(ckv + (((size_t)page * 128 + (tok & 127)) * 4 + slot) * 128 + kv * 64 + 4 * xch)); } } \
        else { _Pragma("unroll") for (int i = 0; i < 9; ++i) { const int ib = i0 + 8 * i + xrow; int tok = 16 * ib + (S); tok = tok < T ? tok : T - 1; \
            xr[i] = *(const u32x4*)(proj + ((size_t)b * T + tok) * DINP + C_KV + slot * 128 + kv * 64 + 8 * xch); } } } while (0)
    LAS int* ptl = (LAS int*)(F.lds + RING_BYTES + 8192);
    int kb1[2];
#pragma unroll
    for (int ks2 = 0; ks2 < 2; ++ks2) kb1[ks2] = (r + 1) * 128 + (((4 * ks2 + q) ^ ((r + 1) & 7)) << 4);
    f32x4 accb[4];
#pragma unroll
    for (int nt = 0; nt < 4; ++nt) accb[nt] = (f32x4){0.f, 0.f, 0.f, 0.f};
    __syncthreads();
    if (tid_ < 64) ptl[tid_] = smp ? pt[tid_] : 0;
    __syncthreads();
    CMP_LOAD_ROWS(0);
#pragma unroll 1
    for (int s = 0; s < 16; ++s) {
#pragma unroll
        for (int sb = 0; sb < 2; ++sb) { *(LAS u32x4*)(wb + (s & 1) * 32768 + (sb * 2 + 0) * 8192 + soff) = rw[sb][0]; *(LAS u32x4*)(wb + (s & 1) * 32768 + (sb * 2 + 1) * 8192 + soff) = rw[sb][1]; }
        __syncthreads();
        if (s + 1 < 16) {
#pragma unroll
            for (int sb = 0; sb < 2; ++sb) { rw[sb][0] = *(const u32x4*)(wsrc + 64 * (s + 1 + 16 * sb)); rw[sb][1] = *(const u32x4*)(wsrc + 64 * 2048 + 64 * (s + 1 + 16 * sb)); } }
        if (smp) {
#pragma unroll
            for (int i = 0; i < 17; ++i) { const f32x4 v = __builtin_bit_cast(f32x4, xr[i]); u32x2 wv; wv.x = pk2(v[0], v[1]); wv.y = pk2(v[2], v[3]);
                const int row = 4 * i + xrow; if (i < 16 || xrow == 0) *(LAS u32x2*)(xt + cmp_tile_off16(row, xch >> 1) + 8 * (xch & 1)) = wv; } }
        else {
#pragma unroll
            for (int i = 0; i < 9; ++i) { const int row = 8 * i + xrow; if (i < 8 || xrow == 0) *(LAS u32x4*)(xt + cmp_tile_off16(row, xch)) = xr[i]; } }
        if (s + 1 < 16) CMP_LOAD_ROWS(s + 1);
#pragma unroll
        for (int sb = 0; sb < 2; ++sb) { const int kp = s + 16 * sb;
            LAS const unsigned char* wt = wb + (s & 1) * 32768 + (sb * 2 + slot) * 8192;
#pragma unroll
            for (int ks2 = 0; ks2 < 2; ++ks2) {
                bf16x8 xf[4];
#pragma unroll
                for (int it = 0; it < 4; ++it) xf[it] = as_frag(*(LAS const u32x4*)(xt + (sb ? kb1[ks2] : kb0[ks2]) + it * 2048));
                const bf16x8 pf = ldfrag_f32(pe + 64 * kp + 32 * ks2 + 8 * q);
#pragma unroll
                for (int nt = 0; nt < 4; ++nt) { const bf16x8 a = as_frag(*(LAS const u32x4*)(wt + kb0[ks2] + nt * 2048));
                    accb[nt] = MFMA16(a, pf, accb[nt]);
#pragma unroll
                    for (int it = 0; it < 4; ++it) acc[nt][it] = MFMA16(a, xf[it], acc[nt][it]); } }
        }
        asm volatile("s_waitcnt lgkmcnt(0)" ::: "memory");
    }
#pragma unroll
    for (int nt = 0; nt < 4; ++nt)
#pragma unroll
        for (int it = 0; it < 4; ++it) acc[nt][it] = acc[nt][it] + accb[nt];
#undef CMP_LOAD_ROWS
    const float* gk0 = FIN(I_GNK);
#pragma unroll
    for (int it = 0; it < 4; ++it) {
        f32x4 g[4];
#pragma unroll
        for (int nt = 0; nt < 4; ++nt)
#pragma unroll
            for (int i = 0; i < 4; ++i) g[nt][i] = gelu_tanh(acc[nt][it][i]);
        const bf16x8 b0 = frag_pk(g[0], g[1]), b1 = frag_pk(g[2], g[3]);
        f32x4 o[4]; float ss = 0.f;
#pragma unroll
        for (int mt = 0; mt < 4; ++mt) { const bf16* wr = W2t + (size_t)(16 * mt + r) * 64 + 4 * q;
            o[mt] = MFMA16(ldfrag2(wr, wr + 16), b0, ((f32x4){0.f, 0.f, 0.f, 0.f}));
            o[mt] = MFMA16(ldfrag2(wr + 32, wr + 48), b1, o[mt]);
            ss += (o[mt][0] * o[mt][0] + o[mt][1] * o[mt][1]) + (o[mt][2] * o[mt][2] + o[mt][3] * o[mt][3]); }
        ss += __shfl_xor(ss, 16); ss += __shfl_xor(ss, 32);
        if (slot == 0) { const float rs = rsqrtf(ss * (1.f / 64.f) + EPS);
#pragma unroll
            for (int mt = 0; mt < 4; ++mt) { const f32x4 gg = *(const f32x4*)(gk0 + 16 * mt + 4 * q); o[mt] = o[mt] * rs * gg; } }
        const int i = i0 + 16 * it + r;
        if (smp) { float* dst = WSP(float, slot ? WS_VCMPS : WS_KCMPS) + ((size_t)(b * 2 + kv) * 512 + i) * 64 + 4 * q;
#pragma unroll
            for (int mt = 0; mt < 4; ++mt) *(f32x4*)(dst + 16 * mt) = o[mt]; }
        else if (slot == 0) { bf16* dst = WSP(bf16, WS_KCMP) + ((size_t)(b * 2 + kv) * 512 + i) * 64 + 4 * q;
#pragma unroll
            for (int mt = 0; mt < 4; ++mt) { u32x2 wv; wv.x = pk2(o[mt][0], o[mt][1]); wv.y = pk2(o[mt][2], o[mt][3]); *(u32x2*)(dst + 16 * mt) = wv; } }
        else { bf16* dst = WSP(bf16, WS_VCMPT) + ((size_t)(b * 2 + kv) * 64 + 4 * q) * 512 + i;
#pragma unroll
            for (int mt = 0; mt < 4; ++mt)
#pragma unroll
                for (int e = 0; e < 4; ++e) dst[(size_t)(16 * mt + e) * 512] = (bf16)f2bf(o[mt][e]); }
    }
}

__device__ __forceinline__ int swz64(int row, int col) { return row * 64 + ((((col >> 3) ^ (row & 7)) << 3) | (col & 7)); }
__device__ __forceinline__ float log_sigmoid_(float z) { return fminf(z, 0.f) - __logf(1.0f + __expf(-fabsf(z))); }
__device__ __forceinline__ void p2_gla_chunk(Frame& F, int bc) {
    const int lane = LANE_, r = lane & 15, q = lane >> 4, h = F.wave >> 1, eh = F.wave & 1;
    LAS bf16* ktT = (LAS bf16*)(F.lds + F.wave * 16384);
    LAS bf16* vT = ktT + 4096;
    const bf16* proj = WSP(bf16, WS_PROJ) + (size_t)bc * 64 * DINP;
    float wg[16];
#pragma unroll
    for (int j = 0; j < 16; ++j) wg[j] = FIN(I_WGG)[j * 256 + h * 64 + lane];
    const float bg = FIN(I_BGG)[h * 64 + lane];
    bf16* qtg = WSP(bf16, WS_QTG) + (size_t)bc * 64 * 256 + h * 64 + lane;
    bf16* ktg = WSP(bf16, WS_KTG) + (size_t)bc * 64 * 256 + h * 64 + lane;
    LAS float* lrs = (LAS float*)(F.lds + RING_BYTES);
    { const int tid_ = F.wave * 64 + lane; if (tid_ < 128) { float f8[8]; unpack8(*(const u32x4*)(proj + (size_t)(tid_ >> 1) * DINP + C_LR + 8 * (tid_ & 1)), f8);
#pragma unroll
        for (int i = 0; i < 8; ++i) lrs[(tid_ >> 1) * 16 + 8 * (tid_ & 1) + i] = f8[i]; } }
    __syncthreads();
    float cb = 0.f;
    bf16 kr[16], qr[16], vr[16], kn[16], qn[16], vn[16];
#pragma unroll
    for (int i = 0; i < 16; ++i) { const bf16* pr = proj + (size_t)i * DINP; kr[i] = pr[C_GK + h * 64 + lane]; qr[i] = pr[C_GQ + h * 64 + lane]; vr[i] = pr[C_GV + h * 128 + eh * 64 + lane]; }
#pragma unroll 1
    for (int tb = 0; tb < 4; ++tb) {
        const int tn = tb < 3 ? tb + 1 : 3;
#pragma unroll
        for (int i = 0; i < 16; ++i) { const bf16* pr = proj + (size_t)(16 * tn + i) * DINP; kn[i] = pr[C_GK + h * 64 + lane]; qn[i] = pr[C_GQ + h * 64 + lane]; vn[i] = pr[C_GV + h * 128 + eh * 64 + lane]; }
#pragma unroll
        for (int i = 0; i < 16; ++i) { const int t = 16 * tb + i;
            float z = bg;
#pragma unroll
            for (int j4 = 0; j4 < 4; ++j4) { const f32x4 l4 = *(LAS const f32x4*)(lrs + t * 16 + 4 * j4); z += l4[0] * wg[4 * j4] + l4[1] * wg[4 * j4 + 1] + l4[2] * wg[4 * j4 + 2] + l4[3] * wg[4 * j4 + 3]; }
            cb += log_sigmoid_(z) * 0.0625f;
            const float kk = bf2f(kr[i]) * __expf(-cb);
            const float qq = bf2f(qr[i]) * 0.125f * __expf(cb);
            const bf16 kb = (bf16)f2bf(kk);
            if (eh == 0) { qtg[(size_t)t * 256] = (bf16)f2bf(qq); ktg[(size_t)t * 256] = kb; }
            ktT[swz64(lane, t)] = kb;
            const bf16 vv = vr[i];
            vT[swz64(lane, t)] = vv; }
#pragma unroll
        for (int i = 0; i < 16; ++i) { kr[i] = kn[i]; qr[i] = qn[i]; vr[i] = vn[i]; }
    }
    const float dec = __expf(cb);
    if (eh == 0) WSP(float, WS_DEC)[(size_t)(bc * 4 + h) * 64 + lane] = dec;
    asm volatile("s_waitcnt lgkmcnt(0)" ::: "memory");
    {
        bf16* vrow = WSP(bf16, WS_VTG) + ((size_t)(bc * 4 + h) * 128 + eh * 64) * 64;
#pragma unroll
        for (int i = 0; i < 8; ++i) { const int e = 8 * i + (lane >> 3), c8 = lane & 7;
            *(u32x4*)(vrow + (size_t)e * 64 + c8 * 8) = *(const LAS u32x4*)(vT + swz64(e, c8 * 8)); } }
    f32x4 acc[4][4];
#pragma unroll
    for (int et = 0; et < 4; ++et)
#pragma unroll
        for (int dt = 0; dt < 4; ++dt) acc[et][dt] = (f32x4){0.f, 0.f, 0.f, 0.f};
#pragma unroll
    for (int ks = 0; ks < 2; ++ks) {
        bf16x8 bfr[4];
#pragma unroll
        for (int dt = 0; dt < 4; ++dt) bfr[dt] = as_frag(*(const LAS u32x4*)(ktT + swz64(16 * dt + r, 32 * ks + 8 * q)));
#pragma unroll
        for (int et = 0; et < 4; ++et) { const bf16x8 a = as_frag(*(const LAS u32x4*)(vT + swz64(16 * et + r, 32 * ks + 8 * q)));
#pragma unroll
            for (int dt = 0; dt < 4; ++dt) acc[et][dt] = MFMA16(a, bfr[dt], acc[et][dt]); }
    }
    float* up = WSP(float, WS_UP) + ((size_t)(bc * 4 + h) * 128 + eh * 64) * 64;
#pragma unroll
    for (int dt = 0; dt < 4; ++dt) { const float dd = __shfl(dec, 16 * dt + r);
#pragma unroll
        for (int et = 0; et < 4; ++et)
#pragma unroll
            for (int i = 0; i < 4; ++i) up[(size_t)(16 * et + 4 * q + i) * 64 + 16 * dt + r] = acc[et][dt][i] * dd; }
}

__device__ __forceinline__ void p2_gla_sample(Frame& F, int task) {
    const int lane = LANE_, b = task >> 2, h = task & 3, tok = NTOKP + b;
    const bf16* pr = WSP(bf16, WS_PROJ) + (size_t)tok * DINP;
    LAS float* sh = (LAS float*)(F.lds + F.wave * 16384);
    { float z = FIN(I_BGG)[h * 64 + lane];
#pragma unroll
      for (int j = 0; j < 16; ++j) z += bf2f(pr[C_LR + j]) * FIN(I_WGG)[j * 256 + h * 64 + lane];
      sh[lane] = __expf(log_sigmoid_(z) * 0.0625f); sh[64 + lane] = bf2f(pr[C_GK + h * 64 + lane]); sh[128 + lane] = bf2f(pr[C_GQ + h * 64 + lane]) * 0.125f; }
    asm volatile("s_waitcnt lgkmcnt(0)" ::: "memory");
    const float v0 = bf2f(pr[C_GV + h * 128 + lane]), v1 = bf2f(pr[C_GV + h * 128 + 64 + lane]);
    const float* s0 = FIN(I_SGLA) + (size_t)(b * 4 + h) * 64 * 128; float* s1 = FOUT + O_GLAS + (size_t)(b * 4 + h) * 64 * 128;
    float o0 = 0.f, o1 = 0.f;
#pragma unroll 4
    for (int d = 0; d < 64; ++d) { const float a = sh[d], k = sh[64 + d], qq = sh[128 + d];
        const float n0 = a * s0[d * 128 + lane] + k * v0, n1 = a * s0[d * 128 + 64 + lane] + k * v1;
        s1[d * 128 + lane] = n0; s1[d * 128 + 64 + lane] = n1; o0 += qq * n0; o1 += qq * n1; }
    const float rs = rsqrtf(wave_sum(o0 * o0 + o1 * o1) * (1.f / 128.f) + EPS);
    const float r0 = bf2f(pr[C_GR + h * 128 + lane]), r1 = bf2f(pr[C_GR + h * 128 + 64 + lane]);
    bf16* og = WSP(bf16, WS_OGLA) + (size_t)tok * 512 + h * 128;
    og[lane] = (bf16)f2bf(o0 * rs * FIN(I_GGO)[lane] * r0 * sigmoidf_(r0));
    og[64 + lane] = (bf16)f2bf(o1 * rs * FIN(I_GGO)[64 + lane] * r1 * sigmoidf_(r1));
}

__device__ __forceinline__ void p3_gla_scan(Frame& F, int task) {
    const int lane = LANE_, b = task >> 9, h = (task >> 7) & 3, e = task & 127;
    const float* up = WSP(float, WS_UP); const float* dec = WSP(float, WS_DEC); bf16* sc = WSP(bf16, WS_SC);
    float S = 0.f;
#pragma unroll 1
    for (int c0 = 0; c0 < 128; c0 += 32) {
        float uu[32], dd[32];
#pragma unroll
        for (int i = 0; i < 32; ++i) { const int bc = b * 128 + c0 + i; uu[i] = up[((size_t)(bc * 4 + h) * 128 + e) * 64 + lane]; dd[i] = dec[(size_t)(bc * 4 + h) * 64 + lane]; }
#pragma unroll
        for (int i = 0; i < 32; ++i) { const int bc = b * 128 + c0 + i; sc[((size_t)(bc * 4 + h) * 128 + e) * 64 + lane] = (bf16)f2bf(S); S = dd[i] * S + uu[i]; } }
    FOUT[O_GLAP + ((size_t)(b * 4 + h) * 64 + lane) * 128 + e] = S;
}

__device__ __forceinline__ void p4_gla_out(Frame& F, int task) {
    const int lane = LANE_, r = lane & 15, q = lane >> 4, bc = task >> 4, h = (task >> 2) & 3, tt = task & 3;
    const bf16* qtg = WSP(bf16, WS_QTG) + (size_t)bc * 64 * 256 + h * 64;
    const bf16* ktg = WSP(bf16, WS_KTG) + (size_t)bc * 64 * 256 + h * 64;
    const bf16* vtg = WSP(bf16, WS_VTG) + (size_t)(bc * 4 + h) * 128 * 64;
    const bf16* sc = WSP(bf16, WS_SC) + (size_t)(bc * 4 + h) * 128 * 64;
    const bf16* proj = WSP(bf16, WS_PROJ) + (size_t)bc * 64 * DINP;
    bf16* og = WSP(bf16, WS_OGLA) + (size_t)bc * 64 * 512 + h * 128;
    const float* ggo = FIN(I_GGO);
    {
        bf16x8 qf[2], kf[4][2], sf[8][2], vf[8][2];
#pragma unroll
        for (int ks = 0; ks < 2; ++ks) qf[ks] = ldfrag(qtg + (size_t)(16 * tt + r) * 256 + 32 * ks + 8 * q);
#pragma unroll
        for (int st = 0; st < 4; ++st)
#pragma unroll
            for (int ks = 0; ks < 2; ++ks) kf[st][ks] = ldfrag(ktg + (size_t)(16 * st + r) * 256 + 32 * ks + 8 * q);
#pragma unroll
        for (int et = 0; et < 8; ++et) { const bf16* srow = sc + (size_t)(16 * et + r) * 64 + 8 * q; sf[et][0] = ldfrag(srow); sf[et][1] = ldfrag(srow + 32);
            const bf16* vrow = vtg + (size_t)(16 * et + r) * 64 + 4 * q; vf[et][0] = ldfrag2(vrow, vrow + 16); vf[et][1] = ldfrag2(vrow + 32, vrow + 48);
        }
        f32x4 sT[4];
#pragma unroll
        for (int st = 0; st < 4; ++st) { sT[st] = (f32x4){0.f, 0.f, 0.f, 0.f};
#pragma unroll
            for (int ks = 0; ks < 2; ++ks) sT[st] = MFMA16(kf[st][ks], qf[ks], sT[st]);
#pragma unroll
            for (int i = 0; i < 4; ++i) if (st > tt || (st == tt && 4 * q + i > r)) sT[st][i] = 0.f; }
        const bf16x8 p01 = frag_pk(sT[0], sT[1]), p23 = frag_pk(sT[2], sT[3]);
        f32x4 acc[8]; float ss = 0.f;
#pragma unroll
        for (int et = 0; et < 8; ++et) { acc[et] = (f32x4){0.f, 0.f, 0.f, 0.f};
            acc[et] = MFMA16(sf[et][0], qf[0], acc[et]); acc[et] = MFMA16(sf[et][1], qf[1], acc[et]);
            acc[et] = MFMA16(vf[et][0], p01, acc[et]); acc[et] = MFMA16(vf[et][1], p23, acc[et]);
            ss += (acc[et][0] * acc[et][0] + acc[et][1] * acc[et][1]) + (acc[et][2] * acc[et][2] + acc[et][3] * acc[et][3]); }
        ss += __shfl_xor(ss, 16); ss += __shfl_xor(ss, 32);
        const float rs = rsqrtf(ss * (1.f / 128.f) + EPS);
        bf16* orow = og + (size_t)(16 * tt + r) * 512 + 4 * q;
#pragma unroll
        for (int et = 0; et < 8; ++et) { const u32x2 rw = *(const u32x2*)(proj + (size_t)(16 * tt + r) * DINP + C_GR + h * 128 + 4 * q + 16 * et); const f32x4 gg = *(const f32x4*)(ggo + 16 * et + 4 * q);
            const float r0 = bflo(rw.x), r1 = bfhi(rw.x), r2 = bflo(rw.y), r3 = bfhi(rw.y);
            u32x2 w; w.x = pk2(acc[et][0] * rs * gg[0] * r0 * sigmoidf_(r0), acc[et][1] * rs * gg[1] * r1 * sigmoidf_(r1));
            w.y = pk2(acc[et][2] * rs * gg[2] * r2 * sigmoidf_(r2), acc[et][3] * rs * gg[3] * r3 * sigmoidf_(r3));
            *(u32x2*)(orow + 16 * et) = w; }
    }
}

__device__ __forceinline__ void p3_xatt(Frame& F, int n, float mb) {
    const int lane = LANE_, r = lane & 15, q = lane >> 4, w = F.wave, tid_ = w * 64 + lane;
    const int b = n >> 7, h = (n >> 5) & 3, chunk = n & 31;
    const bf16* km = WSP(bf16, WS_KMEM) + (size_t)(b * 4 + h) * 256 * 128;
    const bf16* vm = WSP(bf16, WS_VMEMT) + (size_t)(b * 4 + h) * 128 * 256;
    LAS unsigned char* kl = F.lds; LAS unsigned char* vl = F.lds + 65536;
    __syncthreads();
    { u32x4 gk[8], gv[8];
#pragma unroll
      for (int i = 0; i < 8; ++i) { gk[i] = *(const u32x4*)(km + (size_t)(i * 512 + tid_) * 8); gv[i] = *(const u32x4*)(vm + (size_t)(i * 512 + tid_) * 8); }
#pragma unroll
      for (int i = 0; i < 8; ++i) { const int id = i * 512 + tid_;
          *(LAS u32x4*)(kl + (id >> 4) * 256 + ((((id & 15) ^ ((id >> 4) & 15))) << 4)) = gk[i];
          *(LAS u32x4*)(vl + (id >> 5) * 512 + ((((id & 31) ^ ((id >> 5) & 15))) << 4)) = gv[i]; } }
    __syncthreads();
    int kb4[4];
#pragma unroll
    for (int ks = 0; ks < 4; ++ks) kb4[ks] = r * 256 + (((4 * ks + q) ^ r) << 4);
#pragma unroll 1
    for (int tile = 0; tile < 2; ++tile) {
        const int tok0 = b * T + chunk * 256 + w * 32 + tile * 16;
        const bf16* xq = WSP(bf16, WS_XQ) + (size_t)(tok0 + r) * 512 + h * 128 + 8 * q;
        bf16x8 qf[4];
#pragma unroll
        for (int ks = 0; ks < 4; ++ks) qf[ks] = ldfrag(xq + 32 * ks);
        f32x4 o[8]; float l = 0.f;
#pragma unroll
        for (int dt = 0; dt < 8; ++dt) o[dt] = (f32x4){0.f, 0.f, 0.f, 0.f};
#pragma unroll 2
        for (int kk = 0; kk < 8; ++kk) {
            f32x4 p[2];
#pragma unroll
            for (int a = 0; a < 2; ++a) { p[a] = (f32x4){0.f, 0.f, 0.f, 0.f};
#pragma unroll
                for (int ks = 0; ks < 4; ++ks) p[a] = MFMA16(as_frag(*(LAS const u32x4*)(kl + kb4[ks] + (2 * kk + a) * 4096)), qf[ks], p[a]);
#pragma unroll
                for (int i = 0; i < 4; ++i) { p[a][i] = __builtin_amdgcn_exp2f(p[a][i] - mb); l += p[a][i]; } }
            const bf16x8 pf = frag_pk(p[0], p[1]);
            const int v0 = r * 512 + (((4 * kk + (q >> 1)) ^ r) << 4) + 8 * (q & 1), v1 = r * 512 + (((4 * kk + 2 + (q >> 1)) ^ r) << 4) + 8 * (q & 1);
#pragma unroll
            for (int dt = 0; dt < 8; ++dt) { const u32x2 x0 = *(LAS const u32x2*)(vl + v0 + dt * 8192), x1 = *(LAS const u32x2*)(vl + v1 + dt * 8192);
                u32x4 wv; wv.x = x0.x; wv.y = x0.y; wv.z = x1.x; wv.w = x1.y; o[dt] = MFMA16(as_frag(wv), pf, o[dt]); }
        }
        l += __shfl_xor(l, 16); l += __shfl_xor(l, 32);
        const float inv = 1.f / l;
        bf16* ox = WSP(bf16, WS_OX) + (size_t)(tok0 + r) * 512 + h * 128 + 4 * q;
#pragma unroll
        for (int dt = 0; dt < 8; ++dt) { u32x2 wv; wv.x = pk2(o[dt][0] * inv, o[dt][1] * inv); wv.y = pk2(o[dt][2] * inv, o[dt][3] * inv); *(u32x2*)(ox + 16 * dt) = wv; }
    }
}
__device__ __forceinline__ void p3_xatt_sample(Frame& F, int task) {
    const int lane = LANE_, w = F.wave, tid_ = w * 64 + lane, b = task >> 2, h = task & 3, tok = NTOKP + b;
    LAS float* qs = (LAS float*)F.lds; LAS float* sc = qs + 128; LAS float* part = qs + 384;
    const float* cm = FIN(I_CMEM) + (size_t)b * 256 * 1024 + h * 128;
    __syncthreads();
    if (tid_ < 128) qs[tid_] = bf2f(WSP(bf16, WS_XQ)[(size_t)tok * 512 + h * 128 + tid_]);
    __syncthreads();
    {
        const int l8 = lane & 7, kq = lane >> 3;
#pragma unroll
        for (int ps = 0; ps < 4; ++ps) { const int key = 32 * w + 8 * ps + kq; const float* kr = cm + (size_t)key * 1024; float s = 0.f;
#pragma unroll
            for (int j = 0; j < 4; ++j) { const int d = (j * 8 + l8) * 4; const f32x4 kv = *(const f32x4*)(kr + d); const f32x4 qv = *(LAS const f32x4*)(qs + d);
                s += (qv[0] * kv[0] + qv[1] * kv[1]) + (qv[2] * kv[2] + qv[3] * kv[3]); }
            s += __shfl_xor(s, 1); s += __shfl_xor(s, 2); s += __shfl_xor(s, 4);
            if (l8 == 0) sc[key] = s; }
    }
    __syncthreads();
    if (w == 0) { float s[4]; float m = -INFINITY;
#pragma unroll
        for (int k = 0; k < 4; ++k) { s[k] = sc[lane + 64 * k]; m = fmaxf(m, s[k]); }
        m = wave_max(m); float l = 0.f;
#pragma unroll
        for (int k = 0; k < 4; ++k) { s[k] = __builtin_amdgcn_exp2f(s[k] - m); l += s[k]; }
        l = wave_sum(l); const float inv = 1.f / l;
#pragma unroll
        for (int k = 0; k < 4; ++k) sc[lane + 64 * k] = s[k] * inv; }
    __syncthreads();
    { float o0 = 0.f, o1 = 0.f; const float* vv = cm + 512 + (size_t)(32 * w) * 1024;
#pragma unroll 8
      for (int mm = 0; mm < 32; ++mm) { const float p = sc[32 * w + mm]; o0 += p * vv[(size_t)mm * 1024 + lane]; o1 += p * vv[(size_t)mm * 1024 + 64 + lane]; }
      part[w * 128 + lane] = o0; part[w * 128 + 64 + lane] = o1; }
    __syncthreads();
    if (tid_ < 128) { float o = 0.f;
#pragma unroll
        for (int w2 = 0; w2 < 8; ++w2) o += part[w2 * 128 + tid_];
        WSP(bf16, WS_OX)[(size_t)tok * 512 + h * 128 + tid_] = (bf16)f2bf(o); }
}

constexpr int NL_Q = 0;
constexpr int NL_U = 16384;
constexpr int NL_OS = 81920;
constexpr int NL_TB = 16384;
constexpr int NL_SEL = 147456;
constexpr int NL_BT = 147968;
constexpr int NL_LINV = 152096;
constexpr int NL_END = 152608;
static_assert(NL_END <= LDS_BYTES, "NSA LDS map");

__device__ __forceinline__ void nsa_tables(Frame& F) {
    LAS float* bt = (LAS float*)(F.lds + NL_BT);
    for (int i = TID_; i < 129 * 8; i += NTHR) bt[i] = FIN(I_RB)[t5_bucket(i >> 3) * 8 + (i & 7)] * LOG2E;
    __syncthreads();
}
__device__ __forceinline__ float nsa_bound(Frame& F) {
    const float gq = absmax_arr(FIN(I_GNQ), 64, LANE_), gk = absmax_arr(FIN(I_GNK), 192, LANE_), bm = absmax_arr(FIN(I_RB), 256, LANE_);
    return (8.0f * gq * gk * 1.02f + bm) * LOG2E;
}
__device__ __forceinline__ unsigned fkey(float x) { const unsigned u = __float_as_uint(x); return (u & 0x80000000u) ? ~u : (u | 0x80000000u); }

__device__ __forceinline__ int tile_off16(int row, int c16) { return row * 128 + ((c16 ^ (row & 7)) << 4); }
struct TileAddr { int kb[2]; int vb[2][2]; };
__device__ __forceinline__ TileAddr tile_addr(int r, int q) { TileAddr a;
    for (int ks = 0; ks < 2; ++ks) a.kb[ks] = r * 128 + (((4 * ks + q) ^ (r & 7)) << 4);
    for (int s = 0; s < 2; ++s) for (int pc = 0; pc < 2; ++pc) a.vb[s][pc] = r * 128 + (((4 * s + 2 * pc + (q >> 1)) ^ (r & 7)) << 4) + 8 * (q & 1);
    return a; }
__device__ __forceinline__ bf16x8 tile_kfrag(LAS const unsigned char* kb, const TileAddr& ta, int kt, int ks) { return as_frag(*(LAS const u32x4*)(kb + ta.kb[ks] + kt * 2048)); }
__device__ __forceinline__ bf16x8 tile_vfrag(LAS const unsigned char* vb, const TileAddr& ta, int dt, int s) {
    const u32x2 a = *(LAS const u32x2*)(vb + ta.vb[s][0] + dt * 2048), b = *(LAS const u32x2*)(vb + ta.vb[s][1] + dt * 2048);
    u32x4 w; w.x = a.x; w.y = a.y; w.z = b.x; w.w = b.y; return as_frag(w); }

#define OPAQUE_V(x) asm volatile("" : "+v"(x))
__device__ __forceinline__ void p3_nsa_prompt(Frame& F, int n, float mb) {
    int lane0 = LANE_; OPAQUE_V(lane0);
    const int lane = lane0, r = lane & 15, q = lane >> 4, w = F.wave;
    int combo, ti;
    if (F.G == 256) { const int xcd = F.bid & 7, u = (F.bid >> 3) * 2 + (xcd & 1), rnd = n >> 8; combo = xcd >> 1; ti = rnd == 0 ? u : rnd == 1 ? 127 - u : rnd == 2 ? 128 + u : 255 - u; }
    else { const int idx = n & 255; combo = n >> 8; ti = (combo & 1) ? 255 - idx : idx; }
    const int b = combo >> 1, kv = combo & 1, t0 = 32 * ti, bk = b * 2 + kv;
    LAS bf16* Qs = (LAS bf16*)(F.lds + NL_Q); LAS float* U = (LAS float*)(F.lds + NL_U) + w * 2048; LAS unsigned* selm = (LAS unsigned*)(F.lds + NL_SEL);
    LAS const float* bt = (LAS const float*)(F.lds + NL_BT); LAS float* linv = (LAS float*)(F.lds + NL_LINV) + w * 16;
    LAS unsigned char* stA = F.lds + NL_OS;
    LAS unsigned char* stC = F.lds + NL_U;
    LAS unsigned char* stB = F.lds + NL_TB + w * 16384;
    const int tid_ = w * 64 + lane, srow = tid_ >> 3, sc16 = tid_ & 7, soff = tile_off16(srow, sc16);
    const TileAddr ta = tile_addr(r, q);
    __syncthreads();
    { const int tk = TID_ >> 4, ch = TID_ & 15; const bf16* src = WSP(bf16, WS_QN) + (size_t)(b * T + t0 + tk) * 512 + kv * 256 + ch * 16;
      const u32x4 a0 = *(const u32x4*)src, a1 = *(const u32x4*)(src + 8);
      *(LAS u32x4*)(Qs + tk * 256 + ch * 16) = a0; *(LAS u32x4*)(Qs + tk * 256 + ch * 16 + 8) = a1;
      if (TID_ < 128) selm[TID_] = 0u; }
    __syncthreads();
    const int tw = t0 + 4 * w, tr = tw + (r >> 2), h = kv * 4 + (r & 3);
    bf16x8 qf[2];
#pragma unroll
    for (int ks = 0; ks < 2; ++ks) qf[ks] = as_frag(*(LAS const u32x4*)(Qs + (16 * w + r) * 64 + 32 * ks + 8 * q));
    int ncvb = (t0 + 31 - 31) / 16 + 1; ncvb = ncvb < 511 ? ncvb : 511;
    const int nst = (ncvb + 63) >> 6;
    const int tlast = tw + 3; int ncv = tlast >= 31 ? (tlast - 31) / 16 + 1 : 0; ncv = ncv < 511 ? ncv : 511;
    const int nstw = (ncv + 63) >> 6;
    f32x4 oc[4]; float lc = 0.f, carry = 0.f;
#pragma unroll
    for (int dt = 0; dt < 4; ++dt) oc[dt] = (f32x4){0.f, 0.f, 0.f, 0.f};
    {
        const bf16* kc = WSP(bf16, WS_KCMP) + (size_t)bk * 512 * 64 + srow * 64 + sc16 * 8; const bf16* vc = WSP(bf16, WS_VCMPT) + (size_t)bk * 64 * 512 + srow * 512 + sc16 * 8;
        const int nst2 = (nst + 1) >> 1;
        u32x4 rk0 = *(const u32x4*)kc, rv0 = *(const u32x4*)vc, rk1 = *(const u32x4*)(kc + 4096), rv1 = *(const u32x4*)(vc + 64);
#pragma unroll 1
        for (int s2 = 0; s2 < nst2; ++s2) {
            LAS unsigned char* bb = stA + (s2 & 1) * 32768;
            *(LAS u32x4*)(bb + soff) = rk0; *(LAS u32x4*)(bb + 8192 + soff) = rv0; *(LAS u32x4*)(bb + 16384 + soff) = rk1; *(LAS u32x4*)(bb + 24576 + soff) = rv1;
            __syncthreads();
            if (s2 + 1 < nst2) { rk0 = *(const u32x4*)(kc + (size_t)(2 * s2 + 2) * 4096); rv0 = *(const u32x4*)(vc + (2 * s2 + 2) * 64);
                                 rk1 = *(const u32x4*)(kc + (size_t)(2 * s2 + 3) * 4096); rv1 = *(const u32x4*)(vc + (2 * s2 + 3) * 64); }
#pragma unroll
            for (int sub = 0; sub < 2; ++sub) { const int st = 2 * s2 + sub; LAS unsigned char* kb = bb + sub * 16384; LAS unsigned char* vb = kb + 8192;
            if (st < nstw) {
                f32x4 p[4];
#pragma unroll
                for (int kt = 0; kt < 4; ++kt) { const int tile = 4 * st + kt; p[kt] = (f32x4){0.f, 0.f, 0.f, 0.f};
                    p[kt] = MFMA16(tile_kfrag(kb, ta, kt, 0), qf[0], p[kt]); p[kt] = MFMA16(tile_kfrag(kb, ta, kt, 1), qf[1], p[kt]);
                    float G = 0.f;
#pragma unroll
                    for (int i = 0; i < 4; ++i) { const int c = 16 * tile + 4 * q + i, rel = tr - (16 * c + 31); const bool ok = rel >= 0 && c < 511;
                        const int rc = rel < 0 ? 0 : (rel > 128 ? 128 : rel);
                        const float xv = p[kt][i] + bt[rc * 8 + h] - mb;
                        const float e = __builtin_amdgcn_exp2f(ok ? xv : -1e30f); p[kt][i] = e; G += e; }
                    const float send = (q == 3) ? carry : p[kt][3]; const float prev = __shfl(send, (lane + 48) & 63); carry = p[kt][3];
                    U[r * 128 + 4 * tile + q] = G + prev; lc += G; }
                const bf16x8 pf0 = frag_pk(p[0], p[1]), pf1 = frag_pk(p[2], p[3]);
#pragma unroll
                for (int dt = 0; dt < 4; ++dt) { oc[dt] = MFMA16(tile_vfrag(vb, ta, dt, 0), pf0, oc[dt]); oc[dt] = MFMA16(tile_vfrag(vb, ta, dt, 1), pf1, oc[dt]); }
            } }
        }
    }
    lc += __shfl_xor(lc, 16); lc += __shfl_xor(lc, 32);
    const float lcinv = lc > 0.f ? 1.f / lc : 0.f;
    if (q == 0) linv[r] = lcinv;
    asm volatile("s_waitcnt lgkmcnt(0)" ::: "memory");
    {
        const int tk = lane >> 4, jr = lane & 15, t = tw + tk, tblk = t >> 6, jlim = 16 * nstw;
        const float li0 = linv[4 * tk], li1 = linv[4 * tk + 1], li2 = linv[4 * tk + 2], li3 = linv[4 * tk + 3];
        unsigned key[8];
#pragma unroll
        for (int m = 0; m < 8; ++m) { const int j = jr + 16 * m; float v = 0.f;
            if (j < jlim) v = U[(4 * tk) * 128 + j] * li0 + U[(4 * tk + 1) * 128 + j] * li1 + U[(4 * tk + 2) * 128 + j] * li2 + U[(4 * tk + 3) * 128 + j] * li3;
            const bool forced = (j == 0) || (j == tblk) || (j == tblk - 1);
            const float sc = (j <= tblk) ? v + (forced ? 1e4f : 0.f) : -1e30f;
            key[m] = fkey(sc); }
        unsigned pre = 0u;
#pragma unroll 1
        for (int bit = 31; bit >= 0; --bit) { const unsigned cand = pre | (1u << bit); int cnt = 0;
#pragma unroll
            for (int m = 0; m < 8; ++m) cnt += key[m] >= cand ? 1 : 0;
            cnt += __shfl_xor(cnt, 1); cnt += __shfl_xor(cnt, 2); cnt += __shfl_xor(cnt, 4); cnt += __shfl_xor(cnt, 8);
            if (cnt >= 16) pre = cand; }
        int ngt = 0;
#pragma unroll
        for (int m = 0; m < 8; ++m) ngt += key[m] > pre ? 1 : 0;
        ngt += __shfl_xor(ngt, 1); ngt += __shfl_xor(ngt, 2); ngt += __shfl_xor(ngt, 4); ngt += __shfl_xor(ngt, 8);
        const int need = 16 - ngt; int run = 0; const unsigned kinv = fkey(-1e30f);
#pragma unroll
        for (int m = 0; m < 8; ++m) { const bool tie = key[m] == pre; const unsigned long long bal = __ballot(tie);
            const unsigned grp = (unsigned)(bal >> (16 * tk)) & 0xffffu; const int rank = __popc(grp & ((1u << jr) - 1u));
            const bool sel = (key[m] > pre || (tie && run + rank < need)) && key[m] > kinv;
            run += __popc(grp);
            if (sel) atomicOr((unsigned*)(selm + jr + 16 * m), 1u << (4 * w + tk)); }
    }
    __syncthreads();
    f32x4 ow[4]; float lw = 0.f;
#pragma unroll
    for (int dt = 0; dt < 4; ++dt) ow[dt] = (f32x4){0.f, 0.f, 0.f, 0.f};
    {
        int lc_ = lane0; OPAQUE_V(lc_); const int lane = lc_, r = lane & 15, q = lane >> 4, tr = tw + (r >> 2), h = kv * 4 + (r & 3); const TileAddr ta = tile_addr(r, q);
        const int tid_ = w * 64 + lane, srow = tid_ >> 3, sc16 = tid_ & 7, soff = tile_off16(srow, sc16);
        const int jlob = (t0 - 511 > 0 ? t0 - 511 : 0) >> 6, jhib = (t0 + 31) >> 6, nstc = jhib - jlob + 1;
        const int jlo = (tw - 511 > 0 ? tw - 511 : 0) >> 6, jhi = (tw + 3) >> 6;
        const bf16* kwin = WSP(bf16, WS_KWIN) + (size_t)bk * T * 64 + srow * 64 + sc16 * 8; const bf16* vwin = WSP(bf16, WS_VWINT) + (size_t)bk * 128 * 4096 + srow * 64 + sc16 * 8;
        const int nstc2 = (nstc + 1) >> 1;
        u32x4 rk0 = *(const u32x4*)(kwin + (size_t)jlob * 4096), rv0 = *(const u32x4*)(vwin + (size_t)jlob * 4096), rk1 = *(const u32x4*)(kwin + (size_t)(jlob + 1) * 4096), rv1 = *(const u32x4*)(vwin + (size_t)(jlob + 1) * 4096);
#pragma unroll 1
        for (int s2 = 0; s2 < nstc2; ++s2) { const int j0 = jlob + 2 * s2;
            LAS unsigned char* bb = stC + (s2 & 1) * 32768;
            *(LAS u32x4*)(bb + soff) = rk0; *(LAS u32x4*)(bb + 8192 + soff) = rv0; *(LAS u32x4*)(bb + 16384 + soff) = rk1; *(LAS u32x4*)(bb + 24576 + soff) = rv1;
            __syncthreads();
            if (s2 + 1 < nstc2) { rk0 = *(const u32x4*)(kwin + (size_t)(j0 + 2) * 4096); rv0 = *(const u32x4*)(vwin + (size_t)(j0 + 2) * 4096);
                                  rk1 = *(const u32x4*)(kwin + (size_t)(j0 + 3) * 4096); rv1 = *(const u32x4*)(vwin + (size_t)(j0 + 3) * 4096); }
#pragma unroll
            for (int sub = 0; sub < 2; ++sub) { const int j = j0 + sub; LAS unsigned char* kb = bb + sub * 16384; LAS unsigned char* vb = kb + 8192;
            if (j >= jlo && j <= jhi) {
                f32x4 p[4];
#pragma unroll
                for (int kt = 0; kt < 4; ++kt) { p[kt] = (f32x4){0.f, 0.f, 0.f, 0.f};
                    p[kt] = MFMA16(tile_kfrag(kb, ta, kt, 0), qf[0], p[kt]); p[kt] = MFMA16(tile_kfrag(kb, ta, kt, 1), qf[1], p[kt]);
#pragma unroll
                    for (int i = 0; i < 4; ++i) { const int rel = tr - (64 * j + 16 * kt + 4 * q + i); const bool ok = rel >= 0 && rel < 512;
                        const int rc = rel < 0 ? 0 : (rel > 128 ? 128 : rel);
                        const float xv = p[kt][i] + bt[rc * 8 + h] - mb;
                        const float e = __builtin_amdgcn_exp2f(ok ? xv : -1e30f); p[kt][i] = e; lw += e; } }
                const bf16x8 pf0 = frag_pk(p[0], p[1]), pf1 = frag_pk(p[2], p[3]);
#pragma unroll
                for (int dt = 0; dt < 4; ++dt) { ow[dt] = MFMA16(tile_vfrag(vb, ta, dt, 0), pf0, ow[dt]); ow[dt] = MFMA16(tile_vfrag(vb, ta, dt, 1), pf1, ow[dt]); }
            } }
        }
        lw += __shfl_xor(lw, 16); lw += __shfl_xor(lw, 32);
    }
    f32x4 ocw[4];
    { const float* gt = WSP(float, WS_GATES) + (size_t)(b * T + tr) * 24 + h * 3;
      const float g0 = gt[0] * lcinv, g2 = gt[2] * (lw > 0.f ? 1.f / lw : 0.f);
#pragma unroll
      for (int dt = 0; dt < 4; ++dt) ocw[dt] = oc[dt] * g0 + ow[dt] * g2; }
    __syncthreads();
    f32x4 osf[4]; float lsf = 0.f;
    {
        int lb_ = lane0; OPAQUE_V(lb_); const int lane = lb_, r = lane & 15, q = lane >> 4, h = kv * 4 + (r & 3); const TileAddr ta = tile_addr(r, q);
        const int half = w >> 2, jw = w & 3;
        f32x4 osa[4][4]; float lsa[4];
#pragma unroll
        for (int x = 0; x < 4; ++x) { lsa[x] = 0.f;
#pragma unroll
            for (int dt = 0; dt < 4; ++dt) osa[x][dt] = (f32x4){0.f, 0.f, 0.f, 0.f}; }
        const int jmax = (t0 + 31) >> 6;
        const int brow = lane >> 3, bc16 = lane & 7, boff = brow * 64 + bc16 * 8, bsoff = tile_off16(brow, bc16); const float bfar = bt[128 * 8 + h];
        const bf16* ksel = WSP(bf16, WS_KSEL) + (size_t)bk * T * 64 + boff; const bf16* vsel = WSP(bf16, WS_VSELT) + (size_t)bk * 128 * 4096 + boff;
        LAS const bf16* Qh = Qs + (64 * half + r) * 64 + 8 * q;
        u32x4 gk[8], gv[8];
        if (jw <= jmax) {
#pragma unroll
            for (int i = 0; i < 8; ++i) { gk[i] = *(const u32x4*)(ksel + (size_t)jw * 4096 + i * 512); gv[i] = *(const u32x4*)(vsel + (size_t)jw * 4096 + i * 512); } }
#pragma unroll 1
        for (int j = jw; j <= jmax; j += 4) {
            const unsigned msel = ((unsigned)__builtin_amdgcn_readfirstlane((int)selm[j]) >> (16 * half)) & 0xffffu;
            const bool act = msel != 0u;
            asm volatile("s_waitcnt lgkmcnt(0)" ::: "memory");
#pragma unroll
            for (int i = 0; i < 8; ++i) { *(LAS u32x4*)(stB + bsoff + i * 1024) = gk[i]; *(LAS u32x4*)(stB + 8192 + bsoff + i * 1024) = gv[i]; }
            if (j + 4 <= jmax) {
#pragma unroll
                for (int i = 0; i < 8; ++i) { gk[i] = *(const u32x4*)(ksel + (size_t)(j + 4) * 4096 + i * 512); gv[i] = *(const u32x4*)(vsel + (size_t)(j + 4) * 4096 + i * 512); } }
            if (!act) continue;
            asm volatile("s_waitcnt lgkmcnt(0)" ::: "memory");
            const bool far = (t0 - (64 * j + 63)) >= 128;
#pragma unroll
            for (int x = 0; x < 4; ++x) {
                const unsigned nib = (msel >> (4 * x)) & 15u;
                if (nib) {
                    asm volatile("" ::: "memory");
                    const bool tokv = (nib >> (r >> 2)) & 1u; const int t = t0 + 16 * half + 4 * x + (r >> 2);
                    const bf16x8 qs0 = as_frag(*(LAS const u32x4*)(Qh + x * 1024)), qs1 = as_frag(*(LAS const u32x4*)(Qh + x * 1024 + 32));
                    f32x4 p[4]; float ls = 0.f;
#pragma unroll
                    for (int kt = 0; kt < 4; ++kt) { p[kt] = (f32x4){0.f, 0.f, 0.f, 0.f};
                        p[kt] = MFMA16(tile_kfrag(stB, ta, kt, 0), qs0, p[kt]); p[kt] = MFMA16(tile_kfrag(stB, ta, kt, 1), qs1, p[kt]); }
                    if (far) {
                        const float cb_ = bfar - mb;
#pragma unroll
                        for (int kt = 0; kt < 4; ++kt)
#pragma unroll
                            for (int i = 0; i < 4; ++i) { const float e = __builtin_amdgcn_exp2f(tokv ? p[kt][i] + cb_ : -1e30f); p[kt][i] = e; ls += e; }
                    } else {
#pragma unroll
                        for (int kt = 0; kt < 4; ++kt)
#pragma unroll
                            for (int i = 0; i < 4; ++i) { const int rel = t - (64 * j + 16 * kt + 4 * q + i); const bool ok = tokv && rel >= 0;
                                const int rc = rel < 0 ? 0 : (rel > 128 ? 128 : rel);
                                const float xv = p[kt][i] + bt[rc * 8 + h] - mb;
                                const float e = __builtin_amdgcn_exp2f(ok ? xv : -1e30f); p[kt][i] = e; ls += e; }
                    }
                    lsa[x] += ls;
                    const bf16x8 pf0 = frag_pk(p[0], p[1]), pf1 = frag_pk(p[2], p[3]);
#pragma unroll
                    for (int dt = 0; dt < 4; ++dt) { osa[x][dt] = MFMA16(tile_vfrag(stB + 8192, ta, dt, 0), pf0, osa[x][dt]); osa[x][dt] = MFMA16(tile_vfrag(stB + 8192, ta, dt, 1), pf1, osa[x][dt]); }
                }
            }
        }
#pragma unroll
        for (int dt = 0; dt < 4; ++dt) osf[dt] = (f32x4){0.f, 0.f, 0.f, 0.f};
#pragma unroll
        for (int x = 0; x <= 4; ++x) {
            __syncthreads();
            if (x > 0 && jw == x - 1) {
#pragma unroll
                for (int w2 = 0; w2 < 4; ++w2) { LAS const float* rp = (LAS const float*)(F.lds + NL_U + ((x - 1) & 1) * 32768) + (4 * half + w2) * 1024 + lane * 16;
#pragma unroll
                    for (int dt = 0; dt < 4; ++dt) osf[dt] += *(LAS const f32x4*)(rp + 4 * dt);
                    lsf += ((LAS const float*)(F.lds + NL_Q + ((x - 1) & 1) * 2048))[(4 * half + w2) * 64 + lane]; } }
            if (x < 4) { LAS float* Rb = (LAS float*)(F.lds + NL_U + (x & 1) * 32768); LAS float* RLb = (LAS float*)(F.lds + NL_Q + (x & 1) * 2048);
#pragma unroll
                for (int dt = 0; dt < 4; ++dt) *(LAS f32x4*)(Rb + w * 1024 + lane * 16 + 4 * dt) = osa[x][dt];
                RLb[w * 64 + lane] = lsa[x]; }
        }
        lsf += __shfl_xor(lsf, 16); lsf += __shfl_xor(lsf, 32);
    }
    {
        int lf_ = lane0; OPAQUE_V(lf_); const int r = lf_ & 15, q = lf_ >> 4, tr = tw + (r >> 2), h = kv * 4 + (r & 3);
        const int tok = b * T + tr; const float g1 = WSP(float, WS_GATES)[(size_t)tok * 24 + h * 3 + 1] * (lsf > 0.f ? 1.f / lsf : 0.f);
        bf16* on = WSP(bf16, WS_ONSA) + (size_t)tok * 512 + h * 64 + 4 * q;
#pragma unroll
        for (int dt = 0; dt < 4; ++dt) { const f32x4 o = ocw[dt] + osf[dt] * g1;
            u32x2 wv; wv.x = pk2(o[0], o[1]); wv.y = pk2(o[2], o[3]); *(u32x2*)(on + 16 * dt) = wv; }
    }
}

constexpr int SL_Q = 0;
constexpr int SL_S = 1024;
constexpr int SL_O = 17408;
constexpr int SL_PART = 20480;
constexpr int SL_IMP = 28672;
constexpr int SL_IDX = 29200;
constexpr int SL_END = 29328;
static_assert(SL_END <= NL_SEL, "sample NSA LDS map must not overlap the tables");
template <class KP, class VP, class RELF>
__device__ __forceinline__ void sample_segment(Frame& F, int nk, int kv, KP kptr, VP vptr, RELF relf, LAS float* odst) {
    LAS const float* qs = (LAS const float*)(F.lds + SL_Q); LAS float* sc = (LAS float*)(F.lds + SL_S); LAS float* part = (LAS float*)(F.lds + SL_PART);
    LAS const float* bt = (LAS const float*)(F.lds + NL_BT);
    const int nkp = (nk + 63) & ~63;
    for (int n = TID_; n < nkp; n += NTHR) {
        float s0 = -INFINITY, s1 = -INFINITY, s2 = -INFINITY, s3 = -INFINITY;
        const float* kr = n < nk ? kptr(n) : nullptr;
        if (kr) { s0 = s1 = s2 = s3 = 0.f;
            for (int d = 0; d < 64; d += 4) { const f32x4 k4 = *(const f32x4*)(kr + d);
                const f32x4 q0 = *(LAS const f32x4*)(qs + d), q1 = *(LAS const f32x4*)(qs + 64 + d), q2 = *(LAS const f32x4*)(qs + 128 + d), q3 = *(LAS const f32x4*)(qs + 192 + d);
                s0 += (q0[0] * k4[0] + q0[1] * k4[1]) + (q0[2] * k4[2] + q0[3] * k4[3]); s1 += (q1[0] * k4[0] + q1[1] * k4[1]) + (q1[2] * k4[2] + q1[3] * k4[3]);
                s2 += (q2[0] * k4[0] + q2[1] * k4[1]) + (q2[2] * k4[2] + q2[3] * k4[3]); s3 += (q3[0] * k4[0] + q3[1] * k4[1]) + (q3[2] * k4[2] + q3[3] * k4[3]); }
            int rel = relf(n); rel = rel > 128 ? 128 : rel; const int bb = rel * 8 + kv * 4;
            s0 += bt[bb]; s1 += bt[bb + 1]; s2 += bt[bb + 2]; s3 += bt[bb + 3]; }
        sc[n] = s0; sc[1024 + n] = s1; sc[2048 + n] = s2; sc[3072 + n] = s3;
    }
    __syncthreads();
    if (F.wave < 4) { LAS float* row = sc + F.wave * 1024; float m = -INFINITY;
        for (int n = LANE_; n < nkp; n += 64) m = fmaxf(m, row[n]);
        m = wave_max(m); float l = 0.f;
        for (int n = LANE_; n < nkp; n += 64) { const float e = __builtin_amdgcn_exp2f(row[n] - m); row[n] = e; l += e; }
        l = wave_sum(l); const float inv = 1.f / l;
        for (int n = LANE_; n < nkp; n += 64) row[n] *= inv; }
    __syncthreads();
    {
        const int d = LANE_; float o0 = 0.f, o1 = 0.f, o2 = 0.f, o3 = 0.f;
        for (int n0 = F.wave; n0 < nkp; n0 += 128) {
            float v[16];
#pragma unroll
            for (int u = 0; u < 16; ++u) { const int n = n0 + 8 * u; v[u] = n < nk ? vptr(n)[d] : 0.f; }
#pragma unroll
            for (int u = 0; u < 16; ++u) { const int n = n0 + 8 * u; if (n < nkp) { o0 += sc[n] * v[u]; o1 += sc[1024 + n] * v[u]; o2 += sc[2048 + n] * v[u]; o3 += sc[3072 + n] * v[u]; } }
        }
        part[(F.wave * 4 + 0) * 64 + d] = o0; part[(F.wave * 4 + 1) * 64 + d] = o1; part[(F.wave * 4 + 2) * 64 + d] = o2; part[(F.wave * 4 + 3) * 64 + d] = o3; }
    __syncthreads();
    if (TID_ < 256) { float a = 0.f;
#pragma unroll
        for (int w8 = 0; w8 < 8; ++w8) a += part[w8 * 256 + TID_];
        odst[TID_] = a; }
    __syncthreads();
}
__device__ __forceinline__ void p3_nsa_sample(Frame& F, int task, int part) {
    const int b = task >> 1, kv = task & 1, tok = NTOKP + b, bk = b * 2 + kv;
    LAS float* qs = (LAS float*)(F.lds + SL_Q); LAS float* sc = (LAS float*)(F.lds + SL_S); LAS float* ob = (LAS float*)(F.lds + SL_O);
    LAS float* imp = (LAS float*)(F.lds + SL_IMP); LAS int* sidx = (LAS int*)(F.lds + SL_IDX);
    __syncthreads();
    if (TID_ < 256) qs[TID_] = bf2f(WSP(bf16, WS_QN)[(size_t)tok * 512 + kv * 256 + TID_]);
    __syncthreads();
    const float* kcs = WSP(float, WS_KCMPS) + (size_t)bk * 512 * 64; const float* vcs = WSP(float, WS_VCMPS) + (size_t)bk * 512 * 64;
    const float* nkv = WSP(float, WS_NEWKV) + (size_t)b * 4 * 2 * 64 + kv * 64;
    const float* ckv = FIN(I_CKV); const int* pt = (const int*)FIN(I_PT) + b * 64; const float* cwin = FIN(I_CWIN) + (size_t)b * 512 * 256;
    if (part == 0) {
    sample_segment(F, 511, kv, [&](int n) { return kcs + (size_t)n * 64; }, [&](int n) { return vcs + (size_t)n * 64; }, [&](int n) { return T - (16 * n + 31); }, ob);
    if (TID_ < 129) { const int j = TID_; float v = 0.f;
        for (int c = 4 * j - 1; c <= 4 * j + 3; ++c) if (c >= 0 && c < 511) v += (sc[c] + sc[1024 + c]) + (sc[2048 + c] + sc[3072 + c]);
        imp[j] = v; }
    __syncthreads();
    if (F.wave == 0) { const int lane = LANE_; unsigned key[3];
#pragma unroll
        for (int m = 0; m < 3; ++m) { const int j = lane + 64 * m; float s = -1e30f;
            if (j < 129) { const bool forced = (j == 0) || (j == 128) || (j == 127); s = imp[j] + (forced ? 1e4f : 0.f); }
            key[m] = (j < 129) ? fkey(s) : 0u; }
        unsigned pre = 0u;
#pragma unroll 1
        for (int bit = 31; bit >= 0; --bit) { const unsigned cand = pre | (1u << bit); int cnt = 0;
#pragma unroll
            for (int m = 0; m < 3; ++m) cnt += __popcll(__ballot(key[m] >= cand));
            if (cnt >= 16) pre = cand; }
        int ngt = 0;
#pragma unroll
        for (int m = 0; m < 3; ++m) ngt += __popcll(__ballot(key[m] > pre));
        int need = 16 - ngt, cnt = 0;
#pragma unroll
        for (int m = 0; m < 3; ++m) { const bool gt = key[m] > pre, tie = key[m] == pre; const unsigned long long tb = __ballot(tie);
            const int trank = __popcll(tb & ((1ull << lane) - 1ull)); const bool sel = gt || (tie && trank < need);
            need -= __popcll(tb); need = need < 0 ? 0 : need;
            const unsigned long long sb = __ballot(sel); const int pos = cnt + __popcll(sb & ((1ull << lane) - 1ull));
            if (sel && pos < 16) sidx[pos] = lane + 64 * m; cnt += __popcll(sb); } }
    __syncthreads();
    if (TID_ < 16) { const int blk = sidx[TID_]; sidx[16 + TID_] = blk < 128 ? pt[blk >> 1] : 0; }
    __syncthreads();
    sample_segment(F, 1024, kv,
        [&](int n) -> const float* { const int pos = 64 * sidx[n >> 6] + (n & 63); if (pos > T) return nullptr; if (pos == T) return nkv;
                                     return ckv + (((size_t)sidx[16 + (n >> 6)] * 128 + (pos & 127)) * 4 + 2) * 128 + kv * 64; },
        [&](int n) -> const float* { const int pos = 64 * sidx[n >> 6] + (n & 63); if (pos >= T) return nkv + 128;
                                     return ckv + (((size_t)sidx[16 + (n >> 6)] * 128 + (pos & 127)) * 4 + 3) * 128 + kv * 64; },
        [&](int n) { return T - (64 * sidx[n >> 6] + (n & 63)); }, ob + 256);
    } else {
    sample_segment(F, 512, kv,
        [&](int n) -> const float* { return n < 511 ? cwin + (size_t)(n + 1) * 256 + kv * 64 : nkv + 256; },
        [&](int n) -> const float* { return n < 511 ? cwin + (size_t)(n + 1) * 256 + 128 + kv * 64 : nkv + 384; },
        [&](int n) { return 511 - n; }, ob + 512);
    }
    if (TID_ < 256) { const int g = TID_ >> 6, d = TID_ & 63, h = kv * 4 + g; const float* gt = WSP(float, WS_GATES) + (size_t)tok * 24 + h * 3;
        const float v = part == 0 ? gt[0] * ob[TID_] + gt[1] * ob[256 + TID_] : gt[2] * ob[512 + TID_];
        atomicAdd(WSP(float, WS_ONS) + (size_t)b * 512 + h * 64 + d, v); }
}

template <bool A_F32>
__device__ __forceinline__ void skinny_mma(f32x4 (&acc)[2], float (&ssq)[2], const void* A, int lda, const bf16* Bt, int K, int n0, int k0, int nks, int r, int q) {
    acc[0] = (f32x4){0.f, 0.f, 0.f, 0.f}; acc[1] = acc[0]; ssq[0] = 0.f; ssq[1] = 0.f;
#pragma unroll 4
    for (int ks = 0; ks < nks; ++ks) { const int k = k0 + 32 * ks + 8 * q;
        const bf16x8 a = ldfrag(Bt + (size_t)(n0 + r) * K + k);
#pragma unroll
        for (int mt = 0; mt < 2; ++mt) { bf16x8 bfr;
            if (A_F32) { const float* p = (const float*)A + (size_t)(16 * mt + r) * lda + k; const f32x4 x0 = *(const f32x4*)p, x1 = *(const f32x4*)(p + 4);
                ssq[mt] += (x0[0] * x0[0] + x0[1] * x0[1]) + (x0[2] * x0[2] + x0[3] * x0[3]) + (x1[0] * x1[0] + x1[1] * x1[1]) + (x1[2] * x1[2] + x1[3] * x1[3]); bfr = frag_pk(x0, x1); }
            else bfr = ldfrag((const bf16*)A + (size_t)(16 * mt + r) * lda + k);
            acc[mt] = MFMA16(a, bfr, acc[mt]); } }
}
__device__ __forceinline__ void s5_merge(Frame& F, int t) {
    const int lane = LANE_, r = lane & 15, q = lane >> 4, br = t >> 7, nt = (t >> 1) & 63, kc = t & 1;
    const bf16* A = (br == 0 ? WSP(bf16, WS_ONSA) : br == 1 ? WSP(bf16, WS_OGLA) : WSP(bf16, WS_OX)) + (size_t)NTOKP * 512;
    const bf16* Bt = br == 0 ? WSP(bf16, WS_WTNSA) : br == 1 ? WSP(bf16, WS_WTGLA) : WSP(bf16, WS_WTX);
    f32x4 acc[2]; float ssq[2];
    if (br == 0) skinny_mma<true>(acc, ssq, WSP(float, WS_ONS), 512, Bt, 512, 16 * nt, 256 * kc, 8, r, q);
    else skinny_mma<false>(acc, ssq, A, 512, Bt, 512, 16 * nt, 256 * kc, 8, r, q);
    float* ms = WSP(float, WS_MS); const bf16* gate = WSP(bf16, WS_PROJ) + (size_t)NTOKP * DINP + C_MG + br * 1024;
#pragma unroll
    for (int mt = 0; mt < 2; ++mt) { const int m = 16 * mt + r; const u32x2 g = *(const u32x2*)(gate + (size_t)m * DINP + 16 * nt + 4 * q);
        float* d = ms + (size_t)m * 1024 + 16 * nt + 4 * q;
        atomicAdd(d + 0, acc[mt][0] * sigmoidf_(bflo(g.x))); atomicAdd(d + 1, acc[mt][1] * sigmoidf_(bfhi(g.x)));
        atomicAdd(d + 2, acc[mt][2] * sigmoidf_(bflo(g.y))); atomicAdd(d + 3, acc[mt][3] * sigmoidf_(bfhi(g.y))); }
}
__device__ __forceinline__ void s6_wo(Frame& F, int t) {
    const int lane = LANE_, r = lane & 15, q = lane >> 4, nt = t >> 2, kc = t & 3;
    f32x4 acc[2]; float ssq[2]; skinny_mma<true>(acc, ssq, WSP(float, WS_MS), 1024, WSP(bf16, WS_WTO), 1024, 16 * nt, 256 * kc, 8, r, q);
    float* x1s = WSP(float, WS_X1S);
#pragma unroll
    for (int mt = 0; mt < 2; ++mt) { float* d = x1s + (size_t)(16 * mt + r) * 1024 + 16 * nt + 4 * q;
#pragma unroll
        for (int i = 0; i < 4; ++i) atomicAdd(d + i, acc[mt][i]); }
}
__device__ __forceinline__ void s7_up(Frame& F, int t) {
    const int lane = LANE_, r = lane & 15, q = lane >> 4, c0 = 16 * t + 4 * q;
    f32x4 au[2], ag[2]; float ssq[2], ssq2[2];
    skinny_mma<true>(au, ssq, WSP(float, WS_X1S), 1024, WSP(bf16, WS_WTUP), 1024, upmap(16 * t), 0, 32, r, q);
    skinny_mma<true>(ag, ssq2, WSP(float, WS_X1S), 1024, WSP(bf16, WS_WTUP), 1024, upmap(DFF + 16 * t), 0, 32, r, q);
    const float* cw = FIN(I_CONVW); const float* cb = FIN(I_CONVB); const float* sconv = FIN(I_SCONV);
    const f32x4 w0 = *(const f32x4*)(cw + c0), w1 = *(const f32x4*)(cw + DFF + c0), w2 = *(const f32x4*)(cw + 2 * DFF + c0), bb = *(const f32x4*)(cb + c0);
#pragma unroll
    for (int mt = 0; mt < 2; ++mt) { const int sb = 16 * mt + r; float s = ssq[mt]; s += __shfl_xor(s, 16); s += __shfl_xor(s, 32); const float rs = rsqrtf(s * (1.f / 1024.f) + EPS);
        const f32x4 g2 = ag[mt] * rs, uu = au[mt] * rs;
        const f32x4 g0 = *(const f32x4*)(sconv + ((size_t)sb * 2 + 0) * DFF + c0), g1 = *(const f32x4*)(sconv + ((size_t)sb * 2 + 1) * DFF + c0);
        float* o = FOUT + O_CONVS + (size_t)sb * 2 * DFF + c0; *(f32x4*)o = g1; *(f32x4*)(o + DFF) = g2;
        float a[4];
#pragma unroll
        for (int i = 0; i < 4; ++i) a[i] = gelu_tanh(bb[i] + w0[i] * g0[i] + w1[i] * g1[i] + w2[i] * g2[i]) * uu[i];
        u32x2 w; w.x = pk2(a[0], a[1]); w.y = pk2(a[2], a[3]);
        *(u32x2*)(WSP(bf16, WS_ACT) + (size_t)(NTOKP + sb) * DFF + c0) = w; }
}
__device__ __forceinline__ void s9_down(Frame& F, int t) {
    const int lane = LANE_, r = lane & 15, q = lane >> 4, nt = t / 11, kc = t % 11;
    f32x4 acc[2]; float ssq[2]; skinny_mma<false>(acc, ssq, WSP(bf16, WS_ACT) + (size_t)NTOKP * DFF, DFF, WSP(bf16, WS_WTDOWN), DFF, 16 * nt, 256 * kc, 8, r, q);
    float* ys = FOUT + O_YS;
#pragma unroll
    for (int mt = 0; mt < 2; ++mt) { float* d = ys + (size_t)(16 * mt + r) * 1024 + 16 * nt + 4 * q;
#pragma unroll
        for (int i = 0; i < 4; ++i) atomicAdd(d + i, acc[mt][i]); }
}

constexpr int N_PHASES = 9;
__global__ void __launch_bounds__(NTHR, 2) mega_fwd(Args args) {
    extern __shared__ __attribute__((aligned(16))) unsigned char lds_raw[];
    cg::grid_group grid = cg::this_grid();
    Frame F;
    F.lds = (LAS unsigned char*)lds_raw;
    F.wave = __builtin_amdgcn_readfirstlane((int)(threadIdx.x >> 6));
    F.G = gridDim.x; F.bid = blockIdx.x; F.gw = F.bid * NWAVES + F.wave; F.NGW = F.G * NWAVES;
    F.in = args.in; F.out = args.out; F.ws = args.ws;
    const int lo = args.ph_lo, hi = args.ph_hi, sub = args.sub;
    volatile LAS unsigned* xst = (volatile LAS unsigned*)(F.lds + 152640);
    if (threadIdx.x < 2) xst[threadIdx.x] = 0u;
    __syncthreads();
    XcdBarrier xbar; xbar.bar = (unsigned*)(GAS unsigned*)(args.ws + WS_CTL); xbar.x = 0; xbar.st = xst;
    if (lo == 0 && hi == N_PHASES) xbar = xcd_barrier_post((unsigned*)(GAS unsigned*)(args.ws + WS_CTL), xst);
#define SUB(i) ((sub >> (i)) & 1)
#ifndef PROBE_REP
#define PROBE_REP -1
#endif
#define IN(k) (lo <= (k) && (k) < hi)
#define REP(k) for (int rep_ = 0; rep_ < ((k) == PROBE_REP ? 2 : 1); ++rep_)
#define SEAM(k) do { if (IN(k) && IN((k) + 1)) { xcd_barrier(xbar); } { GAS unsigned char* w_ = F.ws; asm volatile("" : "+s"(w_)); F.ws = w_; GAS float* o_ = F.out; asm volatile("" : "+s"(o_)); F.out = o_; } } while (0)
    typedef pg8::StaticOrder SO;
    if (lo < 0) grid.sync();
    int p2_gla_sample_task = -1;
    constexpr int KSPLIT = 9;

    REP(0) if (IN(0)) { p0_prologue(F); }
    SEAM(0);
    if (IN(1)) {
        { pg8::Gemm g{WSP(bf16, WS_XN), WSP(bf16, WS_WTIN), MPAD, DINP, 1024}; SO S; S.init(MPAD, DINP, F.G, F.bid);
          pg8::EpiStore E{WSP(bf16, WS_PROJ), DINP, nullptr};
          pg8::gemm_phase<pg8::EpiStore, SO, true, true>(F.lds, g, S, E, F.wave); }
        __syncthreads();
        { pg8::Gemm g{WSP(bf16, WS_MN), WSP(bf16, WS_WTMEM), 512, 1024, 1024}; SO S; S.init(512, 1024, F.G, F.G - 1 - F.bid);
          pg8::EpiStore E{WSP(bf16, WS_MEMPROJ), 1024, nullptr};
          pg8::gemm_phase<pg8::EpiStore, SO, true, true>(F.lds, g, S, E, F.wave); }
        if (F.G == 256) { if (F.bid >= 154 && F.bid < 248) { __syncthreads(); tr_items<1>(F, (LAS float*)(F.lds + F.wave * 16384), (F.bid - 154) * 8 + F.wave, 94 * 8); win_copy(F, F.bid - 154, 94); } }
        else win_copy(F, F.bid, F.G);
    }
    SEAM(1);
    if (IN(2)) {
        if (F.G == 256) {
            const int bid = F.bid;
            { const bool cblk = bid < 136; const int pidx = cblk ? -1 : ((bid - 136) << 3) + F.wave;
                if (SUB(0)) { const int tok0 = 8 * F.gw; VtAcc va; const TokG tg = p2_token_gains(F); TokRaw raw = p2_token_load(F, tok0), nxt;
#define P2_TOK8(J) nxt = p2_token_load(F, tok0 + ((J) < 7 ? (J) + 1 : 7)); p2_token<J>(F, tok0 + (J), raw, va, tg); raw = nxt;
                    P2_TOK8(0) P2_TOK8(1) P2_TOK8(2) P2_TOK8(3) P2_TOK8(4) P2_TOK8(5) P2_TOK8(6) P2_TOK8(7)
#undef P2_TOK8
                    if (!cblk && pidx >= 512 && pidx < 512 + SB) { const int tok = NTOKP + pidx - 512; p2_token<-1>(F, tok, p2_token_load(F, tok), va, tg); }
                    if (!cblk && pidx < 512) p2_memrow(F, pidx); }
                if (!cblk && SUB(3) && pidx >= 832) p2_gla_sample_task = pidx - 832; }
            if (SUB(1) && bid < CMP_TASKS_S + CMP_TASKS_P) p2_compress(F, bid);
            if (SUB(2) && bid >= 136) { for (int bc = bid - 136; bc < 256; bc += 120) { __syncthreads(); p2_gla_chunk(F, bc); } }
            __syncthreads();
            if (p2_gla_sample_task >= 0) p2_gla_sample(F, p2_gla_sample_task);
        } else {
            if (SUB(0)) { VtAcc va; const TokG tg = p2_token_gains(F); for (int tok = F.gw; tok < NTOK; tok += F.NGW) p2_token<-1>(F, tok, p2_token_load(F, tok), va, tg);
            for (int row = F.gw; row < 512; row += F.NGW) p2_memrow(F, row); }
            if (SUB(1)) for (int t = F.bid; t < CMP_TASKS_S + CMP_TASKS_P; t += F.G) p2_compress(F, t);
            if (SUB(2)) for (int bc = F.bid; bc < 256; bc += F.G) { __syncthreads(); p2_gla_chunk(F, bc); }
            __syncthreads();
            if (SUB(3)) for (int t = F.gw; t < SB * 4; t += F.NGW) p2_gla_sample(F, t);
        }
    }
    SEAM(2);
    REP(3) if (IN(3)) {
        nsa_tables(F);
        const float mb = nsa_bound(F);
        if (SUB(4)) for (int n = F.bid; n < 1024; n += F.G) p3_nsa_prompt(F, n, mb);
        __syncthreads();
        if (SUB(7)) for (int t = F.gw; t < 1024; t += F.NGW) p3_gla_scan(F, t);
    }
    SEAM(3);
    if (IN(4)) {
        nsa_tables(F);
        if (!SUB(5)) {} else if (F.G == 256) { if (F.bid >= 192) p3_nsa_sample(F, 255 - F.bid, 0); else if (F.bid >= 128) p3_nsa_sample(F, 191 - F.bid, 1); }
        else for (int t = F.bid; t < SB * 4; t += F.G) p3_nsa_sample(F, t >> 1, t & 1);
        __syncthreads();
        { const float gq = absmax_arr(FIN(I_GXQ), 128, LANE_), gk = absmax_arr(FIN(I_GXK), 128, LANE_);
          const float mbx = 11.313708498984761f * gq * gk * 1.02f * LOG2E;
          if (SUB(6)) { if (F.G == 256) { if (F.bid < 192) { p3_xatt(F, F.bid, mbx); if (F.bid < 64) p3_xatt(F, 192 + F.bid, mbx); } }
                        else for (int t = F.bid; t < 256; t += F.G) p3_xatt(F, t, mbx); } }
        __syncthreads();
        if (!SUB(0)) {} else if (F.G == 256) { if (F.bid >= 64 && F.bid < 192) p3_xatt_sample(F, F.bid - 64); } else for (int t = F.bid; t < SB * 4; t += F.G) p3_xatt_sample(F, t);
        __syncthreads();
        if (!SUB(1)) {} else if (F.G == 256) {
            if (F.bid < 128) { for (int k = 0; k < 3; ++k) p4_gla_out(F, k * 1024 + F.gw); }
            else if (F.bid < 192) { const int wi = ((F.bid - 128) << 3) + F.wave; for (int k = 0; k < 2; ++k) p4_gla_out(F, 3072 + k * 512 + wi); }
        } else for (int t = F.gw; t < 4096; t += F.NGW) p4_gla_out(F, t);
    }
    SEAM(4);
    if (IN(5)) {
        const bf16* gate = WSP(bf16, WS_PROJ) + C_MG;
        for (int t = F.gw; t < 384; t += F.NGW) s5_merge(F, t);
        static_assert(WS_OGLA - WS_ONSA == (size_t)MPAD * 512 * 2 && WS_OX - WS_OGLA == (size_t)MPAD * 512 * 2 && WS_WTGLA - WS_WTNSA == (size_t)1024 * 512 * 2 && WS_WTX - WS_WTGLA == (size_t)1024 * 512 * 2 && MPAD == 65 * 256, "branch operands contiguous");
        { pg8::Gemm g{WSP(bf16, WS_ONSA), WSP(bf16, WS_WTNSA), 3 * MPAD, 3 * 1024, 512}; pg8::MergeOrder S; S.init(F.G, F.bid);
          pg8::EpiMergeAll E{gate, DINP, WSP(bf16, WS_MERGED), 1024};
          pg8::gemm_phase<pg8::EpiMergeAll, pg8::MergeOrder, true, true>(F.lds, g, S, E, F.wave); }
    }
    SEAM(5);
    if (IN(6)) {
        for (int t = F.gw; t < 256; t += F.NGW) s6_wo(F, t);
        pg8::Gemm g{WSP(bf16, WS_MERGED), WSP(bf16, WS_WTO), NTOKP, 1024, 1024}; SO S; S.init(NTOKP, 1024, F.G, F.bid);
        pg8::EpiWo E{FIN(I_XP), FIN(I_XS), WSP(bf16, WS_X1B), WSP(float, WS_SSQ)};
        pg8::gemm_phase<pg8::EpiWo, SO, true, true>(F.lds, g, S, E, F.wave);
    }
    SEAM(6);
    if (IN(7)) {
        { const float* x1s = WSP(float, WS_X1S); float* ys = FOUT + O_YS; for (int i = F.bid * NTHR + TID_; i < SB * 1024; i += F.G * NTHR) ys[i] = x1s[i]; }
        if (F.G == 256) { if (F.bid >= 150) { const int t = (F.bid - 150) * NWAVES + F.wave; if (t < 176) s7_up(F, t); } }
        else for (int t = F.gw; t < 176; t += F.NGW) s7_up(F, t);
        pg8::Gemm g{WSP(bf16, WS_X1B), WSP(bf16, WS_WTUP), 65 * 256, DUP, 1024, 254}; SO S; S.init(65 * 256, DUP, F.G, F.bid);
        pg8::EpiUpConv E{WSP(bf16, WS_ACT), WSP(float, WS_SSQ), FIN(I_CONVW), FIN(I_CONVB), FOUT + O_CONVP, (LAS pg8::u32x4*)(F.lds + RING_BYTES)};
        pg8::gemm_phase<pg8::EpiUpConv, SO, true, true>(F.lds, g, S, E, F.wave);
    }
    SEAM(7);
    if (IN(8)) {
        for (int t = F.gw; t < 704; t += F.NGW) s9_down(F, t);
        pg8::Gemm g{WSP(bf16, WS_ACT), WSP(bf16, WS_WTDOWN), NTOKP, 1024, DFF}; SO S; S.init(NTOKP, 1024, F.G, F.bid);
        pg8::EpiDown E{WSP(bf16, WS_X1B), FOUT + O_Y};
        pg8::gemm_phase<pg8::EpiDown, SO, true, true>(F.lds, g, S, E, F.wave);
    }
#undef IN
#undef SEAM
}

extern "C" void kernel_launch(void* const* d_in, const int* in_sizes, int n_in, void* d_out, int out_size, void* d_ws, size_t ws_size, hipStream_t stream) {
    static int grid = 0;
    if (grid == 0) {
        if (n_in != N_IN || (size_t)out_size != O_END || ws_size < WS_END) {
            fprintf(stderr, "kernel_launch: built for %d inputs, %zu outputs, >= %zu bytes of workspace; got %d, %d, %zu\n", (int)N_IN, (size_t)O_END, (size_t)WS_END, n_in, out_size, ws_size); grid = -1; return; }
        int dev = 0, cus = 0, per_cu = 0;
        if (hipGetDevice(&dev) != hipSuccess || hipDeviceGetAttribute(&cus, hipDeviceAttributeMultiprocessorCount, dev) != hipSuccess) { grid = -1; return; }
        if (hipFuncSetAttribute((const void*)mega_fwd, hipFuncAttributeMaxDynamicSharedMemorySize, LDS_BYTES) != hipSuccess) { fprintf(stderr, "kernel_launch: hipFuncSetAttribute failed\n"); grid = -1; return; }
        if (hipOccupancyMaxActiveBlocksPerMultiprocessor(&per_cu, (const void*)mega_fwd, NTHR, LDS_BYTES) != hipSuccess || per_cu < 1) { fprintf(stderr, "kernel_launch: occupancy query gave %d\n", per_cu); per_cu = 1; }
        (void)hipGetLastError();
        grid = cus * (per_cu < 1 ? 1 : 1);
    }
    if (grid < 0) return;
    ArgsHost a{};
    for (int i = 0; i < N_IN; ++i) a.in[i] = (const float*)d_in[i];
    a.out = (float*)d_out; a.ws = (unsigned char*)d_ws;
#if MK_N_LAUNCHES == 1
    a.ph_lo = 0; a.ph_hi = N_PHASES; a.sub = 0xff;
    (void)hipMemsetAsync((unsigned char*)d_ws + WS_CTL, 0, CTL_BYTES, stream);
    void* kargs[] = {&a};
    hipError_t e = hipLaunchCooperativeKernel((const void*)mega_fwd, dim3(grid), dim3(NTHR), kargs, LDS_BYTES, stream);
    if (e != hipSuccess) fprintf(stderr, "kernel_launch: cooperative launch failed: %s (grid %d)\n", hipGetErrorString(e), grid);
#ifdef PROBE_EXTRA
    a.ph_lo = PROBE_EXTRA; a.ph_hi = PROBE_EXTRA + 1;
#ifdef PROBE_SUB
    a.sub = PROBE_SUB;
#endif
    { void* ka[] = {&a}; (void)hipLaunchKernel((const void*)mega_fwd, dim3(grid), dim3(NTHR), ka, LDS_BYTES, stream); }
#endif
#else
    a.sub = 0xff;
    for (int p = 0; p < N_PHASES; ++p) { a.ph_lo = p; a.ph_hi = p + 1; void* ka[] = {&a}; (void)hipLaunchKernel((const void*)mega_fwd, dim3(grid), dim3(NTHR), ka, LDS_BYTES, stream); }
#endif
}
```
